# Optimizing an MI355X kernel written in HIP

```python
import math
import jax, jax.numpy as jnp
from jax import lax
import numpy as np

D_MODEL = 2048
BATCH = 1
SEQ = 8192
DEPTH = 1

N_META = 16
MIX_WIDTH = D_MODEL
POOL_WIDTH = MIX_WIDTH // 2
CONV_WIDTH = MIX_WIDTH - POOL_WIDTH
POOL_WINDOWS = (2, 4, 8, 16)
N_POOL_GROUPS = len(POOL_WINDOWS)
POOL_GROUP_DIM = POOL_WIDTH // N_POOL_GROUPS
CONV_HEADS = 8
CONV_KSIZE = 31
IN_WIDTH = POOL_WIDTH + 2 * CONV_WIDTH
PEER_HEADS = 8
PEER_NKEYS = 128
PEER_EXPERTS = PEER_NKEYS * PEER_NKEYS
PEER_QDIM = 256
PEER_HALF = PEER_QDIM // 2
PEER_TOPK = 16
PEER_ROWS = 16
RMS_EPS = 1e-6
LN_EPS = 1e-5

kernel_name = "hymba_pool_conformer_peer_block"


def rms_norm(x, g):
    xf = x.astype(jnp.float32)
    y = xf * lax.rsqrt(jnp.mean(xf * xf, axis=-1, keepdims=True) + RMS_EPS)
    return (y * g.astype(jnp.float32)).astype(x.dtype)


def layer_norm(x, g, b):
    xf = x.astype(jnp.float32)
    mu = jnp.mean(xf, axis=-1, keepdims=True)
    xc = xf - mu
    var = jnp.mean(xc * xc, axis=-1, keepdims=True)
    y = xc * lax.rsqrt(var + LN_EPS) * g.astype(jnp.float32) + b.astype(jnp.float32)
    return y.astype(x.dtype)


def causal_multiscale_pool(xp):
    T = xp.shape[1]
    xf = xp.astype(jnp.float32)
    c0 = jnp.concatenate([jnp.zeros_like(xf[:, :1]), jnp.cumsum(xf, axis=1)], axis=1)
    t = jnp.arange(T, dtype=jnp.int32)
    win = jnp.array(POOL_WINDOWS, dtype=jnp.int32)
    lo = jnp.maximum(t[:, None] + 1 - win[None, :], 0)
    g_idx = jnp.arange(N_POOL_GROUPS, dtype=jnp.int32)[None, :]
    window_sum = c0[:, 1:] - c0[:, lo, g_idx]
    count = (t[:, None] + 1 - lo).astype(jnp.float32)
    mean = window_sum / count[None, :, :, None]
    return (mean - xf).astype(xp.dtype)


def causal_depthwise_conv(x, w, b):
    C = x.shape[-1]
    K = w.shape[0]
    y = lax.conv_general_dilated(
        x, w[:, None, :], window_strides=(1,), padding=[(K - 1, 0)],
        dimension_numbers=("NWC", "WIO", "NWC"), feature_group_count=C)
    return y + b


def peer_ffn(xn, wq, keys, down, up):
    B, T, D = xn.shape
    q = (xn @ wq).reshape(B, T, PEER_HEADS, 2, PEER_HALF)
    s = jnp.einsum("bthpd,hpnd->bthpn", q, keys).astype(jnp.float32)
    sv, si = lax.top_k(s, PEER_TOPK)
    cand_score = (sv[..., 0, :, None] + sv[..., 1, None, :]).reshape(B, T, PEER_HEADS, PEER_TOPK * PEER_TOPK)
    cand_idx = (si[..., 0, :, None] * PEER_NKEYS + si[..., 1, None, :]).reshape(B, T, PEER_HEADS, PEER_TOPK * PEER_TOPK)
    top_score, pos = lax.top_k(cand_score, PEER_TOPK)
    expert_idx = jnp.take_along_axis(cand_idx, pos, axis=-1)
    gate = jax.nn.softmax(top_score, axis=-1).astype(xn.dtype)

    R = B * T
    nb = R // PEER_ROWS

    def block(args):
        xb, ib, gb = args
        u = jnp.take(down, ib, axis=0)
        hidden = jnp.einsum("rd,rhkd->rhk", xb, u)
        act = gb * jax.nn.gelu(hidden, approximate=False)
        v = jnp.take(up, ib, axis=0)
        return jnp.einsum("rhk,rhkd->rd", act, v)

    out = lax.map(block, (xn.reshape(nb, PEER_ROWS, D),
                          expert_idx.reshape(nb, PEER_ROWS, PEER_HEADS, PEER_TOPK),
                          gate.reshape(nb, PEER_ROWS, PEER_HEADS, PEER_TOPK)))
    return out.reshape(B, T, D)


def setup_inputs(seed: int = 0) -> dict:
    key = jax.random.key(seed)
    ks = jax.random.split(key, 20)
    f32 = jnp.float32
    D, L = D_MODEL, DEPTH

    def nrm(k, shape, scale):
        return jax.random.normal(k, shape, f32) * scale

    return {
        "x": nrm(ks[0], (BATCH, SEQ, D), 1.0),
        "meta_tokens": nrm(ks[1], (N_META, D), 1.0),
        "mix_norm_g": 1.0 + nrm(ks[2], (L, D), 0.02),
        "w_in": nrm(ks[3], (L, D, IN_WIDTH), D ** -0.5),
        "pool_w": nrm(ks[4], (L, N_POOL_GROUPS, POOL_GROUP_DIM, POOL_GROUP_DIM), POOL_GROUP_DIM ** -0.5),
        "pool_scale": 1.0 + nrm(ks[5], (L, POOL_WIDTH), 0.02),
        "conv_dw_w": nrm(ks[6], (L, CONV_KSIZE, CONV_WIDTH), CONV_KSIZE ** -0.5),
        "conv_dw_b": nrm(ks[7], (L, CONV_WIDTH), 0.02),
        "conv_ln_g": 1.0 + nrm(ks[8], (L, CONV_WIDTH), 0.02),
        "conv_ln_b": nrm(ks[9], (L, CONV_WIDTH), 0.02),
        "conv_pw_w": nrm(ks[10], (L, CONV_WIDTH, CONV_WIDTH), CONV_WIDTH ** -0.5),
        "conv_pw_b": nrm(ks[11], (L, CONV_WIDTH), 0.02),
        "w_out": nrm(ks[12], (L, MIX_WIDTH, D), MIX_WIDTH ** -0.5),
        "ffn_norm_g": 1.0 + nrm(ks[13], (L, D), 0.02),
        "peer_wq": nrm(ks[14], (L, D, PEER_HEADS * PEER_QDIM), D ** -0.5),
        "peer_keys": nrm(ks[15], (L, PEER_HEADS, 2, PEER_NKEYS, PEER_HALF), PEER_HALF ** -0.5),
        "peer_down": nrm(ks[16], (L, PEER_EXPERTS, D), D ** -0.5),
        "peer_up": nrm(ks[17], (L, PEER_EXPERTS, D), 0.5),
        "final_norm_g": 1.0 + nrm(ks[18], (D,), 0.02),
    }


def reference(x, meta_tokens, mix_norm_g, w_in, pool_w, pool_scale, conv_dw_w, conv_dw_b,
              conv_ln_g, conv_ln_b, conv_pw_w, conv_pw_b, w_out, ffn_norm_g, peer_wq,
              peer_keys, peer_down, peer_up, final_norm_g):
    B = x.shape[0]
    meta = jnp.broadcast_to(meta_tokens[None].astype(x.dtype), (B, N_META, D_MODEL))
    h = jnp.concatenate([meta, x], axis=1)
    T = h.shape[1]
    for l in range(DEPTH):
        hn = rms_norm(h, mix_norm_g[l])
        proj = hn @ w_in[l]
        xp = proj[..., :POOL_WIDTH]
        xa = proj[..., POOL_WIDTH:POOL_WIDTH + CONV_WIDTH]
        xg = proj[..., POOL_WIDTH + CONV_WIDTH:]
        pooled = causal_multiscale_pool(xp.reshape(B, T, N_POOL_GROUPS, POOL_GROUP_DIM))
        ya = jnp.einsum("btgc,gcd->btgd", pooled, pool_w[l]).reshape(B, T, POOL_WIDTH) * pool_scale[l]
        glu = xa * jax.nn.sigmoid(xg)
        cv = causal_depthwise_conv(glu, conv_dw_w[l], conv_dw_b[l])
        cv = jax.nn.silu(layer_norm(cv, conv_ln_g[l], conv_ln_b[l]))
        yb = cv @ conv_pw_w[l] + conv_pw_b[l]
        h = h + jnp.concatenate([ya, yb], axis=-1) @ w_out[l]
        h = h + peer_ffn(rms_norm(h, ffn_norm_g[l]), peer_wq[l], peer_keys[l], peer_down[l], peer_up[l])
    h = rms_norm(h, final_norm_g)
    return h[:, N_META:]
```

```cpp
#include <hip/hip_runtime.h>
#include <stdint.h>

#define NT 512
constexpr int D = 2048, SEQ = 8192, NMETA = 16, T = SEQ + NMETA;
constexpr int PWD = 1024, CWD = 1024, INW = 3072;
constexpr int KS = 31;

struct Params {
    const float *x, *meta, *mix_g, *w_in, *pool_w, *pool_scale, *dw_w, *dw_b, *ln_g, *ln_b, *pw_w, *pw_b, *w_out, *ffn_g, *wq, *keys, *down, *up, *fin_g;
    float* out;
    float *hn, *proj, *yab, *pooled, *cv, *h2, *xn, *q, *gate;
    int* idx;
};

__device__ __forceinline__ const float* hrow(const Params& p, int t) { return t < NMETA ? p.meta + (size_t)t * D : p.x + (size_t)(t - NMETA) * D; }

__device__ __forceinline__ float block_sum(float v, float* red) {
#pragma unroll
    for (int o = 32; o; o >>= 1) v += __shfl_xor(v, o);
    __syncthreads();
    if ((threadIdx.x & 63) == 0) red[threadIdx.x >> 6] = v;
    __syncthreads();
    float s = 0.f;
#pragma unroll
    for (int i = 0; i < NT / 64; ++i) s += red[i];
    return s;
}

__device__ void phase_rms(const Params& p, int mode, float* smem, int bid, int nb) {
    const int tid = threadIdx.x;
    for (int t = bid; t < T; t += nb) {
        const float* src = mode == 0 ? hrow(p, t) : p.h2 + (size_t)t * D;
        const float* g = mode == 0 ? p.mix_g : p.ffn_g;
        float* dst = (mode == 0 ? p.hn : p.xn) + (size_t)t * D;
        const float4 v = *(const float4*)(src + tid * 4);
        const float ss = block_sum(v.x * v.x + v.y * v.y + v.z * v.z + v.w * v.w, smem);
        const float r = rsqrtf(ss * (1.0f / D) + 1e-6f);
        const float4 gv = *(const float4*)(g + tid * 4);
        float4 o; o.x = v.x * r * gv.x; o.y = v.y * r * gv.y; o.z = v.z * r * gv.z; o.w = v.w * r * gv.w;
        *(float4*)(dst + tid * 4) = o;
    }
}

struct GemmArgs { const float* A; int lda; const float* B; int ldb; float* C; int ldc; int M, N, K; const float* bias; const float* scale; int resid_h; };

__device__ void phase_gemm(const Params& p, const GemmArgs g, float* smem, int bid, int nb) {
    constexpr int BM = 128, BN = 64, BK = 16;
    float* As = smem;
    float* Bs = smem + BK * (BM + 4);
    const int tid = threadIdx.x, ty = tid >> 4, tx = tid & 15;
    const int tilesM = (g.M + BM - 1) / BM, tilesN = g.N / BN;
    for (int tile = bid; tile < tilesM * tilesN; tile += nb) {
        const int m0 = (tile / tilesN) * BM, n0 = (tile % tilesN) * BN;
        float acc[4][4];
#pragma unroll
        for (int i = 0; i < 4; ++i)
#pragma unroll
            for (int j = 0; j < 4; ++j) acc[i][j] = 0.f;
        const int ar = tid >> 2, akq = tid & 3;
        int arow = m0 + ar; if (arow >= g.M) arow = g.M - 1;
        const float* ap = g.A + (size_t)arow * g.lda + akq * 4;
        const int bk = tid >> 5, bn = (tid & 31) * 2;
        const float* bp = g.B + (size_t)bk * g.ldb + n0 + bn;
        for (int k0 = 0; k0 < g.K; k0 += BK) {
            const float4 av = *(const float4*)(ap + k0);
            const float2 bv = *(const float2*)(bp + (size_t)k0 * g.ldb);
            __syncthreads();
            As[(akq * 4 + 0) * (BM + 4) + ar] = av.x; As[(akq * 4 + 1) * (BM + 4) + ar] = av.y;
            As[(akq * 4 + 2) * (BM + 4) + ar] = av.z; As[(akq * 4 + 3) * (BM + 4) + ar] = av.w;
            *(float2*)(Bs + bk * BN + bn) = bv;
            __syncthreads();
#pragma unroll
            for (int k = 0; k < BK; ++k) {
                const float4 a = *(const float4*)(As + k * (BM + 4) + ty * 4);
                const float4 b = *(const float4*)(Bs + k * BN + tx * 4);
                const float aa[4] = {a.x, a.y, a.z, a.w}, bb[4] = {b.x, b.y, b.z, b.w};
#pragma unroll
                for (int i = 0; i < 4; ++i)
#pragma unroll
                    for (int j = 0; j < 4; ++j) acc[i][j] += aa[i] * bb[j];
            }
        }
#pragma unroll
        for (int i = 0; i < 4; ++i) {
            const int m = m0 + ty * 4 + i;
            if (m < g.M) {
                const int n = n0 + tx * 4;
                float o[4];
#pragma unroll
                for (int j = 0; j < 4; ++j) {
                    float v = acc[i][j];
                    if (g.bias) v += g.bias[n + j];
                    if (g.scale) v *= g.scale[n + j];
                    if (g.resid_h) v += hrow(p, m)[n + j];
                    o[j] = v;
                }
                *(float4*)(g.C + (size_t)m * g.ldc + n) = make_float4(o[0], o[1], o[2], o[3]);
            }
        }
    }
}

__device__ void phase_poolconv(const Params& p, int bid, int nb) {
    const int tid = threadIdx.x;
    for (int t = bid; t < T; t += nb) {
        for (int c = tid; c < PWD; c += NT) {
            const int g = c >> 8, w = 2 << g;
            const int lo = (t + 1 - w) > 0 ? (t + 1 - w) : 0;
            float s = 0.f;
            for (int u = lo; u <= t; ++u) s += p.proj[(size_t)u * INW + c];
            p.pooled[(size_t)t * PWD + c] = s / (float)(t + 1 - lo) - p.proj[(size_t)t * INW + c];
        }
        for (int c = tid; c < CWD; c += NT) {
            float s = p.dw_b[c];
            for (int k = 0; k < KS; ++k) {
                const int u = t - (KS - 1) + k;
                if (u >= 0) {
                    const float a = p.proj[(size_t)u * INW + PWD + c], gt = p.proj[(size_t)u * INW + PWD + CWD + c];
                    s += a / (1.0f + expf(-gt)) * p.dw_w[k * CWD + c];
                }
            }
            p.cv[(size_t)t * CWD + c] = s;
        }
    }
}

__device__ void phase_ln(const Params& p, float* smem, int bid, int nb) {
    const int tid = threadIdx.x;
    for (int t = bid; t < T; t += nb) {
        float* row = p.cv + (size_t)t * CWD;
        const float2 v = *(const float2*)(row + tid * 2);
        const float mu = block_sum(v.x + v.y, smem) * (1.0f / CWD);
        const float dx = v.x - mu, dy = v.y - mu;
        const float var = block_sum(dx * dx + dy * dy, smem) * (1.0f / CWD);
        const float r = rsqrtf(var + 1e-5f);
        const float y0 = dx * r * p.ln_g[tid * 2] + p.ln_b[tid * 2], y1 = dy * r * p.ln_g[tid * 2 + 1] + p.ln_b[tid * 2 + 1];
        float2 o; o.x = y0 / (1.0f + expf(-y0)); o.y = y1 / (1.0f + expf(-y1));
        *(float2*)(row + tid * 2) = o;
    }
}

__device__ void phase_topk(const Params& p, int bid, int nb) {
    const int lane = threadIdx.x & 63, wv = threadIdx.x >> 6;
    constexpr int NW = NT / 64;
    const float NEG = -3.0e38f;
    for (int item = bid * NW + wv; item < T * 8; item += nb * NW) {
        const int t = item >> 3, h = item & 7;
        const float* q = p.q + (size_t)t * D + h * 256;
        float s00 = 0.f, s01 = 0.f, s10 = 0.f, s11 = 0.f;
        {
            const float* k00 = p.keys + ((size_t)(h * 2 + 0) * 128 + lane) * 128;
            const float* k01 = k00 + 64 * 128;
            const float* k10 = p.keys + ((size_t)(h * 2 + 1) * 128 + lane) * 128;
            const float* k11 = k10 + 64 * 128;
            for (int d = 0; d < 128; ++d) {
                const float q0 = q[d], q1 = q[128 + d];
                s00 += q0 * k00[d]; s01 += q0 * k01[d]; s10 += q1 * k10[d]; s11 += q1 * k11[d];
            }
        }
        float sv0 = 0.f, sv1 = 0.f; int si0 = 0, si1 = 0;
#pragma unroll
        for (int ph = 0; ph < 2; ++ph) {
            float a0 = ph == 0 ? s00 : s10, a1 = ph == 0 ? s01 : s11;
            float svv = 0.f; int sii = 0;
            for (int r = 0; r < 16; ++r) {
                float bv; int bi;
                if (a0 >= a1) { bv = a0; bi = lane; } else { bv = a1; bi = lane + 64; }
#pragma unroll
                for (int o = 32; o; o >>= 1) {
                    const float ov = __shfl_xor(bv, o); const int oi = __shfl_xor(bi, o);
                    if (ov > bv || (ov == bv && oi < bi)) { bv = ov; bi = oi; }
                }
                if (lane == r) { svv = bv; sii = bi; }
                if (bi == lane) a0 = NEG; else if (bi == lane + 64) a1 = NEG;
            }
            if (ph == 0) { sv0 = svv; si0 = sii; } else { sv1 = svv; si1 = sii; }
        }
        const float ci = __shfl(sv0, lane >> 2);
        float c0 = ci + __shfl(sv1, (lane & 3) * 4 + 0), c1 = ci + __shfl(sv1, (lane & 3) * 4 + 1);
        float c2 = ci + __shfl(sv1, (lane & 3) * 4 + 2), c3 = ci + __shfl(sv1, (lane & 3) * 4 + 3);
        float ts = 0.f; int tc = 0;
        for (int r = 0; r < 16; ++r) {
            float bv = c0; int bi = lane * 4;
            if (c1 > bv) { bv = c1; bi = lane * 4 + 1; }
            if (c2 > bv) { bv = c2; bi = lane * 4 + 2; }
            if (c3 > bv) { bv = c3; bi = lane * 4 + 3; }
#pragma unroll
            for (int o = 32; o; o >>= 1) {
                const float ov = __shfl_xor(bv, o); const int oi = __shfl_xor(bi, o);
                if (ov > bv || (ov == bv && oi < bi)) { bv = ov; bi = oi; }
            }
            if (lane == r) { ts = bv; tc = bi; }
            if ((bi >> 2) == lane) { const int m = bi & 3; if (m == 0) c0 = NEG; else if (m == 1) c1 = NEG; else if (m == 2) c2 = NEG; else c3 = NEG; }
        }
        const int e0 = __shfl(si0, (tc >> 4) & 15), e1 = __shfl(si1, tc & 15);
        const float mx = __shfl(ts, 0);
        float ex = lane < 16 ? expf(ts - mx) : 0.f;
        float sum = ex;
#pragma unroll
        for (int o = 32; o; o >>= 1) sum += __shfl_xor(sum, o);
        if (lane < 16) {
            p.idx[(size_t)t * 128 + h * 16 + lane] = e0 * 128 + e1;
            p.gate[(size_t)t * 128 + h * 16 + lane] = ex / sum;
        }
    }
}

__device__ void phase_peer(const Params& p, float* smem, int bid, int nb) {
    const int tid = threadIdx.x, lane = tid & 63, wv = tid >> 6;
    float* act_s = smem + 16;
    int* idx_s = (int*)(smem + 16 + 128);
    for (int t = NMETA + bid; t < T; t += nb) {
        const float* xr = p.xn + (size_t)t * D;
        float4 xv[8];
#pragma unroll
        for (int k = 0; k < 8; ++k) xv[k] = *(const float4*)(xr + lane * 4 + 256 * k);
        __syncthreads();
        for (int jj = 0; jj < 16; ++jj) {
            const int j = wv * 16 + jj;
            const int e = p.idx[(size_t)t * 128 + j];
            const float* dr = p.down + (size_t)e * D;
            float s = 0.f;
#pragma unroll
            for (int k = 0; k < 8; ++k) {
                const float4 dv = *(const float4*)(dr + lane * 4 + 256 * k);
                s += xv[k].x * dv.x + xv[k].y * dv.y + xv[k].z * dv.z + xv[k].w * dv.w;
            }
#pragma unroll
            for (int o = 32; o; o >>= 1) s += __shfl_xor(s, o);
            if (lane == 0) {
                const float ge = 0.5f * s * (1.0f + erff(s * 0.70710678118654752f));
                act_s[j] = p.gate[(size_t)t * 128 + j] * ge;
                idx_s[j] = e;
            }
        }
        __syncthreads();
        float o0 = 0.f, o1 = 0.f, o2 = 0.f, o3 = 0.f;
        for (int j = 0; j < 128; ++j) {
            const float a = act_s[j];
            const float4 uv = *(const float4*)(p.up + (size_t)idx_s[j] * D + tid * 4);
            o0 += a * uv.x; o1 += a * uv.y; o2 += a * uv.z; o3 += a * uv.w;
        }
        const float4 hv = *(const float4*)(p.h2 + (size_t)t * D + tid * 4);
        o0 += hv.x; o1 += hv.y; o2 += hv.z; o3 += hv.w;
        const float ss = block_sum(o0 * o0 + o1 * o1 + o2 * o2 + o3 * o3, smem);
        const float r = rsqrtf(ss * (1.0f / D) + 1e-6f);
        const float4 gv = *(const float4*)(p.fin_g + tid * 4);
        *(float4*)(p.out + (size_t)(t - NMETA) * D + tid * 4) = make_float4(o0 * r * gv.x, o1 * r * gv.y, o2 * r * gv.z, o3 * r * gv.w);
    }
}

__device__ __forceinline__ GemmArgs mk(const float* A, int lda, const float* B, int ldb, float* C, int ldc, int M, int N, int K, const float* bias, const float* scale, int rh) {
    GemmArgs g; g.A = A; g.lda = lda; g.B = B; g.ldb = ldb; g.C = C; g.ldc = ldc; g.M = M; g.N = N; g.K = K; g.bias = bias; g.scale = scale; g.resid_h = rh; return g;
}

__device__ void run_phase(const Params& p, int ph, float* smem, int bid, int nb) {
    switch (ph) {
    case 0: phase_rms(p, 0, smem, bid, nb); break;
    case 1: phase_gemm(p, mk(p.hn, D, p.w_in, INW, p.proj, INW, T, INW, D, nullptr, nullptr, 0), smem, bid, nb); break;
    case 2: phase_poolconv(p, bid, nb); break;
    case 3: phase_ln(p, smem, bid, nb); break;
    case 4:
        for (int g = 0; g < 4; ++g)
            phase_gemm(p, mk(p.pooled + g * 256, PWD, p.pool_w + (size_t)g * 256 * 256, 256, p.yab + g * 256, D, T, 256, 256, nullptr, p.pool_scale + g * 256, 0), smem, bid, nb);
        phase_gemm(p, mk(p.cv, CWD, p.pw_w, CWD, p.yab + PWD, D, T, CWD, CWD, p.pw_b, nullptr, 0), smem, bid, nb);
        break;
    case 5: phase_gemm(p, mk(p.yab, D, p.w_out, D, p.h2, D, T, D, D, nullptr, nullptr, 1), smem, bid, nb); break;
    case 6: phase_rms(p, 1, smem, bid, nb); break;
    case 7: phase_gemm(p, mk(p.xn, D, p.wq, D, p.q, D, T, D, D, nullptr, nullptr, 0), smem, bid, nb); break;
    case 8: phase_topk(p, bid, nb); break;
    case 9: phase_peer(p, smem, bid, nb); break;
    }
}

__global__ void __launch_bounds__(NT) k_phase(Params p, int ph) {
    __shared__ float smem[4096];
    run_phase(p, ph, smem, blockIdx.x, gridDim.x);
}

extern "C" void kernel_launch(void* const* d_in, const int* in_sizes, int n_in, void* d_out, int out_size, void* d_ws, size_t ws_size, hipStream_t stream) {
    Params p{};
    p.x = (const float*)d_in[0]; p.meta = (const float*)d_in[1]; p.mix_g = (const float*)d_in[2]; p.w_in = (const float*)d_in[3];
    p.pool_w = (const float*)d_in[4]; p.pool_scale = (const float*)d_in[5]; p.dw_w = (const float*)d_in[6]; p.dw_b = (const float*)d_in[7];
    p.ln_g = (const float*)d_in[8]; p.ln_b = (const float*)d_in[9]; p.pw_w = (const float*)d_in[10]; p.pw_b = (const float*)d_in[11];
    p.w_out = (const float*)d_in[12]; p.ffn_g = (const float*)d_in[13]; p.wq = (const float*)d_in[14]; p.keys = (const float*)d_in[15];
    p.down = (const float*)d_in[16]; p.up = (const float*)d_in[17]; p.fin_g = (const float*)d_in[18];
    p.out = (float*)d_out;
    char* w = (char*)d_ws; size_t off = 0;
    auto take = [&](size_t bytes) { char* r = w + off; off += (bytes + 255) & ~(size_t)255; return r; };
    float* bufA = (float*)take((size_t)T * D * 4);
    float* bufB = (float*)take((size_t)T * INW * 4);
    float* bufC = (float*)take((size_t)T * D * 4);
    p.pooled = (float*)take((size_t)T * PWD * 4);
    p.cv = (float*)take((size_t)T * CWD * 4);
    p.idx = (int*)take((size_t)T * 128 * 4);
    p.gate = (float*)take((size_t)T * 128 * 4);
    p.hn = bufA; p.h2 = bufA; p.proj = bufB; p.xn = bufB; p.yab = bufC; p.q = bufC;
    for (int ph = 0; ph < 10; ++ph) hipLaunchKernelGGL(k_phase, dim3(1024), dim3(NT), 0, stream, p, ph);
}
```

```cpp
#include <hip/hip_runtime.h>
#include <stdint.h>
#include <hip/hip_cooperative_groups.h>
#include <cstdio>
namespace cg = cooperative_groups;

#define NT 512
constexpr int D = 2048, SEQ = 8192, NMETA = 16, T = SEQ + NMETA;
constexpr int PWD = 1024, CWD = 1024, INW = 3072;
constexpr int KS = 31;

struct Params {
    const float *x, *meta, *mix_g, *w_in, *pool_w, *pool_scale, *dw_w, *dw_b, *ln_g, *ln_b, *pw_w, *pw_b, *w_out, *ffn_g, *wq, *keys, *down, *up, *fin_g;
    float* out;
    float *hn, *proj, *yab, *pooled, *cv, *h2, *xn, *q, *gate;
    int* idx;
};

__device__ __forceinline__ const float* hrow(const Params& p, int t) { return t < NMETA ? p.meta + (size_t)t * D : p.x + (size_t)(t - NMETA) * D; }

__device__ __forceinline__ float block_sum(float v, float* red) {
#pragma unroll
    for (int o = 32; o; o >>= 1) v += __shfl_xor(v, o);
    __syncthreads();
    if ((threadIdx.x & 63) == 0) red[threadIdx.x >> 6] = v;
    __syncthreads();
    float s = 0.f;
#pragma unroll
    for (int i = 0; i < NT / 64; ++i) s += red[i];
    return s;
}

__device__ void phase_rms(const Params& p, int mode, float* smem, int bid, int nb) {
    const int tid = threadIdx.x;
    for (int t = bid; t < T; t += nb) {
        const float* src = mode == 0 ? hrow(p, t) : p.h2 + (size_t)t * D;
        const float* g = mode == 0 ? p.mix_g : p.ffn_g;
        float* dst = (mode == 0 ? p.hn : p.xn) + (size_t)t * D;
        const float4 v = *(const float4*)(src + tid * 4);
        const float ss = block_sum(v.x * v.x + v.y * v.y + v.z * v.z + v.w * v.w, smem);
        const float r = rsqrtf(ss * (1.0f / D) + 1e-6f);
        const float4 gv = *(const float4*)(g + tid * 4);
        float4 o; o.x = v.x * r * gv.x; o.y = v.y * r * gv.y; o.z = v.z * r * gv.z; o.w = v.w * r * gv.w;
        *(float4*)(dst + tid * 4) = o;
    }
}

struct GemmArgs { const float* A; int lda; const float* B; int ldb; float* C; int ldc; int M, N, K; const float* bias; const float* scale; int resid_h; };

__device__ void phase_gemm(const Params& p, const GemmArgs g, float* smem, int bid, int nb) {
    constexpr int BM = 128, BN = 64, BK = 16;
    float* As = smem;
    float* Bs = smem + BK * (BM + 4);
    const int tid = threadIdx.x, ty = tid >> 4, tx = tid & 15;
    const int tilesM = (g.M + BM - 1) / BM, tilesN = g.N / BN;
    for (int tile = bid; tile < tilesM * tilesN; tile += nb) {
        const int m0 = (tile / tilesN) * BM, n0 = (tile % tilesN) * BN;
        float acc[4][4];
#pragma unroll
        for (int i = 0; i < 4; ++i)
#pragma unroll
            for (int j = 0; j < 4; ++j) acc[i][j] = 0.f;
        const int ar = tid >> 2, akq = tid & 3;
        int arow = m0 + ar; if (arow >= g.M) arow = g.M - 1;
        const float* ap = g.A + (size_t)arow * g.lda + akq * 4;
        const int bk = tid >> 5, bn = (tid & 31) * 2;
        const float* bp = g.B + (size_t)bk * g.ldb + n0 + bn;
        for (int k0 = 0; k0 < g.K; k0 += BK) {
            const float4 av = *(const float4*)(ap + k0);
            const float2 bv = *(const float2*)(bp + (size_t)k0 * g.ldb);
            __syncthreads();
            As[(akq * 4 + 0) * (BM + 4) + ar] = av.x; As[(akq * 4 + 1) * (BM + 4) + ar] = av.y;
            As[(akq * 4 + 2) * (BM + 4) + ar] = av.z; As[(akq * 4 + 3) * (BM + 4) + ar] = av.w;
            *(float2*)(Bs + bk * BN + bn) = bv;
            __syncthreads();
#pragma unroll
            for (int k = 0; k < BK; ++k) {
                const float4 a = *(const float4*)(As + k * (BM + 4) + ty * 4);
                const float4 b = *(const float4*)(Bs + k * BN + tx * 4);
                const float aa[4] = {a.x, a.y, a.z, a.w}, bb[4] = {b.x, b.y, b.z, b.w};
#pragma unroll
                for (int i = 0; i < 4; ++i)
#pragma unroll
                    for (int j = 0; j < 4; ++j) acc[i][j] += aa[i] * bb[j];
            }
        }
#pragma unroll
        for (int i = 0; i < 4; ++i) {
            const int m = m0 + ty * 4 + i;
            if (m < g.M) {
                const int n = n0 + tx * 4;
                float o[4];
#pragma unroll
                for (int j = 0; j < 4; ++j) {
                    float v = acc[i][j];
                    if (g.bias) v += g.bias[n + j];
                    if (g.scale) v *= g.scale[n + j];
                    if (g.resid_h) v += hrow(p, m)[n + j];
                    o[j] = v;
                }
                *(float4*)(g.C + (size_t)m * g.ldc + n) = make_float4(o[0], o[1], o[2], o[3]);
            }
        }
    }
}

__device__ void phase_poolconv(const Params& p, int bid, int nb) {
    const int tid = threadIdx.x;
    for (int t = bid; t < T; t += nb) {
        for (int c = tid; c < PWD; c += NT) {
            const int g = c >> 8, w = 2 << g;
            const int lo = (t + 1 - w) > 0 ? (t + 1 - w) : 0;
            float s = 0.f;
            for (int u = lo; u <= t; ++u) s += p.proj[(size_t)u * INW + c];
            p.pooled[(size_t)t * PWD + c] = s / (float)(t + 1 - lo) - p.proj[(size_t)t * INW + c];
        }
        for (int c = tid; c < CWD; c += NT) {
            float s = p.dw_b[c];
            for (int k = 0; k < KS; ++k) {
                const int u = t - (KS - 1) + k;
                if (u >= 0) {
                    const float a = p.proj[(size_t)u * INW + PWD + c], gt = p.proj[(size_t)u * INW + PWD + CWD + c];
                    s += a / (1.0f + expf(-gt)) * p.dw_w[k * CWD + c];
                }
            }
            p.cv[(size_t)t * CWD + c] = s;
        }
    }
}

__device__ void phase_ln(const Params& p, float* smem, int bid, int nb) {
    const int tid = threadIdx.x;
    for (int t = bid; t < T; t += nb) {
        float* row = p.cv + (size_t)t * CWD;
        const float2 v = *(const float2*)(row + tid * 2);
        const float mu = block_sum(v.x + v.y, smem) * (1.0f / CWD);
        const float dx = v.x - mu, dy = v.y - mu;
        const float var = block_sum(dx * dx + dy * dy, smem) * (1.0f / CWD);
        const float r = rsqrtf(var + 1e-5f);
        const float y0 = dx * r * p.ln_g[tid * 2] + p.ln_b[tid * 2], y1 = dy * r * p.ln_g[tid * 2 + 1] + p.ln_b[tid * 2 + 1];
        float2 o; o.x = y0 / (1.0f + expf(-y0)); o.y = y1 / (1.0f + expf(-y1));
        *(float2*)(row + tid * 2) = o;
    }
}

__device__ void phase_topk(const Params& p, int bid, int nb) {
    const int lane = threadIdx.x & 63, wv = threadIdx.x >> 6;
    constexpr int NW = NT / 64;
    const float NEG = -3.0e38f;
    for (int item = bid * NW + wv; item < T * 8; item += nb * NW) {
        const int t = item >> 3, h = item & 7;
        const float* q = p.q + (size_t)t * D + h * 256;
        float s00 = 0.f, s01 = 0.f, s10 = 0.f, s11 = 0.f;
        {
            const float* k00 = p.keys + ((size_t)(h * 2 + 0) * 128 + lane) * 128;
            const float* k01 = k00 + 64 * 128;
            const float* k10 = p.keys + ((size_t)(h * 2 + 1) * 128 + lane) * 128;
            const float* k11 = k10 + 64 * 128;
            for (int d = 0; d < 128; ++d) {
                const float q0 = q[d], q1 = q[128 + d];
                s00 += q0 * k00[d]; s01 += q0 * k01[d]; s10 += q1 * k10[d]; s11 += q1 * k11[d];
            }
        }
        float sv0 = 0.f, sv1 = 0.f; int si0 = 0, si1 = 0;
#pragma unroll
        for (int ph = 0; ph < 2; ++ph) {
            float a0 = ph == 0 ? s00 : s10, a1 = ph == 0 ? s01 : s11;
            float svv = 0.f; int sii = 0;
            for (int r = 0; r < 16; ++r) {
                float bv; int bi;
                if (a0 >= a1) { bv = a0; bi = lane; } else { bv = a1; bi = lane + 64; }
#pragma unroll
                for (int o = 32; o; o >>= 1) {
                    const float ov = __shfl_xor(bv, o); const int oi = __shfl_xor(bi, o);
                    if (ov > bv || (ov == bv && oi < bi)) { bv = ov; bi = oi; }
                }
                if (lane == r) { svv = bv; sii = bi; }
                if (bi == lane) a0 = NEG; else if (bi == lane + 64) a1 = NEG;
            }
            if (ph == 0) { sv0 = svv; si0 = sii; } else { sv1 = svv; si1 = sii; }
        }
        const float ci = __shfl(sv0, lane >> 2);
        float c0 = ci + __shfl(sv1, (lane & 3) * 4 + 0), c1 = ci + __shfl(sv1, (lane & 3) * 4 + 1);
        float c2 = ci + __shfl(sv1, (lane & 3) * 4 + 2), c3 = ci + __shfl(sv1, (lane & 3) * 4 + 3);
        float ts = 0.f; int tc = 0;
        for (int r = 0; r < 16; ++r) {
            float bv = c0; int bi = lane * 4;
            if (c1 > bv) { bv = c1; bi = lane * 4 + 1; }
            if (c2 > bv) { bv = c2; bi = lane * 4 + 2; }
            if (c3 > bv) { bv = c3; bi = lane * 4 + 3; }
#pragma unroll
            for (int o = 32; o; o >>= 1) {
                const float ov = __shfl_xor(bv, o); const int oi = __shfl_xor(bi, o);
                if (ov > bv || (ov == bv && oi < bi)) { bv = ov; bi = oi; }
            }
            if (lane == r) { ts = bv; tc = bi; }
            if ((bi >> 2) == lane) { const int m = bi & 3; if (m == 0) c0 = NEG; else if (m == 1) c1 = NEG; else if (m == 2) c2 = NEG; else c3 = NEG; }
        }
        const int e0 = __shfl(si0, (tc >> 4) & 15), e1 = __shfl(si1, tc & 15);
        const float mx = __shfl(ts, 0);
        float ex = lane < 16 ? expf(ts - mx) : 0.f;
        float sum = ex;
#pragma unroll
        for (int o = 32; o; o >>= 1) sum += __shfl_xor(sum, o);
        if (lane < 16) {
            p.idx[(size_t)t * 128 + h * 16 + lane] = e0 * 128 + e1;
            p.gate[(size_t)t * 128 + h * 16 + lane] = ex / sum;
        }
    }
}

__device__ void phase_peer(const Params& p, float* smem, int bid, int nb) {
    const int tid = threadIdx.x, lane = tid & 63, wv = tid >> 6;
    float* act_s = smem + 16;
    int* idx_s = (int*)(smem + 16 + 128);
    for (int t = NMETA + bid; t < T; t += nb) {
        const float* xr = p.xn + (size_t)t * D;
        float4 xv[8];
#pragma unroll
        for (int k = 0; k < 8; ++k) xv[k] = *(const float4*)(xr + lane * 4 + 256 * k);
        __syncthreads();
        for (int jj = 0; jj < 16; ++jj) {
            const int j = wv * 16 + jj;
            const int e = p.idx[(size_t)t * 128 + j];
            const float* dr = p.down + (size_t)e * D;
            float s = 0.f;
#pragma unroll
            for (int k = 0; k < 8; ++k) {
                const float4 dv = *(const float4*)(dr + lane * 4 + 256 * k);
                s += xv[k].x * dv.x + xv[k].y * dv.y + xv[k].z * dv.z + xv[k].w * dv.w;
            }
#pragma unroll
            for (int o = 32; o; o >>= 1) s += __shfl_xor(s, o);
            if (lane == 0) {
                const float ge = 0.5f * s * (1.0f + erff(s * 0.70710678118654752f));
                act_s[j] = p.gate[(size_t)t * 128 + j] * ge;
                idx_s[j] = e;
            }
        }
        __syncthreads();
        float o0 = 0.f, o1 = 0.f, o2 = 0.f, o3 = 0.f;
        for (int j = 0; j < 128; ++j) {
            const float a = act_s[j];
            const float4 uv = *(const float4*)(p.up + (size_t)idx_s[j] * D + tid * 4);
            o0 += a * uv.x; o1 += a * uv.y; o2 += a * uv.z; o3 += a * uv.w;
        }
        const float4 hv = *(const float4*)(p.h2 + (size_t)t * D + tid * 4);
        o0 += hv.x; o1 += hv.y; o2 += hv.z; o3 += hv.w;
        const float ss = block_sum(o0 * o0 + o1 * o1 + o2 * o2 + o3 * o3, smem);
        const float r = rsqrtf(ss * (1.0f / D) + 1e-6f);
        const float4 gv = *(const float4*)(p.fin_g + tid * 4);
        *(float4*)(p.out + (size_t)(t - NMETA) * D + tid * 4) = make_float4(o0 * r * gv.x, o1 * r * gv.y, o2 * r * gv.z, o3 * r * gv.w);
    }
}

__device__ __forceinline__ GemmArgs mk(const float* A, int lda, const float* B, int ldb, float* C, int ldc, int M, int N, int K, const float* bias, const float* scale, int rh) {
    GemmArgs g; g.A = A; g.lda = lda; g.B = B; g.ldb = ldb; g.C = C; g.ldc = ldc; g.M = M; g.N = N; g.K = K; g.bias = bias; g.scale = scale; g.resid_h = rh; return g;
}

__device__ void run_phase(const Params& p, int ph, float* smem, int bid, int nb) {
    switch (ph) {
    case 0: phase_rms(p, 0, smem, bid, nb); break;
    case 1: phase_gemm(p, mk(p.hn, D, p.w_in, INW, p.proj, INW, T, INW, D, nullptr, nullptr, 0), smem, bid, nb); break;
    case 2: phase_poolconv(p, bid, nb); break;
    case 3: phase_ln(p, smem, bid, nb); break;
    case 4:
        for (int g = 0; g < 4; ++g)
            phase_gemm(p, mk(p.pooled + g * 256, PWD, p.pool_w + (size_t)g * 256 * 256, 256, p.yab + g * 256, D, T, 256, 256, nullptr, p.pool_scale + g * 256, 0), smem, bid, nb);
        phase_gemm(p, mk(p.cv, CWD, p.pw_w, CWD, p.yab + PWD, D, T, CWD, CWD, p.pw_b, nullptr, 0), smem, bid, nb);
        break;
    case 5: phase_gemm(p, mk(p.yab, D, p.w_out, D, p.h2, D, T, D, D, nullptr, nullptr, 1), smem, bid, nb); break;
    case 6: phase_rms(p, 1, smem, bid, nb); break;
    case 7: phase_gemm(p, mk(p.xn, D, p.wq, D, p.q, D, T, D, D, nullptr, nullptr, 0), smem, bid, nb); break;
    case 8: phase_topk(p, bid, nb); break;
    case 9: phase_peer(p, smem, bid, nb); break;
    }
}

__global__ void __launch_bounds__(NT) k_mega(Params p) {
    __shared__ float smem[4096];
    cg::grid_group grid = cg::this_grid();
    for (int ph = 0; ph < 10; ++ph) {
        run_phase(p, ph, smem, blockIdx.x, gridDim.x);
        if (ph < 9) grid.sync();
    }
}

extern "C" void kernel_launch(void* const* d_in, const int* in_sizes, int n_in, void* d_out, int out_size, void* d_ws, size_t ws_size, hipStream_t stream) {
    Params p{};
    p.x = (const float*)d_in[0]; p.meta = (const float*)d_in[1]; p.mix_g = (const float*)d_in[2]; p.w_in = (const float*)d_in[3];
    p.pool_w = (const float*)d_in[4]; p.pool_scale = (const float*)d_in[5]; p.dw_w = (const float*)d_in[6]; p.dw_b = (const float*)d_in[7];
    p.ln_g = (const float*)d_in[8]; p.ln_b = (const float*)d_in[9]; p.pw_w = (const float*)d_in[10]; p.pw_b = (const float*)d_in[11];
    p.w_out = (const float*)d_in[12]; p.ffn_g = (const float*)d_in[13]; p.wq = (const float*)d_in[14]; p.keys = (const float*)d_in[15];
    p.down = (const float*)d_in[16]; p.up = (const float*)d_in[17]; p.fin_g = (const float*)d_in[18];
    p.out = (float*)d_out;
    char* w = (char*)d_ws; size_t off = 0;
    auto take = [&](size_t bytes) { char* r = w + off; off += (bytes + 255) & ~(size_t)255; return r; };
    float* bufA = (float*)take((size_t)T * D * 4);
    float* bufB = (float*)take((size_t)T * INW * 4);
    float* bufC = (float*)take((size_t)T * D * 4);
    p.pooled = (float*)take((size_t)T * PWD * 4);
    p.cv = (float*)take((size_t)T * CWD * 4);
    p.idx = (int*)take((size_t)T * 128 * 4);
    p.gate = (float*)take((size_t)T * 128 * 4);
    p.hn = bufA; p.h2 = bufA; p.proj = bufB; p.xn = bufB; p.yab = bufC; p.q = bufC;
    static int grid_blocks = 0;
    if (!grid_blocks) {
        int dev = 0, cus = 0, per_cu = 0;
        hipGetDevice(&dev);
        hipDeviceGetAttribute(&cus, hipDeviceAttributeMultiprocessorCount, dev);
        hipOccupancyMaxActiveBlocksPerMultiprocessor(&per_cu, k_mega, NT, 0);
        if (per_cu > 2) per_cu = 2;
        grid_blocks = cus * per_cu;
    }
    void* args[] = {&p};
    hipError_t e = hipLaunchCooperativeKernel((void*)k_mega, dim3(grid_blocks), dim3(NT), args, 0, stream);
    if (e != hipSuccess) fprintf(stderr, "cooperative launch failed: %s (grid %d)\n", hipGetErrorString(e), grid_blocks);
}
```

```cpp
#include <hip/hip_runtime.h>
#include <hip/hip_cooperative_groups.h>
#include <stdint.h>
#include <cstdio>
namespace cg = cooperative_groups;

#define NT 512
#define LAS __attribute__((address_space(3)))
typedef unsigned short bf16_t;
typedef short bf16x8 __attribute__((ext_vector_type(8)));
typedef float f32x4 __attribute__((ext_vector_type(4)));
typedef unsigned u32x4 __attribute__((ext_vector_type(4)));
typedef unsigned u32x2 __attribute__((ext_vector_type(2)));

constexpr int D = 2048, SEQ = 8192, NMETA = 16, T = SEQ + NMETA;
constexpr int PWD = 1024, CWD = 1024, INW = 3072;
constexpr int KS = 31;
constexpr int RPAD = 240, RT = 8448;
constexpr int LDS_BYTES = 147456;

struct Params {
    const float *x, *meta, *mix_g, *w_in, *pool_w, *pool_scale, *dw_w, *dw_b, *ln_g, *ln_b, *pw_w, *pw_b, *w_out, *ffn_g, *wq, *keys, *down, *up, *fin_g;
    float* out;
    float *hn, *proj, *yab, *pooled, *cv, *h2, *xn, *q, *gate;
    int* idx;
    bf16_t *hnb, *w_in_t, *xp, *glu, *pooledb, *cvnb, *yabb, *h2b, *pool_wt, *pw_t, *w_out_t, *wq_t, *keysb, *qb, *downb, *upb;
    float *ssq, *rstd;
};

__device__ __forceinline__ unsigned cvt_pk_bf16(float lo, float hi) { unsigned r; asm volatile("v_cvt_pk_bf16_f32 %0, %1, %2" : "=v"(r) : "v"(lo), "v"(hi)); return r; }
__device__ __forceinline__ float wave_sum(float v) {
#pragma unroll
    for (int o = 1; o < 64; o <<= 1) v += __shfl_xor(v, o);
    return v;
}

__device__ __forceinline__ const float* hrow(const Params& p, int t) { return t < NMETA ? p.meta + (size_t)t * D : p.x + (size_t)(t - NMETA) * D; }

__device__ __forceinline__ float block_sum(float v, float* red) {
#pragma unroll
    for (int o = 32; o; o >>= 1) v += __shfl_xor(v, o);
    __syncthreads();
    if ((threadIdx.x & 63) == 0) red[threadIdx.x >> 6] = v;
    __syncthreads();
    float s = 0.f;
#pragma unroll
    for (int i = 0; i < NT / 64; ++i) s += red[i];
    return s;
}

__device__ __forceinline__ void phase_rms(const Params& p, int mode, float* smem, int bid, int nb) {
    const int tid = threadIdx.x;
    for (int t = bid; t < SEQ; t += nb) {
        const float* src = mode == 0 ? hrow(p, t) : p.h2 + (size_t)t * D;
        const float* g = mode == 0 ? p.mix_g : p.ffn_g;
        float* dst = (mode == 0 ? p.hn : p.xn) + (size_t)t * D;
        const float4 v = *(const float4*)(src + tid * 4);
        const float ss = block_sum(v.x * v.x + v.y * v.y + v.z * v.z + v.w * v.w, smem);
        const float r = rsqrtf(ss * (1.0f / D) + 1e-6f);
        const float4 gv = *(const float4*)(g + tid * 4);
        float4 o; o.x = v.x * r * gv.x; o.y = v.y * r * gv.y; o.z = v.z * r * gv.z; o.w = v.w * r * gv.w;
        *(float4*)(dst + tid * 4) = o;
    }
}

struct GemmArgs { const float* A; int lda; const float* B; int ldb; float* C; int ldc; int M, N, K; const float* bias; const float* scale; int resid_h; };

__device__ __forceinline__ void phase_gemm(const Params& p, const GemmArgs g, float* smem, int bid, int nb) {
    constexpr int BM = 128, BN = 64, BK = 16;
    float* As = smem;
    float* Bs = smem + BK * (BM + 4);
    const int tid = threadIdx.x, ty = tid >> 4, tx = tid & 15;
    const int tilesM = (g.M + BM - 1) / BM, tilesN = g.N / BN;
    for (int tile = bid; tile < tilesM * tilesN; tile += nb) {
        const int m0 = (tile / tilesN) * BM, n0 = (tile % tilesN) * BN;
        float acc[4][4];
#pragma unroll
        for (int i = 0; i < 4; ++i)
#pragma unroll
            for (int j = 0; j < 4; ++j) acc[i][j] = 0.f;
        const int ar = tid >> 2, akq = tid & 3;
        int arow = m0 + ar; if (arow >= g.M) arow = g.M - 1;
        const float* ap = g.A + (size_t)arow * g.lda + akq * 4;
        const int bk = tid >> 5, bn = (tid & 31) * 2;
        const float* bp = g.B + (size_t)bk * g.ldb + n0 + bn;
        for (int k0 = 0; k0 < g.K; k0 += BK) {
            const float4 av = *(const float4*)(ap + k0);
            const float2 bv = *(const float2*)(bp + (size_t)k0 * g.ldb);
            __syncthreads();
            As[(akq * 4 + 0) * (BM + 4) + ar] = av.x; As[(akq * 4 + 1) * (BM + 4) + ar] = av.y;
            As[(akq * 4 + 2) * (BM + 4) + ar] = av.z; As[(akq * 4 + 3) * (BM + 4) + ar] = av.w;
            *(float2*)(Bs + bk * BN + bn) = bv;
            __syncthreads();
#pragma unroll
            for (int k = 0; k < BK; ++k) {
                const float4 a = *(const float4*)(As + k * (BM + 4) + ty * 4);
                const float4 b = *(const float4*)(Bs + k * BN + tx * 4);
                const float aa[4] = {a.x, a.y, a.z, a.w}, bb[4] = {b.x, b.y, b.z, b.w};
#pragma unroll
                for (int i = 0; i < 4; ++i)
#pragma unroll
                    for (int j = 0; j < 4; ++j) acc[i][j] += aa[i] * bb[j];
            }
        }
#pragma unroll
        for (int i = 0; i < 4; ++i) {
            const int m = m0 + ty * 4 + i;
            if (m < g.M) {
                const int n = n0 + tx * 4;
                float o[4];
#pragma unroll
                for (int j = 0; j < 4; ++j) {
                    float v = acc[i][j];
                    if (g.bias) v += g.bias[n + j];
                    if (g.scale) v *= g.scale[n + j];
                    if (g.resid_h) v += hrow(p, m)[n + j];
                    o[j] = v;
                }
                *(float4*)(g.C + (size_t)m * g.ldc + n) = make_float4(o[0], o[1], o[2], o[3]);
            }
        }
    }
}

__device__ __forceinline__ void phase_poolconv(const Params& p, int bid, int nb) {
    const int tid = threadIdx.x;
    for (int t = bid; t < T; t += nb) {
        for (int c = tid; c < PWD; c += NT) {
            const int g = c >> 8, w = 2 << g;
            const int lo = (t + 1 - w) > 0 ? (t + 1 - w) : 0;
            float s = 0.f;
            for (int u = lo; u <= t; ++u) s += p.proj[(size_t)u * INW + c];
            p.pooled[(size_t)t * PWD + c] = s / (float)(t + 1 - lo) - p.proj[(size_t)t * INW + c];
        }
        for (int c = tid; c < CWD; c += NT) {
            float s = p.dw_b[c];
            for (int k = 0; k < KS; ++k) {
                const int u = t - (KS - 1) + k;
                if (u >= 0) {
                    const float a = p.proj[(size_t)u * INW + PWD + c], gt = p.proj[(size_t)u * INW + PWD + CWD + c];
                    s += a / (1.0f + expf(-gt)) * p.dw_w[k * CWD + c];
                }
            }
            p.cv[(size_t)t * CWD + c] = s;
        }
    }
}

__device__ __forceinline__ void phase_ln(const Params& p, float* smem, int bid, int nb) {
    const int tid = threadIdx.x;
    for (int t = bid; t < T; t += nb) {
        float* row = p.cv + (size_t)t * CWD;
        const float2 v = *(const float2*)(row + tid * 2);
        const float mu = block_sum(v.x + v.y, smem) * (1.0f / CWD);
        const float dx = v.x - mu, dy = v.y - mu;
        const float var = block_sum(dx * dx + dy * dy, smem) * (1.0f / CWD);
        const float r = rsqrtf(var + 1e-5f);
        const float y0 = dx * r * p.ln_g[tid * 2] + p.ln_b[tid * 2], y1 = dy * r * p.ln_g[tid * 2 + 1] + p.ln_b[tid * 2 + 1];
        float2 o; o.x = y0 / (1.0f + expf(-y0)); o.y = y1 / (1.0f + expf(-y1));
        *(float2*)(row + tid * 2) = o;
    }
}

__device__ __forceinline__ void phase_topk(const Params& p, int bid, int nb) {
    const int lane = threadIdx.x & 63, wv = threadIdx.x >> 6;
    constexpr int NW = NT / 64;
    const float NEG = -3.0e38f;
    for (int item = bid * NW + wv; item < SEQ * 8; item += nb * NW) {
        const int t = item >> 3, h = item & 7;
        const float* q = p.q + (size_t)t * D + h * 256;
        float s00 = 0.f, s01 = 0.f, s10 = 0.f, s11 = 0.f;
        {
            const float* k00 = p.keys + ((size_t)(h * 2 + 0) * 128 + lane) * 128;
            const float* k01 = k00 + 64 * 128;
            const float* k10 = p.keys + ((size_t)(h * 2 + 1) * 128 + lane) * 128;
            const float* k11 = k10 + 64 * 128;
            for (int d = 0; d < 128; ++d) {
                const float q0 = q[d], q1 = q[128 + d];
                s00 += q0 * k00[d]; s01 += q0 * k01[d]; s10 += q1 * k10[d]; s11 += q1 * k11[d];
            }
        }
        float sv0 = 0.f, sv1 = 0.f; int si0 = 0, si1 = 0;
#pragma unroll
        for (int ph = 0; ph < 2; ++ph) {
            float a0 = ph == 0 ? s00 : s10, a1 = ph == 0 ? s01 : s11;
            float svv = 0.f; int sii = 0;
            for (int r = 0; r < 16; ++r) {
                float bv; int bi;
                if (a0 >= a1) { bv = a0; bi = lane; } else { bv = a1; bi = lane + 64; }
#pragma unroll
                for (int o = 32; o; o >>= 1) {
                    const float ov = __shfl_xor(bv, o); const int oi = __shfl_xor(bi, o);
                    if (ov > bv || (ov == bv && oi < bi)) { bv = ov; bi = oi; }
                }
                if (lane == r) { svv = bv; sii = bi; }
                if (bi == lane) a0 = NEG; else if (bi == lane + 64) a1 = NEG;
            }
            if (ph == 0) { sv0 = svv; si0 = sii; } else { sv1 = svv; si1 = sii; }
        }
        const float ci = __shfl(sv0, lane >> 2);
        float c0 = ci + __shfl(sv1, (lane & 3) * 4 + 0), c1 = ci + __shfl(sv1, (lane & 3) * 4 + 1);
        float c2 = ci + __shfl(sv1, (lane & 3) * 4 + 2), c3 = ci + __shfl(sv1, (lane & 3) * 4 + 3);
        float ts = 0.f; int tc = 0;
        for (int r = 0; r < 16; ++r) {
            float bv = c0; int bi = lane * 4;
            if (c1 > bv) { bv = c1; bi = lane * 4 + 1; }
            if (c2 > bv) { bv = c2; bi = lane * 4 + 2; }
            if (c3 > bv) { bv = c3; bi = lane * 4 + 3; }
#pragma unroll
            for (int o = 32; o; o >>= 1) {
                const float ov = __shfl_xor(bv, o); const int oi = __shfl_xor(bi, o);
                if (ov > bv || (ov == bv && oi < bi)) { bv = ov; bi = oi; }
            }
            if (lane == r) { ts = bv; tc = bi; }
            if ((bi >> 2) == lane) { const int m = bi & 3; if (m == 0) c0 = NEG; else if (m == 1) c1 = NEG; else if (m == 2) c2 = NEG; else c3 = NEG; }
        }
        const int e0 = __shfl(si0, (tc >> 4) & 15), e1 = __shfl(si1, tc & 15);
        const float mx = __shfl(ts, 0);
        float ex = lane < 16 ? expf(ts - mx) : 0.f;
        float sum = ex;
#pragma unroll
        for (int o = 32; o; o >>= 1) sum += __shfl_xor(sum, o);
        if (lane < 16) {
            p.idx[(size_t)t * 128 + h * 16 + lane] = e0 * 128 + e1;
            p.gate[(size_t)t * 128 + h * 16 + lane] = ex / sum;
        }
    }
}

__device__ __forceinline__ void phase_peer(const Params& p, float* smem, int bid, int nb) {
    const int tid = threadIdx.x, lane = tid & 63, wv = tid >> 6;
    float* act_s = smem + 16;
    int* idx_s = (int*)(smem + 16 + 128);
    for (int t = bid; t < SEQ; t += nb) {
        const float* xr = p.xn + (size_t)t * D;
        float4 xv[8];
#pragma unroll
        for (int k = 0; k < 8; ++k) xv[k] = *(const float4*)(xr + lane * 4 + 256 * k);
        __syncthreads();
        for (int jj = 0; jj < 16; ++jj) {
            const int j = wv * 16 + jj;
            const int e = p.idx[(size_t)t * 128 + j];
            const float* dr = p.down + (size_t)e * D;
            float s = 0.f;
#pragma unroll
            for (int k = 0; k < 8; ++k) {
                const float4 dv = *(const float4*)(dr + lane * 4 + 256 * k);
                s += xv[k].x * dv.x + xv[k].y * dv.y + xv[k].z * dv.z + xv[k].w * dv.w;
            }
#pragma unroll
            for (int o = 32; o; o >>= 1) s += __shfl_xor(s, o);
            if (lane == 0) {
                const float ge = 0.5f * s * (1.0f + erff(s * 0.70710678118654752f));
                act_s[j] = p.gate[(size_t)t * 128 + j] * ge;
                idx_s[j] = e;
            }
        }
        __syncthreads();
        float o0 = 0.f, o1 = 0.f, o2 = 0.f, o3 = 0.f;
        for (int j = 0; j < 128; ++j) {
            const float a = act_s[j];
            const float4 uv = *(const float4*)(p.up + (size_t)idx_s[j] * D + tid * 4);
            o0 += a * uv.x; o1 += a * uv.y; o2 += a * uv.z; o3 += a * uv.w;
        }
        const float4 hv = *(const float4*)(p.h2 + (size_t)t * D + tid * 4);
        o0 += hv.x; o1 += hv.y; o2 += hv.z; o3 += hv.w;
        const float ss = block_sum(o0 * o0 + o1 * o1 + o2 * o2 + o3 * o3, smem);
        const float r = rsqrtf(ss * (1.0f / D) + 1e-6f);
        const float4 gv = *(const float4*)(p.fin_g + tid * 4);
        *(float4*)(p.out + (size_t)t * D + tid * 4) = make_float4(o0 * r * gv.x, o1 * r * gv.y, o2 * r * gv.z, o3 * r * gv.w);
    }
}


namespace pg8 {
constexpr int BM = 256, BK = 64, HALF = 128, HTB = HALF * BK * 2, STAGE_BYTES = 8 * HTB, NXCD = 8, WGM = 8;
__device__ __forceinline__ int lds_byte(int r, int c) { const int st = (r >> 4) * 2 + (c >> 5), rr = r & 15, cc = c & 31, ob = rr * 64 + cc * 2; return st * 1024 + (ob ^ (((ob >> 9) & 1) << 5)); }
__device__ __forceinline__ void stage_rc(int b, int& R, int& C) { const int st = b / 1024, sb = b % 1024, swz = sb ^ (((sb >> 9) & 1) << 5); R = (st >> 1) * 16 + swz / 64; C = (st & 1) * 32 + (swz % 64) / 2; }
struct Unit { int pm, pn; };
struct Gemm { const bf16_t* A; const bf16_t* Bt; int lda, ldb, K; int a_col_per_pn; };
struct StaticOrder {
    int nM, nN, nwg, G, c;
    __device__ void init(int nM_, int nN_, int G_, int c_) { nM = nM_; nN = nN_; nwg = nM * nN; G = G_; c = c_; }
    __device__ bool next(int i, Unit& u) const {
        const long L = (long)i * G + c; if (L >= nwg) return false;
        int wgid = (int)L; { const int q = nwg / NXCD, r = nwg % NXCD, xcd = wgid % NXCD, off = wgid / NXCD; wgid = (xcd < r ? xcd * (q + 1) : r * (q + 1) + (xcd - r) * q) + off; }
        const int nig = WGM * nN, gid = wgid / nig, fm = gid * WGM, gsz = (nM - fm) < WGM ? (nM - fm) : WGM;
        u.pm = fm + ((wgid % nig) % gsz); u.pn = (wgid % nig) / gsz; return true;
    }
};
template <class Epi, class Sched>
__device__ __forceinline__ void gemm_phase(LAS unsigned char* lds, const Gemm g, const Sched& S, const Epi& E) {
    const int tid = threadIdx.x, wid = __builtin_amdgcn_readfirstlane(tid >> 6), lane = tid & 63, wr = wid >> 2, wc = wid & 3, fr = lane & 15, fq = lane >> 4;
    const int K = g.K, nt = K / BK;
    unsigned voffA[2], voffB[2];
#pragma unroll
    for (int i = 0; i < 2; ++i) { int R, C; stage_rc(tid * 16 + i * 8192, R, C);
        voffA[i] = (unsigned)(R * g.lda + C) * 2u; voffB[i] = (unsigned)(R * g.ldb + C) * 2u; }
    const size_t kstep = (size_t)(BK * 2);
    const size_t hstepA = (size_t)HALF * g.lda * 2, hstepB = (size_t)HALF * g.ldb * 2;
    const size_t tstepA = 2 * hstepA, tstepB = 2 * hstepB;
    const unsigned ldsw = (unsigned)wid * 1024u;
    const int aoff = lds_byte(wr * 64 + fr, fq * 8), boff = lds_byte(wc * 32 + fr, fq * 8);
#define PG8_SA(b, h) (((b) * 2 + (h)) * HTB)
#define PG8_SB(b, h) ((4 + (b) * 2 + (h)) * HTB)
#define PG8_STAGE(bufoff, gbase, voff) do { _Pragma("unroll") for (int _i = 0; _i < 2; ++_i) \
        __builtin_amdgcn_global_load_lds((const unsigned*)((const char*)(gbase) + (voff)[_i]), (LAS unsigned*)(lds + (bufoff) + ldsw + _i * 8192), 16, 0, 0); } while (0)
#define PG8_LDA(dst, b, h) do { _Pragma("unroll") for (int m = 0; m < 4; ++m) _Pragma("unroll") for (int k = 0; k < 2; ++k) dst[m][k] = *(const LAS bf16x8*)(lds + PG8_SA(b, h) + aoff + m * 2048 + k * 1024); } while (0)
#define PG8_LDB(dst, b, h) do { _Pragma("unroll") for (int n = 0; n < 2; ++n) _Pragma("unroll") for (int k = 0; k < 2; ++k) dst[n][k] = *(const LAS bf16x8*)(lds + PG8_SB(b, h) + boff + n * 2048 + k * 1024); } while (0)
#define PG8_MMA(ai, bj, At, Bt) do { __builtin_amdgcn_s_setprio(1); _Pragma("unroll") for (int m = 0; m < 4; ++m) _Pragma("unroll") for (int n = 0; n < 2; ++n) _Pragma("unroll") for (int k = 0; k < 2; ++k) \
        acc[ai][bj][m][n] = __builtin_amdgcn_mfma_f32_16x16x32_bf16(Bt[n][k], At[m][k], acc[ai][bj][m][n], 0, 0, 0); __builtin_amdgcn_s_setprio(0); } while (0)
#define PG8_WAIT_V(n) asm volatile("s_waitcnt vmcnt(" #n ")" ::: "memory")
#define PG8_WAIT_L(n) asm volatile("s_waitcnt lgkmcnt(" #n ")" ::: "memory")
#define PG8_BAR __builtin_amdgcn_s_barrier()
#define PG8_SCHED __builtin_amdgcn_sched_barrier(0)
    Unit cur, nxt; int ui = 0;
    if (!S.next(0, cur)) return;
    f32x4 acc[2][2][4][2];
#pragma unroll
    for (int a = 0; a < 2; ++a)
#pragma unroll
        for (int b = 0; b < 2; ++b)
#pragma unroll
            for (int m = 0; m < 4; ++m)
#pragma unroll
                for (int n = 0; n < 2; ++n) acc[a][b][m][n] = (f32x4){0.f, 0.f, 0.f, 0.f};
    bf16x8 At[4][2], B0[2][2], B1[2][2];
    const char* cA = (const char*)g.A + (size_t)cur.pm * tstepA + (size_t)cur.pn * g.a_col_per_pn * 2; const char* cB = (const char*)g.Bt + (size_t)cur.pn * tstepB;
    PG8_STAGE(PG8_SB(0, 0), cB, voffB); PG8_STAGE(PG8_SA(0, 0), cA, voffA); PG8_STAGE(PG8_SB(0, 1), cB + hstepB, voffB); PG8_STAGE(PG8_SA(0, 1), cA + hstepA, voffA);
    if (wr == 1) PG8_BAR;
    PG8_WAIT_V(4); PG8_BAR;
    PG8_STAGE(PG8_SB(1, 0), cB + kstep, voffB); PG8_STAGE(PG8_SA(1, 0), cA + kstep, voffA); PG8_STAGE(PG8_SB(1, 1), cB + hstepB + kstep, voffB);
    PG8_WAIT_V(6); PG8_BAR;
    for (;;) {
        const bool has_next = S.next(ui + 1, nxt);
        const char* nA = has_next ? (const char*)g.A + (size_t)nxt.pm * tstepA + (size_t)nxt.pn * g.a_col_per_pn * 2 : cA; const char* nB = has_next ? (const char*)g.Bt + (size_t)nxt.pn * tstepB : cB;
        for (int t = 0; t < nt; t += 2) {
            const bool last = (t == nt - 2);
            const char* a1 = cA + (size_t)(t + 1) * kstep;
            const char* a2 = last ? nA : cA + (size_t)(t + 2) * kstep; const char* b2 = last ? nB : cB + (size_t)(t + 2) * kstep;
            const char* a3 = a2 + kstep; const char* b3 = b2 + kstep;
            PG8_LDB(B0, 0, 0); PG8_SCHED; PG8_LDA(At, 0, 0); PG8_STAGE(PG8_SA(1, 1), a1 + hstepA, voffA);
            PG8_WAIT_L(8); PG8_BAR; PG8_WAIT_L(0); PG8_MMA(0, 0, At, B0); PG8_BAR; PG8_SCHED;
            PG8_LDB(B1, 0, 1); PG8_STAGE(PG8_SB(0, 0), b2, voffB);
            PG8_BAR; PG8_WAIT_L(0); PG8_MMA(0, 1, At, B1); PG8_BAR;
            PG8_LDA(At, 0, 1); PG8_STAGE(PG8_SA(0, 0), a2, voffA);
            PG8_BAR; PG8_WAIT_L(0); PG8_MMA(1, 0, At, B0); PG8_BAR; PG8_SCHED;
            PG8_STAGE(PG8_SB(0, 1), b2 + hstepB, voffB);
            PG8_WAIT_V(6); PG8_BAR; PG8_MMA(1, 1, At, B1); PG8_BAR;
            PG8_LDB(B0, 1, 0); PG8_SCHED; PG8_LDA(At, 1, 0); PG8_STAGE(PG8_SA(0, 1), a2 + hstepA, voffA);
            PG8_WAIT_L(8); PG8_BAR; PG8_WAIT_L(0); PG8_MMA(0, 0, At, B0); PG8_BAR; PG8_SCHED;
            PG8_LDB(B1, 1, 1); PG8_STAGE(PG8_SB(1, 0), b3, voffB);
            PG8_BAR; PG8_WAIT_L(0); PG8_MMA(0, 1, At, B1); PG8_BAR;
            PG8_LDA(At, 1, 1); PG8_STAGE(PG8_SA(1, 0), a3, voffA);
            PG8_BAR; PG8_WAIT_L(0); PG8_MMA(1, 0, At, B0); PG8_BAR; PG8_SCHED;
            PG8_STAGE(PG8_SB(1, 1), b3 + hstepB, voffB);
            PG8_WAIT_V(6); PG8_BAR; PG8_MMA(1, 1, At, B1); PG8_BAR;
        }
        E(acc, cur, wr, wc, fr, fq);
        if (!has_next) break;
#pragma unroll
        for (int a = 0; a < 2; ++a)
#pragma unroll
            for (int b = 0; b < 2; ++b)
#pragma unroll
                for (int m = 0; m < 4; ++m)
#pragma unroll
                    for (int n = 0; n < 2; ++n) acc[a][b][m][n] = (f32x4){0.f, 0.f, 0.f, 0.f};
        cur = nxt; cA = nA; cB = nB; ++ui;
    }
    PG8_WAIT_V(0);
    if (wr == 0) PG8_BAR;
    PG8_BAR;
#undef PG8_SA
#undef PG8_SB
#undef PG8_STAGE
#undef PG8_LDA
#undef PG8_LDB
#undef PG8_MMA
#undef PG8_WAIT_V
#undef PG8_WAIT_L
#undef PG8_BAR
#undef PG8_SCHED
}
}

struct EpiProjF32 {
    float* proj;
    __device__ __forceinline__ void operator()(const f32x4 (&acc)[2][2][4][2], const pg8::Unit& u, int wr, int wc, int fr, int fq) const {
#pragma unroll
        for (int ai = 0; ai < 2; ++ai)
#pragma unroll
            for (int m = 0; m < 4; ++m) {
                const int t = u.pm * 256 + ai * 128 + wr * 64 + m * 16 + fr - RPAD;
                if (t >= 0) {
#pragma unroll
                    for (int bj = 0; bj < 2; ++bj)
#pragma unroll
                        for (int n = 0; n < 2; ++n) {
                            const int off = wc * 32 + n * 16 + fq * 4;
                            const int col = u.pn < 4 ? u.pn * 256 + bj * 128 + off : (bj ? 2048 : 1024) + (u.pn - 4) * 128 + off;
                            *(f32x4*)(proj + (size_t)t * INW + col) = acc[ai][bj][m][n];
                        }
                }
            }
    }
};


__device__ __forceinline__ float sigmoidf_fast(float x) { return __builtin_amdgcn_rcpf(1.0f + __expf(-x)); }

struct EpiProj {
    bf16_t* xp; bf16_t* glu;
    __device__ __forceinline__ void operator()(const f32x4 (&acc)[2][2][4][2], const pg8::Unit& u, int wr, int wc, int fr, int fq) const {
#pragma unroll
        for (int ai = 0; ai < 2; ++ai)
#pragma unroll
            for (int m = 0; m < 4; ++m) {
                const size_t row = (size_t)(u.pm * 256 + ai * 128 + wr * 64 + m * 16 + fr);
                if (u.pn < 4) {
#pragma unroll
                    for (int bj = 0; bj < 2; ++bj)
#pragma unroll
                        for (int n = 0; n < 2; ++n) { const f32x4 v = acc[ai][bj][m][n]; u32x2 w; w.x = cvt_pk_bf16(v[0], v[1]); w.y = cvt_pk_bf16(v[2], v[3]);
                            *(u32x2*)(xp + row * PWD + u.pn * 256 + bj * 128 + wc * 32 + n * 16 + fq * 4) = w; }
                } else {
#pragma unroll
                    for (int n = 0; n < 2; ++n) { const f32x4 a = acc[ai][0][m][n], g = acc[ai][1][m][n]; u32x2 w;
                        w.x = cvt_pk_bf16(a[0] * sigmoidf_fast(g[0]), a[1] * sigmoidf_fast(g[1])); w.y = cvt_pk_bf16(a[2] * sigmoidf_fast(g[2]), a[3] * sigmoidf_fast(g[3]));
                        *(u32x2*)(glu + row * CWD + (u.pn - 4) * 128 + wc * 32 + n * 16 + fq * 4) = w; }
                }
            }
    }
};
struct EpiBf16Out {
    bf16_t* O; int ldc; int col0; const float* bias;
    __device__ __forceinline__ void operator()(const f32x4 (&acc)[2][2][4][2], const pg8::Unit& u, int wr, int wc, int fr, int fq) const {
#pragma unroll
        for (int ai = 0; ai < 2; ++ai)
#pragma unroll
            for (int m = 0; m < 4; ++m) {
                const size_t row = (size_t)(u.pm * 256 + ai * 128 + wr * 64 + m * 16 + fr);
#pragma unroll
                for (int bj = 0; bj < 2; ++bj)
#pragma unroll
                    for (int n = 0; n < 2; ++n) { const int c = u.pn * 256 + bj * 128 + wc * 32 + n * 16 + fq * 4; f32x4 v = acc[ai][bj][m][n];
                        if (bias) v += *(const f32x4*)(bias + c);
                        u32x2 w; w.x = cvt_pk_bf16(v[0], v[1]); w.y = cvt_pk_bf16(v[2], v[3]);
                        *(u32x2*)(O + row * ldc + col0 + c) = w; }
            }
    }
};
struct EpiResid {
    const float* x; float* h2; bf16_t* h2b; float* ssq;
    __device__ __forceinline__ void operator()(const f32x4 (&acc)[2][2][4][2], const pg8::Unit& u, int wr, int wc, int fr, int fq) const {
#pragma unroll
        for (int ai = 0; ai < 2; ++ai)
#pragma unroll
            for (int m = 0; m < 4; ++m) {
                const size_t row = (size_t)(u.pm * 256 + ai * 128 + wr * 64 + m * 16 + fr);
                float ss = 0.f;
#pragma unroll
                for (int bj = 0; bj < 2; ++bj)
#pragma unroll
                    for (int n = 0; n < 2; ++n) { const int c = u.pn * 256 + bj * 128 + wc * 32 + n * 16 + fq * 4;
                        const f32x4 v = acc[ai][bj][m][n] + *(const f32x4*)(x + row * D + c);
                        *(f32x4*)(h2 + row * D + c) = v;
                        u32x2 w; w.x = cvt_pk_bf16(v[0], v[1]); w.y = cvt_pk_bf16(v[2], v[3]);
                        *(u32x2*)(h2b + row * D + c) = w;
                        ss += (v[0] * v[0] + v[1] * v[1]) + (v[2] * v[2] + v[3] * v[3]); }
                ss += __shfl_xor(ss, 16); ss += __shfl_xor(ss, 32);
                if (fq == 0) ssq[row * 32 + u.pn * 4 + wc] = ss;
            }
    }
};

__device__ __forceinline__ float bf_lo(unsigned w) { return __uint_as_float(w << 16); }
__device__ __forceinline__ float bf_hi(unsigned w) { return __uint_as_float(w & 0xffff0000u); }

__device__ __forceinline__ void phase_mix(const Params& p, LAS unsigned char* lds, int bid, int nb) {
    const int tid = threadIdx.x, lane = tid & 63, wave = tid >> 6;
    LAS unsigned* gl = (LAS unsigned*)lds;
    LAS float* red = (LAS float*)(lds + 62 * 2048);
    float w0[KS], w1[KS];
#pragma unroll
    for (int k = 0; k < KS; ++k) { const float2 wv = *(const float2*)(p.dw_w + k * CWD + 2 * tid); w0[k] = wv.x; w1[k] = wv.y; }
    const float2 bv = *(const float2*)(p.dw_b + 2 * tid), lg = *(const float2*)(p.ln_g + 2 * tid), lb = *(const float2*)(p.ln_b + 2 * tid);
    for (int tile = bid; tile < SEQ / 32; tile += nb) {
        const int r0 = 256 + tile * 32;
        __syncthreads();
        for (int ch = tid; ch < 62 * 128; ch += NT) { const int rr = ch >> 7, cc = ch & 127;
            *(LAS u32x4*)(lds + rr * 2048 + cc * 16) = *(const u32x4*)(p.glu + (size_t)(r0 - 30 + rr) * CWD + cc * 8); }
        {
            const int g = tid >> 7, w = 2 << g; const float inv = 1.0f / (float)w;
            const unsigned* xpp = (const unsigned*)p.xp + tid;
            float s0 = 0.f, s1 = 0.f;
            for (int u = r0 - w + 1; u <= r0 - 1; ++u) { const unsigned v = xpp[(size_t)u * 512]; s0 += bf_lo(v); s1 += bf_hi(v); }
            for (int i = 0; i < 32; ++i) {
                const unsigned vn = xpp[(size_t)(r0 + i) * 512]; const float a0 = bf_lo(vn), a1 = bf_hi(vn);
                s0 += a0; s1 += a1;
                ((unsigned*)p.pooledb)[(size_t)(tile * 32 + i) * 512 + tid] = cvt_pk_bf16(s0 * inv - a0, s1 * inv - a1);
                const unsigned vo = xpp[(size_t)(r0 + i - w + 1) * 512]; s0 -= bf_lo(vo); s1 -= bf_hi(vo);
            }
        }
        __syncthreads();
        for (int i = 0; i < 32; ++i) {
            float a0 = bv.x, a1 = bv.y;
#pragma unroll
            for (int k = 0; k < KS; ++k) { const unsigned v = gl[(i + k) * 512 + tid]; a0 += bf_lo(v) * w0[k]; a1 += bf_hi(v) * w1[k]; }
            float s1 = a0 + a1, s2 = a0 * a0 + a1 * a1;
            s1 = wave_sum(s1); s2 = wave_sum(s2);
            if (lane == 0) { red[(i * 8 + wave) * 2] = s1; red[(i * 8 + wave) * 2 + 1] = s2; }
        }
        __syncthreads();
        for (int i = 0; i < 32; ++i) {
            float a0 = bv.x, a1 = bv.y;
#pragma unroll
            for (int k = 0; k < KS; ++k) { const unsigned v = gl[(i + k) * 512 + tid]; a0 += bf_lo(v) * w0[k]; a1 += bf_hi(v) * w1[k]; }
            float s1 = 0.f, s2 = 0.f;
#pragma unroll
            for (int q = 0; q < 8; ++q) { s1 += red[(i * 8 + q) * 2]; s2 += red[(i * 8 + q) * 2 + 1]; }
            const float mu = s1 * (1.0f / CWD), var = fmaxf(s2 * (1.0f / CWD) - mu * mu, 0.f), rs = rsqrtf(var + 1e-5f);
            const float y0 = (a0 - mu) * rs * lg.x + lb.x, y1 = (a1 - mu) * rs * lg.y + lb.y;
            ((unsigned*)p.cvnb)[(size_t)(tile * 32 + i) * 512 + tid] = cvt_pk_bf16(y0 * sigmoidf_fast(y0), y1 * sigmoidf_fast(y1));
        }
    }
}


struct EpiQ {
    const float* ssq; float* rstd; bf16_t* qb;
    __device__ __forceinline__ void operator()(const f32x4 (&acc)[2][2][4][2], const pg8::Unit& u, int wr, int wc, int fr, int fq) const {
#pragma unroll
        for (int ai = 0; ai < 2; ++ai)
#pragma unroll
            for (int m = 0; m < 4; ++m) {
                const size_t row = (size_t)(u.pm * 256 + ai * 128 + wr * 64 + m * 16 + fr);
                const f32x4* sp = (const f32x4*)(ssq + row * 32); f32x4 t = sp[0];
#pragma unroll
                for (int i = 1; i < 8; ++i) t += sp[i];
                const float rs = rsqrtf(((t[0] + t[1]) + (t[2] + t[3])) * (1.0f / D) + 1e-6f);
                if (u.pn == 0 && wc == 0 && fq == 0) rstd[row] = rs;
#pragma unroll
                for (int bj = 0; bj < 2; ++bj)
#pragma unroll
                    for (int n = 0; n < 2; ++n) { const int c = u.pn * 256 + bj * 128 + wc * 32 + n * 16 + fq * 4; const f32x4 v = acc[ai][bj][m][n] * rs;
                        u32x2 w; w.x = cvt_pk_bf16(v[0], v[1]); w.y = cvt_pk_bf16(v[2], v[3]);
                        *(u32x2*)(qb + row * D + c) = w; }
            }
    }
};

typedef float f32x16 __attribute__((ext_vector_type(16)));
__device__ __forceinline__ int okey(float s) { const int u = __float_as_int(s); return u ^ ((u >> 31) & 0x7fffffff); }
__device__ __forceinline__ float okey_inv(int k) { return __int_as_float(k ^ ((k >> 31) & 0x7fffffff)); }
__device__ __forceinline__ void sort16_desc(int (&v)[16]) {
#pragma unroll
    for (int k = 2; k <= 16; k <<= 1) {
#pragma unroll
        for (int j = k >> 1; j > 0; j >>= 1) {
#pragma unroll
            for (int i = 0; i < 16; ++i) {
                const int l = i ^ j;
                if (l > i) { const bool desc = (i & k) == 0; const int hi = max(v[i], v[l]), lo = min(v[i], v[l]); v[i] = desc ? hi : lo; v[l] = desc ? lo : hi; }
            }
        }
    }
}
__device__ __forceinline__ void merge16_desc(int (&a)[16], const int (&b)[16]) {
#pragma unroll
    for (int i = 0; i < 16; ++i) a[i] = max(a[i], b[15 - i]);
#pragma unroll
    for (int j = 8; j > 0; j >>= 1) {
#pragma unroll
        for (int i = 0; i < 16; ++i) { const int l = i ^ j; if (l > i) { const int hi = max(a[i], a[l]), lo = min(a[i], a[l]); a[i] = hi; a[l] = lo; } }
    }
}
__device__ __forceinline__ void pair_merge(int (&a)[16]) {
    int b[16];
#pragma unroll
    for (int i = 0; i < 16; ++i) b[i] = __shfl_xor(a[i], 32);
    merge16_desc(a, b);
}
constexpr int CELL_I[64] = {0,0,0,0,0,0,0,0,0,0,0,0,0,0,0,0,1,1,1,1,1,1,1,1,2,2,2,2,2,3,3,3,3,4,4,4,5,5,6,6,7,7,8,9,10,11,12,13,14,15,0,0,0,0,0,0,0,0,0,0,0,0,0,0};
constexpr int CELL_J[64] = {0,1,2,3,4,5,6,7,8,9,10,11,12,13,14,15,0,1,2,3,4,5,6,7,0,1,2,3,4,0,1,2,3,0,1,2,0,1,0,1,0,1,0,0,0,0,0,0,0,0,0,0,0,0,0,0,0,0,0,0,0,0,0,0};
constexpr int NCELL = 50;

__device__ __forceinline__ void phase_topk2(const Params& p, LAS unsigned char* lds, int bid, int nb) {
    const int tid = threadIdx.x, lane = tid & 63, wave = tid >> 6, hh = lane >> 5, l31 = lane & 31;
    LAS int* sit = (LAS int*)(lds + wave * 8448 + lane * 132);
    const int gw = bid * 8 + wave, NGW = nb * 8;
    for (int item = gw; item < (SEQ / 32) * 8; item += NGW) {
        const int h = item & 7, tok0 = (item >> 3) * 32;
        float sv[2][16];
#pragma unroll
        for (int ph = 0; ph < 2; ++ph) {
            const bf16_t* qrow = p.qb + (size_t)(tok0 + l31) * D + h * 256 + ph * 128 + 8 * hh;
            const bf16_t* krow = p.keysb + ((size_t)(h * 2 + ph) * 128 + l31) * 128 + 8 * hh;
            bf16x8 bq[8];
#pragma unroll
            for (int ks = 0; ks < 8; ++ks) bq[ks] = *(const bf16x8*)(qrow + ks * 16);
            int top[16];
#pragma unroll
            for (int kt = 0; kt < 4; ++kt) {
                f32x16 c = {0.f, 0.f, 0.f, 0.f, 0.f, 0.f, 0.f, 0.f, 0.f, 0.f, 0.f, 0.f, 0.f, 0.f, 0.f, 0.f};
#pragma unroll
                for (int ks = 0; ks < 8; ++ks) { const bf16x8 ak = *(const bf16x8*)(krow + (size_t)kt * 32 * 128 + ks * 16);
                    c = __builtin_amdgcn_mfma_f32_32x32x16_bf16(ak, bq[ks], c, 0, 0, 0); }
                int v[16];
#pragma unroll
                for (int r = 0; r < 16; ++r) { const int base = kt * 32 + (r & 3) + 8 * (r >> 2);
                    v[r] = ((okey(c[r]) & ~127) | (127 - base)) ^ (hh << 2); }
                sort16_desc(v);
                if (kt == 0) {
#pragma unroll
                    for (int i = 0; i < 16; ++i) top[i] = v[i];
                } else merge16_desc(top, v);
            }
            pair_merge(top);
#pragma unroll
            for (int i = 0; i < 16; ++i) { sv[ph][i] = okey_inv(top[i] & ~127); sit[ph * 16 + i] = 127 - (top[i] & 127); }
        }
        int w0[16], w1[16];
#pragma unroll
        for (int s = 0; s < 32; ++s) {
            const int e0 = 2 * s, e1 = 2 * s + 1;
            int key;
            if (e0 >= NCELL) key = (int)0x80000000;
            else {
                const float v0 = sv[0][CELL_I[e0]] + sv[1][CELL_J[e0]];
                const int k0 = (okey(v0) & ~255) | (255 - (CELL_I[e0] * 16 + CELL_J[e0]));
                if (e1 >= NCELL) key = hh ? (int)0x80000000 : k0;
                else { const float v1 = sv[0][CELL_I[e1]] + sv[1][CELL_J[e1]];
                    const int k1 = (okey(v1) & ~255) | (255 - (CELL_I[e1] * 16 + CELL_J[e1]));
                    key = hh ? k1 : k0; }
            }
            if (s < 16) w0[s] = key; else w1[s - 16] = key;
        }
        sort16_desc(w0); sort16_desc(w1); merge16_desc(w0, w1); pair_merge(w0);
        const float mx = okey_inv(w0[0] & ~255);
        float sum = 0.f;
#pragma unroll
        for (int k = 0; k < 16; ++k) sum += __expf(okey_inv(w0[k] & ~255) - mx);
        const float inv = 1.0f / sum;
        int eo[8]; float go[8]; const int hmask = -hh;
#pragma unroll
        for (int k = 0; k < 8; ++k) { const int kk = (w0[k] & ~hmask) | (w0[8 + k] & hmask); const int cc = 255 - (kk & 255);
            eo[k] = sit[cc >> 4] * 128 + sit[16 + (cc & 15)]; go[k] = __expf(okey_inv(kk & ~255) - mx) * inv; }
        const size_t ob = (size_t)(tok0 + l31) * 128 + h * 16 + hh * 8;
        *(u32x4*)(p.idx + ob) = (u32x4){(unsigned)eo[0], (unsigned)eo[1], (unsigned)eo[2], (unsigned)eo[3]};
        *(u32x4*)(p.idx + ob + 4) = (u32x4){(unsigned)eo[4], (unsigned)eo[5], (unsigned)eo[6], (unsigned)eo[7]};
        *(f32x4*)(p.gate + ob) = (f32x4){go[0], go[1], go[2], go[3]};
        *(f32x4*)(p.gate + ob + 4) = (f32x4){go[4], go[5], go[6], go[7]};
    }
}


using bf16x2v = __attribute__((ext_vector_type(2))) __bf16;
__device__ __forceinline__ float dot2f(unsigned w, unsigned x, float acc) { return __builtin_amdgcn_fdot2_f32_bf16(__builtin_bit_cast(bf16x2v, w), __builtin_bit_cast(bf16x2v, x), acc, false); }
__device__ __forceinline__ float fsel(int mask, float a, float b) { return __int_as_float((__float_as_int(a) & ~mask) | (__float_as_int(b) & mask)); }

__device__ __forceinline__ u32x4 bload16(__amdgpu_buffer_rsrc_t r, int voff, int soff) { return __builtin_bit_cast(u32x4, __builtin_amdgcn_raw_buffer_load_b128(r, voff, soff, 0)); }

__device__ __forceinline__ void phase_peer2(const Params& p, int bid, int nb) {
    const int tid = threadIdx.x, lane = tid & 63, wave = tid >> 6;
    const int gw = bid * 8 + wave, NGW = nb * 8;
    const int mA = -((lane >> 5) & 1), mB = -((lane >> 4) & 1);
    const __amdgpu_buffer_rsrc_t rd = __builtin_amdgcn_make_buffer_rsrc((void*)p.downb, 0, 16384 * D * 2, 0x00020000);
    const __amdgpu_buffer_rsrc_t ru = __builtin_amdgcn_make_buffer_rsrc((void*)p.upb, 0, 16384 * D * 2, 0x00020000);
    const int voff = lane * 16;
    for (int t = gw; t < SEQ; t += NGW) {
        unsigned xq[16];
        {
            const float rs = p.rstd[t];
#pragma unroll
            for (int k = 0; k < 4; ++k) {
                const f32x4 a = *(const f32x4*)(p.h2 + (size_t)t * D + 512 * k + 8 * lane), b = *(const f32x4*)(p.h2 + (size_t)t * D + 512 * k + 8 * lane + 4);
                const f32x4 ga = *(const f32x4*)(p.ffn_g + 512 * k + 8 * lane), gb = *(const f32x4*)(p.ffn_g + 512 * k + 8 * lane + 4);
                xq[4 * k + 0] = cvt_pk_bf16(a[0] * rs * ga[0], a[1] * rs * ga[1]); xq[4 * k + 1] = cvt_pk_bf16(a[2] * rs * ga[2], a[3] * rs * ga[3]);
                xq[4 * k + 2] = cvt_pk_bf16(b[0] * rs * gb[0], b[1] * rs * gb[1]); xq[4 * k + 3] = cvt_pk_bf16(b[2] * rs * gb[2], b[3] * rs * gb[3]);
            }
        }
        float out[32];
#pragma unroll
        for (int i = 0; i < 32; ++i) out[i] = 0.f;
        const int i_lo = p.idx[(size_t)t * 128 + lane], i_hi = p.idx[(size_t)t * 128 + 64 + lane];
        const float* gp = p.gate + (size_t)t * 128 + ((lane >> 4) & 3);
#pragma unroll 1
        for (int bi = 0; bi < 32; ++bi) {
            asm volatile("" ::: "memory");
            const int isrc = bi < 16 ? i_lo : i_hi;
            int eo[4];
#pragma unroll
            for (int j = 0; j < 4; ++j) eo[j] = __builtin_amdgcn_readlane(isrc, (bi * 4 + j) & 63) * (D * 2);
            const float g = gp[bi * 4];
            u32x4 rdn[4][4], rup[4][4];
#pragma unroll
            for (int j = 0; j < 4; ++j)
#pragma unroll
                for (int k = 0; k < 4; ++k) rdn[j][k] = bload16(rd, voff, eo[j] + k * 1024);
#pragma unroll
            for (int j = 0; j < 4; ++j)
#pragma unroll
                for (int k = 0; k < 4; ++k) rup[j][k] = bload16(ru, voff, eo[j] + k * 1024);
            float pr[4];
#pragma unroll
            for (int j = 0; j < 4; ++j) { float a0 = 0.f, a1 = 0.f;
#pragma unroll
                for (int k = 0; k < 4; ++k) { a0 = dot2f(rdn[j][k].x, xq[4 * k + 0], a0); a1 = dot2f(rdn[j][k].y, xq[4 * k + 1], a1); a0 = dot2f(rdn[j][k].z, xq[4 * k + 2], a0); a1 = dot2f(rdn[j][k].w, xq[4 * k + 3], a1); }
                pr[j] = a0 + a1; }
            const float q0 = fsel(mA, pr[0], pr[2]) + __shfl_xor(fsel(mA, pr[2], pr[0]), 32);
            const float q1 = fsel(mA, pr[1], pr[3]) + __shfl_xor(fsel(mA, pr[3], pr[1]), 32);
            float hs = fsel(mB, q0, q1) + __shfl_xor(fsel(mB, q1, q0), 16);
            hs += __shfl_xor(hs, 8); hs += __shfl_xor(hs, 4); hs += __shfl_xor(hs, 2); hs += __shfl_xor(hs, 1);
            const float act = g * 0.5f * hs * (1.0f + erff(hs * 0.70710678118654752f));
#pragma unroll
            for (int j = 0; j < 4; ++j) { const float a = __int_as_float(__builtin_amdgcn_readlane(__float_as_int(act), 16 * j));
#pragma unroll
                for (int k = 0; k < 4; ++k) {
                    out[8 * k + 0] += a * bf_lo(rup[j][k].x); out[8 * k + 1] += a * bf_hi(rup[j][k].x); out[8 * k + 2] += a * bf_lo(rup[j][k].y); out[8 * k + 3] += a * bf_hi(rup[j][k].y);
                    out[8 * k + 4] += a * bf_lo(rup[j][k].z); out[8 * k + 5] += a * bf_hi(rup[j][k].z); out[8 * k + 6] += a * bf_lo(rup[j][k].w); out[8 * k + 7] += a * bf_hi(rup[j][k].w); } }
        }
        float ss = 0.f;
#pragma unroll
        for (int k = 0; k < 4; ++k) {
            const f32x4 a = *(const f32x4*)(p.h2 + (size_t)t * D + 512 * k + 8 * lane), b = *(const f32x4*)(p.h2 + (size_t)t * D + 512 * k + 8 * lane + 4);
#pragma unroll
            for (int i = 0; i < 4; ++i) { out[8 * k + i] += a[i]; out[8 * k + 4 + i] += b[i]; }
#pragma unroll
            for (int i = 0; i < 8; ++i) ss += out[8 * k + i] * out[8 * k + i];
        }
        const float rf = rsqrtf(wave_sum(ss) * (1.0f / D) + 1e-6f);
#pragma unroll
        for (int k = 0; k < 4; ++k) {
            const f32x4 ga = *(const f32x4*)(p.fin_g + 512 * k + 8 * lane), gb = *(const f32x4*)(p.fin_g + 512 * k + 8 * lane + 4);
            *(f32x4*)(p.out + (size_t)t * D + 512 * k + 8 * lane) = (f32x4){out[8 * k + 0] * rf * ga[0], out[8 * k + 1] * rf * ga[1], out[8 * k + 2] * rf * ga[2], out[8 * k + 3] * rf * ga[3]};
            *(f32x4*)(p.out + (size_t)t * D + 512 * k + 8 * lane + 4) = (f32x4){out[8 * k + 4] * rf * gb[0], out[8 * k + 5] * rf * gb[1], out[8 * k + 6] * rf * gb[2], out[8 * k + 7] * rf * gb[3]};
        }
    }
}

__device__ __forceinline__ void tr_item(const float* W, int ldw, int srccol0, int k0, bf16_t* WT, int ldt, int n0, const float* kscale, const float* nscale, LAS float* scr, int lane) {
#pragma unroll 8
    for (int i = 0; i < 32; ++i) { const int kk = 2 * i + (lane >> 5); float v = W[(size_t)(k0 + kk) * ldw + srccol0 + (lane & 31)];
        if (kscale) v *= kscale[k0 + kk]; if (nscale) v *= nscale[srccol0 + (lane & 31)]; scr[kk * 33 + (lane & 31)] = v; }
    asm volatile("s_waitcnt lgkmcnt(0)" ::: "memory");
    const int c = lane & 7;
#pragma unroll
    for (int j = 0; j < 4; ++j) { const int n = (lane >> 3) + 8 * j; const LAS float* s = scr + (8 * c) * 33 + n;
        u32x4 o; o.x = cvt_pk_bf16(s[0 * 33], s[1 * 33]); o.y = cvt_pk_bf16(s[2 * 33], s[3 * 33]); o.z = cvt_pk_bf16(s[4 * 33], s[5 * 33]); o.w = cvt_pk_bf16(s[6 * 33], s[7 * 33]);
        *(u32x4*)(WT + (size_t)(n0 + n) * ldt + k0 + 8 * c) = o; }
    asm volatile("s_waitcnt lgkmcnt(0)" ::: "memory");
}
__device__ __forceinline__ int win_srccol(int n) { const int pn = n >> 8, w = n & 255; return pn < 4 ? n : ((w >> 7) ? 2048 : 1024) + (pn - 4) * 128 + (w & 127); }

__device__ __forceinline__ void phase_prep(const Params& p, LAS unsigned char* lds, int bid, int nb) {
    const int tid = threadIdx.x, lane = tid & 63, wave = tid >> 6;
    const int gw = bid * 8 + wave, NGW = nb * 8;
    LAS float* scr = (LAS float*)(lds + wave * 8448);
    for (int r = gw; r < RT; r += NGW) {
        unsigned long long* o8 = (unsigned long long*)(p.hnb + (size_t)r * D) + lane;
        if (r < RPAD) {
#pragma unroll
            for (int j = 0; j < 8; ++j) o8[64 * j] = 0ull;
        } else {
            const f32x4* xr = (const f32x4*)hrow(p, r - RPAD) + lane;
            const f32x4* gr = (const f32x4*)p.mix_g + lane;
            f32x4 v[8]; float s = 0.f;
#pragma unroll
            for (int j = 0; j < 8; ++j) { v[j] = xr[64 * j]; s += (v[j].x * v[j].x + v[j].y * v[j].y) + (v[j].z * v[j].z + v[j].w * v[j].w); }
            const float rs = rsqrtf(wave_sum(s) * (1.0f / D) + 1e-6f);
#pragma unroll
            for (int j = 0; j < 8; ++j) { const f32x4 gv = gr[64 * j];
                o8[64 * j] = (unsigned long long)cvt_pk_bf16(v[j].x * rs * gv.x, v[j].y * rs * gv.y) | ((unsigned long long)cvt_pk_bf16(v[j].z * rs * gv.z, v[j].w * rs * gv.w) << 32); }
        }
    }
    for (int it = gw; it < (D / 64) * (INW / 32); it += NGW) {
        const int kb = it / (INW / 32), nbk = it % (INW / 32);
        tr_item(p.w_in, INW, win_srccol(nbk * 32), kb * 64, p.w_in_t, D, nbk * 32, nullptr, nullptr, scr, lane);
    }
    for (int it = gw; it < 4 * 4 * 8; it += NGW) { const int g = it >> 5, kb = (it >> 3) & 3, nbk = it & 7;
        tr_item(p.pool_w + (size_t)g * 65536, 256, nbk * 32, kb * 64, p.pool_wt + (size_t)g * 65536, 256, nbk * 32, nullptr, p.pool_scale + g * 256, scr, lane); }
    for (int it = gw; it < 16 * 32; it += NGW) { const int kb = it >> 5, nbk = it & 31;
        tr_item(p.pw_w, CWD, nbk * 32, kb * 64, p.pw_t, CWD, nbk * 32, nullptr, nullptr, scr, lane); }
    for (int it = gw; it < 32 * 64; it += NGW) { const int kb = it >> 6, nbk = it & 63;
        tr_item(p.w_out, D, nbk * 32, kb * 64, p.w_out_t, D, nbk * 32, nullptr, nullptr, scr, lane); }
    for (int it = gw; it < 32 * 64; it += NGW) { const int kb = it >> 6, nbk = it & 63;
        tr_item(p.wq, D, nbk * 32, kb * 64, p.wq_t, D, nbk * 32, p.ffn_g, nullptr, scr, lane); }
    for (int i = gw * 64 + lane; i < 8 * 2 * 128 * 128 / 4; i += NGW * 64) { const f32x4 v = ((const f32x4*)p.keys)[i];
        u32x2 w; w.x = cvt_pk_bf16(v[0], v[1]); w.y = cvt_pk_bf16(v[2], v[3]); ((u32x2*)p.keysb)[i] = w; }
    for (size_t i = (size_t)gw * 64 + lane; i < (size_t)16384 * D / 8; i += (size_t)NGW * 64) {
        { const f32x4 a = ((const f32x4*)p.down)[2 * i], b = ((const f32x4*)p.down)[2 * i + 1];
          ((u32x4*)p.downb)[i] = (u32x4){cvt_pk_bf16(a[0], a[1]), cvt_pk_bf16(a[2], a[3]), cvt_pk_bf16(b[0], b[1]), cvt_pk_bf16(b[2], b[3])}; }
        { const f32x4 a = ((const f32x4*)p.up)[2 * i], b = ((const f32x4*)p.up)[2 * i + 1];
          ((u32x4*)p.upb)[i] = (u32x4){cvt_pk_bf16(a[0], a[1]), cvt_pk_bf16(a[2], a[3]), cvt_pk_bf16(b[0], b[1]), cvt_pk_bf16(b[2], b[3])}; }
    }
}

__device__ __forceinline__ GemmArgs mk(const float* A, int lda, const float* B, int ldb, float* C, int ldc, int M, int N, int K, const float* bias, const float* scale, int rh) {
    GemmArgs g; g.A = A; g.lda = lda; g.B = B; g.ldb = ldb; g.C = C; g.ldc = ldc; g.M = M; g.N = N; g.K = K; g.bias = bias; g.scale = scale; g.resid_h = rh; return g;
}

__global__ void __launch_bounds__(NT, 2) k_mega(Params p) {
    extern __shared__ __attribute__((aligned(16))) unsigned char lds_raw[];
    LAS unsigned char* lds = (LAS unsigned char*)lds_raw;
    float* smem = (float*)lds_raw;
    cg::grid_group grid = cg::this_grid();
    const int bid = blockIdx.x, nb = gridDim.x;
    phase_prep(p, lds, bid, nb);
    grid.sync();
    { pg8::Gemm g{p.hnb, p.w_in_t, D, D, D, 0}; pg8::StaticOrder S; S.init(RT / 256, INW / 256, nb, bid); EpiProj E{p.xp, p.glu};
      pg8::gemm_phase<EpiProj, pg8::StaticOrder>(lds, g, S, E); }
    grid.sync();
    phase_mix(p, lds, bid, nb);
    grid.sync();
    if (bid < nb / 2) { pg8::Gemm g{p.pooledb, p.pool_wt, PWD, 256, 256, 256}; pg8::StaticOrder S; S.init(SEQ / 256, 4, nb / 2, bid); EpiBf16Out E{p.yabb, D, 0, nullptr};
      pg8::gemm_phase<EpiBf16Out, pg8::StaticOrder>(lds, g, S, E); }
    else { pg8::Gemm g{p.cvnb, p.pw_t, CWD, CWD, CWD, 0}; pg8::StaticOrder S; S.init(SEQ / 256, 4, nb - nb / 2, bid - nb / 2); EpiBf16Out E{p.yabb, D, PWD, p.pw_b};
      pg8::gemm_phase<EpiBf16Out, pg8::StaticOrder>(lds, g, S, E); }
    grid.sync();
    { pg8::Gemm g{p.yabb, p.w_out_t, D, D, D, 0}; pg8::StaticOrder S; S.init(SEQ / 256, D / 256, nb, bid); EpiResid E{p.x, p.h2, p.h2b, p.ssq};
      pg8::gemm_phase<EpiResid, pg8::StaticOrder>(lds, g, S, E); }
    grid.sync();
    { pg8::Gemm g{p.h2b, p.wq_t, D, D, D, 0}; pg8::StaticOrder S; S.init(SEQ / 256, D / 256, nb, bid); EpiQ E{p.ssq, p.rstd, p.qb};
      pg8::gemm_phase<EpiQ, pg8::StaticOrder>(lds, g, S, E); }
    grid.sync();
    phase_topk2(p, lds, bid, nb);
    grid.sync();
    phase_peer2(p, bid, nb);
}

extern "C" void kernel_launch(void* const* d_in, const int* in_sizes, int n_in, void* d_out, int out_size, void* d_ws, size_t ws_size, hipStream_t stream) {
    Params p{};
    p.x = (const float*)d_in[0]; p.meta = (const float*)d_in[1]; p.mix_g = (const float*)d_in[2]; p.w_in = (const float*)d_in[3];
    p.pool_w = (const float*)d_in[4]; p.pool_scale = (const float*)d_in[5]; p.dw_w = (const float*)d_in[6]; p.dw_b = (const float*)d_in[7];
    p.ln_g = (const float*)d_in[8]; p.ln_b = (const float*)d_in[9]; p.pw_w = (const float*)d_in[10]; p.pw_b = (const float*)d_in[11];
    p.w_out = (const float*)d_in[12]; p.ffn_g = (const float*)d_in[13]; p.wq = (const float*)d_in[14]; p.keys = (const float*)d_in[15];
    p.down = (const float*)d_in[16]; p.up = (const float*)d_in[17]; p.fin_g = (const float*)d_in[18];
    p.out = (float*)d_out;
    char* w = (char*)d_ws; size_t off = 0;
    auto take = [&](size_t bytes) { char* r = w + off; off += (bytes + 255) & ~(size_t)255; return r; };
    p.h2 = (float*)take((size_t)SEQ * D * 4);
    p.idx = (int*)take((size_t)SEQ * 128 * 4);
    p.gate = (float*)take((size_t)SEQ * 128 * 4);
    p.hnb = (bf16_t*)take((size_t)RT * D * 2);
    p.w_in_t = (bf16_t*)take((size_t)INW * D * 2);
    p.xp = (bf16_t*)take((size_t)RT * PWD * 2);
    p.glu = (bf16_t*)take((size_t)RT * CWD * 2);
    p.pooledb = (bf16_t*)take((size_t)SEQ * PWD * 2);
    p.cvnb = (bf16_t*)take((size_t)SEQ * CWD * 2);
    p.yabb = (bf16_t*)take((size_t)SEQ * D * 2);
    p.h2b = (bf16_t*)take((size_t)SEQ * D * 2);
    p.pool_wt = (bf16_t*)take((size_t)4 * 256 * 256 * 2);
    p.pw_t = (bf16_t*)take((size_t)CWD * CWD * 2);
    p.w_out_t = (bf16_t*)take((size_t)D * D * 2);
    p.ssq = (float*)take((size_t)SEQ * 32 * 4);
    p.rstd = (float*)take((size_t)SEQ * 4);
    p.wq_t = (bf16_t*)take((size_t)D * D * 2);
    p.keysb = (bf16_t*)take((size_t)8 * 2 * 128 * 128 * 2);
    p.qb = (bf16_t*)take((size_t)SEQ * D * 2);
    p.downb = (bf16_t*)take((size_t)16384 * D * 2);
    p.upb = (bf16_t*)take((size_t)16384 * D * 2);
    static int grid_blocks = 0;
    if (!grid_blocks) {
        int dev = 0, cus = 0, per_cu = 0;
        (void)hipGetDevice(&dev);
        (void)hipDeviceGetAttribute(&cus, hipDeviceAttributeMultiprocessorCount, dev);
        (void)hipFuncSetAttribute((const void*)k_mega, hipFuncAttributeMaxDynamicSharedMemorySize, LDS_BYTES);
        (void)hipOccupancyMaxActiveBlocksPerMultiprocessor(&per_cu, k_mega, NT, LDS_BYTES);
        if (per_cu < 1) fprintf(stderr, "occupancy query says %d blocks per CU\n", per_cu);
        grid_blocks = cus;
    }
    void* args[] = {&p};
    hipError_t e = hipLaunchCooperativeKernel((void*)k_mega, dim3(grid_blocks), dim3(NT), args, LDS_BYTES, stream);
    if (e != hipSuccess) fprintf(stderr, "cooperative launch failed: %s (grid %d)\n", hipGetErrorString(e), grid_blocks);
}
```

```cpp
#include <hip/hip_runtime.h>
#include <hip/hip_cooperative_groups.h>
#include <stdint.h>
#include <cstdio>
namespace cg = cooperative_groups;

#define NT 512
#define LAS __attribute__((address_space(3)))
typedef unsigned short bf16_t;
typedef short bf16x8 __attribute__((ext_vector_type(8)));
typedef float f32x4 __attribute__((ext_vector_type(4)));
typedef unsigned u32x4 __attribute__((ext_vector_type(4)));
typedef unsigned u32x2 __attribute__((ext_vector_type(2)));

constexpr int D = 2048, SEQ = 8192, NMETA = 16, T = SEQ + NMETA;
constexpr int PWD = 1024, CWD = 1024, INW = 3072;
constexpr int KS = 31;
constexpr int RPAD = 240, RT = 8448;
constexpr int LDS_BYTES = 147456;

struct Params {
    const float *x, *meta, *mix_g, *w_in, *pool_w, *pool_scale, *dw_w, *dw_b, *ln_g, *ln_b, *pw_w, *pw_b, *w_out, *ffn_g, *wq, *keys, *down, *up, *fin_g;
    float* out;
    float *hn, *proj, *yab, *pooled, *cv, *h2, *xn, *q, *gate;
    int* idx;
    unsigned* bar;
    bf16_t *hnb, *w_in_t, *xp, *glu, *pooledb, *cvnb, *yabb, *h2b, *pool_wt, *pw_t, *w_out_t, *wq_t, *keysb, *qb, *downb, *upb;
    float *ssq, *rstd;
};

__device__ __forceinline__ unsigned cvt_pk_bf16(float lo, float hi) { unsigned r; asm volatile("v_cvt_pk_bf16_f32 %0, %1, %2" : "=v"(r) : "v"(lo), "v"(hi)); return r; }
__device__ __forceinline__ float wave_sum(float v) {
#pragma unroll
    for (int o = 1; o < 64; o <<= 1) v += __shfl_xor(v, o);
    return v;
}

__device__ __forceinline__ const float* hrow(const Params& p, int t) { return t < NMETA ? p.meta + (size_t)t * D : p.x + (size_t)(t - NMETA) * D; }

__device__ __forceinline__ float block_sum(float v, float* red) {
#pragma unroll
    for (int o = 32; o; o >>= 1) v += __shfl_xor(v, o);
    __syncthreads();
    if ((threadIdx.x & 63) == 0) red[threadIdx.x >> 6] = v;
    __syncthreads();
    float s = 0.f;
#pragma unroll
    for (int i = 0; i < NT / 64; ++i) s += red[i];
    return s;
}

__device__ __forceinline__ void phase_rms(const Params& p, int mode, float* smem, int bid, int nb) {
    const int tid = threadIdx.x;
    for (int t = bid; t < SEQ; t += nb) {
        const float* src = mode == 0 ? hrow(p, t) : p.h2 + (size_t)t * D;
        const float* g = mode == 0 ? p.mix_g : p.ffn_g;
        float* dst = (mode == 0 ? p.hn : p.xn) + (size_t)t * D;
        const float4 v = *(const float4*)(src + tid * 4);
        const float ss = block_sum(v.x * v.x + v.y * v.y + v.z * v.z + v.w * v.w, smem);
        const float r = rsqrtf(ss * (1.0f / D) + 1e-6f);
        const float4 gv = *(const float4*)(g + tid * 4);
        float4 o; o.x = v.x * r * gv.x; o.y = v.y * r * gv.y; o.z = v.z * r * gv.z; o.w = v.w * r * gv.w;
        *(float4*)(dst + tid * 4) = o;
    }
}

struct GemmArgs { const float* A; int lda; const float* B; int ldb; float* C; int ldc; int M, N, K; const float* bias; const float* scale; int resid_h; };

__device__ __forceinline__ void phase_gemm(const Params& p, const GemmArgs g, float* smem, int bid, int nb) {
    constexpr int BM = 128, BN = 64, BK = 16;
    float* As = smem;
    float* Bs = smem + BK * (BM + 4);
    const int tid = threadIdx.x, ty = tid >> 4, tx = tid & 15;
    const int tilesM = (g.M + BM - 1) / BM, tilesN = g.N / BN;
    for (int tile = bid; tile < tilesM * tilesN; tile += nb) {
        const int m0 = (tile / tilesN) * BM, n0 = (tile % tilesN) * BN;
        float acc[4][4];
#pragma unroll
        for (int i = 0; i < 4; ++i)
#pragma unroll
            for (int j = 0; j < 4; ++j) acc[i][j] = 0.f;
        const int ar = tid >> 2, akq = tid & 3;
        int arow = m0 + ar; if (arow >= g.M) arow = g.M - 1;
        const float* ap = g.A + (size_t)arow * g.lda + akq * 4;
        const int bk = tid >> 5, bn = (tid & 31) * 2;
        const float* bp = g.B + (size_t)bk * g.ldb + n0 + bn;
        for (int k0 = 0; k0 < g.K; k0 += BK) {
            const float4 av = *(const float4*)(ap + k0);
            const float2 bv = *(const float2*)(bp + (size_t)k0 * g.ldb);
            __syncthreads();
            As[(akq * 4 + 0) * (BM + 4) + ar] = av.x; As[(akq * 4 + 1) * (BM + 4) + ar] = av.y;
            As[(akq * 4 + 2) * (BM + 4) + ar] = av.z; As[(akq * 4 + 3) * (BM + 4) + ar] = av.w;
            *(float2*)(Bs + bk * BN + bn) = bv;
            __syncthreads();
#pragma unroll
            for (int k = 0; k < BK; ++k) {
                const float4 a = *(const float4*)(As + k * (BM + 4) + ty * 4);
                const float4 b = *(const float4*)(Bs + k * BN + tx * 4);
                const float aa[4] = {a.x, a.y, a.z, a.w}, bb[4] = {b.x, b.y, b.z, b.w};
#pragma unroll
                for (int i = 0; i < 4; ++i)
#pragma unroll
                    for (int j = 0; j < 4; ++j) acc[i][j] += aa[i] * bb[j];
            }
        }
#pragma unroll
        for (int i = 0; i < 4; ++i) {
            const int m = m0 + ty * 4 + i;
            if (m < g.M) {
                const int n = n0 + tx * 4;
                float o[4];
#pragma unroll
                for (int j = 0; j < 4; ++j) {
                    float v = acc[i][j];
                    if (g.bias) v += g.bias[n + j];
                    if (g.scale) v *= g.scale[n + j];
                    if (g.resid_h) v += hrow(p, m)[n + j];
                    o[j] = v;
                }
                *(float4*)(g.C + (size_t)m * g.ldc + n) = make_float4(o[0], o[1], o[2], o[3]);
            }
        }
    }
}

__device__ __forceinline__ void phase_poolconv(const Params& p, int bid, int nb) {
    const int tid = threadIdx.x;
    for (int t = bid; t < T; t += nb) {
        for (int c = tid; c < PWD; c += NT) {
            const int g = c >> 8, w = 2 << g;
            const int lo = (t + 1 - w) > 0 ? (t + 1 - w) : 0;
            float s = 0.f;
            for (int u = lo; u <= t; ++u) s += p.proj[(size_t)u * INW + c];
            p.pooled[(size_t)t * PWD + c] = s / (float)(t + 1 - lo) - p.proj[(size_t)t * INW + c];
        }
        for (int c = tid; c < CWD; c += NT) {
            float s = p.dw_b[c];
            for (int k = 0; k < KS; ++k) {
                const int u = t - (KS - 1) + k;
                if (u >= 0) {
                    const float a = p.proj[(size_t)u * INW + PWD + c], gt = p.proj[(size_t)u * INW + PWD + CWD + c];
                    s += a / (1.0f + expf(-gt)) * p.dw_w[k * CWD + c];
                }
            }
            p.cv[(size_t)t * CWD + c] = s;
        }
    }
}

__device__ __forceinline__ void phase_ln(const Params& p, float* smem, int bid, int nb) {
    const int tid = threadIdx.x;
    for (int t = bid; t < T; t += nb) {
        float* row = p.cv + (size_t)t * CWD;
        const float2 v = *(const float2*)(row + tid * 2);
        const float mu = block_sum(v.x + v.y, smem) * (1.0f / CWD);
        const float dx = v.x - mu, dy = v.y - mu;
        const float var = block_sum(dx * dx + dy * dy, smem) * (1.0f / CWD);
        const float r = rsqrtf(var + 1e-5f);
        const float y0 = dx * r * p.ln_g[tid * 2] + p.ln_b[tid * 2], y1 = dy * r * p.ln_g[tid * 2 + 1] + p.ln_b[tid * 2 + 1];
        float2 o; o.x = y0 / (1.0f + expf(-y0)); o.y = y1 / (1.0f + expf(-y1));
        *(float2*)(row + tid * 2) = o;
    }
}

__device__ __forceinline__ void phase_topk(const Params& p, int bid, int nb) {
    const int lane = threadIdx.x & 63, wv = threadIdx.x >> 6;
    constexpr int NW = NT / 64;
    const float NEG = -3.0e38f;
    for (int item = bid * NW + wv; item < SEQ * 8; item += nb * NW) {
        const int t = item >> 3, h = item & 7;
        const float* q = p.q + (size_t)t * D + h * 256;
        float s00 = 0.f, s01 = 0.f, s10 = 0.f, s11 = 0.f;
        {
            const float* k00 = p.keys + ((size_t)(h * 2 + 0) * 128 + lane) * 128;
            const float* k01 = k00 + 64 * 128;
            const float* k10 = p.keys + ((size_t)(h * 2 + 1) * 128 + lane) * 128;
            const float* k11 = k10 + 64 * 128;
            for (int d = 0; d < 128; ++d) {
                const float q0 = q[d], q1 = q[128 + d];
                s00 += q0 * k00[d]; s01 += q0 * k01[d]; s10 += q1 * k10[d]; s11 += q1 * k11[d];
            }
        }
        float sv0 = 0.f, sv1 = 0.f; int si0 = 0, si1 = 0;
#pragma unroll
        for (int ph = 0; ph < 2; ++ph) {
            float a0 = ph == 0 ? s00 : s10, a1 = ph == 0 ? s01 : s11;
            float svv = 0.f; int sii = 0;
            for (int r = 0; r < 16; ++r) {
                float bv; int bi;
                if (a0 >= a1) { bv = a0; bi = lane; } else { bv = a1; bi = lane + 64; }
#pragma unroll
                for (int o = 32; o; o >>= 1) {
                    const float ov = __shfl_xor(bv, o); const int oi = __shfl_xor(bi, o);
                    if (ov > bv || (ov == bv && oi < bi)) { bv = ov; bi = oi; }
                }
                if (lane == r) { svv = bv; sii = bi; }
                if (bi == lane) a0 = NEG; else if (bi == lane + 64) a1 = NEG;
            }
            if (ph == 0) { sv0 = svv; si0 = sii; } else { sv1 = svv; si1 = sii; }
        }
        const float ci = __shfl(sv0, lane >> 2);
        float c0 = ci + __shfl(sv1, (lane & 3) * 4 + 0), c1 = ci + __shfl(sv1, (lane & 3) * 4 + 1);
        float c2 = ci + __shfl(sv1, (lane & 3) * 4 + 2), c3 = ci + __shfl(sv1, (lane & 3) * 4 + 3);
        float ts = 0.f; int tc = 0;
        for (int r = 0; r < 16; ++r) {
            float bv = c0; int bi = lane * 4;
            if (c1 > bv) { bv = c1; bi = lane * 4 + 1; }
            if (c2 > bv) { bv = c2; bi = lane * 4 + 2; }
            if (c3 > bv) { bv = c3; bi = lane * 4 + 3; }
#pragma unroll
            for (int o = 32; o; o >>= 1) {
                const float ov = __shfl_xor(bv, o); const int oi = __shfl_xor(bi, o);
                if (ov > bv || (ov == bv && oi < bi)) { bv = ov; bi = oi; }
            }
            if (lane == r) { ts = bv; tc = bi; }
            if ((bi >> 2) == lane) { const int m = bi & 3; if (m == 0) c0 = NEG; else if (m == 1) c1 = NEG; else if (m == 2) c2 = NEG; else c3 = NEG; }
        }
        const int e0 = __shfl(si0, (tc >> 4) & 15), e1 = __shfl(si1, tc & 15);
        const float mx = __shfl(ts, 0);
        float ex = lane < 16 ? expf(ts - mx) : 0.f;
        float sum = ex;
#pragma unroll
        for (int o = 32; o; o >>= 1) sum += __shfl_xor(sum, o);
        if (lane < 16) {
            p.idx[(size_t)t * 128 + h * 16 + lane] = e0 * 128 + e1;
            p.gate[(size_t)t * 128 + h * 16 + lane] = ex / sum;
        }
    }
}

__device__ __forceinline__ void phase_peer(const Params& p, float* smem, int bid, int nb) {
    const int tid = threadIdx.x, lane = tid & 63, wv = tid >> 6;
    float* act_s = smem + 16;
    int* idx_s = (int*)(smem + 16 + 128);
    for (int t = bid; t < SEQ; t += nb) {
        const float* xr = p.xn + (size_t)t * D;
        float4 xv[8];
#pragma unroll
        for (int k = 0; k < 8; ++k) xv[k] = *(const float4*)(xr + lane * 4 + 256 * k);
        __syncthreads();
        for (int jj = 0; jj < 16; ++jj) {
            const int j = wv * 16 + jj;
            const int e = p.idx[(size_t)t * 128 + j];
            const float* dr = p.down + (size_t)e * D;
            float s = 0.f;
#pragma unroll
            for (int k = 0; k < 8; ++k) {
                const float4 dv = *(const float4*)(dr + lane * 4 + 256 * k);
                s += xv[k].x * dv.x + xv[k].y * dv.y + xv[k].z * dv.z + xv[k].w * dv.w;
            }
#pragma unroll
            for (int o = 32; o; o >>= 1) s += __shfl_xor(s, o);
            if (lane == 0) {
                const float ge = 0.5f * s * (1.0f + erff(s * 0.70710678118654752f));
                act_s[j] = p.gate[(size_t)t * 128 + j] * ge;
                idx_s[j] = e;
            }
        }
        __syncthreads();
        float o0 = 0.f, o1 = 0.f, o2 = 0.f, o3 = 0.f;
        for (int j = 0; j < 128; ++j) {
            const float a = act_s[j];
            const float4 uv = *(const float4*)(p.up + (size_t)idx_s[j] * D + tid * 4);
            o0 += a * uv.x; o1 += a * uv.y; o2 += a * uv.z; o3 += a * uv.w;
        }
        const float4 hv = *(const float4*)(p.h2 + (size_t)t * D + tid * 4);
        o0 += hv.x; o1 += hv.y; o2 += hv.z; o3 += hv.w;
        const float ss = block_sum(o0 * o0 + o1 * o1 + o2 * o2 + o3 * o3, smem);
        const float r = rsqrtf(ss * (1.0f / D) + 1e-6f);
        const float4 gv = *(const float4*)(p.fin_g + tid * 4);
        *(float4*)(p.out + (size_t)t * D + tid * 4) = make_float4(o0 * r * gv.x, o1 * r * gv.y, o2 * r * gv.z, o3 * r * gv.w);
    }
}


namespace pg8 {
constexpr int BM = 256, BK = 64, HALF = 128, HTB = HALF * BK * 2, STAGE_BYTES = 8 * HTB, NXCD = 8, WGM = 8;
__device__ __forceinline__ int lds_byte(int r, int c) { const int st = (r >> 4) * 2 + (c >> 5), rr = r & 15, cc = c & 31, ob = rr * 64 + cc * 2; return st * 1024 + (ob ^ (((ob >> 9) & 1) << 5)); }
__device__ __forceinline__ void stage_rc(int b, int& R, int& C) { const int st = b / 1024, sb = b % 1024, swz = sb ^ (((sb >> 9) & 1) << 5); R = (st >> 1) * 16 + swz / 64; C = (st & 1) * 32 + (swz % 64) / 2; }
struct Unit { int pm, pn; };
struct Gemm { const bf16_t* A; const bf16_t* Bt; int lda, ldb, K; int a_col_per_pn; };
struct StaticOrder {
    int nM, nN, nwg, G, c;
    __device__ void init(int nM_, int nN_, int G_, int c_) { nM = nM_; nN = nN_; nwg = nM * nN; G = G_; c = c_; }
    __device__ bool next(int i, Unit& u) const {
        const long L = (long)i * G + c; if (L >= nwg) return false;
        int wgid = (int)L; { const int q = nwg / NXCD, r = nwg % NXCD, xcd = wgid % NXCD, off = wgid / NXCD; wgid = (xcd < r ? xcd * (q + 1) : r * (q + 1) + (xcd - r) * q) + off; }
        const int nig = WGM * nN, gid = wgid / nig, fm = gid * WGM, gsz = (nM - fm) < WGM ? (nM - fm) : WGM;
        u.pm = fm + ((wgid % nig) % gsz); u.pn = (wgid % nig) / gsz; return true;
    }
};
template <class Epi, class Sched>
__device__ __forceinline__ void gemm_phase(LAS unsigned char* lds, const Gemm g, const Sched& S, const Epi& E) {
    const int tid = threadIdx.x, wid = __builtin_amdgcn_readfirstlane(tid >> 6), lane = tid & 63, wr = wid >> 2, wc = wid & 3, fr = lane & 15, fq = lane >> 4;
    const int K = g.K, nt = K / BK;
    unsigned voffA[2], voffB[2];
#pragma unroll
    for (int i = 0; i < 2; ++i) { int R, C; stage_rc(tid * 16 + i * 8192, R, C);
        voffA[i] = (unsigned)(R * g.lda + C) * 2u; voffB[i] = (unsigned)(R * g.ldb + C) * 2u; }
    const size_t kstep = (size_t)(BK * 2);
    const size_t hstepA = (size_t)HALF * g.lda * 2, hstepB = (size_t)HALF * g.ldb * 2;
    const size_t tstepA = 2 * hstepA, tstepB = 2 * hstepB;
    const unsigned ldsw = (unsigned)wid * 1024u;
    const int aoff = lds_byte(wr * 64 + fr, fq * 8), boff = lds_byte(wc * 32 + fr, fq * 8);
#define PG8_SA(b, h) (((b) * 2 + (h)) * HTB)
#define PG8_SB(b, h) ((4 + (b) * 2 + (h)) * HTB)
#define PG8_STAGE(bufoff, gbase, voff) do { _Pragma("unroll") for (int _i = 0; _i < 2; ++_i) \
        __builtin_amdgcn_global_load_lds((const unsigned*)((const char*)(gbase) + (voff)[_i]), (LAS unsigned*)(lds + (bufoff) + ldsw + _i * 8192), 16, 0, 0); } while (0)
#define PG8_LDA(dst, b, h) do { _Pragma("unroll") for (int m = 0; m < 4; ++m) _Pragma("unroll") for (int k = 0; k < 2; ++k) dst[m][k] = *(const LAS bf16x8*)(lds + PG8_SA(b, h) + aoff + m * 2048 + k * 1024); } while (0)
#define PG8_LDB(dst, b, h) do { _Pragma("unroll") for (int n = 0; n < 2; ++n) _Pragma("unroll") for (int k = 0; k < 2; ++k) dst[n][k] = *(const LAS bf16x8*)(lds + PG8_SB(b, h) + boff + n * 2048 + k * 1024); } while (0)
#define PG8_MMA(ai, bj, At, Bt) do { __builtin_amdgcn_s_setprio(1); _Pragma("unroll") for (int m = 0; m < 4; ++m) _Pragma("unroll") for (int n = 0; n < 2; ++n) _Pragma("unroll") for (int k = 0; k < 2; ++k) \
        acc[ai][bj][m][n] = __builtin_amdgcn_mfma_f32_16x16x32_bf16(Bt[n][k], At[m][k], acc[ai][bj][m][n], 0, 0, 0); __builtin_amdgcn_s_setprio(0); } while (0)
#define PG8_WAIT_V(n) asm volatile("s_waitcnt vmcnt(" #n ")" ::: "memory")
#define PG8_WAIT_L(n) asm volatile("s_waitcnt lgkmcnt(" #n ")" ::: "memory")
#define PG8_BAR __builtin_amdgcn_s_barrier()
#define PG8_SCHED __builtin_amdgcn_sched_barrier(0)
    Unit cur, nxt; int ui = 0;
    if (!S.next(0, cur)) return;
    f32x4 acc[2][2][4][2];
#pragma unroll
    for (int a = 0; a < 2; ++a)
#pragma unroll
        for (int b = 0; b < 2; ++b)
#pragma unroll
            for (int m = 0; m < 4; ++m)
#pragma unroll
                for (int n = 0; n < 2; ++n) acc[a][b][m][n] = (f32x4){0.f, 0.f, 0.f, 0.f};
    bf16x8 At[4][2], B0[2][2], B1[2][2];
    const char* cA = (const char*)g.A + (size_t)cur.pm * tstepA + (size_t)cur.pn * g.a_col_per_pn * 2; const char* cB = (const char*)g.Bt + (size_t)cur.pn * tstepB;
    PG8_STAGE(PG8_SB(0, 0), cB, voffB); PG8_STAGE(PG8_SA(0, 0), cA, voffA); PG8_STAGE(PG8_SB(0, 1), cB + hstepB, voffB); PG8_STAGE(PG8_SA(0, 1), cA + hstepA, voffA);
    if (wr == 1) PG8_BAR;
    PG8_WAIT_V(4); PG8_BAR;
    PG8_STAGE(PG8_SB(1, 0), cB + kstep, voffB); PG8_STAGE(PG8_SA(1, 0), cA + kstep, voffA); PG8_STAGE(PG8_SB(1, 1), cB + hstepB + kstep, voffB);
    PG8_WAIT_V(6); PG8_BAR;
    for (;;) {
        const bool has_next = S.next(ui + 1, nxt);
        const char* nA = has_next ? (const char*)g.A + (size_t)nxt.pm * tstepA + (size_t)nxt.pn * g.a_col_per_pn * 2 : cA; const char* nB = has_next ? (const char*)g.Bt + (size_t)nxt.pn * tstepB : cB;
        for (int t = 0; t < nt; t += 2) {
            const bool last = (t == nt - 2);
            const char* a1 = cA + (size_t)(t + 1) * kstep;
            const char* a2 = last ? nA : cA + (size_t)(t + 2) * kstep; const char* b2 = last ? nB : cB + (size_t)(t + 2) * kstep;
            const char* a3 = a2 + kstep; const char* b3 = b2 + kstep;
            PG8_LDB(B0, 0, 0); PG8_SCHED; PG8_LDA(At, 0, 0); PG8_STAGE(PG8_SA(1, 1), a1 + hstepA, voffA);
            PG8_WAIT_L(8); PG8_BAR; PG8_WAIT_L(0); PG8_MMA(0, 0, At, B0); PG8_BAR; PG8_SCHED;
            PG8_LDB(B1, 0, 1); PG8_STAGE(PG8_SB(0, 0), b2, voffB);
            PG8_BAR; PG8_WAIT_L(0); PG8_MMA(0, 1, At, B1); PG8_BAR;
            PG8_LDA(At, 0, 1); PG8_STAGE(PG8_SA(0, 0), a2, voffA);
            PG8_BAR; PG8_WAIT_L(0); PG8_MMA(1, 0, At, B0); PG8_BAR; PG8_SCHED;
            PG8_STAGE(PG8_SB(0, 1), b2 + hstepB, voffB);
            PG8_WAIT_V(6); PG8_BAR; PG8_MMA(1, 1, At, B1); PG8_BAR;
            PG8_LDB(B0, 1, 0); PG8_SCHED; PG8_LDA(At, 1, 0); PG8_STAGE(PG8_SA(0, 1), a2 + hstepA, voffA);
            PG8_WAIT_L(8); PG8_BAR; PG8_WAIT_L(0); PG8_MMA(0, 0, At, B0); PG8_BAR; PG8_SCHED;
            PG8_LDB(B1, 1, 1); PG8_STAGE(PG8_SB(1, 0), b3, voffB);
            PG8_BAR; PG8_WAIT_L(0); PG8_MMA(0, 1, At, B1); PG8_BAR;
            PG8_LDA(At, 1, 1); PG8_STAGE(PG8_SA(1, 0), a3, voffA);
            PG8_BAR; PG8_WAIT_L(0); PG8_MMA(1, 0, At, B0); PG8_BAR; PG8_SCHED;
            PG8_STAGE(PG8_SB(1, 1), b3 + hstepB, voffB);
            PG8_WAIT_V(6); PG8_BAR; PG8_MMA(1, 1, At, B1); PG8_BAR;
        }
        E(acc, cur, wr, wc, fr, fq);
        if (!has_next) break;
#pragma unroll
        for (int a = 0; a < 2; ++a)
#pragma unroll
            for (int b = 0; b < 2; ++b)
#pragma unroll
                for (int m = 0; m < 4; ++m)
#pragma unroll
                    for (int n = 0; n < 2; ++n) acc[a][b][m][n] = (f32x4){0.f, 0.f, 0.f, 0.f};
        cur = nxt; cA = nA; cB = nB; ++ui;
    }
    PG8_WAIT_V(0);
    if (wr == 0) PG8_BAR;
    PG8_BAR;
#undef PG8_SA
#undef PG8_SB
#undef PG8_STAGE
#undef PG8_LDA
#undef PG8_LDB
#undef PG8_MMA
#undef PG8_WAIT_V
#undef PG8_WAIT_L
#undef PG8_BAR
#undef PG8_SCHED
}
}

struct EpiProjF32 {
    float* proj;
    __device__ __forceinline__ void operator()(const f32x4 (&acc)[2][2][4][2], const pg8::Unit& u, int wr, int wc, int fr, int fq) const {
#pragma unroll
        for (int ai = 0; ai < 2; ++ai)
#pragma unroll
            for (int m = 0; m < 4; ++m) {
                const int t = u.pm * 256 + ai * 128 + wr * 64 + m * 16 + fr - RPAD;
                if (t >= 0) {
#pragma unroll
                    for (int bj = 0; bj < 2; ++bj)
#pragma unroll
                        for (int n = 0; n < 2; ++n) {
                            const int off = wc * 32 + n * 16 + fq * 4;
                            const int col = u.pn < 4 ? u.pn * 256 + bj * 128 + off : (bj ? 2048 : 1024) + (u.pn - 4) * 128 + off;
                            *(f32x4*)(proj + (size_t)t * INW + col) = acc[ai][bj][m][n];
                        }
                }
            }
    }
};


__device__ __forceinline__ float sigmoidf_fast(float x) { return __builtin_amdgcn_rcpf(1.0f + __expf(-x)); }

struct EpiProj {
    bf16_t* xp; bf16_t* glu;
    __device__ __forceinline__ void operator()(const f32x4 (&acc)[2][2][4][2], const pg8::Unit& u, int wr, int wc, int fr, int fq) const {
#pragma unroll
        for (int ai = 0; ai < 2; ++ai)
#pragma unroll
            for (int m = 0; m < 4; ++m) {
                const size_t row = (size_t)(u.pm * 256 + ai * 128 + wr * 64 + m * 16 + fr);
                if (u.pn < 4) {
#pragma unroll
                    for (int bj = 0; bj < 2; ++bj)
#pragma unroll
                        for (int n = 0; n < 2; ++n) { const f32x4 v = acc[ai][bj][m][n]; u32x2 w; w.x = cvt_pk_bf16(v[0], v[1]); w.y = cvt_pk_bf16(v[2], v[3]);
                            *(u32x2*)(xp + row * PWD + u.pn * 256 + bj * 128 + wc * 32 + n * 16 + fq * 4) = w; }
                } else {
#pragma unroll
                    for (int n = 0; n < 2; ++n) { const f32x4 a = acc[ai][0][m][n], g = acc[ai][1][m][n]; u32x2 w;
                        w.x = cvt_pk_bf16(a[0] * sigmoidf_fast(g[0]), a[1] * sigmoidf_fast(g[1])); w.y = cvt_pk_bf16(a[2] * sigmoidf_fast(g[2]), a[3] * sigmoidf_fast(g[3]));
                        *(u32x2*)(glu + row * CWD + (u.pn - 4) * 128 + wc * 32 + n * 16 + fq * 4) = w; }
                }
            }
    }
};
struct EpiBf16Out {
    bf16_t* O; int ldc; int col0; const float* bias;
    __device__ __forceinline__ void operator()(const f32x4 (&acc)[2][2][4][2], const pg8::Unit& u, int wr, int wc, int fr, int fq) const {
#pragma unroll
        for (int ai = 0; ai < 2; ++ai)
#pragma unroll
            for (int m = 0; m < 4; ++m) {
                const size_t row = (size_t)(u.pm * 256 + ai * 128 + wr * 64 + m * 16 + fr);
#pragma unroll
                for (int bj = 0; bj < 2; ++bj)
#pragma unroll
                    for (int n = 0; n < 2; ++n) { const int c = u.pn * 256 + bj * 128 + wc * 32 + n * 16 + fq * 4; f32x4 v = acc[ai][bj][m][n];
                        if (bias) v += *(const f32x4*)(bias + c);
                        u32x2 w; w.x = cvt_pk_bf16(v[0], v[1]); w.y = cvt_pk_bf16(v[2], v[3]);
                        *(u32x2*)(O + row * ldc + col0 + c) = w; }
            }
    }
};
struct EpiResid {
    const float* x; float* h2; bf16_t* h2b; float* ssq;
    __device__ __forceinline__ void operator()(const f32x4 (&acc)[2][2][4][2], const pg8::Unit& u, int wr, int wc, int fr, int fq) const {
#pragma unroll
        for (int ai = 0; ai < 2; ++ai)
#pragma unroll
            for (int m = 0; m < 4; ++m) {
                const size_t row = (size_t)(u.pm * 256 + ai * 128 + wr * 64 + m * 16 + fr);
                float ss = 0.f;
#pragma unroll
                for (int bj = 0; bj < 2; ++bj)
#pragma unroll
                    for (int n = 0; n < 2; ++n) { const int c = u.pn * 256 + bj * 128 + wc * 32 + n * 16 + fq * 4;
                        const f32x4 v = acc[ai][bj][m][n] + *(const f32x4*)(x + row * D + c);
                        *(f32x4*)(h2 + row * D + c) = v;
                        u32x2 w; w.x = cvt_pk_bf16(v[0], v[1]); w.y = cvt_pk_bf16(v[2], v[3]);
                        *(u32x2*)(h2b + row * D + c) = w;
                        ss += (v[0] * v[0] + v[1] * v[1]) + (v[2] * v[2] + v[3] * v[3]); }
                ss += __shfl_xor(ss, 16); ss += __shfl_xor(ss, 32);
                if (fq == 0) ssq[row * 32 + u.pn * 4 + wc] = ss;
            }
    }
};

__device__ __forceinline__ float bf_lo(unsigned w) { return __uint_as_float(w << 16); }
__device__ __forceinline__ float bf_hi(unsigned w) { return __uint_as_float(w & 0xffff0000u); }

__device__ __forceinline__ void phase_mix(const Params& p, LAS unsigned char* lds, int bid, int nb) {
    const int tid = threadIdx.x, lane = tid & 63, wave = tid >> 6;
    LAS unsigned* gl = (LAS unsigned*)lds;
    LAS float* red = (LAS float*)(lds + 62 * 2048);
    float w0[KS], w1[KS];
#pragma unroll
    for (int k = 0; k < KS; ++k) { const float2 wv = *(const float2*)(p.dw_w + k * CWD + 2 * tid); w0[k] = wv.x; w1[k] = wv.y; }
    const float2 bv = *(const float2*)(p.dw_b + 2 * tid), lg = *(const float2*)(p.ln_g + 2 * tid), lb = *(const float2*)(p.ln_b + 2 * tid);
    for (int tile = bid; tile < SEQ / 32; tile += nb) {
        const int r0 = 256 + tile * 32;
        __syncthreads();
        for (int ch = tid; ch < 62 * 128; ch += NT) { const int rr = ch >> 7, cc = ch & 127;
            *(LAS u32x4*)(lds + rr * 2048 + cc * 16) = *(const u32x4*)(p.glu + (size_t)(r0 - 30 + rr) * CWD + cc * 8); }
        {
            const int g = tid >> 7, w = 2 << g; const float inv = 1.0f / (float)w;
            const unsigned* xpp = (const unsigned*)p.xp + tid;
            float s0 = 0.f, s1 = 0.f;
            for (int u = r0 - w + 1; u <= r0 - 1; ++u) { const unsigned v = xpp[(size_t)u * 512]; s0 += bf_lo(v); s1 += bf_hi(v); }
            for (int i = 0; i < 32; ++i) {
                const unsigned vn = xpp[(size_t)(r0 + i) * 512]; const float a0 = bf_lo(vn), a1 = bf_hi(vn);
                s0 += a0; s1 += a1;
                ((unsigned*)p.pooledb)[(size_t)(tile * 32 + i) * 512 + tid] = cvt_pk_bf16(s0 * inv - a0, s1 * inv - a1);
                const unsigned vo = xpp[(size_t)(r0 + i - w + 1) * 512]; s0 -= bf_lo(vo); s1 -= bf_hi(vo);
            }
        }
        __syncthreads();
        for (int i = 0; i < 32; ++i) {
            float a0 = bv.x, a1 = bv.y;
#pragma unroll
            for (int k = 0; k < KS; ++k) { const unsigned v = gl[(i + k) * 512 + tid]; a0 += bf_lo(v) * w0[k]; a1 += bf_hi(v) * w1[k]; }
            float s1 = a0 + a1, s2 = a0 * a0 + a1 * a1;
            s1 = wave_sum(s1); s2 = wave_sum(s2);
            if (lane == 0) { red[(i * 8 + wave) * 2] = s1; red[(i * 8 + wave) * 2 + 1] = s2; }
        }
        __syncthreads();
        for (int i = 0; i < 32; ++i) {
            float a0 = bv.x, a1 = bv.y;
#pragma unroll
            for (int k = 0; k < KS; ++k) { const unsigned v = gl[(i + k) * 512 + tid]; a0 += bf_lo(v) * w0[k]; a1 += bf_hi(v) * w1[k]; }
            float s1 = 0.f, s2 = 0.f;
#pragma unroll
            for (int q = 0; q < 8; ++q) { s1 += red[(i * 8 + q) * 2]; s2 += red[(i * 8 + q) * 2 + 1]; }
            const float mu = s1 * (1.0f / CWD), var = fmaxf(s2 * (1.0f / CWD) - mu * mu, 0.f), rs = rsqrtf(var + 1e-5f);
            const float y0 = (a0 - mu) * rs * lg.x + lb.x, y1 = (a1 - mu) * rs * lg.y + lb.y;
            ((unsigned*)p.cvnb)[(size_t)(tile * 32 + i) * 512 + tid] = cvt_pk_bf16(y0 * sigmoidf_fast(y0), y1 * sigmoidf_fast(y1));
        }
    }
}


struct EpiQ {
    const float* ssq; float* rstd; bf16_t* qb;
    __device__ __forceinline__ void operator()(const f32x4 (&acc)[2][2][4][2], const pg8::Unit& u, int wr, int wc, int fr, int fq) const {
#pragma unroll
        for (int ai = 0; ai < 2; ++ai)
#pragma unroll
            for (int m = 0; m < 4; ++m) {
                const size_t row = (size_t)(u.pm * 256 + ai * 128 + wr * 64 + m * 16 + fr);
                const f32x4* sp = (const f32x4*)(ssq + row * 32); f32x4 t = sp[0];
#pragma unroll
                for (int i = 1; i < 8; ++i) t += sp[i];
                const float rs = rsqrtf(((t[0] + t[1]) + (t[2] + t[3])) * (1.0f / D) + 1e-6f);
                if (u.pn == 0 && wc == 0 && fq == 0) rstd[row] = rs;
#pragma unroll
                for (int bj = 0; bj < 2; ++bj)
#pragma unroll
                    for (int n = 0; n < 2; ++n) { const int c = u.pn * 256 + bj * 128 + wc * 32 + n * 16 + fq * 4; const f32x4 v = acc[ai][bj][m][n] * rs;
                        u32x2 w; w.x = cvt_pk_bf16(v[0], v[1]); w.y = cvt_pk_bf16(v[2], v[3]);
                        *(u32x2*)(qb + row * D + c) = w; }
            }
    }
};

typedef float f32x16 __attribute__((ext_vector_type(16)));
__device__ __forceinline__ int okey(float s) { const int u = __float_as_int(s); return u ^ ((u >> 31) & 0x7fffffff); }
__device__ __forceinline__ float okey_inv(int k) { return __int_as_float(k ^ ((k >> 31) & 0x7fffffff)); }
__device__ __forceinline__ void sort16_desc(int (&v)[16]) {
#pragma unroll
    for (int k = 2; k <= 16; k <<= 1) {
#pragma unroll
        for (int j = k >> 1; j > 0; j >>= 1) {
#pragma unroll
            for (int i = 0; i < 16; ++i) {
                const int l = i ^ j;
                if (l > i) { const bool desc = (i & k) == 0; const int hi = max(v[i], v[l]), lo = min(v[i], v[l]); v[i] = desc ? hi : lo; v[l] = desc ? lo : hi; }
            }
        }
    }
}
__device__ __forceinline__ void merge16_desc(int (&a)[16], const int (&b)[16]) {
#pragma unroll
    for (int i = 0; i < 16; ++i) a[i] = max(a[i], b[15 - i]);
#pragma unroll
    for (int j = 8; j > 0; j >>= 1) {
#pragma unroll
        for (int i = 0; i < 16; ++i) { const int l = i ^ j; if (l > i) { const int hi = max(a[i], a[l]), lo = min(a[i], a[l]); a[i] = hi; a[l] = lo; } }
    }
}
__device__ __forceinline__ void pair_merge(int (&a)[16]) {
    int b[16];
#pragma unroll
    for (int i = 0; i < 16; ++i) b[i] = __shfl_xor(a[i], 32);
    merge16_desc(a, b);
}
constexpr int CELL_I[64] = {0,0,0,0,0,0,0,0,0,0,0,0,0,0,0,0,1,1,1,1,1,1,1,1,2,2,2,2,2,3,3,3,3,4,4,4,5,5,6,6,7,7,8,9,10,11,12,13,14,15,0,0,0,0,0,0,0,0,0,0,0,0,0,0};
constexpr int CELL_J[64] = {0,1,2,3,4,5,6,7,8,9,10,11,12,13,14,15,0,1,2,3,4,5,6,7,0,1,2,3,4,0,1,2,3,0,1,2,0,1,0,1,0,1,0,0,0,0,0,0,0,0,0,0,0,0,0,0,0,0,0,0,0,0,0,0};
constexpr int NCELL = 50;

__device__ __forceinline__ void phase_topk2(const Params& p, LAS unsigned char* lds, int bid, int nb) {
    const int tid = threadIdx.x, lane = tid & 63, wave = tid >> 6, hh = lane >> 5, l31 = lane & 31;
    LAS int* sit = (LAS int*)(lds + wave * 8448 + lane * 132);
    const int gw = bid * 8 + wave, NGW = nb * 8;
    for (int item = gw; item < (SEQ / 32) * 8; item += NGW) {
        const int h = item & 7, tok0 = (item >> 3) * 32;
        float sv[2][16];
#pragma unroll
        for (int ph = 0; ph < 2; ++ph) {
            const bf16_t* qrow = p.qb + (size_t)(tok0 + l31) * D + h * 256 + ph * 128 + 8 * hh;
            const bf16_t* krow = p.keysb + ((size_t)(h * 2 + ph) * 128 + l31) * 128 + 8 * hh;
            bf16x8 bq[8];
#pragma unroll
            for (int ks = 0; ks < 8; ++ks) bq[ks] = *(const bf16x8*)(qrow + ks * 16);
            int top[16];
#pragma unroll
            for (int kt = 0; kt < 4; ++kt) {
                f32x16 c = {0.f, 0.f, 0.f, 0.f, 0.f, 0.f, 0.f, 0.f, 0.f, 0.f, 0.f, 0.f, 0.f, 0.f, 0.f, 0.f};
#pragma unroll
                for (int ks = 0; ks < 8; ++ks) { const bf16x8 ak = *(const bf16x8*)(krow + (size_t)kt * 32 * 128 + ks * 16);
                    c = __builtin_amdgcn_mfma_f32_32x32x16_bf16(ak, bq[ks], c, 0, 0, 0); }
                int v[16];
#pragma unroll
                for (int r = 0; r < 16; ++r) { const int base = kt * 32 + (r & 3) + 8 * (r >> 2);
                    v[r] = ((okey(c[r]) & ~127) | (127 - base)) ^ (hh << 2); }
                sort16_desc(v);
                if (kt == 0) {
#pragma unroll
                    for (int i = 0; i < 16; ++i) top[i] = v[i];
                } else merge16_desc(top, v);
            }
            pair_merge(top);
#pragma unroll
            for (int i = 0; i < 16; ++i) { sv[ph][i] = okey_inv(top[i] & ~127); sit[ph * 16 + i] = 127 - (top[i] & 127); }
        }
        int w0[16], w1[16];
#pragma unroll
        for (int s = 0; s < 32; ++s) {
            const int e0 = 2 * s, e1 = 2 * s + 1;
            int key;
            if (e0 >= NCELL) key = (int)0x80000000;
            else {
                const float v0 = sv[0][CELL_I[e0]] + sv[1][CELL_J[e0]];
                const int k0 = (okey(v0) & ~255) | (255 - (CELL_I[e0] * 16 + CELL_J[e0]));
                if (e1 >= NCELL) key = hh ? (int)0x80000000 : k0;
                else { const float v1 = sv[0][CELL_I[e1]] + sv[1][CELL_J[e1]];
                    const int k1 = (okey(v1) & ~255) | (255 - (CELL_I[e1] * 16 + CELL_J[e1]));
                    key = hh ? k1 : k0; }
            }
            if (s < 16) w0[s] = key; else w1[s - 16] = key;
        }
        sort16_desc(w0); sort16_desc(w1); merge16_desc(w0, w1); pair_merge(w0);
        const float mx = okey_inv(w0[0] & ~255);
        float sum = 0.f;
#pragma unroll
        for (int k = 0; k < 16; ++k) sum += __expf(okey_inv(w0[k] & ~255) - mx);
        const float inv = 1.0f / sum;
        int eo[8]; float go[8]; const int hmask = -hh;
#pragma unroll
        for (int k = 0; k < 8; ++k) { const int kk = (w0[k] & ~hmask) | (w0[8 + k] & hmask); const int cc = 255 - (kk & 255);
            eo[k] = sit[cc >> 4] * 128 + sit[16 + (cc & 15)]; go[k] = __expf(okey_inv(kk & ~255) - mx) * inv; }
        const size_t ob = (size_t)(tok0 + l31) * 128 + h * 16 + hh * 8;
        *(u32x4*)(p.idx + ob) = (u32x4){(unsigned)eo[0], (unsigned)eo[1], (unsigned)eo[2], (unsigned)eo[3]};
        *(u32x4*)(p.idx + ob + 4) = (u32x4){(unsigned)eo[4], (unsigned)eo[5], (unsigned)eo[6], (unsigned)eo[7]};
        *(f32x4*)(p.gate + ob) = (f32x4){go[0], go[1], go[2], go[3]};
        *(f32x4*)(p.gate + ob + 4) = (f32x4){go[4], go[5], go[6], go[7]};
    }
}


using bf16x2v = __attribute__((ext_vector_type(2))) __bf16;
__device__ __forceinline__ float dot2f(unsigned w, unsigned x, float acc) { return __builtin_amdgcn_fdot2_f32_bf16(__builtin_bit_cast(bf16x2v, w), __builtin_bit_cast(bf16x2v, x), acc, false); }
__device__ __forceinline__ float fsel(int mask, float a, float b) { return __int_as_float((__float_as_int(a) & ~mask) | (__float_as_int(b) & mask)); }

__device__ __forceinline__ u32x4 bload16(__amdgpu_buffer_rsrc_t r, int voff, int soff) { return __builtin_bit_cast(u32x4, __builtin_amdgcn_raw_buffer_load_b128(r, voff, soff, 0)); }

__device__ __forceinline__ void phase_peer2(const Params& p, int bid, int nb) {
    const int tid = threadIdx.x, lane = tid & 63, wave = tid >> 6;
    const int gw = bid * 8 + wave, NGW = nb * 8;
    const int mA = -((lane >> 5) & 1), mB = -((lane >> 4) & 1);
    const __amdgpu_buffer_rsrc_t rd = __builtin_amdgcn_make_buffer_rsrc((void*)p.downb, 0, 16384 * D * 2, 0x00020000);
    const __amdgpu_buffer_rsrc_t ru = __builtin_amdgcn_make_buffer_rsrc((void*)p.upb, 0, 16384 * D * 2, 0x00020000);
    const int voff = lane * 16;
    for (int t = gw; t < SEQ; t += NGW) {
        unsigned xq[16];
        {
            const float rs = p.rstd[t];
#pragma unroll
            for (int k = 0; k < 4; ++k) {
                const f32x4 a = *(const f32x4*)(p.h2 + (size_t)t * D + 512 * k + 8 * lane), b = *(const f32x4*)(p.h2 + (size_t)t * D + 512 * k + 8 * lane + 4);
                const f32x4 ga = *(const f32x4*)(p.ffn_g + 512 * k + 8 * lane), gb = *(const f32x4*)(p.ffn_g + 512 * k + 8 * lane + 4);
                xq[4 * k + 0] = cvt_pk_bf16(a[0] * rs * ga[0], a[1] * rs * ga[1]); xq[4 * k + 1] = cvt_pk_bf16(a[2] * rs * ga[2], a[3] * rs * ga[3]);
                xq[4 * k + 2] = cvt_pk_bf16(b[0] * rs * gb[0], b[1] * rs * gb[1]); xq[4 * k + 3] = cvt_pk_bf16(b[2] * rs * gb[2], b[3] * rs * gb[3]);
            }
        }
        float out[32];
#pragma unroll
        for (int i = 0; i < 32; ++i) out[i] = 0.f;
        const int i_lo = p.idx[(size_t)t * 128 + lane], i_hi = p.idx[(size_t)t * 128 + 64 + lane];
        const float* gp = p.gate + (size_t)t * 128 + ((lane >> 4) & 3);
#pragma unroll 1
        for (int bi = 0; bi < 32; ++bi) {
            asm volatile("" ::: "memory");
            const int isrc = bi < 16 ? i_lo : i_hi;
            int eo[4];
#pragma unroll
            for (int j = 0; j < 4; ++j) eo[j] = __builtin_amdgcn_readlane(isrc, (bi * 4 + j) & 63) * (D * 2);
            const float g = gp[bi * 4];
            u32x4 rdn[4][4], rup[4][4];
#pragma unroll
            for (int j = 0; j < 4; ++j)
#pragma unroll
                for (int k = 0; k < 4; ++k) rdn[j][k] = bload16(rd, voff, eo[j] + k * 1024);
#pragma unroll
            for (int j = 0; j < 4; ++j)
#pragma unroll
                for (int k = 0; k < 4; ++k) rup[j][k] = bload16(ru, voff, eo[j] + k * 1024);
            float pr[4];
#pragma unroll
            for (int j = 0; j < 4; ++j) { float a0 = 0.f, a1 = 0.f;
#pragma unroll
                for (int k = 0; k < 4; ++k) { a0 = dot2f(rdn[j][k].x, xq[4 * k + 0], a0); a1 = dot2f(rdn[j][k].y, xq[4 * k + 1], a1); a0 = dot2f(rdn[j][k].z, xq[4 * k + 2], a0); a1 = dot2f(rdn[j][k].w, xq[4 * k + 3], a1); }
                pr[j] = a0 + a1; }
            const float q0 = fsel(mA, pr[0], pr[2]) + __shfl_xor(fsel(mA, pr[2], pr[0]), 32);
            const float q1 = fsel(mA, pr[1], pr[3]) + __shfl_xor(fsel(mA, pr[3], pr[1]), 32);
            float hs = fsel(mB, q0, q1) + __shfl_xor(fsel(mB, q1, q0), 16);
            hs += __shfl_xor(hs, 8); hs += __shfl_xor(hs, 4); hs += __shfl_xor(hs, 2); hs += __shfl_xor(hs, 1);
            const float act = g * 0.5f * hs * (1.0f + erff(hs * 0.70710678118654752f));
#pragma unroll
            for (int j = 0; j < 4; ++j) { const float a = __int_as_float(__builtin_amdgcn_readlane(__float_as_int(act), 16 * j));
#pragma unroll
                for (int k = 0; k < 4; ++k) {
                    out[8 * k + 0] += a * bf_lo(rup[j][k].x); out[8 * k + 1] += a * bf_hi(rup[j][k].x); out[8 * k + 2] += a * bf_lo(rup[j][k].y); out[8 * k + 3] += a * bf_hi(rup[j][k].y);
                    out[8 * k + 4] += a * bf_lo(rup[j][k].z); out[8 * k + 5] += a * bf_hi(rup[j][k].z); out[8 * k + 6] += a * bf_lo(rup[j][k].w); out[8 * k + 7] += a * bf_hi(rup[j][k].w); } }
        }
        float ss = 0.f;
#pragma unroll
        for (int k = 0; k < 4; ++k) {
            const f32x4 a = *(const f32x4*)(p.h2 + (size_t)t * D + 512 * k + 8 * lane), b = *(const f32x4*)(p.h2 + (size_t)t * D + 512 * k + 8 * lane + 4);
#pragma unroll
            for (int i = 0; i < 4; ++i) { out[8 * k + i] += a[i]; out[8 * k + 4 + i] += b[i]; }
#pragma unroll
            for (int i = 0; i < 8; ++i) ss += out[8 * k + i] * out[8 * k + i];
        }
        const float rf = rsqrtf(wave_sum(ss) * (1.0f / D) + 1e-6f);
#pragma unroll
        for (int k = 0; k < 4; ++k) {
            const f32x4 ga = *(const f32x4*)(p.fin_g + 512 * k + 8 * lane), gb = *(const f32x4*)(p.fin_g + 512 * k + 8 * lane + 4);
            *(f32x4*)(p.out + (size_t)t * D + 512 * k + 8 * lane) = (f32x4){out[8 * k + 0] * rf * ga[0], out[8 * k + 1] * rf * ga[1], out[8 * k + 2] * rf * ga[2], out[8 * k + 3] * rf * ga[3]};
            *(f32x4*)(p.out + (size_t)t * D + 512 * k + 8 * lane + 4) = (f32x4){out[8 * k + 4] * rf * gb[0], out[8 * k + 5] * rf * gb[1], out[8 * k + 6] * rf * gb[2], out[8 * k + 7] * rf * gb[3]};
        }
    }
}

__device__ __forceinline__ void tr_item(const float* W, int ldw, int srccol0, int k0, bf16_t* WT, int ldt, int n0, const float* kscale, const float* nscale, LAS float* scr, int lane) {
#pragma unroll 8
    for (int i = 0; i < 32; ++i) { const int kk = 2 * i + (lane >> 5); float v = W[(size_t)(k0 + kk) * ldw + srccol0 + (lane & 31)];
        if (kscale) v *= kscale[k0 + kk]; if (nscale) v *= nscale[srccol0 + (lane & 31)]; scr[kk * 33 + (lane & 31)] = v; }
    asm volatile("s_waitcnt lgkmcnt(0)" ::: "memory");
    const int c = lane & 7;
#pragma unroll
    for (int j = 0; j < 4; ++j) { const int n = (lane >> 3) + 8 * j; const LAS float* s = scr + (8 * c) * 33 + n;
        u32x4 o; o.x = cvt_pk_bf16(s[0 * 33], s[1 * 33]); o.y = cvt_pk_bf16(s[2 * 33], s[3 * 33]); o.z = cvt_pk_bf16(s[4 * 33], s[5 * 33]); o.w = cvt_pk_bf16(s[6 * 33], s[7 * 33]);
        *(u32x4*)(WT + (size_t)(n0 + n) * ldt + k0 + 8 * c) = o; }
    asm volatile("s_waitcnt lgkmcnt(0)" ::: "memory");
}
__device__ __forceinline__ int win_srccol(int n) { const int pn = n >> 8, w = n & 255; return pn < 4 ? n : ((w >> 7) ? 2048 : 1024) + (pn - 4) * 128 + (w & 127); }

__device__ __forceinline__ void phase_prep(const Params& p, LAS unsigned char* lds, int bid, int nb) {
    const int tid = threadIdx.x, lane = tid & 63, wave = tid >> 6;
    const int gw = bid * 8 + wave, NGW = nb * 8;
    LAS float* scr = (LAS float*)(lds + wave * 8448);
    for (int r = gw; r < RT; r += NGW) {
        unsigned long long* o8 = (unsigned long long*)(p.hnb + (size_t)r * D) + lane;
        if (r < RPAD) {
#pragma unroll
            for (int j = 0; j < 8; ++j) o8[64 * j] = 0ull;
        } else {
            const f32x4* xr = (const f32x4*)hrow(p, r - RPAD) + lane;
            const f32x4* gr = (const f32x4*)p.mix_g + lane;
            f32x4 v[8]; float s = 0.f;
#pragma unroll
            for (int j = 0; j < 8; ++j) { v[j] = xr[64 * j]; s += (v[j].x * v[j].x + v[j].y * v[j].y) + (v[j].z * v[j].z + v[j].w * v[j].w); }
            const float rs = rsqrtf(wave_sum(s) * (1.0f / D) + 1e-6f);
#pragma unroll
            for (int j = 0; j < 8; ++j) { const f32x4 gv = gr[64 * j];
                o8[64 * j] = (unsigned long long)cvt_pk_bf16(v[j].x * rs * gv.x, v[j].y * rs * gv.y) | ((unsigned long long)cvt_pk_bf16(v[j].z * rs * gv.z, v[j].w * rs * gv.w) << 32); }
        }
    }
    for (int it = gw; it < (D / 64) * (INW / 32); it += NGW) {
        const int kb = it / (INW / 32), nbk = it % (INW / 32);
        tr_item(p.w_in, INW, win_srccol(nbk * 32), kb * 64, p.w_in_t, D, nbk * 32, nullptr, nullptr, scr, lane);
    }
    for (int it = gw; it < 4 * 4 * 8; it += NGW) { const int g = it >> 5, kb = (it >> 3) & 3, nbk = it & 7;
        tr_item(p.pool_w + (size_t)g * 65536, 256, nbk * 32, kb * 64, p.pool_wt + (size_t)g * 65536, 256, nbk * 32, nullptr, p.pool_scale + g * 256, scr, lane); }
    for (int it = gw; it < 16 * 32; it += NGW) { const int kb = it >> 5, nbk = it & 31;
        tr_item(p.pw_w, CWD, nbk * 32, kb * 64, p.pw_t, CWD, nbk * 32, nullptr, nullptr, scr, lane); }
    for (int it = gw; it < 32 * 64; it += NGW) { const int kb = it >> 6, nbk = it & 63;
        tr_item(p.w_out, D, nbk * 32, kb * 64, p.w_out_t, D, nbk * 32, nullptr, nullptr, scr, lane); }
    for (int it = gw; it < 32 * 64; it += NGW) { const int kb = it >> 6, nbk = it & 63;
        tr_item(p.wq, D, nbk * 32, kb * 64, p.wq_t, D, nbk * 32, p.ffn_g, nullptr, scr, lane); }
    for (int i = gw * 64 + lane; i < 8 * 2 * 128 * 128 / 4; i += NGW * 64) { const f32x4 v = ((const f32x4*)p.keys)[i];
        u32x2 w; w.x = cvt_pk_bf16(v[0], v[1]); w.y = cvt_pk_bf16(v[2], v[3]); ((u32x2*)p.keysb)[i] = w; }
    for (size_t i = (size_t)gw * 64 + lane; i < (size_t)16384 * D / 8; i += (size_t)NGW * 64) {
        { const f32x4 a = ((const f32x4*)p.down)[2 * i], b = ((const f32x4*)p.down)[2 * i + 1];
          ((u32x4*)p.downb)[i] = (u32x4){cvt_pk_bf16(a[0], a[1]), cvt_pk_bf16(a[2], a[3]), cvt_pk_bf16(b[0], b[1]), cvt_pk_bf16(b[2], b[3])}; }
        { const f32x4 a = ((const f32x4*)p.up)[2 * i], b = ((const f32x4*)p.up)[2 * i + 1];
          ((u32x4*)p.upb)[i] = (u32x4){cvt_pk_bf16(a[0], a[1]), cvt_pk_bf16(a[2], a[3]), cvt_pk_bf16(b[0], b[1]), cvt_pk_bf16(b[2], b[3])}; }
    }
}


#define XB_TMO      128
#define XB_XCNT(j)  (256  + 64 * (j))
#define XB_XSUB(j)  (1280 + 64 * (j))
#define XB_XGEN(j)  (2304 + 64 * (j))
#define XB_TOP      3328
#define XB_TOPGEN   3392
#define XCD_BAR_WORDS 3456
#define XB_SPIN_CAP (1u << 18)
__device__ __forceinline__ unsigned xb_ld(unsigned* p)              { return __hip_atomic_load(p, __ATOMIC_RELAXED, __HIP_MEMORY_SCOPE_AGENT); }
__device__ __forceinline__ unsigned xb_add(unsigned* p, unsigned v) { return __hip_atomic_fetch_add(p, v, __ATOMIC_RELAXED, __HIP_MEMORY_SCOPE_AGENT); }
__device__ __forceinline__ unsigned xb_xcc_id() { return (unsigned)__builtin_amdgcn_s_getreg((3 << 11) | 20) & 0xFu; }
#define XB_SPIN(cond, bar) do { unsigned _sp = 0; while (cond) { __builtin_amdgcn_s_sleep(1); \
    if ((++_sp & 255u) == 0u) { if (xb_ld(&(bar)[XB_TMO])) break; if (_sp > XB_SPIN_CAP) { atomicAdd(&(bar)[XB_TMO], 1u); break; } } } } while (0)
struct XcdBarrier { unsigned* bar; unsigned x; volatile LAS unsigned* st; };
__device__ __forceinline__ XcdBarrier xcd_barrier_post(unsigned* bar, volatile LAS unsigned* st) {
    XcdBarrier b; b.bar = bar; b.x = xb_xcc_id(); b.st = st;
    if (threadIdx.x == 0) (void)xb_add(&bar[XB_XCNT(b.x)], 1u);
    return b;
}
__device__ __forceinline__ void xcd_barrier_complete(unsigned* bar, unsigned x, unsigned& nloc, unsigned& nx) {
    const unsigned G = gridDim.x * gridDim.y * gridDim.z;
    unsigned sum, cnt, mine, sp = 0u;
    for (;;) {
        sum = 0u; cnt = 0u; mine = 0u;
#pragma unroll
        for (unsigned j = 0; j < 16; ++j) { const unsigned c = xb_ld(&bar[XB_XCNT(j)]); sum += c; cnt += (c > 0u) ? 1u : 0u; mine = (j == x) ? c : mine; }
        if (sum == G) break;
        __builtin_amdgcn_s_sleep(1);
        if ((++sp & 255u) == 0u) { if (xb_ld(&bar[XB_TMO])) break; if (sp > XB_SPIN_CAP) { atomicAdd(&bar[XB_TMO], 1u); break; } }
    }
    nloc = mine > 0u ? mine : 1u; nx = cnt > 0u ? cnt : 1u;
}
__device__ __forceinline__ void xcd_barrier(const XcdBarrier& b) {
    asm volatile("s_waitcnt vmcnt(0)" ::: "memory");
    __syncthreads();
    if (threadIdx.x == 0) {
        unsigned* bar = b.bar;
        __builtin_amdgcn_s_waitcnt(0);
        unsigned nloc = b.st[0], nx = b.st[1];
        if (nloc == 0u) { xcd_barrier_complete(bar, b.x, nloc, nx); b.st[0] = nloc; b.st[1] = nx; }
        const unsigned old = xb_add(&bar[XB_XSUB(b.x)], 1u);
        const unsigned gen = old / nloc;
        if (old + 1u == (gen + 1u) * nloc) {
            __builtin_amdgcn_fence(__ATOMIC_RELEASE, "agent");
            asm volatile("s_waitcnt vmcnt(0)" ::: "memory");
            const unsigned og = xb_add(&bar[XB_TOP], 1u);
            const unsigned tg = og / nx;
            if (og + 1u == (tg + 1u) * nx) xb_add(&bar[XB_TOPGEN], 1u);
            else XB_SPIN(xb_ld(&bar[XB_TOPGEN]) == tg, bar);
            __builtin_amdgcn_fence(__ATOMIC_ACQUIRE, "agent");
            xb_add(&bar[XB_XGEN(b.x)], 1u);
            asm volatile("s_waitcnt vmcnt(0)" ::: "memory");
        } else {
            XB_SPIN(xb_ld(&bar[XB_XGEN(b.x)]) == gen, bar);
            __builtin_amdgcn_fence(__ATOMIC_ACQUIRE, "agent");
            asm volatile("s_waitcnt vmcnt(0)" ::: "memory");
        }
    }
    __syncthreads();
}

__device__ __forceinline__ GemmArgs mk(const float* A, int lda, const float* B, int ldb, float* C, int ldc, int M, int N, int K, const float* bias, const float* scale, int rh) {
    GemmArgs g; g.A = A; g.lda = lda; g.B = B; g.ldb = ldb; g.C = C; g.ldc = ldc; g.M = M; g.N = N; g.K = K; g.bias = bias; g.scale = scale; g.resid_h = rh; return g;
}

__global__ void __launch_bounds__(NT, 2) k_mega(Params p) {
    extern __shared__ __attribute__((aligned(16))) unsigned char lds_raw[];
    LAS unsigned char* lds = (LAS unsigned char*)lds_raw;
    float* smem = (float*)lds_raw;
    cg::grid_group grid = cg::this_grid();
    const int bid = blockIdx.x, nb = gridDim.x;
    volatile LAS unsigned* bst = (volatile LAS unsigned*)(lds + 131072);
    if (threadIdx.x < 4) bst[threadIdx.x] = 0u;
    __syncthreads();
    const XcdBarrier xb = xcd_barrier_post(p.bar, bst);
    phase_prep(p, lds, bid, nb);
    grid.sync();
    { pg8::Gemm g{p.hnb, p.w_in_t, D, D, D, 0}; pg8::StaticOrder S; S.init(RT / 256, INW / 256, nb, bid); EpiProj E{p.xp, p.glu};
      pg8::gemm_phase<EpiProj, pg8::StaticOrder>(lds, g, S, E); }
    xcd_barrier(xb);
    phase_mix(p, lds, bid, nb);
    xcd_barrier(xb);
    if (bid < nb / 2) { pg8::Gemm g{p.pooledb, p.pool_wt, PWD, 256, 256, 256}; pg8::StaticOrder S; S.init(SEQ / 256, 4, nb / 2, bid); EpiBf16Out E{p.yabb, D, 0, nullptr};
      pg8::gemm_phase<EpiBf16Out, pg8::StaticOrder>(lds, g, S, E); }
    else { pg8::Gemm g{p.cvnb, p.pw_t, CWD, CWD, CWD, 0}; pg8::StaticOrder S; S.init(SEQ / 256, 4, nb - nb / 2, bid - nb / 2); EpiBf16Out E{p.yabb, D, PWD, p.pw_b};
      pg8::gemm_phase<EpiBf16Out, pg8::StaticOrder>(lds, g, S, E); }
    xcd_barrier(xb);
    { pg8::Gemm g{p.yabb, p.w_out_t, D, D, D, 0}; pg8::StaticOrder S; S.init(SEQ / 256, D / 256, nb, bid); EpiResid E{p.x, p.h2, p.h2b, p.ssq};
      pg8::gemm_phase<EpiResid, pg8::StaticOrder>(lds, g, S, E); }
    xcd_barrier(xb);
    { pg8::Gemm g{p.h2b, p.wq_t, D, D, D, 0}; pg8::StaticOrder S; S.init(SEQ / 256, D / 256, nb, bid); EpiQ E{p.ssq, p.rstd, p.qb};
      pg8::gemm_phase<EpiQ, pg8::StaticOrder>(lds, g, S, E); }
    xcd_barrier(xb);
    phase_topk2(p, lds, bid, nb);
    xcd_barrier(xb);
    phase_peer2(p, bid, nb);
}

extern "C" void kernel_launch(void* const* d_in, const int* in_sizes, int n_in, void* d_out, int out_size, void* d_ws, size_t ws_size, hipStream_t stream) {
    Params p{};
    p.x = (const float*)d_in[0]; p.meta = (const float*)d_in[1]; p.mix_g = (const float*)d_in[2]; p.w_in = (const float*)d_in[3];
    p.pool_w = (const float*)d_in[4]; p.pool_scale = (const float*)d_in[5]; p.dw_w = (const float*)d_in[6]; p.dw_b = (const float*)d_in[7];
    p.ln_g = (const float*)d_in[8]; p.ln_b = (const float*)d_in[9]; p.pw_w = (const float*)d_in[10]; p.pw_b = (const float*)d_in[11];
    p.w_out = (const float*)d_in[12]; p.ffn_g = (const float*)d_in[13]; p.wq = (const float*)d_in[14]; p.keys = (const float*)d_in[15];
    p.down = (const float*)d_in[16]; p.up = (const float*)d_in[17]; p.fin_g = (const float*)d_in[18];
    p.out = (float*)d_out;
    char* w = (char*)d_ws; size_t off = 0;
    auto take = [&](size_t bytes) { char* r = w + off; off += (bytes + 255) & ~(size_t)255; return r; };
    p.h2 = (float*)take((size_t)SEQ * D * 4);
    p.idx = (int*)take((size_t)SEQ * 128 * 4);
    p.gate = (float*)take((size_t)SEQ * 128 * 4);
    p.hnb = (bf16_t*)take((size_t)RT * D * 2);
    p.w_in_t = (bf16_t*)take((size_t)INW * D * 2);
    p.xp = (bf16_t*)take((size_t)RT * PWD * 2);
    p.glu = (bf16_t*)take((size_t)RT * CWD * 2);
    p.pooledb = (bf16_t*)take((size_t)SEQ * PWD * 2);
    p.cvnb = (bf16_t*)take((size_t)SEQ * CWD * 2);
    p.yabb = (bf16_t*)take((size_t)SEQ * D * 2);
    p.h2b = (bf16_t*)take((size_t)SEQ * D * 2);
    p.pool_wt = (bf16_t*)take((size_t)4 * 256 * 256 * 2);
    p.pw_t = (bf16_t*)take((size_t)CWD * CWD * 2);
    p.w_out_t = (bf16_t*)take((size_t)D * D * 2);
    p.ssq = (float*)take((size_t)SEQ * 32 * 4);
    p.bar = (unsigned*)take((size_t)XCD_BAR_WORDS * 4);
    p.rstd = (float*)take((size_t)SEQ * 4);
    p.wq_t = (bf16_t*)take((size_t)D * D * 2);
    p.keysb = (bf16_t*)take((size_t)8 * 2 * 128 * 128 * 2);
    p.qb = (bf16_t*)take((size_t)SEQ * D * 2);
    p.downb = (bf16_t*)take((size_t)16384 * D * 2);
    p.upb = (bf16_t*)take((size_t)16384 * D * 2);
    static int grid_blocks = 0;
    if (!grid_blocks) {
        int dev = 0, cus = 0, per_cu = 0;
        (void)hipGetDevice(&dev);
        (void)hipDeviceGetAttribute(&cus, hipDeviceAttributeMultiprocessorCount, dev);
        (void)hipFuncSetAttribute((const void*)k_mega, hipFuncAttributeMaxDynamicSharedMemorySize, LDS_BYTES);
        (void)hipOccupancyMaxActiveBlocksPerMultiprocessor(&per_cu, k_mega, NT, LDS_BYTES);
        if (per_cu < 1) fprintf(stderr, "occupancy query says %d blocks per CU\n", per_cu);
        grid_blocks = cus;
    }
    (void)hipMemsetAsync(p.bar, 0, (size_t)XCD_BAR_WORDS * 4, stream);
    void* args[] = {&p};
    hipError_t e = hipLaunchCooperativeKernel((void*)k_mega, dim3(grid_blocks), dim3(NT), args, LDS_BYTES, stream);
    if (e != hipSuccess) fprintf(stderr, "cooperative launch failed: %s (grid %d)\n", hipGetErrorString(e), grid_blocks);
}
```

```cpp
#include <hip/hip_runtime.h>
#include <hip/hip_cooperative_groups.h>
#include <stdint.h>
#include <cstdio>
namespace cg = cooperative_groups;

#define NT 512
#define LAS __attribute__((address_space(3)))
typedef unsigned short bf16_t;
typedef short bf16x8 __attribute__((ext_vector_type(8)));
typedef float f32x4 __attribute__((ext_vector_type(4)));
typedef unsigned u32x4 __attribute__((ext_vector_type(4)));
typedef unsigned u32x2 __attribute__((ext_vector_type(2)));

constexpr int D = 2048, SEQ = 8192, NMETA = 16, T = SEQ + NMETA;
constexpr int PWD = 1024, CWD = 1024, INW = 3072;
constexpr int KS = 31;
constexpr int RPAD = 240, RT = 8448;
constexpr int LDS_BYTES = 147456;

struct Params {
    const float *x, *meta, *mix_g, *w_in, *pool_w, *pool_scale, *dw_w, *dw_b, *ln_g, *ln_b, *pw_w, *pw_b, *w_out, *ffn_g, *wq, *keys, *down, *up, *fin_g;
    float* out;
    int* idx;
    unsigned* bar;
    bf16_t *hnb, *w_in_t, *xp, *glu, *pooledb, *cvnb, *yabb, *h2b, *pool_wt, *pw_t, *w_out_t, *wq_t, *keysb, *qb;
    unsigned char *down8, *up8;
    float *sdn, *sup;
    float *gsu, *sdv;
    float *ssq, *rstd;
};

__device__ __forceinline__ unsigned cvt_pk_bf16(float lo, float hi) { unsigned r; asm volatile("v_cvt_pk_bf16_f32 %0, %1, %2" : "=v"(r) : "v"(lo), "v"(hi)); return r; }
__device__ __forceinline__ float wave_sum(float v) {
#pragma unroll
    for (int o = 1; o < 64; o <<= 1) v += __shfl_xor(v, o);
    return v;
}

__device__ __forceinline__ const float* hrow(const Params& p, int t) { return t < NMETA ? p.meta + (size_t)t * D : p.x + (size_t)(t - NMETA) * D; }

__device__ __forceinline__ float block_sum(float v, float* red) {
#pragma unroll
    for (int o = 32; o; o >>= 1) v += __shfl_xor(v, o);
    __syncthreads();
    if ((threadIdx.x & 63) == 0) red[threadIdx.x >> 6] = v;
    __syncthreads();
    float s = 0.f;
#pragma unroll
    for (int i = 0; i < NT / 64; ++i) s += red[i];
    return s;
}

namespace pg8 {
constexpr int BM = 256, BK = 64, HALF = 128, HTB = HALF * BK * 2, STAGE_BYTES = 8 * HTB, NXCD = 8, WGM = 8;
__device__ __forceinline__ int lds_byte(int r, int c) { const int st = (r >> 4) * 2 + (c >> 5), rr = r & 15, cc = c & 31, ob = rr * 64 + cc * 2; return st * 1024 + (ob ^ (((ob >> 9) & 1) << 5)); }
__device__ __forceinline__ void stage_rc(int b, int& R, int& C) { const int st = b / 1024, sb = b % 1024, swz = sb ^ (((sb >> 9) & 1) << 5); R = (st >> 1) * 16 + swz / 64; C = (st & 1) * 32 + (swz % 64) / 2; }
struct Unit { int pm, pn; };
struct Gemm { const bf16_t* A; const bf16_t* Bt; int lda, ldb, K; int a_col_per_pn; };
struct StaticOrder {
    int nM, nN, nwg, G, c;
    __device__ void init(int nM_, int nN_, int G_, int c_) { nM = nM_; nN = nN_; nwg = nM * nN; G = G_; c = c_; }
    __device__ bool next(int i, Unit& u) const {
        const long L = (long)i * G + c; if (L >= nwg) return false;
        int wgid = (int)L; { const int q = nwg / NXCD, r = nwg % NXCD, xcd = wgid % NXCD, off = wgid / NXCD; wgid = (xcd < r ? xcd * (q + 1) : r * (q + 1) + (xcd - r) * q) + off; }
        const int nig = WGM * nN, gid = wgid / nig, fm = gid * WGM, gsz = (nM - fm) < WGM ? (nM - fm) : WGM;
        u.pm = fm + ((wgid % nig) % gsz); u.pn = (wgid % nig) / gsz; return true;
    }
};
template <class Epi, class Sched>
__device__ __forceinline__ void gemm_phase(LAS unsigned char* lds, const Gemm g, const Sched& S, const Epi& E) {
    const int tid = threadIdx.x, wid = __builtin_amdgcn_readfirstlane(tid >> 6), lane = tid & 63, wr = wid >> 2, wc = wid & 3, fr = lane & 15, fq = lane >> 4;
    const int K = g.K, nt = K / BK;
    unsigned voffA[2], voffB[2];
#pragma unroll
    for (int i = 0; i < 2; ++i) { int R, C; stage_rc(tid * 16 + i * 8192, R, C);
        voffA[i] = (unsigned)(R * g.lda + C) * 2u; voffB[i] = (unsigned)(R * g.ldb + C) * 2u; }
    const size_t kstep = (size_t)(BK * 2);
    const size_t hstepA = (size_t)HALF * g.lda * 2, hstepB = (size_t)HALF * g.ldb * 2;
    const size_t tstepA = 2 * hstepA, tstepB = 2 * hstepB;
    const unsigned ldsw = (unsigned)wid * 1024u;
    const int aoff = lds_byte(wr * 64 + fr, fq * 8), boff = lds_byte(wc * 32 + fr, fq * 8);
#define PG8_SA(b, h) (((b) * 2 + (h)) * HTB)
#define PG8_SB(b, h) ((4 + (b) * 2 + (h)) * HTB)
#define PG8_STAGE(bufoff, gbase, voff) do { _Pragma("unroll") for (int _i = 0; _i < 2; ++_i) \
        __builtin_amdgcn_global_load_lds((const unsigned*)((const char*)(gbase) + (voff)[_i]), (LAS unsigned*)(lds + (bufoff) + ldsw + _i * 8192), 16, 0, 0); } while (0)
#define PG8_LDA(dst, b, h) do { _Pragma("unroll") for (int m = 0; m < 4; ++m) _Pragma("unroll") for (int k = 0; k < 2; ++k) dst[m][k] = *(const LAS bf16x8*)(lds + PG8_SA(b, h) + aoff + m * 2048 + k * 1024); } while (0)
#define PG8_LDB(dst, b, h) do { _Pragma("unroll") for (int n = 0; n < 2; ++n) _Pragma("unroll") for (int k = 0; k < 2; ++k) dst[n][k] = *(const LAS bf16x8*)(lds + PG8_SB(b, h) + boff + n * 2048 + k * 1024); } while (0)
#define PG8_MMA(ai, bj, At, Bt) do { __builtin_amdgcn_s_setprio(1); _Pragma("unroll") for (int m = 0; m < 4; ++m) _Pragma("unroll") for (int n = 0; n < 2; ++n) _Pragma("unroll") for (int k = 0; k < 2; ++k) \
        acc[ai][bj][m][n] = __builtin_amdgcn_mfma_f32_16x16x32_bf16(Bt[n][k], At[m][k], acc[ai][bj][m][n], 0, 0, 0); __builtin_amdgcn_s_setprio(0); } while (0)
#define PG8_WAIT_V(n) asm volatile("s_waitcnt vmcnt(" #n ")" ::: "memory")
#define PG8_WAIT_L(n) asm volatile("s_waitcnt lgkmcnt(" #n ")" ::: "memory")
#define PG8_BAR __builtin_amdgcn_s_barrier()
#define PG8_SCHED __builtin_amdgcn_sched_barrier(0)
    Unit cur, nxt; int ui = 0;
    if (!S.next(0, cur)) return;
    f32x4 acc[2][2][4][2];
#pragma unroll
    for (int a = 0; a < 2; ++a)
#pragma unroll
        for (int b = 0; b < 2; ++b)
#pragma unroll
            for (int m = 0; m < 4; ++m)
#pragma unroll
                for (int n = 0; n < 2; ++n) acc[a][b][m][n] = (f32x4){0.f, 0.f, 0.f, 0.f};
    bf16x8 At[4][2], B0[2][2], B1[2][2];
    const char* cA = (const char*)g.A + (size_t)cur.pm * tstepA + (size_t)cur.pn * g.a_col_per_pn * 2; const char* cB = (const char*)g.Bt + (size_t)cur.pn * tstepB;
    PG8_STAGE(PG8_SB(0, 0), cB, voffB); PG8_STAGE(PG8_SA(0, 0), cA, voffA); PG8_STAGE(PG8_SB(0, 1), cB + hstepB, voffB); PG8_STAGE(PG8_SA(0, 1), cA + hstepA, voffA);
    if (wr == 1) PG8_BAR;
    PG8_WAIT_V(4); PG8_BAR;
    PG8_STAGE(PG8_SB(1, 0), cB + kstep, voffB); PG8_STAGE(PG8_SA(1, 0), cA + kstep, voffA); PG8_STAGE(PG8_SB(1, 1), cB + hstepB + kstep, voffB);
    PG8_WAIT_V(6); PG8_BAR;
    for (;;) {
        const bool has_next = S.next(ui + 1, nxt);
        const char* nA = has_next ? (const char*)g.A + (size_t)nxt.pm * tstepA + (size_t)nxt.pn * g.a_col_per_pn * 2 : cA; const char* nB = has_next ? (const char*)g.Bt + (size_t)nxt.pn * tstepB : cB;
        for (int t = 0; t < nt; t += 2) {
            const bool last = (t == nt - 2);
            const char* a1 = cA + (size_t)(t + 1) * kstep;
            const char* a2 = last ? nA : cA + (size_t)(t + 2) * kstep; const char* b2 = last ? nB : cB + (size_t)(t + 2) * kstep;
            const char* a3 = a2 + kstep; const char* b3 = b2 + kstep;
            PG8_LDB(B0, 0, 0); PG8_SCHED; PG8_LDA(At, 0, 0); PG8_STAGE(PG8_SA(1, 1), a1 + hstepA, voffA);
            PG8_WAIT_L(8); PG8_BAR; PG8_WAIT_L(0); PG8_MMA(0, 0, At, B0); PG8_BAR; PG8_SCHED;
            PG8_LDB(B1, 0, 1); PG8_STAGE(PG8_SB(0, 0), b2, voffB);
            PG8_BAR; PG8_WAIT_L(0); PG8_MMA(0, 1, At, B1); PG8_BAR;
            PG8_LDA(At, 0, 1); PG8_STAGE(PG8_SA(0, 0), a2, voffA);
            PG8_BAR; PG8_WAIT_L(0); PG8_MMA(1, 0, At, B0); PG8_BAR; PG8_SCHED;
            PG8_STAGE(PG8_SB(0, 1), b2 + hstepB, voffB);
            PG8_WAIT_V(6); PG8_BAR; PG8_MMA(1, 1, At, B1); PG8_BAR;
            PG8_LDB(B0, 1, 0); PG8_SCHED; PG8_LDA(At, 1, 0); PG8_STAGE(PG8_SA(0, 1), a2 + hstepA, voffA);
            PG8_WAIT_L(8); PG8_BAR; PG8_WAIT_L(0); PG8_MMA(0, 0, At, B0); PG8_BAR; PG8_SCHED;
            PG8_LDB(B1, 1, 1); PG8_STAGE(PG8_SB(1, 0), b3, voffB);
            PG8_BAR; PG8_WAIT_L(0); PG8_MMA(0, 1, At, B1); PG8_BAR;
            PG8_LDA(At, 1, 1); PG8_STAGE(PG8_SA(1, 0), a3, voffA);
            PG8_BAR; PG8_WAIT_L(0); PG8_MMA(1, 0, At, B0); PG8_BAR; PG8_SCHED;
            PG8_STAGE(PG8_SB(1, 1), b3 + hstepB, voffB);
            PG8_WAIT_V(6); PG8_BAR; PG8_MMA(1, 1, At, B1); PG8_BAR;
        }
        E(acc, cur, wr, wc, fr, fq);
        if (!has_next) break;
#pragma unroll
        for (int a = 0; a < 2; ++a)
#pragma unroll
            for (int b = 0; b < 2; ++b)
#pragma unroll
                for (int m = 0; m < 4; ++m)
#pragma unroll
                    for (int n = 0; n < 2; ++n) acc[a][b][m][n] = (f32x4){0.f, 0.f, 0.f, 0.f};
        cur = nxt; cA = nA; cB = nB; ++ui;
    }
    PG8_WAIT_V(0);
    if (wr == 0) PG8_BAR;
    PG8_BAR;
#undef PG8_SA
#undef PG8_SB
#undef PG8_STAGE
#undef PG8_LDA
#undef PG8_LDB
#undef PG8_MMA
#undef PG8_WAIT_V
#undef PG8_WAIT_L
#undef PG8_BAR
#undef PG8_SCHED
}
}

struct EpiProjF32 {
    float* proj;
    __device__ __forceinline__ void operator()(const f32x4 (&acc)[2][2][4][2], const pg8::Unit& u, int wr, int wc, int fr, int fq) const {
#pragma unroll
        for (int ai = 0; ai < 2; ++ai)
#pragma unroll
            for (int m = 0; m < 4; ++m) {
                const int t = u.pm * 256 + ai * 128 + wr * 64 + m * 16 + fr - RPAD;
                if (t >= 0) {
#pragma unroll
                    for (int bj = 0; bj < 2; ++bj)
#pragma unroll
                        for (int n = 0; n < 2; ++n) {
                            const int off = wc * 32 + n * 16 + fq * 4;
                            const int col = u.pn < 4 ? u.pn * 256 + bj * 128 + off : (bj ? 2048 : 1024) + (u.pn - 4) * 128 + off;
                            *(f32x4*)(proj + (size_t)t * INW + col) = acc[ai][bj][m][n];
                        }
                }
            }
    }
};


__device__ __forceinline__ float sigmoidf_fast(float x) { return __builtin_amdgcn_rcpf(1.0f + __expf(-x)); }

struct EpiProj {
    bf16_t* xp; bf16_t* glu;
    __device__ __forceinline__ void operator()(const f32x4 (&acc)[2][2][4][2], const pg8::Unit& u, int wr, int wc, int fr, int fq) const {
#pragma unroll
        for (int ai = 0; ai < 2; ++ai)
#pragma unroll
            for (int m = 0; m < 4; ++m) {
                const size_t row = (size_t)(u.pm * 256 + ai * 128 + wr * 64 + m * 16 + fr);
                if (u.pn < 4) {
#pragma unroll
                    for (int bj = 0; bj < 2; ++bj)
#pragma unroll
                        for (int n = 0; n < 2; ++n) { const f32x4 v = acc[ai][bj][m][n]; u32x2 w; w.x = cvt_pk_bf16(v[0], v[1]); w.y = cvt_pk_bf16(v[2], v[3]);
                            *(u32x2*)(xp + row * PWD + u.pn * 256 + bj * 128 + wc * 32 + n * 16 + fq * 4) = w; }
                } else {
#pragma unroll
                    for (int n = 0; n < 2; ++n) { const f32x4 a = acc[ai][0][m][n], g = acc[ai][1][m][n]; u32x2 w;
                        w.x = cvt_pk_bf16(a[0] * sigmoidf_fast(g[0]), a[1] * sigmoidf_fast(g[1])); w.y = cvt_pk_bf16(a[2] * sigmoidf_fast(g[2]), a[3] * sigmoidf_fast(g[3]));
                        *(u32x2*)(glu + row * CWD + (u.pn - 4) * 128 + wc * 32 + n * 16 + fq * 4) = w; }
                }
            }
    }
};
struct EpiBf16Out {
    bf16_t* O; int ldc; int col0; const float* bias;
    __device__ __forceinline__ void operator()(const f32x4 (&acc)[2][2][4][2], const pg8::Unit& u, int wr, int wc, int fr, int fq) const {
#pragma unroll
        for (int ai = 0; ai < 2; ++ai)
#pragma unroll
            for (int m = 0; m < 4; ++m) {
                const size_t row = (size_t)(u.pm * 256 + ai * 128 + wr * 64 + m * 16 + fr);
#pragma unroll
                for (int bj = 0; bj < 2; ++bj)
#pragma unroll
                    for (int n = 0; n < 2; ++n) { const int c = u.pn * 256 + bj * 128 + wc * 32 + n * 16 + fq * 4; f32x4 v = acc[ai][bj][m][n];
                        if (bias) v += *(const f32x4*)(bias + c);
                        u32x2 w; w.x = cvt_pk_bf16(v[0], v[1]); w.y = cvt_pk_bf16(v[2], v[3]);
                        *(u32x2*)(O + row * ldc + col0 + c) = w; }
            }
    }
};
struct EpiResid {
    const float* x; bf16_t* h2b; float* ssq;
    __device__ __forceinline__ void operator()(const f32x4 (&acc)[2][2][4][2], const pg8::Unit& u, int wr, int wc, int fr, int fq) const {
#pragma unroll
        for (int ai = 0; ai < 2; ++ai)
#pragma unroll
            for (int m = 0; m < 4; ++m) {
                const size_t row = (size_t)(u.pm * 256 + ai * 128 + wr * 64 + m * 16 + fr);
                float ss = 0.f;
#pragma unroll
                for (int bj = 0; bj < 2; ++bj)
#pragma unroll
                    for (int n = 0; n < 2; ++n) { const int c = u.pn * 256 + bj * 128 + wc * 32 + n * 16 + fq * 4;
                        const f32x4 v = acc[ai][bj][m][n] + *(const f32x4*)(x + row * D + c);
                        u32x2 w; w.x = cvt_pk_bf16(v[0], v[1]); w.y = cvt_pk_bf16(v[2], v[3]);
                        *(u32x2*)(h2b + row * D + c) = w;
                        ss += (v[0] * v[0] + v[1] * v[1]) + (v[2] * v[2] + v[3] * v[3]); }
                ss += __shfl_xor(ss, 16); ss += __shfl_xor(ss, 32);
                if (fq == 0) ssq[row * 32 + u.pn * 4 + wc] = ss;
            }
    }
};

__device__ __forceinline__ float bf_lo(unsigned w) { return __uint_as_float(w << 16); }
__device__ __forceinline__ float bf_hi(unsigned w) { return __uint_as_float(w & 0xffff0000u); }

__device__ __forceinline__ void phase_mix(const Params& p, LAS unsigned char* lds, int bid, int nb) {
    const int tid = threadIdx.x, lane = tid & 63, wave = tid >> 6;
    LAS unsigned* gl = (LAS unsigned*)lds;
    LAS float* red = (LAS float*)(lds + 62 * 2048);
    float w0[KS], w1[KS];
#pragma unroll
    for (int k = 0; k < KS; ++k) { const float2 wv = *(const float2*)(p.dw_w + k * CWD + 2 * tid); w0[k] = wv.x; w1[k] = wv.y; }
    const float2 bv = *(const float2*)(p.dw_b + 2 * tid), lg = *(const float2*)(p.ln_g + 2 * tid), lb = *(const float2*)(p.ln_b + 2 * tid);
    for (int tile = bid; tile < SEQ / 32; tile += nb) {
        const int r0 = 256 + tile * 32;
        __syncthreads();
        for (int ch = tid; ch < 62 * 128; ch += NT) { const int rr = ch >> 7, cc = ch & 127;
            *(LAS u32x4*)(lds + rr * 2048 + cc * 16) = *(const u32x4*)(p.glu + (size_t)(r0 - 30 + rr) * CWD + cc * 8); }
        {
            const int g = tid >> 7, w = 2 << g; const float inv = 1.0f / (float)w;
            const unsigned* xpp = (const unsigned*)p.xp + tid;
            float s0 = 0.f, s1 = 0.f;
            for (int u = r0 - w + 1; u <= r0 - 1; ++u) { const unsigned v = xpp[(size_t)u * 512]; s0 += bf_lo(v); s1 += bf_hi(v); }
            for (int i = 0; i < 32; ++i) {
                const unsigned vn = xpp[(size_t)(r0 + i) * 512]; const float a0 = bf_lo(vn), a1 = bf_hi(vn);
                s0 += a0; s1 += a1;
                ((unsigned*)p.pooledb)[(size_t)(tile * 32 + i) * 512 + tid] = cvt_pk_bf16(s0 * inv - a0, s1 * inv - a1);
                const unsigned vo = xpp[(size_t)(r0 + i - w + 1) * 512]; s0 -= bf_lo(vo); s1 -= bf_hi(vo);
            }
        }
        __syncthreads();
        for (int i = 0; i < 32; ++i) {
            float a0 = bv.x, a1 = bv.y;
#pragma unroll
            for (int k = 0; k < KS; ++k) { const unsigned v = gl[(i + k) * 512 + tid]; a0 += bf_lo(v) * w0[k]; a1 += bf_hi(v) * w1[k]; }
            float s1 = a0 + a1, s2 = a0 * a0 + a1 * a1;
            s1 = wave_sum(s1); s2 = wave_sum(s2);
            if (lane == 0) { red[(i * 8 + wave) * 2] = s1; red[(i * 8 + wave) * 2 + 1] = s2; }
        }
        __syncthreads();
        for (int i = 0; i < 32; ++i) {
            float a0 = bv.x, a1 = bv.y;
#pragma unroll
            for (int k = 0; k < KS; ++k) { const unsigned v = gl[(i + k) * 512 + tid]; a0 += bf_lo(v) * w0[k]; a1 += bf_hi(v) * w1[k]; }
            float s1 = 0.f, s2 = 0.f;
#pragma unroll
            for (int q = 0; q < 8; ++q) { s1 += red[(i * 8 + q) * 2]; s2 += red[(i * 8 + q) * 2 + 1]; }
            const float mu = s1 * (1.0f / CWD), var = fmaxf(s2 * (1.0f / CWD) - mu * mu, 0.f), rs = rsqrtf(var + 1e-5f);
            const float y0 = (a0 - mu) * rs * lg.x + lb.x, y1 = (a1 - mu) * rs * lg.y + lb.y;
            ((unsigned*)p.cvnb)[(size_t)(tile * 32 + i) * 512 + tid] = cvt_pk_bf16(y0 * sigmoidf_fast(y0), y1 * sigmoidf_fast(y1));
        }
    }
}


struct EpiQ {
    const float* ssq; float* rstd; bf16_t* qb;
    __device__ __forceinline__ void operator()(const f32x4 (&acc)[2][2][4][2], const pg8::Unit& u, int wr, int wc, int fr, int fq) const {
#pragma unroll
        for (int ai = 0; ai < 2; ++ai)
#pragma unroll
            for (int m = 0; m < 4; ++m) {
                const size_t row = (size_t)(u.pm * 256 + ai * 128 + wr * 64 + m * 16 + fr);
                const f32x4* sp = (const f32x4*)(ssq + row * 32); f32x4 t = sp[0];
#pragma unroll
                for (int i = 1; i < 8; ++i) t += sp[i];
                const float rs = rsqrtf(((t[0] + t[1]) + (t[2] + t[3])) * (1.0f / D) + 1e-6f);
                if (u.pn == 0 && wc == 0 && fq == 0) rstd[row] = rs;
#pragma unroll
                for (int bj = 0; bj < 2; ++bj)
#pragma unroll
                    for (int n = 0; n < 2; ++n) { const int c = u.pn * 256 + bj * 128 + wc * 32 + n * 16 + fq * 4; const f32x4 v = acc[ai][bj][m][n] * rs;
                        u32x2 w; w.x = cvt_pk_bf16(v[0], v[1]); w.y = cvt_pk_bf16(v[2], v[3]);
                        *(u32x2*)(qb + row * D + c) = w; }
            }
    }
};

typedef float f32x16 __attribute__((ext_vector_type(16)));
__device__ __forceinline__ int okey(float s) { const int u = __float_as_int(s); return u ^ ((u >> 31) & 0x7fffffff); }
__device__ __forceinline__ float okey_inv(int k) { return __int_as_float(k ^ ((k >> 31) & 0x7fffffff)); }
__device__ __forceinline__ void sort16_desc(int (&v)[16]) {
#pragma unroll
    for (int k = 2; k <= 16; k <<= 1) {
#pragma unroll
        for (int j = k >> 1; j > 0; j >>= 1) {
#pragma unroll
            for (int i = 0; i < 16; ++i) {
                const int l = i ^ j;
                if (l > i) { const bool desc = (i & k) == 0; const int hi = max(v[i], v[l]), lo = min(v[i], v[l]); v[i] = desc ? hi : lo; v[l] = desc ? lo : hi; }
            }
        }
    }
}
__device__ __forceinline__ void merge16_desc(int (&a)[16], const int (&b)[16]) {
#pragma unroll
    for (int i = 0; i < 16; ++i) a[i] = max(a[i], b[15 - i]);
#pragma unroll
    for (int j = 8; j > 0; j >>= 1) {
#pragma unroll
        for (int i = 0; i < 16; ++i) { const int l = i ^ j; if (l > i) { const int hi = max(a[i], a[l]), lo = min(a[i], a[l]); a[i] = hi; a[l] = lo; } }
    }
}
__device__ __forceinline__ void pair_merge(int (&a)[16]) {
    int b[16];
#pragma unroll
    for (int i = 0; i < 16; ++i) b[i] = __shfl_xor(a[i], 32);
    merge16_desc(a, b);
}
constexpr int CELL_I[64] = {0,0,0,0,0,0,0,0,0,0,0,0,0,0,0,0,1,1,1,1,1,1,1,1,2,2,2,2,2,3,3,3,3,4,4,4,5,5,6,6,7,7,8,9,10,11,12,13,14,15,0,0,0,0,0,0,0,0,0,0,0,0,0,0};
constexpr int CELL_J[64] = {0,1,2,3,4,5,6,7,8,9,10,11,12,13,14,15,0,1,2,3,4,5,6,7,0,1,2,3,4,0,1,2,3,0,1,2,0,1,0,1,0,1,0,0,0,0,0,0,0,0,0,0,0,0,0,0,0,0,0,0,0,0,0,0};
constexpr int NCELL = 50;

__device__ __forceinline__ void phase_topk2(const Params& p, LAS unsigned char* lds, int bid, int nb) {
    const int tid = threadIdx.x, lane = tid & 63, wave = tid >> 6, hh = lane >> 5, l31 = lane & 31;
    LAS int* sit = (LAS int*)(lds + wave * 8448 + lane * 132);
    const int gw = bid * 8 + wave, NGW = nb * 8;
    for (int item = gw; item < (SEQ / 32) * 8; item += NGW) {
        const int h = item & 7, tok0 = (item >> 3) * 32;
        float sv[2][16];
#pragma unroll
        for (int ph = 0; ph < 2; ++ph) {
            const bf16_t* qrow = p.qb + (size_t)(tok0 + l31) * D + h * 256 + ph * 128 + 8 * hh;
            const bf16_t* krow = p.keysb + ((size_t)(h * 2 + ph) * 128 + l31) * 128 + 8 * hh;
            bf16x8 bq[8];
#pragma unroll
            for (int ks = 0; ks < 8; ++ks) bq[ks] = *(const bf16x8*)(qrow + ks * 16);
            int top[16];
#pragma unroll
            for (int kt = 0; kt < 4; ++kt) {
                f32x16 c = {0.f, 0.f, 0.f, 0.f, 0.f, 0.f, 0.f, 0.f, 0.f, 0.f, 0.f, 0.f, 0.f, 0.f, 0.f, 0.f};
#pragma unroll
                for (int ks = 0; ks < 8; ++ks) { const bf16x8 ak = *(const bf16x8*)(krow + (size_t)kt * 32 * 128 + ks * 16);
                    c = __builtin_amdgcn_mfma_f32_32x32x16_bf16(ak, bq[ks], c, 0, 0, 0); }
                int v[16];
#pragma unroll
                for (int r = 0; r < 16; ++r) { const int base = kt * 32 + (r & 3) + 8 * (r >> 2);
                    v[r] = ((okey(c[r]) & ~127) | (127 - base)) ^ (hh << 2); }
                sort16_desc(v);
                if (kt == 0) {
#pragma unroll
                    for (int i = 0; i < 16; ++i) top[i] = v[i];
                } else merge16_desc(top, v);
            }
            pair_merge(top);
#pragma unroll
            for (int i = 0; i < 16; ++i) { sv[ph][i] = okey_inv(top[i] & ~127); sit[ph * 16 + i] = 127 - (top[i] & 127); }
        }
        int w0[16], w1[16];
#pragma unroll
        for (int s = 0; s < 32; ++s) {
            const int e0 = 2 * s, e1 = 2 * s + 1;
            int key;
            if (e0 >= NCELL) key = (int)0x80000000;
            else {
                const float v0 = sv[0][CELL_I[e0]] + sv[1][CELL_J[e0]];
                const int k0 = (okey(v0) & ~255) | (255 - (CELL_I[e0] * 16 + CELL_J[e0]));
                if (e1 >= NCELL) key = hh ? (int)0x80000000 : k0;
                else { const float v1 = sv[0][CELL_I[e1]] + sv[1][CELL_J[e1]];
                    const int k1 = (okey(v1) & ~255) | (255 - (CELL_I[e1] * 16 + CELL_J[e1]));
                    key = hh ? k1 : k0; }
            }
            if (s < 16) w0[s] = key; else w1[s - 16] = key;
        }
        sort16_desc(w0); sort16_desc(w1); merge16_desc(w0, w1); pair_merge(w0);
        const float mx = okey_inv(w0[0] & ~255);
        float sum = 0.f;
#pragma unroll
        for (int k = 0; k < 16; ++k) sum += __expf(okey_inv(w0[k] & ~255) - mx);
        const float inv = 1.0f / sum;
        int eo[8]; float go[8]; const int hmask = -hh;
#pragma unroll
        for (int k = 0; k < 8; ++k) { const int kk = (w0[k] & ~hmask) | (w0[8 + k] & hmask); const int cc = 255 - (kk & 255);
            eo[k] = sit[cc >> 4] * 128 + sit[16 + (cc & 15)]; go[k] = __expf(okey_inv(kk & ~255) - mx) * inv; }
        float so[8];
#pragma unroll
        for (int k = 0; k < 8; ++k) { go[k] *= p.sup[eo[k]]; so[k] = p.sdn[eo[k]]; }
        const size_t ob = (size_t)(tok0 + l31) * 128 + h * 16 + hh * 8;
        *(u32x4*)(p.idx + ob) = (u32x4){(unsigned)eo[0], (unsigned)eo[1], (unsigned)eo[2], (unsigned)eo[3]};
        *(u32x4*)(p.idx + ob + 4) = (u32x4){(unsigned)eo[4], (unsigned)eo[5], (unsigned)eo[6], (unsigned)eo[7]};
        *(f32x4*)(p.gsu + ob) = (f32x4){go[0], go[1], go[2], go[3]};
        *(f32x4*)(p.gsu + ob + 4) = (f32x4){go[4], go[5], go[6], go[7]};
        *(f32x4*)(p.sdv + ob) = (f32x4){so[0], so[1], so[2], so[3]};
        *(f32x4*)(p.sdv + ob + 4) = (f32x4){so[4], so[5], so[6], so[7]};
    }
}


typedef float f32x2 __attribute__((ext_vector_type(2)));
__device__ __forceinline__ float fsel(int mask, float a, float b) { return __int_as_float((__float_as_int(a) & ~mask) | (__float_as_int(b) & mask)); }
__device__ __forceinline__ u32x4 bload16(__amdgpu_buffer_rsrc_t r, int voff, int soff) { return __builtin_bit_cast(u32x4, __builtin_amdgcn_raw_buffer_load_b128(r, voff, soff, 0)); }
__device__ __forceinline__ f32x2 dot16_fp8(const u32x4 w, const f32x2 (&x)[16], int o, f32x2 acc) {
    const unsigned ww[4] = {w.x, w.y, w.z, w.w};
#pragma unroll
    for (int d = 0; d < 4; ++d) { acc += __builtin_amdgcn_cvt_pk_f32_fp8((int)ww[d], false) * x[o + 2 * d]; acc += __builtin_amdgcn_cvt_pk_f32_fp8((int)ww[d], true) * x[o + 2 * d + 1]; }
    return acc;
}
__device__ __forceinline__ void axpy16_fp8(const u32x4 w, float a, f32x2 (&y)[16], int o) {
    const unsigned ww[4] = {w.x, w.y, w.z, w.w}; const f32x2 a2 = {a, a};
#pragma unroll
    for (int d = 0; d < 4; ++d) { y[o + 2 * d] += a2 * __builtin_amdgcn_cvt_pk_f32_fp8((int)ww[d], false); y[o + 2 * d + 1] += a2 * __builtin_amdgcn_cvt_pk_f32_fp8((int)ww[d], true); }
}
#define PEER_LOAD(buf, rs, bb) do { const int _b = (bb) & 15; const int _is = _b < 8 ? i_lo : i_hi; \
    _Pragma("unroll") for (int _j = 0; _j < 8; ++_j) { const int _e = __builtin_amdgcn_readlane(_is, (_b * 8 + _j) & 63) * D; \
        buf[_j][0] = bload16(rs, voff, _e); buf[_j][1] = bload16(rs, voff, _e + 1024); } } while (0)
__device__ __forceinline__ unsigned bload4(__amdgpu_buffer_rsrc_t r, int voff, int soff) { return (unsigned)__builtin_amdgcn_raw_buffer_load_b32(r, voff, soff, 0); }
__device__ __forceinline__ void bstore16(__amdgpu_buffer_rsrc_t r, f32x4 v, int voff, int soff) { __builtin_amdgcn_raw_buffer_store_b128(__builtin_bit_cast(__attribute__((__vector_size__(4 * sizeof(unsigned)))) unsigned, v), r, voff, soff, 0); }

__device__ __forceinline__ void phase_peer2(const Params& p, LAS unsigned char* lds, int bid, int nb) {
    const int tid = threadIdx.x, lane = tid & 63, wave = __builtin_amdgcn_readfirstlane(tid >> 6);
    const int gw = bid * 8 + wave, NGW = nb * 8;
    const int mA = -((lane >> 5) & 1), mB = -((lane >> 4) & 1), mC = -((lane >> 3) & 1);
    const __amdgpu_buffer_rsrc_t rd = __builtin_amdgcn_make_buffer_rsrc((void*)p.down8, 0, 16384 * D, 0x00020000);
    const __amdgpu_buffer_rsrc_t ru = __builtin_amdgcn_make_buffer_rsrc((void*)p.up8, 0, 16384 * D, 0x00020000);
    const __amdgpu_buffer_rsrc_t rh = __builtin_amdgcn_make_buffer_rsrc((void*)p.h2b, 0, SEQ * D * 2, 0x00020000);
    const __amdgpu_buffer_rsrc_t ro = __builtin_amdgcn_make_buffer_rsrc((void*)p.out, 0, SEQ * D * 4, 0x00020000);
    const __amdgpu_buffer_rsrc_t rg1 = __builtin_amdgcn_make_buffer_rsrc((void*)p.ffn_g, 0, D * 4, 0x00020000);
    const __amdgpu_buffer_rsrc_t rg2 = __builtin_amdgcn_make_buffer_rsrc((void*)p.fin_g, 0, D * 4, 0x00020000);
    const __amdgpu_buffer_rsrc_t ri = __builtin_amdgcn_make_buffer_rsrc((void*)p.idx, 0, SEQ * 128 * 4, 0x00020000);
    const __amdgpu_buffer_rsrc_t rgs = __builtin_amdgcn_make_buffer_rsrc((void*)p.gsu, 0, SEQ * 128 * 4, 0x00020000);
    const __amdgpu_buffer_rsrc_t rsd = __builtin_amdgcn_make_buffer_rsrc((void*)p.sdv, 0, SEQ * 128 * 4, 0x00020000);
    const __amdgpu_buffer_rsrc_t rrs = __builtin_amdgcn_make_buffer_rsrc((void*)p.rstd, 0, SEQ * 4, 0x00020000);
    const int voff = lane * 16, voff2 = lane * 32, voff4 = lane * 64, vsub = ((lane >> 3) & 7) * 4, vl4 = lane * 4;
    LAS float* act_s = (LAS float*)(lds + wave * 512);
    for (int t = gw; t < SEQ; t += NGW) {
        const int i_lo = (int)bload4(ri, vl4, t * 512), i_hi = (int)bload4(ri, vl4, t * 512 + 256);
        u32x4 bA[8][2], bB[8][2];
        PEER_LOAD(bA, rd, 0);
        {
            f32x2 xn[16];
            const float rs = __uint_as_float(bload4(rrs, 0, t * 4));
#pragma unroll
            for (int k = 0; k < 2; ++k) {
                const u32x4 h0 = bload16(rh, voff2, t * 4096 + k * 2048), h1 = bload16(rh, voff2, t * 4096 + k * 2048 + 16);
                const unsigned hw[8] = {h0.x, h0.y, h0.z, h0.w, h1.x, h1.y, h1.z, h1.w};
#pragma unroll
                for (int i = 0; i < 4; ++i) { const f32x4 g = __builtin_bit_cast(f32x4, bload16(rg1, voff4, k * 4096 + i * 16));
                    xn[8 * k + 2 * i] = (f32x2){bf_lo(hw[2 * i]) * rs * g[0], bf_hi(hw[2 * i]) * rs * g[1]};
                    xn[8 * k + 2 * i + 1] = (f32x2){bf_lo(hw[2 * i + 1]) * rs * g[2], bf_hi(hw[2 * i + 1]) * rs * g[3]}; }
            }
#define PEER_DOWN(buf, bb) do { const float _g = __uint_as_float(bload4(rgs, vsub, t * 512 + (bb) * 32)), _sd = __uint_as_float(bload4(rsd, vsub, t * 512 + (bb) * 32)); float pr[8]; \
            _Pragma("unroll") for (int j = 0; j < 8; ++j) { const f32x2 z = {0.f, 0.f}; const f32x2 s2 = dot16_fp8(buf[j][0], xn, 0, z) + dot16_fp8(buf[j][1], xn, 8, z); pr[j] = s2.x + s2.y; } \
            float q4[4], q2[2]; \
            _Pragma("unroll") for (int j = 0; j < 4; ++j) q4[j] = fsel(mA, pr[j], pr[j + 4]) + __shfl_xor(fsel(mA, pr[j + 4], pr[j]), 32); \
            _Pragma("unroll") for (int j = 0; j < 2; ++j) q2[j] = fsel(mB, q4[j], q4[j + 2]) + __shfl_xor(fsel(mB, q4[j + 2], q4[j]), 16); \
            float hs = fsel(mC, q2[0], q2[1]) + __shfl_xor(fsel(mC, q2[1], q2[0]), 8); \
            hs += __shfl_xor(hs, 4); hs += __shfl_xor(hs, 2); hs += __shfl_xor(hs, 1); \
            hs *= _sd; \
            const float act = _g * 0.5f * hs * (1.0f + erff(hs * 0.70710678118654752f)); \
            if ((lane & 7) == 0) act_s[(bb) * 8 + (lane >> 3)] = act; } while (0)
#pragma unroll 1
            for (int bi = 0; bi < 16; bi += 2) {
                asm volatile("" ::: "memory");
                PEER_LOAD(bB, rd, bi + 1);
                asm volatile("" ::: "memory");
                PEER_DOWN(bA, bi);
                asm volatile("" ::: "memory");
                if (bi + 2 < 16) PEER_LOAD(bA, rd, bi + 2); else PEER_LOAD(bA, ru, 0);
                asm volatile("" ::: "memory");
                PEER_DOWN(bB, bi + 1);
            }
        }
        asm volatile("s_waitcnt lgkmcnt(0)" ::: "memory");
        f32x2 out[16];
#pragma unroll
        for (int k = 0; k < 2; ++k) {
            const u32x4 h0 = bload16(rh, voff2, t * 4096 + k * 2048), h1 = bload16(rh, voff2, t * 4096 + k * 2048 + 16);
            const unsigned hw[8] = {h0.x, h0.y, h0.z, h0.w, h1.x, h1.y, h1.z, h1.w};
#pragma unroll
            for (int i = 0; i < 8; ++i) out[8 * k + i] = (f32x2){bf_lo(hw[i]), bf_hi(hw[i])};
        }
#define PEER_UP(buf, bb) do { _Pragma("unroll") for (int j = 0; j < 8; ++j) { const float a = act_s[(bb) * 8 + j]; axpy16_fp8(buf[j][0], a, out, 0); axpy16_fp8(buf[j][1], a, out, 8); } } while (0)
#pragma unroll 1
        for (int bi = 0; bi < 16; bi += 2) {
            asm volatile("" ::: "memory");
            PEER_LOAD(bB, ru, bi + 1);
            asm volatile("" ::: "memory");
            PEER_UP(bA, bi);
            asm volatile("" ::: "memory");
            if (bi + 2 < 16) PEER_LOAD(bA, ru, bi + 2);
            asm volatile("" ::: "memory");
            PEER_UP(bB, bi + 1);
        }
        float ss = 0.f;
#pragma unroll
        for (int i = 0; i < 16; ++i) ss += out[i].x * out[i].x + out[i].y * out[i].y;
        const float rf = rsqrtf(wave_sum(ss) * (1.0f / D) + 1e-6f);
#pragma unroll
        for (int k = 0; k < 2; ++k)
#pragma unroll
            for (int i = 0; i < 4; ++i) { const f32x4 g = __builtin_bit_cast(f32x4, bload16(rg2, voff4, k * 4096 + i * 16));
                bstore16(ro, (f32x4){out[8 * k + 2 * i].x * rf * g[0], out[8 * k + 2 * i].y * rf * g[1], out[8 * k + 2 * i + 1].x * rf * g[2], out[8 * k + 2 * i + 1].y * rf * g[3]}, voff4, t * 8192 + k * 4096 + i * 16); }
    }
}

__device__ __forceinline__ void fp8_row(const float* src, unsigned char* dst, float* inv_scale, int lane) {
    f32x4 v[2][4]; float am = 0.f;
#pragma unroll
    for (int k = 0; k < 2; ++k)
#pragma unroll
        for (int i = 0; i < 4; ++i) { v[k][i] = *(const f32x4*)(src + 1024 * k + 16 * lane + 4 * i);
            am = fmaxf(am, fmaxf(fmaxf(fabsf(v[k][i].x), fabsf(v[k][i].y)), fmaxf(fabsf(v[k][i].z), fabsf(v[k][i].w)))); }
#pragma unroll
    for (int o = 1; o < 64; o <<= 1) am = fmaxf(am, __shfl_xor(am, o));
    int be = (__float_as_int(am) >> 23) & 255; be = be < 8 ? 8 : (be > 248 ? 248 : be);
    const float sc = __int_as_float((260 - be) << 23), isc = __int_as_float((be - 6) << 23);
#pragma unroll
    for (int k = 0; k < 2; ++k) { u32x4 w; unsigned ww[4];
#pragma unroll
        for (int i = 0; i < 4; ++i) { int t = 0; t = __builtin_amdgcn_cvt_pk_fp8_f32(v[k][i].x * sc, v[k][i].y * sc, t, false); t = __builtin_amdgcn_cvt_pk_fp8_f32(v[k][i].z * sc, v[k][i].w * sc, t, true); ww[i] = (unsigned)t; }
        w.x = ww[0]; w.y = ww[1]; w.z = ww[2]; w.w = ww[3];
        *(u32x4*)(dst + 1024 * k + 16 * lane) = w; }
    if (lane == 0) *inv_scale = isc;
}

__device__ __forceinline__ void tr_item(const float* W, int ldw, int srccol0, int k0, bf16_t* WT, int ldt, int n0, const float* kscale, const float* nscale, LAS float* scr, int lane) {
#pragma unroll 8
    for (int i = 0; i < 32; ++i) { const int kk = 2 * i + (lane >> 5); float v = W[(size_t)(k0 + kk) * ldw + srccol0 + (lane & 31)];
        if (kscale) v *= kscale[k0 + kk]; if (nscale) v *= nscale[srccol0 + (lane & 31)]; scr[kk * 33 + (lane & 31)] = v; }
    asm volatile("s_waitcnt lgkmcnt(0)" ::: "memory");
    const int c = lane & 7;
#pragma unroll
    for (int j = 0; j < 4; ++j) { const int n = (lane >> 3) + 8 * j; const LAS float* s = scr + (8 * c) * 33 + n;
        u32x4 o; o.x = cvt_pk_bf16(s[0 * 33], s[1 * 33]); o.y = cvt_pk_bf16(s[2 * 33], s[3 * 33]); o.z = cvt_pk_bf16(s[4 * 33], s[5 * 33]); o.w = cvt_pk_bf16(s[6 * 33], s[7 * 33]);
        *(u32x4*)(WT + (size_t)(n0 + n) * ldt + k0 + 8 * c) = o; }
    asm volatile("s_waitcnt lgkmcnt(0)" ::: "memory");
}
__device__ __forceinline__ int win_srccol(int n) { const int pn = n >> 8, w = n & 255; return pn < 4 ? n : ((w >> 7) ? 2048 : 1024) + (pn - 4) * 128 + (w & 127); }

__device__ __forceinline__ void phase_prep(const Params& p, LAS unsigned char* lds, int bid, int nb) {
    const int tid = threadIdx.x, lane = tid & 63, wave = tid >> 6;
    const int gw = bid * 8 + wave, NGW = nb * 8;
    LAS float* scr = (LAS float*)(lds + wave * 8448);
    for (int r = gw; r < RT; r += NGW) {
        unsigned long long* o8 = (unsigned long long*)(p.hnb + (size_t)r * D) + lane;
        if (r < RPAD) {
#pragma unroll
            for (int j = 0; j < 8; ++j) o8[64 * j] = 0ull;
        } else {
            const f32x4* xr = (const f32x4*)hrow(p, r - RPAD) + lane;
            const f32x4* gr = (const f32x4*)p.mix_g + lane;
            f32x4 v[8]; float s = 0.f;
#pragma unroll
            for (int j = 0; j < 8; ++j) { v[j] = xr[64 * j]; s += (v[j].x * v[j].x + v[j].y * v[j].y) + (v[j].z * v[j].z + v[j].w * v[j].w); }
            const float rs = rsqrtf(wave_sum(s) * (1.0f / D) + 1e-6f);
#pragma unroll
            for (int j = 0; j < 8; ++j) { const f32x4 gv = gr[64 * j];
                o8[64 * j] = (unsigned long long)cvt_pk_bf16(v[j].x * rs * gv.x, v[j].y * rs * gv.y) | ((unsigned long long)cvt_pk_bf16(v[j].z * rs * gv.z, v[j].w * rs * gv.w) << 32); }
        }
    }
    for (int it = gw; it < (D / 64) * (INW / 32); it += NGW) {
        const int kb = it / (INW / 32), nbk = it % (INW / 32);
        tr_item(p.w_in, INW, win_srccol(nbk * 32), kb * 64, p.w_in_t, D, nbk * 32, nullptr, nullptr, scr, lane);
    }
    for (int it = gw; it < 4 * 4 * 8; it += NGW) { const int g = it >> 5, kb = (it >> 3) & 3, nbk = it & 7;
        tr_item(p.pool_w + (size_t)g * 65536, 256, nbk * 32, kb * 64, p.pool_wt + (size_t)g * 65536, 256, nbk * 32, nullptr, p.pool_scale + g * 256, scr, lane); }
    for (int it = gw; it < 16 * 32; it += NGW) { const int kb = it >> 5, nbk = it & 31;
        tr_item(p.pw_w, CWD, nbk * 32, kb * 64, p.pw_t, CWD, nbk * 32, nullptr, nullptr, scr, lane); }
    for (int it = gw; it < 32 * 64; it += NGW) { const int kb = it >> 6, nbk = it & 63;
        tr_item(p.w_out, D, nbk * 32, kb * 64, p.w_out_t, D, nbk * 32, nullptr, nullptr, scr, lane); }
    for (int it = gw; it < 32 * 64; it += NGW) { const int kb = it >> 6, nbk = it & 63;
        tr_item(p.wq, D, nbk * 32, kb * 64, p.wq_t, D, nbk * 32, p.ffn_g, nullptr, scr, lane); }
    for (int i = gw * 64 + lane; i < 8 * 2 * 128 * 128 / 4; i += NGW * 64) { const f32x4 v = ((const f32x4*)p.keys)[i];
        u32x2 w; w.x = cvt_pk_bf16(v[0], v[1]); w.y = cvt_pk_bf16(v[2], v[3]); ((u32x2*)p.keysb)[i] = w; }
    for (int e = gw; e < 2 * 16384; e += NGW) {
        if (e < 16384) fp8_row(p.down + (size_t)e * D, p.down8 + (size_t)e * D, p.sdn + e, lane);
        else fp8_row(p.up + (size_t)(e - 16384) * D, p.up8 + (size_t)(e - 16384) * D, p.sup + (e - 16384), lane);
    }
}


#define XB_TMO      128
#define XB_XCNT(j)  (256  + 64 * (j))
#define XB_XSUB(j)  (1280 + 64 * (j))
#define XB_XGEN(j)  (2304 + 64 * (j))
#define XB_TOP      3328
#define XB_TOPGEN   3392
#define XCD_BAR_WORDS 3456
#define XB_SPIN_CAP (1u << 18)
__device__ __forceinline__ unsigned xb_ld(unsigned* p)              { return __hip_atomic_load(p, __ATOMIC_RELAXED, __HIP_MEMORY_SCOPE_AGENT); }
__device__ __forceinline__ unsigned xb_add(unsigned* p, unsigned v) { return __hip_atomic_fetch_add(p, v, __ATOMIC_RELAXED, __HIP_MEMORY_SCOPE_AGENT); }
__device__ __forceinline__ unsigned xb_xcc_id() { return (unsigned)__builtin_amdgcn_s_getreg((3 << 11) | 20) & 0xFu; }
#define XB_SPIN(cond, bar) do { unsigned _sp = 0; while (cond) { __builtin_amdgcn_s_sleep(1); \
    if ((++_sp & 255u) == 0u) { if (xb_ld(&(bar)[XB_TMO])) break; if (_sp > XB_SPIN_CAP) { atomicAdd(&(bar)[XB_TMO], 1u); break; } } } } while (0)
struct XcdBarrier { unsigned* bar; unsigned x; volatile LAS unsigned* st; };
__device__ __forceinline__ XcdBarrier xcd_barrier_post(unsigned* bar, volatile LAS unsigned* st) {
    XcdBarrier b; b.bar = bar; b.x = xb_xcc_id(); b.st = st;
    if (threadIdx.x == 0) (void)xb_add(&bar[XB_XCNT(b.x)], 1u);
    return b;
}
__device__ __forceinline__ void xcd_barrier_complete(unsigned* bar, unsigned x, unsigned& nloc, unsigned& nx) {
    const unsigned G = gridDim.x * gridDim.y * gridDim.z;
    unsigned sum, cnt, mine, sp = 0u;
    for (;;) {
        sum = 0u; cnt = 0u; mine = 0u;
#pragma unroll
        for (unsigned j = 0; j < 16; ++j) { const unsigned c = xb_ld(&bar[XB_XCNT(j)]); sum += c; cnt += (c > 0u) ? 1u : 0u; mine = (j == x) ? c : mine; }
        if (sum == G) break;
        __builtin_amdgcn_s_sleep(1);
        if ((++sp & 255u) == 0u) { if (xb_ld(&bar[XB_TMO])) break; if (sp > XB_SPIN_CAP) { atomicAdd(&bar[XB_TMO], 1u); break; } }
    }
    nloc = mine > 0u ? mine : 1u; nx = cnt > 0u ? cnt : 1u;
}
__device__ __forceinline__ void xcd_barrier(const XcdBarrier& b) {
    asm volatile("s_waitcnt vmcnt(0)" ::: "memory");
    __syncthreads();
    if (threadIdx.x == 0) {
        unsigned* bar = b.bar;
        __builtin_amdgcn_s_waitcnt(0);
        unsigned nloc = b.st[0], nx = b.st[1];
        if (nloc == 0u) { xcd_barrier_complete(bar, b.x, nloc, nx); b.st[0] = nloc; b.st[1] = nx; }
        const unsigned old = xb_add(&bar[XB_XSUB(b.x)], 1u);
        const unsigned gen = old / nloc;
        if (old + 1u == (gen + 1u) * nloc) {
            __builtin_amdgcn_fence(__ATOMIC_RELEASE, "agent");
            asm volatile("s_waitcnt vmcnt(0)" ::: "memory");
            const unsigned og = xb_add(&bar[XB_TOP], 1u);
            const unsigned tg = og / nx;
            if (og + 1u == (tg + 1u) * nx) xb_add(&bar[XB_TOPGEN], 1u);
            else XB_SPIN(xb_ld(&bar[XB_TOPGEN]) == tg, bar);
            __builtin_amdgcn_fence(__ATOMIC_ACQUIRE, "agent");
            xb_add(&bar[XB_XGEN(b.x)], 1u);
            asm volatile("s_waitcnt vmcnt(0)" ::: "memory");
        } else {
            XB_SPIN(xb_ld(&bar[XB_XGEN(b.x)]) == gen, bar);
            __builtin_amdgcn_fence(__ATOMIC_ACQUIRE, "agent");
            asm volatile("s_waitcnt vmcnt(0)" ::: "memory");
        }
    }
    __syncthreads();
}

__global__ void __launch_bounds__(NT, 2) k_mega(Params p) {
    extern __shared__ __attribute__((aligned(16))) unsigned char lds_raw[];
    LAS unsigned char* lds = (LAS unsigned char*)lds_raw;
    cg::grid_group grid = cg::this_grid();
    const int bid = blockIdx.x, nb = gridDim.x;
    volatile LAS unsigned* bst = (volatile LAS unsigned*)(lds + 131072);
    if (threadIdx.x < 4) bst[threadIdx.x] = 0u;
    __syncthreads();
    const XcdBarrier xb = xcd_barrier_post(p.bar, bst);
    phase_prep(p, lds, bid, nb);
    grid.sync();
    { pg8::Gemm g{p.hnb, p.w_in_t, D, D, D, 0}; pg8::StaticOrder S; S.init(RT / 256, INW / 256, nb, bid); EpiProj E{p.xp, p.glu};
      pg8::gemm_phase<EpiProj, pg8::StaticOrder>(lds, g, S, E); }
    xcd_barrier(xb);
    phase_mix(p, lds, bid, nb);
    xcd_barrier(xb);
    if (bid < nb / 2) { pg8::Gemm g{p.pooledb, p.pool_wt, PWD, 256, 256, 256}; pg8::StaticOrder S; S.init(SEQ / 256, 4, nb / 2, bid); EpiBf16Out E{p.yabb, D, 0, nullptr};
      pg8::gemm_phase<EpiBf16Out, pg8::StaticOrder>(lds, g, S, E); }
    else { pg8::Gemm g{p.cvnb, p.pw_t, CWD, CWD, CWD, 0}; pg8::StaticOrder S; S.init(SEQ / 256, 4, nb - nb / 2, bid - nb / 2); EpiBf16Out E{p.yabb, D, PWD, p.pw_b};
      pg8::gemm_phase<EpiBf16Out, pg8::StaticOrder>(lds, g, S, E); }
    xcd_barrier(xb);
    { pg8::Gemm g{p.yabb, p.w_out_t, D, D, D, 0}; pg8::StaticOrder S; S.init(SEQ / 256, D / 256, nb, bid); EpiResid E{p.x, p.h2b, p.ssq};
      pg8::gemm_phase<EpiResid, pg8::StaticOrder>(lds, g, S, E); }
    xcd_barrier(xb);
    { pg8::Gemm g{p.h2b, p.wq_t, D, D, D, 0}; pg8::StaticOrder S; S.init(SEQ / 256, D / 256, nb, bid); EpiQ E{p.ssq, p.rstd, p.qb};
      pg8::gemm_phase<EpiQ, pg8::StaticOrder>(lds, g, S, E); }
    xcd_barrier(xb);
    phase_topk2(p, lds, bid, nb);
    xcd_barrier(xb);
    phase_peer2(p, lds, bid, nb);
}

extern "C" void kernel_launch(void* const* d_in, const int* in_sizes, int n_in, void* d_out, int out_size, void* d_ws, size_t ws_size, hipStream_t stream) {
    Params p{};
    p.x = (const float*)d_in[0]; p.meta = (const float*)d_in[1]; p.mix_g = (const float*)d_in[2]; p.w_in = (const float*)d_in[3];
    p.pool_w = (const float*)d_in[4]; p.pool_scale = (const float*)d_in[5]; p.dw_w = (const float*)d_in[6]; p.dw_b = (const float*)d_in[7];
    p.ln_g = (const float*)d_in[8]; p.ln_b = (const float*)d_in[9]; p.pw_w = (const float*)d_in[10]; p.pw_b = (const float*)d_in[11];
    p.w_out = (const float*)d_in[12]; p.ffn_g = (const float*)d_in[13]; p.wq = (const float*)d_in[14]; p.keys = (const float*)d_in[15];
    p.down = (const float*)d_in[16]; p.up = (const float*)d_in[17]; p.fin_g = (const float*)d_in[18];
    p.out = (float*)d_out;
    char* w = (char*)d_ws; size_t off = 0;
    auto take = [&](size_t bytes) { char* r = w + off; off += (bytes + 255) & ~(size_t)255; return r; };
    p.idx = (int*)take((size_t)SEQ * 128 * 4);
    p.gsu = (float*)take((size_t)SEQ * 128 * 4);
    p.sdv = (float*)take((size_t)SEQ * 128 * 4);
    p.hnb = (bf16_t*)take((size_t)RT * D * 2);
    p.w_in_t = (bf16_t*)take((size_t)INW * D * 2);
    p.xp = (bf16_t*)take((size_t)RT * PWD * 2);
    p.glu = (bf16_t*)take((size_t)RT * CWD * 2);
    p.pooledb = (bf16_t*)take((size_t)SEQ * PWD * 2);
    p.cvnb = (bf16_t*)take((size_t)SEQ * CWD * 2);
    p.yabb = (bf16_t*)take((size_t)SEQ * D * 2);
    p.h2b = (bf16_t*)take((size_t)SEQ * D * 2);
    p.pool_wt = (bf16_t*)take((size_t)4 * 256 * 256 * 2);
    p.pw_t = (bf16_t*)take((size_t)CWD * CWD * 2);
    p.w_out_t = (bf16_t*)take((size_t)D * D * 2);
    p.ssq = (float*)take((size_t)SEQ * 32 * 4);
    p.bar = (unsigned*)take((size_t)XCD_BAR_WORDS * 4);
    p.rstd = (float*)take((size_t)SEQ * 4);
    p.wq_t = (bf16_t*)take((size_t)D * D * 2);
    p.keysb = (bf16_t*)take((size_t)8 * 2 * 128 * 128 * 2);
    p.qb = (bf16_t*)take((size_t)SEQ * D * 2);
    p.down8 = (unsigned char*)take((size_t)16384 * D);
    p.up8 = (unsigned char*)take((size_t)16384 * D);
    p.sdn = (float*)take((size_t)16384 * 4);
    p.sup = (float*)take((size_t)16384 * 4);
    static int grid_blocks = 0;
    if (!grid_blocks) {
        int dev = 0, cus = 0, per_cu = 0;
        (void)hipGetDevice(&dev);
        (void)hipDeviceGetAttribute(&cus, hipDeviceAttributeMultiprocessorCount, dev);
        (void)hipFuncSetAttribute((const void*)k_mega, hipFuncAttributeMaxDynamicSharedMemorySize, LDS_BYTES);
        (void)hipOccupancyMaxActiveBlocksPerMultiprocessor(&per_cu, k_mega, NT, LDS_BYTES);
        if (per_cu < 1) fprintf(stderr, "occupancy query says %d blocks per CU\n", per_cu);
        grid_blocks = cus;
    }
    (void)hipMemsetAsync(p.bar, 0, (size_t)XCD_BAR_WORDS * 4, stream);
    void* args[] = {&p};
    hipError_t e = hipLaunchCooperativeKernel((void*)k_mega, dim3(grid_blocks), dim3(NT), args, LDS_BYTES, stream);
    if (e != hipSuccess) fprintf(stderr, "cooperative launch failed: %s (grid %d)\n", hipGetErrorString(e), grid_blocks);
}
```

```cpp
#include <hip/hip_runtime.h>
#include <hip/hip_cooperative_groups.h>
#include <stdint.h>
#include <cstdio>
namespace cg = cooperative_groups;

#define NT 512
#define LAS __attribute__((address_space(3)))
typedef unsigned short bf16_t;
typedef short bf16x8 __attribute__((ext_vector_type(8)));
typedef float f32x4 __attribute__((ext_vector_type(4)));
typedef unsigned u32x4 __attribute__((ext_vector_type(4)));
typedef unsigned u32x2 __attribute__((ext_vector_type(2)));

constexpr int D = 2048, SEQ = 8192, NMETA = 16, T = SEQ + NMETA;
constexpr int PWD = 1024, CWD = 1024, INW = 3072;
constexpr int KS = 31;
constexpr int RPAD = 240, RT = 8448;
constexpr int LDS_BYTES = 147456;

struct Params {
    const float *x, *meta, *mix_g, *w_in, *pool_w, *pool_scale, *dw_w, *dw_b, *ln_g, *ln_b, *pw_w, *pw_b, *w_out, *ffn_g, *wq, *keys, *down, *up, *fin_g;
    float* out;
    int* idx;
    unsigned* bar;
    bf16_t *hnb, *w_in_t, *xp, *glu, *pooledb, *cvnb, *yabb, *h2b, *pool_wt, *pw_t, *w_out_t, *wq_t, *keysb, *qb;
    unsigned char *down8, *up8;
    float *sdn, *sup;
    float *gsu, *sdv;
    bf16_t* part;
    float *act, *ssq2;
    float *ssq, *rstd;
};

__device__ __forceinline__ unsigned cvt_pk_bf16(float lo, float hi) { unsigned r; asm volatile("v_cvt_pk_bf16_f32 %0, %1, %2" : "=v"(r) : "v"(lo), "v"(hi)); return r; }
__device__ __forceinline__ float wave_sum(float v) {
#pragma unroll
    for (int o = 1; o < 64; o <<= 1) v += __shfl_xor(v, o);
    return v;
}

__device__ __forceinline__ const float* hrow(const Params& p, int t) { return t < NMETA ? p.meta + (size_t)t * D : p.x + (size_t)(t - NMETA) * D; }

__device__ __forceinline__ float block_sum(float v, float* red) {
#pragma unroll
    for (int o = 32; o; o >>= 1) v += __shfl_xor(v, o);
    __syncthreads();
    if ((threadIdx.x & 63) == 0) red[threadIdx.x >> 6] = v;
    __syncthreads();
    float s = 0.f;
#pragma unroll
    for (int i = 0; i < NT / 64; ++i) s += red[i];
    return s;
}

namespace pg8 {
constexpr int BM = 256, BK = 64, HALF = 128, HTB = HALF * BK * 2, STAGE_BYTES = 8 * HTB, NXCD = 8, WGM = 8;
__device__ __forceinline__ int lds_byte(int r, int c) { const int st = (r >> 4) * 2 + (c >> 5), rr = r & 15, cc = c & 31, ob = rr * 64 + cc * 2; return st * 1024 + (ob ^ (((ob >> 9) & 1) << 5)); }
__device__ __forceinline__ void stage_rc(int b, int& R, int& C) { const int st = b / 1024, sb = b % 1024, swz = sb ^ (((sb >> 9) & 1) << 5); R = (st >> 1) * 16 + swz / 64; C = (st & 1) * 32 + (swz % 64) / 2; }
struct Unit { int pm, pn; };
struct Gemm { const bf16_t* A; const bf16_t* Bt; int lda, ldb, K; int a_col_per_pn; };
struct StaticOrder {
    int nM, nN, nwg, G, c;
    __device__ void init(int nM_, int nN_, int G_, int c_) { nM = nM_; nN = nN_; nwg = nM * nN; G = G_; c = c_; }
    __device__ bool next(int i, Unit& u) const {
        const long L = (long)i * G + c; if (L >= nwg) return false;
        int wgid = (int)L; { const int q = nwg / NXCD, r = nwg % NXCD, xcd = wgid % NXCD, off = wgid / NXCD; wgid = (xcd < r ? xcd * (q + 1) : r * (q + 1) + (xcd - r) * q) + off; }
        const int nig = WGM * nN, gid = wgid / nig, fm = gid * WGM, gsz = (nM - fm) < WGM ? (nM - fm) : WGM;
        u.pm = fm + ((wgid % nig) % gsz); u.pn = (wgid % nig) / gsz; return true;
    }
};
template <class Epi, class Sched>
__device__ __forceinline__ void gemm_phase(LAS unsigned char* lds, const Gemm g, const Sched& S, const Epi& E) {
    const int tid = threadIdx.x, wid = __builtin_amdgcn_readfirstlane(tid >> 6), lane = tid & 63, wr = wid >> 2, wc = wid & 3, fr = lane & 15, fq = lane >> 4;
    const int K = g.K, nt = K / BK;
    unsigned voffA[2], voffB[2];
#pragma unroll
    for (int i = 0; i < 2; ++i) { int R, C; stage_rc(tid * 16 + i * 8192, R, C);
        voffA[i] = (unsigned)(R * g.lda + C) * 2u; voffB[i] = (unsigned)(R * g.ldb + C) * 2u; }
    const size_t kstep = (size_t)(BK * 2);
    const size_t hstepA = (size_t)HALF * g.lda * 2, hstepB = (size_t)HALF * g.ldb * 2;
    const size_t tstepA = 2 * hstepA, tstepB = 2 * hstepB;
    const unsigned ldsw = (unsigned)wid * 1024u;
    const int aoff = lds_byte(wr * 64 + fr, fq * 8), boff = lds_byte(wc * 32 + fr, fq * 8);
#define PG8_SA(b, h) (((b) * 2 + (h)) * HTB)
#define PG8_SB(b, h) ((4 + (b) * 2 + (h)) * HTB)
#define PG8_STAGE(bufoff, gbase, voff) do { _Pragma("unroll") for (int _i = 0; _i < 2; ++_i) \
        __builtin_amdgcn_global_load_lds((const unsigned*)((const char*)(gbase) + (voff)[_i]), (LAS unsigned*)(lds + (bufoff) + ldsw + _i * 8192), 16, 0, 0); } while (0)
#define PG8_LDA(dst, b, h) do { _Pragma("unroll") for (int m = 0; m < 4; ++m) _Pragma("unroll") for (int k = 0; k < 2; ++k) dst[m][k] = *(const LAS bf16x8*)(lds + PG8_SA(b, h) + aoff + m * 2048 + k * 1024); } while (0)
#define PG8_LDB(dst, b, h) do { _Pragma("unroll") for (int n = 0; n < 2; ++n) _Pragma("unroll") for (int k = 0; k < 2; ++k) dst[n][k] = *(const LAS bf16x8*)(lds + PG8_SB(b, h) + boff + n * 2048 + k * 1024); } while (0)
#define PG8_MMA(ai, bj, At, Bt) do { __builtin_amdgcn_s_setprio(1); _Pragma("unroll") for (int m = 0; m < 4; ++m) _Pragma("unroll") for (int n = 0; n < 2; ++n) _Pragma("unroll") for (int k = 0; k < 2; ++k) \
        acc[ai][bj][m][n] = __builtin_amdgcn_mfma_f32_16x16x32_bf16(Bt[n][k], At[m][k], acc[ai][bj][m][n], 0, 0, 0); __builtin_amdgcn_s_setprio(0); } while (0)
#define PG8_WAIT_V(n) asm volatile("s_waitcnt vmcnt(" #n ")" ::: "memory")
#define PG8_WAIT_L(n) asm volatile("s_waitcnt lgkmcnt(" #n ")" ::: "memory")
#define PG8_BAR __builtin_amdgcn_s_barrier()
#define PG8_SCHED __builtin_amdgcn_sched_barrier(0)
    Unit cur, nxt; int ui = 0;
    if (!S.next(0, cur)) return;
    f32x4 acc[2][2][4][2];
#pragma unroll
    for (int a = 0; a < 2; ++a)
#pragma unroll
        for (int b = 0; b < 2; ++b)
#pragma unroll
            for (int m = 0; m < 4; ++m)
#pragma unroll
                for (int n = 0; n < 2; ++n) acc[a][b][m][n] = (f32x4){0.f, 0.f, 0.f, 0.f};
    bf16x8 At[4][2], B0[2][2], B1[2][2];
    const char* cA = (const char*)g.A + (size_t)cur.pm * tstepA + (size_t)cur.pn * g.a_col_per_pn * 2; const char* cB = (const char*)g.Bt + (size_t)cur.pn * tstepB;
    PG8_STAGE(PG8_SB(0, 0), cB, voffB); PG8_STAGE(PG8_SA(0, 0), cA, voffA); PG8_STAGE(PG8_SB(0, 1), cB + hstepB, voffB); PG8_STAGE(PG8_SA(0, 1), cA + hstepA, voffA);
    if (wr == 1) PG8_BAR;
    PG8_WAIT_V(4); PG8_BAR;
    PG8_STAGE(PG8_SB(1, 0), cB + kstep, voffB); PG8_STAGE(PG8_SA(1, 0), cA + kstep, voffA); PG8_STAGE(PG8_SB(1, 1), cB + hstepB + kstep, voffB);
    PG8_WAIT_V(6); PG8_BAR;
    for (;;) {
        const bool has_next = S.next(ui + 1, nxt);
        const char* nA = has_next ? (const char*)g.A + (size_t)nxt.pm * tstepA + (size_t)nxt.pn * g.a_col_per_pn * 2 : cA; const char* nB = has_next ? (const char*)g.Bt + (size_t)nxt.pn * tstepB : cB;
        for (int t = 0; t < nt; t += 2) {
            const bool last = (t == nt - 2);
            const char* a1 = cA + (size_t)(t + 1) * kstep;
            const char* a2 = last ? nA : cA + (size_t)(t + 2) * kstep; const char* b2 = last ? nB : cB + (size_t)(t + 2) * kstep;
            const char* a3 = a2 + kstep; const char* b3 = b2 + kstep;
            PG8_LDB(B0, 0, 0); PG8_SCHED; PG8_LDA(At, 0, 0); PG8_STAGE(PG8_SA(1, 1), a1 + hstepA, voffA);
            PG8_WAIT_L(8); PG8_BAR; PG8_WAIT_L(0); PG8_MMA(0, 0, At, B0); PG8_BAR; PG8_SCHED;
            PG8_LDB(B1, 0, 1); PG8_STAGE(PG8_SB(0, 0), b2, voffB);
            PG8_BAR; PG8_WAIT_L(0); PG8_MMA(0, 1, At, B1); PG8_BAR;
            PG8_LDA(At, 0, 1); PG8_STAGE(PG8_SA(0, 0), a2, voffA);
            PG8_BAR; PG8_WAIT_L(0); PG8_MMA(1, 0, At, B0); PG8_BAR; PG8_SCHED;
            PG8_STAGE(PG8_SB(0, 1), b2 + hstepB, voffB);
            PG8_WAIT_V(6); PG8_BAR; PG8_MMA(1, 1, At, B1); PG8_BAR;
            PG8_LDB(B0, 1, 0); PG8_SCHED; PG8_LDA(At, 1, 0); PG8_STAGE(PG8_SA(0, 1), a2 + hstepA, voffA);
            PG8_WAIT_L(8); PG8_BAR; PG8_WAIT_L(0); PG8_MMA(0, 0, At, B0); PG8_BAR; PG8_SCHED;
            PG8_LDB(B1, 1, 1); PG8_STAGE(PG8_SB(1, 0), b3, voffB);
            PG8_BAR; PG8_WAIT_L(0); PG8_MMA(0, 1, At, B1); PG8_BAR;
            PG8_LDA(At, 1, 1); PG8_STAGE(PG8_SA(1, 0), a3, voffA);
            PG8_BAR; PG8_WAIT_L(0); PG8_MMA(1, 0, At, B0); PG8_BAR; PG8_SCHED;
            PG8_STAGE(PG8_SB(1, 1), b3 + hstepB, voffB);
            PG8_WAIT_V(6); PG8_BAR; PG8_MMA(1, 1, At, B1); PG8_BAR;
        }
        E(acc, cur, wr, wc, fr, fq);
        if (!has_next) break;
#pragma unroll
        for (int a = 0; a < 2; ++a)
#pragma unroll
            for (int b = 0; b < 2; ++b)
#pragma unroll
                for (int m = 0; m < 4; ++m)
#pragma unroll
                    for (int n = 0; n < 2; ++n) acc[a][b][m][n] = (f32x4){0.f, 0.f, 0.f, 0.f};
        cur = nxt; cA = nA; cB = nB; ++ui;
    }
    PG8_WAIT_V(0);
    if (wr == 0) PG8_BAR;
    PG8_BAR;
#undef PG8_SA
#undef PG8_SB
#undef PG8_STAGE
#undef PG8_LDA
#undef PG8_LDB
#undef PG8_MMA
#undef PG8_WAIT_V
#undef PG8_WAIT_L
#undef PG8_BAR
#undef PG8_SCHED
}
}

struct EpiProjF32 {
    float* proj;
    __device__ __forceinline__ void operator()(const f32x4 (&acc)[2][2][4][2], const pg8::Unit& u, int wr, int wc, int fr, int fq) const {
#pragma unroll
        for (int ai = 0; ai < 2; ++ai)
#pragma unroll
            for (int m = 0; m < 4; ++m) {
                const int t = u.pm * 256 + ai * 128 + wr * 64 + m * 16 + fr - RPAD;
                if (t >= 0) {
#pragma unroll
                    for (int bj = 0; bj < 2; ++bj)
#pragma unroll
                        for (int n = 0; n < 2; ++n) {
                            const int off = wc * 32 + n * 16 + fq * 4;
                            const int col = u.pn < 4 ? u.pn * 256 + bj * 128 + off : (bj ? 2048 : 1024) + (u.pn - 4) * 128 + off;
                            *(f32x4*)(proj + (size_t)t * INW + col) = acc[ai][bj][m][n];
                        }
                }
            }
    }
};


__device__ __forceinline__ float sigmoidf_fast(float x) { return __builtin_amdgcn_rcpf(1.0f + __expf(-x)); }

struct EpiProj {
    bf16_t* xp; bf16_t* glu;
    __device__ __forceinline__ void operator()(const f32x4 (&acc)[2][2][4][2], const pg8::Unit& u, int wr, int wc, int fr, int fq) const {
#pragma unroll
        for (int ai = 0; ai < 2; ++ai)
#pragma unroll
            for (int m = 0; m < 4; ++m) {
                const size_t row = (size_t)(u.pm * 256 + ai * 128 + wr * 64 + m * 16 + fr);
                if (u.pn < 4) {
#pragma unroll
                    for (int bj = 0; bj < 2; ++bj)
#pragma unroll
                        for (int n = 0; n < 2; ++n) { const f32x4 v = acc[ai][bj][m][n]; u32x2 w; w.x = cvt_pk_bf16(v[0], v[1]); w.y = cvt_pk_bf16(v[2], v[3]);
                            *(u32x2*)(xp + row * PWD + u.pn * 256 + bj * 128 + wc * 32 + n * 16 + fq * 4) = w; }
                } else {
#pragma unroll
                    for (int n = 0; n < 2; ++n) { const f32x4 a = acc[ai][0][m][n], g = acc[ai][1][m][n]; u32x2 w;
                        w.x = cvt_pk_bf16(a[0] * sigmoidf_fast(g[0]), a[1] * sigmoidf_fast(g[1])); w.y = cvt_pk_bf16(a[2] * sigmoidf_fast(g[2]), a[3] * sigmoidf_fast(g[3]));
                        *(u32x2*)(glu + row * CWD + (u.pn - 4) * 128 + wc * 32 + n * 16 + fq * 4) = w; }
                }
            }
    }
};
struct EpiBf16Out {
    bf16_t* O; int ldc; int col0; const float* bias;
    __device__ __forceinline__ void operator()(const f32x4 (&acc)[2][2][4][2], const pg8::Unit& u, int wr, int wc, int fr, int fq) const {
#pragma unroll
        for (int ai = 0; ai < 2; ++ai)
#pragma unroll
            for (int m = 0; m < 4; ++m) {
                const size_t row = (size_t)(u.pm * 256 + ai * 128 + wr * 64 + m * 16 + fr);
#pragma unroll
                for (int bj = 0; bj < 2; ++bj)
#pragma unroll
                    for (int n = 0; n < 2; ++n) { const int c = u.pn * 256 + bj * 128 + wc * 32 + n * 16 + fq * 4; f32x4 v = acc[ai][bj][m][n];
                        if (bias) v += *(const f32x4*)(bias + c);
                        u32x2 w; w.x = cvt_pk_bf16(v[0], v[1]); w.y = cvt_pk_bf16(v[2], v[3]);
                        *(u32x2*)(O + row * ldc + col0 + c) = w; }
            }
    }
};
struct EpiResid {
    const float* x; bf16_t* h2b; float* ssq;
    __device__ __forceinline__ void operator()(const f32x4 (&acc)[2][2][4][2], const pg8::Unit& u, int wr, int wc, int fr, int fq) const {
#pragma unroll
        for (int ai = 0; ai < 2; ++ai)
#pragma unroll
            for (int m = 0; m < 4; ++m) {
                const size_t row = (size_t)(u.pm * 256 + ai * 128 + wr * 64 + m * 16 + fr);
                float ss = 0.f;
#pragma unroll
                for (int bj = 0; bj < 2; ++bj)
#pragma unroll
                    for (int n = 0; n < 2; ++n) { const int c = u.pn * 256 + bj * 128 + wc * 32 + n * 16 + fq * 4;
                        const f32x4 v = acc[ai][bj][m][n] + *(const f32x4*)(x + row * D + c);
                        u32x2 w; w.x = cvt_pk_bf16(v[0], v[1]); w.y = cvt_pk_bf16(v[2], v[3]);
                        *(u32x2*)(h2b + row * D + c) = w;
                        ss += (v[0] * v[0] + v[1] * v[1]) + (v[2] * v[2] + v[3] * v[3]); }
                ss += __shfl_xor(ss, 16); ss += __shfl_xor(ss, 32);
                if (fq == 0) ssq[row * 32 + u.pn * 4 + wc] = ss;
            }
    }
};

__device__ __forceinline__ float bf_lo(unsigned w) { return __uint_as_float(w << 16); }
__device__ __forceinline__ float bf_hi(unsigned w) { return __uint_as_float(w & 0xffff0000u); }

__device__ __forceinline__ void phase_mix(const Params& p, LAS unsigned char* lds, int bid, int nb) {
    const int tid = threadIdx.x, lane = tid & 63, wave = tid >> 6;
    LAS unsigned* gl = (LAS unsigned*)lds;
    LAS float* red = (LAS float*)(lds + 62 * 2048);
    float w0[KS], w1[KS];
#pragma unroll
    for (int k = 0; k < KS; ++k) { const float2 wv = *(const float2*)(p.dw_w + k * CWD + 2 * tid); w0[k] = wv.x; w1[k] = wv.y; }
    const float2 bv = *(const float2*)(p.dw_b + 2 * tid), lg = *(const float2*)(p.ln_g + 2 * tid), lb = *(const float2*)(p.ln_b + 2 * tid);
    for (int tile = bid; tile < SEQ / 32; tile += nb) {
        const int r0 = 256 + tile * 32;
        __syncthreads();
        for (int ch = tid; ch < 62 * 128; ch += NT) { const int rr = ch >> 7, cc = ch & 127;
            *(LAS u32x4*)(lds + rr * 2048 + cc * 16) = *(const u32x4*)(p.glu + (size_t)(r0 - 30 + rr) * CWD + cc * 8); }
        {
            const int g = tid >> 7, w = 2 << g; const float inv = 1.0f / (float)w;
            const unsigned* xpp = (const unsigned*)p.xp + tid;
            float s0 = 0.f, s1 = 0.f;
            for (int u = r0 - w + 1; u <= r0 - 1; ++u) { const unsigned v = xpp[(size_t)u * 512]; s0 += bf_lo(v); s1 += bf_hi(v); }
            for (int i = 0; i < 32; ++i) {
                const unsigned vn = xpp[(size_t)(r0 + i) * 512]; const float a0 = bf_lo(vn), a1 = bf_hi(vn);
                s0 += a0; s1 += a1;
                ((unsigned*)p.pooledb)[(size_t)(tile * 32 + i) * 512 + tid] = cvt_pk_bf16(s0 * inv - a0, s1 * inv - a1);
                const unsigned vo = xpp[(size_t)(r0 + i - w + 1) * 512]; s0 -= bf_lo(vo); s1 -= bf_hi(vo);
            }
        }
        __syncthreads();
        for (int i = 0; i < 32; ++i) {
            float a0 = bv.x, a1 = bv.y;
#pragma unroll
            for (int k = 0; k < KS; ++k) { const unsigned v = gl[(i + k) * 512 + tid]; a0 += bf_lo(v) * w0[k]; a1 += bf_hi(v) * w1[k]; }
            float s1 = a0 + a1, s2 = a0 * a0 + a1 * a1;
            s1 = wave_sum(s1); s2 = wave_sum(s2);
            if (lane == 0) { red[(i * 8 + wave) * 2] = s1; red[(i * 8 + wave) * 2 + 1] = s2; }
        }
        __syncthreads();
        for (int i = 0; i < 32; ++i) {
            float a0 = bv.x, a1 = bv.y;
#pragma unroll
            for (int k = 0; k < KS; ++k) { const unsigned v = gl[(i + k) * 512 + tid]; a0 += bf_lo(v) * w0[k]; a1 += bf_hi(v) * w1[k]; }
            float s1 = 0.f, s2 = 0.f;
#pragma unroll
            for (int q = 0; q < 8; ++q) { s1 += red[(i * 8 + q) * 2]; s2 += red[(i * 8 + q) * 2 + 1]; }
            const float mu = s1 * (1.0f / CWD), var = fmaxf(s2 * (1.0f / CWD) - mu * mu, 0.f), rs = rsqrtf(var + 1e-5f);
            const float y0 = (a0 - mu) * rs * lg.x + lb.x, y1 = (a1 - mu) * rs * lg.y + lb.y;
            ((unsigned*)p.cvnb)[(size_t)(tile * 32 + i) * 512 + tid] = cvt_pk_bf16(y0 * sigmoidf_fast(y0), y1 * sigmoidf_fast(y1));
        }
    }
}


struct EpiQ {
    const float* ssq; float* rstd; bf16_t* qb;
    __device__ __forceinline__ void operator()(const f32x4 (&acc)[2][2][4][2], const pg8::Unit& u, int wr, int wc, int fr, int fq) const {
#pragma unroll
        for (int ai = 0; ai < 2; ++ai)
#pragma unroll
            for (int m = 0; m < 4; ++m) {
                const size_t row = (size_t)(u.pm * 256 + ai * 128 + wr * 64 + m * 16 + fr);
                const f32x4* sp = (const f32x4*)(ssq + row * 32); f32x4 t = sp[0];
#pragma unroll
                for (int i = 1; i < 8; ++i) t += sp[i];
                const float rs = rsqrtf(((t[0] + t[1]) + (t[2] + t[3])) * (1.0f / D) + 1e-6f);
                if (u.pn == 0 && wc == 0 && fq == 0) rstd[row] = rs;
#pragma unroll
                for (int bj = 0; bj < 2; ++bj)
#pragma unroll
                    for (int n = 0; n < 2; ++n) { const int c = u.pn * 256 + bj * 128 + wc * 32 + n * 16 + fq * 4; const f32x4 v = acc[ai][bj][m][n] * rs;
                        u32x2 w; w.x = cvt_pk_bf16(v[0], v[1]); w.y = cvt_pk_bf16(v[2], v[3]);
                        *(u32x2*)(qb + row * D + c) = w; }
            }
    }
};

typedef float f32x16 __attribute__((ext_vector_type(16)));
__device__ __forceinline__ int okey(float s) { const int u = __float_as_int(s); return u ^ ((u >> 31) & 0x7fffffff); }
__device__ __forceinline__ float okey_inv(int k) { return __int_as_float(k ^ ((k >> 31) & 0x7fffffff)); }
__device__ __forceinline__ void sort16_desc(int (&v)[16]) {
#pragma unroll
    for (int k = 2; k <= 16; k <<= 1) {
#pragma unroll
        for (int j = k >> 1; j > 0; j >>= 1) {
#pragma unroll
            for (int i = 0; i < 16; ++i) {
                const int l = i ^ j;
                if (l > i) { const bool desc = (i & k) == 0; const int hi = max(v[i], v[l]), lo = min(v[i], v[l]); v[i] = desc ? hi : lo; v[l] = desc ? lo : hi; }
            }
        }
    }
}
__device__ __forceinline__ void merge16_desc(int (&a)[16], const int (&b)[16]) {
#pragma unroll
    for (int i = 0; i < 16; ++i) a[i] = max(a[i], b[15 - i]);
#pragma unroll
    for (int j = 8; j > 0; j >>= 1) {
#pragma unroll
        for (int i = 0; i < 16; ++i) { const int l = i ^ j; if (l > i) { const int hi = max(a[i], a[l]), lo = min(a[i], a[l]); a[i] = hi; a[l] = lo; } }
    }
}
__device__ __forceinline__ void pair_merge(int (&a)[16]) {
    int b[16];
#pragma unroll
    for (int i = 0; i < 16; ++i) b[i] = __shfl_xor(a[i], 32);
    merge16_desc(a, b);
}
constexpr int CELL_I[64] = {0,0,0,0,0,0,0,0,0,0,0,0,0,0,0,0,1,1,1,1,1,1,1,1,2,2,2,2,2,3,3,3,3,4,4,4,5,5,6,6,7,7,8,9,10,11,12,13,14,15,0,0,0,0,0,0,0,0,0,0,0,0,0,0};
constexpr int CELL_J[64] = {0,1,2,3,4,5,6,7,8,9,10,11,12,13,14,15,0,1,2,3,4,5,6,7,0,1,2,3,4,0,1,2,3,0,1,2,0,1,0,1,0,1,0,0,0,0,0,0,0,0,0,0,0,0,0,0,0,0,0,0,0,0,0,0};
constexpr int NCELL = 50;

__device__ __forceinline__ void phase_topk2(const Params& p, LAS unsigned char* lds, int bid, int nb) {
    const int tid = threadIdx.x, lane = tid & 63, wave = tid >> 6, hh = lane >> 5, l31 = lane & 31;
    LAS int* sit = (LAS int*)(lds + wave * 8448 + lane * 132);
    const int gw = bid * 8 + wave, NGW = nb * 8;
    for (int item = gw; item < (SEQ / 32) * 8; item += NGW) {
        const int h = item & 7, tok0 = (item >> 3) * 32;
        float sv[2][16];
#pragma unroll
        for (int ph = 0; ph < 2; ++ph) {
            const bf16_t* qrow = p.qb + (size_t)(tok0 + l31) * D + h * 256 + ph * 128 + 8 * hh;
            const bf16_t* krow = p.keysb + ((size_t)(h * 2 + ph) * 128 + l31) * 128 + 8 * hh;
            bf16x8 bq[8];
#pragma unroll
            for (int ks = 0; ks < 8; ++ks) bq[ks] = *(const bf16x8*)(qrow + ks * 16);
            int top[16];
#pragma unroll
            for (int kt = 0; kt < 4; ++kt) {
                f32x16 c = {0.f, 0.f, 0.f, 0.f, 0.f, 0.f, 0.f, 0.f, 0.f, 0.f, 0.f, 0.f, 0.f, 0.f, 0.f, 0.f};
#pragma unroll
                for (int ks = 0; ks < 8; ++ks) { const bf16x8 ak = *(const bf16x8*)(krow + (size_t)kt * 32 * 128 + ks * 16);
                    c = __builtin_amdgcn_mfma_f32_32x32x16_bf16(ak, bq[ks], c, 0, 0, 0); }
                int v[16];
#pragma unroll
                for (int r = 0; r < 16; ++r) { const int base = kt * 32 + (r & 3) + 8 * (r >> 2);
                    v[r] = ((okey(c[r]) & ~127) | (127 - base)) ^ (hh << 2); }
                sort16_desc(v);
                if (kt == 0) {
#pragma unroll
                    for (int i = 0; i < 16; ++i) top[i] = v[i];
                } else merge16_desc(top, v);
            }
            pair_merge(top);
#pragma unroll
            for (int i = 0; i < 16; ++i) { sv[ph][i] = okey_inv(top[i] & ~127); sit[ph * 16 + i] = 127 - (top[i] & 127); }
        }
        int w0[16], w1[16];
#pragma unroll
        for (int s = 0; s < 32; ++s) {
            const int e0 = 2 * s, e1 = 2 * s + 1;
            int key;
            if (e0 >= NCELL) key = (int)0x80000000;
            else {
                const float v0 = sv[0][CELL_I[e0]] + sv[1][CELL_J[e0]];
                const int k0 = (okey(v0) & ~255) | (255 - (CELL_I[e0] * 16 + CELL_J[e0]));
                if (e1 >= NCELL) key = hh ? (int)0x80000000 : k0;
                else { const float v1 = sv[0][CELL_I[e1]] + sv[1][CELL_J[e1]];
                    const int k1 = (okey(v1) & ~255) | (255 - (CELL_I[e1] * 16 + CELL_J[e1]));
                    key = hh ? k1 : k0; }
            }
            if (s < 16) w0[s] = key; else w1[s - 16] = key;
        }
        sort16_desc(w0); sort16_desc(w1); merge16_desc(w0, w1); pair_merge(w0);
        const float mx = okey_inv(w0[0] & ~255);
        float sum = 0.f;
#pragma unroll
        for (int k = 0; k < 16; ++k) sum += __expf(okey_inv(w0[k] & ~255) - mx);
        const float inv = 1.0f / sum;
        int eo[8]; float go[8]; const int hmask = -hh;
#pragma unroll
        for (int k = 0; k < 8; ++k) { const int kk = (w0[k] & ~hmask) | (w0[8 + k] & hmask); const int cc = 255 - (kk & 255);
            eo[k] = sit[cc >> 4] * 128 + sit[16 + (cc & 15)]; go[k] = __expf(okey_inv(kk & ~255) - mx) * inv; }
        float so[8];
#pragma unroll
        for (int k = 0; k < 8; ++k) { go[k] *= p.sup[eo[k]]; so[k] = p.sdn[eo[k]]; }
        const size_t ob = (size_t)(tok0 + l31) * 128 + h * 16 + hh * 8;
        *(u32x4*)(p.idx + ob) = (u32x4){(unsigned)eo[0], (unsigned)eo[1], (unsigned)eo[2], (unsigned)eo[3]};
        *(u32x4*)(p.idx + ob + 4) = (u32x4){(unsigned)eo[4], (unsigned)eo[5], (unsigned)eo[6], (unsigned)eo[7]};
        *(f32x4*)(p.gsu + ob) = (f32x4){go[0], go[1], go[2], go[3]};
        *(f32x4*)(p.gsu + ob + 4) = (f32x4){go[4], go[5], go[6], go[7]};
        *(f32x4*)(p.sdv + ob) = (f32x4){so[0], so[1], so[2], so[3]};
        *(f32x4*)(p.sdv + ob + 4) = (f32x4){so[4], so[5], so[6], so[7]};
    }
}


typedef float f32x2 __attribute__((ext_vector_type(2)));
__device__ __forceinline__ float fsel(int mask, float a, float b) { return __int_as_float((__float_as_int(a) & ~mask) | (__float_as_int(b) & mask)); }
__device__ __forceinline__ u32x4 bload16(__amdgpu_buffer_rsrc_t r, int voff, int soff) { return __builtin_bit_cast(u32x4, __builtin_amdgcn_raw_buffer_load_b128(r, voff, soff, 0)); }
template <int N> __device__ __forceinline__ f32x2 dot16_fp8(const u32x4 w, const f32x2 (&x)[N], int o, f32x2 acc) {
    const unsigned ww[4] = {w.x, w.y, w.z, w.w};
#pragma unroll
    for (int d = 0; d < 4; ++d) { acc += __builtin_amdgcn_cvt_pk_f32_fp8((int)ww[d], false) * x[o + 2 * d]; acc += __builtin_amdgcn_cvt_pk_f32_fp8((int)ww[d], true) * x[o + 2 * d + 1]; }
    return acc;
}
template <int N> __device__ __forceinline__ void axpy16_fp8(const u32x4 w, float a, f32x2 (&y)[N], int o) {
    const unsigned ww[4] = {w.x, w.y, w.z, w.w}; const f32x2 a2 = {a, a};
#pragma unroll
    for (int d = 0; d < 4; ++d) { y[o + 2 * d] += a2 * __builtin_amdgcn_cvt_pk_f32_fp8((int)ww[d], false); y[o + 2 * d + 1] += a2 * __builtin_amdgcn_cvt_pk_f32_fp8((int)ww[d], true); }
}
__device__ __forceinline__ unsigned bload4(__amdgpu_buffer_rsrc_t r, int voff, int soff) { return (unsigned)__builtin_amdgcn_raw_buffer_load_b32(r, voff, soff, 0); }
__device__ __forceinline__ void bstore16(__amdgpu_buffer_rsrc_t r, f32x4 v, int voff, int soff) { __builtin_amdgcn_raw_buffer_store_b128(__builtin_bit_cast(__attribute__((__vector_size__(4 * sizeof(unsigned)))) unsigned, v), r, voff, soff, 0); }
__device__ __forceinline__ void bstore8(__amdgpu_buffer_rsrc_t r, f32x2 v, int voff, int soff) { __builtin_amdgcn_raw_buffer_store_b64(__builtin_bit_cast(__attribute__((__vector_size__(2 * sizeof(unsigned)))) unsigned, v), r, voff, soff, 0); }
__device__ __forceinline__ void bstore4(__amdgpu_buffer_rsrc_t r, unsigned v, int voff, int soff) { __builtin_amdgcn_raw_buffer_store_b32(v, r, voff, soff, 0); }
__device__ __forceinline__ f32x2 fsel2(int mask, f32x2 a, f32x2 b) { return (f32x2){fsel(mask, a.x, b.x), fsel(mask, a.y, b.y)}; }
__device__ __forceinline__ f32x2 shx2(f32x2 a, int o) { return (f32x2){__shfl_xor(a.x, o), __shfl_xor(a.y, o)}; }

__device__ __forceinline__ void phase_pd(const Params& p, int bid, int nb) {
    const int tid = threadIdx.x, lane = tid & 63, wave = __builtin_amdgcn_readfirstlane(tid >> 6);
    const int v = bid & 7, lw = (bid >> 3) * 8 + wave, NLW = (nb >> 3) * 8;
    const int c = lane & 7, sub = lane >> 3;
    const int m0 = -(lane & 1), m1 = -((lane >> 1) & 1), m2 = -((lane >> 2) & 1);
    const __amdgpu_buffer_rsrc_t rd = __builtin_amdgcn_make_buffer_rsrc((void*)p.down8, 0, 16384 * D, 0x00020000);
    const __amdgpu_buffer_rsrc_t rh = __builtin_amdgcn_make_buffer_rsrc((void*)p.h2b, 0, SEQ * D * 2, 0x00020000);
    const __amdgpu_buffer_rsrc_t rg1 = __builtin_amdgcn_make_buffer_rsrc((void*)p.ffn_g, 0, D * 4, 0x00020000);
    const __amdgpu_buffer_rsrc_t ri = __builtin_amdgcn_make_buffer_rsrc((void*)p.idx, 0, SEQ * 128 * 4, 0x00020000);
    const __amdgpu_buffer_rsrc_t rrs = __builtin_amdgcn_make_buffer_rsrc((void*)p.rstd, 0, SEQ * 4, 0x00020000);
    const __amdgpu_buffer_rsrc_t rp = __builtin_amdgcn_make_buffer_rsrc((void*)p.part, 0, SEQ * 16 * 128 * 2, 0x00020000);
    const int vsub = sub * 64, vc2 = c * 32, vc1 = c * 16, vl4 = lane * 4;
#pragma unroll 1
    for (int pass = 0; pass < 2; ++pass) {
        const int sl = v * 2 + pass;
        f32x2 gs[8];
#pragma unroll
        for (int i = 0; i < 4; ++i) { const f32x4 g = __builtin_bit_cast(f32x4, bload16(rg1, c * 64, sl * 512 + i * 16)); gs[2 * i] = (f32x2){g[0], g[1]}; gs[2 * i + 1] = (f32x2){g[2], g[3]}; }
        u32x4 ix[4], hh[2]; unsigned rsb;
        {
            const int t = lw;
#pragma unroll
            for (int i = 0; i < 4; ++i) ix[i] = bload16(ri, vsub, t * 512 + i * 16);
            hh[0] = bload16(rh, vc2, t * 4096 + sl * 256); hh[1] = bload16(rh, vc2, t * 4096 + sl * 256 + 16); rsb = bload4(rrs, 0, t * 4);
        }
#pragma unroll 1
        for (int t = lw; t < SEQ; t += NLW) {
            asm volatile("" ::: "memory");
            u32x4 w[16];
            {
                const unsigned e[16] = {ix[0].x, ix[0].y, ix[0].z, ix[0].w, ix[1].x, ix[1].y, ix[1].z, ix[1].w, ix[2].x, ix[2].y, ix[2].z, ix[2].w, ix[3].x, ix[3].y, ix[3].z, ix[3].w};
#pragma unroll
                for (int g = 0; g < 16; ++g) w[g] = bload16(rd, (int)(e[g] * 2048u) + vc1, sl * 128);
            }
            f32x2 xs[8];
            {
                const float rs = __uint_as_float(rsb);
                const unsigned hw[8] = {hh[0].x, hh[0].y, hh[0].z, hh[0].w, hh[1].x, hh[1].y, hh[1].z, hh[1].w};
#pragma unroll
                for (int i = 0; i < 8; ++i) xs[i] = (f32x2){bf_lo(hw[i]) * rs, bf_hi(hw[i]) * rs} * gs[i];
            }
            asm volatile("" ::: "memory");
            {
                const int tn = t + NLW < SEQ ? t + NLW : t;
#pragma unroll
                for (int i = 0; i < 4; ++i) ix[i] = bload16(ri, vsub, tn * 512 + i * 16);
                hh[0] = bload16(rh, vc2, tn * 4096 + sl * 256); hh[1] = bload16(rh, vc2, tn * 4096 + sl * 256 + 16); rsb = bload4(rrs, 0, tn * 4);
            }
            asm volatile("" ::: "memory");
            float r[16];
#pragma unroll
            for (int g = 0; g < 16; ++g) { const f32x2 z = {0.f, 0.f}; const f32x2 s2 = dot16_fp8(w[g], xs, 0, z); r[g] = s2.x + s2.y; }
            float k8[8], k4[4];
#pragma unroll
            for (int i = 0; i < 8; ++i) k8[i] = fsel(m2, r[i], r[i + 8]) + __shfl_xor(fsel(m2, r[i + 8], r[i]), 4);
#pragma unroll
            for (int i = 0; i < 4; ++i) k4[i] = fsel(m1, k8[i], k8[i + 4]) + __shfl_xor(fsel(m1, k8[i + 4], k8[i]), 2);
            const float k0 = fsel(m0, k4[0], k4[2]) + __shfl_xor(fsel(m0, k4[2], k4[0]), 1);
            const float k1 = fsel(m0, k4[1], k4[3]) + __shfl_xor(fsel(m0, k4[3], k4[1]), 1);
            bstore4(rp, cvt_pk_bf16(k0, k1), vl4, (t * 16 + sl) * 256);
        }
    }
}
__device__ __forceinline__ void phase_pa(const Params& p, int bid, int nb) {
    const int tid = threadIdx.x, lane = tid & 63, wave = tid >> 6;
    const int gw = bid * 8 + wave, NGW = nb * 8;
    for (int it = gw; it < SEQ * 2; it += NGW) {
        const int t = it >> 1, pp = (it & 1) * 64 + lane;
        const bf16_t* pr = p.part + (size_t)t * 2048 + pp;
        float hs = 0.f;
#pragma unroll
        for (int sl = 0; sl < 16; ++sl) hs += __uint_as_float((unsigned)pr[sl * 128] << 16);
        hs *= p.sdv[(size_t)t * 128 + pp];
        p.act[(size_t)t * 128 + pp] = p.gsu[(size_t)t * 128 + pp] * 0.5f * hs * (1.0f + erff(hs * 0.70710678118654752f));
    }
}
__device__ __forceinline__ void phase_pu(const Params& p, int bid, int nb) {
    const int tid = threadIdx.x, lane = tid & 63, wave = __builtin_amdgcn_readfirstlane(tid >> 6);
    const int v = bid & 7, lw = (bid >> 3) * 8 + wave, NLW = (nb >> 3) * 8;
    const int c = lane & 7, sub = lane >> 3;
    const int m3 = -((lane >> 3) & 1), m4 = -((lane >> 4) & 1), m5 = -((lane >> 5) & 1);
    const __amdgpu_buffer_rsrc_t ru = __builtin_amdgcn_make_buffer_rsrc((void*)p.up8, 0, 16384 * D, 0x00020000);
    const __amdgpu_buffer_rsrc_t rh = __builtin_amdgcn_make_buffer_rsrc((void*)p.h2b, 0, SEQ * D * 2, 0x00020000);
    const __amdgpu_buffer_rsrc_t ri = __builtin_amdgcn_make_buffer_rsrc((void*)p.idx, 0, SEQ * 128 * 4, 0x00020000);
    const __amdgpu_buffer_rsrc_t ra = __builtin_amdgcn_make_buffer_rsrc((void*)p.act, 0, SEQ * 128 * 4, 0x00020000);
    const __amdgpu_buffer_rsrc_t ro = __builtin_amdgcn_make_buffer_rsrc((void*)p.out, 0, SEQ * D * 4, 0x00020000);
    const __amdgpu_buffer_rsrc_t rq = __builtin_amdgcn_make_buffer_rsrc((void*)p.ssq2, 0, SEQ * 16 * 4, 0x00020000);
    const int vsub = sub * 64, vc1 = c * 16, vh = c * 32 + sub * 4, vo = c * 64 + sub * 8;
#pragma unroll 1
    for (int pass = 0; pass < 2; ++pass) {
        const int sl = v * 2 + pass;
        u32x4 ix[4], ac[4]; unsigned hb;
        {
            const int t = lw;
#pragma unroll
            for (int i = 0; i < 4; ++i) { ix[i] = bload16(ri, vsub, t * 512 + i * 16); ac[i] = bload16(ra, vsub, t * 512 + i * 16); }
            hb = bload4(rh, vh, t * 4096 + sl * 256);
        }
#pragma unroll 1
        for (int t = lw; t < SEQ; t += NLW) {
            asm volatile("" ::: "memory");
            u32x4 w[16];
            {
                const unsigned e[16] = {ix[0].x, ix[0].y, ix[0].z, ix[0].w, ix[1].x, ix[1].y, ix[1].z, ix[1].w, ix[2].x, ix[2].y, ix[2].z, ix[2].w, ix[3].x, ix[3].y, ix[3].z, ix[3].w};
#pragma unroll
                for (int g = 0; g < 16; ++g) w[g] = bload16(ru, (int)(e[g] * 2048u) + vc1, sl * 128);
            }
            const float a[16] = {__uint_as_float(ac[0].x), __uint_as_float(ac[0].y), __uint_as_float(ac[0].z), __uint_as_float(ac[0].w), __uint_as_float(ac[1].x), __uint_as_float(ac[1].y), __uint_as_float(ac[1].z), __uint_as_float(ac[1].w),
                                 __uint_as_float(ac[2].x), __uint_as_float(ac[2].y), __uint_as_float(ac[2].z), __uint_as_float(ac[2].w), __uint_as_float(ac[3].x), __uint_as_float(ac[3].y), __uint_as_float(ac[3].z), __uint_as_float(ac[3].w)};
            const unsigned hcur = hb;
            asm volatile("" ::: "memory");
            {
                const int tn = t + NLW < SEQ ? t + NLW : t;
#pragma unroll
                for (int i = 0; i < 4; ++i) { ix[i] = bload16(ri, vsub, tn * 512 + i * 16); ac[i] = bload16(ra, vsub, tn * 512 + i * 16); }
                hb = bload4(rh, vh, tn * 4096 + sl * 256);
            }
            asm volatile("" ::: "memory");
            f32x2 acc[8];
#pragma unroll
            for (int i = 0; i < 8; ++i) acc[i] = (f32x2){0.f, 0.f};
#pragma unroll
            for (int g = 0; g < 16; ++g) axpy16_fp8(w[g], a[g], acc, 0);
            f32x2 k4[4], k2[2];
#pragma unroll
            for (int i = 0; i < 4; ++i) k4[i] = fsel2(m5, acc[i], acc[i + 4]) + shx2(fsel2(m5, acc[i + 4], acc[i]), 32);
#pragma unroll
            for (int i = 0; i < 2; ++i) k2[i] = fsel2(m4, k4[i], k4[i + 2]) + shx2(fsel2(m4, k4[i + 2], k4[i]), 16);
            f32x2 h3 = fsel2(m3, k2[0], k2[1]) + shx2(fsel2(m3, k2[1], k2[0]), 8);
            h3 += (f32x2){bf_lo(hcur), bf_hi(hcur)};
            bstore8(ro, h3, vo, t * 8192 + sl * 512);
            const float ss = wave_sum(h3.x * h3.x + h3.y * h3.y);
            if (lane == 0) bstore4(rq, __float_as_uint(ss), 0, (t * 16 + sl) * 4);
        }
    }
}
__device__ __forceinline__ void phase_pf(const Params& p, int bid, int nb) {
    const int tid = threadIdx.x, lane = tid & 63, wave = tid >> 6;
    const int gw = bid * 8 + wave, NGW = nb * 8;
    for (int t = gw; t < SEQ; t += NGW) {
        const f32x4* sp = (const f32x4*)(p.ssq2 + (size_t)t * 16); f32x4 q = sp[0] + sp[1] + sp[2] + sp[3];
        const float rf = rsqrtf(((q[0] + q[1]) + (q[2] + q[3])) * (1.0f / D) + 1e-6f);
        f32x4* o = (f32x4*)(p.out + (size_t)t * D) + lane; const f32x4* g = (const f32x4*)p.fin_g + lane;
#pragma unroll
        for (int j = 0; j < 8; ++j) o[64 * j] = o[64 * j] * rf * g[64 * j];
    }
}

__device__ __forceinline__ void fp8_row(const float* src, unsigned char* dst, float* inv_scale, int lane) {
    f32x4 v[2][4]; float am = 0.f;
#pragma unroll
    for (int k = 0; k < 2; ++k)
#pragma unroll
        for (int i = 0; i < 4; ++i) { v[k][i] = *(const f32x4*)(src + 1024 * k + 16 * lane + 4 * i);
            am = fmaxf(am, fmaxf(fmaxf(fabsf(v[k][i].x), fabsf(v[k][i].y)), fmaxf(fabsf(v[k][i].z), fabsf(v[k][i].w)))); }
#pragma unroll
    for (int o = 1; o < 64; o <<= 1) am = fmaxf(am, __shfl_xor(am, o));
    int be = (__float_as_int(am) >> 23) & 255; be = be < 8 ? 8 : (be > 248 ? 248 : be);
    const float sc = __int_as_float((260 - be) << 23), isc = __int_as_float((be - 6) << 23);
#pragma unroll
    for (int k = 0; k < 2; ++k) { u32x4 w; unsigned ww[4];
#pragma unroll
        for (int i = 0; i < 4; ++i) { int t = 0; t = __builtin_amdgcn_cvt_pk_fp8_f32(v[k][i].x * sc, v[k][i].y * sc, t, false); t = __builtin_amdgcn_cvt_pk_fp8_f32(v[k][i].z * sc, v[k][i].w * sc, t, true); ww[i] = (unsigned)t; }
        w.x = ww[0]; w.y = ww[1]; w.z = ww[2]; w.w = ww[3];
        *(u32x4*)(dst + 1024 * k + 16 * lane) = w; }
    if (lane == 0) *inv_scale = isc;
}

__device__ __forceinline__ void tr_item(const float* W, int ldw, int srccol0, int k0, bf16_t* WT, int ldt, int n0, const float* kscale, const float* nscale, LAS float* scr, int lane) {
#pragma unroll 8
    for (int i = 0; i < 32; ++i) { const int kk = 2 * i + (lane >> 5); float v = W[(size_t)(k0 + kk) * ldw + srccol0 + (lane & 31)];
        if (kscale) v *= kscale[k0 + kk]; if (nscale) v *= nscale[srccol0 + (lane & 31)]; scr[kk * 33 + (lane & 31)] = v; }
    asm volatile("s_waitcnt lgkmcnt(0)" ::: "memory");
    const int c = lane & 7;
#pragma unroll
    for (int j = 0; j < 4; ++j) { const int n = (lane >> 3) + 8 * j; const LAS float* s = scr + (8 * c) * 33 + n;
        u32x4 o; o.x = cvt_pk_bf16(s[0 * 33], s[1 * 33]); o.y = cvt_pk_bf16(s[2 * 33], s[3 * 33]); o.z = cvt_pk_bf16(s[4 * 33], s[5 * 33]); o.w = cvt_pk_bf16(s[6 * 33], s[7 * 33]);
        *(u32x4*)(WT + (size_t)(n0 + n) * ldt + k0 + 8 * c) = o; }
    asm volatile("s_waitcnt lgkmcnt(0)" ::: "memory");
}
__device__ __forceinline__ int win_srccol(int n) { const int pn = n >> 8, w = n & 255; return pn < 4 ? n : ((w >> 7) ? 2048 : 1024) + (pn - 4) * 128 + (w & 127); }

__device__ __forceinline__ void phase_prep(const Params& p, LAS unsigned char* lds, int bid, int nb) {
    const int tid = threadIdx.x, lane = tid & 63, wave = tid >> 6;
    const int gw = bid * 8 + wave, NGW = nb * 8;
    LAS float* scr = (LAS float*)(lds + wave * 8448);
    for (int r = gw; r < RT; r += NGW) {
        unsigned long long* o8 = (unsigned long long*)(p.hnb + (size_t)r * D) + lane;
        if (r < RPAD) {
#pragma unroll
            for (int j = 0; j < 8; ++j) o8[64 * j] = 0ull;
        } else {
            const f32x4* xr = (const f32x4*)hrow(p, r - RPAD) + lane;
            const f32x4* gr = (const f32x4*)p.mix_g + lane;
            f32x4 v[8]; float s = 0.f;
#pragma unroll
            for (int j = 0; j < 8; ++j) { v[j] = xr[64 * j]; s += (v[j].x * v[j].x + v[j].y * v[j].y) + (v[j].z * v[j].z + v[j].w * v[j].w); }
            const float rs = rsqrtf(wave_sum(s) * (1.0f / D) + 1e-6f);
#pragma unroll
            for (int j = 0; j < 8; ++j) { const f32x4 gv = gr[64 * j];
                o8[64 * j] = (unsigned long long)cvt_pk_bf16(v[j].x * rs * gv.x, v[j].y * rs * gv.y) | ((unsigned long long)cvt_pk_bf16(v[j].z * rs * gv.z, v[j].w * rs * gv.w) << 32); }
        }
    }
    for (int it = gw; it < (D / 64) * (INW / 32); it += NGW) {
        const int kb = it / (INW / 32), nbk = it % (INW / 32);
        tr_item(p.w_in, INW, win_srccol(nbk * 32), kb * 64, p.w_in_t, D, nbk * 32, nullptr, nullptr, scr, lane);
    }
    for (int it = gw; it < 4 * 4 * 8; it += NGW) { const int g = it >> 5, kb = (it >> 3) & 3, nbk = it & 7;
        tr_item(p.pool_w + (size_t)g * 65536, 256, nbk * 32, kb * 64, p.pool_wt + (size_t)g * 65536, 256, nbk * 32, nullptr, p.pool_scale + g * 256, scr, lane); }
    for (int it = gw; it < 16 * 32; it += NGW) { const int kb = it >> 5, nbk = it & 31;
        tr_item(p.pw_w, CWD, nbk * 32, kb * 64, p.pw_t, CWD, nbk * 32, nullptr, nullptr, scr, lane); }
    for (int it = gw; it < 32 * 64; it += NGW) { const int kb = it >> 6, nbk = it & 63;
        tr_item(p.w_out, D, nbk * 32, kb * 64, p.w_out_t, D, nbk * 32, nullptr, nullptr, scr, lane); }
    for (int it = gw; it < 32 * 64; it += NGW) { const int kb = it >> 6, nbk = it & 63;
        tr_item(p.wq, D, nbk * 32, kb * 64, p.wq_t, D, nbk * 32, p.ffn_g, nullptr, scr, lane); }
    for (int i = gw * 64 + lane; i < 8 * 2 * 128 * 128 / 4; i += NGW * 64) { const f32x4 v = ((const f32x4*)p.keys)[i];
        u32x2 w; w.x = cvt_pk_bf16(v[0], v[1]); w.y = cvt_pk_bf16(v[2], v[3]); ((u32x2*)p.keysb)[i] = w; }
    for (int e = gw; e < 2 * 16384; e += NGW) {
        if (e < 16384) fp8_row(p.down + (size_t)e * D, p.down8 + (size_t)e * D, p.sdn + e, lane);
        else fp8_row(p.up + (size_t)(e - 16384) * D, p.up8 + (size_t)(e - 16384) * D, p.sup + (e - 16384), lane);
    }
}


#define XB_TMO      128
#define XB_XCNT(j)  (256  + 64 * (j))
#define XB_XSUB(j)  (1280 + 64 * (j))
#define XB_XGEN(j)  (2304 + 64 * (j))
#define XB_TOP      3328
#define XB_TOPGEN   3392
#define XCD_BAR_WORDS 3456
#define XB_SPIN_CAP (1u << 18)
__device__ __forceinline__ unsigned xb_ld(unsigned* p)              { return __hip_atomic_load(p, __ATOMIC_RELAXED, __HIP_MEMORY_SCOPE_AGENT); }
__device__ __forceinline__ unsigned xb_add(unsigned* p, unsigned v) { return __hip_atomic_fetch_add(p, v, __ATOMIC_RELAXED, __HIP_MEMORY_SCOPE_AGENT); }
__device__ __forceinline__ unsigned xb_xcc_id() { return (unsigned)__builtin_amdgcn_s_getreg((3 << 11) | 20) & 0xFu; }
#define XB_SPIN(cond, bar) do { unsigned _sp = 0; while (cond) { __builtin_amdgcn_s_sleep(1); \
    if ((++_sp & 255u) == 0u) { if (xb_ld(&(bar)[XB_TMO])) break; if (_sp > XB_SPIN_CAP) { atomicAdd(&(bar)[XB_TMO], 1u); break; } } } } while (0)
struct XcdBarrier { unsigned* bar; unsigned x; volatile LAS unsigned* st; };
__device__ __forceinline__ XcdBarrier xcd_barrier_post(unsigned* bar, volatile LAS unsigned* st) {
    XcdBarrier b; b.bar = bar; b.x = xb_xcc_id(); b.st = st;
    if (threadIdx.x == 0) (void)xb_add(&bar[XB_XCNT(b.x)], 1u);
    return b;
}
__device__ __forceinline__ void xcd_barrier_complete(unsigned* bar, unsigned x, unsigned& nloc, unsigned& nx) {
    const unsigned G = gridDim.x * gridDim.y * gridDim.z;
    unsigned sum, cnt, mine, sp = 0u;
    for (;;) {
        sum = 0u; cnt = 0u; mine = 0u;
#pragma unroll
        for (unsigned j = 0; j < 16; ++j) { const unsigned c = xb_ld(&bar[XB_XCNT(j)]); sum += c; cnt += (c > 0u) ? 1u : 0u; mine = (j == x) ? c : mine; }
        if (sum == G) break;
        __builtin_amdgcn_s_sleep(1);
        if ((++sp & 255u) == 0u) { if (xb_ld(&bar[XB_TMO])) break; if (sp > XB_SPIN_CAP) { atomicAdd(&bar[XB_TMO], 1u); break; } }
    }
    nloc = mine > 0u ? mine : 1u; nx = cnt > 0u ? cnt : 1u;
}
__device__ __forceinline__ void xcd_barrier(const XcdBarrier& b) {
    asm volatile("s_waitcnt vmcnt(0)" ::: "memory");
    __syncthreads();
    if (threadIdx.x == 0) {
        unsigned* bar = b.bar;
        __builtin_amdgcn_s_waitcnt(0);
        unsigned nloc = b.st[0], nx = b.st[1];
        if (nloc == 0u) { xcd_barrier_complete(bar, b.x, nloc, nx); b.st[0] = nloc; b.st[1] = nx; }
        const unsigned old = xb_add(&bar[XB_XSUB(b.x)], 1u);
        const unsigned gen = old / nloc;
        if (old + 1u == (gen + 1u) * nloc) {
            __builtin_amdgcn_fence(__ATOMIC_RELEASE, "agent");
            asm volatile("s_waitcnt vmcnt(0)" ::: "memory");
            const unsigned og = xb_add(&bar[XB_TOP], 1u);
            const unsigned tg = og / nx;
            if (og + 1u == (tg + 1u) * nx) xb_add(&bar[XB_TOPGEN], 1u);
            else XB_SPIN(xb_ld(&bar[XB_TOPGEN]) == tg, bar);
            __builtin_amdgcn_fence(__ATOMIC_ACQUIRE, "agent");
            xb_add(&bar[XB_XGEN(b.x)], 1u);
            asm volatile("s_waitcnt vmcnt(0)" ::: "memory");
        } else {
            XB_SPIN(xb_ld(&bar[XB_XGEN(b.x)]) == gen, bar);
            __builtin_amdgcn_fence(__ATOMIC_ACQUIRE, "agent");
            asm volatile("s_waitcnt vmcnt(0)" ::: "memory");
        }
    }
    __syncthreads();
}

__global__ void __launch_bounds__(NT, 2) k_mega(Params p) {
    extern __shared__ __attribute__((aligned(16))) unsigned char lds_raw[];
    LAS unsigned char* lds = (LAS unsigned char*)lds_raw;
    cg::grid_group grid = cg::this_grid();
    const int bid = blockIdx.x, nb = gridDim.x;
    volatile LAS unsigned* bst = (volatile LAS unsigned*)(lds + 131072);
    if (threadIdx.x < 4) bst[threadIdx.x] = 0u;
    __syncthreads();
    const XcdBarrier xb = xcd_barrier_post(p.bar, bst);
    phase_prep(p, lds, bid, nb);
    grid.sync();
    { pg8::Gemm g{p.hnb, p.w_in_t, D, D, D, 0}; pg8::StaticOrder S; S.init(RT / 256, INW / 256, nb, bid); EpiProj E{p.xp, p.glu};
      pg8::gemm_phase<EpiProj, pg8::StaticOrder>(lds, g, S, E); }
    xcd_barrier(xb);
    phase_mix(p, lds, bid, nb);
    xcd_barrier(xb);
    if (bid < nb / 2) { pg8::Gemm g{p.pooledb, p.pool_wt, PWD, 256, 256, 256}; pg8::StaticOrder S; S.init(SEQ / 256, 4, nb / 2, bid); EpiBf16Out E{p.yabb, D, 0, nullptr};
      pg8::gemm_phase<EpiBf16Out, pg8::StaticOrder>(lds, g, S, E); }
    else { pg8::Gemm g{p.cvnb, p.pw_t, CWD, CWD, CWD, 0}; pg8::StaticOrder S; S.init(SEQ / 256, 4, nb - nb / 2, bid - nb / 2); EpiBf16Out E{p.yabb, D, PWD, p.pw_b};
      pg8::gemm_phase<EpiBf16Out, pg8::StaticOrder>(lds, g, S, E); }
    xcd_barrier(xb);
    { pg8::Gemm g{p.yabb, p.w_out_t, D, D, D, 0}; pg8::StaticOrder S; S.init(SEQ / 256, D / 256, nb, bid); EpiResid E{p.x, p.h2b, p.ssq};
      pg8::gemm_phase<EpiResid, pg8::StaticOrder>(lds, g, S, E); }
    xcd_barrier(xb);
    { pg8::Gemm g{p.h2b, p.wq_t, D, D, D, 0}; pg8::StaticOrder S; S.init(SEQ / 256, D / 256, nb, bid); EpiQ E{p.ssq, p.rstd, p.qb};
      pg8::gemm_phase<EpiQ, pg8::StaticOrder>(lds, g, S, E); }
    xcd_barrier(xb);
    phase_topk2(p, lds, bid, nb);
    xcd_barrier(xb);
    phase_pd(p, bid, nb);
    xcd_barrier(xb);
    phase_pa(p, bid, nb);
    xcd_barrier(xb);
    phase_pu(p, bid, nb);
    xcd_barrier(xb);
    phase_pf(p, bid, nb);
}

extern "C" void kernel_launch(void* const* d_in, const int* in_sizes, int n_in, void* d_out, int out_size, void* d_ws, size_t ws_size, hipStream_t stream) {
    Params p{};
    p.x = (const float*)d_in[0]; p.meta = (const float*)d_in[1]; p.mix_g = (const float*)d_in[2]; p.w_in = (const float*)d_in[3];
    p.pool_w = (const float*)d_in[4]; p.pool_scale = (const float*)d_in[5]; p.dw_w = (const float*)d_in[6]; p.dw_b = (const float*)d_in[7];
    p.ln_g = (const float*)d_in[8]; p.ln_b = (const float*)d_in[9]; p.pw_w = (const float*)d_in[10]; p.pw_b = (const float*)d_in[11];
    p.w_out = (const float*)d_in[12]; p.ffn_g = (const float*)d_in[13]; p.wq = (const float*)d_in[14]; p.keys = (const float*)d_in[15];
    p.down = (const float*)d_in[16]; p.up = (const float*)d_in[17]; p.fin_g = (const float*)d_in[18];
    p.out = (float*)d_out;
    char* w = (char*)d_ws; size_t off = 0;
    auto take = [&](size_t bytes) { char* r = w + off; off += (bytes + 255) & ~(size_t)255; return r; };
    p.idx = (int*)take((size_t)SEQ * 128 * 4);
    p.gsu = (float*)take((size_t)SEQ * 128 * 4);
    p.part = (bf16_t*)take((size_t)SEQ * 16 * 128 * 2);
    p.act = (float*)take((size_t)SEQ * 128 * 4);
    p.ssq2 = (float*)take((size_t)SEQ * 16 * 4);
    p.sdv = (float*)take((size_t)SEQ * 128 * 4);
    p.hnb = (bf16_t*)take((size_t)RT * D * 2);
    p.w_in_t = (bf16_t*)take((size_t)INW * D * 2);
    p.xp = (bf16_t*)take((size_t)RT * PWD * 2);
    p.glu = (bf16_t*)take((size_t)RT * CWD * 2);
    p.pooledb = (bf16_t*)take((size_t)SEQ * PWD * 2);
    p.cvnb = (bf16_t*)take((size_t)SEQ * CWD * 2);
    p.yabb = (bf16_t*)take((size_t)SEQ * D * 2);
    p.h2b = (bf16_t*)take((size_t)SEQ * D * 2);
    p.pool_wt = (bf16_t*)take((size_t)4 * 256 * 256 * 2);
    p.pw_t = (bf16_t*)take((size_t)CWD * CWD * 2);
    p.w_out_t = (bf16_t*)take((size_t)D * D * 2);
    p.ssq = (float*)take((size_t)SEQ * 32 * 4);
    p.bar = (unsigned*)take((size_t)XCD_BAR_WORDS * 4);
    p.rstd = (float*)take((size_t)SEQ * 4);
    p.wq_t = (bf16_t*)take((size_t)D * D * 2);
    p.keysb = (bf16_t*)take((size_t)8 * 2 * 128 * 128 * 2);
    p.qb = (bf16_t*)take((size_t)SEQ * D * 2);
    p.down8 = (unsigned char*)take((size_t)16384 * D);
    p.up8 = (unsigned char*)take((size_t)16384 * D);
    p.sdn = (float*)take((size_t)16384 * 4);
    p.sup = (float*)take((size_t)16384 * 4);
    static int grid_blocks = 0;
    if (!grid_blocks) {
        int dev = 0, cus = 0, per_cu = 0;
        (void)hipGetDevice(&dev);
        (void)hipDeviceGetAttribute(&cus, hipDeviceAttributeMultiprocessorCount, dev);
        (void)hipFuncSetAttribute((const void*)k_mega, hipFuncAttributeMaxDynamicSharedMemorySize, LDS_BYTES);
        (void)hipOccupancyMaxActiveBlocksPerMultiprocessor(&per_cu, k_mega, NT, LDS_BYTES);
        if (per_cu < 1) fprintf(stderr, "occupancy query says %d blocks per CU\n", per_cu);
        grid_blocks = cus;
    }
    (void)hipMemsetAsync(p.bar, 0, (size_t)XCD_BAR_WORDS * 4, stream);
    void* args[] = {&p};
    hipError_t e = hipLaunchCooperativeKernel((void*)k_mega, dim3(grid_blocks), dim3(NT), args, LDS_BYTES, stream);
    if (e != hipSuccess) fprintf(stderr, "cooperative launch failed: %s (grid %d)\n", hipGetErrorString(e), grid_blocks);
}
```

```cpp
#include <hip/hip_runtime.h>
#include <hip/hip_cooperative_groups.h>
#include <stdint.h>
#include <cstdio>
namespace cg = cooperative_groups;

#define NT 512
#define LAS __attribute__((address_space(3)))
typedef unsigned short bf16_t;
typedef short bf16x8 __attribute__((ext_vector_type(8)));
typedef float f32x4 __attribute__((ext_vector_type(4)));
typedef unsigned u32x4 __attribute__((ext_vector_type(4)));
typedef unsigned u32x2 __attribute__((ext_vector_type(2)));

constexpr int D = 2048, SEQ = 8192, NMETA = 16, T = SEQ + NMETA;
constexpr int PWD = 1024, CWD = 1024, INW = 3072;
constexpr int KS = 31;
constexpr int RPAD = 240, RT = 8448;
constexpr int LDS_BYTES = 147456;

struct Params {
    const float *x, *meta, *mix_g, *w_in, *pool_w, *pool_scale, *dw_w, *dw_b, *ln_g, *ln_b, *pw_w, *pw_b, *w_out, *ffn_g, *wq, *keys, *down, *up, *fin_g;
    float* out;
    int* idx;
    unsigned* bar;
    bf16_t *hnb, *w_in_t, *xp, *glu, *pooledb, *cvnb, *yabb, *h2b, *pool_wt, *pw_t, *w_out_t, *wq_t, *keysb, *qb;
    unsigned char *down8, *up8;
    float *sdn, *sup;
    float *gsu, *sdv;
    bf16_t* part;
    float *act, *ssq2;
    float *ssq, *rstd;
};

__device__ __forceinline__ unsigned cvt_pk_bf16(float lo, float hi) { unsigned r; asm volatile("v_cvt_pk_bf16_f32 %0, %1, %2" : "=v"(r) : "v"(lo), "v"(hi)); return r; }
__device__ __forceinline__ float wave_sum(float v) {
#pragma unroll
    for (int o = 1; o < 64; o <<= 1) v += __shfl_xor(v, o);
    return v;
}

__device__ __forceinline__ const float* hrow(const Params& p, int t) { return t < NMETA ? p.meta + (size_t)t * D : p.x + (size_t)(t - NMETA) * D; }

__device__ __forceinline__ float block_sum(float v, float* red) {
#pragma unroll
    for (int o = 32; o; o >>= 1) v += __shfl_xor(v, o);
    __syncthreads();
    if ((threadIdx.x & 63) == 0) red[threadIdx.x >> 6] = v;
    __syncthreads();
    float s = 0.f;
#pragma unroll
    for (int i = 0; i < NT / 64; ++i) s += red[i];
    return s;
}

namespace pg8 {
constexpr int BM = 256, BK = 64, HALF = 128, HTB = HALF * BK * 2, STAGE_BYTES = 8 * HTB, NXCD = 8, WGM = 8;
__device__ __forceinline__ int lds_byte(int r, int c) { const int st = (r >> 4) * 2 + (c >> 5), rr = r & 15, cc = c & 31, ob = rr * 64 + cc * 2; return st * 1024 + (ob ^ (((ob >> 9) & 1) << 5)); }
__device__ __forceinline__ void stage_rc(int b, int& R, int& C) { const int st = b / 1024, sb = b % 1024, swz = sb ^ (((sb >> 9) & 1) << 5); R = (st >> 1) * 16 + swz / 64; C = (st & 1) * 32 + (swz % 64) / 2; }
struct Unit { int pm, pn; };
struct Gemm { const bf16_t* A; const bf16_t* Bt; int lda, ldb, K; int a_col_per_pn; };
struct StaticOrder {
    int nM, nN, nwg, G, c;
    __device__ void init(int nM_, int nN_, int G_, int c_) { nM = nM_; nN = nN_; nwg = nM * nN; G = G_; c = c_; }
    __device__ bool next(int i, Unit& u) const {
        const long L = (long)i * G + c; if (L >= nwg) return false;
        int wgid = (int)L; { const int q = nwg / NXCD, r = nwg % NXCD, xcd = wgid % NXCD, off = wgid / NXCD; wgid = (xcd < r ? xcd * (q + 1) : r * (q + 1) + (xcd - r) * q) + off; }
        const int nig = WGM * nN, gid = wgid / nig, fm = gid * WGM, gsz = (nM - fm) < WGM ? (nM - fm) : WGM;
        u.pm = fm + ((wgid % nig) % gsz); u.pn = (wgid % nig) / gsz; return true;
    }
};
template <class Epi, class Sched>
__device__ __forceinline__ void gemm_phase(LAS unsigned char* lds, const Gemm g, const Sched& S, const Epi& E) {
    const int tid = threadIdx.x, wid = __builtin_amdgcn_readfirstlane(tid >> 6), lane = tid & 63, wr = wid >> 2, wc = wid & 3, fr = lane & 15, fq = lane >> 4;
    const int K = g.K, nt = K / BK;
    unsigned voffA[2], voffB[2];
#pragma unroll
    for (int i = 0; i < 2; ++i) { int R, C; stage_rc(tid * 16 + i * 8192, R, C);
        voffA[i] = (unsigned)(R * g.lda + C) * 2u; voffB[i] = (unsigned)(R * g.ldb + C) * 2u; }
    const size_t kstep = (size_t)(BK * 2);
    const size_t hstepA = (size_t)HALF * g.lda * 2, hstepB = (size_t)HALF * g.ldb * 2;
    const size_t tstepA = 2 * hstepA, tstepB = 2 * hstepB;
    const unsigned ldsw = (unsigned)wid * 1024u;
    const int aoff = lds_byte(wr * 64 + fr, fq * 8), boff = lds_byte(wc * 32 + fr, fq * 8);
#define PG8_SA(b, h) (((b) * 2 + (h)) * HTB)
#define PG8_SB(b, h) ((4 + (b) * 2 + (h)) * HTB)
#define PG8_STAGE(bufoff, gbase, voff) do { _Pragma("unroll") for (int _i = 0; _i < 2; ++_i) \
        __builtin_amdgcn_global_load_lds((const unsigned*)((const char*)(gbase) + (voff)[_i]), (LAS unsigned*)(lds + (bufoff) + ldsw + _i * 8192), 16, 0, 0); } while (0)
#define PG8_LDA(dst, b, h) do { _Pragma("unroll") for (int m = 0; m < 4; ++m) _Pragma("unroll") for (int k = 0; k < 2; ++k) dst[m][k] = *(const LAS bf16x8*)(lds + PG8_SA(b, h) + aoff + m * 2048 + k * 1024); } while (0)
#define PG8_LDB(dst, b, h) do { _Pragma("unroll") for (int n = 0; n < 2; ++n) _Pragma("unroll") for (int k = 0; k < 2; ++k) dst[n][k] = *(const LAS bf16x8*)(lds + PG8_SB(b, h) + boff + n * 2048 + k * 1024); } while (0)
#define PG8_MMA(ai, bj, At, Bt) do { __builtin_amdgcn_s_setprio(1); _Pragma("unroll") for (int m = 0; m < 4; ++m) _Pragma("unroll") for (int n = 0; n < 2; ++n) _Pragma("unroll") for (int k = 0; k < 2; ++k) \
        acc[ai][bj][m][n] = __builtin_amdgcn_mfma_f32_16x16x32_bf16(Bt[n][k], At[m][k], acc[ai][bj][m][n], 0, 0, 0); __builtin_amdgcn_s_setprio(0); } while (0)
#define PG8_WAIT_V(n) asm volatile("s_waitcnt vmcnt(" #n ")" ::: "memory")
#define PG8_WAIT_L(n) asm volatile("s_waitcnt lgkmcnt(" #n ")" ::: "memory")
#define PG8_BAR __builtin_amdgcn_s_barrier()
#define PG8_SCHED __builtin_amdgcn_sched_barrier(0)
    Unit cur, nxt; int ui = 0;
    if (!S.next(0, cur)) return;
    f32x4 acc[2][2][4][2];
#pragma unroll
    for (int a = 0; a < 2; ++a)
#pragma unroll
        for (int b = 0; b < 2; ++b)
#pragma unroll
            for (int m = 0; m < 4; ++m)
#pragma unroll
                for (int n = 0; n < 2; ++n) acc[a][b][m][n] = (f32x4){0.f, 0.f, 0.f, 0.f};
    bf16x8 At[4][2], B0[2][2], B1[2][2];
    const char* cA = (const char*)g.A + (size_t)cur.pm * tstepA + (size_t)cur.pn * g.a_col_per_pn * 2; const char* cB = (const char*)g.Bt + (size_t)cur.pn * tstepB;
    PG8_STAGE(PG8_SB(0, 0), cB, voffB); PG8_STAGE(PG8_SA(0, 0), cA, voffA); PG8_STAGE(PG8_SB(0, 1), cB + hstepB, voffB); PG8_STAGE(PG8_SA(0, 1), cA + hstepA, voffA);
    if (wr == 1) PG8_BAR;
    PG8_WAIT_V(4); PG8_BAR;
    PG8_STAGE(PG8_SB(1, 0), cB + kstep, voffB); PG8_STAGE(PG8_SA(1, 0), cA + kstep, voffA); PG8_STAGE(PG8_SB(1, 1), cB + hstepB + kstep, voffB);
    PG8_WAIT_V(6); PG8_BAR;
    for (;;) {
        const bool has_next = S.next(ui + 1, nxt);
        const char* nA = has_next ? (const char*)g.A + (size_t)nxt.pm * tstepA + (size_t)nxt.pn * g.a_col_per_pn * 2 : cA; const char* nB = has_next ? (const char*)g.Bt + (size_t)nxt.pn * tstepB : cB;
        for (int t = 0; t < nt; t += 2) {
            const bool last = (t == nt - 2);
            const char* a1 = cA + (size_t)(t + 1) * kstep;
            const char* a2 = last ? nA : cA + (size_t)(t + 2) * kstep; const char* b2 = last ? nB : cB + (size_t)(t + 2) * kstep;
            const char* a3 = a2 + kstep; const char* b3 = b2 + kstep;
            PG8_LDB(B0, 0, 0); PG8_SCHED; PG8_LDA(At, 0, 0); PG8_STAGE(PG8_SA(1, 1), a1 + hstepA, voffA);
            PG8_WAIT_L(8); PG8_BAR; PG8_WAIT_L(0); PG8_MMA(0, 0, At, B0); PG8_BAR; PG8_SCHED;
            PG8_LDB(B1, 0, 1); PG8_STAGE(PG8_SB(0, 0), b2, voffB);
            PG8_BAR; PG8_WAIT_L(0); PG8_MMA(0, 1, At, B1); PG8_BAR;
            PG8_LDA(At, 0, 1); PG8_STAGE(PG8_SA(0, 0), a2, voffA);
            PG8_BAR; PG8_WAIT_L(0); PG8_MMA(1, 0, At, B0); PG8_BAR; PG8_SCHED;
            PG8_STAGE(PG8_SB(0, 1), b2 + hstepB, voffB);
            PG8_WAIT_V(6); PG8_BAR; PG8_MMA(1, 1, At, B1); PG8_BAR;
            PG8_LDB(B0, 1, 0); PG8_SCHED; PG8_LDA(At, 1, 0); PG8_STAGE(PG8_SA(0, 1), a2 + hstepA, voffA);
            PG8_WAIT_L(8); PG8_BAR; PG8_WAIT_L(0); PG8_MMA(0, 0, At, B0); PG8_BAR; PG8_SCHED;
            PG8_LDB(B1, 1, 1); PG8_STAGE(PG8_SB(1, 0), b3, voffB);
            PG8_BAR; PG8_WAIT_L(0); PG8_MMA(0, 1, At, B1); PG8_BAR;
            PG8_LDA(At, 1, 1); PG8_STAGE(PG8_SA(1, 0), a3, voffA);
            PG8_BAR; PG8_WAIT_L(0); PG8_MMA(1, 0, At, B0); PG8_BAR; PG8_SCHED;
            PG8_STAGE(PG8_SB(1, 1), b3 + hstepB, voffB);
            PG8_WAIT_V(6); PG8_BAR; PG8_MMA(1, 1, At, B1); PG8_BAR;
        }
        E(acc, cur, wr, wc, fr, fq);
        if (!has_next) break;
#pragma unroll
        for (int a = 0; a < 2; ++a)
#pragma unroll
            for (int b = 0; b < 2; ++b)
#pragma unroll
                for (int m = 0; m < 4; ++m)
#pragma unroll
                    for (int n = 0; n < 2; ++n) acc[a][b][m][n] = (f32x4){0.f, 0.f, 0.f, 0.f};
        cur = nxt; cA = nA; cB = nB; ++ui;
    }
    PG8_WAIT_V(0);
    if (wr == 0) PG8_BAR;
    PG8_BAR;
#undef PG8_SA
#undef PG8_SB
#undef PG8_STAGE
#undef PG8_LDA
#undef PG8_LDB
#undef PG8_MMA
#undef PG8_WAIT_V
#undef PG8_WAIT_L
#undef PG8_BAR
#undef PG8_SCHED
}
}

struct EpiProjF32 {
    float* proj;
    __device__ __forceinline__ void operator()(const f32x4 (&acc)[2][2][4][2], const pg8::Unit& u, int wr, int wc, int fr, int fq) const {
#pragma unroll
        for (int ai = 0; ai < 2; ++ai)
#pragma unroll
            for (int m = 0; m < 4; ++m) {
                const int t = u.pm * 256 + ai * 128 + wr * 64 + m * 16 + fr - RPAD;
                if (t >= 0) {
#pragma unroll
                    for (int bj = 0; bj < 2; ++bj)
#pragma unroll
                        for (int n = 0; n < 2; ++n) {
                            const int off = wc * 32 + n * 16 + fq * 4;
                            const int col = u.pn < 4 ? u.pn * 256 + bj * 128 + off : (bj ? 2048 : 1024) + (u.pn - 4) * 128 + off;
                            *(f32x4*)(proj + (size_t)t * INW + col) = acc[ai][bj][m][n];
                        }
                }
            }
    }
};


__device__ __forceinline__ float sigmoidf_fast(float x) { return __builtin_amdgcn_rcpf(1.0f + __expf(-x)); }

struct EpiProj {
    bf16_t* xp; bf16_t* glu;
    __device__ __forceinline__ void operator()(const f32x4 (&acc)[2][2][4][2], const pg8::Unit& u, int wr, int wc, int fr, int fq) const {
#pragma unroll
        for (int ai = 0; ai < 2; ++ai)
#pragma unroll
            for (int m = 0; m < 4; ++m) {
                const size_t row = (size_t)(u.pm * 256 + ai * 128 + wr * 64 + m * 16 + fr);
                if (u.pn < 4) {
#pragma unroll
                    for (int bj = 0; bj < 2; ++bj)
#pragma unroll
                        for (int n = 0; n < 2; ++n) { const f32x4 v = acc[ai][bj][m][n]; u32x2 w; w.x = cvt_pk_bf16(v[0], v[1]); w.y = cvt_pk_bf16(v[2], v[3]);
                            *(u32x2*)(xp + row * PWD + u.pn * 256 + bj * 128 + wc * 32 + n * 16 + fq * 4) = w; }
                } else {
#pragma unroll
                    for (int n = 0; n < 2; ++n) { const f32x4 a = acc[ai][0][m][n], g = acc[ai][1][m][n]; u32x2 w;
                        w.x = cvt_pk_bf16(a[0] * sigmoidf_fast(g[0]), a[1] * sigmoidf_fast(g[1])); w.y = cvt_pk_bf16(a[2] * sigmoidf_fast(g[2]), a[3] * sigmoidf_fast(g[3]));
                        *(u32x2*)(glu + row * CWD + (u.pn - 4) * 128 + wc * 32 + n * 16 + fq * 4) = w; }
                }
            }
    }
};
struct EpiBf16Out {
    bf16_t* O; int ldc; int col0; const float* bias;
    __device__ __forceinline__ void operator()(const f32x4 (&acc)[2][2][4][2], const pg8::Unit& u, int wr, int wc, int fr, int fq) const {
#pragma unroll
        for (int ai = 0; ai < 2; ++ai)
#pragma unroll
            for (int m = 0; m < 4; ++m) {
                const size_t row = (size_t)(u.pm * 256 + ai * 128 + wr * 64 + m * 16 + fr);
#pragma unroll
                for (int bj = 0; bj < 2; ++bj)
#pragma unroll
                    for (int n = 0; n < 2; ++n) { const int c = u.pn * 256 + bj * 128 + wc * 32 + n * 16 + fq * 4; f32x4 v = acc[ai][bj][m][n];
                        if (bias) v += *(const f32x4*)(bias + c);
                        u32x2 w; w.x = cvt_pk_bf16(v[0], v[1]); w.y = cvt_pk_bf16(v[2], v[3]);
                        *(u32x2*)(O + row * ldc + col0 + c) = w; }
            }
    }
};
struct EpiResid {
    const float* x; bf16_t* h2b; float* ssq;
    __device__ __forceinline__ void operator()(const f32x4 (&acc)[2][2][4][2], const pg8::Unit& u, int wr, int wc, int fr, int fq) const {
#pragma unroll
        for (int ai = 0; ai < 2; ++ai)
#pragma unroll
            for (int m = 0; m < 4; ++m) {
                const size_t row = (size_t)(u.pm * 256 + ai * 128 + wr * 64 + m * 16 + fr);
                float ss = 0.f;
#pragma unroll
                for (int bj = 0; bj < 2; ++bj)
#pragma unroll
                    for (int n = 0; n < 2; ++n) { const int c = u.pn * 256 + bj * 128 + wc * 32 + n * 16 + fq * 4;
                        const f32x4 v = acc[ai][bj][m][n] + *(const f32x4*)(x + row * D + c);
                        u32x2 w; w.x = cvt_pk_bf16(v[0], v[1]); w.y = cvt_pk_bf16(v[2], v[3]);
                        *(u32x2*)(h2b + row * D + c) = w;
                        ss += (v[0] * v[0] + v[1] * v[1]) + (v[2] * v[2] + v[3] * v[3]); }
                ss += __shfl_xor(ss, 16); ss += __shfl_xor(ss, 32);
                if (fq == 0) ssq[row * 32 + u.pn * 4 + wc] = ss;
            }
    }
};

__device__ __forceinline__ float fsel(int mask, float a, float b) { return __int_as_float((__float_as_int(a) & ~mask) | (__float_as_int(b) & mask)); }
__device__ __forceinline__ float bf_lo(unsigned w) { return __uint_as_float(w << 16); }
__device__ __forceinline__ float bf_hi(unsigned w) { return __uint_as_float(w & 0xffff0000u); }

__device__ __forceinline__ u32x4 bload16(__amdgpu_buffer_rsrc_t r, int voff, int soff) { return __builtin_bit_cast(u32x4, __builtin_amdgcn_raw_buffer_load_b128(r, voff, soff, 0)); }
__device__ __forceinline__ unsigned bload4(__amdgpu_buffer_rsrc_t r, int voff, int soff) { return (unsigned)__builtin_amdgcn_raw_buffer_load_b32(r, voff, soff, 0); }
__device__ __forceinline__ void bstore4(__amdgpu_buffer_rsrc_t r, unsigned v, int voff, int soff) { __builtin_amdgcn_raw_buffer_store_b32(v, r, voff, soff, 0); }
template <int W> __device__ __forceinline__ void pool_tile(__amdgpu_buffer_rsrc_t rxp, __amdgpu_buffer_rsrc_t rpo, int r0, int tile, int tid) {
    unsigned v[32 + W - 1];
#pragma unroll
    for (int i = 0; i < 32 + W - 1; ++i) v[i] = bload4(rxp, tid * 4, (r0 - (W - 1) + i) * 2048);
    float s0 = 0.f, s1 = 0.f;
#pragma unroll
    for (int i = 0; i < W - 1; ++i) { s0 += bf_lo(v[i]); s1 += bf_hi(v[i]); }
    constexpr float inv = 1.0f / (float)W;
#pragma unroll
    for (int i = 0; i < 32; ++i) {
        const float a0 = bf_lo(v[W - 1 + i]), a1 = bf_hi(v[W - 1 + i]);
        s0 += a0; s1 += a1;
        bstore4(rpo, cvt_pk_bf16(s0 * inv - a0, s1 * inv - a1), tid * 4, (tile * 32 + i) * 2048);
        s0 -= bf_lo(v[i]); s1 -= bf_hi(v[i]);
    }
}
__device__ __forceinline__ void phase_mix(const Params& p, LAS unsigned char* lds, int bid, int nb) {
    const int tid = threadIdx.x, lane = tid & 63, wave = tid >> 6;
    LAS unsigned* gl = (LAS unsigned*)lds;
    LAS float* red = (LAS float*)(lds + 62 * 2048);
    const __amdgpu_buffer_rsrc_t rxp = __builtin_amdgcn_make_buffer_rsrc((void*)p.xp, 0, RT * PWD * 2, 0x00020000);
    const __amdgpu_buffer_rsrc_t rgl = __builtin_amdgcn_make_buffer_rsrc((void*)p.glu, 0, RT * CWD * 2, 0x00020000);
    const __amdgpu_buffer_rsrc_t rpo = __builtin_amdgcn_make_buffer_rsrc((void*)p.pooledb, 0, SEQ * PWD * 2, 0x00020000);
    const __amdgpu_buffer_rsrc_t rcv = __builtin_amdgcn_make_buffer_rsrc((void*)p.cvnb, 0, SEQ * CWD * 2, 0x00020000);
    const __amdgpu_buffer_rsrc_t rww = __builtin_amdgcn_make_buffer_rsrc((void*)p.dw_w, 0, KS * CWD * 4, 0x00020000);
    const __amdgpu_buffer_rsrc_t rwb = __builtin_amdgcn_make_buffer_rsrc((void*)p.dw_b, 0, CWD * 4, 0x00020000);
    const __amdgpu_buffer_rsrc_t rlg = __builtin_amdgcn_make_buffer_rsrc((void*)p.ln_g, 0, CWD * 4, 0x00020000);
    const __amdgpu_buffer_rsrc_t rlb = __builtin_amdgcn_make_buffer_rsrc((void*)p.ln_b, 0, CWD * 4, 0x00020000);
    for (int tile = bid; tile < SEQ / 32; tile += nb) {
        const int r0 = 256 + tile * 32;
        __syncthreads();
#pragma unroll
        for (int j = 0; j < 16; ++j) { const int ch = j * NT + tid; if (ch < 62 * 128)
            *(LAS u32x4*)(lds + ch * 16) = bload16(rgl, tid * 16, (r0 - 30) * 2048 + j * 8192); }
        { const int g = __builtin_amdgcn_readfirstlane(tid >> 7);
          if (g == 0) pool_tile<2>(rxp, rpo, r0, tile, tid); else if (g == 1) pool_tile<4>(rxp, rpo, r0, tile, tid); else if (g == 2) pool_tile<8>(rxp, rpo, r0, tile, tid); else pool_tile<16>(rxp, rpo, r0, tile, tid); }
        __syncthreads();
#pragma unroll 1
        for (int hf = 0; hf < 2; ++hf) {
            float c0[16], c1[16];
            {
                float w0[KS], w1[KS];
#pragma unroll
                for (int k = 0; k < KS; ++k) { w0[k] = __uint_as_float(bload4(rww, tid * 8, k * 4096)); w1[k] = __uint_as_float(bload4(rww, tid * 8 + 4, k * 4096)); }
                const float b0 = __uint_as_float(bload4(rwb, tid * 8, 0)), b1 = __uint_as_float(bload4(rwb, tid * 8 + 4, 0));
#pragma unroll
                for (int i = 0; i < 16; ++i) { c0[i] = b0; c1[i] = b1; }
                const LAS unsigned* glh = gl + hf * 16 * 512 + tid;
#pragma unroll
                for (int rr = 0; rr < 46; ++rr) {
                    if ((rr & 7) == 0) asm volatile("" ::: "memory");
                    const unsigned vv = glh[rr * 512]; const float x0 = bf_lo(vv), x1 = bf_hi(vv);
#pragma unroll
                    for (int i = 0; i < 16; ++i) { const int k = rr - i; if (k >= 0 && k < KS) { c0[i] += x0 * w0[k]; c1[i] += x1 * w1[k]; } }
                }
            }
            asm volatile("" ::: "memory");
#pragma unroll
            for (int which = 0; which < 2; ++which) {
                float st[16];
#pragma unroll
                for (int i = 0; i < 16; ++i) st[i] = which == 0 ? c0[i] + c1[i] : c0[i] * c0[i] + c1[i] * c1[i];
#pragma unroll
                for (int lvl = 0; lvl < 4; ++lvl) {
                    const int o = 32 >> lvl, n = 8 >> lvl; const int mk = -((lane >> (5 - lvl)) & 1);
#pragma unroll
                    for (int j = 0; j < 8; ++j) if (j < n) st[j] = fsel(mk, st[j], st[j + n]) + __shfl_xor(fsel(mk, st[j + n], st[j]), o);
                }
                float tot = st[0] + __shfl_xor(st[0], 2); tot += __shfl_xor(tot, 1);
                if ((lane & 3) == 0) red[wave * 32 + which * 16 + (lane >> 2)] = tot;
            }
            __syncthreads();
            if (tid < 32) { float t = 0.f;
#pragma unroll
                for (int q = 0; q < 8; ++q) t += red[q * 32 + tid];
                red[256 + tid] = t; }
            __syncthreads();
            const float lg0 = __uint_as_float(bload4(rlg, tid * 8, 0)), lg1 = __uint_as_float(bload4(rlg, tid * 8 + 4, 0)), lb0 = __uint_as_float(bload4(rlb, tid * 8, 0)), lb1 = __uint_as_float(bload4(rlb, tid * 8 + 4, 0));
#pragma unroll
            for (int i = 0; i < 16; ++i) {
                const float s1 = red[256 + i], s2 = red[256 + 16 + i];
                const float mu = s1 * (1.0f / CWD), var = fmaxf(s2 * (1.0f / CWD) - mu * mu, 0.f), rs = rsqrtf(var + 1e-5f);
                const float y0 = (c0[i] - mu) * rs * lg0 + lb0, y1 = (c1[i] - mu) * rs * lg1 + lb1;
                bstore4(rcv, cvt_pk_bf16(y0 * sigmoidf_fast(y0), y1 * sigmoidf_fast(y1)), tid * 4, (tile * 32 + hf * 16 + i) * 2048);
            }
            __syncthreads();
        }
    }
}

struct EpiQ {
    const float* ssq; float* rstd; bf16_t* qb;
    __device__ __forceinline__ void operator()(const f32x4 (&acc)[2][2][4][2], const pg8::Unit& u, int wr, int wc, int fr, int fq) const {
#pragma unroll
        for (int ai = 0; ai < 2; ++ai)
#pragma unroll
            for (int m = 0; m < 4; ++m) {
                const size_t row = (size_t)(u.pm * 256 + ai * 128 + wr * 64 + m * 16 + fr);
                const f32x4* sp = (const f32x4*)(ssq + row * 32); f32x4 t = sp[0];
#pragma unroll
                for (int i = 1; i < 8; ++i) t += sp[i];
                const float rs = rsqrtf(((t[0] + t[1]) + (t[2] + t[3])) * (1.0f / D) + 1e-6f);
                if (u.pn == 0 && wc == 0 && fq == 0) rstd[row] = rs;
#pragma unroll
                for (int bj = 0; bj < 2; ++bj)
#pragma unroll
                    for (int n = 0; n < 2; ++n) { const int c = u.pn * 256 + bj * 128 + wc * 32 + n * 16 + fq * 4; const f32x4 v = acc[ai][bj][m][n] * rs;
                        u32x2 w; w.x = cvt_pk_bf16(v[0], v[1]); w.y = cvt_pk_bf16(v[2], v[3]);
                        *(u32x2*)(qb + row * D + c) = w; }
            }
    }
};

typedef float f32x16 __attribute__((ext_vector_type(16)));
__device__ __forceinline__ int okey(float s) { const int u = __float_as_int(s); return u ^ ((u >> 31) & 0x7fffffff); }
__device__ __forceinline__ float okey_inv(int k) { return __int_as_float(k ^ ((k >> 31) & 0x7fffffff)); }
__device__ __forceinline__ void sort16_desc(int (&v)[16]) {
#pragma unroll
    for (int k = 2; k <= 16; k <<= 1) {
#pragma unroll
        for (int j = k >> 1; j > 0; j >>= 1) {
#pragma unroll
            for (int i = 0; i < 16; ++i) {
                const int l = i ^ j;
                if (l > i) { const bool desc = (i & k) == 0; const int hi = max(v[i], v[l]), lo = min(v[i], v[l]); v[i] = desc ? hi : lo; v[l] = desc ? lo : hi; }
            }
        }
    }
}
__device__ __forceinline__ void merge16_desc(int (&a)[16], const int (&b)[16]) {
#pragma unroll
    for (int i = 0; i < 16; ++i) a[i] = max(a[i], b[15 - i]);
#pragma unroll
    for (int j = 8; j > 0; j >>= 1) {
#pragma unroll
        for (int i = 0; i < 16; ++i) { const int l = i ^ j; if (l > i) { const int hi = max(a[i], a[l]), lo = min(a[i], a[l]); a[i] = hi; a[l] = lo; } }
    }
}
__device__ __forceinline__ void pair_merge(int (&a)[16]) {
    int b[16];
#pragma unroll
    for (int i = 0; i < 16; ++i) b[i] = __shfl_xor(a[i], 32);
    merge16_desc(a, b);
}
constexpr int CELL_I[64] = {0,0,0,0,0,0,0,0,0,0,0,0,0,0,0,0,1,1,1,1,1,1,1,1,2,2,2,2,2,3,3,3,3,4,4,4,5,5,6,6,7,7,8,9,10,11,12,13,14,15,0,0,0,0,0,0,0,0,0,0,0,0,0,0};
constexpr int CELL_J[64] = {0,1,2,3,4,5,6,7,8,9,10,11,12,13,14,15,0,1,2,3,4,5,6,7,0,1,2,3,4,0,1,2,3,0,1,2,0,1,0,1,0,1,0,0,0,0,0,0,0,0,0,0,0,0,0,0,0,0,0,0,0,0,0,0};
constexpr int NCELL = 50;

__device__ __forceinline__ void phase_topk2(const Params& p, LAS unsigned char* lds, int bid, int nb) {
    const int tid = threadIdx.x, lane = tid & 63, wave = tid >> 6, hh = lane >> 5, l31 = lane & 31;
    LAS int* sit = (LAS int*)(lds + wave * 8448 + lane * 132);
    const int gw = bid * 8 + wave, NGW = nb * 8;
    for (int item = gw; item < (SEQ / 32) * 8; item += NGW) {
        const int h = item & 7, tok0 = (item >> 3) * 32;
        float sv[2][16];
#pragma unroll
        for (int ph = 0; ph < 2; ++ph) {
            const bf16_t* qrow = p.qb + (size_t)(tok0 + l31) * D + h * 256 + ph * 128 + 8 * hh;
            const bf16_t* krow = p.keysb + ((size_t)(h * 2 + ph) * 128 + l31) * 128 + 8 * hh;
            bf16x8 bq[8];
#pragma unroll
            for (int ks = 0; ks < 8; ++ks) bq[ks] = *(const bf16x8*)(qrow + ks * 16);
            int top[16];
#pragma unroll
            for (int kt = 0; kt < 4; ++kt) {
                f32x16 c = {0.f, 0.f, 0.f, 0.f, 0.f, 0.f, 0.f, 0.f, 0.f, 0.f, 0.f, 0.f, 0.f, 0.f, 0.f, 0.f};
#pragma unroll
                for (int ks = 0; ks < 8; ++ks) { const bf16x8 ak = *(const bf16x8*)(krow + (size_t)kt * 32 * 128 + ks * 16);
                    c = __builtin_amdgcn_mfma_f32_32x32x16_bf16(ak, bq[ks], c, 0, 0, 0); }
                int v[16];
#pragma unroll
                for (int r = 0; r < 16; ++r) { const int base = kt * 32 + (r & 3) + 8 * (r >> 2);
                    v[r] = ((okey(c[r]) & ~127) | (127 - base)) ^ (hh << 2); }
                sort16_desc(v);
                if (kt == 0) {
#pragma unroll
                    for (int i = 0; i < 16; ++i) top[i] = v[i];
                } else merge16_desc(top, v);
            }
            pair_merge(top);
#pragma unroll
            for (int i = 0; i < 16; ++i) { sv[ph][i] = okey_inv(top[i] & ~127); sit[ph * 16 + i] = 127 - (top[i] & 127); }
        }
        int w0[16], w1[16];
#pragma unroll
        for (int s = 0; s < 32; ++s) {
            const int e0 = 2 * s, e1 = 2 * s + 1;
            int key;
            if (e0 >= NCELL) key = (int)0x80000000;
            else {
                const float v0 = sv[0][CELL_I[e0]] + sv[1][CELL_J[e0]];
                const int k0 = (okey(v0) & ~255) | (255 - (CELL_I[e0] * 16 + CELL_J[e0]));
                if (e1 >= NCELL) key = hh ? (int)0x80000000 : k0;
                else { const float v1 = sv[0][CELL_I[e1]] + sv[1][CELL_J[e1]];
                    const int k1 = (okey(v1) & ~255) | (255 - (CELL_I[e1] * 16 + CELL_J[e1]));
                    key = hh ? k1 : k0; }
            }
            if (s < 16) w0[s] = key; else w1[s - 16] = key;
        }
        sort16_desc(w0); sort16_desc(w1); merge16_desc(w0, w1); pair_merge(w0);
        const float mx = okey_inv(w0[0] & ~255);
        float sum = 0.f;
#pragma unroll
        for (int k = 0; k < 16; ++k) sum += __expf(okey_inv(w0[k] & ~255) - mx);
        const float inv = 1.0f / sum;
        int eo[8]; float go[8]; const int hmask = -hh;
#pragma unroll
        for (int k = 0; k < 8; ++k) { const int kk = (w0[k] & ~hmask) | (w0[8 + k] & hmask); const int cc = 255 - (kk & 255);
            eo[k] = sit[cc >> 4] * 128 + sit[16 + (cc & 15)]; go[k] = __expf(okey_inv(kk & ~255) - mx) * inv; }
        float so[8];
#pragma unroll
        for (int k = 0; k < 8; ++k) { go[k] *= p.sup[eo[k]]; so[k] = p.sdn[eo[k]]; }
        const size_t ob = (size_t)(tok0 + l31) * 128 + h * 16 + hh * 8;
        *(u32x4*)(p.idx + ob) = (u32x4){(unsigned)eo[0], (unsigned)eo[1], (unsigned)eo[2], (unsigned)eo[3]};
        *(u32x4*)(p.idx + ob + 4) = (u32x4){(unsigned)eo[4], (unsigned)eo[5], (unsigned)eo[6], (unsigned)eo[7]};
        *(f32x4*)(p.gsu + ob) = (f32x4){go[0], go[1], go[2], go[3]};
        *(f32x4*)(p.gsu + ob + 4) = (f32x4){go[4], go[5], go[6], go[7]};
        *(f32x4*)(p.sdv + ob) = (f32x4){so[0], so[1], so[2], so[3]};
        *(f32x4*)(p.sdv + ob + 4) = (f32x4){so[4], so[5], so[6], so[7]};
    }
}


typedef float f32x2 __attribute__((ext_vector_type(2)));
template <int N> __device__ __forceinline__ f32x2 dot16_fp8(const u32x4 w, const f32x2 (&x)[N], int o, f32x2 acc) {
    const unsigned ww[4] = {w.x, w.y, w.z, w.w};
#pragma unroll
    for (int d = 0; d < 4; ++d) { acc += __builtin_amdgcn_cvt_pk_f32_fp8((int)ww[d], false) * x[o + 2 * d]; acc += __builtin_amdgcn_cvt_pk_f32_fp8((int)ww[d], true) * x[o + 2 * d + 1]; }
    return acc;
}
template <int N> __device__ __forceinline__ void axpy16_fp8(const u32x4 w, float a, f32x2 (&y)[N], int o) {
    const unsigned ww[4] = {w.x, w.y, w.z, w.w}; const f32x2 a2 = {a, a};
#pragma unroll
    for (int d = 0; d < 4; ++d) { y[o + 2 * d] += a2 * __builtin_amdgcn_cvt_pk_f32_fp8((int)ww[d], false); y[o + 2 * d + 1] += a2 * __builtin_amdgcn_cvt_pk_f32_fp8((int)ww[d], true); }
}
__device__ __forceinline__ void bstore16(__amdgpu_buffer_rsrc_t r, f32x4 v, int voff, int soff) { __builtin_amdgcn_raw_buffer_store_b128(__builtin_bit_cast(__attribute__((__vector_size__(4 * sizeof(unsigned)))) unsigned, v), r, voff, soff, 0); }
__device__ __forceinline__ void bstore8(__amdgpu_buffer_rsrc_t r, f32x2 v, int voff, int soff) { __builtin_amdgcn_raw_buffer_store_b64(__builtin_bit_cast(__attribute__((__vector_size__(2 * sizeof(unsigned)))) unsigned, v), r, voff, soff, 0); }
__device__ __forceinline__ f32x2 fsel2(int mask, f32x2 a, f32x2 b) { return (f32x2){fsel(mask, a.x, b.x), fsel(mask, a.y, b.y)}; }
__device__ __forceinline__ f32x2 shx2(f32x2 a, int o) { return (f32x2){__shfl_xor(a.x, o), __shfl_xor(a.y, o)}; }

__device__ __forceinline__ void phase_pd(const Params& p, int bid, int nb) {
    const int tid = threadIdx.x, lane = tid & 63, wave = __builtin_amdgcn_readfirstlane(tid >> 6);
    const int v = bid & 7, lw = (bid >> 3) * 8 + wave, NLW = (nb >> 3) * 8;
    const int c = lane & 7, sub = lane >> 3;
    const int m0 = -(lane & 1), m1 = -((lane >> 1) & 1), m2 = -((lane >> 2) & 1);
    const __amdgpu_buffer_rsrc_t rd = __builtin_amdgcn_make_buffer_rsrc((void*)p.down8, 0, 16384 * D, 0x00020000);
    const __amdgpu_buffer_rsrc_t rh = __builtin_amdgcn_make_buffer_rsrc((void*)p.h2b, 0, SEQ * D * 2, 0x00020000);
    const __amdgpu_buffer_rsrc_t rg1 = __builtin_amdgcn_make_buffer_rsrc((void*)p.ffn_g, 0, D * 4, 0x00020000);
    const __amdgpu_buffer_rsrc_t ri = __builtin_amdgcn_make_buffer_rsrc((void*)p.idx, 0, SEQ * 128 * 4, 0x00020000);
    const __amdgpu_buffer_rsrc_t rrs = __builtin_amdgcn_make_buffer_rsrc((void*)p.rstd, 0, SEQ * 4, 0x00020000);
    const __amdgpu_buffer_rsrc_t rp = __builtin_amdgcn_make_buffer_rsrc((void*)p.part, 0, SEQ * 16 * 128 * 2, 0x00020000);
    const int vsub = sub * 64, vc2 = c * 32, vc1 = c * 16, vl4 = lane * 4;
#pragma unroll 1
    for (int pass = 0; pass < 2; ++pass) {
        const int sl = v * 2 + pass;
        f32x2 gs[8];
#pragma unroll
        for (int i = 0; i < 4; ++i) { const f32x4 g = __builtin_bit_cast(f32x4, bload16(rg1, c * 64, sl * 512 + i * 16)); gs[2 * i] = (f32x2){g[0], g[1]}; gs[2 * i + 1] = (f32x2){g[2], g[3]}; }
        u32x4 ix[4], hh[2]; unsigned rsb;
        {
            const int t = lw;
#pragma unroll
            for (int i = 0; i < 4; ++i) ix[i] = bload16(ri, vsub, t * 512 + i * 16);
            hh[0] = bload16(rh, vc2, t * 4096 + sl * 256); hh[1] = bload16(rh, vc2, t * 4096 + sl * 256 + 16); rsb = bload4(rrs, 0, t * 4);
        }
#pragma unroll 1
        for (int t = lw; t < SEQ; t += NLW) {
            asm volatile("" ::: "memory");
            u32x4 w[16];
            {
                const unsigned e[16] = {ix[0].x, ix[0].y, ix[0].z, ix[0].w, ix[1].x, ix[1].y, ix[1].z, ix[1].w, ix[2].x, ix[2].y, ix[2].z, ix[2].w, ix[3].x, ix[3].y, ix[3].z, ix[3].w};
#pragma unroll
                for (int g = 0; g < 16; ++g) w[g] = bload16(rd, (int)(e[g] * 2048u) + vc1, sl * 128);
            }
            f32x2 xs[8];
            {
                const float rs = __uint_as_float(rsb);
                const unsigned hw[8] = {hh[0].x, hh[0].y, hh[0].z, hh[0].w, hh[1].x, hh[1].y, hh[1].z, hh[1].w};
#pragma unroll
                for (int i = 0; i < 8; ++i) xs[i] = (f32x2){bf_lo(hw[i]) * rs, bf_hi(hw[i]) * rs} * gs[i];
            }
            asm volatile("" ::: "memory");
            {
                const int tn = t + NLW < SEQ ? t + NLW : t;
#pragma unroll
                for (int i = 0; i < 4; ++i) ix[i] = bload16(ri, vsub, tn * 512 + i * 16);
                hh[0] = bload16(rh, vc2, tn * 4096 + sl * 256); hh[1] = bload16(rh, vc2, tn * 4096 + sl * 256 + 16); rsb = bload4(rrs, 0, tn * 4);
            }
            asm volatile("" ::: "memory");
            float r[16];
#pragma unroll
            for (int g = 0; g < 16; ++g) { const f32x2 z = {0.f, 0.f}; const f32x2 s2 = dot16_fp8(w[g], xs, 0, z); r[g] = s2.x + s2.y; }
            float k8[8], k4[4];
#pragma unroll
            for (int i = 0; i < 8; ++i) k8[i] = fsel(m2, r[i], r[i + 8]) + __shfl_xor(fsel(m2, r[i + 8], r[i]), 4);
#pragma unroll
            for (int i = 0; i < 4; ++i) k4[i] = fsel(m1, k8[i], k8[i + 4]) + __shfl_xor(fsel(m1, k8[i + 4], k8[i]), 2);
            const float k0 = fsel(m0, k4[0], k4[2]) + __shfl_xor(fsel(m0, k4[2], k4[0]), 1);
            const float k1 = fsel(m0, k4[1], k4[3]) + __shfl_xor(fsel(m0, k4[3], k4[1]), 1);
            bstore4(rp, cvt_pk_bf16(k0, k1), vl4, (t * 16 + sl) * 256);
        }
    }
}
__device__ __forceinline__ void phase_pa(const Params& p, int bid, int nb) {
    const int tid = threadIdx.x, lane = tid & 63, wave = tid >> 6;
    const int gw = bid * 8 + wave, NGW = nb * 8;
    for (int it = gw; it < SEQ * 2; it += NGW) {
        const int t = it >> 1, pp = (it & 1) * 64 + lane;
        const bf16_t* pr = p.part + (size_t)t * 2048 + pp;
        float hs = 0.f;
#pragma unroll
        for (int sl = 0; sl < 16; ++sl) hs += __uint_as_float((unsigned)pr[sl * 128] << 16);
        hs *= p.sdv[(size_t)t * 128 + pp];
        p.act[(size_t)t * 128 + pp] = p.gsu[(size_t)t * 128 + pp] * 0.5f * hs * (1.0f + erff(hs * 0.70710678118654752f));
    }
}
__device__ __forceinline__ void phase_pu(const Params& p, int bid, int nb) {
    const int tid = threadIdx.x, lane = tid & 63, wave = __builtin_amdgcn_readfirstlane(tid >> 6);
    const int v = bid & 7, lw = (bid >> 3) * 8 + wave, NLW = (nb >> 3) * 8;
    const int c = lane & 7, sub = lane >> 3;
    const int m3 = -((lane >> 3) & 1), m4 = -((lane >> 4) & 1), m5 = -((lane >> 5) & 1);
    const __amdgpu_buffer_rsrc_t ru = __builtin_amdgcn_make_buffer_rsrc((void*)p.up8, 0, 16384 * D, 0x00020000);
    const __amdgpu_buffer_rsrc_t rh = __builtin_amdgcn_make_buffer_rsrc((void*)p.h2b, 0, SEQ * D * 2, 0x00020000);
    const __amdgpu_buffer_rsrc_t ri = __builtin_amdgcn_make_buffer_rsrc((void*)p.idx, 0, SEQ * 128 * 4, 0x00020000);
    const __amdgpu_buffer_rsrc_t ra = __builtin_amdgcn_make_buffer_rsrc((void*)p.act, 0, SEQ * 128 * 4, 0x00020000);
    const __amdgpu_buffer_rsrc_t ro = __builtin_amdgcn_make_buffer_rsrc((void*)p.out, 0, SEQ * D * 4, 0x00020000);
    const __amdgpu_buffer_rsrc_t rq = __builtin_amdgcn_make_buffer_rsrc((void*)p.ssq2, 0, SEQ * 16 * 4, 0x00020000);
    const int vsub = sub * 64, vc1 = c * 16, vh = c * 32 + sub * 4, vo = c * 64 + sub * 8;
#pragma unroll 1
    for (int pass = 0; pass < 2; ++pass) {
        const int sl = v * 2 + pass;
        u32x4 ix[4], ac[4]; unsigned hb;
        {
            const int t = lw;
#pragma unroll
            for (int i = 0; i < 4; ++i) { ix[i] = bload16(ri, vsub, t * 512 + i * 16); ac[i] = bload16(ra, vsub, t * 512 + i * 16); }
            hb = bload4(rh, vh, t * 4096 + sl * 256);
        }
#pragma unroll 1
        for (int t = lw; t < SEQ; t += NLW) {
            asm volatile("" ::: "memory");
            u32x4 w[16];
            {
                const unsigned e[16] = {ix[0].x, ix[0].y, ix[0].z, ix[0].w, ix[1].x, ix[1].y, ix[1].z, ix[1].w, ix[2].x, ix[2].y, ix[2].z, ix[2].w, ix[3].x, ix[3].y, ix[3].z, ix[3].w};
#pragma unroll
                for (int g = 0; g < 16; ++g) w[g] = bload16(ru, (int)(e[g] * 2048u) + vc1, sl * 128);
            }
            const float a[16] = {__uint_as_float(ac[0].x), __uint_as_float(ac[0].y), __uint_as_float(ac[0].z), __uint_as_float(ac[0].w), __uint_as_float(ac[1].x), __uint_as_float(ac[1].y), __uint_as_float(ac[1].z), __uint_as_float(ac[1].w),
                                 __uint_as_float(ac[2].x), __uint_as_float(ac[2].y), __uint_as_float(ac[2].z), __uint_as_float(ac[2].w), __uint_as_float(ac[3].x), __uint_as_float(ac[3].y), __uint_as_float(ac[3].z), __uint_as_float(ac[3].w)};
            const unsigned hcur = hb;
            asm volatile("" ::: "memory");
            {
                const int tn = t + NLW < SEQ ? t + NLW : t;
#pragma unroll
                for (int i = 0; i < 4; ++i) { ix[i] = bload16(ri, vsub, tn * 512 + i * 16); ac[i] = bload16(ra, vsub, tn * 512 + i * 16); }
                hb = bload4(rh, vh, tn * 4096 + sl * 256);
            }
            asm volatile("" ::: "memory");
            f32x2 acc[8];
#pragma unroll
            for (int i = 0; i < 8; ++i) acc[i] = (f32x2){0.f, 0.f};
#pragma unroll
            for (int g = 0; g < 16; ++g) axpy16_fp8(w[g], a[g], acc, 0);
            f32x2 k4[4], k2[2];
#pragma unroll
            for (int i = 0; i < 4; ++i) k4[i] = fsel2(m5, acc[i], acc[i + 4]) + shx2(fsel2(m5, acc[i + 4], acc[i]), 32);
#pragma unroll
            for (int i = 0; i < 2; ++i) k2[i] = fsel2(m4, k4[i], k4[i + 2]) + shx2(fsel2(m4, k4[i + 2], k4[i]), 16);
            f32x2 h3 = fsel2(m3, k2[0], k2[1]) + shx2(fsel2(m3, k2[1], k2[0]), 8);
            h3 += (f32x2){bf_lo(hcur), bf_hi(hcur)};
            bstore8(ro, h3, vo, t * 8192 + sl * 512);
            const float ss = wave_sum(h3.x * h3.x + h3.y * h3.y);
            if (lane == 0) bstore4(rq, __float_as_uint(ss), 0, (t * 16 + sl) * 4);
        }
    }
}
__device__ __forceinline__ void phase_pf(const Params& p, int bid, int nb) {
    const int tid = threadIdx.x, lane = tid & 63, wave = tid >> 6;
    const int gw = bid * 8 + wave, NGW = nb * 8;
    for (int t = gw; t < SEQ; t += NGW) {
        const f32x4* sp = (const f32x4*)(p.ssq2 + (size_t)t * 16); f32x4 q = sp[0] + sp[1] + sp[2] + sp[3];
        const float rf = rsqrtf(((q[0] + q[1]) + (q[2] + q[3])) * (1.0f / D) + 1e-6f);
        f32x4* o = (f32x4*)(p.out + (size_t)t * D) + lane; const f32x4* g = (const f32x4*)p.fin_g + lane;
#pragma unroll
        for (int j = 0; j < 8; ++j) o[64 * j] = o[64 * j] * rf * g[64 * j];
    }
}

__device__ __forceinline__ void fp8_row(const float* src, unsigned char* dst, float* inv_scale, int lane) {
    f32x4 v[2][4]; float am = 0.f;
#pragma unroll
    for (int k = 0; k < 2; ++k)
#pragma unroll
        for (int i = 0; i < 4; ++i) { v[k][i] = *(const f32x4*)(src + 1024 * k + 16 * lane + 4 * i);
            am = fmaxf(am, fmaxf(fmaxf(fabsf(v[k][i].x), fabsf(v[k][i].y)), fmaxf(fabsf(v[k][i].z), fabsf(v[k][i].w)))); }
#pragma unroll
    for (int o = 1; o < 64; o <<= 1) am = fmaxf(am, __shfl_xor(am, o));
    int be = (__float_as_int(am) >> 23) & 255; be = be < 8 ? 8 : (be > 248 ? 248 : be);
    const float sc = __int_as_float((260 - be) << 23), isc = __int_as_float((be - 6) << 23);
#pragma unroll
    for (int k = 0; k < 2; ++k) { u32x4 w; unsigned ww[4];
#pragma unroll
        for (int i = 0; i < 4; ++i) { int t = 0; t = __builtin_amdgcn_cvt_pk_fp8_f32(v[k][i].x * sc, v[k][i].y * sc, t, false); t = __builtin_amdgcn_cvt_pk_fp8_f32(v[k][i].z * sc, v[k][i].w * sc, t, true); ww[i] = (unsigned)t; }
        w.x = ww[0]; w.y = ww[1]; w.z = ww[2]; w.w = ww[3];
        *(u32x4*)(dst + 1024 * k + 16 * lane) = w; }
    if (lane == 0) *inv_scale = isc;
}

__device__ __forceinline__ void tr_item(const float* W, int ldw, int srccol0, int k0, bf16_t* WT, int ldt, int n0, const float* kscale, const float* nscale, LAS float* scr, int lane) {
#pragma unroll 8
    for (int i = 0; i < 32; ++i) { const int kk = 2 * i + (lane >> 5); float v = W[(size_t)(k0 + kk) * ldw + srccol0 + (lane & 31)];
        if (kscale) v *= kscale[k0 + kk]; if (nscale) v *= nscale[srccol0 + (lane & 31)]; scr[kk * 33 + (lane & 31)] = v; }
    asm volatile("s_waitcnt lgkmcnt(0)" ::: "memory");
    const int c = lane & 7;
#pragma unroll
    for (int j = 0; j < 4; ++j) { const int n = (lane >> 3) + 8 * j; const LAS float* s = scr + (8 * c) * 33 + n;
        u32x4 o; o.x = cvt_pk_bf16(s[0 * 33], s[1 * 33]); o.y = cvt_pk_bf16(s[2 * 33], s[3 * 33]); o.z = cvt_pk_bf16(s[4 * 33], s[5 * 33]); o.w = cvt_pk_bf16(s[6 * 33], s[7 * 33]);
        *(u32x4*)(WT + (size_t)(n0 + n) * ldt + k0 + 8 * c) = o; }
    asm volatile("s_waitcnt lgkmcnt(0)" ::: "memory");
}
__device__ __forceinline__ int win_srccol(int n) { const int pn = n >> 8, w = n & 255; return pn < 4 ? n : ((w >> 7) ? 2048 : 1024) + (pn - 4) * 128 + (w & 127); }

__device__ __forceinline__ void phase_prep(const Params& p, LAS unsigned char* lds, int bid, int nb) {
    const int tid = threadIdx.x, lane = tid & 63, wave = tid >> 6;
    const int gw = bid * 8 + wave, NGW = nb * 8;
    LAS float* scr = (LAS float*)(lds + wave * 8448);
    for (int r = gw; r < RT; r += NGW) {
        unsigned long long* o8 = (unsigned long long*)(p.hnb + (size_t)r * D) + lane;
        if (r < RPAD) {
#pragma unroll
            for (int j = 0; j < 8; ++j) o8[64 * j] = 0ull;
        } else {
            const f32x4* xr = (const f32x4*)hrow(p, r - RPAD) + lane;
            const f32x4* gr = (const f32x4*)p.mix_g + lane;
            f32x4 v[8]; float s = 0.f;
#pragma unroll
            for (int j = 0; j < 8; ++j) { v[j] = xr[64 * j]; s += (v[j].x * v[j].x + v[j].y * v[j].y) + (v[j].z * v[j].z + v[j].w * v[j].w); }
            const float rs = rsqrtf(wave_sum(s) * (1.0f / D) + 1e-6f);
#pragma unroll
            for (int j = 0; j < 8; ++j) { const f32x4 gv = gr[64 * j];
                o8[64 * j] = (unsigned long long)cvt_pk_bf16(v[j].x * rs * gv.x, v[j].y * rs * gv.y) | ((unsigned long long)cvt_pk_bf16(v[j].z * rs * gv.z, v[j].w * rs * gv.w) << 32); }
        }
    }
    for (int it = gw; it < (D / 64) * (INW / 32); it += NGW) {
        const int kb = it / (INW / 32), nbk = it % (INW / 32);
        tr_item(p.w_in, INW, win_srccol(nbk * 32), kb * 64, p.w_in_t, D, nbk * 32, nullptr, nullptr, scr, lane);
    }
    for (int it = gw; it < 4 * 4 * 8; it += NGW) { const int g = it >> 5, kb = (it >> 3) & 3, nbk = it & 7;
        tr_item(p.pool_w + (size_t)g * 65536, 256, nbk * 32, kb * 64, p.pool_wt + (size_t)g * 65536, 256, nbk * 32, nullptr, p.pool_scale + g * 256, scr, lane); }
    for (int it = gw; it < 16 * 32; it += NGW) { const int kb = it >> 5, nbk = it & 31;
        tr_item(p.pw_w, CWD, nbk * 32, kb * 64, p.pw_t, CWD, nbk * 32, nullptr, nullptr, scr, lane); }
    for (int it = gw; it < 32 * 64; it += NGW) { const int kb = it >> 6, nbk = it & 63;
        tr_item(p.w_out, D, nbk * 32, kb * 64, p.w_out_t, D, nbk * 32, nullptr, nullptr, scr, lane); }
    for (int it = gw; it < 32 * 64; it += NGW) { const int kb = it >> 6, nbk = it & 63;
        tr_item(p.wq, D, nbk * 32, kb * 64, p.wq_t, D, nbk * 32, p.ffn_g, nullptr, scr, lane); }
    for (int i = gw * 64 + lane; i < 8 * 2 * 128 * 128 / 4; i += NGW * 64) { const f32x4 v = ((const f32x4*)p.keys)[i];
        u32x2 w; w.x = cvt_pk_bf16(v[0], v[1]); w.y = cvt_pk_bf16(v[2], v[3]); ((u32x2*)p.keysb)[i] = w; }
    for (int e = gw; e < 2 * 16384; e += NGW) {
        if (e < 16384) fp8_row(p.down + (size_t)e * D, p.down8 + (size_t)e * D, p.sdn + e, lane);
        else fp8_row(p.up + (size_t)(e - 16384) * D, p.up8 + (size_t)(e - 16384) * D, p.sup + (e - 16384), lane);
    }
}


#define XB_TMO      128
#define XB_XCNT(j)  (256  + 64 * (j))
#define XB_XSUB(j)  (1280 + 64 * (j))
#define XB_XGEN(j)  (2304 + 64 * (j))
#define XB_TOP      3328
#define XB_TOPGEN   3392
#define XCD_BAR_WORDS 3456
#define XB_SPIN_CAP (1u << 18)
__device__ __forceinline__ unsigned xb_ld(unsigned* p)              { return __hip_atomic_load(p, __ATOMIC_RELAXED, __HIP_MEMORY_SCOPE_AGENT); }
__device__ __forceinline__ unsigned xb_add(unsigned* p, unsigned v) { return __hip_atomic_fetch_add(p, v, __ATOMIC_RELAXED, __HIP_MEMORY_SCOPE_AGENT); }
__device__ __forceinline__ unsigned xb_xcc_id() { return (unsigned)__builtin_amdgcn_s_getreg((3 << 11) | 20) & 0xFu; }
#define XB_SPIN(cond, bar) do { unsigned _sp = 0; while (cond) { __builtin_amdgcn_s_sleep(1); \
    if ((++_sp & 255u) == 0u) { if (xb_ld(&(bar)[XB_TMO])) break; if (_sp > XB_SPIN_CAP) { atomicAdd(&(bar)[XB_TMO], 1u); break; } } } } while (0)
struct XcdBarrier { unsigned* bar; unsigned x; volatile LAS unsigned* st; };
__device__ __forceinline__ XcdBarrier xcd_barrier_post(unsigned* bar, volatile LAS unsigned* st) {
    XcdBarrier b; b.bar = bar; b.x = xb_xcc_id(); b.st = st;
    if (threadIdx.x == 0) (void)xb_add(&bar[XB_XCNT(b.x)], 1u);
    return b;
}
__device__ __forceinline__ void xcd_barrier_complete(unsigned* bar, unsigned x, unsigned& nloc, unsigned& nx) {
    const unsigned G = gridDim.x * gridDim.y * gridDim.z;
    unsigned sum, cnt, mine, sp = 0u;
    for (;;) {
        sum = 0u; cnt = 0u; mine = 0u;
#pragma unroll
        for (unsigned j = 0; j < 16; ++j) { const unsigned c = xb_ld(&bar[XB_XCNT(j)]); sum += c; cnt += (c > 0u) ? 1u : 0u; mine = (j == x) ? c : mine; }
        if (sum == G) break;
        __builtin_amdgcn_s_sleep(1);
        if ((++sp & 255u) == 0u) { if (xb_ld(&bar[XB_TMO])) break; if (sp > XB_SPIN_CAP) { atomicAdd(&bar[XB_TMO], 1u); break; } }
    }
    nloc = mine > 0u ? mine : 1u; nx = cnt > 0u ? cnt : 1u;
}
__device__ __forceinline__ void xcd_barrier(const XcdBarrier& b) {
    asm volatile("s_waitcnt vmcnt(0)" ::: "memory");
    __syncthreads();
    if (threadIdx.x == 0) {
        unsigned* bar = b.bar;
        __builtin_amdgcn_s_waitcnt(0);
        unsigned nloc = b.st[0], nx = b.st[1];
        if (nloc == 0u) { xcd_barrier_complete(bar, b.x, nloc, nx); b.st[0] = nloc; b.st[1] = nx; }
        const unsigned old = xb_add(&bar[XB_XSUB(b.x)], 1u);
        const unsigned gen = old / nloc;
        if (old + 1u == (gen + 1u) * nloc) {
            __builtin_amdgcn_fence(__ATOMIC_RELEASE, "agent");
            asm volatile("s_waitcnt vmcnt(0)" ::: "memory");
            const unsigned og = xb_add(&bar[XB_TOP], 1u);
            const unsigned tg = og / nx;
            if (og + 1u == (tg + 1u) * nx) xb_add(&bar[XB_TOPGEN], 1u);
            else XB_SPIN(xb_ld(&bar[XB_TOPGEN]) == tg, bar);
            __builtin_amdgcn_fence(__ATOMIC_ACQUIRE, "agent");
            xb_add(&bar[XB_XGEN(b.x)], 1u);
            asm volatile("s_waitcnt vmcnt(0)" ::: "memory");
        } else {
            XB_SPIN(xb_ld(&bar[XB_XGEN(b.x)]) == gen, bar);
            __builtin_amdgcn_fence(__ATOMIC_ACQUIRE, "agent");
            asm volatile("s_waitcnt vmcnt(0)" ::: "memory");
        }
    }
    __syncthreads();
}

__global__ void __launch_bounds__(NT, 2) k_mega(Params p) {
    extern __shared__ __attribute__((aligned(16))) unsigned char lds_raw[];
    LAS unsigned char* lds = (LAS unsigned char*)lds_raw;
    cg::grid_group grid = cg::this_grid();
    const int bid = blockIdx.x, nb = gridDim.x;
    volatile LAS unsigned* bst = (volatile LAS unsigned*)(lds + 131072);
    if (threadIdx.x < 4) bst[threadIdx.x] = 0u;
    __syncthreads();
    const XcdBarrier xb = xcd_barrier_post(p.bar, bst);
    phase_prep(p, lds, bid, nb);
    grid.sync();
    { pg8::Gemm g{p.hnb, p.w_in_t, D, D, D, 0}; pg8::StaticOrder S; S.init(RT / 256, INW / 256, nb, bid); EpiProj E{p.xp, p.glu};
      pg8::gemm_phase<EpiProj, pg8::StaticOrder>(lds, g, S, E); }
    xcd_barrier(xb);
    phase_mix(p, lds, bid, nb);
    xcd_barrier(xb);
    if (bid < nb / 2) { pg8::Gemm g{p.pooledb, p.pool_wt, PWD, 256, 256, 256}; pg8::StaticOrder S; S.init(SEQ / 256, 4, nb / 2, bid); EpiBf16Out E{p.yabb, D, 0, nullptr};
      pg8::gemm_phase<EpiBf16Out, pg8::StaticOrder>(lds, g, S, E); }
    else { pg8::Gemm g{p.cvnb, p.pw_t, CWD, CWD, CWD, 0}; pg8::StaticOrder S; S.init(SEQ / 256, 4, nb - nb / 2, bid - nb / 2); EpiBf16Out E{p.yabb, D, PWD, p.pw_b};
      pg8::gemm_phase<EpiBf16Out, pg8::StaticOrder>(lds, g, S, E); }
    xcd_barrier(xb);
    { pg8::Gemm g{p.yabb, p.w_out_t, D, D, D, 0}; pg8::StaticOrder S; S.init(SEQ / 256, D / 256, nb, bid); EpiResid E{p.x, p.h2b, p.ssq};
      pg8::gemm_phase<EpiResid, pg8::StaticOrder>(lds, g, S, E); }
    xcd_barrier(xb);
    { pg8::Gemm g{p.h2b, p.wq_t, D, D, D, 0}; pg8::StaticOrder S; S.init(SEQ / 256, D / 256, nb, bid); EpiQ E{p.ssq, p.rstd, p.qb};
      pg8::gemm_phase<EpiQ, pg8::StaticOrder>(lds, g, S, E); }
    xcd_barrier(xb);
    phase_topk2(p, lds, bid, nb);
    xcd_barrier(xb);
    phase_pd(p, bid, nb);
    xcd_barrier(xb);
    phase_pa(p, bid, nb);
    xcd_barrier(xb);
    phase_pu(p, bid, nb);
    xcd_barrier(xb);
    phase_pf(p, bid, nb);
}

extern "C" void kernel_launch(void* const* d_in, const int* in_sizes, int n_in, void* d_out, int out_size, void* d_ws, size_t ws_size, hipStream_t stream) {
    Params p{};
    p.x = (const float*)d_in[0]; p.meta = (const float*)d_in[1]; p.mix_g = (const float*)d_in[2]; p.w_in = (const float*)d_in[3];
    p.pool_w = (const float*)d_in[4]; p.pool_scale = (const float*)d_in[5]; p.dw_w = (const float*)d_in[6]; p.dw_b = (const float*)d_in[7];
    p.ln_g = (const float*)d_in[8]; p.ln_b = (const float*)d_in[9]; p.pw_w = (const float*)d_in[10]; p.pw_b = (const float*)d_in[11];
    p.w_out = (const float*)d_in[12]; p.ffn_g = (const float*)d_in[13]; p.wq = (const float*)d_in[14]; p.keys = (const float*)d_in[15];
    p.down = (const float*)d_in[16]; p.up = (const float*)d_in[17]; p.fin_g = (const float*)d_in[18];
    p.out = (float*)d_out;
    char* w = (char*)d_ws; size_t off = 0;
    auto take = [&](size_t bytes) { char* r = w + off; off += (bytes + 255) & ~(size_t)255; return r; };
    p.idx = (int*)take((size_t)SEQ * 128 * 4);
    p.gsu = (float*)take((size_t)SEQ * 128 * 4);
    p.part = (bf16_t*)take((size_t)SEQ * 16 * 128 * 2);
    p.act = (float*)take((size_t)SEQ * 128 * 4);
    p.ssq2 = (float*)take((size_t)SEQ * 16 * 4);
    p.sdv = (float*)take((size_t)SEQ * 128 * 4);
    p.hnb = (bf16_t*)take((size_t)RT * D * 2);
    p.w_in_t = (bf16_t*)take((size_t)INW * D * 2);
    p.xp = (bf16_t*)take((size_t)RT * PWD * 2);
    p.glu = (bf16_t*)take((size_t)RT * CWD * 2);
    p.pooledb = (bf16_t*)take((size_t)SEQ * PWD * 2);
    p.cvnb = (bf16_t*)take((size_t)SEQ * CWD * 2);
    p.yabb = (bf16_t*)take((size_t)SEQ * D * 2);
    p.h2b = (bf16_t*)take((size_t)SEQ * D * 2);
    p.pool_wt = (bf16_t*)take((size_t)4 * 256 * 256 * 2);
    p.pw_t = (bf16_t*)take((size_t)CWD * CWD * 2);
    p.w_out_t = (bf16_t*)take((size_t)D * D * 2);
    p.ssq = (float*)take((size_t)SEQ * 32 * 4);
    p.bar = (unsigned*)take((size_t)XCD_BAR_WORDS * 4);
    p.rstd = (float*)take((size_t)SEQ * 4);
    p.wq_t = (bf16_t*)take((size_t)D * D * 2);
    p.keysb = (bf16_t*)take((size_t)8 * 2 * 128 * 128 * 2);
    p.qb = (bf16_t*)take((size_t)SEQ * D * 2);
    p.down8 = (unsigned char*)take((size_t)16384 * D);
    p.up8 = (unsigned char*)take((size_t)16384 * D);
    p.sdn = (float*)take((size_t)16384 * 4);
    p.sup = (float*)take((size_t)16384 * 4);
    static int grid_blocks = 0;
    if (!grid_blocks) {
        int dev = 0, cus = 0, per_cu = 0;
        (void)hipGetDevice(&dev);
        (void)hipDeviceGetAttribute(&cus, hipDeviceAttributeMultiprocessorCount, dev);
        (void)hipFuncSetAttribute((const void*)k_mega, hipFuncAttributeMaxDynamicSharedMemorySize, LDS_BYTES);
        (void)hipOccupancyMaxActiveBlocksPerMultiprocessor(&per_cu, k_mega, NT, LDS_BYTES);
        if (per_cu < 1) fprintf(stderr, "occupancy query says %d blocks per CU\n", per_cu);
        grid_blocks = cus;
    }
    (void)hipMemsetAsync(p.bar, 0, (size_t)XCD_BAR_WORDS * 4, stream);
    void* args[] = {&p};
    hipError_t e = hipLaunchCooperativeKernel((void*)k_mega, dim3(grid_blocks), dim3(NT), args, LDS_BYTES, stream);
    if (e != hipSuccess) fprintf(stderr, "cooperative launch failed: %s (grid %d)\n", hipGetErrorString(e), grid_blocks);
}
```

```cpp
#include <hip/hip_runtime.h>
#include <hip/hip_cooperative_groups.h>
#include <stdint.h>
#include <cstdio>
namespace cg = cooperative_groups;

#define NT 512
#define LAS __attribute__((address_space(3)))
typedef unsigned short bf16_t;
typedef short bf16x8 __attribute__((ext_vector_type(8)));
typedef float f32x4 __attribute__((ext_vector_type(4)));
typedef unsigned u32x4 __attribute__((ext_vector_type(4)));
typedef unsigned u32x2 __attribute__((ext_vector_type(2)));

constexpr int D = 2048, SEQ = 8192, NMETA = 16, T = SEQ + NMETA;
constexpr int PWD = 1024, CWD = 1024, INW = 3072;
constexpr int KS = 31;
constexpr int RPAD = 240, RT = 8448;
constexpr int LDS_BYTES = 147456;

struct Params {
    const float *x, *meta, *mix_g, *w_in, *pool_w, *pool_scale, *dw_w, *dw_b, *ln_g, *ln_b, *pw_w, *pw_b, *w_out, *ffn_g, *wq, *keys, *down, *up, *fin_g;
    float* out;
    int* idx;
    unsigned* bar;
    bf16_t *hnb, *w_in_t, *xp, *glu, *mixb, *h2b, *pool_ws, *pw_b16, *w_eff_t, *w_out_t, *wq_t, *keysb, *qb;
    unsigned char *down8, *up8;
    float *sdn, *sup;
    float *gsu, *sdv;
    bf16_t* part;
    float *act, *ssq2;
    float *ssq, *rstd, *bias_eff;
};

__device__ __forceinline__ unsigned cvt_pk_bf16(float lo, float hi) { unsigned r; asm volatile("v_cvt_pk_bf16_f32 %0, %1, %2" : "=v"(r) : "v"(lo), "v"(hi)); return r; }
__device__ __forceinline__ float wave_sum(float v) {
#pragma unroll
    for (int o = 1; o < 64; o <<= 1) v += __shfl_xor(v, o);
    return v;
}

__device__ __forceinline__ const float* hrow(const Params& p, int t) { return t < NMETA ? p.meta + (size_t)t * D : p.x + (size_t)(t - NMETA) * D; }

__device__ __forceinline__ float block_sum(float v, float* red) {
#pragma unroll
    for (int o = 32; o; o >>= 1) v += __shfl_xor(v, o);
    __syncthreads();
    if ((threadIdx.x & 63) == 0) red[threadIdx.x >> 6] = v;
    __syncthreads();
    float s = 0.f;
#pragma unroll
    for (int i = 0; i < NT / 64; ++i) s += red[i];
    return s;
}

namespace pg8 {
constexpr int BM = 256, BK = 64, HALF = 128, HTB = HALF * BK * 2, STAGE_BYTES = 8 * HTB, NXCD = 8, WGM = 8;
__device__ __forceinline__ int lds_byte(int r, int c) { const int st = (r >> 4) * 2 + (c >> 5), rr = r & 15, cc = c & 31, ob = rr * 64 + cc * 2; return st * 1024 + (ob ^ (((ob >> 9) & 1) << 5)); }
__device__ __forceinline__ void stage_rc(int b, int& R, int& C) { const int st = b / 1024, sb = b % 1024, swz = sb ^ (((sb >> 9) & 1) << 5); R = (st >> 1) * 16 + swz / 64; C = (st & 1) * 32 + (swz % 64) / 2; }
struct Unit { int pm, pn; };
struct Gemm { const bf16_t* A; const bf16_t* Bt; int lda, ldb, K; int a_col_per_pn; };
struct StaticOrder {
    int nM, nN, nwg, G, c;
    __device__ void init(int nM_, int nN_, int G_, int c_) { nM = nM_; nN = nN_; nwg = nM * nN; G = G_; c = c_; }
    __device__ bool next(int i, Unit& u) const {
        const long L = (long)i * G + c; if (L >= nwg) return false;
        int wgid = (int)L; { const int q = nwg / NXCD, r = nwg % NXCD, xcd = wgid % NXCD, off = wgid / NXCD; wgid = (xcd < r ? xcd * (q + 1) : r * (q + 1) + (xcd - r) * q) + off; }
        const int nig = WGM * nN, gid = wgid / nig, fm = gid * WGM, gsz = (nM - fm) < WGM ? (nM - fm) : WGM;
        u.pm = fm + ((wgid % nig) % gsz); u.pn = (wgid % nig) / gsz; return true;
    }
};
struct OneUnit { Unit u; __device__ bool next(int i, Unit& o) const { if (i) return false; o = u; return true; } };
template <class Epi, class Sched>
__device__ __forceinline__ void gemm_phase(LAS unsigned char* lds, const Gemm g, const Sched& S, const Epi& E) {
    const int tid = threadIdx.x, wid = __builtin_amdgcn_readfirstlane(tid >> 6), lane = tid & 63, wr = wid >> 2, wc = wid & 3, fr = lane & 15, fq = lane >> 4;
    const int K = g.K, nt = K / BK;
    unsigned voffA[2], voffB[2];
#pragma unroll
    for (int i = 0; i < 2; ++i) { int R, C; stage_rc(tid * 16 + i * 8192, R, C);
        voffA[i] = (unsigned)(R * g.lda + C) * 2u; voffB[i] = (unsigned)(R * g.ldb + C) * 2u; }
    const size_t kstep = (size_t)(BK * 2);
    const size_t hstepA = (size_t)HALF * g.lda * 2, hstepB = (size_t)HALF * g.ldb * 2;
    const size_t tstepA = 2 * hstepA, tstepB = 2 * hstepB;
    const unsigned ldsw = (unsigned)wid * 1024u;
    const int aoff = lds_byte(wr * 64 + fr, fq * 8), boff = lds_byte(wc * 32 + fr, fq * 8);
#define PG8_SA(b, h) (((b) * 2 + (h)) * HTB)
#define PG8_SB(b, h) ((4 + (b) * 2 + (h)) * HTB)
#define PG8_STAGE(bufoff, gbase, voff) do { _Pragma("unroll") for (int _i = 0; _i < 2; ++_i) \
        __builtin_amdgcn_global_load_lds((const unsigned*)((const char*)(gbase) + (voff)[_i]), (LAS unsigned*)(lds + (bufoff) + ldsw + _i * 8192), 16, 0, 0); } while (0)
#define PG8_LDA(dst, b, h) do { _Pragma("unroll") for (int m = 0; m < 4; ++m) _Pragma("unroll") for (int k = 0; k < 2; ++k) dst[m][k] = *(const LAS bf16x8*)(lds + PG8_SA(b, h) + aoff + m * 2048 + k * 1024); } while (0)
#define PG8_LDB(dst, b, h) do { _Pragma("unroll") for (int n = 0; n < 2; ++n) _Pragma("unroll") for (int k = 0; k < 2; ++k) dst[n][k] = *(const LAS bf16x8*)(lds + PG8_SB(b, h) + boff + n * 2048 + k * 1024); } while (0)
#define PG8_MMA(ai, bj, At, Bt) do { __builtin_amdgcn_s_setprio(1); _Pragma("unroll") for (int m = 0; m < 4; ++m) _Pragma("unroll") for (int n = 0; n < 2; ++n) _Pragma("unroll") for (int k = 0; k < 2; ++k) \
        acc[ai][bj][m][n] = __builtin_amdgcn_mfma_f32_16x16x32_bf16(Bt[n][k], At[m][k], acc[ai][bj][m][n], 0, 0, 0); __builtin_amdgcn_s_setprio(0); } while (0)
#define PG8_WAIT_V(n) asm volatile("s_waitcnt vmcnt(" #n ")" ::: "memory")
#define PG8_WAIT_L(n) asm volatile("s_waitcnt lgkmcnt(" #n ")" ::: "memory")
#define PG8_BAR __builtin_amdgcn_s_barrier()
#define PG8_SCHED __builtin_amdgcn_sched_barrier(0)
    Unit cur, nxt; int ui = 0;
    if (!S.next(0, cur)) return;
    f32x4 acc[2][2][4][2];
#pragma unroll
    for (int a = 0; a < 2; ++a)
#pragma unroll
        for (int b = 0; b < 2; ++b)
#pragma unroll
            for (int m = 0; m < 4; ++m)
#pragma unroll
                for (int n = 0; n < 2; ++n) acc[a][b][m][n] = (f32x4){0.f, 0.f, 0.f, 0.f};
    bf16x8 At[4][2], B0[2][2], B1[2][2];
    const char* cA = (const char*)g.A + (size_t)cur.pm * tstepA + (size_t)cur.pn * g.a_col_per_pn * 2; const char* cB = (const char*)g.Bt + (size_t)cur.pn * tstepB;
    PG8_STAGE(PG8_SB(0, 0), cB, voffB); PG8_STAGE(PG8_SA(0, 0), cA, voffA); PG8_STAGE(PG8_SB(0, 1), cB + hstepB, voffB); PG8_STAGE(PG8_SA(0, 1), cA + hstepA, voffA);
    if (wr == 1) PG8_BAR;
    PG8_WAIT_V(4); PG8_BAR;
    PG8_STAGE(PG8_SB(1, 0), cB + kstep, voffB); PG8_STAGE(PG8_SA(1, 0), cA + kstep, voffA); PG8_STAGE(PG8_SB(1, 1), cB + hstepB + kstep, voffB);
    PG8_WAIT_V(6); PG8_BAR;
    for (;;) {
        const bool has_next = S.next(ui + 1, nxt);
        const char* nA = has_next ? (const char*)g.A + (size_t)nxt.pm * tstepA + (size_t)nxt.pn * g.a_col_per_pn * 2 : cA; const char* nB = has_next ? (const char*)g.Bt + (size_t)nxt.pn * tstepB : cB;
        for (int t = 0; t < nt; t += 2) {
            const bool last = (t == nt - 2);
            const char* a1 = cA + (size_t)(t + 1) * kstep;
            const char* a2 = last ? nA : cA + (size_t)(t + 2) * kstep; const char* b2 = last ? nB : cB + (size_t)(t + 2) * kstep;
            const char* a3 = a2 + kstep; const char* b3 = b2 + kstep;
            PG8_LDB(B0, 0, 0); PG8_SCHED; PG8_LDA(At, 0, 0); PG8_STAGE(PG8_SA(1, 1), a1 + hstepA, voffA);
            PG8_WAIT_L(8); PG8_BAR; PG8_WAIT_L(0); PG8_MMA(0, 0, At, B0); PG8_BAR; PG8_SCHED;
            PG8_LDB(B1, 0, 1); PG8_STAGE(PG8_SB(0, 0), b2, voffB);
            PG8_BAR; PG8_WAIT_L(0); PG8_MMA(0, 1, At, B1); PG8_BAR;
            PG8_LDA(At, 0, 1); PG8_STAGE(PG8_SA(0, 0), a2, voffA);
            PG8_BAR; PG8_WAIT_L(0); PG8_MMA(1, 0, At, B0); PG8_BAR; PG8_SCHED;
            PG8_STAGE(PG8_SB(0, 1), b2 + hstepB, voffB);
            PG8_WAIT_V(6); PG8_BAR; PG8_MMA(1, 1, At, B1); PG8_BAR;
            PG8_LDB(B0, 1, 0); PG8_SCHED; PG8_LDA(At, 1, 0); PG8_STAGE(PG8_SA(0, 1), a2 + hstepA, voffA);
            PG8_WAIT_L(8); PG8_BAR; PG8_WAIT_L(0); PG8_MMA(0, 0, At, B0); PG8_BAR; PG8_SCHED;
            PG8_LDB(B1, 1, 1); PG8_STAGE(PG8_SB(1, 0), b3, voffB);
            PG8_BAR; PG8_WAIT_L(0); PG8_MMA(0, 1, At, B1); PG8_BAR;
            PG8_LDA(At, 1, 1); PG8_STAGE(PG8_SA(1, 0), a3, voffA);
            PG8_BAR; PG8_WAIT_L(0); PG8_MMA(1, 0, At, B0); PG8_BAR; PG8_SCHED;
            PG8_STAGE(PG8_SB(1, 1), b3 + hstepB, voffB);
            PG8_WAIT_V(6); PG8_BAR; PG8_MMA(1, 1, At, B1); PG8_BAR;
        }
        E(acc, cur, wr, wc, fr, fq);
        if (!has_next) break;
#pragma unroll
        for (int a = 0; a < 2; ++a)
#pragma unroll
            for (int b = 0; b < 2; ++b)
#pragma unroll
                for (int m = 0; m < 4; ++m)
#pragma unroll
                    for (int n = 0; n < 2; ++n) acc[a][b][m][n] = (f32x4){0.f, 0.f, 0.f, 0.f};
        cur = nxt; cA = nA; cB = nB; ++ui;
    }
    PG8_WAIT_V(0);
    if (wr == 0) PG8_BAR;
    PG8_BAR;
#undef PG8_SA
#undef PG8_SB
#undef PG8_STAGE
#undef PG8_LDA
#undef PG8_LDB
#undef PG8_MMA
#undef PG8_WAIT_V
#undef PG8_WAIT_L
#undef PG8_BAR
#undef PG8_SCHED
}
}

struct EpiProjF32 {
    float* proj;
    __device__ __forceinline__ void operator()(const f32x4 (&acc)[2][2][4][2], const pg8::Unit& u, int wr, int wc, int fr, int fq) const {
#pragma unroll
        for (int ai = 0; ai < 2; ++ai)
#pragma unroll
            for (int m = 0; m < 4; ++m) {
                const int t = u.pm * 256 + ai * 128 + wr * 64 + m * 16 + fr - RPAD;
                if (t >= 0) {
#pragma unroll
                    for (int bj = 0; bj < 2; ++bj)
#pragma unroll
                        for (int n = 0; n < 2; ++n) {
                            const int off = wc * 32 + n * 16 + fq * 4;
                            const int col = u.pn < 4 ? u.pn * 256 + bj * 128 + off : (bj ? 2048 : 1024) + (u.pn - 4) * 128 + off;
                            *(f32x4*)(proj + (size_t)t * INW + col) = acc[ai][bj][m][n];
                        }
                }
            }
    }
};


__device__ __forceinline__ float sigmoidf_fast(float x) { return __builtin_amdgcn_rcpf(1.0f + __expf(-x)); }

struct EpiProj {
    bf16_t* xp; bf16_t* glu;
    __device__ __forceinline__ void operator()(const f32x4 (&acc)[2][2][4][2], const pg8::Unit& u, int wr, int wc, int fr, int fq) const {
#pragma unroll
        for (int ai = 0; ai < 2; ++ai)
#pragma unroll
            for (int m = 0; m < 4; ++m) {
                const size_t row = (size_t)(u.pm * 256 + ai * 128 + wr * 64 + m * 16 + fr);
                if (u.pn < 4) {
#pragma unroll
                    for (int bj = 0; bj < 2; ++bj)
#pragma unroll
                        for (int n = 0; n < 2; ++n) { const f32x4 v = acc[ai][bj][m][n]; u32x2 w; w.x = cvt_pk_bf16(v[0], v[1]); w.y = cvt_pk_bf16(v[2], v[3]);
                            *(u32x2*)(xp + row * PWD + u.pn * 256 + bj * 128 + wc * 32 + n * 16 + fq * 4) = w; }
                } else {
#pragma unroll
                    for (int n = 0; n < 2; ++n) { const f32x4 a = acc[ai][0][m][n], g = acc[ai][1][m][n]; u32x2 w;
                        w.x = cvt_pk_bf16(a[0] * sigmoidf_fast(g[0]), a[1] * sigmoidf_fast(g[1])); w.y = cvt_pk_bf16(a[2] * sigmoidf_fast(g[2]), a[3] * sigmoidf_fast(g[3]));
                        *(u32x2*)(glu + row * CWD + (u.pn - 4) * 128 + wc * 32 + n * 16 + fq * 4) = w; }
                }
            }
    }
};
struct EpiBf16Out {
    bf16_t* O; int ldc; int col0; const float* bias;
    __device__ __forceinline__ void operator()(const f32x4 (&acc)[2][2][4][2], const pg8::Unit& u, int wr, int wc, int fr, int fq) const {
#pragma unroll
        for (int ai = 0; ai < 2; ++ai)
#pragma unroll
            for (int m = 0; m < 4; ++m) {
                const size_t row = (size_t)(u.pm * 256 + ai * 128 + wr * 64 + m * 16 + fr);
#pragma unroll
                for (int bj = 0; bj < 2; ++bj)
#pragma unroll
                    for (int n = 0; n < 2; ++n) { const int c = u.pn * 256 + bj * 128 + wc * 32 + n * 16 + fq * 4; f32x4 v = acc[ai][bj][m][n];
                        if (bias) v += *(const f32x4*)(bias + c);
                        u32x2 w; w.x = cvt_pk_bf16(v[0], v[1]); w.y = cvt_pk_bf16(v[2], v[3]);
                        *(u32x2*)(O + row * ldc + col0 + c) = w; }
            }
    }
};
struct EpiResid {
    const float* x; const float* bias; bf16_t* h2b; float* ssq;
    __device__ __forceinline__ void operator()(const f32x4 (&acc)[2][2][4][2], const pg8::Unit& u, int wr, int wc, int fr, int fq) const {
#pragma unroll
        for (int ai = 0; ai < 2; ++ai)
#pragma unroll
            for (int m = 0; m < 4; ++m) {
                const size_t row = (size_t)(u.pm * 256 + ai * 128 + wr * 64 + m * 16 + fr);
                float ss = 0.f;
#pragma unroll
                for (int bj = 0; bj < 2; ++bj)
#pragma unroll
                    for (int n = 0; n < 2; ++n) { const int c = u.pn * 256 + bj * 128 + wc * 32 + n * 16 + fq * 4;
                        const f32x4 v = acc[ai][bj][m][n] + *(const f32x4*)(x + row * D + c) + *(const f32x4*)(bias + c);
                        u32x2 w; w.x = cvt_pk_bf16(v[0], v[1]); w.y = cvt_pk_bf16(v[2], v[3]);
                        *(u32x2*)(h2b + row * D + c) = w;
                        ss += (v[0] * v[0] + v[1] * v[1]) + (v[2] * v[2] + v[3] * v[3]); }
                ss += __shfl_xor(ss, 16); ss += __shfl_xor(ss, 32);
                if (fq == 0) ssq[row * 32 + u.pn * 4 + wc] = ss;
            }
    }
};

__device__ __forceinline__ float fsel(int mask, float a, float b) { return __int_as_float((__float_as_int(a) & ~mask) | (__float_as_int(b) & mask)); }
__device__ __forceinline__ float bf_lo(unsigned w) { return __uint_as_float(w << 16); }
__device__ __forceinline__ float bf_hi(unsigned w) { return __uint_as_float(w & 0xffff0000u); }

__device__ __forceinline__ u32x4 bload16(__amdgpu_buffer_rsrc_t r, int voff, int soff) { return __builtin_bit_cast(u32x4, __builtin_amdgcn_raw_buffer_load_b128(r, voff, soff, 0)); }
__device__ __forceinline__ unsigned bload4(__amdgpu_buffer_rsrc_t r, int voff, int soff) { return (unsigned)__builtin_amdgcn_raw_buffer_load_b32(r, voff, soff, 0); }
__device__ __forceinline__ void bstore4(__amdgpu_buffer_rsrc_t r, unsigned v, int voff, int soff) { __builtin_amdgcn_raw_buffer_store_b32(v, r, voff, soff, 0); }
template <int W> __device__ __forceinline__ void pool_tile(__amdgpu_buffer_rsrc_t rxp, __amdgpu_buffer_rsrc_t rpo, int r0, int tile, int tid) {
    unsigned v[32 + W - 1];
#pragma unroll
    for (int i = 0; i < 32 + W - 1; ++i) v[i] = bload4(rxp, tid * 4, (r0 - (W - 1) + i) * 2048);
    float s0 = 0.f, s1 = 0.f;
#pragma unroll
    for (int i = 0; i < W - 1; ++i) { s0 += bf_lo(v[i]); s1 += bf_hi(v[i]); }
    constexpr float inv = 1.0f / (float)W;
#pragma unroll
    for (int i = 0; i < 32; ++i) {
        const float a0 = bf_lo(v[W - 1 + i]), a1 = bf_hi(v[W - 1 + i]);
        s0 += a0; s1 += a1;
        bstore4(rpo, cvt_pk_bf16(s0 * inv - a0, s1 * inv - a1), tid * 4, (tile * 32 + i) * 4096);
        s0 -= bf_lo(v[i]); s1 -= bf_hi(v[i]);
    }
}
__device__ __forceinline__ void phase_mix(const Params& p, LAS unsigned char* lds, int bid, int nb) {
    const int tid = threadIdx.x, lane = tid & 63, wave = tid >> 6;
    LAS unsigned* gl = (LAS unsigned*)lds;
    LAS float* red = (LAS float*)(lds + 62 * 2048);
    const __amdgpu_buffer_rsrc_t rxp = __builtin_amdgcn_make_buffer_rsrc((void*)p.xp, 0, RT * PWD * 2, 0x00020000);
    const __amdgpu_buffer_rsrc_t rgl = __builtin_amdgcn_make_buffer_rsrc((void*)p.glu, 0, RT * CWD * 2, 0x00020000);
    const __amdgpu_buffer_rsrc_t rpo = __builtin_amdgcn_make_buffer_rsrc((void*)p.mixb, 0, SEQ * D * 2, 0x00020000);
    const __amdgpu_buffer_rsrc_t rww = __builtin_amdgcn_make_buffer_rsrc((void*)p.dw_w, 0, KS * CWD * 4, 0x00020000);
    const __amdgpu_buffer_rsrc_t rwb = __builtin_amdgcn_make_buffer_rsrc((void*)p.dw_b, 0, CWD * 4, 0x00020000);
    const __amdgpu_buffer_rsrc_t rlg = __builtin_amdgcn_make_buffer_rsrc((void*)p.ln_g, 0, CWD * 4, 0x00020000);
    const __amdgpu_buffer_rsrc_t rlb = __builtin_amdgcn_make_buffer_rsrc((void*)p.ln_b, 0, CWD * 4, 0x00020000);
    for (int tile = bid; tile < SEQ / 32; tile += nb) {
        const int r0 = 256 + tile * 32;
        __syncthreads();
#pragma unroll
        for (int j = 0; j < 16; ++j) { const int ch = j * NT + tid; if (ch < 62 * 128)
            *(LAS u32x4*)(lds + ch * 16) = bload16(rgl, tid * 16, (r0 - 30) * 2048 + j * 8192); }
        { const int g = __builtin_amdgcn_readfirstlane(tid >> 7);
          if (g == 0) pool_tile<2>(rxp, rpo, r0, tile, tid); else if (g == 1) pool_tile<4>(rxp, rpo, r0, tile, tid); else if (g == 2) pool_tile<8>(rxp, rpo, r0, tile, tid); else pool_tile<16>(rxp, rpo, r0, tile, tid); }
        __syncthreads();
#pragma unroll 1
        for (int hf = 0; hf < 2; ++hf) {
            float c0[16], c1[16];
            {
                float w0[KS], w1[KS];
#pragma unroll
                for (int k = 0; k < KS; ++k) { w0[k] = __uint_as_float(bload4(rww, tid * 8, k * 4096)); w1[k] = __uint_as_float(bload4(rww, tid * 8 + 4, k * 4096)); }
                const float b0 = __uint_as_float(bload4(rwb, tid * 8, 0)), b1 = __uint_as_float(bload4(rwb, tid * 8 + 4, 0));
#pragma unroll
                for (int i = 0; i < 16; ++i) { c0[i] = b0; c1[i] = b1; }
                const LAS unsigned* glh = gl + hf * 16 * 512 + tid;
#pragma unroll
                for (int rr = 0; rr < 46; ++rr) {
                    if ((rr & 7) == 0) asm volatile("" ::: "memory");
                    const unsigned vv = glh[rr * 512]; const float x0 = bf_lo(vv), x1 = bf_hi(vv);
#pragma unroll
                    for (int i = 0; i < 16; ++i) { const int k = rr - i; if (k >= 0 && k < KS) { c0[i] += x0 * w0[k]; c1[i] += x1 * w1[k]; } }
                }
            }
            asm volatile("" ::: "memory");
#pragma unroll
            for (int which = 0; which < 2; ++which) {
                float st[16];
#pragma unroll
                for (int i = 0; i < 16; ++i) st[i] = which == 0 ? c0[i] + c1[i] : c0[i] * c0[i] + c1[i] * c1[i];
#pragma unroll
                for (int lvl = 0; lvl < 4; ++lvl) {
                    const int o = 32 >> lvl, n = 8 >> lvl; const int mk = -((lane >> (5 - lvl)) & 1);
#pragma unroll
                    for (int j = 0; j < 8; ++j) if (j < n) st[j] = fsel(mk, st[j], st[j + n]) + __shfl_xor(fsel(mk, st[j + n], st[j]), o);
                }
                float tot = st[0] + __shfl_xor(st[0], 2); tot += __shfl_xor(tot, 1);
                if ((lane & 3) == 0) red[wave * 32 + which * 16 + (lane >> 2)] = tot;
            }
            __syncthreads();
            if (tid < 32) { float t = 0.f;
#pragma unroll
                for (int q = 0; q < 8; ++q) t += red[q * 32 + tid];
                red[256 + tid] = t; }
            __syncthreads();
            const float lg0 = __uint_as_float(bload4(rlg, tid * 8, 0)), lg1 = __uint_as_float(bload4(rlg, tid * 8 + 4, 0)), lb0 = __uint_as_float(bload4(rlb, tid * 8, 0)), lb1 = __uint_as_float(bload4(rlb, tid * 8 + 4, 0));
#pragma unroll
            for (int i = 0; i < 16; ++i) {
                const float s1 = red[256 + i], s2 = red[256 + 16 + i];
                const float mu = s1 * (1.0f / CWD), var = fmaxf(s2 * (1.0f / CWD) - mu * mu, 0.f), rs = rsqrtf(var + 1e-5f);
                const float y0 = (c0[i] - mu) * rs * lg0 + lb0, y1 = (c1[i] - mu) * rs * lg1 + lb1;
                bstore4(rpo, cvt_pk_bf16(y0 * sigmoidf_fast(y0), y1 * sigmoidf_fast(y1)), tid * 4, (tile * 32 + hf * 16 + i) * 4096 + 2048);
            }
            __syncthreads();
        }
    }
}

struct EpiQ {
    const float* ssq; float* rstd; bf16_t* qb;
    __device__ __forceinline__ void operator()(const f32x4 (&acc)[2][2][4][2], const pg8::Unit& u, int wr, int wc, int fr, int fq) const {
#pragma unroll
        for (int ai = 0; ai < 2; ++ai)
#pragma unroll
            for (int m = 0; m < 4; ++m) {
                const size_t row = (size_t)(u.pm * 256 + ai * 128 + wr * 64 + m * 16 + fr);
                const f32x4* sp = (const f32x4*)(ssq + row * 32); f32x4 t = sp[0];
#pragma unroll
                for (int i = 1; i < 8; ++i) t += sp[i];
                const float rs = rsqrtf(((t[0] + t[1]) + (t[2] + t[3])) * (1.0f / D) + 1e-6f);
                if (u.pn == 0 && wc == 0 && fq == 0) rstd[row] = rs;
#pragma unroll
                for (int bj = 0; bj < 2; ++bj)
#pragma unroll
                    for (int n = 0; n < 2; ++n) { const int c = u.pn * 256 + bj * 128 + wc * 32 + n * 16 + fq * 4; const f32x4 v = acc[ai][bj][m][n] * rs;
                        u32x2 w; w.x = cvt_pk_bf16(v[0], v[1]); w.y = cvt_pk_bf16(v[2], v[3]);
                        *(u32x2*)(qb + row * D + c) = w; }
            }
    }
};

typedef float f32x16 __attribute__((ext_vector_type(16)));
__device__ __forceinline__ int okey(float s) { const int u = __float_as_int(s); return u ^ ((u >> 31) & 0x7fffffff); }
__device__ __forceinline__ float okey_inv(int k) { return __int_as_float(k ^ ((k >> 31) & 0x7fffffff)); }
__device__ __forceinline__ void sort16_desc(int (&v)[16]) {
#pragma unroll
    for (int k = 2; k <= 16; k <<= 1) {
#pragma unroll
        for (int j = k >> 1; j > 0; j >>= 1) {
#pragma unroll
            for (int i = 0; i < 16; ++i) {
                const int l = i ^ j;
                if (l > i) { const bool desc = (i & k) == 0; const int hi = max(v[i], v[l]), lo = min(v[i], v[l]); v[i] = desc ? hi : lo; v[l] = desc ? lo : hi; }
            }
        }
    }
}
__device__ __forceinline__ void merge16_desc(int (&a)[16], const int (&b)[16]) {
#pragma unroll
    for (int i = 0; i < 16; ++i) a[i] = max(a[i], b[15 - i]);
#pragma unroll
    for (int j = 8; j > 0; j >>= 1) {
#pragma unroll
        for (int i = 0; i < 16; ++i) { const int l = i ^ j; if (l > i) { const int hi = max(a[i], a[l]), lo = min(a[i], a[l]); a[i] = hi; a[l] = lo; } }
    }
}
__device__ __forceinline__ void pair_merge(int (&a)[16]) {
    int b[16];
#pragma unroll
    for (int i = 0; i < 16; ++i) b[i] = __shfl_xor(a[i], 32);
    merge16_desc(a, b);
}
constexpr int CELL_I[64] = {0,0,0,0,0,0,0,0,0,0,0,0,0,0,0,0,1,1,1,1,1,1,1,1,2,2,2,2,2,3,3,3,3,4,4,4,5,5,6,6,7,7,8,9,10,11,12,13,14,15,0,0,0,0,0,0,0,0,0,0,0,0,0,0};
constexpr int CELL_J[64] = {0,1,2,3,4,5,6,7,8,9,10,11,12,13,14,15,0,1,2,3,4,5,6,7,0,1,2,3,4,0,1,2,3,0,1,2,0,1,0,1,0,1,0,0,0,0,0,0,0,0,0,0,0,0,0,0,0,0,0,0,0,0,0,0};
constexpr int NCELL = 50;

__device__ __forceinline__ void phase_topk2(const Params& p, LAS unsigned char* lds, int bid, int nb) {
    const int tid = threadIdx.x, lane = tid & 63, wave = tid >> 6, hh = lane >> 5, l31 = lane & 31;
    LAS int* sit = (LAS int*)(lds + wave * 8448 + lane * 132);
    const int gw = bid * 8 + wave, NGW = nb * 8;
    for (int item = gw; item < (SEQ / 32) * 8; item += NGW) {
        const int h = item & 7, tok0 = (item >> 3) * 32;
        float sv[2][16];
#pragma unroll
        for (int ph = 0; ph < 2; ++ph) {
            const bf16_t* qrow = p.qb + (size_t)(tok0 + l31) * D + h * 256 + ph * 128 + 8 * hh;
            const bf16_t* krow = p.keysb + ((size_t)(h * 2 + ph) * 128 + l31) * 128 + 8 * hh;
            bf16x8 bq[8];
#pragma unroll
            for (int ks = 0; ks < 8; ++ks) bq[ks] = *(const bf16x8*)(qrow + ks * 16);
            int top[16];
#pragma unroll
            for (int kt = 0; kt < 4; ++kt) {
                f32x16 c = {0.f, 0.f, 0.f, 0.f, 0.f, 0.f, 0.f, 0.f, 0.f, 0.f, 0.f, 0.f, 0.f, 0.f, 0.f, 0.f};
#pragma unroll
                for (int ks = 0; ks < 8; ++ks) { const bf16x8 ak = *(const bf16x8*)(krow + (size_t)kt * 32 * 128 + ks * 16);
                    c = __builtin_amdgcn_mfma_f32_32x32x16_bf16(ak, bq[ks], c, 0, 0, 0); }
                int v[16];
#pragma unroll
                for (int r = 0; r < 16; ++r) { const int base = kt * 32 + (r & 3) + 8 * (r >> 2);
                    v[r] = ((okey(c[r]) & ~127) | (127 - base)) ^ (hh << 2); }
                sort16_desc(v);
                if (kt == 0) {
#pragma unroll
                    for (int i = 0; i < 16; ++i) top[i] = v[i];
                } else merge16_desc(top, v);
            }
            pair_merge(top);
#pragma unroll
            for (int i = 0; i < 16; ++i) { sv[ph][i] = okey_inv(top[i] & ~127); sit[ph * 16 + i] = 127 - (top[i] & 127); }
        }
        int w0[16], w1[16];
#pragma unroll
        for (int s = 0; s < 32; ++s) {
            const int e0 = 2 * s, e1 = 2 * s + 1;
            int key;
            if (e0 >= NCELL) key = (int)0x80000000;
            else {
                const float v0 = sv[0][CELL_I[e0]] + sv[1][CELL_J[e0]];
                const int k0 = (okey(v0) & ~255) | (255 - (CELL_I[e0] * 16 + CELL_J[e0]));
                if (e1 >= NCELL) key = hh ? (int)0x80000000 : k0;
                else { const float v1 = sv[0][CELL_I[e1]] + sv[1][CELL_J[e1]];
                    const int k1 = (okey(v1) & ~255) | (255 - (CELL_I[e1] * 16 + CELL_J[e1]));
                    key = hh ? k1 : k0; }
            }
            if (s < 16) w0[s] = key; else w1[s - 16] = key;
        }
        sort16_desc(w0); sort16_desc(w1); merge16_desc(w0, w1); pair_merge(w0);
        const float mx = okey_inv(w0[0] & ~255);
        float sum = 0.f;
#pragma unroll
        for (int k = 0; k < 16; ++k) sum += __expf(okey_inv(w0[k] & ~255) - mx);
        const float inv = 1.0f / sum;
        int eo[8]; float go[8]; const int hmask = -hh;
#pragma unroll
        for (int k = 0; k < 8; ++k) { const int kk = (w0[k] & ~hmask) | (w0[8 + k] & hmask); const int cc = 255 - (kk & 255);
            eo[k] = sit[cc >> 4] * 128 + sit[16 + (cc & 15)]; go[k] = __expf(okey_inv(kk & ~255) - mx) * inv; }
        float so[8];
#pragma unroll
        for (int k = 0; k < 8; ++k) { go[k] *= p.sup[eo[k]]; so[k] = p.sdn[eo[k]]; }
        const size_t ob = (size_t)(tok0 + l31) * 128 + h * 16 + hh * 8;
        *(u32x4*)(p.idx + ob) = (u32x4){(unsigned)eo[0], (unsigned)eo[1], (unsigned)eo[2], (unsigned)eo[3]};
        *(u32x4*)(p.idx + ob + 4) = (u32x4){(unsigned)eo[4], (unsigned)eo[5], (unsigned)eo[6], (unsigned)eo[7]};
        *(f32x4*)(p.gsu + ob) = (f32x4){go[0], go[1], go[2], go[3]};
        *(f32x4*)(p.gsu + ob + 4) = (f32x4){go[4], go[5], go[6], go[7]};
        *(f32x4*)(p.sdv + ob) = (f32x4){so[0], so[1], so[2], so[3]};
        *(f32x4*)(p.sdv + ob + 4) = (f32x4){so[4], so[5], so[6], so[7]};
    }
}


typedef float f32x2 __attribute__((ext_vector_type(2)));
template <int N> __device__ __forceinline__ f32x2 dot16_fp8(const u32x4 w, const f32x2 (&x)[N], int o, f32x2 acc) {
    const unsigned ww[4] = {w.x, w.y, w.z, w.w};
#pragma unroll
    for (int d = 0; d < 4; ++d) { acc += __builtin_amdgcn_cvt_pk_f32_fp8((int)ww[d], false) * x[o + 2 * d]; acc += __builtin_amdgcn_cvt_pk_f32_fp8((int)ww[d], true) * x[o + 2 * d + 1]; }
    return acc;
}
template <int N> __device__ __forceinline__ void axpy16_fp8(const u32x4 w, float a, f32x2 (&y)[N], int o) {
    const unsigned ww[4] = {w.x, w.y, w.z, w.w}; const f32x2 a2 = {a, a};
#pragma unroll
    for (int d = 0; d < 4; ++d) { y[o + 2 * d] += a2 * __builtin_amdgcn_cvt_pk_f32_fp8((int)ww[d], false); y[o + 2 * d + 1] += a2 * __builtin_amdgcn_cvt_pk_f32_fp8((int)ww[d], true); }
}
__device__ __forceinline__ void bstore16(__amdgpu_buffer_rsrc_t r, f32x4 v, int voff, int soff) { __builtin_amdgcn_raw_buffer_store_b128(__builtin_bit_cast(__attribute__((__vector_size__(4 * sizeof(unsigned)))) unsigned, v), r, voff, soff, 0); }
__device__ __forceinline__ void bstore8(__amdgpu_buffer_rsrc_t r, f32x2 v, int voff, int soff) { __builtin_amdgcn_raw_buffer_store_b64(__builtin_bit_cast(__attribute__((__vector_size__(2 * sizeof(unsigned)))) unsigned, v), r, voff, soff, 0); }
__device__ __forceinline__ f32x2 fsel2(int mask, f32x2 a, f32x2 b) { return (f32x2){fsel(mask, a.x, b.x), fsel(mask, a.y, b.y)}; }
__device__ __forceinline__ f32x2 shx2(f32x2 a, int o) { return (f32x2){__shfl_xor(a.x, o), __shfl_xor(a.y, o)}; }

__device__ __forceinline__ void phase_pd(const Params& p, int bid, int nb) {
    const int tid = threadIdx.x, lane = tid & 63, wave = __builtin_amdgcn_readfirstlane(tid >> 6);
    const int v = bid & 7, lw = (bid >> 3) * 8 + wave, NLW = (nb >> 3) * 8;
    const int c = lane & 7, sub = lane >> 3;
    const int m0 = -(lane & 1), m1 = -((lane >> 1) & 1), m2 = -((lane >> 2) & 1);
    const __amdgpu_buffer_rsrc_t rd = __builtin_amdgcn_make_buffer_rsrc((void*)p.down8, 0, 16384 * D, 0x00020000);
    const __amdgpu_buffer_rsrc_t rh = __builtin_amdgcn_make_buffer_rsrc((void*)p.h2b, 0, SEQ * D * 2, 0x00020000);
    const __amdgpu_buffer_rsrc_t rg1 = __builtin_amdgcn_make_buffer_rsrc((void*)p.ffn_g, 0, D * 4, 0x00020000);
    const __amdgpu_buffer_rsrc_t ri = __builtin_amdgcn_make_buffer_rsrc((void*)p.idx, 0, SEQ * 128 * 4, 0x00020000);
    const __amdgpu_buffer_rsrc_t rrs = __builtin_amdgcn_make_buffer_rsrc((void*)p.rstd, 0, SEQ * 4, 0x00020000);
    const __amdgpu_buffer_rsrc_t rp = __builtin_amdgcn_make_buffer_rsrc((void*)p.part, 0, SEQ * 16 * 128 * 2, 0x00020000);
    const int vsub = sub * 64, vc2 = c * 32, vc1 = c * 16, vl4 = lane * 4;
#pragma unroll 1
    for (int pass = 0; pass < 2; ++pass) {
        const int sl = v * 2 + pass;
        f32x2 gs[8];
#pragma unroll
        for (int i = 0; i < 4; ++i) { const f32x4 g = __builtin_bit_cast(f32x4, bload16(rg1, c * 64, sl * 512 + i * 16)); gs[2 * i] = (f32x2){g[0], g[1]}; gs[2 * i + 1] = (f32x2){g[2], g[3]}; }
        u32x4 ix[4], hh[2]; unsigned rsb;
        {
            const int t = lw;
#pragma unroll
            for (int i = 0; i < 4; ++i) ix[i] = bload16(ri, vsub, t * 512 + i * 16);
            hh[0] = bload16(rh, vc2, t * 4096 + sl * 256); hh[1] = bload16(rh, vc2, t * 4096 + sl * 256 + 16); rsb = bload4(rrs, 0, t * 4);
        }
#pragma unroll 1
        for (int t = lw; t < SEQ; t += NLW) {
            asm volatile("" ::: "memory");
            u32x4 w[16];
            {
                const unsigned e[16] = {ix[0].x, ix[0].y, ix[0].z, ix[0].w, ix[1].x, ix[1].y, ix[1].z, ix[1].w, ix[2].x, ix[2].y, ix[2].z, ix[2].w, ix[3].x, ix[3].y, ix[3].z, ix[3].w};
#pragma unroll
                for (int g = 0; g < 16; ++g) w[g] = bload16(rd, (int)(e[g] * 2048u) + vc1, sl * 128);
            }
            f32x2 xs[8];
            {
                const float rs = __uint_as_float(rsb);
                const unsigned hw[8] = {hh[0].x, hh[0].y, hh[0].z, hh[0].w, hh[1].x, hh[1].y, hh[1].z, hh[1].w};
#pragma unroll
                for (int i = 0; i < 8; ++i) xs[i] = (f32x2){bf_lo(hw[i]) * rs, bf_hi(hw[i]) * rs} * gs[i];
            }
            asm volatile("" ::: "memory");
            {
                const int tn = t + NLW < SEQ ? t + NLW : t;
#pragma unroll
                for (int i = 0; i < 4; ++i) ix[i] = bload16(ri, vsub, tn * 512 + i * 16);
                hh[0] = bload16(rh, vc2, tn * 4096 + sl * 256); hh[1] = bload16(rh, vc2, tn * 4096 + sl * 256 + 16); rsb = bload4(rrs, 0, tn * 4);
            }
            asm volatile("" ::: "memory");
            float r[16];
#pragma unroll
            for (int g = 0; g < 16; ++g) { const f32x2 z = {0.f, 0.f}; const f32x2 s2 = dot16_fp8(w[g], xs, 0, z); r[g] = s2.x + s2.y; }
            float k8[8], k4[4];
#pragma unroll
            for (int i = 0; i < 8; ++i) k8[i] = fsel(m2, r[i], r[i + 8]) + __shfl_xor(fsel(m2, r[i + 8], r[i]), 4);
#pragma unroll
            for (int i = 0; i < 4; ++i) k4[i] = fsel(m1, k8[i], k8[i + 4]) + __shfl_xor(fsel(m1, k8[i + 4], k8[i]), 2);
            const float k0 = fsel(m0, k4[0], k4[2]) + __shfl_xor(fsel(m0, k4[2], k4[0]), 1);
            const float k1 = fsel(m0, k4[1], k4[3]) + __shfl_xor(fsel(m0, k4[3], k4[1]), 1);
            bstore4(rp, cvt_pk_bf16(k0, k1), vl4, (t * 16 + sl) * 256);
        }
    }
}
__device__ __forceinline__ void phase_pa(const Params& p, int bid, int nb) {
    const int tid = threadIdx.x, lane = tid & 63, wave = tid >> 6;
    const int gw = bid * 8 + wave, NGW = nb * 8;
    for (int it = gw; it < SEQ * 2; it += NGW) {
        const int t = it >> 1, pp = (it & 1) * 64 + lane;
        const bf16_t* pr = p.part + (size_t)t * 2048 + pp;
        float hs = 0.f;
#pragma unroll
        for (int sl = 0; sl < 16; ++sl) hs += __uint_as_float((unsigned)pr[sl * 128] << 16);
        hs *= p.sdv[(size_t)t * 128 + pp];
        p.act[(size_t)t * 128 + pp] = p.gsu[(size_t)t * 128 + pp] * 0.5f * hs * (1.0f + erff(hs * 0.70710678118654752f));
    }
}
__device__ __forceinline__ void phase_pu(const Params& p, int bid, int nb) {
    const int tid = threadIdx.x, lane = tid & 63, wave = __builtin_amdgcn_readfirstlane(tid >> 6);
    const int v = bid & 7, lw = (bid >> 3) * 8 + wave, NLW = (nb >> 3) * 8;
    const int c = lane & 7, sub = lane >> 3;
    const int m3 = -((lane >> 3) & 1), m4 = -((lane >> 4) & 1), m5 = -((lane >> 5) & 1);
    const __amdgpu_buffer_rsrc_t ru = __builtin_amdgcn_make_buffer_rsrc((void*)p.up8, 0, 16384 * D, 0x00020000);
    const __amdgpu_buffer_rsrc_t rh = __builtin_amdgcn_make_buffer_rsrc((void*)p.h2b, 0, SEQ * D * 2, 0x00020000);
    const __amdgpu_buffer_rsrc_t ri = __builtin_amdgcn_make_buffer_rsrc((void*)p.idx, 0, SEQ * 128 * 4, 0x00020000);
    const __amdgpu_buffer_rsrc_t ra = __builtin_amdgcn_make_buffer_rsrc((void*)p.act, 0, SEQ * 128 * 4, 0x00020000);
    const __amdgpu_buffer_rsrc_t ro = __builtin_amdgcn_make_buffer_rsrc((void*)p.out, 0, SEQ * D * 4, 0x00020000);
    const __amdgpu_buffer_rsrc_t rq = __builtin_amdgcn_make_buffer_rsrc((void*)p.ssq2, 0, SEQ * 16 * 4, 0x00020000);
    const int vsub = sub * 64, vc1 = c * 16, vh = c * 32 + sub * 4, vo = c * 64 + sub * 8;
#pragma unroll 1
    for (int pass = 0; pass < 2; ++pass) {
        const int sl = v * 2 + pass;
        u32x4 ix[4], ac[4]; unsigned hb;
        {
            const int t = lw;
#pragma unroll
            for (int i = 0; i < 4; ++i) { ix[i] = bload16(ri, vsub, t * 512 + i * 16); ac[i] = bload16(ra, vsub, t * 512 + i * 16); }
            hb = bload4(rh, vh, t * 4096 + sl * 256);
        }
#pragma unroll 1
        for (int t = lw; t < SEQ; t += NLW) {
            asm volatile("" ::: "memory");
            u32x4 w[16];
            {
                const unsigned e[16] = {ix[0].x, ix[0].y, ix[0].z, ix[0].w, ix[1].x, ix[1].y, ix[1].z, ix[1].w, ix[2].x, ix[2].y, ix[2].z, ix[2].w, ix[3].x, ix[3].y, ix[3].z, ix[3].w};
#pragma unroll
                for (int g = 0; g < 16; ++g) w[g] = bload16(ru, (int)(e[g] * 2048u) + vc1, sl * 128);
            }
            const float a[16] = {__uint_as_float(ac[0].x), __uint_as_float(ac[0].y), __uint_as_float(ac[0].z), __uint_as_float(ac[0].w), __uint_as_float(ac[1].x), __uint_as_float(ac[1].y), __uint_as_float(ac[1].z), __uint_as_float(ac[1].w),
                                 __uint_as_float(ac[2].x), __uint_as_float(ac[2].y), __uint_as_float(ac[2].z), __uint_as_float(ac[2].w), __uint_as_float(ac[3].x), __uint_as_float(ac[3].y), __uint_as_float(ac[3].z), __uint_as_float(ac[3].w)};
            const unsigned hcur = hb;
            asm volatile("" ::: "memory");
            {
                const int tn = t + NLW < SEQ ? t + NLW : t;
#pragma unroll
                for (int i = 0; i < 4; ++i) { ix[i] = bload16(ri, vsub, tn * 512 + i * 16); ac[i] = bload16(ra, vsub, tn * 512 + i * 16); }
                hb = bload4(rh, vh, tn * 4096 + sl * 256);
            }
            asm volatile("" ::: "memory");
            f32x2 acc[8];
#pragma unroll
            for (int i = 0; i < 8; ++i) acc[i] = (f32x2){0.f, 0.f};
#pragma unroll
            for (int g = 0; g < 16; ++g) axpy16_fp8(w[g], a[g], acc, 0);
            f32x2 k4[4], k2[2];
#pragma unroll
            for (int i = 0; i < 4; ++i) k4[i] = fsel2(m5, acc[i], acc[i + 4]) + shx2(fsel2(m5, acc[i + 4], acc[i]), 32);
#pragma unroll
            for (int i = 0; i < 2; ++i) k2[i] = fsel2(m4, k4[i], k4[i + 2]) + shx2(fsel2(m4, k4[i + 2], k4[i]), 16);
            f32x2 h3 = fsel2(m3, k2[0], k2[1]) + shx2(fsel2(m3, k2[1], k2[0]), 8);
            h3 += (f32x2){bf_lo(hcur), bf_hi(hcur)};
            bstore8(ro, h3, vo, t * 8192 + sl * 512);
            const float ss = wave_sum(h3.x * h3.x + h3.y * h3.y);
            if (lane == 0) bstore4(rq, __float_as_uint(ss), 0, (t * 16 + sl) * 4);
        }
    }
}
__device__ __forceinline__ void phase_pf(const Params& p, int bid, int nb) {
    const int tid = threadIdx.x, lane = tid & 63, wave = tid >> 6;
    const int gw = bid * 8 + wave, NGW = nb * 8;
    for (int t = gw; t < SEQ; t += NGW) {
        const f32x4* sp = (const f32x4*)(p.ssq2 + (size_t)t * 16); f32x4 q = sp[0] + sp[1] + sp[2] + sp[3];
        const float rf = rsqrtf(((q[0] + q[1]) + (q[2] + q[3])) * (1.0f / D) + 1e-6f);
        f32x4* o = (f32x4*)(p.out + (size_t)t * D) + lane; const f32x4* g = (const f32x4*)p.fin_g + lane;
#pragma unroll
        for (int j = 0; j < 8; ++j) o[64 * j] = o[64 * j] * rf * g[64 * j];
    }
}

__device__ __forceinline__ void fp8_row(const float* src, unsigned char* dst, float* inv_scale, int lane) {
    f32x4 v[2][4]; float am = 0.f;
#pragma unroll
    for (int k = 0; k < 2; ++k)
#pragma unroll
        for (int i = 0; i < 4; ++i) { v[k][i] = *(const f32x4*)(src + 1024 * k + 16 * lane + 4 * i);
            am = fmaxf(am, fmaxf(fmaxf(fabsf(v[k][i].x), fabsf(v[k][i].y)), fmaxf(fabsf(v[k][i].z), fabsf(v[k][i].w)))); }
#pragma unroll
    for (int o = 1; o < 64; o <<= 1) am = fmaxf(am, __shfl_xor(am, o));
    int be = (__float_as_int(am) >> 23) & 255; be = be < 8 ? 8 : (be > 248 ? 248 : be);
    const float sc = __int_as_float((260 - be) << 23), isc = __int_as_float((be - 6) << 23);
#pragma unroll
    for (int k = 0; k < 2; ++k) { u32x4 w; unsigned ww[4];
#pragma unroll
        for (int i = 0; i < 4; ++i) { int t = 0; t = __builtin_amdgcn_cvt_pk_fp8_f32(v[k][i].x * sc, v[k][i].y * sc, t, false); t = __builtin_amdgcn_cvt_pk_fp8_f32(v[k][i].z * sc, v[k][i].w * sc, t, true); ww[i] = (unsigned)t; }
        w.x = ww[0]; w.y = ww[1]; w.z = ww[2]; w.w = ww[3];
        *(u32x4*)(dst + 1024 * k + 16 * lane) = w; }
    if (lane == 0) *inv_scale = isc;
}

__device__ __forceinline__ void tr_item(const float* W, int ldw, int srccol0, int k0, bf16_t* WT, int ldt, int n0, const float* kscale, const float* nscale, LAS float* scr, int lane) {
#pragma unroll 8
    for (int i = 0; i < 32; ++i) { const int kk = 2 * i + (lane >> 5); float v = W[(size_t)(k0 + kk) * ldw + srccol0 + (lane & 31)];
        if (kscale) v *= kscale[k0 + kk]; if (nscale) v *= nscale[srccol0 + (lane & 31)]; scr[kk * 33 + (lane & 31)] = v; }
    asm volatile("s_waitcnt lgkmcnt(0)" ::: "memory");
    const int c = lane & 7;
#pragma unroll
    for (int j = 0; j < 4; ++j) { const int n = (lane >> 3) + 8 * j; const LAS float* s = scr + (8 * c) * 33 + n;
        u32x4 o; o.x = cvt_pk_bf16(s[0 * 33], s[1 * 33]); o.y = cvt_pk_bf16(s[2 * 33], s[3 * 33]); o.z = cvt_pk_bf16(s[4 * 33], s[5 * 33]); o.w = cvt_pk_bf16(s[6 * 33], s[7 * 33]);
        *(u32x4*)(WT + (size_t)(n0 + n) * ldt + k0 + 8 * c) = o; }
    asm volatile("s_waitcnt lgkmcnt(0)" ::: "memory");
}
__device__ __forceinline__ int win_srccol(int n) { const int pn = n >> 8, w = n & 255; return pn < 4 ? n : ((w >> 7) ? 2048 : 1024) + (pn - 4) * 128 + (w & 127); }

__device__ __forceinline__ void phase_prep(const Params& p, LAS unsigned char* lds, int bid, int nb) {
    const int tid = threadIdx.x, lane = tid & 63, wave = tid >> 6;
    const int gw = bid * 8 + wave, NGW = nb * 8;
    LAS float* scr = (LAS float*)(lds + wave * 8448);
    for (int r = gw; r < RT; r += NGW) {
        unsigned long long* o8 = (unsigned long long*)(p.hnb + (size_t)r * D) + lane;
        if (r < RPAD) {
#pragma unroll
            for (int j = 0; j < 8; ++j) o8[64 * j] = 0ull;
        } else {
            const f32x4* xr = (const f32x4*)hrow(p, r - RPAD) + lane;
            const f32x4* gr = (const f32x4*)p.mix_g + lane;
            f32x4 v[8]; float s = 0.f;
#pragma unroll
            for (int j = 0; j < 8; ++j) { v[j] = xr[64 * j]; s += (v[j].x * v[j].x + v[j].y * v[j].y) + (v[j].z * v[j].z + v[j].w * v[j].w); }
            const float rs = rsqrtf(wave_sum(s) * (1.0f / D) + 1e-6f);
#pragma unroll
            for (int j = 0; j < 8; ++j) { const f32x4 gv = gr[64 * j];
                o8[64 * j] = (unsigned long long)cvt_pk_bf16(v[j].x * rs * gv.x, v[j].y * rs * gv.y) | ((unsigned long long)cvt_pk_bf16(v[j].z * rs * gv.z, v[j].w * rs * gv.w) << 32); }
        }
    }
    for (int it = gw; it < (D / 64) * (INW / 32); it += NGW) {
        const int kb = it / (INW / 32), nbk = it % (INW / 32);
        tr_item(p.w_in, INW, win_srccol(nbk * 32), kb * 64, p.w_in_t, D, nbk * 32, nullptr, nullptr, scr, lane);
    }
    for (int i = gw * 64 + lane; i < 4 * 256 * 256 / 4; i += NGW * 64) { const f32x4 v = ((const f32x4*)p.pool_w)[i];
        const int g = i >> 14, d = (i & 63) * 4; const f32x4 sc = *(const f32x4*)(p.pool_scale + g * 256 + d);
        u32x2 w; w.x = cvt_pk_bf16(v[0] * sc[0], v[1] * sc[1]); w.y = cvt_pk_bf16(v[2] * sc[2], v[3] * sc[3]); ((u32x2*)p.pool_ws)[i] = w; }
    for (int i = gw * 64 + lane; i < CWD * CWD / 4; i += NGW * 64) { const f32x4 v = ((const f32x4*)p.pw_w)[i];
        u32x2 w; w.x = cvt_pk_bf16(v[0], v[1]); w.y = cvt_pk_bf16(v[2], v[3]); ((u32x2*)p.pw_b16)[i] = w; }
    if (gw < D / 64) { const int n = gw * 64 + lane; float a0 = 0.f, a1 = 0.f, a2 = 0.f, a3 = 0.f;
        for (int j = 0; j < CWD; j += 4) { a0 += p.pw_b[j] * p.w_out[(size_t)(PWD + j) * D + n]; a1 += p.pw_b[j + 1] * p.w_out[(size_t)(PWD + j + 1) * D + n];
            a2 += p.pw_b[j + 2] * p.w_out[(size_t)(PWD + j + 2) * D + n]; a3 += p.pw_b[j + 3] * p.w_out[(size_t)(PWD + j + 3) * D + n]; }
        p.bias_eff[n] = (a0 + a1) + (a2 + a3); }
    for (int it = gw; it < 32 * 64; it += NGW) { const int kb = it >> 6, nbk = it & 63;
        tr_item(p.w_out, D, nbk * 32, kb * 64, p.w_out_t, D, nbk * 32, nullptr, nullptr, scr, lane); }
    for (int it = gw; it < 32 * 64; it += NGW) { const int kb = it >> 6, nbk = it & 63;
        tr_item(p.wq, D, nbk * 32, kb * 64, p.wq_t, D, nbk * 32, p.ffn_g, nullptr, scr, lane); }
    for (int i = gw * 64 + lane; i < 8 * 2 * 128 * 128 / 4; i += NGW * 64) { const f32x4 v = ((const f32x4*)p.keys)[i];
        u32x2 w; w.x = cvt_pk_bf16(v[0], v[1]); w.y = cvt_pk_bf16(v[2], v[3]); ((u32x2*)p.keysb)[i] = w; }
    for (int e = gw; e < 2 * 16384; e += NGW) {
        if (e < 16384) fp8_row(p.down + (size_t)e * D, p.down8 + (size_t)e * D, p.sdn + e, lane);
        else fp8_row(p.up + (size_t)(e - 16384) * D, p.up8 + (size_t)(e - 16384) * D, p.sup + (e - 16384), lane);
    }
}


#define XB_TMO      128
#define XB_XCNT(j)  (256  + 64 * (j))
#define XB_XSUB(j)  (1280 + 64 * (j))
#define XB_XGEN(j)  (2304 + 64 * (j))
#define XB_TOP      3328
#define XB_TOPGEN   3392
#define XCD_BAR_WORDS 3456
#define XB_SPIN_CAP (1u << 18)
__device__ __forceinline__ unsigned xb_ld(unsigned* p)              { return __hip_atomic_load(p, __ATOMIC_RELAXED, __HIP_MEMORY_SCOPE_AGENT); }
__device__ __forceinline__ unsigned xb_add(unsigned* p, unsigned v) { return __hip_atomic_fetch_add(p, v, __ATOMIC_RELAXED, __HIP_MEMORY_SCOPE_AGENT); }
__device__ __forceinline__ unsigned xb_xcc_id() { return (unsigned)__builtin_amdgcn_s_getreg((3 << 11) | 20) & 0xFu; }
#define XB_SPIN(cond, bar) do { unsigned _sp = 0; while (cond) { __builtin_amdgcn_s_sleep(1); \
    if ((++_sp & 255u) == 0u) { if (xb_ld(&(bar)[XB_TMO])) break; if (_sp > XB_SPIN_CAP) { atomicAdd(&(bar)[XB_TMO], 1u); break; } } } } while (0)
struct XcdBarrier { unsigned* bar; unsigned x; volatile LAS unsigned* st; };
__device__ __forceinline__ XcdBarrier xcd_barrier_post(unsigned* bar, volatile LAS unsigned* st) {
    XcdBarrier b; b.bar = bar; b.x = xb_xcc_id(); b.st = st;
    if (threadIdx.x == 0) (void)xb_add(&bar[XB_XCNT(b.x)], 1u);
    return b;
}
__device__ __forceinline__ void xcd_barrier_complete(unsigned* bar, unsigned x, unsigned& nloc, unsigned& nx) {
    const unsigned G = gridDim.x * gridDim.y * gridDim.z;
    unsigned sum, cnt, mine, sp = 0u;
    for (;;) {
        sum = 0u; cnt = 0u; mine = 0u;
#pragma unroll
        for (unsigned j = 0; j < 16; ++j) { const unsigned c = xb_ld(&bar[XB_XCNT(j)]); sum += c; cnt += (c > 0u) ? 1u : 0u; mine = (j == x) ? c : mine; }
        if (sum == G) break;
        __builtin_amdgcn_s_sleep(1);
        if ((++sp & 255u) == 0u) { if (xb_ld(&bar[XB_TMO])) break; if (sp > XB_SPIN_CAP) { atomicAdd(&bar[XB_TMO], 1u); break; } }
    }
    nloc = mine > 0u ? mine : 1u; nx = cnt > 0u ? cnt : 1u;
}
__device__ __forceinline__ void xcd_barrier(const XcdBarrier& b) {
    asm volatile("s_waitcnt vmcnt(0)" ::: "memory");
    __syncthreads();
    if (threadIdx.x == 0) {
        unsigned* bar = b.bar;
        __builtin_amdgcn_s_waitcnt(0);
        unsigned nloc = b.st[0], nx = b.st[1];
        if (nloc == 0u) { xcd_barrier_complete(bar, b.x, nloc, nx); b.st[0] = nloc; b.st[1] = nx; }
        const unsigned old = xb_add(&bar[XB_XSUB(b.x)], 1u);
        const unsigned gen = old / nloc;
        if (old + 1u == (gen + 1u) * nloc) {
            __builtin_amdgcn_fence(__ATOMIC_RELEASE, "agent");
            asm volatile("s_waitcnt vmcnt(0)" ::: "memory");
            const unsigned og = xb_add(&bar[XB_TOP], 1u);
            const unsigned tg = og / nx;
            if (og + 1u == (tg + 1u) * nx) xb_add(&bar[XB_TOPGEN], 1u);
            else XB_SPIN(xb_ld(&bar[XB_TOPGEN]) == tg, bar);
            __builtin_amdgcn_fence(__ATOMIC_ACQUIRE, "agent");
            xb_add(&bar[XB_XGEN(b.x)], 1u);
            asm volatile("s_waitcnt vmcnt(0)" ::: "memory");
        } else {
            XB_SPIN(xb_ld(&bar[XB_XGEN(b.x)]) == gen, bar);
            __builtin_amdgcn_fence(__ATOMIC_ACQUIRE, "agent");
            asm volatile("s_waitcnt vmcnt(0)" ::: "memory");
        }
    }
    __syncthreads();
}

__global__ void __launch_bounds__(NT, 2) k_mega(Params p) {
    extern __shared__ __attribute__((aligned(16))) unsigned char lds_raw[];
    LAS unsigned char* lds = (LAS unsigned char*)lds_raw;
    cg::grid_group grid = cg::this_grid();
    const int bid = blockIdx.x, nb = gridDim.x;
    volatile LAS unsigned* bst = (volatile LAS unsigned*)(lds + 131072);
    if (threadIdx.x < 4) bst[threadIdx.x] = 0u;
    __syncthreads();
    const XcdBarrier xb = xcd_barrier_post(p.bar, bst);
    phase_prep(p, lds, bid, nb);
    grid.sync();
    { pg8::Gemm g{p.hnb, p.w_in_t, D, D, D, 0}; pg8::StaticOrder S; S.init(RT / 256, INW / 256, nb, bid); EpiProj E{p.xp, p.glu};
      pg8::gemm_phase<EpiProj, pg8::StaticOrder>(lds, g, S, E); }
    { const int nproj = (RT / 256) * (INW / 256); const int first = (nproj > nb && nproj < 2 * nb) ? nproj - nb : 0, nfree = nb - first;
      for (int uu = bid - first; uu >= 0 && uu < 64; uu += nfree) {
        __syncthreads();
        const bool pw = uu < 32;
        pg8::Gemm g{pw ? p.w_out_t + PWD : p.w_out_t, pw ? p.pw_b16 : p.pool_ws, D, pw ? CWD : 256, pw ? CWD : 256, pw ? 0 : 256};
        pg8::OneUnit S; S.u.pm = (uu & 31) >> 2; S.u.pn = uu & 3; EpiBf16Out E{p.w_eff_t, D, pw ? PWD : 0, nullptr};
        pg8::gemm_phase<EpiBf16Out, pg8::OneUnit>(lds, g, S, E);
      }
    }
    xcd_barrier(xb);
    phase_mix(p, lds, bid, nb);
    xcd_barrier(xb);
    { pg8::Gemm g{p.mixb, p.w_eff_t, D, D, D, 0}; pg8::StaticOrder S; S.init(SEQ / 256, D / 256, nb, bid); EpiResid E{p.x, p.bias_eff, p.h2b, p.ssq};
      pg8::gemm_phase<EpiResid, pg8::StaticOrder>(lds, g, S, E); }
    xcd_barrier(xb);
    { pg8::Gemm g{p.h2b, p.wq_t, D, D, D, 0}; pg8::StaticOrder S; S.init(SEQ / 256, D / 256, nb, bid); EpiQ E{p.ssq, p.rstd, p.qb};
      pg8::gemm_phase<EpiQ, pg8::StaticOrder>(lds, g, S, E); }
    xcd_barrier(xb);
    phase_topk2(p, lds, bid, nb);
    xcd_barrier(xb);
    phase_pd(p, bid, nb);
    xcd_barrier(xb);
    phase_pa(p, bid, nb);
    xcd_barrier(xb);
    phase_pu(p, bid, nb);
    xcd_barrier(xb);
    phase_pf(p, bid, nb);
}

extern "C" void kernel_launch(void* const* d_in, const int* in_sizes, int n_in, void* d_out, int out_size, void* d_ws, size_t ws_size, hipStream_t stream) {
    Params p{};
    p.x = (const float*)d_in[0]; p.meta = (const float*)d_in[1]; p.mix_g = (const float*)d_in[2]; p.w_in = (const float*)d_in[3];
    p.pool_w = (const float*)d_in[4]; p.pool_scale = (const float*)d_in[5]; p.dw_w = (const float*)d_in[6]; p.dw_b = (const float*)d_in[7];
    p.ln_g = (const float*)d_in[8]; p.ln_b = (const float*)d_in[9]; p.pw_w = (const float*)d_in[10]; p.pw_b = (const float*)d_in[11];
    p.w_out = (const float*)d_in[12]; p.ffn_g = (const float*)d_in[13]; p.wq = (const float*)d_in[14]; p.keys = (const float*)d_in[15];
    p.down = (const float*)d_in[16]; p.up = (const float*)d_in[17]; p.fin_g = (const float*)d_in[18];
    p.out = (float*)d_out;
    char* w = (char*)d_ws; size_t off = 0;
    auto take = [&](size_t bytes) { char* r = w + off; off += (bytes + 255) & ~(size_t)255; return r; };
    p.idx = (int*)take((size_t)SEQ * 128 * 4);
    p.gsu = (float*)take((size_t)SEQ * 128 * 4);
    p.part = (bf16_t*)take((size_t)SEQ * 16 * 128 * 2);
    p.act = (float*)take((size_t)SEQ * 128 * 4);
    p.ssq2 = (float*)take((size_t)SEQ * 16 * 4);
    p.sdv = (float*)take((size_t)SEQ * 128 * 4);
    p.hnb = (bf16_t*)take((size_t)RT * D * 2);
    p.w_in_t = (bf16_t*)take((size_t)INW * D * 2);
    p.xp = (bf16_t*)take((size_t)RT * PWD * 2);
    p.glu = (bf16_t*)take((size_t)RT * CWD * 2);
    p.mixb = (bf16_t*)take((size_t)SEQ * D * 2);
    p.h2b = (bf16_t*)take((size_t)SEQ * D * 2);
    p.pool_ws = (bf16_t*)take((size_t)4 * 256 * 256 * 2);
    p.pw_b16 = (bf16_t*)take((size_t)CWD * CWD * 2);
    p.w_eff_t = (bf16_t*)take((size_t)D * D * 2);
    p.bias_eff = (float*)take((size_t)D * 4);
    p.w_out_t = (bf16_t*)take((size_t)D * D * 2);
    p.ssq = (float*)take((size_t)SEQ * 32 * 4);
    p.bar = (unsigned*)take((size_t)XCD_BAR_WORDS * 4);
    p.rstd = (float*)take((size_t)SEQ * 4);
    p.wq_t = (bf16_t*)take((size_t)D * D * 2);
    p.keysb = (bf16_t*)take((size_t)8 * 2 * 128 * 128 * 2);
    p.qb = (bf16_t*)take((size_t)SEQ * D * 2);
    p.down8 = (unsigned char*)take((size_t)16384 * D);
    p.up8 = (unsigned char*)take((size_t)16384 * D);
    p.sdn = (float*)take((size_t)16384 * 4);
    p.sup = (float*)take((size_t)16384 * 4);
    static int grid_blocks = 0;
    if (!grid_blocks) {
        int dev = 0, cus = 0, per_cu = 0;
        (void)hipGetDevice(&dev);
        (void)hipDeviceGetAttribute(&cus, hipDeviceAttributeMultiprocessorCount, dev);
        (void)hipFuncSetAttribute((const void*)k_mega, hipFuncAttributeMaxDynamicSharedMemorySize, LDS_BYTES);
        (void)hipOccupancyMaxActiveBlocksPerMultiprocessor(&per_cu, k_mega, NT, LDS_BYTES);
        if (per_cu < 1) fprintf(stderr, "occupancy query says %d blocks per CU\n", per_cu);
        grid_blocks = cus;
    }
    (void)hipMemsetAsync(p.bar, 0, (size_t)XCD_BAR_WORDS * 4, stream);
    void* args[] = {&p};
    hipError_t e = hipLaunchCooperativeKernel((void*)k_mega, dim3(grid_blocks), dim3(NT), args, LDS_BYTES, stream);
    if (e != hipSuccess) fprintf(stderr, "cooperative launch failed: %s (grid %d)\n", hipGetErrorString(e), grid_blocks);
}
```

```cpp
#include <hip/hip_runtime.h>
#include <hip/hip_cooperative_groups.h>
#include <stdint.h>
#include <cstdio>
namespace cg = cooperative_groups;

#define NT 512
#define LAS __attribute__((address_space(3)))
typedef unsigned short bf16_t;
typedef short bf16x8 __attribute__((ext_vector_type(8)));
typedef float f32x4 __attribute__((ext_vector_type(4)));
typedef unsigned u32x4 __attribute__((ext_vector_type(4)));
typedef unsigned u32x2 __attribute__((ext_vector_type(2)));

constexpr int D = 2048, SEQ = 8192, NMETA = 16, T = SEQ + NMETA;
constexpr int PWD = 1024, CWD = 1024, INW = 3072;
constexpr int KS = 31;
constexpr int RPAD = 240, RT = 8448;
constexpr int LDS_BYTES = 147456;

struct Params {
    const float *x, *meta, *mix_g, *w_in, *pool_w, *pool_scale, *dw_w, *dw_b, *ln_g, *ln_b, *pw_w, *pw_b, *w_out, *ffn_g, *wq, *keys, *down, *up, *fin_g;
    float* out;
    int* idx;
    unsigned* bar;
    bf16_t *hnb, *w_in_t, *xp, *glu, *mixb, *h2b, *pool_ws, *pw_b16, *w_eff_t, *w_out_t, *wq_t, *keysb, *qb;
    unsigned char *down8, *up8;
    float *sdn, *sup;
    float *gsu, *sdv;
    bf16_t* part;
    float *act, *ssq2;
    bf16_t* h3b;
    float *ssq, *rstd, *bias_eff;
};

__device__ __forceinline__ unsigned cvt_pk_bf16(float lo, float hi) { unsigned r; asm volatile("v_cvt_pk_bf16_f32 %0, %1, %2" : "=v"(r) : "v"(lo), "v"(hi)); return r; }
__device__ __forceinline__ float wave_sum(float v) {
#pragma unroll
    for (int o = 1; o < 64; o <<= 1) v += __shfl_xor(v, o);
    return v;
}

__device__ __forceinline__ const float* hrow(const Params& p, int t) { return t < NMETA ? p.meta + (size_t)t * D : p.x + (size_t)(t - NMETA) * D; }

__device__ __forceinline__ float block_sum(float v, float* red) {
#pragma unroll
    for (int o = 32; o; o >>= 1) v += __shfl_xor(v, o);
    __syncthreads();
    if ((threadIdx.x & 63) == 0) red[threadIdx.x >> 6] = v;
    __syncthreads();
    float s = 0.f;
#pragma unroll
    for (int i = 0; i < NT / 64; ++i) s += red[i];
    return s;
}

namespace pg8 {
constexpr int BM = 256, BK = 64, HALF = 128, HTB = HALF * BK * 2, STAGE_BYTES = 8 * HTB, NXCD = 8, WGM = 8;
__device__ __forceinline__ int lds_byte(int r, int c) { const int st = (r >> 4) * 2 + (c >> 5), rr = r & 15, cc = c & 31, ob = rr * 64 + cc * 2; return st * 1024 + (ob ^ (((ob >> 9) & 1) << 5)); }
__device__ __forceinline__ void stage_rc(int b, int& R, int& C) { const int st = b / 1024, sb = b % 1024, swz = sb ^ (((sb >> 9) & 1) << 5); R = (st >> 1) * 16 + swz / 64; C = (st & 1) * 32 + (swz % 64) / 2; }
struct Unit { int pm, pn; };
struct Gemm { const bf16_t* A; const bf16_t* Bt; int lda, ldb, K; int a_col_per_pn; };
struct StaticOrder {
    int nM, nN, nwg, G, c;
    __device__ void init(int nM_, int nN_, int G_, int c_) { nM = nM_; nN = nN_; nwg = nM * nN; G = G_; c = c_; }
    __device__ bool next(int i, Unit& u) const {
        const long L = (long)i * G + c; if (L >= nwg) return false;
        int wgid = (int)L; { const int q = nwg / NXCD, r = nwg % NXCD, xcd = wgid % NXCD, off = wgid / NXCD; wgid = (xcd < r ? xcd * (q + 1) : r * (q + 1) + (xcd - r) * q) + off; }
        const int nig = WGM * nN, gid = wgid / nig, fm = gid * WGM, gsz = (nM - fm) < WGM ? (nM - fm) : WGM;
        u.pm = fm + ((wgid % nig) % gsz); u.pn = (wgid % nig) / gsz; return true;
    }
};
struct OneUnit { Unit u; __device__ bool next(int i, Unit& o) const { if (i) return false; o = u; return true; } };
template <class Epi, class Sched>
__device__ __forceinline__ void gemm_phase(LAS unsigned char* lds, const Gemm g, const Sched& S, const Epi& E) {
    const int tid = threadIdx.x, wid = __builtin_amdgcn_readfirstlane(tid >> 6), lane = tid & 63, wr = wid >> 2, wc = wid & 3, fr = lane & 15, fq = lane >> 4;
    const int K = g.K, nt = K / BK;
    unsigned voffA[2], voffB[2];
#pragma unroll
    for (int i = 0; i < 2; ++i) { int R, C; stage_rc(tid * 16 + i * 8192, R, C);
        voffA[i] = (unsigned)(R * g.lda + C) * 2u; voffB[i] = (unsigned)(R * g.ldb + C) * 2u; }
    const size_t kstep = (size_t)(BK * 2);
    const size_t hstepA = (size_t)HALF * g.lda * 2, hstepB = (size_t)HALF * g.ldb * 2;
    const size_t tstepA = 2 * hstepA, tstepB = 2 * hstepB;
    const unsigned ldsw = (unsigned)wid * 1024u;
    const int aoff = lds_byte(wr * 64 + fr, fq * 8), boff = lds_byte(wc * 32 + fr, fq * 8);
#define PG8_SA(b, h) (((b) * 2 + (h)) * HTB)
#define PG8_SB(b, h) ((4 + (b) * 2 + (h)) * HTB)
#define PG8_STAGE(bufoff, gbase, voff) do { _Pragma("unroll") for (int _i = 0; _i < 2; ++_i) \
        __builtin_amdgcn_global_load_lds((const unsigned*)((const char*)(gbase) + (voff)[_i]), (LAS unsigned*)(lds + (bufoff) + ldsw + _i * 8192), 16, 0, 0); } while (0)
#define PG8_LDA(dst, b, h) do { _Pragma("unroll") for (int m = 0; m < 4; ++m) _Pragma("unroll") for (int k = 0; k < 2; ++k) dst[m][k] = *(const LAS bf16x8*)(lds + PG8_SA(b, h) + aoff + m * 2048 + k * 1024); } while (0)
#define PG8_LDB(dst, b, h) do { _Pragma("unroll") for (int n = 0; n < 2; ++n) _Pragma("unroll") for (int k = 0; k < 2; ++k) dst[n][k] = *(const LAS bf16x8*)(lds + PG8_SB(b, h) + boff + n * 2048 + k * 1024); } while (0)
#define PG8_MMA(ai, bj, At, Bt) do { __builtin_amdgcn_s_setprio(1); _Pragma("unroll") for (int m = 0; m < 4; ++m) _Pragma("unroll") for (int n = 0; n < 2; ++n) _Pragma("unroll") for (int k = 0; k < 2; ++k) \
        acc[ai][bj][m][n] = __builtin_amdgcn_mfma_f32_16x16x32_bf16(Bt[n][k], At[m][k], acc[ai][bj][m][n], 0, 0, 0); __builtin_amdgcn_s_setprio(0); } while (0)
#define PG8_WAIT_V(n) asm volatile("s_waitcnt vmcnt(" #n ")" ::: "memory")
#define PG8_WAIT_L(n) asm volatile("s_waitcnt lgkmcnt(" #n ")" ::: "memory")
#define PG8_BAR __builtin_amdgcn_s_barrier()
#define PG8_SCHED __builtin_amdgcn_sched_barrier(0)
    Unit cur, nxt; int ui = 0;
    if (!S.next(0, cur)) return;
    f32x4 acc[2][2][4][2];
#pragma unroll
    for (int a = 0; a < 2; ++a)
#pragma unroll
        for (int b = 0; b < 2; ++b)
#pragma unroll
            for (int m = 0; m < 4; ++m)
#pragma unroll
                for (int n = 0; n < 2; ++n) acc[a][b][m][n] = (f32x4){0.f, 0.f, 0.f, 0.f};
    bf16x8 At[4][2], B0[2][2], B1[2][2];
    const char* cA = (const char*)g.A + (size_t)cur.pm * tstepA + (size_t)cur.pn * g.a_col_per_pn * 2; const char* cB = (const char*)g.Bt + (size_t)cur.pn * tstepB;
    PG8_STAGE(PG8_SB(0, 0), cB, voffB); PG8_STAGE(PG8_SA(0, 0), cA, voffA); PG8_STAGE(PG8_SB(0, 1), cB + hstepB, voffB); PG8_STAGE(PG8_SA(0, 1), cA + hstepA, voffA);
    if (wr == 1) PG8_BAR;
    PG8_WAIT_V(4); PG8_BAR;
    PG8_STAGE(PG8_SB(1, 0), cB + kstep, voffB); PG8_STAGE(PG8_SA(1, 0), cA + kstep, voffA); PG8_STAGE(PG8_SB(1, 1), cB + hstepB + kstep, voffB);
    PG8_WAIT_V(6); PG8_BAR;
    for (;;) {
        const bool has_next = S.next(ui + 1, nxt);
        const char* nA = has_next ? (const char*)g.A + (size_t)nxt.pm * tstepA + (size_t)nxt.pn * g.a_col_per_pn * 2 : cA; const char* nB = has_next ? (const char*)g.Bt + (size_t)nxt.pn * tstepB : cB;
        for (int t = 0; t < nt; t += 2) {
            const bool last = (t == nt - 2);
            const char* a1 = cA + (size_t)(t + 1) * kstep;
            const char* a2 = last ? nA : cA + (size_t)(t + 2) * kstep; const char* b2 = last ? nB : cB + (size_t)(t + 2) * kstep;
            const char* a3 = a2 + kstep; const char* b3 = b2 + kstep;
            PG8_LDB(B0, 0, 0); PG8_SCHED; PG8_LDA(At, 0, 0); PG8_STAGE(PG8_SA(1, 1), a1 + hstepA, voffA);
            PG8_WAIT_L(8); PG8_BAR; PG8_WAIT_L(0); PG8_MMA(0, 0, At, B0); PG8_BAR; PG8_SCHED;
            PG8_LDB(B1, 0, 1); PG8_STAGE(PG8_SB(0, 0), b2, voffB);
            PG8_BAR; PG8_WAIT_L(0); PG8_MMA(0, 1, At, B1); PG8_BAR;
            PG8_LDA(At, 0, 1); PG8_STAGE(PG8_SA(0, 0), a2, voffA);
            PG8_BAR; PG8_WAIT_L(0); PG8_MMA(1, 0, At, B0); PG8_BAR; PG8_SCHED;
            PG8_STAGE(PG8_SB(0, 1), b2 + hstepB, voffB);
            PG8_WAIT_V(6); PG8_BAR; PG8_MMA(1, 1, At, B1); PG8_BAR;
            PG8_LDB(B0, 1, 0); PG8_SCHED; PG8_LDA(At, 1, 0); PG8_STAGE(PG8_SA(0, 1), a2 + hstepA, voffA);
            PG8_WAIT_L(8); PG8_BAR; PG8_WAIT_L(0); PG8_MMA(0, 0, At, B0); PG8_BAR; PG8_SCHED;
            PG8_LDB(B1, 1, 1); PG8_STAGE(PG8_SB(1, 0), b3, voffB);
            PG8_BAR; PG8_WAIT_L(0); PG8_MMA(0, 1, At, B1); PG8_BAR;
            PG8_LDA(At, 1, 1); PG8_STAGE(PG8_SA(1, 0), a3, voffA);
            PG8_BAR; PG8_WAIT_L(0); PG8_MMA(1, 0, At, B0); PG8_BAR; PG8_SCHED;
            PG8_STAGE(PG8_SB(1, 1), b3 + hstepB, voffB);
            PG8_WAIT_V(6); PG8_BAR; PG8_MMA(1, 1, At, B1); PG8_BAR;
        }
        E(acc, cur, wr, wc, fr, fq);
        if (!has_next) break;
#pragma unroll
        for (int a = 0; a < 2; ++a)
#pragma unroll
            for (int b = 0; b < 2; ++b)
#pragma unroll
                for (int m = 0; m < 4; ++m)
#pragma unroll
                    for (int n = 0; n < 2; ++n) acc[a][b][m][n] = (f32x4){0.f, 0.f, 0.f, 0.f};
        cur = nxt; cA = nA; cB = nB; ++ui;
    }
    PG8_WAIT_V(0);
    if (wr == 0) PG8_BAR;
    PG8_BAR;
#undef PG8_SA
#undef PG8_SB
#undef PG8_STAGE
#undef PG8_LDA
#undef PG8_LDB
#undef PG8_MMA
#undef PG8_WAIT_V
#undef PG8_WAIT_L
#undef PG8_BAR
#undef PG8_SCHED
}
}

struct EpiProjF32 {
    float* proj;
    __device__ __forceinline__ void operator()(const f32x4 (&acc)[2][2][4][2], const pg8::Unit& u, int wr, int wc, int fr, int fq) const {
#pragma unroll
        for (int ai = 0; ai < 2; ++ai)
#pragma unroll
            for (int m = 0; m < 4; ++m) {
                const int t = u.pm * 256 + ai * 128 + wr * 64 + m * 16 + fr - RPAD;
                if (t >= 0) {
#pragma unroll
                    for (int bj = 0; bj < 2; ++bj)
#pragma unroll
                        for (int n = 0; n < 2; ++n) {
                            const int off = wc * 32 + n * 16 + fq * 4;
                            const int col = u.pn < 4 ? u.pn * 256 + bj * 128 + off : (bj ? 2048 : 1024) + (u.pn - 4) * 128 + off;
                            *(f32x4*)(proj + (size_t)t * INW + col) = acc[ai][bj][m][n];
                        }
                }
            }
    }
};


__device__ __forceinline__ float sigmoidf_fast(float x) { return __builtin_amdgcn_rcpf(1.0f + __expf(-x)); }

struct EpiProj {
    bf16_t* xp; bf16_t* glu;
    __device__ __forceinline__ void operator()(const f32x4 (&acc)[2][2][4][2], const pg8::Unit& u, int wr, int wc, int fr, int fq) const {
#pragma unroll
        for (int ai = 0; ai < 2; ++ai)
#pragma unroll
            for (int m = 0; m < 4; ++m) {
                const size_t row = (size_t)(u.pm * 256 + ai * 128 + wr * 64 + m * 16 + fr);
                if (u.pn < 4) {
#pragma unroll
                    for (int bj = 0; bj < 2; ++bj)
#pragma unroll
                        for (int n = 0; n < 2; ++n) { const f32x4 v = acc[ai][bj][m][n]; u32x2 w; w.x = cvt_pk_bf16(v[0], v[1]); w.y = cvt_pk_bf16(v[2], v[3]);
                            *(u32x2*)(xp + row * PWD + u.pn * 256 + bj * 128 + wc * 32 + n * 16 + fq * 4) = w; }
                } else {
#pragma unroll
                    for (int n = 0; n < 2; ++n) { const f32x4 a = acc[ai][0][m][n], g = acc[ai][1][m][n]; u32x2 w;
                        w.x = cvt_pk_bf16(a[0] * sigmoidf_fast(g[0]), a[1] * sigmoidf_fast(g[1])); w.y = cvt_pk_bf16(a[2] * sigmoidf_fast(g[2]), a[3] * sigmoidf_fast(g[3]));
                        *(u32x2*)(glu + row * CWD + (u.pn - 4) * 128 + wc * 32 + n * 16 + fq * 4) = w; }
                }
            }
    }
};
struct EpiBf16Out {
    bf16_t* O; int ldc; int col0; const float* bias;
    __device__ __forceinline__ void operator()(const f32x4 (&acc)[2][2][4][2], const pg8::Unit& u, int wr, int wc, int fr, int fq) const {
#pragma unroll
        for (int ai = 0; ai < 2; ++ai)
#pragma unroll
            for (int m = 0; m < 4; ++m) {
                const size_t row = (size_t)(u.pm * 256 + ai * 128 + wr * 64 + m * 16 + fr);
#pragma unroll
                for (int bj = 0; bj < 2; ++bj)
#pragma unroll
                    for (int n = 0; n < 2; ++n) { const int c = u.pn * 256 + bj * 128 + wc * 32 + n * 16 + fq * 4; f32x4 v = acc[ai][bj][m][n];
                        if (bias) v += *(const f32x4*)(bias + c);
                        u32x2 w; w.x = cvt_pk_bf16(v[0], v[1]); w.y = cvt_pk_bf16(v[2], v[3]);
                        *(u32x2*)(O + row * ldc + col0 + c) = w; }
            }
    }
};
struct EpiResid {
    const float* x; const float* bias; bf16_t* h2b; float* ssq;
    __device__ __forceinline__ void operator()(const f32x4 (&acc)[2][2][4][2], const pg8::Unit& u, int wr, int wc, int fr, int fq) const {
#pragma unroll
        for (int ai = 0; ai < 2; ++ai)
#pragma unroll
            for (int m = 0; m < 4; ++m) {
                const size_t row = (size_t)(u.pm * 256 + ai * 128 + wr * 64 + m * 16 + fr);
                float ss = 0.f;
#pragma unroll
                for (int bj = 0; bj < 2; ++bj)
#pragma unroll
                    for (int n = 0; n < 2; ++n) { const int c = u.pn * 256 + bj * 128 + wc * 32 + n * 16 + fq * 4;
                        const f32x4 v = acc[ai][bj][m][n] + *(const f32x4*)(x + row * D + c) + *(const f32x4*)(bias + c);
                        u32x2 w; w.x = cvt_pk_bf16(v[0], v[1]); w.y = cvt_pk_bf16(v[2], v[3]);
                        *(u32x2*)(h2b + row * D + c) = w;
                        ss += (v[0] * v[0] + v[1] * v[1]) + (v[2] * v[2] + v[3] * v[3]); }
                ss += __shfl_xor(ss, 16); ss += __shfl_xor(ss, 32);
                if (fq == 0) ssq[row * 32 + u.pn * 4 + wc] = ss;
            }
    }
};

__device__ __forceinline__ float fsel(int mask, float a, float b) { return __int_as_float((__float_as_int(a) & ~mask) | (__float_as_int(b) & mask)); }
__device__ __forceinline__ float bf_lo(unsigned w) { return __uint_as_float(w << 16); }
__device__ __forceinline__ float bf_hi(unsigned w) { return __uint_as_float(w & 0xffff0000u); }

__device__ __forceinline__ u32x4 bload16(__amdgpu_buffer_rsrc_t r, int voff, int soff) { return __builtin_bit_cast(u32x4, __builtin_amdgcn_raw_buffer_load_b128(r, voff, soff, 0)); }
__device__ __forceinline__ unsigned bload4(__amdgpu_buffer_rsrc_t r, int voff, int soff) { return (unsigned)__builtin_amdgcn_raw_buffer_load_b32(r, voff, soff, 0); }
__device__ __forceinline__ void bstore4(__amdgpu_buffer_rsrc_t r, unsigned v, int voff, int soff) { __builtin_amdgcn_raw_buffer_store_b32(v, r, voff, soff, 0); }
template <int W> __device__ __forceinline__ void pool_tile(__amdgpu_buffer_rsrc_t rxp, __amdgpu_buffer_rsrc_t rpo, int r0, int tile, int tid) {
    unsigned v[32 + W - 1];
#pragma unroll
    for (int i = 0; i < 32 + W - 1; ++i) v[i] = bload4(rxp, tid * 4, (r0 - (W - 1) + i) * 2048);
    float s0 = 0.f, s1 = 0.f;
#pragma unroll
    for (int i = 0; i < W - 1; ++i) { s0 += bf_lo(v[i]); s1 += bf_hi(v[i]); }
    constexpr float inv = 1.0f / (float)W;
#pragma unroll
    for (int i = 0; i < 32; ++i) {
        const float a0 = bf_lo(v[W - 1 + i]), a1 = bf_hi(v[W - 1 + i]);
        s0 += a0; s1 += a1;
        bstore4(rpo, cvt_pk_bf16(s0 * inv - a0, s1 * inv - a1), tid * 4, (tile * 32 + i) * 4096);
        s0 -= bf_lo(v[i]); s1 -= bf_hi(v[i]);
    }
}
__device__ __forceinline__ void phase_mix(const Params& p, LAS unsigned char* lds, int bid, int nb) {
    const int tid = threadIdx.x, lane = tid & 63, wave = tid >> 6;
    LAS unsigned* gl = (LAS unsigned*)lds;
    LAS float* red = (LAS float*)(lds + 62 * 2048);
    const __amdgpu_buffer_rsrc_t rxp = __builtin_amdgcn_make_buffer_rsrc((void*)p.xp, 0, RT * PWD * 2, 0x00020000);
    const __amdgpu_buffer_rsrc_t rgl = __builtin_amdgcn_make_buffer_rsrc((void*)p.glu, 0, RT * CWD * 2, 0x00020000);
    const __amdgpu_buffer_rsrc_t rpo = __builtin_amdgcn_make_buffer_rsrc((void*)p.mixb, 0, SEQ * D * 2, 0x00020000);
    const __amdgpu_buffer_rsrc_t rww = __builtin_amdgcn_make_buffer_rsrc((void*)p.dw_w, 0, KS * CWD * 4, 0x00020000);
    const __amdgpu_buffer_rsrc_t rwb = __builtin_amdgcn_make_buffer_rsrc((void*)p.dw_b, 0, CWD * 4, 0x00020000);
    const __amdgpu_buffer_rsrc_t rlg = __builtin_amdgcn_make_buffer_rsrc((void*)p.ln_g, 0, CWD * 4, 0x00020000);
    const __amdgpu_buffer_rsrc_t rlb = __builtin_amdgcn_make_buffer_rsrc((void*)p.ln_b, 0, CWD * 4, 0x00020000);
    for (int tile = bid; tile < SEQ / 32; tile += nb) {
        const int r0 = 256 + tile * 32;
        __syncthreads();
#pragma unroll
        for (int j = 0; j < 16; ++j) { const int ch = j * NT + tid; if (ch < 62 * 128)
            *(LAS u32x4*)(lds + ch * 16) = bload16(rgl, tid * 16, (r0 - 30) * 2048 + j * 8192); }
        { const int g = __builtin_amdgcn_readfirstlane(tid >> 7);
          if (g == 0) pool_tile<2>(rxp, rpo, r0, tile, tid); else if (g == 1) pool_tile<4>(rxp, rpo, r0, tile, tid); else if (g == 2) pool_tile<8>(rxp, rpo, r0, tile, tid); else pool_tile<16>(rxp, rpo, r0, tile, tid); }
        __syncthreads();
#pragma unroll 1
        for (int hf = 0; hf < 2; ++hf) {
            float c0[16], c1[16];
            {
                float w0[KS], w1[KS];
#pragma unroll
                for (int k = 0; k < KS; ++k) { w0[k] = __uint_as_float(bload4(rww, tid * 8, k * 4096)); w1[k] = __uint_as_float(bload4(rww, tid * 8 + 4, k * 4096)); }
                const float b0 = __uint_as_float(bload4(rwb, tid * 8, 0)), b1 = __uint_as_float(bload4(rwb, tid * 8 + 4, 0));
#pragma unroll
                for (int i = 0; i < 16; ++i) { c0[i] = b0; c1[i] = b1; }
                const LAS unsigned* glh = gl + hf * 16 * 512 + tid;
#pragma unroll
                for (int rr = 0; rr < 46; ++rr) {
                    if ((rr & 7) == 0) asm volatile("" ::: "memory");
                    const unsigned vv = glh[rr * 512]; const float x0 = bf_lo(vv), x1 = bf_hi(vv);
#pragma unroll
                    for (int i = 0; i < 16; ++i) { const int k = rr - i; if (k >= 0 && k < KS) { c0[i] += x0 * w0[k]; c1[i] += x1 * w1[k]; } }
                }
            }
            asm volatile("" ::: "memory");
#pragma unroll
            for (int which = 0; which < 2; ++which) {
                float st[16];
#pragma unroll
                for (int i = 0; i < 16; ++i) st[i] = which == 0 ? c0[i] + c1[i] : c0[i] * c0[i] + c1[i] * c1[i];
#pragma unroll
                for (int lvl = 0; lvl < 4; ++lvl) {
                    const int o = 32 >> lvl, n = 8 >> lvl; const int mk = -((lane >> (5 - lvl)) & 1);
#pragma unroll
                    for (int j = 0; j < 8; ++j) if (j < n) st[j] = fsel(mk, st[j], st[j + n]) + __shfl_xor(fsel(mk, st[j + n], st[j]), o);
                }
                float tot = st[0] + __shfl_xor(st[0], 2); tot += __shfl_xor(tot, 1);
                if ((lane & 3) == 0) red[wave * 32 + which * 16 + (lane >> 2)] = tot;
            }
            __syncthreads();
            if (tid < 32) { float t = 0.f;
#pragma unroll
                for (int q = 0; q < 8; ++q) t += red[q * 32 + tid];
                red[256 + tid] = t; }
            __syncthreads();
            const float lg0 = __uint_as_float(bload4(rlg, tid * 8, 0)), lg1 = __uint_as_float(bload4(rlg, tid * 8 + 4, 0)), lb0 = __uint_as_float(bload4(rlb, tid * 8, 0)), lb1 = __uint_as_float(bload4(rlb, tid * 8 + 4, 0));
#pragma unroll
            for (int i = 0; i < 16; ++i) {
                const float s1 = red[256 + i], s2 = red[256 + 16 + i];
                const float mu = s1 * (1.0f / CWD), var = fmaxf(s2 * (1.0f / CWD) - mu * mu, 0.f), rs = rsqrtf(var + 1e-5f);
                const float y0 = (c0[i] - mu) * rs * lg0 + lb0, y1 = (c1[i] - mu) * rs * lg1 + lb1;
                bstore4(rpo, cvt_pk_bf16(y0 * sigmoidf_fast(y0), y1 * sigmoidf_fast(y1)), tid * 4, (tile * 32 + hf * 16 + i) * 4096 + 2048);
            }
            __syncthreads();
        }
    }
}

struct EpiQ {
    const float* ssq; float* rstd; bf16_t* qb;
    __device__ __forceinline__ void operator()(const f32x4 (&acc)[2][2][4][2], const pg8::Unit& u, int wr, int wc, int fr, int fq) const {
#pragma unroll
        for (int ai = 0; ai < 2; ++ai)
#pragma unroll
            for (int m = 0; m < 4; ++m) {
                const size_t row = (size_t)(u.pm * 256 + ai * 128 + wr * 64 + m * 16 + fr);
                const f32x4* sp = (const f32x4*)(ssq + row * 32); f32x4 t = sp[0];
#pragma unroll
                for (int i = 1; i < 8; ++i) t += sp[i];
                const float rs = rsqrtf(((t[0] + t[1]) + (t[2] + t[3])) * (1.0f / D) + 1e-6f);
                if (u.pn == 0 && wc == 0 && fq == 0) rstd[row] = rs;
#pragma unroll
                for (int bj = 0; bj < 2; ++bj)
#pragma unroll
                    for (int n = 0; n < 2; ++n) { const int c = u.pn * 256 + bj * 128 + wc * 32 + n * 16 + fq * 4; const f32x4 v = acc[ai][bj][m][n] * rs;
                        u32x2 w; w.x = cvt_pk_bf16(v[0], v[1]); w.y = cvt_pk_bf16(v[2], v[3]);
                        *(u32x2*)(qb + row * D + c) = w; }
            }
    }
};

typedef float f32x16 __attribute__((ext_vector_type(16)));
__device__ __forceinline__ int okey(float s) { const int u = __float_as_int(s); return u ^ ((u >> 31) & 0x7fffffff); }
__device__ __forceinline__ float okey_inv(int k) { return __int_as_float(k ^ ((k >> 31) & 0x7fffffff)); }
__device__ __forceinline__ void sort16_desc(int (&v)[16]) {
#pragma unroll
    for (int k = 2; k <= 16; k <<= 1) {
#pragma unroll
        for (int j = k >> 1; j > 0; j >>= 1) {
#pragma unroll
            for (int i = 0; i < 16; ++i) {
                const int l = i ^ j;
                if (l > i) { const bool desc = (i & k) == 0; const int hi = max(v[i], v[l]), lo = min(v[i], v[l]); v[i] = desc ? hi : lo; v[l] = desc ? lo : hi; }
            }
        }
    }
}
__device__ __forceinline__ void merge16_desc(int (&a)[16], const int (&b)[16]) {
#pragma unroll
    for (int i = 0; i < 16; ++i) a[i] = max(a[i], b[15 - i]);
#pragma unroll
    for (int j = 8; j > 0; j >>= 1) {
#pragma unroll
        for (int i = 0; i < 16; ++i) { const int l = i ^ j; if (l > i) { const int hi = max(a[i], a[l]), lo = min(a[i], a[l]); a[i] = hi; a[l] = lo; } }
    }
}
__device__ __forceinline__ void pair_merge(int (&a)[16]) {
    int b[16];
#pragma unroll
    for (int i = 0; i < 16; ++i) b[i] = __shfl_xor(a[i], 32);
    merge16_desc(a, b);
}
constexpr int CELL_I[64] = {0,0,0,0,0,0,0,0,0,0,0,0,0,0,0,0,1,1,1,1,1,1,1,1,2,2,2,2,2,3,3,3,3,4,4,4,5,5,6,6,7,7,8,9,10,11,12,13,14,15,0,0,0,0,0,0,0,0,0,0,0,0,0,0};
constexpr int CELL_J[64] = {0,1,2,3,4,5,6,7,8,9,10,11,12,13,14,15,0,1,2,3,4,5,6,7,0,1,2,3,4,0,1,2,3,0,1,2,0,1,0,1,0,1,0,0,0,0,0,0,0,0,0,0,0,0,0,0,0,0,0,0,0,0,0,0};
constexpr int NCELL = 50;

__device__ __forceinline__ void phase_topk2(const Params& p, LAS unsigned char* lds, int bid, int nb) {
    const int tid = threadIdx.x, lane = tid & 63, wave = tid >> 6, hh = lane >> 5, l31 = lane & 31;
    LAS int* sit = (LAS int*)(lds + wave * 8448 + lane * 132);
    LAS float* svt = (LAS float*)(lds + 67584 + wave * 8448 + lane * 132);
    const int gw = bid * 8 + wave, NGW = nb * 8;
    for (int item = gw; item < (SEQ / 32) * 8; item += NGW) {
        const int h = item & 7, tok0 = (item >> 3) * 32;
#pragma unroll 1
        for (int ph = 0; ph < 2; ++ph) {
            const bf16_t* qrow = p.qb + (size_t)(tok0 + l31) * D + h * 256 + ph * 128 + 8 * hh;
            const bf16_t* krow = p.keysb + ((size_t)(h * 2 + ph) * 128 + l31) * 128 + 8 * hh;
            bf16x8 bq[8];
#pragma unroll
            for (int ks = 0; ks < 8; ++ks) bq[ks] = *(const bf16x8*)(qrow + ks * 16);
            int top[16];
#pragma unroll
            for (int i = 0; i < 16; ++i) top[i] = (int)0x80000000;
#pragma unroll 1
            for (int kt = 0; kt < 4; ++kt) {
                f32x16 c = {0.f, 0.f, 0.f, 0.f, 0.f, 0.f, 0.f, 0.f, 0.f, 0.f, 0.f, 0.f, 0.f, 0.f, 0.f, 0.f};
#pragma unroll
                for (int ks = 0; ks < 8; ++ks) { const bf16x8 ak = *(const bf16x8*)(krow + (size_t)kt * 32 * 128 + ks * 16);
                    c = __builtin_amdgcn_mfma_f32_32x32x16_bf16(ak, bq[ks], c, 0, 0, 0); }
                int v[16];
                const int lowb = (127 - kt * 32) ^ (hh << 2);
#pragma unroll
                for (int r = 0; r < 16; ++r) v[r] = (okey(c[r]) & ~127) | (lowb - ((r & 3) + 8 * (r >> 2)));
                sort16_desc(v);
                merge16_desc(top, v);
            }
            pair_merge(top);
#pragma unroll
            for (int i = 0; i < 16; ++i) { svt[ph * 16 + i] = okey_inv(top[i] & ~127); sit[ph * 16 + i] = 127 - (top[i] & 127); }
        }
        float sv[2][16];
#pragma unroll
        for (int i = 0; i < 16; ++i) { sv[0][i] = svt[i]; sv[1][i] = svt[16 + i]; }
        int w0[16], w1[16];
#pragma unroll
        for (int s = 0; s < 32; ++s) {
            const int e0 = 2 * s, e1 = 2 * s + 1;
            int key;
            if (e0 >= NCELL) key = (int)0x80000000;
            else {
                const float v0 = sv[0][CELL_I[e0]] + sv[1][CELL_J[e0]];
                const int k0 = (okey(v0) & ~255) | (255 - (CELL_I[e0] * 16 + CELL_J[e0]));
                if (e1 >= NCELL) key = hh ? (int)0x80000000 : k0;
                else { const float v1 = sv[0][CELL_I[e1]] + sv[1][CELL_J[e1]];
                    const int k1 = (okey(v1) & ~255) | (255 - (CELL_I[e1] * 16 + CELL_J[e1]));
                    key = hh ? k1 : k0; }
            }
            if (s < 16) w0[s] = key; else w1[s - 16] = key;
        }
        sort16_desc(w0); sort16_desc(w1); merge16_desc(w0, w1); pair_merge(w0);
        const float mx = okey_inv(w0[0] & ~255);
        float sum = 0.f;
#pragma unroll
        for (int k = 0; k < 16; ++k) sum += __expf(okey_inv(w0[k] & ~255) - mx);
        const float inv = 1.0f / sum;
        int eo[8]; float go[8]; const int hmask = -hh;
#pragma unroll
        for (int k = 0; k < 8; ++k) { const int kk = (w0[k] & ~hmask) | (w0[8 + k] & hmask); const int cc = 255 - (kk & 255);
            eo[k] = sit[cc >> 4] * 128 + sit[16 + (cc & 15)]; go[k] = __expf(okey_inv(kk & ~255) - mx) * inv; }
        float so[8];
#pragma unroll
        for (int k = 0; k < 8; ++k) { go[k] *= p.sup[eo[k]]; so[k] = p.sdn[eo[k]]; }
        const size_t ob = (size_t)(tok0 + l31) * 128 + h * 16 + hh * 8;
        *(u32x4*)(p.idx + ob) = (u32x4){(unsigned)eo[0], (unsigned)eo[1], (unsigned)eo[2], (unsigned)eo[3]};
        *(u32x4*)(p.idx + ob + 4) = (u32x4){(unsigned)eo[4], (unsigned)eo[5], (unsigned)eo[6], (unsigned)eo[7]};
        *(f32x4*)(p.gsu + ob) = (f32x4){go[0], go[1], go[2], go[3]};
        *(f32x4*)(p.gsu + ob + 4) = (f32x4){go[4], go[5], go[6], go[7]};
        *(f32x4*)(p.sdv + ob) = (f32x4){so[0], so[1], so[2], so[3]};
        *(f32x4*)(p.sdv + ob + 4) = (f32x4){so[4], so[5], so[6], so[7]};
    }
}


typedef float f32x2 __attribute__((ext_vector_type(2)));
template <int N> __device__ __forceinline__ f32x2 dot16_fp8(const u32x4 w, const f32x2 (&x)[N], int o, f32x2 acc) {
    const unsigned ww[4] = {w.x, w.y, w.z, w.w};
#pragma unroll
    for (int d = 0; d < 4; ++d) { acc += __builtin_amdgcn_cvt_pk_f32_fp8((int)ww[d], false) * x[o + 2 * d]; acc += __builtin_amdgcn_cvt_pk_f32_fp8((int)ww[d], true) * x[o + 2 * d + 1]; }
    return acc;
}
template <int N> __device__ __forceinline__ void axpy16_fp8(const u32x4 w, float a, f32x2 (&y)[N], int o) {
    const unsigned ww[4] = {w.x, w.y, w.z, w.w}; const f32x2 a2 = {a, a};
#pragma unroll
    for (int d = 0; d < 4; ++d) { y[o + 2 * d] += a2 * __builtin_amdgcn_cvt_pk_f32_fp8((int)ww[d], false); y[o + 2 * d + 1] += a2 * __builtin_amdgcn_cvt_pk_f32_fp8((int)ww[d], true); }
}
__device__ __forceinline__ void bstore16(__amdgpu_buffer_rsrc_t r, f32x4 v, int voff, int soff) { __builtin_amdgcn_raw_buffer_store_b128(__builtin_bit_cast(__attribute__((__vector_size__(4 * sizeof(unsigned)))) unsigned, v), r, voff, soff, 0); }
__device__ __forceinline__ void bstore8(__amdgpu_buffer_rsrc_t r, f32x2 v, int voff, int soff) { __builtin_amdgcn_raw_buffer_store_b64(__builtin_bit_cast(__attribute__((__vector_size__(2 * sizeof(unsigned)))) unsigned, v), r, voff, soff, 0); }
__device__ __forceinline__ f32x2 fsel2(int mask, f32x2 a, f32x2 b) { return (f32x2){fsel(mask, a.x, b.x), fsel(mask, a.y, b.y)}; }
__device__ __forceinline__ f32x2 shx2(f32x2 a, int o) { return (f32x2){__shfl_xor(a.x, o), __shfl_xor(a.y, o)}; }

__device__ __forceinline__ void phase_pd(const Params& p, int bid, int nb) {
    const int tid = threadIdx.x, lane = tid & 63, wave = __builtin_amdgcn_readfirstlane(tid >> 6);
    const int v = bid & 7, lw = (bid >> 3) * 8 + wave, NLW = (nb >> 3) * 8;
    const int c = lane & 7, sub = lane >> 3;
    const int m0 = -(lane & 1), m1 = -((lane >> 1) & 1), m2 = -((lane >> 2) & 1);
    const __amdgpu_buffer_rsrc_t rd = __builtin_amdgcn_make_buffer_rsrc((void*)p.down8, 0, 16384 * D, 0x00020000);
    const __amdgpu_buffer_rsrc_t rh = __builtin_amdgcn_make_buffer_rsrc((void*)p.h2b, 0, SEQ * D * 2, 0x00020000);
    const __amdgpu_buffer_rsrc_t rg1 = __builtin_amdgcn_make_buffer_rsrc((void*)p.ffn_g, 0, D * 4, 0x00020000);
    const __amdgpu_buffer_rsrc_t ri = __builtin_amdgcn_make_buffer_rsrc((void*)p.idx, 0, SEQ * 128 * 4, 0x00020000);
    const __amdgpu_buffer_rsrc_t rrs = __builtin_amdgcn_make_buffer_rsrc((void*)p.rstd, 0, SEQ * 4, 0x00020000);
    const __amdgpu_buffer_rsrc_t rp = __builtin_amdgcn_make_buffer_rsrc((void*)p.part, 0, SEQ * 16 * 128 * 2, 0x00020000);
    const int vsub = sub * 64, vc2 = c * 32, vc1 = c * 16, vl4 = lane * 4;
#pragma unroll 1
    for (int pass = 0; pass < 2; ++pass) {
        const int sl = v * 2 + pass;
        f32x2 gs[8];
#pragma unroll
        for (int i = 0; i < 4; ++i) { const f32x4 g = __builtin_bit_cast(f32x4, bload16(rg1, c * 64, sl * 512 + i * 16)); gs[2 * i] = (f32x2){g[0], g[1]}; gs[2 * i + 1] = (f32x2){g[2], g[3]}; }
        u32x4 ix[4], hh[2]; unsigned rsb;
        {
            const int t = lw;
#pragma unroll
            for (int i = 0; i < 4; ++i) ix[i] = bload16(ri, vsub, t * 512 + i * 16);
            hh[0] = bload16(rh, vc2, t * 4096 + sl * 256); hh[1] = bload16(rh, vc2, t * 4096 + sl * 256 + 16); rsb = bload4(rrs, 0, t * 4);
        }
#pragma unroll 1
        for (int t = lw; t < SEQ; t += NLW) {
            asm volatile("" ::: "memory");
            u32x4 w[16];
            {
                const unsigned e[16] = {ix[0].x, ix[0].y, ix[0].z, ix[0].w, ix[1].x, ix[1].y, ix[1].z, ix[1].w, ix[2].x, ix[2].y, ix[2].z, ix[2].w, ix[3].x, ix[3].y, ix[3].z, ix[3].w};
#pragma unroll
                for (int g = 0; g < 16; ++g) w[g] = bload16(rd, (int)(e[g] * 2048u) + vc1, sl * 128);
            }
            f32x2 xs[8];
            {
                const float rs = __uint_as_float(rsb);
                const unsigned hw[8] = {hh[0].x, hh[0].y, hh[0].z, hh[0].w, hh[1].x, hh[1].y, hh[1].z, hh[1].w};
#pragma unroll
                for (int i = 0; i < 8; ++i) xs[i] = (f32x2){bf_lo(hw[i]) * rs, bf_hi(hw[i]) * rs} * gs[i];
            }
            asm volatile("" ::: "memory");
            {
                const int tn = t + NLW < SEQ ? t + NLW : t;
#pragma unroll
                for (int i = 0; i < 4; ++i) ix[i] = bload16(ri, vsub, tn * 512 + i * 16);
                hh[0] = bload16(rh, vc2, tn * 4096 + sl * 256); hh[1] = bload16(rh, vc2, tn * 4096 + sl * 256 + 16); rsb = bload4(rrs, 0, tn * 4);
            }
            asm volatile("" ::: "memory");
            float r[16];
#pragma unroll
            for (int g = 0; g < 16; ++g) { const f32x2 z = {0.f, 0.f}; const f32x2 s2 = dot16_fp8(w[g], xs, 0, z); r[g] = s2.x + s2.y; }
            float k8[8], k4[4];
#pragma unroll
            for (int i = 0; i < 8; ++i) k8[i] = fsel(m2, r[i], r[i + 8]) + __shfl_xor(fsel(m2, r[i + 8], r[i]), 4);
#pragma unroll
            for (int i = 0; i < 4; ++i) k4[i] = fsel(m1, k8[i], k8[i + 4]) + __shfl_xor(fsel(m1, k8[i + 4], k8[i]), 2);
            const float k0 = fsel(m0, k4[0], k4[2]) + __shfl_xor(fsel(m0, k4[2], k4[0]), 1);
            const float k1 = fsel(m0, k4[1], k4[3]) + __shfl_xor(fsel(m0, k4[3], k4[1]), 1);
            bstore4(rp, cvt_pk_bf16(k0, k1), vl4, (t * 16 + sl) * 256);
        }
    }
}
__device__ __forceinline__ void phase_pa(const Params& p, int bid, int nb) {
    const int tid = threadIdx.x, lane = tid & 63, wave = tid >> 6;
    const int gw = bid * 8 + wave, NGW = nb * 8;
    for (int it = gw; it < SEQ * 2; it += NGW) {
        const int t = it >> 1, pp = (it & 1) * 64 + lane;
        const bf16_t* pr = p.part + (size_t)t * 2048 + pp;
        float hs = 0.f;
#pragma unroll
        for (int sl = 0; sl < 16; ++sl) hs += __uint_as_float((unsigned)pr[sl * 128] << 16);
        hs *= p.sdv[(size_t)t * 128 + pp];
        p.act[(size_t)t * 128 + pp] = p.gsu[(size_t)t * 128 + pp] * 0.5f * hs * (1.0f + erff(hs * 0.70710678118654752f));
    }
}
__device__ __forceinline__ void phase_pu(const Params& p, int bid, int nb) {
    const int tid = threadIdx.x, lane = tid & 63, wave = __builtin_amdgcn_readfirstlane(tid >> 6);
    const int v = bid & 7, lw = (bid >> 3) * 8 + wave, NLW = (nb >> 3) * 8;
    const int c = lane & 7, sub = lane >> 3;
    const int m3 = -((lane >> 3) & 1), m4 = -((lane >> 4) & 1), m5 = -((lane >> 5) & 1);
    const __amdgpu_buffer_rsrc_t ru = __builtin_amdgcn_make_buffer_rsrc((void*)p.up8, 0, 16384 * D, 0x00020000);
    const __amdgpu_buffer_rsrc_t rh = __builtin_amdgcn_make_buffer_rsrc((void*)p.h2b, 0, SEQ * D * 2, 0x00020000);
    const __amdgpu_buffer_rsrc_t ri = __builtin_amdgcn_make_buffer_rsrc((void*)p.idx, 0, SEQ * 128 * 4, 0x00020000);
    const __amdgpu_buffer_rsrc_t ra = __builtin_amdgcn_make_buffer_rsrc((void*)p.act, 0, SEQ * 128 * 4, 0x00020000);
    const __amdgpu_buffer_rsrc_t ro = __builtin_amdgcn_make_buffer_rsrc((void*)p.h3b, 0, SEQ * D * 2, 0x00020000);
    const __amdgpu_buffer_rsrc_t rq = __builtin_amdgcn_make_buffer_rsrc((void*)p.ssq2, 0, SEQ * 16 * 4, 0x00020000);
    const int vsub = sub * 64, vc1 = c * 16, vh = c * 32 + sub * 4;
#pragma unroll 1
    for (int pass = 0; pass < 2; ++pass) {
        const int sl = v * 2 + pass;
        u32x4 ix[4], ac[4]; unsigned hb;
        {
            const int t = lw;
#pragma unroll
            for (int i = 0; i < 4; ++i) { ix[i] = bload16(ri, vsub, t * 512 + i * 16); ac[i] = bload16(ra, vsub, t * 512 + i * 16); }
            hb = bload4(rh, vh, t * 4096 + sl * 256);
        }
#pragma unroll 1
        for (int t = lw; t < SEQ; t += NLW) {
            asm volatile("" ::: "memory");
            u32x4 w[16];
            {
                const unsigned e[16] = {ix[0].x, ix[0].y, ix[0].z, ix[0].w, ix[1].x, ix[1].y, ix[1].z, ix[1].w, ix[2].x, ix[2].y, ix[2].z, ix[2].w, ix[3].x, ix[3].y, ix[3].z, ix[3].w};
#pragma unroll
                for (int g = 0; g < 16; ++g) w[g] = bload16(ru, (int)(e[g] * 2048u) + vc1, sl * 128);
            }
            const float a[16] = {__uint_as_float(ac[0].x), __uint_as_float(ac[0].y), __uint_as_float(ac[0].z), __uint_as_float(ac[0].w), __uint_as_float(ac[1].x), __uint_as_float(ac[1].y), __uint_as_float(ac[1].z), __uint_as_float(ac[1].w),
                                 __uint_as_float(ac[2].x), __uint_as_float(ac[2].y), __uint_as_float(ac[2].z), __uint_as_float(ac[2].w), __uint_as_float(ac[3].x), __uint_as_float(ac[3].y), __uint_as_float(ac[3].z), __uint_as_float(ac[3].w)};
            const unsigned hcur = hb;
            asm volatile("" ::: "memory");
            {
                const int tn = t + NLW < SEQ ? t + NLW : t;
#pragma unroll
                for (int i = 0; i < 4; ++i) { ix[i] = bload16(ri, vsub, tn * 512 + i * 16); ac[i] = bload16(ra, vsub, tn * 512 + i * 16); }
                hb = bload4(rh, vh, tn * 4096 + sl * 256);
            }
            asm volatile("" ::: "memory");
            f32x2 acc[8];
#pragma unroll
            for (int i = 0; i < 8; ++i) acc[i] = (f32x2){0.f, 0.f};
#pragma unroll
            for (int g = 0; g < 16; ++g) axpy16_fp8(w[g], a[g], acc, 0);
            f32x2 k4[4], k2[2];
#pragma unroll
            for (int i = 0; i < 4; ++i) k4[i] = fsel2(m5, acc[i], acc[i + 4]) + shx2(fsel2(m5, acc[i + 4], acc[i]), 32);
#pragma unroll
            for (int i = 0; i < 2; ++i) k2[i] = fsel2(m4, k4[i], k4[i + 2]) + shx2(fsel2(m4, k4[i + 2], k4[i]), 16);
            f32x2 h3 = fsel2(m3, k2[0], k2[1]) + shx2(fsel2(m3, k2[1], k2[0]), 8);
            h3 += (f32x2){bf_lo(hcur), bf_hi(hcur)};
            bstore4(ro, cvt_pk_bf16(h3.x, h3.y), vh, t * 4096 + sl * 256);
            const float ss = wave_sum(h3.x * h3.x + h3.y * h3.y);
            if (lane == 0) bstore4(rq, __float_as_uint(ss), 0, (t * 16 + sl) * 4);
        }
    }
}
__device__ __forceinline__ void phase_pf(const Params& p, int bid, int nb) {
    const int tid = threadIdx.x, lane = tid & 63, wave = tid >> 6;
    const int gw = bid * 8 + wave, NGW = nb * 8;
    for (int t = gw; t < SEQ; t += NGW) {
        const f32x4* sp = (const f32x4*)(p.ssq2 + (size_t)t * 16); f32x4 q = sp[0] + sp[1] + sp[2] + sp[3];
        const float rf = rsqrtf(((q[0] + q[1]) + (q[2] + q[3])) * (1.0f / D) + 1e-6f);
        const u32x4* hp = (const u32x4*)(p.h3b + (size_t)t * D) + lane;
        f32x4* o = (f32x4*)(p.out + (size_t)t * D) + 2 * lane; const f32x4* g = (const f32x4*)p.fin_g + 2 * lane;
#pragma unroll
        for (int j = 0; j < 4; ++j) { const u32x4 h = hp[64 * j]; const f32x4 g0 = g[128 * j], g1 = g[128 * j + 1];
            o[128 * j] = (f32x4){bf_lo(h.x) * rf * g0[0], bf_hi(h.x) * rf * g0[1], bf_lo(h.y) * rf * g0[2], bf_hi(h.y) * rf * g0[3]};
            o[128 * j + 1] = (f32x4){bf_lo(h.z) * rf * g1[0], bf_hi(h.z) * rf * g1[1], bf_lo(h.w) * rf * g1[2], bf_hi(h.w) * rf * g1[3]}; }
    }
}

__device__ __forceinline__ void fp8_row(const float* src, unsigned char* dst, float* inv_scale, int lane) {
    f32x4 v[2][4]; float am = 0.f;
#pragma unroll
    for (int k = 0; k < 2; ++k)
#pragma unroll
        for (int i = 0; i < 4; ++i) { v[k][i] = *(const f32x4*)(src + 1024 * k + 16 * lane + 4 * i);
            am = fmaxf(am, fmaxf(fmaxf(fabsf(v[k][i].x), fabsf(v[k][i].y)), fmaxf(fabsf(v[k][i].z), fabsf(v[k][i].w)))); }
#pragma unroll
    for (int o = 1; o < 64; o <<= 1) am = fmaxf(am, __shfl_xor(am, o));
    int be = (__float_as_int(am) >> 23) & 255; be = be < 8 ? 8 : (be > 248 ? 248 : be);
    const float sc = __int_as_float((260 - be) << 23), isc = __int_as_float((be - 6) << 23);
#pragma unroll
    for (int k = 0; k < 2; ++k) { u32x4 w; unsigned ww[4];
#pragma unroll
        for (int i = 0; i < 4; ++i) { int t = 0; t = __builtin_amdgcn_cvt_pk_fp8_f32(v[k][i].x * sc, v[k][i].y * sc, t, false); t = __builtin_amdgcn_cvt_pk_fp8_f32(v[k][i].z * sc, v[k][i].w * sc, t, true); ww[i] = (unsigned)t; }
        w.x = ww[0]; w.y = ww[1]; w.z = ww[2]; w.w = ww[3];
        *(u32x4*)(dst + 1024 * k + 16 * lane) = w; }
    if (lane == 0) *inv_scale = isc;
}

__device__ __forceinline__ void tr_item(const float* W, int ldw, int srccol0, int k0, bf16_t* WT, int ldt, int n0, const float* kscale, const float* nscale, LAS float* scr, int lane) {
#pragma unroll 8
    for (int i = 0; i < 32; ++i) { const int kk = 2 * i + (lane >> 5); float v = W[(size_t)(k0 + kk) * ldw + srccol0 + (lane & 31)];
        if (kscale) v *= kscale[k0 + kk]; if (nscale) v *= nscale[srccol0 + (lane & 31)]; scr[kk * 33 + (lane & 31)] = v; }
    asm volatile("s_waitcnt lgkmcnt(0)" ::: "memory");
    const int c = lane & 7;
#pragma unroll
    for (int j = 0; j < 4; ++j) { const int n = (lane >> 3) + 8 * j; const LAS float* s = scr + (8 * c) * 33 + n;
        u32x4 o; o.x = cvt_pk_bf16(s[0 * 33], s[1 * 33]); o.y = cvt_pk_bf16(s[2 * 33], s[3 * 33]); o.z = cvt_pk_bf16(s[4 * 33], s[5 * 33]); o.w = cvt_pk_bf16(s[6 * 33], s[7 * 33]);
        *(u32x4*)(WT + (size_t)(n0 + n) * ldt + k0 + 8 * c) = o; }
    asm volatile("s_waitcnt lgkmcnt(0)" ::: "memory");
}
__device__ __forceinline__ int win_srccol(int n) { const int pn = n >> 8, w = n & 255; return pn < 4 ? n : ((w >> 7) ? 2048 : 1024) + (pn - 4) * 128 + (w & 127); }

__device__ __forceinline__ void phase_prep(const Params& p, LAS unsigned char* lds, int bid, int nb) {
    const int tid = threadIdx.x, lane = tid & 63, wave = tid >> 6;
    const int gw = bid * 8 + wave, NGW = nb * 8;
    LAS float* scr = (LAS float*)(lds + wave * 8448);
    for (int r = gw; r < RT; r += NGW) {
        unsigned long long* o8 = (unsigned long long*)(p.hnb + (size_t)r * D) + lane;
        if (r < RPAD) {
#pragma unroll
            for (int j = 0; j < 8; ++j) o8[64 * j] = 0ull;
        } else {
            const f32x4* xr = (const f32x4*)hrow(p, r - RPAD) + lane;
            const f32x4* gr = (const f32x4*)p.mix_g + lane;
            f32x4 v[8]; float s = 0.f;
#pragma unroll
            for (int j = 0; j < 8; ++j) { v[j] = xr[64 * j]; s += (v[j].x * v[j].x + v[j].y * v[j].y) + (v[j].z * v[j].z + v[j].w * v[j].w); }
            const float rs = rsqrtf(wave_sum(s) * (1.0f / D) + 1e-6f);
#pragma unroll
            for (int j = 0; j < 8; ++j) { const f32x4 gv = gr[64 * j];
                o8[64 * j] = (unsigned long long)cvt_pk_bf16(v[j].x * rs * gv.x, v[j].y * rs * gv.y) | ((unsigned long long)cvt_pk_bf16(v[j].z * rs * gv.z, v[j].w * rs * gv.w) << 32); }
        }
    }
    for (int it = gw; it < (D / 64) * (INW / 32); it += NGW) {
        const int kb = it / (INW / 32), nbk = it % (INW / 32);
        tr_item(p.w_in, INW, win_srccol(nbk * 32), kb * 64, p.w_in_t, D, nbk * 32, nullptr, nullptr, scr, lane);
    }
    for (int i = gw * 64 + lane; i < 4 * 256 * 256 / 4; i += NGW * 64) { const f32x4 v = ((const f32x4*)p.pool_w)[i];
        const int g = i >> 14, d = (i & 63) * 4; const f32x4 sc = *(const f32x4*)(p.pool_scale + g * 256 + d);
        u32x2 w; w.x = cvt_pk_bf16(v[0] * sc[0], v[1] * sc[1]); w.y = cvt_pk_bf16(v[2] * sc[2], v[3] * sc[3]); ((u32x2*)p.pool_ws)[i] = w; }
    for (int i = gw * 64 + lane; i < CWD * CWD / 4; i += NGW * 64) { const f32x4 v = ((const f32x4*)p.pw_w)[i];
        u32x2 w; w.x = cvt_pk_bf16(v[0], v[1]); w.y = cvt_pk_bf16(v[2], v[3]); ((u32x2*)p.pw_b16)[i] = w; }
    if (gw < D / 64) { const int n = gw * 64 + lane; float a0 = 0.f, a1 = 0.f, a2 = 0.f, a3 = 0.f;
        for (int j = 0; j < CWD; j += 4) { a0 += p.pw_b[j] * p.w_out[(size_t)(PWD + j) * D + n]; a1 += p.pw_b[j + 1] * p.w_out[(size_t)(PWD + j + 1) * D + n];
            a2 += p.pw_b[j + 2] * p.w_out[(size_t)(PWD + j + 2) * D + n]; a3 += p.pw_b[j + 3] * p.w_out[(size_t)(PWD + j + 3) * D + n]; }
        p.bias_eff[n] = (a0 + a1) + (a2 + a3); }
    for (int it = gw; it < 32 * 64; it += NGW) { const int kb = it >> 6, nbk = it & 63;
        tr_item(p.w_out, D, nbk * 32, kb * 64, p.w_out_t, D, nbk * 32, nullptr, nullptr, scr, lane); }
    for (int it = gw; it < 32 * 64; it += NGW) { const int kb = it >> 6, nbk = it & 63;
        tr_item(p.wq, D, nbk * 32, kb * 64, p.wq_t, D, nbk * 32, p.ffn_g, nullptr, scr, lane); }
    for (int i = gw * 64 + lane; i < 8 * 2 * 128 * 128 / 4; i += NGW * 64) { const f32x4 v = ((const f32x4*)p.keys)[i];
        u32x2 w; w.x = cvt_pk_bf16(v[0], v[1]); w.y = cvt_pk_bf16(v[2], v[3]); ((u32x2*)p.keysb)[i] = w; }
    for (int e = gw; e < 2 * 16384; e += NGW) {
        if (e < 16384) fp8_row(p.down + (size_t)e * D, p.down8 + (size_t)e * D, p.sdn + e, lane);
        else fp8_row(p.up + (size_t)(e - 16384) * D, p.up8 + (size_t)(e - 16384) * D, p.sup + (e - 16384), lane);
    }
}


#define XB_TMO      128
#define XB_XCNT(j)  (256  + 64 * (j))
#define XB_XSUB(j)  (1280 + 64 * (j))
#define XB_XGEN(j)  (2304 + 64 * (j))
#define XB_TOP      3328
#define XB_TOPGEN   3392
#define XCD_BAR_WORDS 3456
#define XB_SPIN_CAP (1u << 18)
__device__ __forceinline__ unsigned xb_ld(unsigned* p)              { return __hip_atomic_load(p, __ATOMIC_RELAXED, __HIP_MEMORY_SCOPE_AGENT); }
__device__ __forceinline__ unsigned xb_add(unsigned* p, unsigned v) { return __hip_atomic_fetch_add(p, v, __ATOMIC_RELAXED, __HIP_MEMORY_SCOPE_AGENT); }
__device__ __forceinline__ unsigned xb_xcc_id() { return (unsigned)__builtin_amdgcn_s_getreg((3 << 11) | 20) & 0xFu; }
#define XB_SPIN(cond, bar) do { unsigned _sp = 0; while (cond) { __builtin_amdgcn_s_sleep(1); \
    if ((++_sp & 255u) == 0u) { if (xb_ld(&(bar)[XB_TMO])) break; if (_sp > XB_SPIN_CAP) { atomicAdd(&(bar)[XB_TMO], 1u); break; } } } } while (0)
struct XcdBarrier { unsigned* bar; unsigned x; volatile LAS unsigned* st; };
__device__ __forceinline__ XcdBarrier xcd_barrier_post(unsigned* bar, volatile LAS unsigned* st) {
    XcdBarrier b; b.bar = bar; b.x = xb_xcc_id(); b.st = st;
    if (threadIdx.x == 0) (void)xb_add(&bar[XB_XCNT(b.x)], 1u);
    return b;
}
__device__ __forceinline__ void xcd_barrier_complete(unsigned* bar, unsigned x, unsigned& nloc, unsigned& nx) {
    const unsigned G = gridDim.x * gridDim.y * gridDim.z;
    unsigned sum, cnt, mine, sp = 0u;
    for (;;) {
        sum = 0u; cnt = 0u; mine = 0u;
#pragma unroll
        for (unsigned j = 0; j < 16; ++j) { const unsigned c = xb_ld(&bar[XB_XCNT(j)]); sum += c; cnt += (c > 0u) ? 1u : 0u; mine = (j == x) ? c : mine; }
        if (sum == G) break;
        __builtin_amdgcn_s_sleep(1);
        if ((++sp & 255u) == 0u) { if (xb_ld(&bar[XB_TMO])) break; if (sp > XB_SPIN_CAP) { atomicAdd(&bar[XB_TMO], 1u); break; } }
    }
    nloc = mine > 0u ? mine : 1u; nx = cnt > 0u ? cnt : 1u;
}
__device__ __forceinline__ void xcd_barrier(const XcdBarrier& b) {
    asm volatile("s_waitcnt vmcnt(0)" ::: "memory");
    __syncthreads();
    if (threadIdx.x == 0) {
        unsigned* bar = b.bar;
        __builtin_amdgcn_s_waitcnt(0);
        unsigned nloc = b.st[0], nx = b.st[1];
        if (nloc == 0u) { xcd_barrier_complete(bar, b.x, nloc, nx); b.st[0] = nloc; b.st[1] = nx; }
        const unsigned old = xb_add(&bar[XB_XSUB(b.x)], 1u);
        const unsigned gen = old / nloc;
        if (old + 1u == (gen + 1u) * nloc) {
            __builtin_amdgcn_fence(__ATOMIC_RELEASE, "agent");
            asm volatile("s_waitcnt vmcnt(0)" ::: "memory");
            const unsigned og = xb_add(&bar[XB_TOP], 1u);
            const unsigned tg = og / nx;
            if (og + 1u == (tg + 1u) * nx) xb_add(&bar[XB_TOPGEN], 1u);
            else XB_SPIN(xb_ld(&bar[XB_TOPGEN]) == tg, bar);
            __builtin_amdgcn_fence(__ATOMIC_ACQUIRE, "agent");
            xb_add(&bar[XB_XGEN(b.x)], 1u);
            asm volatile("s_waitcnt vmcnt(0)" ::: "memory");
        } else {
            XB_SPIN(xb_ld(&bar[XB_XGEN(b.x)]) == gen, bar);
            __builtin_amdgcn_fence(__ATOMIC_ACQUIRE, "agent");
            asm volatile("s_waitcnt vmcnt(0)" ::: "memory");
        }
    }
    __syncthreads();
}

__global__ void __launch_bounds__(NT, 2) k_mega(Params p) {
    extern __shared__ __attribute__((aligned(16))) unsigned char lds_raw[];
    LAS unsigned char* lds = (LAS unsigned char*)lds_raw;
    cg::grid_group grid = cg::this_grid();
    const int bid = blockIdx.x, nb = gridDim.x;
    volatile LAS unsigned* bst = (volatile LAS unsigned*)(lds + LDS_BYTES - 16);
    if (threadIdx.x < 4) bst[threadIdx.x] = 0u;
    __syncthreads();
    const XcdBarrier xb = xcd_barrier_post(p.bar, bst);
    phase_prep(p, lds, bid, nb);
    grid.sync();
    { pg8::Gemm g{p.hnb, p.w_in_t, D, D, D, 0}; pg8::StaticOrder S; S.init(RT / 256, INW / 256, nb, bid); EpiProj E{p.xp, p.glu};
      pg8::gemm_phase<EpiProj, pg8::StaticOrder>(lds, g, S, E); }
    { const int nproj = (RT / 256) * (INW / 256); const int first = (nproj > nb && nproj < 2 * nb) ? nproj - nb : 0, nfree = nb - first;
      for (int uu = bid - first; uu >= 0 && uu < 64; uu += nfree) {
        __syncthreads();
        const bool pw = uu < 32;
        pg8::Gemm g{pw ? p.w_out_t + PWD : p.w_out_t, pw ? p.pw_b16 : p.pool_ws, D, pw ? CWD : 256, pw ? CWD : 256, pw ? 0 : 256};
        pg8::OneUnit S; S.u.pm = (uu & 31) >> 2; S.u.pn = uu & 3; EpiBf16Out E{p.w_eff_t, D, pw ? PWD : 0, nullptr};
        pg8::gemm_phase<EpiBf16Out, pg8::OneUnit>(lds, g, S, E);
      }
    }
    xcd_barrier(xb);
    phase_mix(p, lds, bid, nb);
    xcd_barrier(xb);
    { pg8::Gemm g{p.mixb, p.w_eff_t, D, D, D, 0}; pg8::StaticOrder S; S.init(SEQ / 256, D / 256, nb, bid); EpiResid E{p.x, p.bias_eff, p.h2b, p.ssq};
      pg8::gemm_phase<EpiResid, pg8::StaticOrder>(lds, g, S, E); }
    xcd_barrier(xb);
    { pg8::Gemm g{p.h2b, p.wq_t, D, D, D, 0}; pg8::StaticOrder S; S.init(SEQ / 256, D / 256, nb, bid); EpiQ E{p.ssq, p.rstd, p.qb};
      pg8::gemm_phase<EpiQ, pg8::StaticOrder>(lds, g, S, E); }
    xcd_barrier(xb);
    phase_topk2(p, lds, bid, nb);
    xcd_barrier(xb);
    phase_pd(p, bid, nb);
    xcd_barrier(xb);
    phase_pa(p, bid, nb);
    xcd_barrier(xb);
    phase_pu(p, bid, nb);
    xcd_barrier(xb);
    phase_pf(p, bid, nb);
}

extern "C" void kernel_launch(void* const* d_in, const int* in_sizes, int n_in, void* d_out, int out_size, void* d_ws, size_t ws_size, hipStream_t stream) {
    Params p{};
    p.x = (const float*)d_in[0]; p.meta = (const float*)d_in[1]; p.mix_g = (const float*)d_in[2]; p.w_in = (const float*)d_in[3];
    p.pool_w = (const float*)d_in[4]; p.pool_scale = (const float*)d_in[5]; p.dw_w = (const float*)d_in[6]; p.dw_b = (const float*)d_in[7];
    p.ln_g = (const float*)d_in[8]; p.ln_b = (const float*)d_in[9]; p.pw_w = (const float*)d_in[10]; p.pw_b = (const float*)d_in[11];
    p.w_out = (const float*)d_in[12]; p.ffn_g = (const float*)d_in[13]; p.wq = (const float*)d_in[14]; p.keys = (const float*)d_in[15];
    p.down = (const float*)d_in[16]; p.up = (const float*)d_in[17]; p.fin_g = (const float*)d_in[18];
    p.out = (float*)d_out;
    char* w = (char*)d_ws; size_t off = 0;
    auto take = [&](size_t bytes) { char* r = w + off; off += (bytes + 255) & ~(size_t)255; return r; };
    p.idx = (int*)take((size_t)SEQ * 128 * 4);
    p.gsu = (float*)take((size_t)SEQ * 128 * 4);
    p.part = (bf16_t*)take((size_t)SEQ * 16 * 128 * 2);
    p.act = (float*)take((size_t)SEQ * 128 * 4);
    p.ssq2 = (float*)take((size_t)SEQ * 16 * 4);
    p.h3b = (bf16_t*)take((size_t)SEQ * D * 2);
    p.sdv = (float*)take((size_t)SEQ * 128 * 4);
    p.hnb = (bf16_t*)take((size_t)RT * D * 2);
    p.w_in_t = (bf16_t*)take((size_t)INW * D * 2);
    p.xp = (bf16_t*)take((size_t)RT * PWD * 2);
    p.glu = (bf16_t*)take((size_t)RT * CWD * 2);
    p.mixb = (bf16_t*)take((size_t)SEQ * D * 2);
    p.h2b = (bf16_t*)take((size_t)SEQ * D * 2);
    p.pool_ws = (bf16_t*)take((size_t)4 * 256 * 256 * 2);
    p.pw_b16 = (bf16_t*)take((size_t)CWD * CWD * 2);
    p.w_eff_t = (bf16_t*)take((size_t)D * D * 2);
    p.bias_eff = (float*)take((size_t)D * 4);
    p.w_out_t = (bf16_t*)take((size_t)D * D * 2);
    p.ssq = (float*)take((size_t)SEQ * 32 * 4);
    p.bar = (unsigned*)take((size_t)XCD_BAR_WORDS * 4);
    p.rstd = (float*)take((size_t)SEQ * 4);
    p.wq_t = (bf16_t*)take((size_t)D * D * 2);
    p.keysb = (bf16_t*)take((size_t)8 * 2 * 128 * 128 * 2);
    p.qb = (bf16_t*)take((size_t)SEQ * D * 2);
    p.down8 = (unsigned char*)take((size_t)16384 * D);
    p.up8 = (unsigned char*)take((size_t)16384 * D);
    p.sdn = (float*)take((size_t)16384 * 4);
    p.sup = (float*)take((size_t)16384 * 4);
    static int grid_blocks = 0;
    if (!grid_blocks) {
        int dev = 0, cus = 0, per_cu = 0;
        (void)hipGetDevice(&dev);
        (void)hipDeviceGetAttribute(&cus, hipDeviceAttributeMultiprocessorCount, dev);
        (void)hipFuncSetAttribute((const void*)k_mega, hipFuncAttributeMaxDynamicSharedMemorySize, LDS_BYTES);
        (void)hipOccupancyMaxActiveBlocksPerMultiprocessor(&per_cu, k_mega, NT, LDS_BYTES);
        if (per_cu < 1) fprintf(stderr, "occupancy query says %d blocks per CU\n", per_cu);
        grid_blocks = cus;
    }
    (void)hipMemsetAsync(p.bar, 0, (size_t)XCD_BAR_WORDS * 4, stream);
    void* args[] = {&p};
    hipError_t e = hipLaunchCooperativeKernel((void*)k_mega, dim3(grid_blocks), dim3(NT), args, LDS_BYTES, stream);
    if (e != hipSuccess) fprintf(stderr, "cooperative launch failed: %s (grid %d)\n", hipGetErrorString(e), grid_blocks);
}
```

```cpp
#include <hip/hip_runtime.h>
#include <hip/hip_cooperative_groups.h>
#include <stdint.h>
#include <cstdio>
namespace cg = cooperative_groups;

#define NT 512
#define LAS __attribute__((address_space(3)))
typedef unsigned short bf16_t;
typedef short bf16x8 __attribute__((ext_vector_type(8)));
typedef float f32x4 __attribute__((ext_vector_type(4)));
typedef unsigned u32x4 __attribute__((ext_vector_type(4)));
typedef unsigned u32x2 __attribute__((ext_vector_type(2)));

constexpr int D = 2048, SEQ = 8192, NMETA = 16, T = SEQ + NMETA;
constexpr int PWD = 1024, CWD = 1024, INW = 3072;
constexpr int KS = 31;
constexpr int RPAD = 240, RT = 8448;
constexpr int LDS_BYTES = 147456;

struct Params {
    const float *x, *meta, *mix_g, *w_in, *pool_w, *pool_scale, *dw_w, *dw_b, *ln_g, *ln_b, *pw_w, *pw_b, *w_out, *ffn_g, *wq, *keys, *down, *up, *fin_g;
    float* out;
    int* idx;
    unsigned* bar;
    bf16_t *hnb, *w_in_t, *xp, *glu, *mixb, *h2b, *pool_ws, *pw_b16, *w_eff_t, *w_out_t, *wq_t, *keysb, *qb;
    unsigned char *down8, *up8;
    float *sdn, *sup;
    float *gsu, *sdv;
    bf16_t* part;
    float *act, *ssq2;
    bf16_t* h3b;
    float *ssq, *rstd, *bias_eff;
};

__device__ __forceinline__ unsigned cvt_pk_bf16(float lo, float hi) { unsigned r; asm volatile("v_cvt_pk_bf16_f32 %0, %1, %2" : "=v"(r) : "v"(lo), "v"(hi)); return r; }
__device__ __forceinline__ float wave_sum(float v) {
#pragma unroll
    for (int o = 1; o < 64; o <<= 1) v += __shfl_xor(v, o);
    return v;
}

__device__ __forceinline__ const float* hrow(const Params& p, int t) { return t < NMETA ? p.meta + (size_t)t * D : p.x + (size_t)(t - NMETA) * D; }

__device__ __forceinline__ float block_sum(float v, float* red) {
#pragma unroll
    for (int o = 32; o; o >>= 1) v += __shfl_xor(v, o);
    __syncthreads();
    if ((threadIdx.x & 63) == 0) red[threadIdx.x >> 6] = v;
    __syncthreads();
    float s = 0.f;
#pragma unroll
    for (int i = 0; i < NT / 64; ++i) s += red[i];
    return s;
}

namespace pg8 {
constexpr int BM = 256, BK = 64, HALF = 128, HTB = HALF * BK * 2, STAGE_BYTES = 8 * HTB, NXCD = 8, WGM = 8;
__device__ __forceinline__ int lds_byte(int r, int c) { const int st = (r >> 4) * 2 + (c >> 5), rr = r & 15, cc = c & 31, ob = rr * 64 + cc * 2; return st * 1024 + (ob ^ (((ob >> 9) & 1) << 5)); }
__device__ __forceinline__ void stage_rc(int b, int& R, int& C) { const int st = b / 1024, sb = b % 1024, swz = sb ^ (((sb >> 9) & 1) << 5); R = (st >> 1) * 16 + swz / 64; C = (st & 1) * 32 + (swz % 64) / 2; }
struct Unit { int pm, pn; };
struct Gemm { const bf16_t* A; const bf16_t* Bt; int lda, ldb, K; int a_col_per_pn; };
struct StaticOrder {
    int nM, nN, nwg, G, c;
    __device__ void init(int nM_, int nN_, int G_, int c_) { nM = nM_; nN = nN_; nwg = nM * nN; G = G_; c = c_; }
    __device__ bool next(int i, Unit& u) const {
        const long L = (long)i * G + c; if (L >= nwg) return false;
        int wgid = (int)L; { const int q = nwg / NXCD, r = nwg % NXCD, xcd = wgid % NXCD, off = wgid / NXCD; wgid = (xcd < r ? xcd * (q + 1) : r * (q + 1) + (xcd - r) * q) + off; }
        const int nig = WGM * nN, gid = wgid / nig, fm = gid * WGM, gsz = (nM - fm) < WGM ? (nM - fm) : WGM;
        u.pm = fm + ((wgid % nig) % gsz); u.pn = (wgid % nig) / gsz; return true;
    }
};
struct OneUnit { Unit u; __device__ bool next(int i, Unit& o) const { if (i) return false; o = u; return true; } };
template <class Epi, class Sched>
__device__ __forceinline__ void gemm_phase(LAS unsigned char* lds, const Gemm g, const Sched& S, const Epi& E) {
    const int tid = threadIdx.x, wid = __builtin_amdgcn_readfirstlane(tid >> 6), lane = tid & 63, wr = wid >> 2, wc = wid & 3, fr = lane & 15, fq = lane >> 4;
    const int K = g.K, nt = K / BK;
    unsigned voffA[2], voffB[2];
#pragma unroll
    for (int i = 0; i < 2; ++i) { int R, C; stage_rc(tid * 16 + i * 8192, R, C);
        voffA[i] = (unsigned)(R * g.lda + C) * 2u; voffB[i] = (unsigned)(R * g.ldb + C) * 2u; }
    const size_t kstep = (size_t)(BK * 2);
    const size_t hstepA = (size_t)HALF * g.lda * 2, hstepB = (size_t)HALF * g.ldb * 2;
    const size_t tstepA = 2 * hstepA, tstepB = 2 * hstepB;
    const unsigned ldsw = (unsigned)wid * 1024u;
    const int aoff = lds_byte(wr * 64 + fr, fq * 8), boff = lds_byte(wc * 32 + fr, fq * 8);
#define PG8_SA(b, h) (((b) * 2 + (h)) * HTB)
#define PG8_SB(b, h) ((4 + (b) * 2 + (h)) * HTB)
#define PG8_STAGE(bufoff, gbase, voff) do { _Pragma("unroll") for (int _i = 0; _i < 2; ++_i) \
        __builtin_amdgcn_global_load_lds((const unsigned*)((const char*)(gbase) + (voff)[_i]), (LAS unsigned*)(lds + (bufoff) + ldsw + _i * 8192), 16, 0, 0); } while (0)
#define PG8_LDA(dst, b, h) do { _Pragma("unroll") for (int m = 0; m < 4; ++m) _Pragma("unroll") for (int k = 0; k < 2; ++k) dst[m][k] = *(const LAS bf16x8*)(lds + PG8_SA(b, h) + aoff + m * 2048 + k * 1024); } while (0)
#define PG8_LDB(dst, b, h) do { _Pragma("unroll") for (int n = 0; n < 2; ++n) _Pragma("unroll") for (int k = 0; k < 2; ++k) dst[n][k] = *(const LAS bf16x8*)(lds + PG8_SB(b, h) + boff + n * 2048 + k * 1024); } while (0)
#define PG8_MMA(ai, bj, At, Bt) do { __builtin_amdgcn_s_setprio(1); _Pragma("unroll") for (int m = 0; m < 4; ++m) _Pragma("unroll") for (int n = 0; n < 2; ++n) _Pragma("unroll") for (int k = 0; k < 2; ++k) \
        acc[ai][bj][m][n] = __builtin_amdgcn_mfma_f32_16x16x32_bf16(Bt[n][k], At[m][k], acc[ai][bj][m][n], 0, 0, 0); __builtin_amdgcn_s_setprio(0); } while (0)
#define PG8_WAIT_V(n) asm volatile("s_waitcnt vmcnt(" #n ")" ::: "memory")
#define PG8_WAIT_L(n) asm volatile("s_waitcnt lgkmcnt(" #n ")" ::: "memory")
#define PG8_BAR __builtin_amdgcn_s_barrier()
#define PG8_SCHED __builtin_amdgcn_sched_barrier(0)
    Unit cur, nxt; int ui = 0;
    if (!S.next(0, cur)) return;
    f32x4 acc[2][2][4][2];
#pragma unroll
    for (int a = 0; a < 2; ++a)
#pragma unroll
        for (int b = 0; b < 2; ++b)
#pragma unroll
            for (int m = 0; m < 4; ++m)
#pragma unroll
                for (int n = 0; n < 2; ++n) acc[a][b][m][n] = (f32x4){0.f, 0.f, 0.f, 0.f};
    bf16x8 At[4][2], B0[2][2], B1[2][2];
    const char* cA = (const char*)g.A + (size_t)cur.pm * tstepA + (size_t)cur.pn * g.a_col_per_pn * 2; const char* cB = (const char*)g.Bt + (size_t)cur.pn * tstepB;
    PG8_STAGE(PG8_SB(0, 0), cB, voffB); PG8_STAGE(PG8_SA(0, 0), cA, voffA); PG8_STAGE(PG8_SB(0, 1), cB + hstepB, voffB); PG8_STAGE(PG8_SA(0, 1), cA + hstepA, voffA);
    if (wr == 1) PG8_BAR;
    PG8_WAIT_V(4); PG8_BAR;
    PG8_STAGE(PG8_SB(1, 0), cB + kstep, voffB); PG8_STAGE(PG8_SA(1, 0), cA + kstep, voffA); PG8_STAGE(PG8_SB(1, 1), cB + hstepB + kstep, voffB);
    PG8_WAIT_V(6); PG8_BAR;
    for (;;) {
        const bool has_next = S.next(ui + 1, nxt);
        const char* nA = has_next ? (const char*)g.A + (size_t)nxt.pm * tstepA + (size_t)nxt.pn * g.a_col_per_pn * 2 : cA; const char* nB = has_next ? (const char*)g.Bt + (size_t)nxt.pn * tstepB : cB;
        for (int t = 0; t < nt; t += 2) {
            const bool last = (t == nt - 2);
            const char* a1 = cA + (size_t)(t + 1) * kstep;
            const char* a2 = last ? nA : cA + (size_t)(t + 2) * kstep; const char* b2 = last ? nB : cB + (size_t)(t + 2) * kstep;
            const char* a3 = a2 + kstep; const char* b3 = b2 + kstep;
            PG8_LDB(B0, 0, 0); PG8_SCHED; PG8_LDA(At, 0, 0); PG8_STAGE(PG8_SA(1, 1), a1 + hstepA, voffA);
            PG8_WAIT_L(8); PG8_BAR; PG8_WAIT_L(0); PG8_MMA(0, 0, At, B0); PG8_BAR; PG8_SCHED;
            PG8_LDB(B1, 0, 1); PG8_STAGE(PG8_SB(0, 0), b2, voffB);
            PG8_BAR; PG8_WAIT_L(0); PG8_MMA(0, 1, At, B1); PG8_BAR;
            PG8_LDA(At, 0, 1); PG8_STAGE(PG8_SA(0, 0), a2, voffA);
            PG8_BAR; PG8_WAIT_L(0); PG8_MMA(1, 0, At, B0); PG8_BAR; PG8_SCHED;
            PG8_STAGE(PG8_SB(0, 1), b2 + hstepB, voffB);
            PG8_WAIT_V(6); PG8_BAR; PG8_MMA(1, 1, At, B1); PG8_BAR;
            PG8_LDB(B0, 1, 0); PG8_SCHED; PG8_LDA(At, 1, 0); PG8_STAGE(PG8_SA(0, 1), a2 + hstepA, voffA);
            PG8_WAIT_L(8); PG8_BAR; PG8_WAIT_L(0); PG8_MMA(0, 0, At, B0); PG8_BAR; PG8_SCHED;
            PG8_LDB(B1, 1, 1); PG8_STAGE(PG8_SB(1, 0), b3, voffB);
            PG8_BAR; PG8_WAIT_L(0); PG8_MMA(0, 1, At, B1); PG8_BAR;
            PG8_LDA(At, 1, 1); PG8_STAGE(PG8_SA(1, 0), a3, voffA);
            PG8_BAR; PG8_WAIT_L(0); PG8_MMA(1, 0, At, B0); PG8_BAR; PG8_SCHED;
            PG8_STAGE(PG8_SB(1, 1), b3 + hstepB, voffB);
            PG8_WAIT_V(6); PG8_BAR; PG8_MMA(1, 1, At, B1); PG8_BAR;
        }
        E(acc, cur, wr, wc, fr, fq);
        if (!has_next) break;
#pragma unroll
        for (int a = 0; a < 2; ++a)
#pragma unroll
            for (int b = 0; b < 2; ++b)
#pragma unroll
                for (int m = 0; m < 4; ++m)
#pragma unroll
                    for (int n = 0; n < 2; ++n) acc[a][b][m][n] = (f32x4){0.f, 0.f, 0.f, 0.f};
        cur = nxt; cA = nA; cB = nB; ++ui;
    }
    PG8_WAIT_V(0);
    if (wr == 0) PG8_BAR;
    PG8_BAR;
#undef PG8_SA
#undef PG8_SB
#undef PG8_STAGE
#undef PG8_LDA
#undef PG8_LDB
#undef PG8_MMA
#undef PG8_WAIT_V
#undef PG8_WAIT_L
#undef PG8_BAR
#undef PG8_SCHED
}
}

struct EpiProjF32 {
    float* proj;
    __device__ __forceinline__ void operator()(const f32x4 (&acc)[2][2][4][2], const pg8::Unit& u, int wr, int wc, int fr, int fq) const {
#pragma unroll
        for (int ai = 0; ai < 2; ++ai)
#pragma unroll
            for (int m = 0; m < 4; ++m) {
                const int t = u.pm * 256 + ai * 128 + wr * 64 + m * 16 + fr - RPAD;
                if (t >= 0) {
#pragma unroll
                    for (int bj = 0; bj < 2; ++bj)
#pragma unroll
                        for (int n = 0; n < 2; ++n) {
                            const int off = wc * 32 + n * 16 + fq * 4;
                            const int col = u.pn < 4 ? u.pn * 256 + bj * 128 + off : (bj ? 2048 : 1024) + (u.pn - 4) * 128 + off;
                            *(f32x4*)(proj + (size_t)t * INW + col) = acc[ai][bj][m][n];
                        }
                }
            }
    }
};


__device__ __forceinline__ float sigmoidf_fast(float x) { return __builtin_amdgcn_rcpf(1.0f + __expf(-x)); }

struct EpiProj {
    bf16_t* xp; bf16_t* glu;
    __device__ __forceinline__ void operator()(const f32x4 (&acc)[2][2][4][2], const pg8::Unit& u, int wr, int wc, int fr, int fq) const {
#pragma unroll
        for (int ai = 0; ai < 2; ++ai)
#pragma unroll
            for (int m = 0; m < 4; ++m) {
                const size_t row = (size_t)(u.pm * 256 + ai * 128 + wr * 64 + m * 16 + fr);
                if (u.pn < 4) {
#pragma unroll
                    for (int bj = 0; bj < 2; ++bj)
#pragma unroll
                        for (int n = 0; n < 2; ++n) { const f32x4 v = acc[ai][bj][m][n]; u32x2 w; w.x = cvt_pk_bf16(v[0], v[1]); w.y = cvt_pk_bf16(v[2], v[3]);
                            *(u32x2*)(xp + row * PWD + u.pn * 256 + bj * 128 + wc * 32 + n * 16 + fq * 4) = w; }
                } else {
#pragma unroll
                    for (int n = 0; n < 2; ++n) { const f32x4 a = acc[ai][0][m][n], g = acc[ai][1][m][n]; u32x2 w;
                        w.x = cvt_pk_bf16(a[0] * sigmoidf_fast(g[0]), a[1] * sigmoidf_fast(g[1])); w.y = cvt_pk_bf16(a[2] * sigmoidf_fast(g[2]), a[3] * sigmoidf_fast(g[3]));
                        *(u32x2*)(glu + row * CWD + (u.pn - 4) * 128 + wc * 32 + n * 16 + fq * 4) = w; }
                }
            }
    }
};
struct EpiBf16Out {
    bf16_t* O; int ldc; int col0; const float* bias;
    __device__ __forceinline__ void operator()(const f32x4 (&acc)[2][2][4][2], const pg8::Unit& u, int wr, int wc, int fr, int fq) const {
#pragma unroll
        for (int ai = 0; ai < 2; ++ai)
#pragma unroll
            for (int m = 0; m < 4; ++m) {
                const size_t row = (size_t)(u.pm * 256 + ai * 128 + wr * 64 + m * 16 + fr);
#pragma unroll
                for (int bj = 0; bj < 2; ++bj)
#pragma unroll
                    for (int n = 0; n < 2; ++n) { const int c = u.pn * 256 + bj * 128 + wc * 32 + n * 16 + fq * 4; f32x4 v = acc[ai][bj][m][n];
                        if (bias) v += *(const f32x4*)(bias + c);
                        u32x2 w; w.x = cvt_pk_bf16(v[0], v[1]); w.y = cvt_pk_bf16(v[2], v[3]);
                        *(u32x2*)(O + row * ldc + col0 + c) = w; }
            }
    }
};
struct EpiResid {
    const float* x; const float* bias; bf16_t* h2b; float* ssq;
    __device__ __forceinline__ void operator()(const f32x4 (&acc)[2][2][4][2], const pg8::Unit& u, int wr, int wc, int fr, int fq) const {
#pragma unroll
        for (int ai = 0; ai < 2; ++ai)
#pragma unroll
            for (int m = 0; m < 4; ++m) {
                const size_t row = (size_t)(u.pm * 256 + ai * 128 + wr * 64 + m * 16 + fr);
                float ss = 0.f;
#pragma unroll
                for (int bj = 0; bj < 2; ++bj)
#pragma unroll
                    for (int n = 0; n < 2; ++n) { const int c = u.pn * 256 + bj * 128 + wc * 32 + n * 16 + fq * 4;
                        const f32x4 v = acc[ai][bj][m][n] + *(const f32x4*)(x + row * D + c) + *(const f32x4*)(bias + c);
                        u32x2 w; w.x = cvt_pk_bf16(v[0], v[1]); w.y = cvt_pk_bf16(v[2], v[3]);
                        *(u32x2*)(h2b + row * D + c) = w;
                        ss += (v[0] * v[0] + v[1] * v[1]) + (v[2] * v[2] + v[3] * v[3]); }
                ss += __shfl_xor(ss, 16); ss += __shfl_xor(ss, 32);
                if (fq == 0) ssq[row * 32 + u.pn * 4 + wc] = ss;
            }
    }
};

__device__ __forceinline__ float fsel(int mask, float a, float b) { return __int_as_float((__float_as_int(a) & ~mask) | (__float_as_int(b) & mask)); }
__device__ __forceinline__ float bf_lo(unsigned w) { return __uint_as_float(w << 16); }
__device__ __forceinline__ float bf_hi(unsigned w) { return __uint_as_float(w & 0xffff0000u); }

__device__ __forceinline__ u32x4 bload16(__amdgpu_buffer_rsrc_t r, int voff, int soff) { return __builtin_bit_cast(u32x4, __builtin_amdgcn_raw_buffer_load_b128(r, voff, soff, 0)); }
__device__ __forceinline__ unsigned bload4(__amdgpu_buffer_rsrc_t r, int voff, int soff) { return (unsigned)__builtin_amdgcn_raw_buffer_load_b32(r, voff, soff, 0); }
__device__ __forceinline__ void bstore4(__amdgpu_buffer_rsrc_t r, unsigned v, int voff, int soff) { __builtin_amdgcn_raw_buffer_store_b32(v, r, voff, soff, 0); }
template <int W> __device__ __forceinline__ void pool_tile(__amdgpu_buffer_rsrc_t rxp, __amdgpu_buffer_rsrc_t rpo, int r0, int tile, int tid) {
    unsigned v[32 + W - 1];
#pragma unroll
    for (int i = 0; i < 32 + W - 1; ++i) v[i] = bload4(rxp, tid * 4, (r0 - (W - 1) + i) * 2048);
    float s0 = 0.f, s1 = 0.f;
#pragma unroll
    for (int i = 0; i < W - 1; ++i) { s0 += bf_lo(v[i]); s1 += bf_hi(v[i]); }
    constexpr float inv = 1.0f / (float)W;
#pragma unroll
    for (int i = 0; i < 32; ++i) {
        const float a0 = bf_lo(v[W - 1 + i]), a1 = bf_hi(v[W - 1 + i]);
        s0 += a0; s1 += a1;
        bstore4(rpo, cvt_pk_bf16(s0 * inv - a0, s1 * inv - a1), tid * 4, (tile * 32 + i) * 4096);
        s0 -= bf_lo(v[i]); s1 -= bf_hi(v[i]);
    }
}
__device__ __forceinline__ void phase_mix(const Params& p, LAS unsigned char* lds, int bid, int nb) {
    const int tid = threadIdx.x, lane = tid & 63, wave = tid >> 6;
    LAS unsigned* gl = (LAS unsigned*)lds;
    LAS float* red = (LAS float*)(lds + 62 * 2048);
    const __amdgpu_buffer_rsrc_t rxp = __builtin_amdgcn_make_buffer_rsrc((void*)p.xp, 0, RT * PWD * 2, 0x00020000);
    const __amdgpu_buffer_rsrc_t rgl = __builtin_amdgcn_make_buffer_rsrc((void*)p.glu, 0, RT * CWD * 2, 0x00020000);
    const __amdgpu_buffer_rsrc_t rpo = __builtin_amdgcn_make_buffer_rsrc((void*)p.mixb, 0, SEQ * D * 2, 0x00020000);
    const __amdgpu_buffer_rsrc_t rww = __builtin_amdgcn_make_buffer_rsrc((void*)p.dw_w, 0, KS * CWD * 4, 0x00020000);
    const __amdgpu_buffer_rsrc_t rwb = __builtin_amdgcn_make_buffer_rsrc((void*)p.dw_b, 0, CWD * 4, 0x00020000);
    const __amdgpu_buffer_rsrc_t rlg = __builtin_amdgcn_make_buffer_rsrc((void*)p.ln_g, 0, CWD * 4, 0x00020000);
    const __amdgpu_buffer_rsrc_t rlb = __builtin_amdgcn_make_buffer_rsrc((void*)p.ln_b, 0, CWD * 4, 0x00020000);
    for (int tile = bid; tile < SEQ / 32; tile += nb) {
        const int r0 = 256 + tile * 32;
        __syncthreads();
#pragma unroll
        for (int j = 0; j < 16; ++j) { const int ch = j * NT + tid; if (ch < 62 * 128)
            *(LAS u32x4*)(lds + ch * 16) = bload16(rgl, tid * 16, (r0 - 30) * 2048 + j * 8192); }
        { const int g = __builtin_amdgcn_readfirstlane(tid >> 7);
          if (g == 0) pool_tile<2>(rxp, rpo, r0, tile, tid); else if (g == 1) pool_tile<4>(rxp, rpo, r0, tile, tid); else if (g == 2) pool_tile<8>(rxp, rpo, r0, tile, tid); else pool_tile<16>(rxp, rpo, r0, tile, tid); }
        __syncthreads();
#pragma unroll 1
        for (int hf = 0; hf < 2; ++hf) {
            float c0[16], c1[16];
            {
                float w0[KS], w1[KS];
#pragma unroll
                for (int k = 0; k < KS; ++k) { w0[k] = __uint_as_float(bload4(rww, tid * 8, k * 4096)); w1[k] = __uint_as_float(bload4(rww, tid * 8 + 4, k * 4096)); }
                const float b0 = __uint_as_float(bload4(rwb, tid * 8, 0)), b1 = __uint_as_float(bload4(rwb, tid * 8 + 4, 0));
#pragma unroll
                for (int i = 0; i < 16; ++i) { c0[i] = b0; c1[i] = b1; }
                const LAS unsigned* glh = gl + hf * 16 * 512 + tid;
#pragma unroll
                for (int rr = 0; rr < 46; ++rr) {
                    if ((rr & 7) == 0) asm volatile("" ::: "memory");
                    const unsigned vv = glh[rr * 512]; const float x0 = bf_lo(vv), x1 = bf_hi(vv);
#pragma unroll
                    for (int i = 0; i < 16; ++i) { const int k = rr - i; if (k >= 0 && k < KS) { c0[i] += x0 * w0[k]; c1[i] += x1 * w1[k]; } }
                }
            }
            asm volatile("" ::: "memory");
#pragma unroll
            for (int which = 0; which < 2; ++which) {
                float st[16];
#pragma unroll
                for (int i = 0; i < 16; ++i) st[i] = which == 0 ? c0[i] + c1[i] : c0[i] * c0[i] + c1[i] * c1[i];
#pragma unroll
                for (int lvl = 0; lvl < 4; ++lvl) {
                    const int o = 32 >> lvl, n = 8 >> lvl; const int mk = -((lane >> (5 - lvl)) & 1);
#pragma unroll
                    for (int j = 0; j < 8; ++j) if (j < n) st[j] = fsel(mk, st[j], st[j + n]) + __shfl_xor(fsel(mk, st[j + n], st[j]), o);
                }
                float tot = st[0] + __shfl_xor(st[0], 2); tot += __shfl_xor(tot, 1);
                if ((lane & 3) == 0) red[wave * 32 + which * 16 + (lane >> 2)] = tot;
            }
            __syncthreads();
            if (tid < 32) { float t = 0.f;
#pragma unroll
                for (int q = 0; q < 8; ++q) t += red[q * 32 + tid];
                red[256 + tid] = t; }
            __syncthreads();
            const float lg0 = __uint_as_float(bload4(rlg, tid * 8, 0)), lg1 = __uint_as_float(bload4(rlg, tid * 8 + 4, 0)), lb0 = __uint_as_float(bload4(rlb, tid * 8, 0)), lb1 = __uint_as_float(bload4(rlb, tid * 8 + 4, 0));
#pragma unroll
            for (int i = 0; i < 16; ++i) {
                const float s1 = red[256 + i], s2 = red[256 + 16 + i];
                const float mu = s1 * (1.0f / CWD), var = fmaxf(s2 * (1.0f / CWD) - mu * mu, 0.f), rs = rsqrtf(var + 1e-5f);
                const float y0 = (c0[i] - mu) * rs * lg0 + lb0, y1 = (c1[i] - mu) * rs * lg1 + lb1;
                bstore4(rpo, cvt_pk_bf16(y0 * sigmoidf_fast(y0), y1 * sigmoidf_fast(y1)), tid * 4, (tile * 32 + hf * 16 + i) * 4096 + 2048);
            }
            __syncthreads();
        }
    }
}

struct EpiQ {
    const float* ssq; float* rstd; bf16_t* qb;
    __device__ __forceinline__ void operator()(const f32x4 (&acc)[2][2][4][2], const pg8::Unit& u, int wr, int wc, int fr, int fq) const {
#pragma unroll
        for (int ai = 0; ai < 2; ++ai)
#pragma unroll
            for (int m = 0; m < 4; ++m) {
                const size_t row = (size_t)(u.pm * 256 + ai * 128 + wr * 64 + m * 16 + fr);
                const f32x4* sp = (const f32x4*)(ssq + row * 32); f32x4 t = sp[0];
#pragma unroll
                for (int i = 1; i < 8; ++i) t += sp[i];
                const float rs = rsqrtf(((t[0] + t[1]) + (t[2] + t[3])) * (1.0f / D) + 1e-6f);
                if (u.pn == 0 && wc == 0 && fq == 0) rstd[row] = rs;
#pragma unroll
                for (int bj = 0; bj < 2; ++bj)
#pragma unroll
                    for (int n = 0; n < 2; ++n) { const int c = u.pn * 256 + bj * 128 + wc * 32 + n * 16 + fq * 4; const f32x4 v = acc[ai][bj][m][n] * rs;
                        u32x2 w; w.x = cvt_pk_bf16(v[0], v[1]); w.y = cvt_pk_bf16(v[2], v[3]);
                        *(u32x2*)(qb + row * D + c) = w; }
            }
    }
};

typedef float f32x16 __attribute__((ext_vector_type(16)));
__device__ __forceinline__ int okey(float s) { const int u = __float_as_int(s); return u ^ ((u >> 31) & 0x7fffffff); }
__device__ __forceinline__ float okey_inv(int k) { return __int_as_float(k ^ ((k >> 31) & 0x7fffffff)); }
__device__ __forceinline__ void sort16_desc(int (&v)[16]) {
#pragma unroll
    for (int k = 2; k <= 16; k <<= 1) {
#pragma unroll
        for (int j = k >> 1; j > 0; j >>= 1) {
#pragma unroll
            for (int i = 0; i < 16; ++i) {
                const int l = i ^ j;
                if (l > i) { const bool desc = (i & k) == 0; const int hi = max(v[i], v[l]), lo = min(v[i], v[l]); v[i] = desc ? hi : lo; v[l] = desc ? lo : hi; }
            }
        }
    }
}
__device__ __forceinline__ void merge16_desc(int (&a)[16], const int (&b)[16]) {
#pragma unroll
    for (int i = 0; i < 16; ++i) a[i] = max(a[i], b[15 - i]);
#pragma unroll
    for (int j = 8; j > 0; j >>= 1) {
#pragma unroll
        for (int i = 0; i < 16; ++i) { const int l = i ^ j; if (l > i) { const int hi = max(a[i], a[l]), lo = min(a[i], a[l]); a[i] = hi; a[l] = lo; } }
    }
}
__device__ __forceinline__ void pair_merge(int (&a)[16]) {
    int b[16];
#pragma unroll
    for (int i = 0; i < 16; ++i) b[i] = __shfl_xor(a[i], 32);
    merge16_desc(a, b);
}
constexpr int CELL_I[64] = {0,0,0,0,0,0,0,0,0,0,0,0,0,0,0,0,1,1,1,1,1,1,1,1,2,2,2,2,2,3,3,3,3,4,4,4,5,5,6,6,7,7,8,9,10,11,12,13,14,15,0,0,0,0,0,0,0,0,0,0,0,0,0,0};
constexpr int CELL_J[64] = {0,1,2,3,4,5,6,7,8,9,10,11,12,13,14,15,0,1,2,3,4,5,6,7,0,1,2,3,4,0,1,2,3,0,1,2,0,1,0,1,0,1,0,0,0,0,0,0,0,0,0,0,0,0,0,0,0,0,0,0,0,0,0,0};
constexpr int NCELL = 50;

__device__ __forceinline__ void phase_topk2(const Params& p, LAS unsigned char* lds, int bid, int nb) {
    const int tid = threadIdx.x, lane = tid & 63, wave = tid >> 6, hh = lane >> 5, l31 = lane & 31;
    LAS int* sit = (LAS int*)(lds + wave * 8448 + lane * 132);
    LAS float* svt = (LAS float*)(lds + 67584 + wave * 8448 + lane * 132);
    const int gw = bid * 8 + wave, NGW = nb * 8;
    for (int item = gw; item < (SEQ / 32) * 8; item += NGW) {
        const int h = item & 7, tok0 = (item >> 3) * 32;
#pragma unroll 1
        for (int ph = 0; ph < 2; ++ph) {
            const bf16_t* qrow = p.qb + (size_t)(tok0 + l31) * D + h * 256 + ph * 128 + 8 * hh;
            const bf16_t* krow = p.keysb + ((size_t)(h * 2 + ph) * 128 + l31) * 128 + 8 * hh;
            bf16x8 bq[8];
#pragma unroll
            for (int ks = 0; ks < 8; ++ks) bq[ks] = *(const bf16x8*)(qrow + ks * 16);
            int top[16];
#pragma unroll
            for (int i = 0; i < 16; ++i) top[i] = (int)0x80000000;
#pragma unroll 1
            for (int kt = 0; kt < 4; ++kt) {
                f32x16 c = {0.f, 0.f, 0.f, 0.f, 0.f, 0.f, 0.f, 0.f, 0.f, 0.f, 0.f, 0.f, 0.f, 0.f, 0.f, 0.f};
#pragma unroll
                for (int ks = 0; ks < 8; ++ks) { const bf16x8 ak = *(const bf16x8*)(krow + (size_t)kt * 32 * 128 + ks * 16);
                    c = __builtin_amdgcn_mfma_f32_32x32x16_bf16(ak, bq[ks], c, 0, 0, 0); }
                int v[16];
                const int lowb = (127 - kt * 32) ^ (hh << 2);
#pragma unroll
                for (int r = 0; r < 16; ++r) v[r] = (okey(c[r]) & ~127) | (lowb - ((r & 3) + 8 * (r >> 2)));
                sort16_desc(v);
                merge16_desc(top, v);
            }
            pair_merge(top);
#pragma unroll
            for (int i = 0; i < 16; ++i) { svt[ph * 16 + i] = okey_inv(top[i] & ~127); sit[ph * 16 + i] = 127 - (top[i] & 127); }
        }
        float sv[2][16];
#pragma unroll
        for (int i = 0; i < 16; ++i) { sv[0][i] = svt[i]; sv[1][i] = svt[16 + i]; }
        int w0[16], w1[16];
#pragma unroll
        for (int s = 0; s < 32; ++s) {
            const int e0 = 2 * s, e1 = 2 * s + 1;
            int key;
            if (e0 >= NCELL) key = (int)0x80000000;
            else {
                const float v0 = sv[0][CELL_I[e0]] + sv[1][CELL_J[e0]];
                const int k0 = (okey(v0) & ~255) | (255 - (CELL_I[e0] * 16 + CELL_J[e0]));
                if (e1 >= NCELL) key = hh ? (int)0x80000000 : k0;
                else { const float v1 = sv[0][CELL_I[e1]] + sv[1][CELL_J[e1]];
                    const int k1 = (okey(v1) & ~255) | (255 - (CELL_I[e1] * 16 + CELL_J[e1]));
                    key = hh ? k1 : k0; }
            }
            if (s < 16) w0[s] = key; else w1[s - 16] = key;
        }
        sort16_desc(w0); sort16_desc(w1); merge16_desc(w0, w1); pair_merge(w0);
        const float mx = okey_inv(w0[0] & ~255);
        float sum = 0.f;
#pragma unroll
        for (int k = 0; k < 16; ++k) sum += __expf(okey_inv(w0[k] & ~255) - mx);
        const float inv = 1.0f / sum;
        int eo[8]; float go[8]; const int hmask = -hh;
#pragma unroll
        for (int k = 0; k < 8; ++k) { const int kk = (w0[k] & ~hmask) | (w0[8 + k] & hmask); const int cc = 255 - (kk & 255);
            eo[k] = sit[cc >> 4] * 128 + sit[16 + (cc & 15)]; go[k] = __expf(okey_inv(kk & ~255) - mx) * inv; }
        float so[8];
#pragma unroll
        for (int k = 0; k < 8; ++k) { go[k] *= p.sup[eo[k]]; so[k] = p.sdn[eo[k]]; }
        const size_t ob = (size_t)(tok0 + l31) * 128 + h * 16 + hh * 8;
        *(u32x4*)(p.idx + ob) = (u32x4){(unsigned)eo[0], (unsigned)eo[1], (unsigned)eo[2], (unsigned)eo[3]};
        *(u32x4*)(p.idx + ob + 4) = (u32x4){(unsigned)eo[4], (unsigned)eo[5], (unsigned)eo[6], (unsigned)eo[7]};
        *(f32x4*)(p.gsu + ob) = (f32x4){go[0], go[1], go[2], go[3]};
        *(f32x4*)(p.gsu + ob + 4) = (f32x4){go[4], go[5], go[6], go[7]};
        *(f32x4*)(p.sdv + ob) = (f32x4){so[0], so[1], so[2], so[3]};
        *(f32x4*)(p.sdv + ob + 4) = (f32x4){so[4], so[5], so[6], so[7]};
    }
}


typedef float f32x2 __attribute__((ext_vector_type(2)));
template <int N> __device__ __forceinline__ f32x2 dot16_fp8(const u32x4 w, const f32x2 (&x)[N], int o, f32x2 acc) {
    const unsigned ww[4] = {w.x, w.y, w.z, w.w};
#pragma unroll
    for (int d = 0; d < 4; ++d) { acc += __builtin_amdgcn_cvt_pk_f32_fp8((int)ww[d], false) * x[o + 2 * d]; acc += __builtin_amdgcn_cvt_pk_f32_fp8((int)ww[d], true) * x[o + 2 * d + 1]; }
    return acc;
}
template <int N> __device__ __forceinline__ void axpy16_fp8(const u32x4 w, float a, f32x2 (&y)[N], int o) {
    const unsigned ww[4] = {w.x, w.y, w.z, w.w}; const f32x2 a2 = {a, a};
#pragma unroll
    for (int d = 0; d < 4; ++d) { y[o + 2 * d] += a2 * __builtin_amdgcn_cvt_pk_f32_fp8((int)ww[d], false); y[o + 2 * d + 1] += a2 * __builtin_amdgcn_cvt_pk_f32_fp8((int)ww[d], true); }
}
__device__ __forceinline__ void bstore16(__amdgpu_buffer_rsrc_t r, f32x4 v, int voff, int soff) { __builtin_amdgcn_raw_buffer_store_b128(__builtin_bit_cast(__attribute__((__vector_size__(4 * sizeof(unsigned)))) unsigned, v), r, voff, soff, 0); }
__device__ __forceinline__ void bstore8(__amdgpu_buffer_rsrc_t r, f32x2 v, int voff, int soff) { __builtin_amdgcn_raw_buffer_store_b64(__builtin_bit_cast(__attribute__((__vector_size__(2 * sizeof(unsigned)))) unsigned, v), r, voff, soff, 0); }
__device__ __forceinline__ f32x2 fsel2(int mask, f32x2 a, f32x2 b) { return (f32x2){fsel(mask, a.x, b.x), fsel(mask, a.y, b.y)}; }
__device__ __forceinline__ f32x2 shx2(f32x2 a, int o) { return (f32x2){__shfl_xor(a.x, o), __shfl_xor(a.y, o)}; }

__device__ __forceinline__ void phase_pd(const Params& p, int bid, int nb) {
    const int tid = threadIdx.x, lane = tid & 63, wave = __builtin_amdgcn_readfirstlane(tid >> 6);
    const int v = bid & 7, lw = (bid >> 3) * 8 + wave, NLW = (nb >> 3) * 8;
    const int c = lane & 7, sub = lane >> 3;
    const int m0 = -(lane & 1), m1 = -((lane >> 1) & 1), m2 = -((lane >> 2) & 1);
    const __amdgpu_buffer_rsrc_t rd = __builtin_amdgcn_make_buffer_rsrc((void*)p.down8, 0, 16384 * D, 0x00020000);
    const __amdgpu_buffer_rsrc_t rh = __builtin_amdgcn_make_buffer_rsrc((void*)p.h2b, 0, SEQ * D * 2, 0x00020000);
    const __amdgpu_buffer_rsrc_t rg1 = __builtin_amdgcn_make_buffer_rsrc((void*)p.ffn_g, 0, D * 4, 0x00020000);
    const __amdgpu_buffer_rsrc_t ri = __builtin_amdgcn_make_buffer_rsrc((void*)p.idx, 0, SEQ * 128 * 4, 0x00020000);
    const __amdgpu_buffer_rsrc_t rrs = __builtin_amdgcn_make_buffer_rsrc((void*)p.rstd, 0, SEQ * 4, 0x00020000);
    const __amdgpu_buffer_rsrc_t rp = __builtin_amdgcn_make_buffer_rsrc((void*)p.part, 0, SEQ * 16 * 128 * 2, 0x00020000);
    const int vsub = sub * 64, vc2 = c * 32, vc1 = c * 16, vl4 = lane * 4;
#pragma unroll 1
    for (int pass = 0; pass < 2; ++pass) {
        const int sl = v * 2 + pass;
        f32x2 gs[8];
#pragma unroll
        for (int i = 0; i < 4; ++i) { const f32x4 g = __builtin_bit_cast(f32x4, bload16(rg1, c * 64, sl * 512 + i * 16)); gs[2 * i] = (f32x2){g[0], g[1]}; gs[2 * i + 1] = (f32x2){g[2], g[3]}; }
        u32x4 ix[4], hh[2]; unsigned rsb;
        {
            const int t = lw;
#pragma unroll
            for (int i = 0; i < 4; ++i) ix[i] = bload16(ri, vsub, t * 512 + i * 16);
            hh[0] = bload16(rh, vc2, t * 4096 + sl * 256); hh[1] = bload16(rh, vc2, t * 4096 + sl * 256 + 16); rsb = bload4(rrs, 0, t * 4);
        }
#pragma unroll 1
        for (int t = lw; t < SEQ; t += NLW) {
            asm volatile("" ::: "memory");
            u32x4 w[16];
            {
                const unsigned e[16] = {ix[0].x, ix[0].y, ix[0].z, ix[0].w, ix[1].x, ix[1].y, ix[1].z, ix[1].w, ix[2].x, ix[2].y, ix[2].z, ix[2].w, ix[3].x, ix[3].y, ix[3].z, ix[3].w};
#pragma unroll
                for (int g = 0; g < 16; ++g) w[g] = bload16(rd, (int)(e[g] * 2048u) + vc1, sl * 128);
            }
            f32x2 xs[8];
            {
                const float rs = __uint_as_float(rsb);
                const unsigned hw[8] = {hh[0].x, hh[0].y, hh[0].z, hh[0].w, hh[1].x, hh[1].y, hh[1].z, hh[1].w};
#pragma unroll
                for (int i = 0; i < 8; ++i) xs[i] = (f32x2){bf_lo(hw[i]) * rs, bf_hi(hw[i]) * rs} * gs[i];
            }
            asm volatile("" ::: "memory");
            {
                const int tn = t + NLW < SEQ ? t + NLW : t;
#pragma unroll
                for (int i = 0; i < 4; ++i) ix[i] = bload16(ri, vsub, tn * 512 + i * 16);
                hh[0] = bload16(rh, vc2, tn * 4096 + sl * 256); hh[1] = bload16(rh, vc2, tn * 4096 + sl * 256 + 16); rsb = bload4(rrs, 0, tn * 4);
            }
            asm volatile("" ::: "memory");
            float r[16];
#pragma unroll
            for (int g = 0; g < 16; ++g) { const f32x2 z = {0.f, 0.f}; const f32x2 s2 = dot16_fp8(w[g], xs, 0, z); r[g] = s2.x + s2.y; }
            float k8[8], k4[4];
#pragma unroll
            for (int i = 0; i < 8; ++i) k8[i] = fsel(m2, r[i], r[i + 8]) + __shfl_xor(fsel(m2, r[i + 8], r[i]), 4);
#pragma unroll
            for (int i = 0; i < 4; ++i) k4[i] = fsel(m1, k8[i], k8[i + 4]) + __shfl_xor(fsel(m1, k8[i + 4], k8[i]), 2);
            const float k0 = fsel(m0, k4[0], k4[2]) + __shfl_xor(fsel(m0, k4[2], k4[0]), 1);
            const float k1 = fsel(m0, k4[1], k4[3]) + __shfl_xor(fsel(m0, k4[3], k4[1]), 1);
            bstore4(rp, cvt_pk_bf16(k0, k1), vl4, (t * 16 + sl) * 256);
        }
    }
}
__device__ __forceinline__ void phase_pa(const Params& p, int bid, int nb) {
    const int tid = threadIdx.x, lane = tid & 63, wave = tid >> 6;
    const int gw = bid * 8 + wave, NGW = nb * 8;
    for (int it = gw; it < SEQ * 2; it += NGW) {
        const int t = it >> 1, pp = (it & 1) * 64 + lane;
        const bf16_t* pr = p.part + (size_t)t * 2048 + pp;
        float hs = 0.f;
#pragma unroll
        for (int sl = 0; sl < 16; ++sl) hs += __uint_as_float((unsigned)pr[sl * 128] << 16);
        hs *= p.sdv[(size_t)t * 128 + pp];
        p.act[(size_t)t * 128 + pp] = p.gsu[(size_t)t * 128 + pp] * 0.5f * hs * (1.0f + erff(hs * 0.70710678118654752f));
    }
}
__device__ __forceinline__ void phase_pu(const Params& p, int bid, int nb) {
    const int tid = threadIdx.x, lane = tid & 63, wave = __builtin_amdgcn_readfirstlane(tid >> 6);
    const int v = bid & 7, lw = (bid >> 3) * 8 + wave, NLW = (nb >> 3) * 8;
    const int c = lane & 7, sub = lane >> 3;
    const int m3 = -((lane >> 3) & 1), m4 = -((lane >> 4) & 1), m5 = -((lane >> 5) & 1);
    const __amdgpu_buffer_rsrc_t ru = __builtin_amdgcn_make_buffer_rsrc((void*)p.up8, 0, 16384 * D, 0x00020000);
    const __amdgpu_buffer_rsrc_t rh = __builtin_amdgcn_make_buffer_rsrc((void*)p.h2b, 0, SEQ * D * 2, 0x00020000);
    const __amdgpu_buffer_rsrc_t ri = __builtin_amdgcn_make_buffer_rsrc((void*)p.idx, 0, SEQ * 128 * 4, 0x00020000);
    const __amdgpu_buffer_rsrc_t ra = __builtin_amdgcn_make_buffer_rsrc((void*)p.act, 0, SEQ * 128 * 4, 0x00020000);
    const __amdgpu_buffer_rsrc_t ro = __builtin_amdgcn_make_buffer_rsrc((void*)p.h3b, 0, SEQ * D * 2, 0x00020000);
    const __amdgpu_buffer_rsrc_t rq = __builtin_amdgcn_make_buffer_rsrc((void*)p.ssq2, 0, SEQ * 16 * 4, 0x00020000);
    const int vsub = sub * 64, vc1 = c * 16, vh = c * 32 + sub * 4;
#pragma unroll 1
    for (int pass = 0; pass < 2; ++pass) {
        const int sl = v * 2 + pass;
        u32x4 ix[4], ac[4]; unsigned hb;
        {
            const int t = lw;
#pragma unroll
            for (int i = 0; i < 4; ++i) { ix[i] = bload16(ri, vsub, t * 512 + i * 16); ac[i] = bload16(ra, vsub, t * 512 + i * 16); }
            hb = bload4(rh, vh, t * 4096 + sl * 256);
        }
#pragma unroll 1
        for (int t = lw; t < SEQ; t += NLW) {
            asm volatile("" ::: "memory");
            u32x4 w[16];
            {
                const unsigned e[16] = {ix[0].x, ix[0].y, ix[0].z, ix[0].w, ix[1].x, ix[1].y, ix[1].z, ix[1].w, ix[2].x, ix[2].y, ix[2].z, ix[2].w, ix[3].x, ix[3].y, ix[3].z, ix[3].w};
#pragma unroll
                for (int g = 0; g < 16; ++g) w[g] = bload16(ru, (int)(e[g] * 2048u) + vc1, sl * 128);
            }
            const float a[16] = {__uint_as_float(ac[0].x), __uint_as_float(ac[0].y), __uint_as_float(ac[0].z), __uint_as_float(ac[0].w), __uint_as_float(ac[1].x), __uint_as_float(ac[1].y), __uint_as_float(ac[1].z), __uint_as_float(ac[1].w),
                                 __uint_as_float(ac[2].x), __uint_as_float(ac[2].y), __uint_as_float(ac[2].z), __uint_as_float(ac[2].w), __uint_as_float(ac[3].x), __uint_as_float(ac[3].y), __uint_as_float(ac[3].z), __uint_as_float(ac[3].w)};
            const unsigned hcur = hb;
            asm volatile("" ::: "memory");
            {
                const int tn = t + NLW < SEQ ? t + NLW : t;
#pragma unroll
                for (int i = 0; i < 4; ++i) { ix[i] = bload16(ri, vsub, tn * 512 + i * 16); ac[i] = bload16(ra, vsub, tn * 512 + i * 16); }
                hb = bload4(rh, vh, tn * 4096 + sl * 256);
            }
            asm volatile("" ::: "memory");
            f32x2 acc[8];
#pragma unroll
            for (int i = 0; i < 8; ++i) acc[i] = (f32x2){0.f, 0.f};
#pragma unroll
            for (int g = 0; g < 16; ++g) axpy16_fp8(w[g], a[g], acc, 0);
            f32x2 k4[4], k2[2];
#pragma unroll
            for (int i = 0; i < 4; ++i) k4[i] = fsel2(m5, acc[i], acc[i + 4]) + shx2(fsel2(m5, acc[i + 4], acc[i]), 32);
#pragma unroll
            for (int i = 0; i < 2; ++i) k2[i] = fsel2(m4, k4[i], k4[i + 2]) + shx2(fsel2(m4, k4[i + 2], k4[i]), 16);
            f32x2 h3 = fsel2(m3, k2[0], k2[1]) + shx2(fsel2(m3, k2[1], k2[0]), 8);
            h3 += (f32x2){bf_lo(hcur), bf_hi(hcur)};
            bstore4(ro, cvt_pk_bf16(h3.x, h3.y), vh, t * 4096 + sl * 256);
            const float ss = wave_sum(h3.x * h3.x + h3.y * h3.y);
            if (lane == 0) bstore4(rq, __float_as_uint(ss), 0, (t * 16 + sl) * 4);
        }
    }
}
__device__ __forceinline__ void phase_pf(const Params& p, int bid, int nb) {
    const int tid = threadIdx.x, lane = tid & 63, wave = tid >> 6;
    const int gw = bid * 8 + wave, NGW = nb * 8;
    for (int t = gw; t < SEQ; t += NGW) {
        const f32x4* sp = (const f32x4*)(p.ssq2 + (size_t)t * 16); f32x4 q = sp[0] + sp[1] + sp[2] + sp[3];
        const float rf = rsqrtf(((q[0] + q[1]) + (q[2] + q[3])) * (1.0f / D) + 1e-6f);
        const u32x4* hp = (const u32x4*)(p.h3b + (size_t)t * D) + lane;
        f32x4* o = (f32x4*)(p.out + (size_t)t * D) + 2 * lane; const f32x4* g = (const f32x4*)p.fin_g + 2 * lane;
#pragma unroll
        for (int j = 0; j < 4; ++j) { const u32x4 h = hp[64 * j]; const f32x4 g0 = g[128 * j], g1 = g[128 * j + 1];
            o[128 * j] = (f32x4){bf_lo(h.x) * rf * g0[0], bf_hi(h.x) * rf * g0[1], bf_lo(h.y) * rf * g0[2], bf_hi(h.y) * rf * g0[3]};
            o[128 * j + 1] = (f32x4){bf_lo(h.z) * rf * g1[0], bf_hi(h.z) * rf * g1[1], bf_lo(h.w) * rf * g1[2], bf_hi(h.w) * rf * g1[3]}; }
    }
}

__device__ __forceinline__ void fp8_row(const float* src, unsigned char* dst, float* inv_scale, int lane) {
    f32x4 v[2][4]; float am = 0.f;
#pragma unroll
    for (int k = 0; k < 2; ++k)
#pragma unroll
        for (int i = 0; i < 4; ++i) { v[k][i] = *(const f32x4*)(src + 1024 * k + 16 * lane + 4 * i);
            am = fmaxf(am, fmaxf(fmaxf(fabsf(v[k][i].x), fabsf(v[k][i].y)), fmaxf(fabsf(v[k][i].z), fabsf(v[k][i].w)))); }
#pragma unroll
    for (int o = 1; o < 64; o <<= 1) am = fmaxf(am, __shfl_xor(am, o));
    int be = (__float_as_int(am) >> 23) & 255; be = be < 8 ? 8 : (be > 248 ? 248 : be);
    const float sc = __int_as_float((260 - be) << 23), isc = __int_as_float((be - 6) << 23);
#pragma unroll
    for (int k = 0; k < 2; ++k) { u32x4 w; unsigned ww[4];
#pragma unroll
        for (int i = 0; i < 4; ++i) { int t = 0; t = __builtin_amdgcn_cvt_pk_fp8_f32(v[k][i].x * sc, v[k][i].y * sc, t, false); t = __builtin_amdgcn_cvt_pk_fp8_f32(v[k][i].z * sc, v[k][i].w * sc, t, true); ww[i] = (unsigned)t; }
        w.x = ww[0]; w.y = ww[1]; w.z = ww[2]; w.w = ww[3];
        *(u32x4*)(dst + 1024 * k + 16 * lane) = w; }
    if (lane == 0) *inv_scale = isc;
}

__device__ __forceinline__ void fp8_row2(const float* s0, unsigned char* d0, float* i0, const float* s1, unsigned char* d1, float* i1, int lane) {
    f32x4 v[2][2][4]; float am[2] = {0.f, 0.f};
#pragma unroll
    for (int r = 0; r < 2; ++r)
#pragma unroll
        for (int k = 0; k < 2; ++k)
#pragma unroll
            for (int i = 0; i < 4; ++i) v[r][k][i] = *(const f32x4*)((r ? s1 : s0) + 1024 * k + 16 * lane + 4 * i);
#pragma unroll
    for (int r = 0; r < 2; ++r) {
#pragma unroll
        for (int k = 0; k < 2; ++k)
#pragma unroll
            for (int i = 0; i < 4; ++i) am[r] = fmaxf(am[r], fmaxf(fmaxf(fabsf(v[r][k][i].x), fabsf(v[r][k][i].y)), fmaxf(fabsf(v[r][k][i].z), fabsf(v[r][k][i].w))));
#pragma unroll
        for (int o = 1; o < 64; o <<= 1) am[r] = fmaxf(am[r], __shfl_xor(am[r], o));
        int be = (__float_as_int(am[r]) >> 23) & 255; be = be < 8 ? 8 : (be > 248 ? 248 : be);
        const float sc = __int_as_float((260 - be) << 23), isc = __int_as_float((be - 6) << 23);
#pragma unroll
        for (int k = 0; k < 2; ++k) { u32x4 w; unsigned ww[4];
#pragma unroll
            for (int i = 0; i < 4; ++i) { int t = 0; t = __builtin_amdgcn_cvt_pk_fp8_f32(v[r][k][i].x * sc, v[r][k][i].y * sc, t, false); t = __builtin_amdgcn_cvt_pk_fp8_f32(v[r][k][i].z * sc, v[r][k][i].w * sc, t, true); ww[i] = (unsigned)t; }
            w.x = ww[0]; w.y = ww[1]; w.z = ww[2]; w.w = ww[3];
            *(u32x4*)((r ? d1 : d0) + 1024 * k + 16 * lane) = w; }
        if (lane == 0) *(r ? i1 : i0) = isc;
    }
}

__device__ __forceinline__ void tr_item(const float* W, int ldw, int srccol0, int k0, bf16_t* WT, int ldt, int n0, const float* kscale, const float* nscale, LAS float* scr, int lane) {
    float tv[32];
#pragma unroll
    for (int i = 0; i < 32; ++i) { const int kk = 2 * i + (lane >> 5); tv[i] = W[(size_t)(k0 + kk) * ldw + srccol0 + (lane & 31)]; }
    const float ns = nscale ? nscale[srccol0 + (lane & 31)] : 1.0f;
#pragma unroll
    for (int i = 0; i < 32; ++i) { const int kk = 2 * i + (lane >> 5); float v = tv[i] * ns;
        if (kscale) v *= kscale[k0 + kk]; scr[kk * 33 + (lane & 31)] = v; }
    asm volatile("s_waitcnt lgkmcnt(0)" ::: "memory");
    const int c = lane & 7;
#pragma unroll
    for (int j = 0; j < 4; ++j) { const int n = (lane >> 3) + 8 * j; const LAS float* s = scr + (8 * c) * 33 + n;
        u32x4 o; o.x = cvt_pk_bf16(s[0 * 33], s[1 * 33]); o.y = cvt_pk_bf16(s[2 * 33], s[3 * 33]); o.z = cvt_pk_bf16(s[4 * 33], s[5 * 33]); o.w = cvt_pk_bf16(s[6 * 33], s[7 * 33]);
        *(u32x4*)(WT + (size_t)(n0 + n) * ldt + k0 + 8 * c) = o; }
    asm volatile("s_waitcnt lgkmcnt(0)" ::: "memory");
}
__device__ __forceinline__ int win_srccol(int n) { const int pn = n >> 8, w = n & 255; return pn < 4 ? n : ((w >> 7) ? 2048 : 1024) + (pn - 4) * 128 + (w & 127); }

__device__ __forceinline__ void phase_prep(const Params& p, LAS unsigned char* lds, int bid, int nb) {
    const int tid = threadIdx.x, lane = tid & 63, wave = tid >> 6;
    const int gw = bid * 8 + wave, NGW = nb * 8;
    LAS float* scr = (LAS float*)(lds + wave * 8448);
    for (int r = gw; r < RT; r += NGW) {
        unsigned long long* o8 = (unsigned long long*)(p.hnb + (size_t)r * D) + lane;
        if (r < RPAD) {
#pragma unroll
            for (int j = 0; j < 8; ++j) o8[64 * j] = 0ull;
        } else {
            const f32x4* xr = (const f32x4*)hrow(p, r - RPAD) + lane;
            const f32x4* gr = (const f32x4*)p.mix_g + lane;
            f32x4 v[8]; float s = 0.f;
#pragma unroll
            for (int j = 0; j < 8; ++j) { v[j] = xr[64 * j]; s += (v[j].x * v[j].x + v[j].y * v[j].y) + (v[j].z * v[j].z + v[j].w * v[j].w); }
            const float rs = rsqrtf(wave_sum(s) * (1.0f / D) + 1e-6f);
#pragma unroll
            for (int j = 0; j < 8; ++j) { const f32x4 gv = gr[64 * j];
                o8[64 * j] = (unsigned long long)cvt_pk_bf16(v[j].x * rs * gv.x, v[j].y * rs * gv.y) | ((unsigned long long)cvt_pk_bf16(v[j].z * rs * gv.z, v[j].w * rs * gv.w) << 32); }
        }
    }
    for (int it = gw; it < (D / 64) * (INW / 32); it += NGW) {
        const int kb = it / (INW / 32), nbk = it % (INW / 32);
        tr_item(p.w_in, INW, win_srccol(nbk * 32), kb * 64, p.w_in_t, D, nbk * 32, nullptr, nullptr, scr, lane);
    }
    for (int i = gw * 64 + lane; i < 4 * 256 * 256 / 4; i += NGW * 64) { const f32x4 v = ((const f32x4*)p.pool_w)[i];
        const int g = i >> 14, d = (i & 63) * 4; const f32x4 sc = *(const f32x4*)(p.pool_scale + g * 256 + d);
        u32x2 w; w.x = cvt_pk_bf16(v[0] * sc[0], v[1] * sc[1]); w.y = cvt_pk_bf16(v[2] * sc[2], v[3] * sc[3]); ((u32x2*)p.pool_ws)[i] = w; }
    for (int i = gw * 64 + lane; i < CWD * CWD / 4; i += NGW * 64) { const f32x4 v = ((const f32x4*)p.pw_w)[i];
        u32x2 w; w.x = cvt_pk_bf16(v[0], v[1]); w.y = cvt_pk_bf16(v[2], v[3]); ((u32x2*)p.pw_b16)[i] = w; }
    if (gw < D / 64) { const int n = gw * 64 + lane; float a0 = 0.f, a1 = 0.f, a2 = 0.f, a3 = 0.f;
        for (int j = 0; j < CWD; j += 4) { a0 += p.pw_b[j] * p.w_out[(size_t)(PWD + j) * D + n]; a1 += p.pw_b[j + 1] * p.w_out[(size_t)(PWD + j + 1) * D + n];
            a2 += p.pw_b[j + 2] * p.w_out[(size_t)(PWD + j + 2) * D + n]; a3 += p.pw_b[j + 3] * p.w_out[(size_t)(PWD + j + 3) * D + n]; }
        p.bias_eff[n] = (a0 + a1) + (a2 + a3); }
    for (int it = gw; it < 32 * 64; it += NGW) { const int kb = it >> 6, nbk = it & 63;
        tr_item(p.w_out, D, nbk * 32, kb * 64, p.w_out_t, D, nbk * 32, nullptr, nullptr, scr, lane); }
    for (int it = gw; it < 32 * 64; it += NGW) { const int kb = it >> 6, nbk = it & 63;
        tr_item(p.wq, D, nbk * 32, kb * 64, p.wq_t, D, nbk * 32, p.ffn_g, nullptr, scr, lane); }
    for (int i = gw * 64 + lane; i < 8 * 2 * 128 * 128 / 4; i += NGW * 64) { const f32x4 v = ((const f32x4*)p.keys)[i];
        u32x2 w; w.x = cvt_pk_bf16(v[0], v[1]); w.y = cvt_pk_bf16(v[2], v[3]); ((u32x2*)p.keysb)[i] = w; }
    for (int e = gw; e < 16384; e += NGW)
        fp8_row2(p.down + (size_t)e * D, p.down8 + (size_t)e * D, p.sdn + e, p.up + (size_t)e * D, p.up8 + (size_t)e * D, p.sup + e, lane);
}


#define XB_TMO      128
#define XB_XCNT(j)  (256  + 64 * (j))
#define XB_XSUB(j)  (1280 + 64 * (j))
#define XB_XGEN(j)  (2304 + 64 * (j))
#define XB_TOP      3328
#define XB_TOPGEN   3392
#define XCD_BAR_WORDS 3456
#define XB_SPIN_CAP (1u << 18)
__device__ __forceinline__ unsigned xb_ld(unsigned* p)              { return __hip_atomic_load(p, __ATOMIC_RELAXED, __HIP_MEMORY_SCOPE_AGENT); }
__device__ __forceinline__ unsigned xb_add(unsigned* p, unsigned v) { return __hip_atomic_fetch_add(p, v, __ATOMIC_RELAXED, __HIP_MEMORY_SCOPE_AGENT); }
__device__ __forceinline__ unsigned xb_xcc_id() { return (unsigned)__builtin_amdgcn_s_getreg((3 << 11) | 20) & 0xFu; }
#define XB_SPIN(cond, bar) do { unsigned _sp = 0; while (cond) { __builtin_amdgcn_s_sleep(1); \
    if ((++_sp & 255u) == 0u) { if (xb_ld(&(bar)[XB_TMO])) break; if (_sp > XB_SPIN_CAP) { atomicAdd(&(bar)[XB_TMO], 1u); break; } } } } while (0)
struct XcdBarrier { unsigned* bar; unsigned x; volatile LAS unsigned* st; };
__device__ __forceinline__ XcdBarrier xcd_barrier_post(unsigned* bar, volatile LAS unsigned* st) {
    XcdBarrier b; b.bar = bar; b.x = xb_xcc_id(); b.st = st;
    if (threadIdx.x == 0) (void)xb_add(&bar[XB_XCNT(b.x)], 1u);
    return b;
}
__device__ __forceinline__ void xcd_barrier_complete(unsigned* bar, unsigned x, unsigned& nloc, unsigned& nx) {
    const unsigned G = gridDim.x * gridDim.y * gridDim.z;
    unsigned sum, cnt, mine, sp = 0u;
    for (;;) {
        sum = 0u; cnt = 0u; mine = 0u;
#pragma unroll
        for (unsigned j = 0; j < 16; ++j) { const unsigned c = xb_ld(&bar[XB_XCNT(j)]); sum += c; cnt += (c > 0u) ? 1u : 0u; mine = (j == x) ? c : mine; }
        if (sum == G) break;
        __builtin_amdgcn_s_sleep(1);
        if ((++sp & 255u) == 0u) { if (xb_ld(&bar[XB_TMO])) break; if (sp > XB_SPIN_CAP) { atomicAdd(&bar[XB_TMO], 1u); break; } }
    }
    nloc = mine > 0u ? mine : 1u; nx = cnt > 0u ? cnt : 1u;
}
__device__ __forceinline__ void xcd_barrier(const XcdBarrier& b) {
    asm volatile("s_waitcnt vmcnt(0)" ::: "memory");
    __syncthreads();
    if (threadIdx.x == 0) {
        unsigned* bar = b.bar;
        __builtin_amdgcn_s_waitcnt(0);
        unsigned nloc = b.st[0], nx = b.st[1];
        if (nloc == 0u) { xcd_barrier_complete(bar, b.x, nloc, nx); b.st[0] = nloc; b.st[1] = nx; }
        const unsigned old = xb_add(&bar[XB_XSUB(b.x)], 1u);
        const unsigned gen = old / nloc;
        if (old + 1u == (gen + 1u) * nloc) {
            __builtin_amdgcn_fence(__ATOMIC_RELEASE, "agent");
            asm volatile("s_waitcnt vmcnt(0)" ::: "memory");
            const unsigned og = xb_add(&bar[XB_TOP], 1u);
            const unsigned tg = og / nx;
            if (og + 1u == (tg + 1u) * nx) xb_add(&bar[XB_TOPGEN], 1u);
            else XB_SPIN(xb_ld(&bar[XB_TOPGEN]) == tg, bar);
            __builtin_amdgcn_fence(__ATOMIC_ACQUIRE, "agent");
            xb_add(&bar[XB_XGEN(b.x)], 1u);
            asm volatile("s_waitcnt vmcnt(0)" ::: "memory");
        } else {
            XB_SPIN(xb_ld(&bar[XB_XGEN(b.x)]) == gen, bar);
            __builtin_amdgcn_fence(__ATOMIC_ACQUIRE, "agent");
            asm volatile("s_waitcnt vmcnt(0)" ::: "memory");
        }
    }
    __syncthreads();
}

__global__ void __launch_bounds__(NT, 2) k_mega(Params p) {
    extern __shared__ __attribute__((aligned(16))) unsigned char lds_raw[];
    LAS unsigned char* lds = (LAS unsigned char*)lds_raw;
    const int bid = blockIdx.x, nb = gridDim.x;
    volatile LAS unsigned* bst = (volatile LAS unsigned*)(lds + LDS_BYTES - 16);
    if (threadIdx.x < 4) bst[threadIdx.x] = 0u;
    __syncthreads();
    const XcdBarrier xb = xcd_barrier_post(p.bar, bst);
    phase_prep(p, lds, bid, nb);
    xcd_barrier(xb);
    { pg8::Gemm g{p.hnb, p.w_in_t, D, D, D, 0}; pg8::StaticOrder S; S.init(RT / 256, INW / 256, nb, bid); EpiProj E{p.xp, p.glu};
      pg8::gemm_phase<EpiProj, pg8::StaticOrder>(lds, g, S, E); }
    { const int nproj = (RT / 256) * (INW / 256); const int first = (nproj > nb && nproj < 2 * nb) ? nproj - nb : 0, nfree = nb - first;
      for (int uu = bid - first; uu >= 0 && uu < 64; uu += nfree) {
        __syncthreads();
        const bool pw = uu < 32;
        pg8::Gemm g{pw ? p.w_out_t + PWD : p.w_out_t, pw ? p.pw_b16 : p.pool_ws, D, pw ? CWD : 256, pw ? CWD : 256, pw ? 0 : 256};
        pg8::OneUnit S; S.u.pm = (uu & 31) >> 2; S.u.pn = uu & 3; EpiBf16Out E{p.w_eff_t, D, pw ? PWD : 0, nullptr};
        pg8::gemm_phase<EpiBf16Out, pg8::OneUnit>(lds, g, S, E);
      }
    }
    xcd_barrier(xb);
    phase_mix(p, lds, bid, nb);
    xcd_barrier(xb);
    { pg8::Gemm g{p.mixb, p.w_eff_t, D, D, D, 0}; pg8::StaticOrder S; S.init(SEQ / 256, D / 256, nb, bid); EpiResid E{p.x, p.bias_eff, p.h2b, p.ssq};
      pg8::gemm_phase<EpiResid, pg8::StaticOrder>(lds, g, S, E); }
    xcd_barrier(xb);
    { pg8::Gemm g{p.h2b, p.wq_t, D, D, D, 0}; pg8::StaticOrder S; S.init(SEQ / 256, D / 256, nb, bid); EpiQ E{p.ssq, p.rstd, p.qb};
      pg8::gemm_phase<EpiQ, pg8::StaticOrder>(lds, g, S, E); }
    xcd_barrier(xb);
    phase_topk2(p, lds, bid, nb);
    xcd_barrier(xb);
    phase_pd(p, bid, nb);
    xcd_barrier(xb);
    phase_pa(p, bid, nb);
    xcd_barrier(xb);
    phase_pu(p, bid, nb);
    xcd_barrier(xb);
    phase_pf(p, bid, nb);
}

extern "C" void kernel_launch(void* const* d_in, const int* in_sizes, int n_in, void* d_out, int out_size, void* d_ws, size_t ws_size, hipStream_t stream) {
    Params p{};
    p.x = (const float*)d_in[0]; p.meta = (const float*)d_in[1]; p.mix_g = (const float*)d_in[2]; p.w_in = (const float*)d_in[3];
    p.pool_w = (const float*)d_in[4]; p.pool_scale = (const float*)d_in[5]; p.dw_w = (const float*)d_in[6]; p.dw_b = (const float*)d_in[7];
    p.ln_g = (const float*)d_in[8]; p.ln_b = (const float*)d_in[9]; p.pw_w = (const float*)d_in[10]; p.pw_b = (const float*)d_in[11];
    p.w_out = (const float*)d_in[12]; p.ffn_g = (const float*)d_in[13]; p.wq = (const float*)d_in[14]; p.keys = (const float*)d_in[15];
    p.down = (const float*)d_in[16]; p.up = (const float*)d_in[17]; p.fin_g = (const float*)d_in[18];
    p.out = (float*)d_out;
    char* w = (char*)d_ws; size_t off = 0;
    auto take = [&](size_t bytes) { char* r = w + off; off += (bytes + 255) & ~(size_t)255; return r; };
    p.idx = (int*)take((size_t)SEQ * 128 * 4);
    p.gsu = (float*)take((size_t)SEQ * 128 * 4);
    p.part = (bf16_t*)take((size_t)SEQ * 16 * 128 * 2);
    p.act = (float*)take((size_t)SEQ * 128 * 4);
    p.ssq2 = (float*)take((size_t)SEQ * 16 * 4);
    p.h3b = (bf16_t*)take((size_t)SEQ * D * 2);
    p.sdv = (float*)take((size_t)SEQ * 128 * 4);
    p.hnb = (bf16_t*)take((size_t)RT * D * 2);
    p.w_in_t = (bf16_t*)take((size_t)INW * D * 2);
    p.xp = (bf16_t*)take((size_t)RT * PWD * 2);
    p.glu = (bf16_t*)take((size_t)RT * CWD * 2);
    p.mixb = (bf16_t*)take((size_t)SEQ * D * 2);
    p.h2b = (bf16_t*)take((size_t)SEQ * D * 2);
    p.pool_ws = (bf16_t*)take((size_t)4 * 256 * 256 * 2);
    p.pw_b16 = (bf16_t*)take((size_t)CWD * CWD * 2);
    p.w_eff_t = (bf16_t*)take((size_t)D * D * 2);
    p.bias_eff = (float*)take((size_t)D * 4);
    p.w_out_t = (bf16_t*)take((size_t)D * D * 2);
    p.ssq = (float*)take((size_t)SEQ * 32 * 4);
    p.bar = (unsigned*)take((size_t)XCD_BAR_WORDS * 4);
    p.rstd = (float*)take((size_t)SEQ * 4);
    p.wq_t = (bf16_t*)take((size_t)D * D * 2);
    p.keysb = (bf16_t*)take((size_t)8 * 2 * 128 * 128 * 2);
    p.qb = (bf16_t*)take((size_t)SEQ * D * 2);
    p.down8 = (unsigned char*)take((size_t)16384 * D);
    p.up8 = (unsigned char*)take((size_t)16384 * D);
    p.sdn = (float*)take((size_t)16384 * 4);
    p.sup = (float*)take((size_t)16384 * 4);
    static int grid_blocks = 0;
    if (!grid_blocks) {
        int dev = 0, cus = 0, per_cu = 0;
        (void)hipGetDevice(&dev);
        (void)hipDeviceGetAttribute(&cus, hipDeviceAttributeMultiprocessorCount, dev);
        (void)hipFuncSetAttribute((const void*)k_mega, hipFuncAttributeMaxDynamicSharedMemorySize, LDS_BYTES);
        (void)hipOccupancyMaxActiveBlocksPerMultiprocessor(&per_cu, k_mega, NT, LDS_BYTES);
        if (per_cu < 1) { fprintf(stderr, "occupancy query says %d workgroups per CU: nothing launched\n", per_cu); grid_blocks = -1; }
        else grid_blocks = cus;
    }
    if (grid_blocks < 0) return;
    (void)hipMemsetAsync(p.bar, 0, (size_t)XCD_BAR_WORDS * 4, stream);
    void* args[] = {&p};
    hipError_t e = hipLaunchCooperativeKernel((void*)k_mega, dim3(grid_blocks), dim3(NT), args, LDS_BYTES, stream);
    if (e != hipSuccess) fprintf(stderr, "cooperative launch failed: %s (grid %d)\n", hipGetErrorString(e), grid_blocks);
}
```

```cpp
#include <hip/hip_runtime.h>
#include <hip/hip_cooperative_groups.h>
#include <stdint.h>
#include <cstdio>
namespace cg = cooperative_groups;

#define NT 512
#define LAS __attribute__((address_space(3)))
typedef unsigned short bf16_t;
typedef short bf16x8 __attribute__((ext_vector_type(8)));
typedef float f32x4 __attribute__((ext_vector_type(4)));
typedef unsigned u32x4 __attribute__((ext_vector_type(4)));
typedef unsigned u32x2 __attribute__((ext_vector_type(2)));

constexpr int D = 2048, SEQ = 8192, NMETA = 16, T = SEQ + NMETA;
constexpr int PWD = 1024, CWD = 1024, INW = 3072;
constexpr int KS = 31;
constexpr int RPAD = 240, RT = 8448;
constexpr int LDS_BYTES = 151552;

struct Params {
    const float *x, *meta, *mix_g, *w_in, *pool_w, *pool_scale, *dw_w, *dw_b, *ln_g, *ln_b, *pw_w, *pw_b, *w_out, *ffn_g, *wq, *keys, *down, *up, *fin_g;
    float* out;
    unsigned short* idx;
    unsigned* bar;
    bf16_t *hnb, *w_in_t, *xp, *glu, *mixb, *h2b, *pool_ws, *pw_b16, *w_eff_t, *w_out_t, *wq_t, *keysb, *qb;
    unsigned char *down8, *up8;
    float *sdn, *sup;
    float *gsu;
    bf16_t* part;
    bf16_t* act;
    float* ssq2;
    bf16_t* h3b;
    float *ssq, *rstd, *bias_eff;
};

__device__ __forceinline__ unsigned cvt_pk_bf16(float lo, float hi) { unsigned r; asm volatile("v_cvt_pk_bf16_f32 %0, %1, %2" : "=v"(r) : "v"(lo), "v"(hi)); return r; }
__device__ __forceinline__ float wave_sum(float v) {
#pragma unroll
    for (int o = 1; o < 64; o <<= 1) v += __shfl_xor(v, o);
    return v;
}

__device__ __forceinline__ const float* hrow(const Params& p, int t) { return t < NMETA ? p.meta + (size_t)t * D : p.x + (size_t)(t - NMETA) * D; }

__device__ __forceinline__ float block_sum(float v, float* red) {
#pragma unroll
    for (int o = 32; o; o >>= 1) v += __shfl_xor(v, o);
    __syncthreads();
    if ((threadIdx.x & 63) == 0) red[threadIdx.x >> 6] = v;
    __syncthreads();
    float s = 0.f;
#pragma unroll
    for (int i = 0; i < NT / 64; ++i) s += red[i];
    return s;
}

namespace pg8 {
constexpr int BM = 256, BK = 64, HALF = 128, HTB = HALF * BK * 2, STAGE_BYTES = 8 * HTB, NXCD = 8, WGM = 8;
__device__ __forceinline__ int lds_byte(int r, int c) { const int st = (r >> 4) * 2 + (c >> 5), rr = r & 15, cc = c & 31, ob = rr * 64 + cc * 2; return st * 1024 + (ob ^ (((ob >> 9) & 1) << 5)); }
__device__ __forceinline__ void stage_rc(int b, int& R, int& C) { const int st = b / 1024, sb = b % 1024, swz = sb ^ (((sb >> 9) & 1) << 5); R = (st >> 1) * 16 + swz / 64; C = (st & 1) * 32 + (swz % 64) / 2; }
struct Unit { int pm, pn; };
struct Gemm { const bf16_t* A; const bf16_t* Bt; int lda, ldb, K; int a_col_per_pn; };
struct StaticOrder {
    int nM, nN, nwg, G, c;
    __device__ void init(int nM_, int nN_, int G_, int c_) { nM = nM_; nN = nN_; nwg = nM * nN; G = G_; c = c_; }
    __device__ bool next(int i, Unit& u) const {
        const long L = (long)i * G + c; if (L >= nwg) return false;
        int wgid = (int)L; { const int q = nwg / NXCD, r = nwg % NXCD, xcd = wgid % NXCD, off = wgid / NXCD; wgid = (xcd < r ? xcd * (q + 1) : r * (q + 1) + (xcd - r) * q) + off; }
        const int nig = WGM * nN, gid = wgid / nig, fm = gid * WGM, gsz = (nM - fm) < WGM ? (nM - fm) : WGM;
        u.pm = fm + ((wgid % nig) % gsz); u.pn = (wgid % nig) / gsz; return true;
    }
};
struct OneUnit { Unit u; __device__ bool next(int i, Unit& o) const { if (i) return false; o = u; return true; } };
template <class Epi, class Sched>
__device__ __forceinline__ void gemm_phase(LAS unsigned char* lds, const Gemm g, const Sched& S, const Epi& E) {
    const int tid = threadIdx.x, wid = __builtin_amdgcn_readfirstlane(tid >> 6), lane = tid & 63, wr = wid >> 2, wc = wid & 3, fr = lane & 15, fq = lane >> 4;
    const int K = g.K, nt = K / BK;
    unsigned voffA[2], voffB[2];
#pragma unroll
    for (int i = 0; i < 2; ++i) { int R, C; stage_rc(tid * 16 + i * 8192, R, C);
        voffA[i] = (unsigned)(R * g.lda + C) * 2u; voffB[i] = (unsigned)(R * g.ldb + C) * 2u; }
    const size_t kstep = (size_t)(BK * 2);
    const size_t hstepA = (size_t)HALF * g.lda * 2, hstepB = (size_t)HALF * g.ldb * 2;
    const size_t tstepA = 2 * hstepA, tstepB = 2 * hstepB;
    const unsigned ldsw = (unsigned)wid * 1024u;
    const int aoff = lds_byte(wr * 64 + fr, fq * 8), boff = lds_byte(wc * 32 + fr, fq * 8);
#define PG8_SA(b, h) (((b) * 2 + (h)) * HTB)
#define PG8_SB(b, h) ((4 + (b) * 2 + (h)) * HTB)
#define PG8_STAGE(bufoff, gbase, voff) do { _Pragma("unroll") for (int _i = 0; _i < 2; ++_i) \
        __builtin_amdgcn_global_load_lds((const unsigned*)((const char*)(gbase) + (voff)[_i]), (LAS unsigned*)(lds + (bufoff) + ldsw + _i * 8192), 16, 0, 0); } while (0)
#define PG8_LDA(dst, b, h) do { _Pragma("unroll") for (int m = 0; m < 4; ++m) _Pragma("unroll") for (int k = 0; k < 2; ++k) dst[m][k] = *(const LAS bf16x8*)(lds + PG8_SA(b, h) + aoff + m * 2048 + k * 1024); } while (0)
#define PG8_LDB(dst, b, h) do { _Pragma("unroll") for (int n = 0; n < 2; ++n) _Pragma("unroll") for (int k = 0; k < 2; ++k) dst[n][k] = *(const LAS bf16x8*)(lds + PG8_SB(b, h) + boff + n * 2048 + k * 1024); } while (0)
#define PG8_MMA(ai, bj, At, Bt) do { __builtin_amdgcn_s_setprio(1); _Pragma("unroll") for (int m = 0; m < 4; ++m) _Pragma("unroll") for (int n = 0; n < 2; ++n) _Pragma("unroll") for (int k = 0; k < 2; ++k) \
        acc[ai][bj][m][n] = __builtin_amdgcn_mfma_f32_16x16x32_bf16(Bt[n][k], At[m][k], acc[ai][bj][m][n], 0, 0, 0); __builtin_amdgcn_s_setprio(0); } while (0)
#define PG8_WAIT_V(n) asm volatile("s_waitcnt vmcnt(" #n ")" ::: "memory")
#define PG8_WAIT_L(n) asm volatile("s_waitcnt lgkmcnt(" #n ")" ::: "memory")
#define PG8_BAR __builtin_amdgcn_s_barrier()
#define PG8_SCHED __builtin_amdgcn_sched_barrier(0)
    Unit cur, nxt; int ui = 0;
    if (!S.next(0, cur)) return;
    f32x4 acc[2][2][4][2];
#pragma unroll
    for (int a = 0; a < 2; ++a)
#pragma unroll
        for (int b = 0; b < 2; ++b)
#pragma unroll
            for (int m = 0; m < 4; ++m)
#pragma unroll
                for (int n = 0; n < 2; ++n) acc[a][b][m][n] = (f32x4){0.f, 0.f, 0.f, 0.f};
    bf16x8 At[4][2], B0[2][2], B1[2][2];
    const char* cA = (const char*)g.A + (size_t)cur.pm * tstepA + (size_t)cur.pn * g.a_col_per_pn * 2; const char* cB = (const char*)g.Bt + (size_t)cur.pn * tstepB;
    PG8_STAGE(PG8_SB(0, 0), cB, voffB); PG8_STAGE(PG8_SA(0, 0), cA, voffA); PG8_STAGE(PG8_SB(0, 1), cB + hstepB, voffB); PG8_STAGE(PG8_SA(0, 1), cA + hstepA, voffA);
    if (wr == 1) PG8_BAR;
    PG8_WAIT_V(4); PG8_BAR;
    PG8_STAGE(PG8_SB(1, 0), cB + kstep, voffB); PG8_STAGE(PG8_SA(1, 0), cA + kstep, voffA); PG8_STAGE(PG8_SB(1, 1), cB + hstepB + kstep, voffB);
    PG8_WAIT_V(6); PG8_BAR;
    for (;;) {
        const bool has_next = S.next(ui + 1, nxt);
        const char* nA = has_next ? (const char*)g.A + (size_t)nxt.pm * tstepA + (size_t)nxt.pn * g.a_col_per_pn * 2 : cA; const char* nB = has_next ? (const char*)g.Bt + (size_t)nxt.pn * tstepB : cB;
        for (int t = 0; t < nt; t += 2) {
            const bool last = (t == nt - 2);
            const char* a1 = cA + (size_t)(t + 1) * kstep;
            const char* a2 = last ? nA : cA + (size_t)(t + 2) * kstep; const char* b2 = last ? nB : cB + (size_t)(t + 2) * kstep;
            const char* a3 = a2 + kstep; const char* b3 = b2 + kstep;
            PG8_LDB(B0, 0, 0); PG8_SCHED; PG8_LDA(At, 0, 0); PG8_STAGE(PG8_SA(1, 1), a1 + hstepA, voffA);
            PG8_WAIT_L(8); PG8_BAR; PG8_WAIT_L(0); PG8_MMA(0, 0, At, B0); PG8_BAR; PG8_SCHED;
            PG8_LDB(B1, 0, 1); PG8_STAGE(PG8_SB(0, 0), b2, voffB);
            PG8_BAR; PG8_WAIT_L(0); PG8_MMA(0, 1, At, B1); PG8_BAR;
            PG8_LDA(At, 0, 1); PG8_STAGE(PG8_SA(0, 0), a2, voffA);
            PG8_BAR; PG8_WAIT_L(0); PG8_MMA(1, 0, At, B0); PG8_BAR; PG8_SCHED;
            PG8_STAGE(PG8_SB(0, 1), b2 + hstepB, voffB);
            PG8_WAIT_V(6); PG8_BAR; PG8_MMA(1, 1, At, B1); PG8_BAR;
            PG8_LDB(B0, 1, 0); PG8_SCHED; PG8_LDA(At, 1, 0); PG8_STAGE(PG8_SA(0, 1), a2 + hstepA, voffA);
            PG8_WAIT_L(8); PG8_BAR; PG8_WAIT_L(0); PG8_MMA(0, 0, At, B0); PG8_BAR; PG8_SCHED;
            PG8_LDB(B1, 1, 1); PG8_STAGE(PG8_SB(1, 0), b3, voffB);
            PG8_BAR; PG8_WAIT_L(0); PG8_MMA(0, 1, At, B1); PG8_BAR;
            PG8_LDA(At, 1, 1); PG8_STAGE(PG8_SA(1, 0), a3, voffA);
            PG8_BAR; PG8_WAIT_L(0); PG8_MMA(1, 0, At, B0); PG8_BAR; PG8_SCHED;
            PG8_STAGE(PG8_SB(1, 1), b3 + hstepB, voffB);
            PG8_WAIT_V(6); PG8_BAR; PG8_MMA(1, 1, At, B1); PG8_BAR;
        }
        if constexpr (!Epi::AFTER_DRAIN) E(acc, cur, wr, wc, fr, fq);
        if (!has_next) break;
#pragma unroll
        for (int a = 0; a < 2; ++a)
#pragma unroll
            for (int b = 0; b < 2; ++b)
#pragma unroll
                for (int m = 0; m < 4; ++m)
#pragma unroll
                    for (int n = 0; n < 2; ++n) acc[a][b][m][n] = (f32x4){0.f, 0.f, 0.f, 0.f};
        cur = nxt; cA = nA; cB = nB; ++ui;
    }
    PG8_WAIT_V(0);
    if (wr == 0) PG8_BAR;
    PG8_BAR;
    if constexpr (Epi::AFTER_DRAIN) E.fused(acc, cur, wr, wc, fr, fq, lds, wid, lane);
#undef PG8_SA
#undef PG8_SB
#undef PG8_STAGE
#undef PG8_LDA
#undef PG8_LDB
#undef PG8_MMA
#undef PG8_WAIT_V
#undef PG8_WAIT_L
#undef PG8_BAR
#undef PG8_SCHED
}
}

struct EpiProjF32 {
    static constexpr bool AFTER_DRAIN = false;
    float* proj;
    __device__ __forceinline__ void operator()(const f32x4 (&acc)[2][2][4][2], const pg8::Unit& u, int wr, int wc, int fr, int fq) const {
#pragma unroll
        for (int ai = 0; ai < 2; ++ai)
#pragma unroll
            for (int m = 0; m < 4; ++m) {
                const int t = u.pm * 256 + ai * 128 + wr * 64 + m * 16 + fr - RPAD;
                if (t >= 0) {
#pragma unroll
                    for (int bj = 0; bj < 2; ++bj)
#pragma unroll
                        for (int n = 0; n < 2; ++n) {
                            const int off = wc * 32 + n * 16 + fq * 4;
                            const int col = u.pn < 4 ? u.pn * 256 + bj * 128 + off : (bj ? 2048 : 1024) + (u.pn - 4) * 128 + off;
                            *(f32x4*)(proj + (size_t)t * INW + col) = acc[ai][bj][m][n];
                        }
                }
            }
    }
};


__device__ __forceinline__ float sigmoidf_fast(float x) { return __builtin_amdgcn_rcpf(1.0f + __expf(-x)); }

struct EpiProj {
    static constexpr bool AFTER_DRAIN = false;
    bf16_t* xp; bf16_t* glu;
    __device__ __forceinline__ void operator()(const f32x4 (&acc)[2][2][4][2], const pg8::Unit& u, int wr, int wc, int fr, int fq) const {
#pragma unroll
        for (int ai = 0; ai < 2; ++ai)
#pragma unroll
            for (int m = 0; m < 4; ++m) {
                const size_t row = (size_t)(u.pm * 256 + ai * 128 + wr * 64 + m * 16 + fr);
                if (u.pn < 4) {
#pragma unroll
                    for (int bj = 0; bj < 2; ++bj)
#pragma unroll
                        for (int n = 0; n < 2; ++n) { const f32x4 v = acc[ai][bj][m][n]; u32x2 w; w.x = cvt_pk_bf16(v[0], v[1]); w.y = cvt_pk_bf16(v[2], v[3]);
                            *(u32x2*)(xp + row * PWD + u.pn * 256 + bj * 128 + wc * 32 + n * 16 + fq * 4) = w; }
                } else {
#pragma unroll
                    for (int n = 0; n < 2; ++n) { const f32x4 a = acc[ai][0][m][n], g = acc[ai][1][m][n]; u32x2 w;
                        w.x = cvt_pk_bf16(a[0] * sigmoidf_fast(g[0]), a[1] * sigmoidf_fast(g[1])); w.y = cvt_pk_bf16(a[2] * sigmoidf_fast(g[2]), a[3] * sigmoidf_fast(g[3]));
                        *(u32x2*)(glu + row * CWD + (u.pn - 4) * 128 + wc * 32 + n * 16 + fq * 4) = w; }
                }
            }
    }
};
struct EpiBf16Out {
    static constexpr bool AFTER_DRAIN = false;
    bf16_t* O; int ldc; int col0; const float* bias;
    __device__ __forceinline__ void operator()(const f32x4 (&acc)[2][2][4][2], const pg8::Unit& u, int wr, int wc, int fr, int fq) const {
#pragma unroll
        for (int ai = 0; ai < 2; ++ai)
#pragma unroll
            for (int m = 0; m < 4; ++m) {
                const size_t row = (size_t)(u.pm * 256 + ai * 128 + wr * 64 + m * 16 + fr);
#pragma unroll
                for (int bj = 0; bj < 2; ++bj)
#pragma unroll
                    for (int n = 0; n < 2; ++n) { const int c = u.pn * 256 + bj * 128 + wc * 32 + n * 16 + fq * 4; f32x4 v = acc[ai][bj][m][n];
                        if (bias) v += *(const f32x4*)(bias + c);
                        u32x2 w; w.x = cvt_pk_bf16(v[0], v[1]); w.y = cvt_pk_bf16(v[2], v[3]);
                        *(u32x2*)(O + row * ldc + col0 + c) = w; }
            }
    }
};
struct EpiResid {
    static constexpr bool AFTER_DRAIN = false;
    const float* x; const float* bias; bf16_t* h2b; float* ssq;
    __device__ __forceinline__ void operator()(const f32x4 (&acc)[2][2][4][2], const pg8::Unit& u, int wr, int wc, int fr, int fq) const {
#pragma unroll
        for (int ai = 0; ai < 2; ++ai)
#pragma unroll
            for (int m = 0; m < 4; ++m) {
                const size_t row = (size_t)(u.pm * 256 + ai * 128 + wr * 64 + m * 16 + fr);
                float ss = 0.f;
#pragma unroll
                for (int bj = 0; bj < 2; ++bj)
#pragma unroll
                    for (int n = 0; n < 2; ++n) { const int c = u.pn * 256 + bj * 128 + wc * 32 + n * 16 + fq * 4;
                        const f32x4 v = acc[ai][bj][m][n] + *(const f32x4*)(x + row * D + c) + *(const f32x4*)(bias + c);
                        u32x2 w; w.x = cvt_pk_bf16(v[0], v[1]); w.y = cvt_pk_bf16(v[2], v[3]);
                        *(u32x2*)(h2b + row * D + c) = w;
                        ss += (v[0] * v[0] + v[1] * v[1]) + (v[2] * v[2] + v[3] * v[3]); }
                ss += __shfl_xor(ss, 16); ss += __shfl_xor(ss, 32);
                if (fq == 0) ssq[row * 32 + u.pn * 4 + wc] = ss;
            }
    }
};

__device__ __forceinline__ float fsel(int mask, float a, float b) { return __int_as_float((__float_as_int(a) & ~mask) | (__float_as_int(b) & mask)); }
__device__ __forceinline__ float bf_lo(unsigned w) { return __uint_as_float(w << 16); }
__device__ __forceinline__ float bf_hi(unsigned w) { return __uint_as_float(w & 0xffff0000u); }

__device__ __forceinline__ u32x4 bload16(__amdgpu_buffer_rsrc_t r, int voff, int soff) { return __builtin_bit_cast(u32x4, __builtin_amdgcn_raw_buffer_load_b128(r, voff, soff, 0)); }
__device__ __forceinline__ unsigned bload4(__amdgpu_buffer_rsrc_t r, int voff, int soff) { return (unsigned)__builtin_amdgcn_raw_buffer_load_b32(r, voff, soff, 0); }
__device__ __forceinline__ void bstore4(__amdgpu_buffer_rsrc_t r, unsigned v, int voff, int soff) { __builtin_amdgcn_raw_buffer_store_b32(v, r, voff, soff, 0); }
template <int W> __device__ __forceinline__ void pool_tile(__amdgpu_buffer_rsrc_t rxp, __amdgpu_buffer_rsrc_t rpo, int r0, int tile, int tid) {
    unsigned v[32 + W - 1];
#pragma unroll
    for (int i = 0; i < 32 + W - 1; ++i) v[i] = bload4(rxp, tid * 4, (r0 - (W - 1) + i) * 2048);
    float s0 = 0.f, s1 = 0.f;
#pragma unroll
    for (int i = 0; i < W - 1; ++i) { s0 += bf_lo(v[i]); s1 += bf_hi(v[i]); }
    constexpr float inv = 1.0f / (float)W;
#pragma unroll
    for (int i = 0; i < 32; ++i) {
        const float a0 = bf_lo(v[W - 1 + i]), a1 = bf_hi(v[W - 1 + i]);
        s0 += a0; s1 += a1;
        bstore4(rpo, cvt_pk_bf16(s0 * inv - a0, s1 * inv - a1), tid * 4, (tile * 32 + i) * 4096);
        s0 -= bf_lo(v[i]); s1 -= bf_hi(v[i]);
    }
}
__device__ __forceinline__ void phase_mix(const Params& p, LAS unsigned char* lds, int bid, int nb) {
    const int tid = threadIdx.x, lane = tid & 63, wave = tid >> 6;
    LAS unsigned* gl = (LAS unsigned*)lds;
    LAS float* red = (LAS float*)(lds + 62 * 2048);
    const __amdgpu_buffer_rsrc_t rxp = __builtin_amdgcn_make_buffer_rsrc((void*)p.xp, 0, RT * PWD * 2, 0x00020000);
    const __amdgpu_buffer_rsrc_t rgl = __builtin_amdgcn_make_buffer_rsrc((void*)p.glu, 0, RT * CWD * 2, 0x00020000);
    const __amdgpu_buffer_rsrc_t rpo = __builtin_amdgcn_make_buffer_rsrc((void*)p.mixb, 0, SEQ * D * 2, 0x00020000);
    const __amdgpu_buffer_rsrc_t rww = __builtin_amdgcn_make_buffer_rsrc((void*)p.dw_w, 0, KS * CWD * 4, 0x00020000);
    const __amdgpu_buffer_rsrc_t rwb = __builtin_amdgcn_make_buffer_rsrc((void*)p.dw_b, 0, CWD * 4, 0x00020000);
    const __amdgpu_buffer_rsrc_t rlg = __builtin_amdgcn_make_buffer_rsrc((void*)p.ln_g, 0, CWD * 4, 0x00020000);
    const __amdgpu_buffer_rsrc_t rlb = __builtin_amdgcn_make_buffer_rsrc((void*)p.ln_b, 0, CWD * 4, 0x00020000);
    for (int tile = bid; tile < SEQ / 32; tile += nb) {
        const int r0 = 256 + tile * 32;
        __syncthreads();
#pragma unroll
        for (int j = 0; j < 16; ++j) { const int ch = j * NT + tid; if (ch < 62 * 128)
            *(LAS u32x4*)(lds + ch * 16) = bload16(rgl, tid * 16, (r0 - 30) * 2048 + j * 8192); }
        { const int g = __builtin_amdgcn_readfirstlane(tid >> 7);
          if (g == 0) pool_tile<2>(rxp, rpo, r0, tile, tid); else if (g == 1) pool_tile<4>(rxp, rpo, r0, tile, tid); else if (g == 2) pool_tile<8>(rxp, rpo, r0, tile, tid); else pool_tile<16>(rxp, rpo, r0, tile, tid); }
        __syncthreads();
#pragma unroll 1
        for (int hf = 0; hf < 2; ++hf) {
            float c0[16], c1[16];
            {
                float w0[KS], w1[KS];
#pragma unroll
                for (int k = 0; k < KS; ++k) { w0[k] = __uint_as_float(bload4(rww, tid * 8, k * 4096)); w1[k] = __uint_as_float(bload4(rww, tid * 8 + 4, k * 4096)); }
                const float b0 = __uint_as_float(bload4(rwb, tid * 8, 0)), b1 = __uint_as_float(bload4(rwb, tid * 8 + 4, 0));
#pragma unroll
                for (int i = 0; i < 16; ++i) { c0[i] = b0; c1[i] = b1; }
                const LAS unsigned* glh = gl + hf * 16 * 512 + tid;
#pragma unroll
                for (int rr = 0; rr < 46; ++rr) {
                    if ((rr & 7) == 0) asm volatile("" ::: "memory");
                    const unsigned vv = glh[rr * 512]; const float x0 = bf_lo(vv), x1 = bf_hi(vv);
#pragma unroll
                    for (int i = 0; i < 16; ++i) { const int k = rr - i; if (k >= 0 && k < KS) { c0[i] += x0 * w0[k]; c1[i] += x1 * w1[k]; } }
                }
            }
            asm volatile("" ::: "memory");
#pragma unroll
            for (int which = 0; which < 2; ++which) {
                float st[16];
#pragma unroll
                for (int i = 0; i < 16; ++i) st[i] = which == 0 ? c0[i] + c1[i] : c0[i] * c0[i] + c1[i] * c1[i];
#pragma unroll
                for (int lvl = 0; lvl < 4; ++lvl) {
                    const int o = 32 >> lvl, n = 8 >> lvl; const int mk = -((lane >> (5 - lvl)) & 1);
#pragma unroll
                    for (int j = 0; j < 8; ++j) if (j < n) st[j] = fsel(mk, st[j], st[j + n]) + __shfl_xor(fsel(mk, st[j + n], st[j]), o);
                }
                float tot = st[0] + __shfl_xor(st[0], 2); tot += __shfl_xor(tot, 1);
                if ((lane & 3) == 0) red[wave * 32 + which * 16 + (lane >> 2)] = tot;
            }
            __syncthreads();
            if (tid < 32) { float t = 0.f;
#pragma unroll
                for (int q = 0; q < 8; ++q) t += red[q * 32 + tid];
                red[256 + tid] = t; }
            __syncthreads();
            const float lg0 = __uint_as_float(bload4(rlg, tid * 8, 0)), lg1 = __uint_as_float(bload4(rlg, tid * 8 + 4, 0)), lb0 = __uint_as_float(bload4(rlb, tid * 8, 0)), lb1 = __uint_as_float(bload4(rlb, tid * 8 + 4, 0));
#pragma unroll
            for (int i = 0; i < 16; ++i) {
                const float s1 = red[256 + i], s2 = red[256 + 16 + i];
                const float mu = s1 * (1.0f / CWD), var = fmaxf(s2 * (1.0f / CWD) - mu * mu, 0.f), rs = rsqrtf(var + 1e-5f);
                const float y0 = (c0[i] - mu) * rs * lg0 + lb0, y1 = (c1[i] - mu) * rs * lg1 + lb1;
                bstore4(rpo, cvt_pk_bf16(y0 * sigmoidf_fast(y0), y1 * sigmoidf_fast(y1)), tid * 4, (tile * 32 + hf * 16 + i) * 4096 + 2048);
            }
            __syncthreads();
        }
    }
}

typedef float f32x16 __attribute__((ext_vector_type(16)));
__device__ __forceinline__ int okey(float s) { const int u = __float_as_int(s); return u ^ ((u >> 31) & 0x7fffffff); }
__device__ __forceinline__ float okey_inv(int k) { return __int_as_float(k ^ ((k >> 31) & 0x7fffffff)); }
__device__ __forceinline__ void sort16_desc(int (&v)[16]) {
#pragma unroll
    for (int k = 2; k <= 16; k <<= 1) {
#pragma unroll
        for (int j = k >> 1; j > 0; j >>= 1) {
#pragma unroll
            for (int i = 0; i < 16; ++i) {
                const int l = i ^ j;
                if (l > i) { const bool desc = (i & k) == 0; const int hi = max(v[i], v[l]), lo = min(v[i], v[l]); v[i] = desc ? hi : lo; v[l] = desc ? lo : hi; }
            }
        }
    }
}
__device__ __forceinline__ void merge16_desc(int (&a)[16], const int (&b)[16]) {
#pragma unroll
    for (int i = 0; i < 16; ++i) a[i] = max(a[i], b[15 - i]);
#pragma unroll
    for (int j = 8; j > 0; j >>= 1) {
#pragma unroll
        for (int i = 0; i < 16; ++i) { const int l = i ^ j; if (l > i) { const int hi = max(a[i], a[l]), lo = min(a[i], a[l]); a[i] = hi; a[l] = lo; } }
    }
}
__device__ __forceinline__ void pair_merge(int (&a)[16]) {
    int b[16];
#pragma unroll
    for (int i = 0; i < 16; ++i) b[i] = __shfl_xor(a[i], 32);
    merge16_desc(a, b);
}
constexpr int CELL_I[64] = {0,0,0,0,0,0,0,0,0,0,0,0,0,0,0,0,1,1,1,1,1,1,1,1,2,2,2,2,2,3,3,3,3,4,4,4,5,5,6,6,7,7,8,9,10,11,12,13,14,15,0,0,0,0,0,0,0,0,0,0,0,0,0,0};
constexpr int CELL_J[64] = {0,1,2,3,4,5,6,7,8,9,10,11,12,13,14,15,0,1,2,3,4,5,6,7,0,1,2,3,4,0,1,2,3,0,1,2,0,1,0,1,0,1,0,0,0,0,0,0,0,0,0,0,0,0,0,0,0,0,0,0,0,0,0,0};
constexpr int NCELL = 50;

struct EpiQTopk {
    static constexpr bool AFTER_DRAIN = true;
    const float* ssq; float* rstd; const bf16_t* keysb; unsigned short* idx; float* gsu;
    __device__ __forceinline__ void fused(const f32x4 (&acc)[2][2][4][2], const pg8::Unit& u, int wr, int wc, int fr, int fq, LAS unsigned char* lds, int wid, int lane) const {
        const int hh = lane >> 5, l31 = lane & 31, h = u.pn;
        LAS float* svt = (LAS float*)(lds + 65536 + (wid * 64 + lane) * 164);
        LAS unsigned char* sit = (LAS unsigned char*)(svt + 32);
        float rs[2][4];
#pragma unroll
        for (int ai = 0; ai < 2; ++ai)
#pragma unroll
            for (int m = 0; m < 4; ++m) {
                const size_t row = (size_t)(u.pm * 256 + ai * 128 + wr * 64 + m * 16 + fr);
                const f32x4* sp = (const f32x4*)(ssq + row * 32); f32x4 t = sp[0];
#pragma unroll
                for (int i = 1; i < 8; ++i) t += sp[i];
                rs[ai][m] = rsqrtf(((t[0] + t[1]) + (t[2] + t[3])) * (1.0f / D) + 1e-6f);
                if (u.pn == 0 && wc == 0 && fq == 0) rstd[row] = rs[ai][m];
            }
        const int trow = wid * 32 + l31;
#pragma unroll
        for (int ph = 0; ph < 2; ++ph) {
#pragma unroll
            for (int ai = 0; ai < 2; ++ai)
#pragma unroll
                for (int m = 0; m < 4; ++m) { const int row = ai * 128 + wr * 64 + m * 16 + fr;
#pragma unroll
                    for (int n = 0; n < 2; ++n) { const f32x4 v = acc[ai][ph][m][n] * rs[ai][m]; const int chunk = 4 * wc + 2 * n + (fq >> 1);
                        u32x2 w; w.x = cvt_pk_bf16(v[0], v[1]); w.y = cvt_pk_bf16(v[2], v[3]);
                        *(LAS u32x2*)(lds + row * 256 + ((chunk ^ (row & 15)) << 4) + (fq & 1) * 8) = w; } }
            __syncthreads();
            const bf16_t* krow = keysb + ((size_t)(h * 2 + ph) * 128 + l31) * 128 + 8 * hh;
            bf16x8 bq[8];
#pragma unroll
            for (int ks = 0; ks < 8; ++ks) bq[ks] = *(const LAS bf16x8*)(lds + trow * 256 + (((ks * 2 + hh) ^ (trow & 15)) << 4));
            int top[16];
#pragma unroll
            for (int i = 0; i < 16; ++i) top[i] = (int)0x80000000;
            bf16x8 ak[8];
#pragma unroll
            for (int ks = 0; ks < 8; ++ks) ak[ks] = *(const bf16x8*)(krow + ks * 16);
#pragma unroll 1
            for (int kt = 0; kt < 4; ++kt) {
                f32x16 c = {0.f, 0.f, 0.f, 0.f, 0.f, 0.f, 0.f, 0.f, 0.f, 0.f, 0.f, 0.f, 0.f, 0.f, 0.f, 0.f};
#pragma unroll
                for (int ks = 0; ks < 8; ++ks) c = __builtin_amdgcn_mfma_f32_32x32x16_bf16(ak[ks], bq[ks], c, 0, 0, 0);
                { const int kn = kt < 3 ? kt + 1 : 3;
#pragma unroll
                  for (int ks = 0; ks < 8; ++ks) ak[ks] = *(const bf16x8*)(krow + (size_t)kn * 32 * 128 + ks * 16); }
                int v[16];
                const int lowb = (127 - kt * 32) ^ (hh << 2);
#pragma unroll
                for (int r = 0; r < 16; ++r) v[r] = (okey(c[r]) & ~127) | (lowb - ((r & 3) + 8 * (r >> 2)));
                sort16_desc(v);
                merge16_desc(top, v);
            }
            pair_merge(top);
#pragma unroll
            for (int i = 0; i < 16; ++i) { svt[ph * 16 + i] = okey_inv(top[i] & ~127); sit[ph * 16 + i] = (unsigned char)(127 - (top[i] & 127)); }
            __syncthreads();
        }
        float sv[2][16];
#pragma unroll
        for (int i = 0; i < 16; ++i) { sv[0][i] = svt[i]; sv[1][i] = svt[16 + i]; }
        int w0[16], w1[16];
#pragma unroll
        for (int s = 0; s < 32; ++s) {
            const int e0 = 2 * s, e1 = 2 * s + 1;
            int key;
            if (e0 >= NCELL) key = (int)0x80000000;
            else {
                const float v0 = sv[0][CELL_I[e0]] + sv[1][CELL_J[e0]];
                const int k0 = (okey(v0) & ~255) | (255 - (CELL_I[e0] * 16 + CELL_J[e0]));
                if (e1 >= NCELL) key = hh ? (int)0x80000000 : k0;
                else { const float v1 = sv[0][CELL_I[e1]] + sv[1][CELL_J[e1]];
                    const int k1 = (okey(v1) & ~255) | (255 - (CELL_I[e1] * 16 + CELL_J[e1]));
                    key = hh ? k1 : k0; }
            }
            if (s < 16) w0[s] = key; else w1[s - 16] = key;
        }
        sort16_desc(w0); sort16_desc(w1); merge16_desc(w0, w1); pair_merge(w0);
        const float mx = okey_inv(w0[0] & ~255);
        float sum = 0.f;
#pragma unroll
        for (int k = 0; k < 16; ++k) sum += __expf(okey_inv(w0[k] & ~255) - mx);
        const float inv = 1.0f / sum;
        int eo[8]; float go[8]; const int hmask = -hh;
#pragma unroll
        for (int k = 0; k < 8; ++k) { const int kk = (w0[k] & ~hmask) | (w0[8 + k] & hmask); const int cc = 255 - (kk & 255);
            eo[k] = (int)sit[cc >> 4] * 128 + (int)sit[16 + (cc & 15)]; go[k] = __expf(okey_inv(kk & ~255) - mx) * inv; }
        const size_t ob = (size_t)(u.pm * 256 + trow) * 128 + h * 16 + hh * 8;
        *(u32x4*)(idx + ob) = (u32x4){(unsigned)eo[0] | ((unsigned)eo[1] << 16), (unsigned)eo[2] | ((unsigned)eo[3] << 16), (unsigned)eo[4] | ((unsigned)eo[5] << 16), (unsigned)eo[6] | ((unsigned)eo[7] << 16)};
        *(f32x4*)(gsu + ob) = (f32x4){go[0], go[1], go[2], go[3]};
        *(f32x4*)(gsu + ob + 4) = (f32x4){go[4], go[5], go[6], go[7]};
    }
    __device__ __forceinline__ void operator()(const f32x4 (&)[2][2][4][2], const pg8::Unit&, int, int, int, int) const {}
};

typedef float f32x2 __attribute__((ext_vector_type(2)));
template <int N> __device__ __forceinline__ f32x2 dot16_fp8(const u32x4 w, const f32x2 (&x)[N], int o, f32x2 acc) {
    const unsigned ww[4] = {w.x, w.y, w.z, w.w};
#pragma unroll
    for (int d = 0; d < 4; ++d) { acc += __builtin_amdgcn_cvt_pk_f32_fp8((int)ww[d], false) * x[o + 2 * d]; acc += __builtin_amdgcn_cvt_pk_f32_fp8((int)ww[d], true) * x[o + 2 * d + 1]; }
    return acc;
}
template <int N> __device__ __forceinline__ void axpy16_fp8(const u32x4 w, float a, f32x2 (&y)[N], int o) {
    const unsigned ww[4] = {w.x, w.y, w.z, w.w}; const f32x2 a2 = {a, a};
#pragma unroll
    for (int d = 0; d < 4; ++d) { y[o + 2 * d] += a2 * __builtin_amdgcn_cvt_pk_f32_fp8((int)ww[d], false); y[o + 2 * d + 1] += a2 * __builtin_amdgcn_cvt_pk_f32_fp8((int)ww[d], true); }
}
__device__ __forceinline__ void bstore16(__amdgpu_buffer_rsrc_t r, f32x4 v, int voff, int soff) { __builtin_amdgcn_raw_buffer_store_b128(__builtin_bit_cast(__attribute__((__vector_size__(4 * sizeof(unsigned)))) unsigned, v), r, voff, soff, 0); }
__device__ __forceinline__ void bstore8(__amdgpu_buffer_rsrc_t r, f32x2 v, int voff, int soff) { __builtin_amdgcn_raw_buffer_store_b64(__builtin_bit_cast(__attribute__((__vector_size__(2 * sizeof(unsigned)))) unsigned, v), r, voff, soff, 0); }
__device__ __forceinline__ f32x2 fsel2(int mask, f32x2 a, f32x2 b) { return (f32x2){fsel(mask, a.x, b.x), fsel(mask, a.y, b.y)}; }
__device__ __forceinline__ f32x2 shx2(f32x2 a, int o) { return (f32x2){__shfl_xor(a.x, o), __shfl_xor(a.y, o)}; }

__device__ __forceinline__ void phase_pd(const Params& p, int bid, int nb) {
    const int tid = threadIdx.x, lane = tid & 63, wave = __builtin_amdgcn_readfirstlane(tid >> 6);
    const int v = bid & 7, lw = (bid >> 3) * 8 + wave, NLW = (nb >> 3) * 8;
    const int c = lane & 7, sub = lane >> 3;
    const int m0 = -(lane & 1), m1 = -((lane >> 1) & 1), m2 = -((lane >> 2) & 1);
    const __amdgpu_buffer_rsrc_t rd = __builtin_amdgcn_make_buffer_rsrc((void*)p.down8, 0, 16384 * D, 0x00020000);
    const __amdgpu_buffer_rsrc_t rh = __builtin_amdgcn_make_buffer_rsrc((void*)p.h2b, 0, SEQ * D * 2, 0x00020000);
    const __amdgpu_buffer_rsrc_t rg1 = __builtin_amdgcn_make_buffer_rsrc((void*)p.ffn_g, 0, D * 4, 0x00020000);
    const __amdgpu_buffer_rsrc_t ri = __builtin_amdgcn_make_buffer_rsrc((void*)p.idx, 0, SEQ * 128 * 2, 0x00020000);
    const __amdgpu_buffer_rsrc_t rrs = __builtin_amdgcn_make_buffer_rsrc((void*)p.rstd, 0, SEQ * 4, 0x00020000);
    const __amdgpu_buffer_rsrc_t rp = __builtin_amdgcn_make_buffer_rsrc((void*)p.part, 0, SEQ * 16 * 128 * 2, 0x00020000);
    const int vsub = sub * 32, vc2 = c * 32, vc1 = c * 16, vl4 = lane * 4;
#pragma unroll 1
    for (int pass = 0; pass < 2; ++pass) {
        const int sl = v * 2 + pass;
        f32x2 gs[8];
#pragma unroll
        for (int i = 0; i < 4; ++i) { const f32x4 g = __builtin_bit_cast(f32x4, bload16(rg1, c * 64, sl * 512 + i * 16)); gs[2 * i] = (f32x2){g[0], g[1]}; gs[2 * i + 1] = (f32x2){g[2], g[3]}; }
        u32x4 ix[2], hh[2]; unsigned rsb;
        {
            const int t = lw;
#pragma unroll
            for (int i = 0; i < 2; ++i) ix[i] = bload16(ri, vsub, t * 256 + i * 16);
            hh[0] = bload16(rh, vc2, t * 4096 + sl * 256); hh[1] = bload16(rh, vc2, t * 4096 + sl * 256 + 16); rsb = bload4(rrs, 0, t * 4);
        }
#pragma unroll 1
        for (int t = lw; t < SEQ; t += NLW) {
            asm volatile("" ::: "memory");
            u32x4 w[16];
            {
                const unsigned ew[8] = {ix[0].x, ix[0].y, ix[0].z, ix[0].w, ix[1].x, ix[1].y, ix[1].z, ix[1].w};
#pragma unroll
                for (int g = 0; g < 16; ++g) { const unsigned e = (g & 1) ? (ew[g >> 1] >> 16) : (ew[g >> 1] & 0xffffu); w[g] = bload16(rd, (int)(e * 2048u) + vc1, sl * 128); }
            }
            f32x2 xs[8];
            {
                const float rs = __uint_as_float(rsb);
                const unsigned hw[8] = {hh[0].x, hh[0].y, hh[0].z, hh[0].w, hh[1].x, hh[1].y, hh[1].z, hh[1].w};
#pragma unroll
                for (int i = 0; i < 8; ++i) xs[i] = (f32x2){bf_lo(hw[i]) * rs, bf_hi(hw[i]) * rs} * gs[i];
            }
            asm volatile("" ::: "memory");
            {
                const int tn = t + NLW < SEQ ? t + NLW : t;
#pragma unroll
                for (int i = 0; i < 2; ++i) ix[i] = bload16(ri, vsub, tn * 256 + i * 16);
                hh[0] = bload16(rh, vc2, tn * 4096 + sl * 256); hh[1] = bload16(rh, vc2, tn * 4096 + sl * 256 + 16); rsb = bload4(rrs, 0, tn * 4);
            }
            asm volatile("" ::: "memory");
            float r[16];
#pragma unroll
            for (int g = 0; g < 16; ++g) { const f32x2 z = {0.f, 0.f}; const f32x2 s2 = dot16_fp8(w[g], xs, 0, z); r[g] = s2.x + s2.y; }
            float k8[8], k4[4];
#pragma unroll
            for (int i = 0; i < 8; ++i) k8[i] = fsel(m2, r[i], r[i + 8]) + __shfl_xor(fsel(m2, r[i + 8], r[i]), 4);
#pragma unroll
            for (int i = 0; i < 4; ++i) k4[i] = fsel(m1, k8[i], k8[i + 4]) + __shfl_xor(fsel(m1, k8[i + 4], k8[i]), 2);
            const float k0 = fsel(m0, k4[0], k4[2]) + __shfl_xor(fsel(m0, k4[2], k4[0]), 1);
            const float k1 = fsel(m0, k4[1], k4[3]) + __shfl_xor(fsel(m0, k4[3], k4[1]), 1);
            bstore4(rp, cvt_pk_bf16(k0, k1), vl4, (t * 16 + sl) * 256);
        }
    }
}
__device__ __forceinline__ void phase_pa(const Params& p, int bid, int nb) {
    const int tid = threadIdx.x, lane = tid & 63, wave = tid >> 6;
    const int gw = bid * 8 + wave, NGW = nb * 8;
    for (int it = gw; it < SEQ * 2; it += NGW) {
        const int t = it >> 1, pp = (it & 1) * 64 + lane;
        const bf16_t* pr = p.part + (size_t)t * 2048 + pp;
        float hs = 0.f;
#pragma unroll
        for (int sl = 0; sl < 16; ++sl) hs += __uint_as_float((unsigned)pr[sl * 128] << 16);
        const int e = (int)p.idx[(size_t)t * 128 + pp];
        hs *= p.sdn[e];
        const float av = p.gsu[(size_t)t * 128 + pp] * p.sup[e] * 0.5f * hs * (1.0f + erff(hs * 0.70710678118654752f));
        p.act[(size_t)t * 128 + pp] = (bf16_t)(cvt_pk_bf16(av, 0.f) & 0xffffu);
    }
}
__device__ __forceinline__ void phase_pu(const Params& p, int bid, int nb) {
    const int tid = threadIdx.x, lane = tid & 63, wave = __builtin_amdgcn_readfirstlane(tid >> 6);
    const int v = bid & 7, lw = (bid >> 3) * 8 + wave, NLW = (nb >> 3) * 8;
    const int c = lane & 7, sub = lane >> 3;
    const int m3 = -((lane >> 3) & 1), m4 = -((lane >> 4) & 1), m5 = -((lane >> 5) & 1);
    const __amdgpu_buffer_rsrc_t ru = __builtin_amdgcn_make_buffer_rsrc((void*)p.up8, 0, 16384 * D, 0x00020000);
    const __amdgpu_buffer_rsrc_t rh = __builtin_amdgcn_make_buffer_rsrc((void*)p.h2b, 0, SEQ * D * 2, 0x00020000);
    const __amdgpu_buffer_rsrc_t ri = __builtin_amdgcn_make_buffer_rsrc((void*)p.idx, 0, SEQ * 128 * 2, 0x00020000);
    const __amdgpu_buffer_rsrc_t ra = __builtin_amdgcn_make_buffer_rsrc((void*)p.act, 0, SEQ * 128 * 2, 0x00020000);
    const __amdgpu_buffer_rsrc_t ro = __builtin_amdgcn_make_buffer_rsrc((void*)p.h3b, 0, SEQ * D * 2, 0x00020000);
    const __amdgpu_buffer_rsrc_t rq = __builtin_amdgcn_make_buffer_rsrc((void*)p.ssq2, 0, SEQ * 16 * 4, 0x00020000);
    const int vsub = sub * 32, vc1 = c * 16, vh = c * 32 + sub * 4;
#pragma unroll 1
    for (int pass = 0; pass < 2; ++pass) {
        const int sl = v * 2 + pass;
        u32x4 ix[2], ac[2]; unsigned hb;
        {
            const int t = lw;
#pragma unroll
            for (int i = 0; i < 2; ++i) { ix[i] = bload16(ri, vsub, t * 256 + i * 16); ac[i] = bload16(ra, vsub, t * 256 + i * 16); }
            hb = bload4(rh, vh, t * 4096 + sl * 256);
        }
#pragma unroll 1
        for (int t = lw; t < SEQ; t += NLW) {
            asm volatile("" ::: "memory");
            u32x4 w[16];
            {
                const unsigned ew[8] = {ix[0].x, ix[0].y, ix[0].z, ix[0].w, ix[1].x, ix[1].y, ix[1].z, ix[1].w};
#pragma unroll
                for (int g = 0; g < 16; ++g) { const unsigned e = (g & 1) ? (ew[g >> 1] >> 16) : (ew[g >> 1] & 0xffffu); w[g] = bload16(ru, (int)(e * 2048u) + vc1, sl * 128); }
            }
            const unsigned aw[8] = {ac[0].x, ac[0].y, ac[0].z, ac[0].w, ac[1].x, ac[1].y, ac[1].z, ac[1].w};
            float a[16];
#pragma unroll
            for (int g = 0; g < 16; ++g) a[g] = (g & 1) ? bf_hi(aw[g >> 1]) : bf_lo(aw[g >> 1]);
            const unsigned hcur = hb;
            asm volatile("" ::: "memory");
            {
                const int tn = t + NLW < SEQ ? t + NLW : t;
#pragma unroll
                for (int i = 0; i < 2; ++i) { ix[i] = bload16(ri, vsub, tn * 256 + i * 16); ac[i] = bload16(ra, vsub, tn * 256 + i * 16); }
                hb = bload4(rh, vh, tn * 4096 + sl * 256);
            }
            asm volatile("" ::: "memory");
            f32x2 acc[8];
#pragma unroll
            for (int i = 0; i < 8; ++i) acc[i] = (f32x2){0.f, 0.f};
#pragma unroll
            for (int g = 0; g < 16; ++g) axpy16_fp8(w[g], a[g], acc, 0);
            f32x2 k4[4], k2[2];
#pragma unroll
            for (int i = 0; i < 4; ++i) k4[i] = fsel2(m5, acc[i], acc[i + 4]) + shx2(fsel2(m5, acc[i + 4], acc[i]), 32);
#pragma unroll
            for (int i = 0; i < 2; ++i) k2[i] = fsel2(m4, k4[i], k4[i + 2]) + shx2(fsel2(m4, k4[i + 2], k4[i]), 16);
            f32x2 h3 = fsel2(m3, k2[0], k2[1]) + shx2(fsel2(m3, k2[1], k2[0]), 8);
            h3 += (f32x2){bf_lo(hcur), bf_hi(hcur)};
            bstore4(ro, cvt_pk_bf16(h3.x, h3.y), vh, t * 4096 + sl * 256);
            const float ss = wave_sum(h3.x * h3.x + h3.y * h3.y);
            if (lane == 0) bstore4(rq, __float_as_uint(ss), 0, (t * 16 + sl) * 4);
        }
    }
}
__device__ __forceinline__ void phase_pf(const Params& p, int bid, int nb) {
    const int tid = threadIdx.x, lane = tid & 63, wave = tid >> 6;
    const int gw = bid * 8 + wave, NGW = nb * 8;
    for (int t = gw; t < SEQ; t += NGW) {
        const f32x4* sp = (const f32x4*)(p.ssq2 + (size_t)t * 16); f32x4 q = sp[0] + sp[1] + sp[2] + sp[3];
        const float rf = rsqrtf(((q[0] + q[1]) + (q[2] + q[3])) * (1.0f / D) + 1e-6f);
        const u32x4* hp = (const u32x4*)(p.h3b + (size_t)t * D) + lane;
        f32x4* o = (f32x4*)(p.out + (size_t)t * D) + 2 * lane; const f32x4* g = (const f32x4*)p.fin_g + 2 * lane;
#pragma unroll
        for (int j = 0; j < 4; ++j) { const u32x4 h = hp[64 * j]; const f32x4 g0 = g[128 * j], g1 = g[128 * j + 1];
            o[128 * j] = (f32x4){bf_lo(h.x) * rf * g0[0], bf_hi(h.x) * rf * g0[1], bf_lo(h.y) * rf * g0[2], bf_hi(h.y) * rf * g0[3]};
            o[128 * j + 1] = (f32x4){bf_lo(h.z) * rf * g1[0], bf_hi(h.z) * rf * g1[1], bf_lo(h.w) * rf * g1[2], bf_hi(h.w) * rf * g1[3]}; }
    }
}

__device__ __forceinline__ void fp8_row(const float* src, unsigned char* dst, float* inv_scale, int lane) {
    f32x4 v[2][4]; float am = 0.f;
#pragma unroll
    for (int k = 0; k < 2; ++k)
#pragma unroll
        for (int i = 0; i < 4; ++i) { v[k][i] = *(const f32x4*)(src + 1024 * k + 16 * lane + 4 * i);
            am = fmaxf(am, fmaxf(fmaxf(fabsf(v[k][i].x), fabsf(v[k][i].y)), fmaxf(fabsf(v[k][i].z), fabsf(v[k][i].w)))); }
#pragma unroll
    for (int o = 1; o < 64; o <<= 1) am = fmaxf(am, __shfl_xor(am, o));
    int be = (__float_as_int(am) >> 23) & 255; be = be < 8 ? 8 : (be > 248 ? 248 : be);
    const float sc = __int_as_float((260 - be) << 23), isc = __int_as_float((be - 6) << 23);
#pragma unroll
    for (int k = 0; k < 2; ++k) { u32x4 w; unsigned ww[4];
#pragma unroll
        for (int i = 0; i < 4; ++i) { int t = 0; t = __builtin_amdgcn_cvt_pk_fp8_f32(v[k][i].x * sc, v[k][i].y * sc, t, false); t = __builtin_amdgcn_cvt_pk_fp8_f32(v[k][i].z * sc, v[k][i].w * sc, t, true); ww[i] = (unsigned)t; }
        w.x = ww[0]; w.y = ww[1]; w.z = ww[2]; w.w = ww[3];
        *(u32x4*)(dst + 1024 * k + 16 * lane) = w; }
    if (lane == 0) *inv_scale = isc;
}

__device__ __forceinline__ void fp8_row2(const float* s0, unsigned char* d0, float* i0, const float* s1, unsigned char* d1, float* i1, int lane) {
    f32x4 v[2][2][4]; float am[2] = {0.f, 0.f};
#pragma unroll
    for (int r = 0; r < 2; ++r)
#pragma unroll
        for (int k = 0; k < 2; ++k)
#pragma unroll
            for (int i = 0; i < 4; ++i) v[r][k][i] = *(const f32x4*)((r ? s1 : s0) + 1024 * k + 16 * lane + 4 * i);
#pragma unroll
    for (int r = 0; r < 2; ++r) {
#pragma unroll
        for (int k = 0; k < 2; ++k)
#pragma unroll
            for (int i = 0; i < 4; ++i) am[r] = fmaxf(am[r], fmaxf(fmaxf(fabsf(v[r][k][i].x), fabsf(v[r][k][i].y)), fmaxf(fabsf(v[r][k][i].z), fabsf(v[r][k][i].w))));
#pragma unroll
        for (int o = 1; o < 64; o <<= 1) am[r] = fmaxf(am[r], __shfl_xor(am[r], o));
        int be = (__float_as_int(am[r]) >> 23) & 255; be = be < 8 ? 8 : (be > 248 ? 248 : be);
        const float sc = __int_as_float((260 - be) << 23), isc = __int_as_float((be - 6) << 23);
#pragma unroll
        for (int k = 0; k < 2; ++k) { u32x4 w; unsigned ww[4];
#pragma unroll
            for (int i = 0; i < 4; ++i) { int t = 0; t = __builtin_amdgcn_cvt_pk_fp8_f32(v[r][k][i].x * sc, v[r][k][i].y * sc, t, false); t = __builtin_amdgcn_cvt_pk_fp8_f32(v[r][k][i].z * sc, v[r][k][i].w * sc, t, true); ww[i] = (unsigned)t; }
            w.x = ww[0]; w.y = ww[1]; w.z = ww[2]; w.w = ww[3];
            *(u32x4*)((r ? d1 : d0) + 1024 * k + 16 * lane) = w; }
        if (lane == 0) *(r ? i1 : i0) = isc;
    }
}

__device__ __forceinline__ void tr_item(const float* W, int ldw, int srccol0, int k0, bf16_t* WT, int ldt, int n0, const float* kscale, const float* nscale, LAS float* scr, int lane) {
    float tv[32];
#pragma unroll
    for (int i = 0; i < 32; ++i) { const int kk = 2 * i + (lane >> 5); tv[i] = W[(size_t)(k0 + kk) * ldw + srccol0 + (lane & 31)]; }
    const float ns = nscale ? nscale[srccol0 + (lane & 31)] : 1.0f;
#pragma unroll
    for (int i = 0; i < 32; ++i) { const int kk = 2 * i + (lane >> 5); float v = tv[i] * ns;
        if (kscale) v *= kscale[k0 + kk]; scr[kk * 33 + (lane & 31)] = v; }
    asm volatile("s_waitcnt lgkmcnt(0)" ::: "memory");
    const int c = lane & 7;
#pragma unroll
    for (int j = 0; j < 4; ++j) { const int n = (lane >> 3) + 8 * j; const LAS float* s = scr + (8 * c) * 33 + n;
        u32x4 o; o.x = cvt_pk_bf16(s[0 * 33], s[1 * 33]); o.y = cvt_pk_bf16(s[2 * 33], s[3 * 33]); o.z = cvt_pk_bf16(s[4 * 33], s[5 * 33]); o.w = cvt_pk_bf16(s[6 * 33], s[7 * 33]);
        *(u32x4*)(WT + (size_t)(n0 + n) * ldt + k0 + 8 * c) = o; }
    asm volatile("s_waitcnt lgkmcnt(0)" ::: "memory");
}
__device__ __forceinline__ int win_srccol(int n) { const int pn = n >> 8, w = n & 255; return pn < 4 ? n : ((w >> 7) ? 2048 : 1024) + (pn - 4) * 128 + (w & 127); }

__device__ __forceinline__ void phase_prep(const Params& p, LAS unsigned char* lds, int bid, int nb) {
    const int tid = threadIdx.x, lane = tid & 63, wave = tid >> 6;
    const int gw = bid * 8 + wave, NGW = nb * 8;
    LAS float* scr = (LAS float*)(lds + wave * 8448);
    for (int r = gw; r < RT; r += NGW) {
        unsigned long long* o8 = (unsigned long long*)(p.hnb + (size_t)r * D) + lane;
        if (r < RPAD) {
#pragma unroll
            for (int j = 0; j < 8; ++j) o8[64 * j] = 0ull;
        } else {
            const f32x4* xr = (const f32x4*)hrow(p, r - RPAD) + lane;
            const f32x4* gr = (const f32x4*)p.mix_g + lane;
            f32x4 v[8]; float s = 0.f;
#pragma unroll
            for (int j = 0; j < 8; ++j) { v[j] = xr[64 * j]; s += (v[j].x * v[j].x + v[j].y * v[j].y) + (v[j].z * v[j].z + v[j].w * v[j].w); }
            const float rs = rsqrtf(wave_sum(s) * (1.0f / D) + 1e-6f);
#pragma unroll
            for (int j = 0; j < 8; ++j) { const f32x4 gv = gr[64 * j];
                o8[64 * j] = (unsigned long long)cvt_pk_bf16(v[j].x * rs * gv.x, v[j].y * rs * gv.y) | ((unsigned long long)cvt_pk_bf16(v[j].z * rs * gv.z, v[j].w * rs * gv.w) << 32); }
        }
    }
    for (int it = gw; it < (D / 64) * (INW / 32); it += NGW) {
        const int kb = it / (INW / 32), nbk = it % (INW / 32);
        tr_item(p.w_in, INW, win_srccol(nbk * 32), kb * 64, p.w_in_t, D, nbk * 32, nullptr, nullptr, scr, lane);
    }
    for (int i = gw * 64 + lane; i < 4 * 256 * 256 / 4; i += NGW * 64) { const f32x4 v = ((const f32x4*)p.pool_w)[i];
        const int g = i >> 14, d = (i & 63) * 4; const f32x4 sc = *(const f32x4*)(p.pool_scale + g * 256 + d);
        u32x2 w; w.x = cvt_pk_bf16(v[0] * sc[0], v[1] * sc[1]); w.y = cvt_pk_bf16(v[2] * sc[2], v[3] * sc[3]); ((u32x2*)p.pool_ws)[i] = w; }
    for (int i = gw * 64 + lane; i < CWD * CWD / 4; i += NGW * 64) { const f32x4 v = ((const f32x4*)p.pw_w)[i];
        u32x2 w; w.x = cvt_pk_bf16(v[0], v[1]); w.y = cvt_pk_bf16(v[2], v[3]); ((u32x2*)p.pw_b16)[i] = w; }
    if (gw < D / 64) { const int n = gw * 64 + lane; float a0 = 0.f, a1 = 0.f, a2 = 0.f, a3 = 0.f;
        for (int j = 0; j < CWD; j += 4) { a0 += p.pw_b[j] * p.w_out[(size_t)(PWD + j) * D + n]; a1 += p.pw_b[j + 1] * p.w_out[(size_t)(PWD + j + 1) * D + n];
            a2 += p.pw_b[j + 2] * p.w_out[(size_t)(PWD + j + 2) * D + n]; a3 += p.pw_b[j + 3] * p.w_out[(size_t)(PWD + j + 3) * D + n]; }
        p.bias_eff[n] = (a0 + a1) + (a2 + a3); }
    for (int it = gw; it < 32 * 64; it += NGW) { const int kb = it >> 6, nbk = it & 63;
        tr_item(p.w_out, D, nbk * 32, kb * 64, p.w_out_t, D, nbk * 32, nullptr, nullptr, scr, lane); }
    for (int it = gw; it < 32 * 64; it += NGW) { const int kb = it >> 6, nbk = it & 63;
        tr_item(p.wq, D, nbk * 32, kb * 64, p.wq_t, D, nbk * 32, p.ffn_g, nullptr, scr, lane); }
    for (int i = gw * 64 + lane; i < 8 * 2 * 128 * 128 / 4; i += NGW * 64) { const f32x4 v = ((const f32x4*)p.keys)[i];
        u32x2 w; w.x = cvt_pk_bf16(v[0], v[1]); w.y = cvt_pk_bf16(v[2], v[3]); ((u32x2*)p.keysb)[i] = w; }
    for (int e = gw; e < 16384; e += NGW)
        fp8_row2(p.down + (size_t)e * D, p.down8 + (size_t)e * D, p.sdn + e, p.up + (size_t)e * D, p.up8 + (size_t)e * D, p.sup + e, lane);
}


#define XB_TMO      128
#define XB_XCNT(j)  (256  + 64 * (j))
#define XB_XSUB(j)  (1280 + 64 * (j))
#define XB_XGEN(j)  (2304 + 64 * (j))
#define XB_TOP      3328
#define XB_TOPGEN   3392
#define XCD_BAR_WORDS 3456
#define XB_SPIN_CAP (1u << 18)
__device__ __forceinline__ unsigned xb_ld(unsigned* p)              { return __hip_atomic_load(p, __ATOMIC_RELAXED, __HIP_MEMORY_SCOPE_AGENT); }
__device__ __forceinline__ unsigned xb_add(unsigned* p, unsigned v) { return __hip_atomic_fetch_add(p, v, __ATOMIC_RELAXED, __HIP_MEMORY_SCOPE_AGENT); }
__device__ __forceinline__ unsigned xb_xcc_id() { return (unsigned)__builtin_amdgcn_s_getreg((3 << 11) | 20) & 0xFu; }
#define XB_SPIN(cond, bar) do { unsigned _sp = 0; while (cond) { __builtin_amdgcn_s_sleep(1); \
    if ((++_sp & 255u) == 0u) { if (xb_ld(&(bar)[XB_TMO])) break; if (_sp > XB_SPIN_CAP) { atomicAdd(&(bar)[XB_TMO], 1u); break; } } } } while (0)
struct XcdBarrier { unsigned* bar; unsigned x; volatile LAS unsigned* st; };
__device__ __forceinline__ XcdBarrier xcd_barrier_post(unsigned* bar, volatile LAS unsigned* st) {
    XcdBarrier b; b.bar = bar; b.x = xb_xcc_id(); b.st = st;
    if (threadIdx.x == 0) (void)xb_add(&bar[XB_XCNT(b.x)], 1u);
    return b;
}
__device__ __forceinline__ void xcd_barrier_complete(unsigned* bar, unsigned x, unsigned& nloc, unsigned& nx) {
    const unsigned G = gridDim.x * gridDim.y * gridDim.z;
    unsigned sum, cnt, mine, sp = 0u;
    for (;;) {
        sum = 0u; cnt = 0u; mine = 0u;
#pragma unroll
        for (unsigned j = 0; j < 16; ++j) { const unsigned c = xb_ld(&bar[XB_XCNT(j)]); sum += c; cnt += (c > 0u) ? 1u : 0u; mine = (j == x) ? c : mine; }
        if (sum == G) break;
        __builtin_amdgcn_s_sleep(1);
        if ((++sp & 255u) == 0u) { if (xb_ld(&bar[XB_TMO])) break; if (sp > XB_SPIN_CAP) { atomicAdd(&bar[XB_TMO], 1u); break; } }
    }
    nloc = mine > 0u ? mine : 1u; nx = cnt > 0u ? cnt : 1u;
}
__device__ __forceinline__ void xcd_barrier(const XcdBarrier& b) {
    asm volatile("s_waitcnt vmcnt(0)" ::: "memory");
    __syncthreads();
    if (threadIdx.x == 0) {
        unsigned* bar = b.bar;
        __builtin_amdgcn_s_waitcnt(0);
        unsigned nloc = b.st[0], nx = b.st[1];
        if (nloc == 0u) { xcd_barrier_complete(bar, b.x, nloc, nx); b.st[0] = nloc; b.st[1] = nx; }
        const unsigned old = xb_add(&bar[XB_XSUB(b.x)], 1u);
        const unsigned gen = old / nloc;
        if (old + 1u == (gen + 1u) * nloc) {
            __builtin_amdgcn_fence(__ATOMIC_RELEASE, "agent");
            asm volatile("s_waitcnt vmcnt(0)" ::: "memory");
            const unsigned og = xb_add(&bar[XB_TOP], 1u);
            const unsigned tg = og / nx;
            if (og + 1u == (tg + 1u) * nx) xb_add(&bar[XB_TOPGEN], 1u);
            else XB_SPIN(xb_ld(&bar[XB_TOPGEN]) == tg, bar);
            __builtin_amdgcn_fence(__ATOMIC_ACQUIRE, "agent");
            xb_add(&bar[XB_XGEN(b.x)], 1u);
            asm volatile("s_waitcnt vmcnt(0)" ::: "memory");
        } else {
            XB_SPIN(xb_ld(&bar[XB_XGEN(b.x)]) == gen, bar);
            __builtin_amdgcn_fence(__ATOMIC_ACQUIRE, "agent");
            asm volatile("s_waitcnt vmcnt(0)" ::: "memory");
        }
    }
    __syncthreads();
}

__global__ void __launch_bounds__(NT, 2) k_mega(Params p) {
    extern __shared__ __attribute__((aligned(16))) unsigned char lds_raw[];
    LAS unsigned char* lds = (LAS unsigned char*)lds_raw;
    const int bid = blockIdx.x, nb = gridDim.x;
    volatile LAS unsigned* bst = (volatile LAS unsigned*)(lds + LDS_BYTES - 16);
    if (threadIdx.x < 4) bst[threadIdx.x] = 0u;
    __syncthreads();
    const XcdBarrier xb = xcd_barrier_post(p.bar, bst);
    phase_prep(p, lds, bid, nb);
    xcd_barrier(xb);
    { pg8::Gemm g{p.hnb, p.w_in_t, D, D, D, 0}; pg8::StaticOrder S; S.init(RT / 256, INW / 256, nb, bid); EpiProj E{p.xp, p.glu};
      pg8::gemm_phase<EpiProj, pg8::StaticOrder>(lds, g, S, E); }
    { const int nproj = (RT / 256) * (INW / 256); const int first = (nproj > nb && nproj < 2 * nb) ? nproj - nb : 0, nfree = nb - first;
      for (int uu = bid - first; uu >= 0 && uu < 64; uu += nfree) {
        __syncthreads();
        const bool pw = uu < 32;
        pg8::Gemm g{pw ? p.w_out_t + PWD : p.w_out_t, pw ? p.pw_b16 : p.pool_ws, D, pw ? CWD : 256, pw ? CWD : 256, pw ? 0 : 256};
        pg8::OneUnit S; S.u.pm = (uu & 31) >> 2; S.u.pn = uu & 3; EpiBf16Out E{p.w_eff_t, D, pw ? PWD : 0, nullptr};
        pg8::gemm_phase<EpiBf16Out, pg8::OneUnit>(lds, g, S, E);
      }
    }
    xcd_barrier(xb);
    phase_mix(p, lds, bid, nb);
    xcd_barrier(xb);
    { pg8::Gemm g{p.mixb, p.w_eff_t, D, D, D, 0}; pg8::StaticOrder S; S.init(SEQ / 256, D / 256, nb, bid); EpiResid E{p.x, p.bias_eff, p.h2b, p.ssq};
      pg8::gemm_phase<EpiResid, pg8::StaticOrder>(lds, g, S, E); }
    xcd_barrier(xb);
    { pg8::Gemm g{p.h2b, p.wq_t, D, D, D, 0}; pg8::StaticOrder S; S.init(SEQ / 256, D / 256, nb, bid); EpiQTopk E{p.ssq, p.rstd, p.keysb, p.idx, p.gsu};
      pg8::gemm_phase<EpiQTopk, pg8::StaticOrder>(lds, g, S, E); }
    xcd_barrier(xb);
    phase_pd(p, bid, nb);
    xcd_barrier(xb);
    phase_pa(p, bid, nb);
    xcd_barrier(xb);
    phase_pu(p, bid, nb);
    xcd_barrier(xb);
    phase_pf(p, bid, nb);
}

extern "C" void kernel_launch(void* const* d_in, const int* in_sizes, int n_in, void* d_out, int out_size, void* d_ws, size_t ws_size, hipStream_t stream) {
    Params p{};
    p.x = (const float*)d_in[0]; p.meta = (const float*)d_in[1]; p.mix_g = (const float*)d_in[2]; p.w_in = (const float*)d_in[3];
    p.pool_w = (const float*)d_in[4]; p.pool_scale = (const float*)d_in[5]; p.dw_w = (const float*)d_in[6]; p.dw_b = (const float*)d_in[7];
    p.ln_g = (const float*)d_in[8]; p.ln_b = (const float*)d_in[9]; p.pw_w = (const float*)d_in[10]; p.pw_b = (const float*)d_in[11];
    p.w_out = (const float*)d_in[12]; p.ffn_g = (const float*)d_in[13]; p.wq = (const float*)d_in[14]; p.keys = (const float*)d_in[15];
    p.down = (const float*)d_in[16]; p.up = (const float*)d_in[17]; p.fin_g = (const float*)d_in[18];
    p.out = (float*)d_out;
    char* w = (char*)d_ws; size_t off = 0;
    auto take = [&](size_t bytes) { char* r = w + off; off += (bytes + 255) & ~(size_t)255; return r; };
    p.idx = (unsigned short*)take((size_t)SEQ * 128 * 2);
    p.gsu = (float*)take((size_t)SEQ * 128 * 4);
    p.part = (bf16_t*)take((size_t)SEQ * 16 * 128 * 2);
    p.act = (bf16_t*)take((size_t)SEQ * 128 * 2);
    p.ssq2 = (float*)take((size_t)SEQ * 16 * 4);
    p.h3b = (bf16_t*)take((size_t)SEQ * D * 2);
    p.hnb = (bf16_t*)take((size_t)RT * D * 2);
    p.w_in_t = (bf16_t*)take((size_t)INW * D * 2);
    p.xp = (bf16_t*)take((size_t)RT * PWD * 2);
    p.glu = (bf16_t*)take((size_t)RT * CWD * 2);
    p.mixb = (bf16_t*)take((size_t)SEQ * D * 2);
    p.h2b = (bf16_t*)take((size_t)SEQ * D * 2);
    p.pool_ws = (bf16_t*)take((size_t)4 * 256 * 256 * 2);
    p.pw_b16 = (bf16_t*)take((size_t)CWD * CWD * 2);
    p.w_eff_t = (bf16_t*)take((size_t)D * D * 2);
    p.bias_eff = (float*)take((size_t)D * 4);
    p.w_out_t = (bf16_t*)take((size_t)D * D * 2);
    p.ssq = (float*)take((size_t)SEQ * 32 * 4);
    p.bar = (unsigned*)take((size_t)XCD_BAR_WORDS * 4);
    p.rstd = (float*)take((size_t)SEQ * 4);
    p.wq_t = (bf16_t*)take((size_t)D * D * 2);
    p.keysb = (bf16_t*)take((size_t)8 * 2 * 128 * 128 * 2);
    p.qb = (bf16_t*)take((size_t)SEQ * D * 2);
    p.down8 = (unsigned char*)take((size_t)16384 * D);
    p.up8 = (unsigned char*)take((size_t)16384 * D);
    p.sdn = (float*)take((size_t)16384 * 4);
    p.sup = (float*)take((size_t)16384 * 4);
    static int grid_blocks = 0;
    if (!grid_blocks) {
        int dev = 0, cus = 0, per_cu = 0;
        (void)hipGetDevice(&dev);
        (void)hipDeviceGetAttribute(&cus, hipDeviceAttributeMultiprocessorCount, dev);
        (void)hipFuncSetAttribute((const void*)k_mega, hipFuncAttributeMaxDynamicSharedMemorySize, LDS_BYTES);
        (void)hipOccupancyMaxActiveBlocksPerMultiprocessor(&per_cu, k_mega, NT, LDS_BYTES);
        if (per_cu < 1) { fprintf(stderr, "occupancy query says %d workgroups per CU: nothing launched\n", per_cu); grid_blocks = -1; }
        else if (cus != (SEQ / 256) * (D / 256)) { fprintf(stderr, "this build needs a %d-CU device (got %d): nothing launched\n", (SEQ / 256) * (D / 256), cus); grid_blocks = -1; }
        else grid_blocks = cus;
    }
    if (grid_blocks < 0) return;
    (void)hipMemsetAsync(p.bar, 0, (size_t)XCD_BAR_WORDS * 4, stream);
    void* args[] = {&p};
    hipError_t e = hipLaunchCooperativeKernel((void*)k_mega, dim3(grid_blocks), dim3(NT), args, LDS_BYTES, stream);
    if (e != hipSuccess) fprintf(stderr, "cooperative launch failed: %s (grid %d)\n", hipGetErrorString(e), grid_blocks);
}
```

```cpp
#include <hip/hip_runtime.h>
#include <hip/hip_cooperative_groups.h>
#include <stdint.h>
#include <cstdio>
namespace cg = cooperative_groups;

#define NT 512
#define LAS __attribute__((address_space(3)))
typedef unsigned short bf16_t;
typedef short bf16x8 __attribute__((ext_vector_type(8)));
typedef float f32x4 __attribute__((ext_vector_type(4)));
typedef unsigned u32x4 __attribute__((ext_vector_type(4)));
typedef unsigned u32x2 __attribute__((ext_vector_type(2)));

constexpr int D = 2048, SEQ = 8192, NMETA = 16, T = SEQ + NMETA;
constexpr int PWD = 1024, CWD = 1024, INW = 3072;
constexpr int KS = 31;
constexpr int RPAD = 240, RT = 8448;
constexpr int LDS_BYTES = 151552;

struct Params {
    const float *x, *meta, *mix_g, *w_in, *pool_w, *pool_scale, *dw_w, *dw_b, *ln_g, *ln_b, *pw_w, *pw_b, *w_out, *ffn_g, *wq, *keys, *down, *up, *fin_g;
    float* out;
    unsigned short* idx;
    unsigned* bar;
    bf16_t *hnb, *w_in_t, *xp, *glu, *mixb, *h2b, *pool_ws, *pw_b16, *w_eff_t, *w_out_t, *wq_t, *keysb, *qb;
    unsigned char *down8, *up8;
    float *sdn, *sup;
    float *gsu;
    bf16_t* part;
    bf16_t* act;
    float* ssq2;
    bf16_t* h3b;
    float *ssq, *rstd, *bias_eff;
};

__device__ __forceinline__ unsigned cvt_pk_bf16(float lo, float hi) { unsigned r; asm volatile("v_cvt_pk_bf16_f32 %0, %1, %2" : "=v"(r) : "v"(lo), "v"(hi)); return r; }
__device__ __forceinline__ float wave_sum(float v) {
#pragma unroll
    for (int o = 1; o < 64; o <<= 1) v += __shfl_xor(v, o);
    return v;
}

__device__ __forceinline__ const float* hrow(const Params& p, int t) { return t < NMETA ? p.meta + (size_t)t * D : p.x + (size_t)(t - NMETA) * D; }

__device__ __forceinline__ float block_sum(float v, float* red) {
#pragma unroll
    for (int o = 32; o; o >>= 1) v += __shfl_xor(v, o);
    __syncthreads();
    if ((threadIdx.x & 63) == 0) red[threadIdx.x >> 6] = v;
    __syncthreads();
    float s = 0.f;
#pragma unroll
    for (int i = 0; i < NT / 64; ++i) s += red[i];
    return s;
}

namespace pg8 {
constexpr int BM = 256, BK = 64, HALF = 128, HTB = HALF * BK * 2, STAGE_BYTES = 8 * HTB, NXCD = 8, WGM = 8;
__device__ __forceinline__ int lds_byte(int r, int c) { const int st = (r >> 4) * 2 + (c >> 5), rr = r & 15, cc = c & 31, ob = rr * 64 + cc * 2; return st * 1024 + (ob ^ (((ob >> 9) & 1) << 5)); }
__device__ __forceinline__ void stage_rc(int b, int& R, int& C) { const int st = b / 1024, sb = b % 1024, swz = sb ^ (((sb >> 9) & 1) << 5); R = (st >> 1) * 16 + swz / 64; C = (st & 1) * 32 + (swz % 64) / 2; }
struct Unit { int pm, pn; };
struct Gemm { const bf16_t* A; const bf16_t* Bt; int lda, ldb, K; int a_col_per_pn; };
struct StaticOrder {
    int nM, nN, nwg, G, c;
    __device__ void init(int nM_, int nN_, int G_, int c_) { nM = nM_; nN = nN_; nwg = nM * nN; G = G_; c = c_; }
    __device__ bool next(int i, Unit& u) const {
        const long L = (long)i * G + c; if (L >= nwg) return false;
        int wgid = (int)L; { const int q = nwg / NXCD, r = nwg % NXCD, xcd = wgid % NXCD, off = wgid / NXCD; wgid = (xcd < r ? xcd * (q + 1) : r * (q + 1) + (xcd - r) * q) + off; }
        const int nig = WGM * nN, gid = wgid / nig, fm = gid * WGM, gsz = (nM - fm) < WGM ? (nM - fm) : WGM;
        u.pm = fm + ((wgid % nig) % gsz); u.pn = (wgid % nig) / gsz; return true;
    }
};
struct OneUnit { Unit u; __device__ bool next(int i, Unit& o) const { if (i) return false; o = u; return true; } };
template <class Epi, class Sched>
__device__ __forceinline__ void gemm_phase(LAS unsigned char* lds, const Gemm g, const Sched& S, const Epi& E) {
    const int tid = threadIdx.x, wid = __builtin_amdgcn_readfirstlane(tid >> 6), lane = tid & 63, wr = wid >> 2, wc = wid & 3, fr = lane & 15, fq = lane >> 4;
    const int K = g.K, nt = K / BK;
    unsigned voffA[2], voffB[2];
#pragma unroll
    for (int i = 0; i < 2; ++i) { int R, C; stage_rc(tid * 16 + i * 8192, R, C);
        voffA[i] = (unsigned)(R * g.lda + C) * 2u; voffB[i] = (unsigned)(R * g.ldb + C) * 2u; }
    const size_t kstep = (size_t)(BK * 2);
    const size_t hstepA = (size_t)HALF * g.lda * 2, hstepB = (size_t)HALF * g.ldb * 2;
    const size_t tstepA = 2 * hstepA, tstepB = 2 * hstepB;
    const unsigned ldsw = (unsigned)wid * 1024u;
    const int aoff = lds_byte(wr * 64 + fr, fq * 8), boff = lds_byte(wc * 32 + fr, fq * 8);
#define PG8_SA(b, h) (((b) * 2 + (h)) * HTB)
#define PG8_SB(b, h) ((4 + (b) * 2 + (h)) * HTB)
#define PG8_STAGE(bufoff, gbase, voff) do { _Pragma("unroll") for (int _i = 0; _i < 2; ++_i) \
        __builtin_amdgcn_global_load_lds((const unsigned*)((const char*)(gbase) + (voff)[_i]), (LAS unsigned*)(lds + (bufoff) + ldsw + _i * 8192), 16, 0, 0); } while (0)
#define PG8_LDA(dst, b, h) do { _Pragma("unroll") for (int m = 0; m < 4; ++m) _Pragma("unroll") for (int k = 0; k < 2; ++k) dst[m][k] = *(const LAS bf16x8*)(lds + PG8_SA(b, h) + aoff + m * 2048 + k * 1024); } while (0)
#define PG8_LDB(dst, b, h) do { _Pragma("unroll") for (int n = 0; n < 2; ++n) _Pragma("unroll") for (int k = 0; k < 2; ++k) dst[n][k] = *(const LAS bf16x8*)(lds + PG8_SB(b, h) + boff + n * 2048 + k * 1024); } while (0)
#define PG8_MMA(ai, bj, At, Bt) do { __builtin_amdgcn_s_setprio(1); _Pragma("unroll") for (int m = 0; m < 4; ++m) _Pragma("unroll") for (int n = 0; n < 2; ++n) _Pragma("unroll") for (int k = 0; k < 2; ++k) \
        acc[ai][bj][m][n] = __builtin_amdgcn_mfma_f32_16x16x32_bf16(Bt[n][k], At[m][k], acc[ai][bj][m][n], 0, 0, 0); __builtin_amdgcn_s_setprio(0); } while (0)
#define PG8_WAIT_V(n) asm volatile("s_waitcnt vmcnt(" #n ")" ::: "memory")
#define PG8_WAIT_L(n) asm volatile("s_waitcnt lgkmcnt(" #n ")" ::: "memory")
#define PG8_BAR __builtin_amdgcn_s_barrier()
#define PG8_SCHED __builtin_amdgcn_sched_barrier(0)
    Unit cur, nxt; int ui = 0;
    if (!S.next(0, cur)) return;
    f32x4 acc[2][2][4][2];
#pragma unroll
    for (int a = 0; a < 2; ++a)
#pragma unroll
        for (int b = 0; b < 2; ++b)
#pragma unroll
            for (int m = 0; m < 4; ++m)
#pragma unroll
                for (int n = 0; n < 2; ++n) acc[a][b][m][n] = (f32x4){0.f, 0.f, 0.f, 0.f};
    bf16x8 At[4][2], B0[2][2], B1[2][2];
    const char* cA = (const char*)g.A + (size_t)cur.pm * tstepA + (size_t)cur.pn * g.a_col_per_pn * 2; const char* cB = (const char*)g.Bt + (size_t)cur.pn * tstepB;
    PG8_STAGE(PG8_SB(0, 0), cB, voffB); PG8_STAGE(PG8_SA(0, 0), cA, voffA); PG8_STAGE(PG8_SB(0, 1), cB + hstepB, voffB); PG8_STAGE(PG8_SA(0, 1), cA + hstepA, voffA);
    if (wr == 1) PG8_BAR;
    PG8_WAIT_V(4); PG8_BAR;
    PG8_STAGE(PG8_SB(1, 0), cB + kstep, voffB); PG8_STAGE(PG8_SA(1, 0), cA + kstep, voffA); PG8_STAGE(PG8_SB(1, 1), cB + hstepB + kstep, voffB);
    PG8_WAIT_V(6); PG8_BAR;
    for (;;) {
        const bool has_next = S.next(ui + 1, nxt);
        const char* nA = has_next ? (const char*)g.A + (size_t)nxt.pm * tstepA + (size_t)nxt.pn * g.a_col_per_pn * 2 : cA; const char* nB = has_next ? (const char*)g.Bt + (size_t)nxt.pn * tstepB : cB;
        for (int t = 0; t < nt; t += 2) {
            const bool last = (t == nt - 2);
            const char* a1 = cA + (size_t)(t + 1) * kstep;
            const char* a2 = last ? nA : cA + (size_t)(t + 2) * kstep; const char* b2 = last ? nB : cB + (size_t)(t + 2) * kstep;
            const char* a3 = a2 + kstep; const char* b3 = b2 + kstep;
            PG8_LDB(B0, 0, 0); PG8_SCHED; PG8_LDA(At, 0, 0); PG8_STAGE(PG8_SA(1, 1), a1 + hstepA, voffA);
            PG8_WAIT_L(8); PG8_BAR; PG8_WAIT_L(0); PG8_MMA(0, 0, At, B0); PG8_BAR; PG8_SCHED;
            PG8_LDB(B1, 0, 1); PG8_STAGE(PG8_SB(0, 0), b2, voffB);
            PG8_BAR; PG8_WAIT_L(0); PG8_MMA(0, 1, At, B1); PG8_BAR;
            PG8_LDA(At, 0, 1); PG8_STAGE(PG8_SA(0, 0), a2, voffA);
            PG8_BAR; PG8_WAIT_L(0); PG8_MMA(1, 0, At, B0); PG8_BAR; PG8_SCHED;
            PG8_STAGE(PG8_SB(0, 1), b2 + hstepB, voffB);
            PG8_WAIT_V(6); PG8_BAR; PG8_MMA(1, 1, At, B1); PG8_BAR;
            PG8_LDB(B0, 1, 0); PG8_SCHED; PG8_LDA(At, 1, 0); PG8_STAGE(PG8_SA(0, 1), a2 + hstepA, voffA);
            PG8_WAIT_L(8); PG8_BAR; PG8_WAIT_L(0); PG8_MMA(0, 0, At, B0); PG8_BAR; PG8_SCHED;
            PG8_LDB(B1, 1, 1); PG8_STAGE(PG8_SB(1, 0), b3, voffB);
            PG8_BAR; PG8_WAIT_L(0); PG8_MMA(0, 1, At, B1); PG8_BAR;
            PG8_LDA(At, 1, 1); PG8_STAGE(PG8_SA(1, 0), a3, voffA);
            PG8_BAR; PG8_WAIT_L(0); PG8_MMA(1, 0, At, B0); PG8_BAR; PG8_SCHED;
            PG8_STAGE(PG8_SB(1, 1), b3 + hstepB, voffB);
            PG8_WAIT_V(6); PG8_BAR; PG8_MMA(1, 1, At, B1); PG8_BAR;
        }
        if constexpr (!Epi::AFTER_DRAIN) E(acc, cur, wr, wc, fr, fq);
        if (!has_next) break;
#pragma unroll
        for (int a = 0; a < 2; ++a)
#pragma unroll
            for (int b = 0; b < 2; ++b)
#pragma unroll
                for (int m = 0; m < 4; ++m)
#pragma unroll
                    for (int n = 0; n < 2; ++n) acc[a][b][m][n] = (f32x4){0.f, 0.f, 0.f, 0.f};
        cur = nxt; cA = nA; cB = nB; ++ui;
    }
    PG8_WAIT_V(0);
    if (wr == 0) PG8_BAR;
    PG8_BAR;
    if constexpr (Epi::AFTER_DRAIN) E.fused(acc, cur, wr, wc, fr, fq, lds, wid, lane);
#undef PG8_SA
#undef PG8_SB
#undef PG8_STAGE
#undef PG8_LDA
#undef PG8_LDB
#undef PG8_MMA
#undef PG8_WAIT_V
#undef PG8_WAIT_L
#undef PG8_BAR
#undef PG8_SCHED
}
}

struct EpiProjF32 {
    static constexpr bool AFTER_DRAIN = false;
    float* proj;
    __device__ __forceinline__ void operator()(const f32x4 (&acc)[2][2][4][2], const pg8::Unit& u, int wr, int wc, int fr, int fq) const {
#pragma unroll
        for (int ai = 0; ai < 2; ++ai)
#pragma unroll
            for (int m = 0; m < 4; ++m) {
                const int t = u.pm * 256 + ai * 128 + wr * 64 + m * 16 + fr - RPAD;
                if (t >= 0) {
#pragma unroll
                    for (int bj = 0; bj < 2; ++bj)
#pragma unroll
                        for (int n = 0; n < 2; ++n) {
                            const int off = wc * 32 + n * 16 + fq * 4;
                            const int col = u.pn < 4 ? u.pn * 256 + bj * 128 + off : (bj ? 2048 : 1024) + (u.pn - 4) * 128 + off;
                            *(f32x4*)(proj + (size_t)t * INW + col) = acc[ai][bj][m][n];
                        }
                }
            }
    }
};


__device__ __forceinline__ float sigmoidf_fast(float x) { return __builtin_amdgcn_rcpf(1.0f + __expf(-x)); }

struct EpiProj {
    static constexpr bool AFTER_DRAIN = false;
    bf16_t* xp; bf16_t* glu;
    __device__ __forceinline__ void operator()(const f32x4 (&acc)[2][2][4][2], const pg8::Unit& u, int wr, int wc, int fr, int fq) const {
#pragma unroll
        for (int ai = 0; ai < 2; ++ai)
#pragma unroll
            for (int m = 0; m < 4; ++m) {
                const size_t row = (size_t)(u.pm * 256 + ai * 128 + wr * 64 + m * 16 + fr);
                if (u.pn < 4) {
#pragma unroll
                    for (int bj = 0; bj < 2; ++bj)
#pragma unroll
                        for (int n = 0; n < 2; ++n) { const f32x4 v = acc[ai][bj][m][n]; u32x2 w; w.x = cvt_pk_bf16(v[0], v[1]); w.y = cvt_pk_bf16(v[2], v[3]);
                            *(u32x2*)(xp + row * PWD + u.pn * 256 + bj * 128 + wc * 32 + n * 16 + fq * 4) = w; }
                } else {
#pragma unroll
                    for (int n = 0; n < 2; ++n) { const f32x4 a = acc[ai][0][m][n], g = acc[ai][1][m][n]; u32x2 w;
                        w.x = cvt_pk_bf16(a[0] * sigmoidf_fast(g[0]), a[1] * sigmoidf_fast(g[1])); w.y = cvt_pk_bf16(a[2] * sigmoidf_fast(g[2]), a[3] * sigmoidf_fast(g[3]));
                        *(u32x2*)(glu + row * CWD + (u.pn - 4) * 128 + wc * 32 + n * 16 + fq * 4) = w; }
                }
            }
    }
};
struct EpiBf16Out {
    static constexpr bool AFTER_DRAIN = false;
    bf16_t* O; int ldc; int col0; const float* bias;
    __device__ __forceinline__ void operator()(const f32x4 (&acc)[2][2][4][2], const pg8::Unit& u, int wr, int wc, int fr, int fq) const {
#pragma unroll
        for (int ai = 0; ai < 2; ++ai)
#pragma unroll
            for (int m = 0; m < 4; ++m) {
                const size_t row = (size_t)(u.pm * 256 + ai * 128 + wr * 64 + m * 16 + fr);
#pragma unroll
                for (int bj = 0; bj < 2; ++bj)
#pragma unroll
                    for (int n = 0; n < 2; ++n) { const int c = u.pn * 256 + bj * 128 + wc * 32 + n * 16 + fq * 4; f32x4 v = acc[ai][bj][m][n];
                        if (bias) v += *(const f32x4*)(bias + c);
                        u32x2 w; w.x = cvt_pk_bf16(v[0], v[1]); w.y = cvt_pk_bf16(v[2], v[3]);
                        *(u32x2*)(O + row * ldc + col0 + c) = w; }
            }
    }
};
struct EpiResid {
    static constexpr bool AFTER_DRAIN = false;
    const float* x; const float* bias; bf16_t* h2b; float* ssq;
    __device__ __forceinline__ void operator()(const f32x4 (&acc)[2][2][4][2], const pg8::Unit& u, int wr, int wc, int fr, int fq) const {
#pragma unroll
        for (int ai = 0; ai < 2; ++ai)
#pragma unroll
            for (int m = 0; m < 4; ++m) {
                const size_t row = (size_t)(u.pm * 256 + ai * 128 + wr * 64 + m * 16 + fr);
                float ss = 0.f;
#pragma unroll
                for (int bj = 0; bj < 2; ++bj)
#pragma unroll
                    for (int n = 0; n < 2; ++n) { const int c = u.pn * 256 + bj * 128 + wc * 32 + n * 16 + fq * 4;
                        const f32x4 v = acc[ai][bj][m][n] + *(const f32x4*)(x + row * D + c) + *(const f32x4*)(bias + c);
                        u32x2 w; w.x = cvt_pk_bf16(v[0], v[1]); w.y = cvt_pk_bf16(v[2], v[3]);
                        *(u32x2*)(h2b + row * D + c) = w;
                        ss += (v[0] * v[0] + v[1] * v[1]) + (v[2] * v[2] + v[3] * v[3]); }
                ss += __shfl_xor(ss, 16); ss += __shfl_xor(ss, 32);
                if (fq == 0) ssq[row * 32 + u.pn * 4 + wc] = ss;
            }
    }
};

__device__ __forceinline__ float fsel(int mask, float a, float b) { return __int_as_float((__float_as_int(a) & ~mask) | (__float_as_int(b) & mask)); }
__device__ __forceinline__ float bf_lo(unsigned w) { return __uint_as_float(w << 16); }
__device__ __forceinline__ float bf_hi(unsigned w) { return __uint_as_float(w & 0xffff0000u); }

__device__ __forceinline__ u32x4 bload16(__amdgpu_buffer_rsrc_t r, int voff, int soff) { return __builtin_bit_cast(u32x4, __builtin_amdgcn_raw_buffer_load_b128(r, voff, soff, 0)); }
__device__ __forceinline__ unsigned bload4(__amdgpu_buffer_rsrc_t r, int voff, int soff) { return (unsigned)__builtin_amdgcn_raw_buffer_load_b32(r, voff, soff, 0); }
__device__ __forceinline__ void bstore4(__amdgpu_buffer_rsrc_t r, unsigned v, int voff, int soff) { __builtin_amdgcn_raw_buffer_store_b32(v, r, voff, soff, 0); }
template <int W> __device__ __forceinline__ void pool_tile(__amdgpu_buffer_rsrc_t rxp, __amdgpu_buffer_rsrc_t rpo, int r0, int tile, int tid) {
    unsigned v[32 + W - 1];
#pragma unroll
    for (int i = 0; i < 32 + W - 1; ++i) v[i] = bload4(rxp, tid * 4, (r0 - (W - 1) + i) * 2048);
    float s0 = 0.f, s1 = 0.f;
#pragma unroll
    for (int i = 0; i < W - 1; ++i) { s0 += bf_lo(v[i]); s1 += bf_hi(v[i]); }
    constexpr float inv = 1.0f / (float)W;
#pragma unroll
    for (int i = 0; i < 32; ++i) {
        const float a0 = bf_lo(v[W - 1 + i]), a1 = bf_hi(v[W - 1 + i]);
        s0 += a0; s1 += a1;
        bstore4(rpo, cvt_pk_bf16(s0 * inv - a0, s1 * inv - a1), tid * 4, (tile * 32 + i) * 4096);
        s0 -= bf_lo(v[i]); s1 -= bf_hi(v[i]);
    }
}
__device__ __forceinline__ void phase_mix(const Params& p, LAS unsigned char* lds, int bid, int nb) {
    const int tid = threadIdx.x, lane = tid & 63, wave = tid >> 6;
    LAS unsigned* gl = (LAS unsigned*)lds;
    LAS float* red = (LAS float*)(lds + 62 * 2048);
    const __amdgpu_buffer_rsrc_t rxp = __builtin_amdgcn_make_buffer_rsrc((void*)p.xp, 0, RT * PWD * 2, 0x00020000);
    const __amdgpu_buffer_rsrc_t rgl = __builtin_amdgcn_make_buffer_rsrc((void*)p.glu, 0, RT * CWD * 2, 0x00020000);
    const __amdgpu_buffer_rsrc_t rpo = __builtin_amdgcn_make_buffer_rsrc((void*)p.mixb, 0, SEQ * D * 2, 0x00020000);
    const __amdgpu_buffer_rsrc_t rww = __builtin_amdgcn_make_buffer_rsrc((void*)p.dw_w, 0, KS * CWD * 4, 0x00020000);
    const __amdgpu_buffer_rsrc_t rwb = __builtin_amdgcn_make_buffer_rsrc((void*)p.dw_b, 0, CWD * 4, 0x00020000);
    const __amdgpu_buffer_rsrc_t rlg = __builtin_amdgcn_make_buffer_rsrc((void*)p.ln_g, 0, CWD * 4, 0x00020000);
    const __amdgpu_buffer_rsrc_t rlb = __builtin_amdgcn_make_buffer_rsrc((void*)p.ln_b, 0, CWD * 4, 0x00020000);
    for (int tile = bid; tile < SEQ / 32; tile += nb) {
        const int r0 = 256 + tile * 32;
        __syncthreads();
#pragma unroll
        for (int j = 0; j < 16; ++j) { const int ch = j * NT + tid; if (ch < 62 * 128)
            *(LAS u32x4*)(lds + ch * 16) = bload16(rgl, tid * 16, (r0 - 30) * 2048 + j * 8192); }
        { const int g = __builtin_amdgcn_readfirstlane(tid >> 7);
          if (g == 0) pool_tile<2>(rxp, rpo, r0, tile, tid); else if (g == 1) pool_tile<4>(rxp, rpo, r0, tile, tid); else if (g == 2) pool_tile<8>(rxp, rpo, r0, tile, tid); else pool_tile<16>(rxp, rpo, r0, tile, tid); }
        __syncthreads();
#pragma unroll 1
        for (int hf = 0; hf < 2; ++hf) {
            float c0[16], c1[16];
            {
                float w0[KS], w1[KS];
#pragma unroll
                for (int k = 0; k < KS; ++k) { w0[k] = __uint_as_float(bload4(rww, tid * 8, k * 4096)); w1[k] = __uint_as_float(bload4(rww, tid * 8 + 4, k * 4096)); }
                const float b0 = __uint_as_float(bload4(rwb, tid * 8, 0)), b1 = __uint_as_float(bload4(rwb, tid * 8 + 4, 0));
#pragma unroll
                for (int i = 0; i < 16; ++i) { c0[i] = b0; c1[i] = b1; }
                const LAS unsigned* glh = gl + hf * 16 * 512 + tid;
#pragma unroll
                for (int rr = 0; rr < 46; ++rr) {
                    if ((rr & 7) == 0) asm volatile("" ::: "memory");
                    const unsigned vv = glh[rr * 512]; const float x0 = bf_lo(vv), x1 = bf_hi(vv);
#pragma unroll
                    for (int i = 0; i < 16; ++i) { const int k = rr - i; if (k >= 0 && k < KS) { c0[i] += x0 * w0[k]; c1[i] += x1 * w1[k]; } }
                }
            }
            asm volatile("" ::: "memory");
#pragma unroll
            for (int which = 0; which < 2; ++which) {
                float st[16];
#pragma unroll
                for (int i = 0; i < 16; ++i) st[i] = which == 0 ? c0[i] + c1[i] : c0[i] * c0[i] + c1[i] * c1[i];
#pragma unroll
                for (int lvl = 0; lvl < 4; ++lvl) {
                    const int o = 32 >> lvl, n = 8 >> lvl; const int mk = -((lane >> (5 - lvl)) & 1);
#pragma unroll
                    for (int j = 0; j < 8; ++j) if (j < n) st[j] = fsel(mk, st[j], st[j + n]) + __shfl_xor(fsel(mk, st[j + n], st[j]), o);
                }
                float tot = st[0] + __shfl_xor(st[0], 2); tot += __shfl_xor(tot, 1);
                if ((lane & 3) == 0) red[wave * 32 + which * 16 + (lane >> 2)] = tot;
            }
            __syncthreads();
            if (tid < 32) { float t = 0.f;
#pragma unroll
                for (int q = 0; q < 8; ++q) t += red[q * 32 + tid];
                red[256 + tid] = t; }
            __syncthreads();
            const float lg0 = __uint_as_float(bload4(rlg, tid * 8, 0)), lg1 = __uint_as_float(bload4(rlg, tid * 8 + 4, 0)), lb0 = __uint_as_float(bload4(rlb, tid * 8, 0)), lb1 = __uint_as_float(bload4(rlb, tid * 8 + 4, 0));
#pragma unroll
            for (int i = 0; i < 16; ++i) {
                const float s1 = red[256 + i], s2 = red[256 + 16 + i];
                const float mu = s1 * (1.0f / CWD), var = fmaxf(s2 * (1.0f / CWD) - mu * mu, 0.f), rs = rsqrtf(var + 1e-5f);
                const float y0 = (c0[i] - mu) * rs * lg0 + lb0, y1 = (c1[i] - mu) * rs * lg1 + lb1;
                bstore4(rpo, cvt_pk_bf16(y0 * sigmoidf_fast(y0), y1 * sigmoidf_fast(y1)), tid * 4, (tile * 32 + hf * 16 + i) * 4096 + 2048);
            }
            __syncthreads();
        }
    }
}

typedef float f32x16 __attribute__((ext_vector_type(16)));
__device__ __forceinline__ int okey(float s) { const int u = __float_as_int(s); return u ^ ((u >> 31) & 0x7fffffff); }
__device__ __forceinline__ float okey_inv(int k) { return __int_as_float(k ^ ((k >> 31) & 0x7fffffff)); }
__device__ __forceinline__ void sort16_desc(int (&v)[16]) {
#pragma unroll
    for (int k = 2; k <= 16; k <<= 1) {
#pragma unroll
        for (int j = k >> 1; j > 0; j >>= 1) {
#pragma unroll
            for (int i = 0; i < 16; ++i) {
                const int l = i ^ j;
                if (l > i) { const bool desc = (i & k) == 0; const int hi = max(v[i], v[l]), lo = min(v[i], v[l]); v[i] = desc ? hi : lo; v[l] = desc ? lo : hi; }
            }
        }
    }
}
__device__ __forceinline__ void merge16_desc(int (&a)[16], const int (&b)[16]) {
#pragma unroll
    for (int i = 0; i < 16; ++i) a[i] = max(a[i], b[15 - i]);
#pragma unroll
    for (int j = 8; j > 0; j >>= 1) {
#pragma unroll
        for (int i = 0; i < 16; ++i) { const int l = i ^ j; if (l > i) { const int hi = max(a[i], a[l]), lo = min(a[i], a[l]); a[i] = hi; a[l] = lo; } }
    }
}
__device__ __forceinline__ void pair_merge(int (&a)[16]) {
    int b[16];
#pragma unroll
    for (int i = 0; i < 16; ++i) b[i] = __shfl_xor(a[i], 32);
    merge16_desc(a, b);
}
constexpr int CELL_I[64] = {0,0,0,0,0,0,0,0,0,0,0,0,0,0,0,0,1,1,1,1,1,1,1,1,2,2,2,2,2,3,3,3,3,4,4,4,5,5,6,6,7,7,8,9,10,11,12,13,14,15,0,0,0,0,0,0,0,0,0,0,0,0,0,0};
constexpr int CELL_J[64] = {0,1,2,3,4,5,6,7,8,9,10,11,12,13,14,15,0,1,2,3,4,5,6,7,0,1,2,3,4,0,1,2,3,0,1,2,0,1,0,1,0,1,0,0,0,0,0,0,0,0,0,0,0,0,0,0,0,0,0,0,0,0,0,0};
constexpr int NCELL = 50;

struct EpiQTopk {
    static constexpr bool AFTER_DRAIN = true;
    const float* ssq; float* rstd; const bf16_t* keysb; unsigned short* idx; float* gsu;
    __device__ __forceinline__ void fused(const f32x4 (&acc)[2][2][4][2], const pg8::Unit& u, int wr, int wc, int fr, int fq, LAS unsigned char* lds, int wid, int lane) const {
        const int hh = lane >> 5, l31 = lane & 31, h = u.pn;
        LAS float* svt = (LAS float*)(lds + 65536 + (wid * 64 + lane) * 164);
        LAS unsigned char* sit = (LAS unsigned char*)(svt + 32);
        float rs[2][4];
#pragma unroll
        for (int ai = 0; ai < 2; ++ai)
#pragma unroll
            for (int m = 0; m < 4; ++m) {
                const size_t row = (size_t)(u.pm * 256 + ai * 128 + wr * 64 + m * 16 + fr);
                const f32x4* sp = (const f32x4*)(ssq + row * 32); f32x4 t = sp[0];
#pragma unroll
                for (int i = 1; i < 8; ++i) t += sp[i];
                rs[ai][m] = rsqrtf(((t[0] + t[1]) + (t[2] + t[3])) * (1.0f / D) + 1e-6f);
                if (u.pn == 0 && wc == 0 && fq == 0) rstd[row] = rs[ai][m];
            }
        const int trow = wid * 32 + l31;
#pragma unroll
        for (int ph = 0; ph < 2; ++ph) {
#pragma unroll
            for (int ai = 0; ai < 2; ++ai)
#pragma unroll
                for (int m = 0; m < 4; ++m) { const int row = ai * 128 + wr * 64 + m * 16 + fr;
#pragma unroll
                    for (int n = 0; n < 2; ++n) { const f32x4 v = acc[ai][ph][m][n] * rs[ai][m]; const int chunk = 4 * wc + 2 * n + (fq >> 1);
                        u32x2 w; w.x = cvt_pk_bf16(v[0], v[1]); w.y = cvt_pk_bf16(v[2], v[3]);
                        *(LAS u32x2*)(lds + row * 256 + ((chunk ^ (row & 15)) << 4) + (fq & 1) * 8) = w; } }
            __syncthreads();
            const bf16_t* krow = keysb + ((size_t)(h * 2 + ph) * 128 + l31) * 128 + 8 * hh;
            bf16x8 bq[8];
#pragma unroll
            for (int ks = 0; ks < 8; ++ks) bq[ks] = *(const LAS bf16x8*)(lds + trow * 256 + (((ks * 2 + hh) ^ (trow & 15)) << 4));
            int top[16];
#pragma unroll
            for (int i = 0; i < 16; ++i) top[i] = (int)0x80000000;
            bf16x8 ak[8];
#pragma unroll
            for (int ks = 0; ks < 8; ++ks) ak[ks] = *(const bf16x8*)(krow + ks * 16);
#pragma unroll 1
            for (int kt = 0; kt < 4; ++kt) {
                f32x16 c = {0.f, 0.f, 0.f, 0.f, 0.f, 0.f, 0.f, 0.f, 0.f, 0.f, 0.f, 0.f, 0.f, 0.f, 0.f, 0.f};
#pragma unroll
                for (int ks = 0; ks < 8; ++ks) c = __builtin_amdgcn_mfma_f32_32x32x16_bf16(ak[ks], bq[ks], c, 0, 0, 0);
                { const int kn = kt < 3 ? kt + 1 : 3;
#pragma unroll
                  for (int ks = 0; ks < 8; ++ks) ak[ks] = *(const bf16x8*)(krow + (size_t)kn * 32 * 128 + ks * 16); }
                int v[16];
                const int lowb = (127 - kt * 32) ^ (hh << 2);
#pragma unroll
                for (int r = 0; r < 16; ++r) v[r] = (okey(c[r]) & ~127) | (lowb - ((r & 3) + 8 * (r >> 2)));
                sort16_desc(v);
                merge16_desc(top, v);
            }
            pair_merge(top);
#pragma unroll
            for (int i = 0; i < 16; ++i) { svt[ph * 16 + i] = okey_inv(top[i] & ~127); sit[ph * 16 + i] = (unsigned char)(127 - (top[i] & 127)); }
            __syncthreads();
        }
        float sv[2][16];
#pragma unroll
        for (int i = 0; i < 16; ++i) { sv[0][i] = svt[i]; sv[1][i] = svt[16 + i]; }
        int w0[16], w1[16];
#pragma unroll
        for (int s = 0; s < 32; ++s) {
            const int e0 = 2 * s, e1 = 2 * s + 1;
            int key;
            if (e0 >= NCELL) key = (int)0x80000000;
            else {
                const float v0 = sv[0][CELL_I[e0]] + sv[1][CELL_J[e0]];
                const int k0 = (okey(v0) & ~255) | (255 - (CELL_I[e0] * 16 + CELL_J[e0]));
                if (e1 >= NCELL) key = hh ? (int)0x80000000 : k0;
                else { const float v1 = sv[0][CELL_I[e1]] + sv[1][CELL_J[e1]];
                    const int k1 = (okey(v1) & ~255) | (255 - (CELL_I[e1] * 16 + CELL_J[e1]));
                    key = hh ? k1 : k0; }
            }
            if (s < 16) w0[s] = key; else w1[s - 16] = key;
        }
        sort16_desc(w0); sort16_desc(w1); merge16_desc(w0, w1); pair_merge(w0);
        const float mx = okey_inv(w0[0] & ~255);
        float sum = 0.f;
#pragma unroll
        for (int k = 0; k < 16; ++k) sum += __expf(okey_inv(w0[k] & ~255) - mx);
        const float inv = 1.0f / sum;
        int eo[8]; float go[8]; const int hmask = -hh;
#pragma unroll
        for (int k = 0; k < 8; ++k) { const int kk = (w0[k] & ~hmask) | (w0[8 + k] & hmask); const int cc = 255 - (kk & 255);
            eo[k] = (int)sit[cc >> 4] * 128 + (int)sit[16 + (cc & 15)]; go[k] = __expf(okey_inv(kk & ~255) - mx) * inv; }
        const size_t ob = (size_t)(u.pm * 256 + trow) * 128 + h * 16 + hh * 8;
        *(u32x4*)(idx + ob) = (u32x4){(unsigned)eo[0] | ((unsigned)eo[1] << 16), (unsigned)eo[2] | ((unsigned)eo[3] << 16), (unsigned)eo[4] | ((unsigned)eo[5] << 16), (unsigned)eo[6] | ((unsigned)eo[7] << 16)};
        *(f32x4*)(gsu + ob) = (f32x4){go[0], go[1], go[2], go[3]};
        *(f32x4*)(gsu + ob + 4) = (f32x4){go[4], go[5], go[6], go[7]};
    }
    __device__ __forceinline__ void operator()(const f32x4 (&)[2][2][4][2], const pg8::Unit&, int, int, int, int) const {}
};

typedef float f32x2 __attribute__((ext_vector_type(2)));
template <int N> __device__ __forceinline__ f32x2 dot16_fp8(const u32x4 w, const f32x2 (&x)[N], int o, f32x2 acc) {
    const unsigned ww[4] = {w.x, w.y, w.z, w.w};
#pragma unroll
    for (int d = 0; d < 4; ++d) { acc += __builtin_amdgcn_cvt_pk_f32_fp8((int)ww[d], false) * x[o + 2 * d]; acc += __builtin_amdgcn_cvt_pk_f32_fp8((int)ww[d], true) * x[o + 2 * d + 1]; }
    return acc;
}
template <int N> __device__ __forceinline__ void axpy16_fp8(const u32x4 w, float a, f32x2 (&y)[N], int o) {
    const unsigned ww[4] = {w.x, w.y, w.z, w.w}; const f32x2 a2 = {a, a};
#pragma unroll
    for (int d = 0; d < 4; ++d) { y[o + 2 * d] += a2 * __builtin_amdgcn_cvt_pk_f32_fp8((int)ww[d], false); y[o + 2 * d + 1] += a2 * __builtin_amdgcn_cvt_pk_f32_fp8((int)ww[d], true); }
}
__device__ __forceinline__ void bstore16(__amdgpu_buffer_rsrc_t r, f32x4 v, int voff, int soff) { __builtin_amdgcn_raw_buffer_store_b128(__builtin_bit_cast(__attribute__((__vector_size__(4 * sizeof(unsigned)))) unsigned, v), r, voff, soff, 0); }
__device__ __forceinline__ void bstore8(__amdgpu_buffer_rsrc_t r, f32x2 v, int voff, int soff) { __builtin_amdgcn_raw_buffer_store_b64(__builtin_bit_cast(__attribute__((__vector_size__(2 * sizeof(unsigned)))) unsigned, v), r, voff, soff, 0); }
__device__ __forceinline__ f32x2 fsel2(int mask, f32x2 a, f32x2 b) { return (f32x2){fsel(mask, a.x, b.x), fsel(mask, a.y, b.y)}; }
__device__ __forceinline__ f32x2 shx2(f32x2 a, int o) { return (f32x2){__shfl_xor(a.x, o), __shfl_xor(a.y, o)}; }

__device__ __forceinline__ void phase_pd(const Params& p, int bid, int nb) {
    const int tid = threadIdx.x, lane = tid & 63, wave = __builtin_amdgcn_readfirstlane(tid >> 6);
    const int v = bid & 7, lw = (bid >> 3) * 8 + wave, NLW = (nb >> 3) * 8;
    const int c = lane & 7, sub = lane >> 3;
    const int m0 = -(lane & 1), m1 = -((lane >> 1) & 1), m2 = -((lane >> 2) & 1);
    const __amdgpu_buffer_rsrc_t rd = __builtin_amdgcn_make_buffer_rsrc((void*)p.down8, 0, 16384 * D, 0x00020000);
    const __amdgpu_buffer_rsrc_t rh = __builtin_amdgcn_make_buffer_rsrc((void*)p.h2b, 0, SEQ * D * 2, 0x00020000);
    const __amdgpu_buffer_rsrc_t rg1 = __builtin_amdgcn_make_buffer_rsrc((void*)p.ffn_g, 0, D * 4, 0x00020000);
    const __amdgpu_buffer_rsrc_t ri = __builtin_amdgcn_make_buffer_rsrc((void*)p.idx, 0, SEQ * 128 * 2, 0x00020000);
    const __amdgpu_buffer_rsrc_t rrs = __builtin_amdgcn_make_buffer_rsrc((void*)p.rstd, 0, SEQ * 4, 0x00020000);
    const __amdgpu_buffer_rsrc_t rp = __builtin_amdgcn_make_buffer_rsrc((void*)p.part, 0, SEQ * 16 * 128 * 2, 0x00020000);
    const int vsub = sub * 32, vc2 = c * 32, vc1 = c * 16, vl4 = lane * 4;
#pragma unroll 1
    for (int pass = 0; pass < 2; ++pass) {
        const int sl = v * 2 + pass;
        f32x2 gs[8];
#pragma unroll
        for (int i = 0; i < 4; ++i) { const f32x4 g = __builtin_bit_cast(f32x4, bload16(rg1, c * 64, sl * 512 + i * 16)); gs[2 * i] = (f32x2){g[0], g[1]}; gs[2 * i + 1] = (f32x2){g[2], g[3]}; }
        u32x4 ix[2], hh[2]; unsigned rsb;
        {
            const int t = lw;
#pragma unroll
            for (int i = 0; i < 2; ++i) ix[i] = bload16(ri, vsub, t * 256 + i * 16);
            hh[0] = bload16(rh, vc2, t * 4096 + sl * 256); hh[1] = bload16(rh, vc2, t * 4096 + sl * 256 + 16); rsb = bload4(rrs, 0, t * 4);
        }
#pragma unroll 1
        for (int t = lw; t < SEQ; t += NLW) {
            asm volatile("" ::: "memory");
            u32x4 w[16];
            {
                const unsigned ew[8] = {ix[0].x, ix[0].y, ix[0].z, ix[0].w, ix[1].x, ix[1].y, ix[1].z, ix[1].w};
#pragma unroll
                for (int g = 0; g < 16; ++g) { const unsigned e = (g & 1) ? (ew[g >> 1] >> 16) : (ew[g >> 1] & 0xffffu); w[g] = bload16(rd, (int)(e * 2048u) + vc1, sl * 128); }
            }
            f32x2 xs[8];
            {
                const float rs = __uint_as_float(rsb);
                const unsigned hw[8] = {hh[0].x, hh[0].y, hh[0].z, hh[0].w, hh[1].x, hh[1].y, hh[1].z, hh[1].w};
#pragma unroll
                for (int i = 0; i < 8; ++i) xs[i] = (f32x2){bf_lo(hw[i]) * rs, bf_hi(hw[i]) * rs} * gs[i];
            }
            asm volatile("" ::: "memory");
            {
                const int tn = t + NLW < SEQ ? t + NLW : t;
#pragma unroll
                for (int i = 0; i < 2; ++i) ix[i] = bload16(ri, vsub, tn * 256 + i * 16);
                hh[0] = bload16(rh, vc2, tn * 4096 + sl * 256); hh[1] = bload16(rh, vc2, tn * 4096 + sl * 256 + 16); rsb = bload4(rrs, 0, tn * 4);
            }
            asm volatile("" ::: "memory");
            float r[16];
#pragma unroll
            for (int g = 0; g < 16; ++g) { const f32x2 z = {0.f, 0.f}; const f32x2 s2 = dot16_fp8(w[g], xs, 0, z); r[g] = s2.x + s2.y; }
            float k8[8], k4[4];
#pragma unroll
            for (int i = 0; i < 8; ++i) k8[i] = fsel(m2, r[i], r[i + 8]) + __shfl_xor(fsel(m2, r[i + 8], r[i]), 4);
#pragma unroll
            for (int i = 0; i < 4; ++i) k4[i] = fsel(m1, k8[i], k8[i + 4]) + __shfl_xor(fsel(m1, k8[i + 4], k8[i]), 2);
            const float k0 = fsel(m0, k4[0], k4[2]) + __shfl_xor(fsel(m0, k4[2], k4[0]), 1);
            const float k1 = fsel(m0, k4[1], k4[3]) + __shfl_xor(fsel(m0, k4[3], k4[1]), 1);
            bstore4(rp, cvt_pk_bf16(k0, k1), vl4, (t * 16 + sl) * 256);
        }
    }
}
__device__ __forceinline__ void phase_pa(const Params& p, int bid, int nb) {
    const int tid = threadIdx.x, lane = tid & 63, wave = tid >> 6;
    const int gw = bid * 8 + wave, NGW = nb * 8;
    for (int it = gw; it < SEQ * 2; it += NGW) {
        const int t = it >> 1, pp = (it & 1) * 64 + lane;
        const bf16_t* pr = p.part + (size_t)t * 2048 + pp;
        float hs = 0.f;
#pragma unroll
        for (int sl = 0; sl < 16; ++sl) hs += __uint_as_float((unsigned)pr[sl * 128] << 16);
        const int e = (int)p.idx[(size_t)t * 128 + pp];
        hs *= p.sdn[e];
        const float av = p.gsu[(size_t)t * 128 + pp] * p.sup[e] * 0.5f * hs * (1.0f + erff(hs * 0.70710678118654752f));
        p.act[(size_t)t * 128 + pp] = (bf16_t)(cvt_pk_bf16(av, 0.f) & 0xffffu);
    }
}
__device__ __forceinline__ void phase_pu(const Params& p, int bid, int nb) {
    const int tid = threadIdx.x, lane = tid & 63, wave = __builtin_amdgcn_readfirstlane(tid >> 6);
    const int v = bid & 7, lw = (bid >> 3) * 8 + wave, NLW = (nb >> 3) * 8;
    const int c = lane & 7, sub = lane >> 3;
    const int m3 = -((lane >> 3) & 1), m4 = -((lane >> 4) & 1), m5 = -((lane >> 5) & 1);
    const __amdgpu_buffer_rsrc_t ru = __builtin_amdgcn_make_buffer_rsrc((void*)p.up8, 0, 16384 * D, 0x00020000);
    const __amdgpu_buffer_rsrc_t rh = __builtin_amdgcn_make_buffer_rsrc((void*)p.h2b, 0, SEQ * D * 2, 0x00020000);
    const __amdgpu_buffer_rsrc_t ri = __builtin_amdgcn_make_buffer_rsrc((void*)p.idx, 0, SEQ * 128 * 2, 0x00020000);
    const __amdgpu_buffer_rsrc_t ra = __builtin_amdgcn_make_buffer_rsrc((void*)p.act, 0, SEQ * 128 * 2, 0x00020000);
    const __amdgpu_buffer_rsrc_t ro = __builtin_amdgcn_make_buffer_rsrc((void*)p.h3b, 0, SEQ * D * 2, 0x00020000);
    const __amdgpu_buffer_rsrc_t rq = __builtin_amdgcn_make_buffer_rsrc((void*)p.ssq2, 0, SEQ * 16 * 4, 0x00020000);
    const int vsub = sub * 32, vc1 = c * 16, vh = c * 32 + sub * 4;
#pragma unroll 1
    for (int pass = 0; pass < 2; ++pass) {
        const int sl = v * 2 + pass;
        u32x4 ix[2], ac[2]; unsigned hb;
        {
            const int t = lw;
#pragma unroll
            for (int i = 0; i < 2; ++i) { ix[i] = bload16(ri, vsub, t * 256 + i * 16); ac[i] = bload16(ra, vsub, t * 256 + i * 16); }
            hb = bload4(rh, vh, t * 4096 + sl * 256);
        }
#pragma unroll 1
        for (int t = lw; t < SEQ; t += NLW) {
            asm volatile("" ::: "memory");
            u32x4 w[16];
            {
                const unsigned ew[8] = {ix[0].x, ix[0].y, ix[0].z, ix[0].w, ix[1].x, ix[1].y, ix[1].z, ix[1].w};
#pragma unroll
                for (int g = 0; g < 16; ++g) { const unsigned e = (g & 1) ? (ew[g >> 1] >> 16) : (ew[g >> 1] & 0xffffu); w[g] = bload16(ru, (int)(e * 2048u) + vc1, sl * 128); }
            }
            const unsigned aw[8] = {ac[0].x, ac[0].y, ac[0].z, ac[0].w, ac[1].x, ac[1].y, ac[1].z, ac[1].w};
            float a[16];
#pragma unroll
            for (int g = 0; g < 16; ++g) a[g] = (g & 1) ? bf_hi(aw[g >> 1]) : bf_lo(aw[g >> 1]);
            const unsigned hcur = hb;
            asm volatile("" ::: "memory");
            {
                const int tn = t + NLW < SEQ ? t + NLW : t;
#pragma unroll
                for (int i = 0; i < 2; ++i) { ix[i] = bload16(ri, vsub, tn * 256 + i * 16); ac[i] = bload16(ra, vsub, tn * 256 + i * 16); }
                hb = bload4(rh, vh, tn * 4096 + sl * 256);
            }
            asm volatile("" ::: "memory");
            f32x2 acc[8];
#pragma unroll
            for (int i = 0; i < 8; ++i) acc[i] = (f32x2){0.f, 0.f};
#pragma unroll
            for (int g = 0; g < 16; ++g) axpy16_fp8(w[g], a[g], acc, 0);
            f32x2 k4[4], k2[2];
#pragma unroll
            for (int i = 0; i < 4; ++i) k4[i] = fsel2(m5, acc[i], acc[i + 4]) + shx2(fsel2(m5, acc[i + 4], acc[i]), 32);
#pragma unroll
            for (int i = 0; i < 2; ++i) k2[i] = fsel2(m4, k4[i], k4[i + 2]) + shx2(fsel2(m4, k4[i + 2], k4[i]), 16);
            f32x2 h3 = fsel2(m3, k2[0], k2[1]) + shx2(fsel2(m3, k2[1], k2[0]), 8);
            h3 += (f32x2){bf_lo(hcur), bf_hi(hcur)};
            bstore4(ro, cvt_pk_bf16(h3.x, h3.y), vh, t * 4096 + sl * 256);
            const float ss = wave_sum(h3.x * h3.x + h3.y * h3.y);
            if (lane == 0) bstore4(rq, __float_as_uint(ss), 0, (t * 16 + sl) * 4);
        }
    }
}
__device__ __forceinline__ void phase_pf(const Params& p, int bid, int nb) {
    const int tid = threadIdx.x, lane = tid & 63, wave = tid >> 6;
    const int gw = bid * 8 + wave, NGW = nb * 8;
    for (int t = gw; t < SEQ; t += NGW) {
        const f32x4* sp = (const f32x4*)(p.ssq2 + (size_t)t * 16); f32x4 q = sp[0] + sp[1] + sp[2] + sp[3];
        const float rf = rsqrtf(((q[0] + q[1]) + (q[2] + q[3])) * (1.0f / D) + 1e-6f);
        const u32x4* hp = (const u32x4*)(p.h3b + (size_t)t * D) + lane;
        f32x4* o = (f32x4*)(p.out + (size_t)t * D) + 2 * lane; const f32x4* g = (const f32x4*)p.fin_g + 2 * lane;
#pragma unroll
        for (int j = 0; j < 4; ++j) { const u32x4 h = hp[64 * j]; const f32x4 g0 = g[128 * j], g1 = g[128 * j + 1];
            o[128 * j] = (f32x4){bf_lo(h.x) * rf * g0[0], bf_hi(h.x) * rf * g0[1], bf_lo(h.y) * rf * g0[2], bf_hi(h.y) * rf * g0[3]};
            o[128 * j + 1] = (f32x4){bf_lo(h.z) * rf * g1[0], bf_hi(h.z) * rf * g1[1], bf_lo(h.w) * rf * g1[2], bf_hi(h.w) * rf * g1[3]}; }
    }
}

__device__ __forceinline__ void fp8_row(const float* src, unsigned char* dst, float* inv_scale, int lane) {
    f32x4 v[2][4]; float am = 0.f;
#pragma unroll
    for (int k = 0; k < 2; ++k)
#pragma unroll
        for (int i = 0; i < 4; ++i) { v[k][i] = *(const f32x4*)(src + 1024 * k + 16 * lane + 4 * i);
            am = fmaxf(am, fmaxf(fmaxf(fabsf(v[k][i].x), fabsf(v[k][i].y)), fmaxf(fabsf(v[k][i].z), fabsf(v[k][i].w)))); }
#pragma unroll
    for (int o = 1; o < 64; o <<= 1) am = fmaxf(am, __shfl_xor(am, o));
    int be = (__float_as_int(am) >> 23) & 255; be = be < 8 ? 8 : (be > 248 ? 248 : be);
    const float sc = __int_as_float((260 - be) << 23), isc = __int_as_float((be - 6) << 23);
#pragma unroll
    for (int k = 0; k < 2; ++k) { u32x4 w; unsigned ww[4];
#pragma unroll
        for (int i = 0; i < 4; ++i) { int t = 0; t = __builtin_amdgcn_cvt_pk_fp8_f32(v[k][i].x * sc, v[k][i].y * sc, t, false); t = __builtin_amdgcn_cvt_pk_fp8_f32(v[k][i].z * sc, v[k][i].w * sc, t, true); ww[i] = (unsigned)t; }
        w.x = ww[0]; w.y = ww[1]; w.z = ww[2]; w.w = ww[3];
        *(u32x4*)(dst + 1024 * k + 16 * lane) = w; }
    if (lane == 0) *inv_scale = isc;
}

__device__ __forceinline__ void fp8_row2(const float* s0, unsigned char* d0, float* i0, const float* s1, unsigned char* d1, float* i1, int lane) {
    f32x4 v[2][2][4]; float am[2] = {0.f, 0.f};
#pragma unroll
    for (int r = 0; r < 2; ++r)
#pragma unroll
        for (int k = 0; k < 2; ++k)
#pragma unroll
            for (int i = 0; i < 4; ++i) v[r][k][i] = __builtin_nontemporal_load((const f32x4*)((r ? s1 : s0) + 1024 * k + 16 * lane + 4 * i));
#pragma unroll
    for (int r = 0; r < 2; ++r) {
#pragma unroll
        for (int k = 0; k < 2; ++k)
#pragma unroll
            for (int i = 0; i < 4; ++i) am[r] = fmaxf(am[r], fmaxf(fmaxf(fabsf(v[r][k][i].x), fabsf(v[r][k][i].y)), fmaxf(fabsf(v[r][k][i].z), fabsf(v[r][k][i].w))));
#pragma unroll
        for (int o = 1; o < 64; o <<= 1) am[r] = fmaxf(am[r], __shfl_xor(am[r], o));
        int be = (__float_as_int(am[r]) >> 23) & 255; be = be < 8 ? 8 : (be > 248 ? 248 : be);
        const float sc = __int_as_float((260 - be) << 23), isc = __int_as_float((be - 6) << 23);
#pragma unroll
        for (int k = 0; k < 2; ++k) { u32x4 w; unsigned ww[4];
#pragma unroll
            for (int i = 0; i < 4; ++i) { int t = 0; t = __builtin_amdgcn_cvt_pk_fp8_f32(v[r][k][i].x * sc, v[r][k][i].y * sc, t, false); t = __builtin_amdgcn_cvt_pk_fp8_f32(v[r][k][i].z * sc, v[r][k][i].w * sc, t, true); ww[i] = (unsigned)t; }
            w.x = ww[0]; w.y = ww[1]; w.z = ww[2]; w.w = ww[3];
            *(u32x4*)((r ? d1 : d0) + 1024 * k + 16 * lane) = w; }
        if (lane == 0) *(r ? i1 : i0) = isc;
    }
}

__device__ __forceinline__ void tr_item(const float* W, int ldw, int srccol0, int k0, bf16_t* WT, int ldt, int n0, const float* kscale, const float* nscale, LAS float* scr, int lane) {
    float tv[32];
#pragma unroll
    for (int i = 0; i < 32; ++i) { const int kk = 2 * i + (lane >> 5); tv[i] = W[(size_t)(k0 + kk) * ldw + srccol0 + (lane & 31)]; }
    const float ns = nscale ? nscale[srccol0 + (lane & 31)] : 1.0f;
#pragma unroll
    for (int i = 0; i < 32; ++i) { const int kk = 2 * i + (lane >> 5); float v = tv[i] * ns;
        if (kscale) v *= kscale[k0 + kk]; scr[kk * 33 + (lane & 31)] = v; }
    asm volatile("s_waitcnt lgkmcnt(0)" ::: "memory");
    const int c = lane & 7;
#pragma unroll
    for (int j = 0; j < 4; ++j) { const int n = (lane >> 3) + 8 * j; const LAS float* s = scr + (8 * c) * 33 + n;
        u32x4 o; o.x = cvt_pk_bf16(s[0 * 33], s[1 * 33]); o.y = cvt_pk_bf16(s[2 * 33], s[3 * 33]); o.z = cvt_pk_bf16(s[4 * 33], s[5 * 33]); o.w = cvt_pk_bf16(s[6 * 33], s[7 * 33]);
        *(u32x4*)(WT + (size_t)(n0 + n) * ldt + k0 + 8 * c) = o; }
    asm volatile("s_waitcnt lgkmcnt(0)" ::: "memory");
}
__device__ __forceinline__ int win_srccol(int n) { const int pn = n >> 8, w = n & 255; return pn < 4 ? n : ((w >> 7) ? 2048 : 1024) + (pn - 4) * 128 + (w & 127); }

__device__ __forceinline__ void phase_prep(const Params& p, LAS unsigned char* lds, int bid, int nb) {
    const int tid = threadIdx.x, lane = tid & 63, wave = tid >> 6;
    const int gw = bid * 8 + wave, NGW = nb * 8;
    LAS float* scr = (LAS float*)(lds + wave * 8448);
    for (int r = gw; r < RT; r += NGW) {
        unsigned long long* o8 = (unsigned long long*)(p.hnb + (size_t)r * D) + lane;
        if (r < RPAD) {
#pragma unroll
            for (int j = 0; j < 8; ++j) o8[64 * j] = 0ull;
        } else {
            const f32x4* xr = (const f32x4*)hrow(p, r - RPAD) + lane;
            const f32x4* gr = (const f32x4*)p.mix_g + lane;
            f32x4 v[8]; float s = 0.f;
#pragma unroll
            for (int j = 0; j < 8; ++j) { v[j] = __builtin_nontemporal_load(xr + 64 * j); s += (v[j].x * v[j].x + v[j].y * v[j].y) + (v[j].z * v[j].z + v[j].w * v[j].w); }
            const float rs = rsqrtf(wave_sum(s) * (1.0f / D) + 1e-6f);
#pragma unroll
            for (int j = 0; j < 8; ++j) { const f32x4 gv = gr[64 * j];
                o8[64 * j] = (unsigned long long)cvt_pk_bf16(v[j].x * rs * gv.x, v[j].y * rs * gv.y) | ((unsigned long long)cvt_pk_bf16(v[j].z * rs * gv.z, v[j].w * rs * gv.w) << 32); }
        }
    }
    for (int it = gw; it < (D / 64) * (INW / 32); it += NGW) {
        const int kb = it / (INW / 32), nbk = it % (INW / 32);
        tr_item(p.w_in, INW, win_srccol(nbk * 32), kb * 64, p.w_in_t, D, nbk * 32, nullptr, nullptr, scr, lane);
    }
    for (int i = gw * 64 + lane; i < 4 * 256 * 256 / 4; i += NGW * 64) { const f32x4 v = ((const f32x4*)p.pool_w)[i];
        const int g = i >> 14, d = (i & 63) * 4; const f32x4 sc = *(const f32x4*)(p.pool_scale + g * 256 + d);
        u32x2 w; w.x = cvt_pk_bf16(v[0] * sc[0], v[1] * sc[1]); w.y = cvt_pk_bf16(v[2] * sc[2], v[3] * sc[3]); ((u32x2*)p.pool_ws)[i] = w; }
    for (int i = gw * 64 + lane; i < CWD * CWD / 4; i += NGW * 64) { const f32x4 v = ((const f32x4*)p.pw_w)[i];
        u32x2 w; w.x = cvt_pk_bf16(v[0], v[1]); w.y = cvt_pk_bf16(v[2], v[3]); ((u32x2*)p.pw_b16)[i] = w; }
    if (gw < D / 64) { const int n = gw * 64 + lane; float a0 = 0.f, a1 = 0.f, a2 = 0.f, a3 = 0.f;
        for (int j = 0; j < CWD; j += 4) { a0 += p.pw_b[j] * p.w_out[(size_t)(PWD + j) * D + n]; a1 += p.pw_b[j + 1] * p.w_out[(size_t)(PWD + j + 1) * D + n];
            a2 += p.pw_b[j + 2] * p.w_out[(size_t)(PWD + j + 2) * D + n]; a3 += p.pw_b[j + 3] * p.w_out[(size_t)(PWD + j + 3) * D + n]; }
        p.bias_eff[n] = (a0 + a1) + (a2 + a3); }
    for (int it = gw; it < 32 * 64; it += NGW) { const int kb = it >> 6, nbk = it & 63;
        tr_item(p.w_out, D, nbk * 32, kb * 64, p.w_out_t, D, nbk * 32, nullptr, nullptr, scr, lane); }
    for (int it = gw; it < 32 * 64; it += NGW) { const int kb = it >> 6, nbk = it & 63;
        tr_item(p.wq, D, nbk * 32, kb * 64, p.wq_t, D, nbk * 32, p.ffn_g, nullptr, scr, lane); }
    for (int i = gw * 64 + lane; i < 8 * 2 * 128 * 128 / 4; i += NGW * 64) { const f32x4 v = ((const f32x4*)p.keys)[i];
        u32x2 w; w.x = cvt_pk_bf16(v[0], v[1]); w.y = cvt_pk_bf16(v[2], v[3]); ((u32x2*)p.keysb)[i] = w; }
    for (int e = gw; e < 16384; e += NGW)
        fp8_row2(p.down + (size_t)e * D, p.down8 + (size_t)e * D, p.sdn + e, p.up + (size_t)e * D, p.up8 + (size_t)e * D, p.sup + e, lane);
}


#define XB_TMO      128
#define XB_XCNT(j)  (256  + 64 * (j))
#define XB_XSUB(j)  (1280 + 64 * (j))
#define XB_XGEN(j)  (2304 + 64 * (j))
#define XB_TOP      3328
#define XB_TOPGEN   3392
#define XCD_BAR_WORDS 3456
#define XB_SPIN_CAP (1u << 18)
__device__ __forceinline__ unsigned xb_ld(unsigned* p)              { return __hip_atomic_load(p, __ATOMIC_RELAXED, __HIP_MEMORY_SCOPE_AGENT); }
__device__ __forceinline__ unsigned xb_add(unsigned* p, unsigned v) { return __hip_atomic_fetch_add(p, v, __ATOMIC_RELAXED, __HIP_MEMORY_SCOPE_AGENT); }
__device__ __forceinline__ unsigned xb_xcc_id() { return (unsigned)__builtin_amdgcn_s_getreg((3 << 11) | 20) & 0xFu; }
#define XB_SPIN(cond, bar) do { unsigned _sp = 0; while (cond) { __builtin_amdgcn_s_sleep(1); \
    if ((++_sp & 255u) == 0u) { if (xb_ld(&(bar)[XB_TMO])) break; if (_sp > XB_SPIN_CAP) { atomicAdd(&(bar)[XB_TMO], 1u); break; } } } } while (0)
struct XcdBarrier { unsigned* bar; unsigned x; volatile LAS unsigned* st; };
__device__ __forceinline__ XcdBarrier xcd_barrier_post(unsigned* bar, volatile LAS unsigned* st) {
    XcdBarrier b; b.bar = bar; b.x = xb_xcc_id(); b.st = st;
    if (threadIdx.x == 0) (void)xb_add(&bar[XB_XCNT(b.x)], 1u);
    return b;
}
__device__ __forceinline__ void xcd_barrier_complete(unsigned* bar, unsigned x, unsigned& nloc, unsigned& nx) {
    const unsigned G = gridDim.x * gridDim.y * gridDim.z;
    unsigned sum, cnt, mine, sp = 0u;
    for (;;) {
        sum = 0u; cnt = 0u; mine = 0u;
#pragma unroll
        for (unsigned j = 0; j < 16; ++j) { const unsigned c = xb_ld(&bar[XB_XCNT(j)]); sum += c; cnt += (c > 0u) ? 1u : 0u; mine = (j == x) ? c : mine; }
        if (sum == G) break;
        __builtin_amdgcn_s_sleep(1);
        if ((++sp & 255u) == 0u) { if (xb_ld(&bar[XB_TMO])) break; if (sp > XB_SPIN_CAP) { atomicAdd(&bar[XB_TMO], 1u); break; } }
    }
    nloc = mine > 0u ? mine : 1u; nx = cnt > 0u ? cnt : 1u;
}
__device__ __forceinline__ void xcd_barrier(const XcdBarrier& b) {
    asm volatile("s_waitcnt vmcnt(0)" ::: "memory");
    __syncthreads();
    if (threadIdx.x == 0) {
        unsigned* bar = b.bar;
        __builtin_amdgcn_s_waitcnt(0);
        unsigned nloc = b.st[0], nx = b.st[1];
        if (nloc == 0u) { xcd_barrier_complete(bar, b.x, nloc, nx); b.st[0] = nloc; b.st[1] = nx; }
        const unsigned old = xb_add(&bar[XB_XSUB(b.x)], 1u);
        const unsigned gen = old / nloc;
        if (old + 1u == (gen + 1u) * nloc) {
            __builtin_amdgcn_fence(__ATOMIC_RELEASE, "agent");
            asm volatile("s_waitcnt vmcnt(0)" ::: "memory");
            const unsigned og = xb_add(&bar[XB_TOP], 1u);
            const unsigned tg = og / nx;
            if (og + 1u == (tg + 1u) * nx) xb_add(&bar[XB_TOPGEN], 1u);
            else XB_SPIN(xb_ld(&bar[XB_TOPGEN]) == tg, bar);
            __builtin_amdgcn_fence(__ATOMIC_ACQUIRE, "agent");
            xb_add(&bar[XB_XGEN(b.x)], 1u);
            asm volatile("s_waitcnt vmcnt(0)" ::: "memory");
        } else {
            XB_SPIN(xb_ld(&bar[XB_XGEN(b.x)]) == gen, bar);
            __builtin_amdgcn_fence(__ATOMIC_ACQUIRE, "agent");
            asm volatile("s_waitcnt vmcnt(0)" ::: "memory");
        }
    }
    __syncthreads();
}

__global__ void __launch_bounds__(NT, 2) k_mega(Params p) {
    extern __shared__ __attribute__((aligned(16))) unsigned char lds_raw[];
    LAS unsigned char* lds = (LAS unsigned char*)lds_raw;
    const int bid = blockIdx.x, nb = gridDim.x;
    volatile LAS unsigned* bst = (volatile LAS unsigned*)(lds + LDS_BYTES - 16);
    if (threadIdx.x < 4) bst[threadIdx.x] = 0u;
    __syncthreads();
    const XcdBarrier xb = xcd_barrier_post(p.bar, bst);
    phase_prep(p, lds, bid, nb);
    xcd_barrier(xb);
    { pg8::Gemm g{p.hnb, p.w_in_t, D, D, D, 0}; pg8::StaticOrder S; S.init(RT / 256, INW / 256, nb, bid); EpiProj E{p.xp, p.glu};
      pg8::gemm_phase<EpiProj, pg8::StaticOrder>(lds, g, S, E); }
    { const int nproj = (RT / 256) * (INW / 256); const int first = (nproj > nb && nproj < 2 * nb) ? nproj - nb : 0, nfree = nb - first;
      for (int uu = bid - first; uu >= 0 && uu < 64; uu += nfree) {
        __syncthreads();
        const bool pw = uu < 32;
        pg8::Gemm g{pw ? p.w_out_t + PWD : p.w_out_t, pw ? p.pw_b16 : p.pool_ws, D, pw ? CWD : 256, pw ? CWD : 256, pw ? 0 : 256};
        pg8::OneUnit S; S.u.pm = (uu & 31) >> 2; S.u.pn = uu & 3; EpiBf16Out E{p.w_eff_t, D, pw ? PWD : 0, nullptr};
        pg8::gemm_phase<EpiBf16Out, pg8::OneUnit>(lds, g, S, E);
      }
    }
    xcd_barrier(xb);
    phase_mix(p, lds, bid, nb);
    xcd_barrier(xb);
    { pg8::Gemm g{p.mixb, p.w_eff_t, D, D, D, 0}; pg8::StaticOrder S; S.init(SEQ / 256, D / 256, nb, bid); EpiResid E{p.x, p.bias_eff, p.h2b, p.ssq};
      pg8::gemm_phase<EpiResid, pg8::StaticOrder>(lds, g, S, E); }
    xcd_barrier(xb);
    { pg8::Gemm g{p.h2b, p.wq_t, D, D, D, 0}; pg8::StaticOrder S; S.init(SEQ / 256, D / 256, nb, bid); EpiQTopk E{p.ssq, p.rstd, p.keysb, p.idx, p.gsu};
      pg8::gemm_phase<EpiQTopk, pg8::StaticOrder>(lds, g, S, E); }
    xcd_barrier(xb);
    phase_pd(p, bid, nb);
    xcd_barrier(xb);
    phase_pa(p, bid, nb);
    xcd_barrier(xb);
    phase_pu(p, bid, nb);
    xcd_barrier(xb);
    phase_pf(p, bid, nb);
}

extern "C" void kernel_launch(void* const* d_in, const int* in_sizes, int n_in, void* d_out, int out_size, void* d_ws, size_t ws_size, hipStream_t stream) {
    Params p{};
    p.x = (const float*)d_in[0]; p.meta = (const float*)d_in[1]; p.mix_g = (const float*)d_in[2]; p.w_in = (const float*)d_in[3];
    p.pool_w = (const float*)d_in[4]; p.pool_scale = (const float*)d_in[5]; p.dw_w = (const float*)d_in[6]; p.dw_b = (const float*)d_in[7];
    p.ln_g = (const float*)d_in[8]; p.ln_b = (const float*)d_in[9]; p.pw_w = (const float*)d_in[10]; p.pw_b = (const float*)d_in[11];
    p.w_out = (const float*)d_in[12]; p.ffn_g = (const float*)d_in[13]; p.wq = (const float*)d_in[14]; p.keys = (const float*)d_in[15];
    p.down = (const float*)d_in[16]; p.up = (const float*)d_in[17]; p.fin_g = (const float*)d_in[18];
    p.out = (float*)d_out;
    char* w = (char*)d_ws; size_t off = 0;
    auto take = [&](size_t bytes) { char* r = w + off; off += (bytes + 255) & ~(size_t)255; return r; };
    p.idx = (unsigned short*)take((size_t)SEQ * 128 * 2);
    p.gsu = (float*)take((size_t)SEQ * 128 * 4);
    p.part = (bf16_t*)take((size_t)SEQ * 16 * 128 * 2);
    p.act = (bf16_t*)take((size_t)SEQ * 128 * 2);
    p.ssq2 = (float*)take((size_t)SEQ * 16 * 4);
    p.h3b = (bf16_t*)take((size_t)SEQ * D * 2);
    p.hnb = (bf16_t*)take((size_t)RT * D * 2);
    p.w_in_t = (bf16_t*)take((size_t)INW * D * 2);
    p.xp = (bf16_t*)take((size_t)RT * PWD * 2);
    p.glu = (bf16_t*)take((size_t)RT * CWD * 2);
    p.mixb = (bf16_t*)take((size_t)SEQ * D * 2);
    p.h2b = (bf16_t*)take((size_t)SEQ * D * 2);
    p.pool_ws = (bf16_t*)take((size_t)4 * 256 * 256 * 2);
    p.pw_b16 = (bf16_t*)take((size_t)CWD * CWD * 2);
    p.w_eff_t = (bf16_t*)take((size_t)D * D * 2);
    p.bias_eff = (float*)take((size_t)D * 4);
    p.w_out_t = (bf16_t*)take((size_t)D * D * 2);
    p.ssq = (float*)take((size_t)SEQ * 32 * 4);
    p.bar = (unsigned*)take((size_t)XCD_BAR_WORDS * 4);
    p.rstd = (float*)take((size_t)SEQ * 4);
    p.wq_t = (bf16_t*)take((size_t)D * D * 2);
    p.keysb = (bf16_t*)take((size_t)8 * 2 * 128 * 128 * 2);
    p.qb = (bf16_t*)take((size_t)SEQ * D * 2);
    p.down8 = (unsigned char*)take((size_t)16384 * D);
    p.up8 = (unsigned char*)take((size_t)16384 * D);
    p.sdn = (float*)take((size_t)16384 * 4);
    p.sup = (float*)take((size_t)16384 * 4);
    static int grid_blocks = 0;
    if (!grid_blocks) {
        int dev = 0, cus = 0, per_cu = 0;
        (void)hipGetDevice(&dev);
        (void)hipDeviceGetAttribute(&cus, hipDeviceAttributeMultiprocessorCount, dev);
        (void)hipFuncSetAttribute((const void*)k_mega, hipFuncAttributeMaxDynamicSharedMemorySize, LDS_BYTES);
        (void)hipOccupancyMaxActiveBlocksPerMultiprocessor(&per_cu, k_mega, NT, LDS_BYTES);
        if (per_cu < 1) { fprintf(stderr, "occupancy query says %d workgroups per CU: nothing launched\n", per_cu); grid_blocks = -1; }
        else if (cus != (SEQ / 256) * (D / 256)) { fprintf(stderr, "this build needs a %d-CU device (got %d): nothing launched\n", (SEQ / 256) * (D / 256), cus); grid_blocks = -1; }
        else grid_blocks = cus;
    }
    if (grid_blocks < 0) return;
    (void)hipMemsetAsync(p.bar, 0, (size_t)XCD_BAR_WORDS * 4, stream);
    void* args[] = {&p};
    hipError_t e = hipLaunchCooperativeKernel((void*)k_mega, dim3(grid_blocks), dim3(NT), args, LDS_BYTES, stream);
    if (e != hipSuccess) fprintf(stderr, "cooperative launch failed: %s (grid %d)\n", hipGetErrorString(e), grid_blocks);
}
```

```cpp
#include <hip/hip_runtime.h>
#include <hip/hip_cooperative_groups.h>
#include <stdint.h>
#include <cstdio>
namespace cg = cooperative_groups;

#define NT 512
#define LAS __attribute__((address_space(3)))
typedef unsigned short bf16_t;
typedef short bf16x8 __attribute__((ext_vector_type(8)));
typedef float f32x4 __attribute__((ext_vector_type(4)));
typedef unsigned u32x4 __attribute__((ext_vector_type(4)));
typedef unsigned u32x2 __attribute__((ext_vector_type(2)));

constexpr int D = 2048, SEQ = 8192, NMETA = 16, T = SEQ + NMETA;
constexpr int PWD = 1024, CWD = 1024, INW = 3072;
constexpr int KS = 31;
constexpr int RPAD = 240, RT = 8448;
constexpr int LDS_BYTES = 151552;

struct Params {
    const float *x, *meta, *mix_g, *w_in, *pool_w, *pool_scale, *dw_w, *dw_b, *ln_g, *ln_b, *pw_w, *pw_b, *w_out, *ffn_g, *wq, *keys, *down, *up, *fin_g;
    float* out;
    unsigned short* idx;
    unsigned* bar;
    bf16_t *hnb, *w_in_t, *xp, *glu, *mixb, *h2b, *pool_ws, *pw_b16, *w_eff_t, *w_out_t, *wq_t, *keysb, *qb;
    unsigned char *down8, *up8;
    float *sdn, *sup;
    float *gsu;
    bf16_t* part;
    bf16_t* act;
    float* ssq2;
    bf16_t* h3b;
    float *ssq, *rstd, *bias_eff;
};

__device__ __forceinline__ unsigned cvt_pk_bf16(float lo, float hi) { unsigned r; asm volatile("v_cvt_pk_bf16_f32 %0, %1, %2" : "=v"(r) : "v"(lo), "v"(hi)); return r; }
__device__ __forceinline__ float wave_sum(float v) {
#pragma unroll
    for (int o = 1; o < 64; o <<= 1) v += __shfl_xor(v, o);
    return v;
}

__device__ __forceinline__ const float* hrow(const Params& p, int t) { return t < NMETA ? p.meta + (size_t)t * D : p.x + (size_t)(t - NMETA) * D; }

__device__ __forceinline__ float block_sum(float v, float* red) {
#pragma unroll
    for (int o = 32; o; o >>= 1) v += __shfl_xor(v, o);
    __syncthreads();
    if ((threadIdx.x & 63) == 0) red[threadIdx.x >> 6] = v;
    __syncthreads();
    float s = 0.f;
#pragma unroll
    for (int i = 0; i < NT / 64; ++i) s += red[i];
    return s;
}

namespace pg8 {
constexpr int BM = 256, BK = 64, HALF = 128, HTB = HALF * BK * 2, STAGE_BYTES = 8 * HTB, NXCD = 8, WGM = 8;
__device__ __forceinline__ int lds_byte(int r, int c) { const int st = (r >> 4) * 2 + (c >> 5), rr = r & 15, cc = c & 31, ob = rr * 64 + cc * 2; return st * 1024 + (ob ^ (((ob >> 9) & 1) << 5)); }
__device__ __forceinline__ void stage_rc(int b, int& R, int& C) { const int st = b / 1024, sb = b % 1024, swz = sb ^ (((sb >> 9) & 1) << 5); R = (st >> 1) * 16 + swz / 64; C = (st & 1) * 32 + (swz % 64) / 2; }
struct Unit { int pm, pn; };
struct Gemm { const bf16_t* A; const bf16_t* Bt; int lda, ldb, K; int a_col_per_pn; };
struct StaticOrder {
    int nM, nN, nwg, G, c;
    __device__ void init(int nM_, int nN_, int G_, int c_) { nM = nM_; nN = nN_; nwg = nM * nN; G = G_; c = c_; }
    __device__ bool next(int i, Unit& u) const {
        const long L = (long)i * G + c; if (L >= nwg) return false;
        int wgid = (int)L; { const int q = nwg / NXCD, r = nwg % NXCD, xcd = wgid % NXCD, off = wgid / NXCD; wgid = (xcd < r ? xcd * (q + 1) : r * (q + 1) + (xcd - r) * q) + off; }
        const int nig = WGM * nN, gid = wgid / nig, fm = gid * WGM, gsz = (nM - fm) < WGM ? (nM - fm) : WGM;
        u.pm = fm + ((wgid % nig) % gsz); u.pn = (wgid % nig) / gsz; return true;
    }
};
struct OneUnit { Unit u; __device__ bool next(int i, Unit& o) const { if (i) return false; o = u; return true; } };
template <class Epi, class Sched>
__device__ __forceinline__ void gemm_phase(LAS unsigned char* lds, const Gemm g, const Sched& S, const Epi& E) {
    const int tid = threadIdx.x, wid = __builtin_amdgcn_readfirstlane(tid >> 6), lane = tid & 63, wr = wid >> 2, wc = wid & 3, fr = lane & 15, fq = lane >> 4;
    const int K = g.K, nt = K / BK;
    unsigned voffA[2], voffB[2];
#pragma unroll
    for (int i = 0; i < 2; ++i) { int R, C; stage_rc(tid * 16 + i * 8192, R, C);
        voffA[i] = (unsigned)(R * g.lda + C) * 2u; voffB[i] = (unsigned)(R * g.ldb + C) * 2u; }
    const size_t kstep = (size_t)(BK * 2);
    const size_t hstepA = (size_t)HALF * g.lda * 2, hstepB = (size_t)HALF * g.ldb * 2;
    const size_t tstepA = 2 * hstepA, tstepB = 2 * hstepB;
    const unsigned ldsw = (unsigned)wid * 1024u;
    const int aoff = lds_byte(wr * 64 + fr, fq * 8), boff = lds_byte(wc * 32 + fr, fq * 8);
#define PG8_SA(b, h) (((b) * 2 + (h)) * HTB)
#define PG8_SB(b, h) ((4 + (b) * 2 + (h)) * HTB)
#define PG8_STAGE(bufoff, gbase, voff) do { _Pragma("unroll") for (int _i = 0; _i < 2; ++_i) \
        __builtin_amdgcn_global_load_lds((const unsigned*)((const char*)(gbase) + (voff)[_i]), (LAS unsigned*)(lds + (bufoff) + ldsw + _i * 8192), 16, 0, 0); } while (0)
#define PG8_LDA(dst, b, h) do { _Pragma("unroll") for (int m = 0; m < 4; ++m) _Pragma("unroll") for (int k = 0; k < 2; ++k) dst[m][k] = *(const LAS bf16x8*)(lds + PG8_SA(b, h) + aoff + m * 2048 + k * 1024); } while (0)
#define PG8_LDB(dst, b, h) do { _Pragma("unroll") for (int n = 0; n < 2; ++n) _Pragma("unroll") for (int k = 0; k < 2; ++k) dst[n][k] = *(const LAS bf16x8*)(lds + PG8_SB(b, h) + boff + n * 2048 + k * 1024); } while (0)
#define PG8_MMA(ai, bj, At, Bt) do { __builtin_amdgcn_s_setprio(1); _Pragma("unroll") for (int m = 0; m < 4; ++m) _Pragma("unroll") for (int n = 0; n < 2; ++n) _Pragma("unroll") for (int k = 0; k < 2; ++k) \
        acc[ai][bj][m][n] = __builtin_amdgcn_mfma_f32_16x16x32_bf16(Bt[n][k], At[m][k], acc[ai][bj][m][n], 0, 0, 0); __builtin_amdgcn_s_setprio(0); } while (0)
#define PG8_WAIT_V(n) asm volatile("s_waitcnt vmcnt(" #n ")" ::: "memory")
#define PG8_WAIT_L(n) asm volatile("s_waitcnt lgkmcnt(" #n ")" ::: "memory")
#define PG8_BAR __builtin_amdgcn_s_barrier()
#define PG8_SCHED __builtin_amdgcn_sched_barrier(0)
    Unit cur, nxt; int ui = 0;
    if (!S.next(0, cur)) return;
    f32x4 acc[2][2][4][2];
#pragma unroll
    for (int a = 0; a < 2; ++a)
#pragma unroll
        for (int b = 0; b < 2; ++b)
#pragma unroll
            for (int m = 0; m < 4; ++m)
#pragma unroll
                for (int n = 0; n < 2; ++n) acc[a][b][m][n] = (f32x4){0.f, 0.f, 0.f, 0.f};
    bf16x8 At[4][2], B0[2][2], B1[2][2];
    const char* cA = (const char*)g.A + (size_t)cur.pm * tstepA + (size_t)cur.pn * g.a_col_per_pn * 2; const char* cB = (const char*)g.Bt + (size_t)cur.pn * tstepB;
    PG8_STAGE(PG8_SB(0, 0), cB, voffB); PG8_STAGE(PG8_SA(0, 0), cA, voffA); PG8_STAGE(PG8_SB(0, 1), cB + hstepB, voffB); PG8_STAGE(PG8_SA(0, 1), cA + hstepA, voffA);
    if (wr == 1) PG8_BAR;
    PG8_WAIT_V(4); PG8_BAR;
    PG8_STAGE(PG8_SB(1, 0), cB + kstep, voffB); PG8_STAGE(PG8_SA(1, 0), cA + kstep, voffA); PG8_STAGE(PG8_SB(1, 1), cB + hstepB + kstep, voffB);
    PG8_WAIT_V(6); PG8_BAR;
    for (;;) {
        const bool has_next = S.next(ui + 1, nxt);
        const char* nA = has_next ? (const char*)g.A + (size_t)nxt.pm * tstepA + (size_t)nxt.pn * g.a_col_per_pn * 2 : cA; const char* nB = has_next ? (const char*)g.Bt + (size_t)nxt.pn * tstepB : cB;
        for (int t = 0; t < nt; t += 2) {
            const bool last = (t == nt - 2);
            const char* a1 = cA + (size_t)(t + 1) * kstep;
            const char* a2 = last ? nA : cA + (size_t)(t + 2) * kstep; const char* b2 = last ? nB : cB + (size_t)(t + 2) * kstep;
            const char* a3 = a2 + kstep; const char* b3 = b2 + kstep;
            PG8_LDB(B0, 0, 0); PG8_SCHED; PG8_LDA(At, 0, 0); PG8_STAGE(PG8_SA(1, 1), a1 + hstepA, voffA);
            PG8_WAIT_L(8); PG8_BAR; PG8_WAIT_L(0); PG8_MMA(0, 0, At, B0); PG8_BAR; PG8_SCHED;
            PG8_LDB(B1, 0, 1); PG8_STAGE(PG8_SB(0, 0), b2, voffB);
            PG8_BAR; PG8_WAIT_L(0); PG8_MMA(0, 1, At, B1); PG8_BAR;
            PG8_LDA(At, 0, 1); PG8_STAGE(PG8_SA(0, 0), a2, voffA);
            PG8_BAR; PG8_WAIT_L(0); PG8_MMA(1, 0, At, B0); PG8_BAR; PG8_SCHED;
            PG8_STAGE(PG8_SB(0, 1), b2 + hstepB, voffB);
            PG8_WAIT_V(6); PG8_BAR; PG8_MMA(1, 1, At, B1); PG8_BAR;
            PG8_LDB(B0, 1, 0); PG8_SCHED; PG8_LDA(At, 1, 0); PG8_STAGE(PG8_SA(0, 1), a2 + hstepA, voffA);
            PG8_WAIT_L(8); PG8_BAR; PG8_WAIT_L(0); PG8_MMA(0, 0, At, B0); PG8_BAR; PG8_SCHED;
            PG8_LDB(B1, 1, 1); PG8_STAGE(PG8_SB(1, 0), b3, voffB);
            PG8_BAR; PG8_WAIT_L(0); PG8_MMA(0, 1, At, B1); PG8_BAR;
            PG8_LDA(At, 1, 1); PG8_STAGE(PG8_SA(1, 0), a3, voffA);
            PG8_BAR; PG8_WAIT_L(0); PG8_MMA(1, 0, At, B0); PG8_BAR; PG8_SCHED;
            PG8_STAGE(PG8_SB(1, 1), b3 + hstepB, voffB);
            PG8_WAIT_V(6); PG8_BAR; PG8_MMA(1, 1, At, B1); PG8_BAR;
        }
        if constexpr (!Epi::AFTER_DRAIN) E(acc, cur, wr, wc, fr, fq);
        if (!has_next) break;
#pragma unroll
        for (int a = 0; a < 2; ++a)
#pragma unroll
            for (int b = 0; b < 2; ++b)
#pragma unroll
                for (int m = 0; m < 4; ++m)
#pragma unroll
                    for (int n = 0; n < 2; ++n) acc[a][b][m][n] = (f32x4){0.f, 0.f, 0.f, 0.f};
        cur = nxt; cA = nA; cB = nB; ++ui;
    }
    PG8_WAIT_V(0);
    if (wr == 0) PG8_BAR;
    PG8_BAR;
    if constexpr (Epi::AFTER_DRAIN) E.fused(acc, cur, wr, wc, fr, fq, lds, wid, lane);
#undef PG8_SA
#undef PG8_SB
#undef PG8_STAGE
#undef PG8_LDA
#undef PG8_LDB
#undef PG8_MMA
#undef PG8_WAIT_V
#undef PG8_WAIT_L
#undef PG8_BAR
#undef PG8_SCHED
}
}

struct EpiProjF32 {
    static constexpr bool AFTER_DRAIN = false;
    float* proj;
    __device__ __forceinline__ void operator()(const f32x4 (&acc)[2][2][4][2], const pg8::Unit& u, int wr, int wc, int fr, int fq) const {
#pragma unroll
        for (int ai = 0; ai < 2; ++ai)
#pragma unroll
            for (int m = 0; m < 4; ++m) {
                const int t = u.pm * 256 + ai * 128 + wr * 64 + m * 16 + fr - RPAD;
                if (t >= 0) {
#pragma unroll
                    for (int bj = 0; bj < 2; ++bj)
#pragma unroll
                        for (int n = 0; n < 2; ++n) {
                            const int off = wc * 32 + n * 16 + fq * 4;
                            const int col = u.pn < 4 ? u.pn * 256 + bj * 128 + off : (bj ? 2048 : 1024) + (u.pn - 4) * 128 + off;
                            *(f32x4*)(proj + (size_t)t * INW + col) = acc[ai][bj][m][n];
                        }
                }
            }
    }
};


__device__ __forceinline__ float sigmoidf_fast(float x) { return __builtin_amdgcn_rcpf(1.0f + __expf(-x)); }

struct EpiProj {
    static constexpr bool AFTER_DRAIN = false;
    bf16_t* xp; bf16_t* glu;
    __device__ __forceinline__ void operator()(const f32x4 (&acc)[2][2][4][2], const pg8::Unit& u, int wr, int wc, int fr, int fq) const {
#pragma unroll
        for (int ai = 0; ai < 2; ++ai)
#pragma unroll
            for (int m = 0; m < 4; ++m) {
                const size_t row = (size_t)(u.pm * 256 + ai * 128 + wr * 64 + m * 16 + fr);
                if (u.pn < 4) {
#pragma unroll
                    for (int bj = 0; bj < 2; ++bj)
#pragma unroll
                        for (int n = 0; n < 2; ++n) { const f32x4 v = acc[ai][bj][m][n]; u32x2 w; w.x = cvt_pk_bf16(v[0], v[1]); w.y = cvt_pk_bf16(v[2], v[3]);
                            *(u32x2*)(xp + row * PWD + u.pn * 256 + bj * 128 + wc * 32 + n * 16 + fq * 4) = w; }
                } else {
#pragma unroll
                    for (int n = 0; n < 2; ++n) { const f32x4 a = acc[ai][0][m][n], g = acc[ai][1][m][n]; u32x2 w;
                        w.x = cvt_pk_bf16(a[0] * sigmoidf_fast(g[0]), a[1] * sigmoidf_fast(g[1])); w.y = cvt_pk_bf16(a[2] * sigmoidf_fast(g[2]), a[3] * sigmoidf_fast(g[3]));
                        *(u32x2*)(glu + row * CWD + (u.pn - 4) * 128 + wc * 32 + n * 16 + fq * 4) = w; }
                }
            }
    }
};
struct EpiBf16Out {
    static constexpr bool AFTER_DRAIN = false;
    bf16_t* O; int ldc; int col0; const float* bias;
    __device__ __forceinline__ void operator()(const f32x4 (&acc)[2][2][4][2], const pg8::Unit& u, int wr, int wc, int fr, int fq) const {
#pragma unroll
        for (int ai = 0; ai < 2; ++ai)
#pragma unroll
            for (int m = 0; m < 4; ++m) {
                const size_t row = (size_t)(u.pm * 256 + ai * 128 + wr * 64 + m * 16 + fr);
#pragma unroll
                for (int bj = 0; bj < 2; ++bj)
#pragma unroll
                    for (int n = 0; n < 2; ++n) { const int c = u.pn * 256 + bj * 128 + wc * 32 + n * 16 + fq * 4; f32x4 v = acc[ai][bj][m][n];
                        if (bias) v += *(const f32x4*)(bias + c);
                        u32x2 w; w.x = cvt_pk_bf16(v[0], v[1]); w.y = cvt_pk_bf16(v[2], v[3]);
                        *(u32x2*)(O + row * ldc + col0 + c) = w; }
            }
    }
};
struct EpiResid {
    static constexpr bool AFTER_DRAIN = false;
    const float* x; const float* bias; bf16_t* h2b; float* ssq;
    __device__ __forceinline__ void operator()(const f32x4 (&acc)[2][2][4][2], const pg8::Unit& u, int wr, int wc, int fr, int fq) const {
#pragma unroll
        for (int ai = 0; ai < 2; ++ai)
#pragma unroll
            for (int m = 0; m < 4; ++m) {
                const size_t row = (size_t)(u.pm * 256 + ai * 128 + wr * 64 + m * 16 + fr);
                float ss = 0.f;
#pragma unroll
                for (int bj = 0; bj < 2; ++bj)
#pragma unroll
                    for (int n = 0; n < 2; ++n) { const int c = u.pn * 256 + bj * 128 + wc * 32 + n * 16 + fq * 4;
                        const f32x4 v = acc[ai][bj][m][n] + *(const f32x4*)(x + row * D + c) + *(const f32x4*)(bias + c);
                        u32x2 w; w.x = cvt_pk_bf16(v[0], v[1]); w.y = cvt_pk_bf16(v[2], v[3]);
                        *(u32x2*)(h2b + row * D + c) = w;
                        ss += (v[0] * v[0] + v[1] * v[1]) + (v[2] * v[2] + v[3] * v[3]); }
                ss += __shfl_xor(ss, 16); ss += __shfl_xor(ss, 32);
                if (fq == 0) ssq[row * 32 + u.pn * 4 + wc] = ss;
            }
    }
};

__device__ __forceinline__ float fsel(int mask, float a, float b) { return __int_as_float((__float_as_int(a) & ~mask) | (__float_as_int(b) & mask)); }
__device__ __forceinline__ float bf_lo(unsigned w) { return __uint_as_float(w << 16); }
__device__ __forceinline__ float bf_hi(unsigned w) { return __uint_as_float(w & 0xffff0000u); }

__device__ __forceinline__ u32x4 bload16(__amdgpu_buffer_rsrc_t r, int voff, int soff) { return __builtin_bit_cast(u32x4, __builtin_amdgcn_raw_buffer_load_b128(r, voff, soff, 0)); }
__device__ __forceinline__ unsigned bload4(__amdgpu_buffer_rsrc_t r, int voff, int soff) { return (unsigned)__builtin_amdgcn_raw_buffer_load_b32(r, voff, soff, 0); }
__device__ __forceinline__ void bstore4(__amdgpu_buffer_rsrc_t r, unsigned v, int voff, int soff) { __builtin_amdgcn_raw_buffer_store_b32(v, r, voff, soff, 0); }
__device__ __forceinline__ u32x2 bload8(__amdgpu_buffer_rsrc_t r, int voff, int soff) { return __builtin_bit_cast(u32x2, __builtin_amdgcn_raw_buffer_load_b64(r, voff, soff, 0)); }
template <int W> __device__ __forceinline__ void pool_tile(__amdgpu_buffer_rsrc_t rxp, __amdgpu_buffer_rsrc_t rpo, int r0, int tile, int tid) {
    unsigned v[32 + W - 1];
#pragma unroll
    for (int i = 0; i < 32 + W - 1; ++i) v[i] = bload4(rxp, tid * 4, (r0 - (W - 1) + i) * 2048);
    float s0 = 0.f, s1 = 0.f;
#pragma unroll
    for (int i = 0; i < W - 1; ++i) { s0 += bf_lo(v[i]); s1 += bf_hi(v[i]); }
    constexpr float inv = 1.0f / (float)W;
#pragma unroll
    for (int i = 0; i < 32; ++i) {
        const float a0 = bf_lo(v[W - 1 + i]), a1 = bf_hi(v[W - 1 + i]);
        s0 += a0; s1 += a1;
        bstore4(rpo, cvt_pk_bf16(s0 * inv - a0, s1 * inv - a1), tid * 4, (tile * 32 + i) * 4096);
        s0 -= bf_lo(v[i]); s1 -= bf_hi(v[i]);
    }
}
__device__ __forceinline__ void phase_mix(const Params& p, LAS unsigned char* lds, int bid, int nb) {
    const int tid = threadIdx.x, lane = tid & 63, wave = tid >> 6;
    LAS unsigned* gl = (LAS unsigned*)lds;
    LAS float* red = (LAS float*)(lds + 62 * 2048);
    const __amdgpu_buffer_rsrc_t rxp = __builtin_amdgcn_make_buffer_rsrc((void*)p.xp, 0, RT * PWD * 2, 0x00020000);
    const __amdgpu_buffer_rsrc_t rgl = __builtin_amdgcn_make_buffer_rsrc((void*)p.glu, 0, RT * CWD * 2, 0x00020000);
    const __amdgpu_buffer_rsrc_t rpo = __builtin_amdgcn_make_buffer_rsrc((void*)p.mixb, 0, SEQ * D * 2, 0x00020000);
    const __amdgpu_buffer_rsrc_t rww = __builtin_amdgcn_make_buffer_rsrc((void*)p.dw_w, 0, KS * CWD * 4, 0x00020000);
    const __amdgpu_buffer_rsrc_t rwb = __builtin_amdgcn_make_buffer_rsrc((void*)p.dw_b, 0, CWD * 4, 0x00020000);
    const __amdgpu_buffer_rsrc_t rlg = __builtin_amdgcn_make_buffer_rsrc((void*)p.ln_g, 0, CWD * 4, 0x00020000);
    const __amdgpu_buffer_rsrc_t rlb = __builtin_amdgcn_make_buffer_rsrc((void*)p.ln_b, 0, CWD * 4, 0x00020000);
    for (int tile = bid; tile < SEQ / 32; tile += nb) {
        const int r0 = 256 + tile * 32;
        __syncthreads();
#pragma unroll
        for (int j = 0; j < 16; ++j) { const int ch = j * NT + tid; if (ch < 62 * 128)
            *(LAS u32x4*)(lds + ch * 16) = bload16(rgl, tid * 16, (r0 - 30) * 2048 + j * 8192); }
        { const int g = __builtin_amdgcn_readfirstlane(tid >> 7);
          if (g == 0) pool_tile<2>(rxp, rpo, r0, tile, tid); else if (g == 1) pool_tile<4>(rxp, rpo, r0, tile, tid); else if (g == 2) pool_tile<8>(rxp, rpo, r0, tile, tid); else pool_tile<16>(rxp, rpo, r0, tile, tid); }
        __syncthreads();
#pragma unroll 1
        for (int hf = 0; hf < 2; ++hf) {
            float c0[16], c1[16];
            {
                float w0[KS], w1[KS];
#pragma unroll
                for (int k = 0; k < KS; ++k) { const u32x2 wv = bload8(rww, tid * 8, k * 4096); w0[k] = __uint_as_float(wv.x); w1[k] = __uint_as_float(wv.y); }
                const u32x2 bvv = bload8(rwb, tid * 8, 0); const float b0 = __uint_as_float(bvv.x), b1 = __uint_as_float(bvv.y);
#pragma unroll
                for (int i = 0; i < 16; ++i) { c0[i] = b0; c1[i] = b1; }
                const LAS unsigned* glh = gl + hf * 16 * 512 + tid;
#pragma unroll
                for (int rr = 0; rr < 46; ++rr) {
                    if ((rr & 7) == 0) asm volatile("" ::: "memory");
                    const unsigned vv = glh[rr * 512]; const float x0 = bf_lo(vv), x1 = bf_hi(vv);
#pragma unroll
                    for (int i = 0; i < 16; ++i) { const int k = rr - i; if (k >= 0 && k < KS) { c0[i] += x0 * w0[k]; c1[i] += x1 * w1[k]; } }
                }
            }
            asm volatile("" ::: "memory");
#pragma unroll
            for (int which = 0; which < 2; ++which) {
                float st[16];
#pragma unroll
                for (int i = 0; i < 16; ++i) st[i] = which == 0 ? c0[i] + c1[i] : c0[i] * c0[i] + c1[i] * c1[i];
#pragma unroll
                for (int lvl = 0; lvl < 4; ++lvl) {
                    const int o = 32 >> lvl, n = 8 >> lvl; const int mk = -((lane >> (5 - lvl)) & 1);
#pragma unroll
                    for (int j = 0; j < 8; ++j) if (j < n) st[j] = fsel(mk, st[j], st[j + n]) + __shfl_xor(fsel(mk, st[j + n], st[j]), o);
                }
                float tot = st[0] + __shfl_xor(st[0], 2); tot += __shfl_xor(tot, 1);
                if ((lane & 3) == 0) red[wave * 32 + which * 16 + (lane >> 2)] = tot;
            }
            __syncthreads();
            if (tid < 32) { float t = 0.f;
#pragma unroll
                for (int q = 0; q < 8; ++q) t += red[q * 32 + tid];
                red[256 + tid] = t; }
            __syncthreads();
            const u32x2 lgv = bload8(rlg, tid * 8, 0), lbv = bload8(rlb, tid * 8, 0); const float lg0 = __uint_as_float(lgv.x), lg1 = __uint_as_float(lgv.y), lb0 = __uint_as_float(lbv.x), lb1 = __uint_as_float(lbv.y);
#pragma unroll
            for (int i = 0; i < 16; ++i) {
                const float s1 = red[256 + i], s2 = red[256 + 16 + i];
                const float mu = s1 * (1.0f / CWD), var = fmaxf(s2 * (1.0f / CWD) - mu * mu, 0.f), rs = rsqrtf(var + 1e-5f);
                const float y0 = (c0[i] - mu) * rs * lg0 + lb0, y1 = (c1[i] - mu) * rs * lg1 + lb1;
                bstore4(rpo, cvt_pk_bf16(y0 * sigmoidf_fast(y0), y1 * sigmoidf_fast(y1)), tid * 4, (tile * 32 + hf * 16 + i) * 4096 + 2048);
            }
            __syncthreads();
        }
    }
}

typedef float f32x16 __attribute__((ext_vector_type(16)));
__device__ __forceinline__ int okey(float s) { const int u = __float_as_int(s); return u ^ ((u >> 31) & 0x7fffffff); }
__device__ __forceinline__ float okey_inv(int k) { return __int_as_float(k ^ ((k >> 31) & 0x7fffffff)); }
__device__ __forceinline__ void sort16_desc(int (&v)[16]) {
#pragma unroll
    for (int k = 2; k <= 16; k <<= 1) {
#pragma unroll
        for (int j = k >> 1; j > 0; j >>= 1) {
#pragma unroll
            for (int i = 0; i < 16; ++i) {
                const int l = i ^ j;
                if (l > i) { const bool desc = (i & k) == 0; const int hi = max(v[i], v[l]), lo = min(v[i], v[l]); v[i] = desc ? hi : lo; v[l] = desc ? lo : hi; }
            }
        }
    }
}
__device__ __forceinline__ void merge16_desc(int (&a)[16], const int (&b)[16]) {
#pragma unroll
    for (int i = 0; i < 16; ++i) a[i] = max(a[i], b[15 - i]);
#pragma unroll
    for (int j = 8; j > 0; j >>= 1) {
#pragma unroll
        for (int i = 0; i < 16; ++i) { const int l = i ^ j; if (l > i) { const int hi = max(a[i], a[l]), lo = min(a[i], a[l]); a[i] = hi; a[l] = lo; } }
    }
}
__device__ __forceinline__ void pair_merge(int (&a)[16]) {
    int b[16];
#pragma unroll
    for (int i = 0; i < 16; ++i) b[i] = __shfl_xor(a[i], 32);
    merge16_desc(a, b);
}
constexpr int CELL_I[64] = {0,0,0,0,0,0,0,0,0,0,0,0,0,0,0,0,1,1,1,1,1,1,1,1,2,2,2,2,2,3,3,3,3,4,4,4,5,5,6,6,7,7,8,9,10,11,12,13,14,15,0,0,0,0,0,0,0,0,0,0,0,0,0,0};
constexpr int CELL_J[64] = {0,1,2,3,4,5,6,7,8,9,10,11,12,13,14,15,0,1,2,3,4,5,6,7,0,1,2,3,4,0,1,2,3,0,1,2,0,1,0,1,0,1,0,0,0,0,0,0,0,0,0,0,0,0,0,0,0,0,0,0,0,0,0,0};
constexpr int NCELL = 50;

struct EpiQTopk {
    static constexpr bool AFTER_DRAIN = true;
    const float* ssq; float* rstd; const bf16_t* keysb; unsigned short* idx; float* gsu;
    __device__ __forceinline__ void fused(const f32x4 (&acc)[2][2][4][2], const pg8::Unit& u, int wr, int wc, int fr, int fq, LAS unsigned char* lds, int wid, int lane) const {
        const int hh = lane >> 5, l31 = lane & 31, h = u.pn;
        LAS float* svt = (LAS float*)(lds + 65536 + (wid * 64 + lane) * 164);
        LAS unsigned char* sit = (LAS unsigned char*)(svt + 32);
        float rs[2][4];
#pragma unroll
        for (int ai = 0; ai < 2; ++ai)
#pragma unroll
            for (int m = 0; m < 4; ++m) {
                const size_t row = (size_t)(u.pm * 256 + ai * 128 + wr * 64 + m * 16 + fr);
                const f32x4* sp = (const f32x4*)(ssq + row * 32); f32x4 t = sp[0];
#pragma unroll
                for (int i = 1; i < 8; ++i) t += sp[i];
                rs[ai][m] = rsqrtf(((t[0] + t[1]) + (t[2] + t[3])) * (1.0f / D) + 1e-6f);
                if (u.pn == 0 && wc == 0 && fq == 0) rstd[row] = rs[ai][m];
            }
        const int trow = wid * 32 + l31;
#pragma unroll
        for (int ph = 0; ph < 2; ++ph) {
#pragma unroll
            for (int ai = 0; ai < 2; ++ai)
#pragma unroll
                for (int m = 0; m < 4; ++m) { const int row = ai * 128 + wr * 64 + m * 16 + fr;
#pragma unroll
                    for (int n = 0; n < 2; ++n) { const f32x4 v = acc[ai][ph][m][n] * rs[ai][m]; const int chunk = 4 * wc + 2 * n + (fq >> 1);
                        u32x2 w; w.x = cvt_pk_bf16(v[0], v[1]); w.y = cvt_pk_bf16(v[2], v[3]);
                        *(LAS u32x2*)(lds + row * 256 + ((chunk ^ (row & 15)) << 4) + (fq & 1) * 8) = w; } }
            __syncthreads();
            const bf16_t* krow = keysb + ((size_t)(h * 2 + ph) * 128 + l31) * 128 + 8 * hh;
            bf16x8 bq[8];
#pragma unroll
            for (int ks = 0; ks < 8; ++ks) bq[ks] = *(const LAS bf16x8*)(lds + trow * 256 + (((ks * 2 + hh) ^ (trow & 15)) << 4));
            int top[16];
#pragma unroll
            for (int i = 0; i < 16; ++i) top[i] = (int)0x80000000;
            bf16x8 ak[8];
#pragma unroll
            for (int ks = 0; ks < 8; ++ks) ak[ks] = *(const bf16x8*)(krow + ks * 16);
#pragma unroll 1
            for (int kt = 0; kt < 4; ++kt) {
                f32x16 c = {0.f, 0.f, 0.f, 0.f, 0.f, 0.f, 0.f, 0.f, 0.f, 0.f, 0.f, 0.f, 0.f, 0.f, 0.f, 0.f};
#pragma unroll
                for (int ks = 0; ks < 8; ++ks) c = __builtin_amdgcn_mfma_f32_32x32x16_bf16(ak[ks], bq[ks], c, 0, 0, 0);
                { const int kn = kt < 3 ? kt + 1 : 3;
#pragma unroll
                  for (int ks = 0; ks < 8; ++ks) ak[ks] = *(const bf16x8*)(krow + (size_t)kn * 32 * 128 + ks * 16); }
                int v[16];
                const int lowb = (127 - kt * 32) ^ (hh << 2);
#pragma unroll
                for (int r = 0; r < 16; ++r) v[r] = (okey(c[r]) & ~127) | (lowb - ((r & 3) + 8 * (r >> 2)));
                sort16_desc(v);
                merge16_desc(top, v);
            }
            pair_merge(top);
#pragma unroll
            for (int i = 0; i < 16; ++i) { svt[ph * 16 + i] = okey_inv(top[i] & ~127); sit[ph * 16 + i] = (unsigned char)(127 - (top[i] & 127)); }
            __syncthreads();
        }
        float sv[2][16];
#pragma unroll
        for (int i = 0; i < 16; ++i) { sv[0][i] = svt[i]; sv[1][i] = svt[16 + i]; }
        int w0[16], w1[16];
#pragma unroll
        for (int s = 0; s < 32; ++s) {
            const int e0 = 2 * s, e1 = 2 * s + 1;
            int key;
            if (e0 >= NCELL) key = (int)0x80000000;
            else {
                const float v0 = sv[0][CELL_I[e0]] + sv[1][CELL_J[e0]];
                const int k0 = (okey(v0) & ~255) | (255 - (CELL_I[e0] * 16 + CELL_J[e0]));
                if (e1 >= NCELL) key = hh ? (int)0x80000000 : k0;
                else { const float v1 = sv[0][CELL_I[e1]] + sv[1][CELL_J[e1]];
                    const int k1 = (okey(v1) & ~255) | (255 - (CELL_I[e1] * 16 + CELL_J[e1]));
                    key = hh ? k1 : k0; }
            }
            if (s < 16) w0[s] = key; else w1[s - 16] = key;
        }
        sort16_desc(w0); sort16_desc(w1); merge16_desc(w0, w1); pair_merge(w0);
        const float mx = okey_inv(w0[0] & ~255);
        float sum = 0.f;
#pragma unroll
        for (int k = 0; k < 16; ++k) sum += __expf(okey_inv(w0[k] & ~255) - mx);
        const float inv = 1.0f / sum;
        int eo[8]; float go[8]; const int hmask = -hh;
#pragma unroll
        for (int k = 0; k < 8; ++k) { const int kk = (w0[k] & ~hmask) | (w0[8 + k] & hmask); const int cc = 255 - (kk & 255);
            eo[k] = (int)sit[cc >> 4] * 128 + (int)sit[16 + (cc & 15)]; go[k] = __expf(okey_inv(kk & ~255) - mx) * inv; }
        const size_t ob = (size_t)(u.pm * 256 + trow) * 128 + h * 16 + hh * 8;
        *(u32x4*)(idx + ob) = (u32x4){(unsigned)eo[0] | ((unsigned)eo[1] << 16), (unsigned)eo[2] | ((unsigned)eo[3] << 16), (unsigned)eo[4] | ((unsigned)eo[5] << 16), (unsigned)eo[6] | ((unsigned)eo[7] << 16)};
        *(f32x4*)(gsu + ob) = (f32x4){go[0], go[1], go[2], go[3]};
        *(f32x4*)(gsu + ob + 4) = (f32x4){go[4], go[5], go[6], go[7]};
    }
    __device__ __forceinline__ void operator()(const f32x4 (&)[2][2][4][2], const pg8::Unit&, int, int, int, int) const {}
};

typedef float f32x2 __attribute__((ext_vector_type(2)));
template <int N> __device__ __forceinline__ f32x2 dot16_fp8(const u32x4 w, const f32x2 (&x)[N], int o, f32x2 acc) {
    const unsigned ww[4] = {w.x, w.y, w.z, w.w};
#pragma unroll
    for (int d = 0; d < 4; ++d) { acc += __builtin_amdgcn_cvt_pk_f32_fp8((int)ww[d], false) * x[o + 2 * d]; acc += __builtin_amdgcn_cvt_pk_f32_fp8((int)ww[d], true) * x[o + 2 * d + 1]; }
    return acc;
}
template <int N> __device__ __forceinline__ void axpy16_fp8(const u32x4 w, float a, f32x2 (&y)[N], int o) {
    const unsigned ww[4] = {w.x, w.y, w.z, w.w}; const f32x2 a2 = {a, a};
#pragma unroll
    for (int d = 0; d < 4; ++d) { y[o + 2 * d] += a2 * __builtin_amdgcn_cvt_pk_f32_fp8((int)ww[d], false); y[o + 2 * d + 1] += a2 * __builtin_amdgcn_cvt_pk_f32_fp8((int)ww[d], true); }
}
__device__ __forceinline__ void bstore16(__amdgpu_buffer_rsrc_t r, f32x4 v, int voff, int soff) { __builtin_amdgcn_raw_buffer_store_b128(__builtin_bit_cast(__attribute__((__vector_size__(4 * sizeof(unsigned)))) unsigned, v), r, voff, soff, 0); }
__device__ __forceinline__ void bstore8(__amdgpu_buffer_rsrc_t r, f32x2 v, int voff, int soff) { __builtin_amdgcn_raw_buffer_store_b64(__builtin_bit_cast(__attribute__((__vector_size__(2 * sizeof(unsigned)))) unsigned, v), r, voff, soff, 0); }
__device__ __forceinline__ f32x2 fsel2(int mask, f32x2 a, f32x2 b) { return (f32x2){fsel(mask, a.x, b.x), fsel(mask, a.y, b.y)}; }
__device__ __forceinline__ f32x2 shx2(f32x2 a, int o) { return (f32x2){__shfl_xor(a.x, o), __shfl_xor(a.y, o)}; }

__device__ __forceinline__ void phase_pd(const Params& p, int bid, int nb) {
    const int tid = threadIdx.x, lane = tid & 63, wave = __builtin_amdgcn_readfirstlane(tid >> 6);
    const int v = bid & 7, lw = (bid >> 3) * 8 + wave, NLW = (nb >> 3) * 8;
    const int c = lane & 7, sub = lane >> 3;
    const int m0 = -(lane & 1), m1 = -((lane >> 1) & 1), m2 = -((lane >> 2) & 1);
    const __amdgpu_buffer_rsrc_t rd = __builtin_amdgcn_make_buffer_rsrc((void*)p.down8, 0, 16384 * D, 0x00020000);
    const __amdgpu_buffer_rsrc_t rh = __builtin_amdgcn_make_buffer_rsrc((void*)p.h2b, 0, SEQ * D * 2, 0x00020000);
    const __amdgpu_buffer_rsrc_t rg1 = __builtin_amdgcn_make_buffer_rsrc((void*)p.ffn_g, 0, D * 4, 0x00020000);
    const __amdgpu_buffer_rsrc_t ri = __builtin_amdgcn_make_buffer_rsrc((void*)p.idx, 0, SEQ * 128 * 2, 0x00020000);
    const __amdgpu_buffer_rsrc_t rrs = __builtin_amdgcn_make_buffer_rsrc((void*)p.rstd, 0, SEQ * 4, 0x00020000);
    const __amdgpu_buffer_rsrc_t rp = __builtin_amdgcn_make_buffer_rsrc((void*)p.part, 0, SEQ * 16 * 128 * 2, 0x00020000);
    const int vsub = sub * 32, vc2 = c * 32, vc1 = c * 16, vl4 = lane * 4;
#pragma unroll 1
    for (int pass = 0; pass < 2; ++pass) {
        const int sl = v * 2 + pass;
        f32x2 gs[8];
#pragma unroll
        for (int i = 0; i < 4; ++i) { const f32x4 g = __builtin_bit_cast(f32x4, bload16(rg1, c * 64, sl * 512 + i * 16)); gs[2 * i] = (f32x2){g[0], g[1]}; gs[2 * i + 1] = (f32x2){g[2], g[3]}; }
        u32x4 ix[2], hh[2]; unsigned rsb;
        {
            const int t = lw;
#pragma unroll
            for (int i = 0; i < 2; ++i) ix[i] = bload16(ri, vsub, t * 256 + i * 16);
            hh[0] = bload16(rh, vc2, t * 4096 + sl * 256); hh[1] = bload16(rh, vc2, t * 4096 + sl * 256 + 16); rsb = bload4(rrs, 0, t * 4);
        }
#pragma unroll 1
        for (int t = lw; t < SEQ; t += NLW) {
            asm volatile("" ::: "memory");
            u32x4 w[16];
            {
                const unsigned ew[8] = {ix[0].x, ix[0].y, ix[0].z, ix[0].w, ix[1].x, ix[1].y, ix[1].z, ix[1].w};
#pragma unroll
                for (int g = 0; g < 16; ++g) { const unsigned e = (g & 1) ? (ew[g >> 1] >> 16) : (ew[g >> 1] & 0xffffu); w[g] = bload16(rd, (int)(e * 2048u) + vc1, sl * 128); }
            }
            f32x2 xs[8];
            {
                const float rs = __uint_as_float(rsb);
                const unsigned hw[8] = {hh[0].x, hh[0].y, hh[0].z, hh[0].w, hh[1].x, hh[1].y, hh[1].z, hh[1].w};
#pragma unroll
                for (int i = 0; i < 8; ++i) xs[i] = (f32x2){bf_lo(hw[i]) * rs, bf_hi(hw[i]) * rs} * gs[i];
            }
            asm volatile("" ::: "memory");
            {
                const int tn = t + NLW < SEQ ? t + NLW : t;
#pragma unroll
                for (int i = 0; i < 2; ++i) ix[i] = bload16(ri, vsub, tn * 256 + i * 16);
                hh[0] = bload16(rh, vc2, tn * 4096 + sl * 256); hh[1] = bload16(rh, vc2, tn * 4096 + sl * 256 + 16); rsb = bload4(rrs, 0, tn * 4);
            }
            asm volatile("" ::: "memory");
            float r[16];
#pragma unroll
            for (int g = 0; g < 16; ++g) { const f32x2 z = {0.f, 0.f}; const f32x2 s2 = dot16_fp8(w[g], xs, 0, z); r[g] = s2.x + s2.y; }
            float k8[8], k4[4];
#pragma unroll
            for (int i = 0; i < 8; ++i) k8[i] = fsel(m2, r[i], r[i + 8]) + __shfl_xor(fsel(m2, r[i + 8], r[i]), 4);
#pragma unroll
            for (int i = 0; i < 4; ++i) k4[i] = fsel(m1, k8[i], k8[i + 4]) + __shfl_xor(fsel(m1, k8[i + 4], k8[i]), 2);
            const float k0 = fsel(m0, k4[0], k4[2]) + __shfl_xor(fsel(m0, k4[2], k4[0]), 1);
            const float k1 = fsel(m0, k4[1], k4[3]) + __shfl_xor(fsel(m0, k4[3], k4[1]), 1);
            bstore4(rp, cvt_pk_bf16(k0, k1), vl4, (t * 16 + sl) * 256);
        }
    }
}
__device__ __forceinline__ void phase_pa(const Params& p, int bid, int nb) {
    const int tid = threadIdx.x, lane = tid & 63, wave = tid >> 6;
    const int gw = bid * 8 + wave, NGW = nb * 8;
    for (int it = gw; it < SEQ * 2; it += NGW) {
        const int t = it >> 1, pp = (it & 1) * 64 + lane;
        const bf16_t* pr = p.part + (size_t)t * 2048 + pp;
        float hs = 0.f;
#pragma unroll
        for (int sl = 0; sl < 16; ++sl) hs += __uint_as_float((unsigned)pr[sl * 128] << 16);
        const int e = (int)p.idx[(size_t)t * 128 + pp];
        hs *= p.sdn[e];
        const float av = p.gsu[(size_t)t * 128 + pp] * p.sup[e] * 0.5f * hs * (1.0f + erff(hs * 0.70710678118654752f));
        p.act[(size_t)t * 128 + pp] = (bf16_t)(cvt_pk_bf16(av, 0.f) & 0xffffu);
    }
}
__device__ __forceinline__ void phase_pu(const Params& p, int bid, int nb) {
    const int tid = threadIdx.x, lane = tid & 63, wave = __builtin_amdgcn_readfirstlane(tid >> 6);
    const int v = bid & 7, lw = (bid >> 3) * 8 + wave, NLW = (nb >> 3) * 8;
    const int c = lane & 7, sub = lane >> 3;
    const int m3 = -((lane >> 3) & 1), m4 = -((lane >> 4) & 1), m5 = -((lane >> 5) & 1);
    const __amdgpu_buffer_rsrc_t ru = __builtin_amdgcn_make_buffer_rsrc((void*)p.up8, 0, 16384 * D, 0x00020000);
    const __amdgpu_buffer_rsrc_t rh = __builtin_amdgcn_make_buffer_rsrc((void*)p.h2b, 0, SEQ * D * 2, 0x00020000);
    const __amdgpu_buffer_rsrc_t ri = __builtin_amdgcn_make_buffer_rsrc((void*)p.idx, 0, SEQ * 128 * 2, 0x00020000);
    const __amdgpu_buffer_rsrc_t ra = __builtin_amdgcn_make_buffer_rsrc((void*)p.act, 0, SEQ * 128 * 2, 0x00020000);
    const __amdgpu_buffer_rsrc_t ro = __builtin_amdgcn_make_buffer_rsrc((void*)p.h3b, 0, SEQ * D * 2, 0x00020000);
    const __amdgpu_buffer_rsrc_t rq = __builtin_amdgcn_make_buffer_rsrc((void*)p.ssq2, 0, SEQ * 16 * 4, 0x00020000);
    const int vsub = sub * 32, vc1 = c * 16, vh = c * 32 + sub * 4;
#pragma unroll 1
    for (int pass = 0; pass < 2; ++pass) {
        const int sl = v * 2 + pass;
        u32x4 ix[2], ac[2]; unsigned hb;
        {
            const int t = lw;
#pragma unroll
            for (int i = 0; i < 2; ++i) { ix[i] = bload16(ri, vsub, t * 256 + i * 16); ac[i] = bload16(ra, vsub, t * 256 + i * 16); }
            hb = bload4(rh, vh, t * 4096 + sl * 256);
        }
#pragma unroll 1
        for (int t = lw; t < SEQ; t += NLW) {
            asm volatile("" ::: "memory");
            u32x4 w[16];
            {
                const unsigned ew[8] = {ix[0].x, ix[0].y, ix[0].z, ix[0].w, ix[1].x, ix[1].y, ix[1].z, ix[1].w};
#pragma unroll
                for (int g = 0; g < 16; ++g) { const unsigned e = (g & 1) ? (ew[g >> 1] >> 16) : (ew[g >> 1] & 0xffffu); w[g] = bload16(ru, (int)(e * 2048u) + vc1, sl * 128); }
            }
            const unsigned aw[8] = {ac[0].x, ac[0].y, ac[0].z, ac[0].w, ac[1].x, ac[1].y, ac[1].z, ac[1].w};
            float a[16];
#pragma unroll
            for (int g = 0; g < 16; ++g) a[g] = (g & 1) ? bf_hi(aw[g >> 1]) : bf_lo(aw[g >> 1]);
            const unsigned hcur = hb;
            asm volatile("" ::: "memory");
            {
                const int tn = t + NLW < SEQ ? t + NLW : t;
#pragma unroll
                for (int i = 0; i < 2; ++i) { ix[i] = bload16(ri, vsub, tn * 256 + i * 16); ac[i] = bload16(ra, vsub, tn * 256 + i * 16); }
                hb = bload4(rh, vh, tn * 4096 + sl * 256);
            }
            asm volatile("" ::: "memory");
            f32x2 acc[8];
#pragma unroll
            for (int i = 0; i < 8; ++i) acc[i] = (f32x2){0.f, 0.f};
#pragma unroll
            for (int g = 0; g < 16; ++g) axpy16_fp8(w[g], a[g], acc, 0);
            f32x2 k4[4], k2[2];
#pragma unroll
            for (int i = 0; i < 4; ++i) k4[i] = fsel2(m5, acc[i], acc[i + 4]) + shx2(fsel2(m5, acc[i + 4], acc[i]), 32);
#pragma unroll
            for (int i = 0; i < 2; ++i) k2[i] = fsel2(m4, k4[i], k4[i + 2]) + shx2(fsel2(m4, k4[i + 2], k4[i]), 16);
            f32x2 h3 = fsel2(m3, k2[0], k2[1]) + shx2(fsel2(m3, k2[1], k2[0]), 8);
            h3 += (f32x2){bf_lo(hcur), bf_hi(hcur)};
            bstore4(ro, cvt_pk_bf16(h3.x, h3.y), vh, t * 4096 + sl * 256);
            const float ss = wave_sum(h3.x * h3.x + h3.y * h3.y);
            if (lane == 0) bstore4(rq, __float_as_uint(ss), 0, (t * 16 + sl) * 4);
        }
    }
}
__device__ __forceinline__ void phase_pf(const Params& p, int bid, int nb) {
    const int tid = threadIdx.x, lane = tid & 63, wave = tid >> 6;
    const int gw = bid * 8 + wave, NGW = nb * 8;
    for (int t = gw; t < SEQ; t += NGW) {
        const f32x4* sp = (const f32x4*)(p.ssq2 + (size_t)t * 16); f32x4 q = sp[0] + sp[1] + sp[2] + sp[3];
        const float rf = rsqrtf(((q[0] + q[1]) + (q[2] + q[3])) * (1.0f / D) + 1e-6f);
        const u32x4* hp = (const u32x4*)(p.h3b + (size_t)t * D) + lane;
        f32x4* o = (f32x4*)(p.out + (size_t)t * D) + 2 * lane; const f32x4* g = (const f32x4*)p.fin_g + 2 * lane;
#pragma unroll
        for (int j = 0; j < 4; ++j) { const u32x4 h = hp[64 * j]; const f32x4 g0 = g[128 * j], g1 = g[128 * j + 1];
            o[128 * j] = (f32x4){bf_lo(h.x) * rf * g0[0], bf_hi(h.x) * rf * g0[1], bf_lo(h.y) * rf * g0[2], bf_hi(h.y) * rf * g0[3]};
            o[128 * j + 1] = (f32x4){bf_lo(h.z) * rf * g1[0], bf_hi(h.z) * rf * g1[1], bf_lo(h.w) * rf * g1[2], bf_hi(h.w) * rf * g1[3]}; }
    }
}

__device__ __forceinline__ void fp8_row(const float* src, unsigned char* dst, float* inv_scale, int lane) {
    f32x4 v[2][4]; float am = 0.f;
#pragma unroll
    for (int k = 0; k < 2; ++k)
#pragma unroll
        for (int i = 0; i < 4; ++i) { v[k][i] = *(const f32x4*)(src + 1024 * k + 16 * lane + 4 * i);
            am = fmaxf(am, fmaxf(fmaxf(fabsf(v[k][i].x), fabsf(v[k][i].y)), fmaxf(fabsf(v[k][i].z), fabsf(v[k][i].w)))); }
#pragma unroll
    for (int o = 1; o < 64; o <<= 1) am = fmaxf(am, __shfl_xor(am, o));
    int be = (__float_as_int(am) >> 23) & 255; be = be < 8 ? 8 : (be > 248 ? 248 : be);
    const float sc = __int_as_float((260 - be) << 23), isc = __int_as_float((be - 6) << 23);
#pragma unroll
    for (int k = 0; k < 2; ++k) { u32x4 w; unsigned ww[4];
#pragma unroll
        for (int i = 0; i < 4; ++i) { int t = 0; t = __builtin_amdgcn_cvt_pk_fp8_f32(v[k][i].x * sc, v[k][i].y * sc, t, false); t = __builtin_amdgcn_cvt_pk_fp8_f32(v[k][i].z * sc, v[k][i].w * sc, t, true); ww[i] = (unsigned)t; }
        w.x = ww[0]; w.y = ww[1]; w.z = ww[2]; w.w = ww[3];
        *(u32x4*)(dst + 1024 * k + 16 * lane) = w; }
    if (lane == 0) *inv_scale = isc;
}

__device__ __forceinline__ void fp8_row2(const float* s0, unsigned char* d0, float* i0, const float* s1, unsigned char* d1, float* i1, int lane) {
    f32x4 v[2][2][4]; float am[2] = {0.f, 0.f};
#pragma unroll
    for (int r = 0; r < 2; ++r)
#pragma unroll
        for (int k = 0; k < 2; ++k)
#pragma unroll
            for (int i = 0; i < 4; ++i) v[r][k][i] = __builtin_nontemporal_load((const f32x4*)((r ? s1 : s0) + 1024 * k + 16 * lane + 4 * i));
#pragma unroll
    for (int r = 0; r < 2; ++r) {
#pragma unroll
        for (int k = 0; k < 2; ++k)
#pragma unroll
            for (int i = 0; i < 4; ++i) am[r] = fmaxf(am[r], fmaxf(fmaxf(fabsf(v[r][k][i].x), fabsf(v[r][k][i].y)), fmaxf(fabsf(v[r][k][i].z), fabsf(v[r][k][i].w))));
#pragma unroll
        for (int o = 1; o < 64; o <<= 1) am[r] = fmaxf(am[r], __shfl_xor(am[r], o));
        int be = (__float_as_int(am[r]) >> 23) & 255; be = be < 8 ? 8 : (be > 248 ? 248 : be);
        const float sc = __int_as_float((260 - be) << 23), isc = __int_as_float((be - 6) << 23);
#pragma unroll
        for (int k = 0; k < 2; ++k) { u32x4 w; unsigned ww[4];
#pragma unroll
            for (int i = 0; i < 4; ++i) { int t = 0; t = __builtin_amdgcn_cvt_pk_fp8_f32(v[r][k][i].x * sc, v[r][k][i].y * sc, t, false); t = __builtin_amdgcn_cvt_pk_fp8_f32(v[r][k][i].z * sc, v[r][k][i].w * sc, t, true); ww[i] = (unsigned)t; }
            w.x = ww[0]; w.y = ww[1]; w.z = ww[2]; w.w = ww[3];
            *(u32x4*)((r ? d1 : d0) + 1024 * k + 16 * lane) = w; }
        if (lane == 0) *(r ? i1 : i0) = isc;
    }
}

__device__ __forceinline__ void tr_item(const float* W, int ldw, int srccol0, int k0, bf16_t* WT, int ldt, int n0, const float* kscale, const float* nscale, LAS float* scr, int lane) {
    float tv[32];
#pragma unroll
    for (int i = 0; i < 32; ++i) { const int kk = 2 * i + (lane >> 5); tv[i] = W[(size_t)(k0 + kk) * ldw + srccol0 + (lane & 31)]; }
    const float ns = nscale ? nscale[srccol0 + (lane & 31)] : 1.0f;
#pragma unroll
    for (int i = 0; i < 32; ++i) { const int kk = 2 * i + (lane >> 5); float v = tv[i] * ns;
        if (kscale) v *= kscale[k0 + kk]; scr[kk * 33 + (lane & 31)] = v; }
    asm volatile("s_waitcnt lgkmcnt(0)" ::: "memory");
    const int c = lane & 7;
#pragma unroll
    for (int j = 0; j < 4; ++j) { const int n = (lane >> 3) + 8 * j; const LAS float* s = scr + (8 * c) * 33 + n;
        u32x4 o; o.x = cvt_pk_bf16(s[0 * 33], s[1 * 33]); o.y = cvt_pk_bf16(s[2 * 33], s[3 * 33]); o.z = cvt_pk_bf16(s[4 * 33], s[5 * 33]); o.w = cvt_pk_bf16(s[6 * 33], s[7 * 33]);
        *(u32x4*)(WT + (size_t)(n0 + n) * ldt + k0 + 8 * c) = o; }
    asm volatile("s_waitcnt lgkmcnt(0)" ::: "memory");
}
__device__ __forceinline__ int win_srccol(int n) { const int pn = n >> 8, w = n & 255; return pn < 4 ? n : ((w >> 7) ? 2048 : 1024) + (pn - 4) * 128 + (w & 127); }

__device__ __forceinline__ void phase_prep(const Params& p, LAS unsigned char* lds, int bid, int nb) {
    const int tid = threadIdx.x, lane = tid & 63, wave = tid >> 6;
    const int gw = bid * 8 + wave, NGW = nb * 8;
    LAS float* scr = (LAS float*)(lds + wave * 8448);
    for (int r = gw; r < RT; r += NGW) {
        unsigned long long* o8 = (unsigned long long*)(p.hnb + (size_t)r * D) + lane;
        if (r < RPAD) {
#pragma unroll
            for (int j = 0; j < 8; ++j) o8[64 * j] = 0ull;
        } else {
            const f32x4* xr = (const f32x4*)hrow(p, r - RPAD) + lane;
            const f32x4* gr = (const f32x4*)p.mix_g + lane;
            f32x4 v[8]; float s = 0.f;
#pragma unroll
            for (int j = 0; j < 8; ++j) { v[j] = __builtin_nontemporal_load(xr + 64 * j); s += (v[j].x * v[j].x + v[j].y * v[j].y) + (v[j].z * v[j].z + v[j].w * v[j].w); }
            const float rs = rsqrtf(wave_sum(s) * (1.0f / D) + 1e-6f);
#pragma unroll
            for (int j = 0; j < 8; ++j) { const f32x4 gv = gr[64 * j];
                o8[64 * j] = (unsigned long long)cvt_pk_bf16(v[j].x * rs * gv.x, v[j].y * rs * gv.y) | ((unsigned long long)cvt_pk_bf16(v[j].z * rs * gv.z, v[j].w * rs * gv.w) << 32); }
        }
    }
    for (int it = gw; it < (D / 64) * (INW / 32); it += NGW) {
        const int kb = it / (INW / 32), nbk = it % (INW / 32);
        tr_item(p.w_in, INW, win_srccol(nbk * 32), kb * 64, p.w_in_t, D, nbk * 32, nullptr, nullptr, scr, lane);
    }
    for (int i = gw * 64 + lane; i < 4 * 256 * 256 / 4; i += NGW * 64) { const f32x4 v = ((const f32x4*)p.pool_w)[i];
        const int g = i >> 14, d = (i & 63) * 4; const f32x4 sc = *(const f32x4*)(p.pool_scale + g * 256 + d);
        u32x2 w; w.x = cvt_pk_bf16(v[0] * sc[0], v[1] * sc[1]); w.y = cvt_pk_bf16(v[2] * sc[2], v[3] * sc[3]); ((u32x2*)p.pool_ws)[i] = w; }
    for (int i = gw * 64 + lane; i < CWD * CWD / 4; i += NGW * 64) { const f32x4 v = ((const f32x4*)p.pw_w)[i];
        u32x2 w; w.x = cvt_pk_bf16(v[0], v[1]); w.y = cvt_pk_bf16(v[2], v[3]); ((u32x2*)p.pw_b16)[i] = w; }
    if (gw < D / 64) { const int n = gw * 64 + lane; float a0 = 0.f, a1 = 0.f, a2 = 0.f, a3 = 0.f;
        for (int j = 0; j < CWD; j += 4) { a0 += p.pw_b[j] * p.w_out[(size_t)(PWD + j) * D + n]; a1 += p.pw_b[j + 1] * p.w_out[(size_t)(PWD + j + 1) * D + n];
            a2 += p.pw_b[j + 2] * p.w_out[(size_t)(PWD + j + 2) * D + n]; a3 += p.pw_b[j + 3] * p.w_out[(size_t)(PWD + j + 3) * D + n]; }
        p.bias_eff[n] = (a0 + a1) + (a2 + a3); }
    for (int it = gw; it < 32 * 64; it += NGW) { const int kb = it >> 6, nbk = it & 63;
        tr_item(p.w_out, D, nbk * 32, kb * 64, p.w_out_t, D, nbk * 32, nullptr, nullptr, scr, lane); }
    for (int it = gw; it < 32 * 64; it += NGW) { const int kb = it >> 6, nbk = it & 63;
        tr_item(p.wq, D, nbk * 32, kb * 64, p.wq_t, D, nbk * 32, p.ffn_g, nullptr, scr, lane); }
    for (int i = gw * 64 + lane; i < 8 * 2 * 128 * 128 / 4; i += NGW * 64) { const f32x4 v = ((const f32x4*)p.keys)[i];
        u32x2 w; w.x = cvt_pk_bf16(v[0], v[1]); w.y = cvt_pk_bf16(v[2], v[3]); ((u32x2*)p.keysb)[i] = w; }
    for (int e = gw; e < 16384; e += NGW)
        fp8_row2(p.down + (size_t)e * D, p.down8 + (size_t)e * D, p.sdn + e, p.up + (size_t)e * D, p.up8 + (size_t)e * D, p.sup + e, lane);
}


#define XB_TMO      128
#define XB_XCNT(j)  (256  + 64 * (j))
#define XB_XSUB(j)  (1280 + 64 * (j))
#define XB_XGEN(j)  (2304 + 64 * (j))
#define XB_TOP      3328
#define XB_TOPGEN   3392
#define XCD_BAR_WORDS 3456
#define XB_SPIN_CAP (1u << 18)
__device__ __forceinline__ unsigned xb_ld(unsigned* p)              { return __hip_atomic_load(p, __ATOMIC_RELAXED, __HIP_MEMORY_SCOPE_AGENT); }
__device__ __forceinline__ unsigned xb_add(unsigned* p, unsigned v) { return __hip_atomic_fetch_add(p, v, __ATOMIC_RELAXED, __HIP_MEMORY_SCOPE_AGENT); }
__device__ __forceinline__ unsigned xb_xcc_id() { return (unsigned)__builtin_amdgcn_s_getreg((3 << 11) | 20) & 0xFu; }
#define XB_SPIN(cond, bar) do { unsigned _sp = 0; while (cond) { __builtin_amdgcn_s_sleep(1); \
    if ((++_sp & 255u) == 0u) { if (xb_ld(&(bar)[XB_TMO])) break; if (_sp > XB_SPIN_CAP) { atomicAdd(&(bar)[XB_TMO], 1u); break; } } } } while (0)
struct XcdBarrier { unsigned* bar; unsigned x; volatile LAS unsigned* st; };
__device__ __forceinline__ XcdBarrier xcd_barrier_post(unsigned* bar, volatile LAS unsigned* st) {
    XcdBarrier b; b.bar = bar; b.x = xb_xcc_id(); b.st = st;
    if (threadIdx.x == 0) (void)xb_add(&bar[XB_XCNT(b.x)], 1u);
    return b;
}
__device__ __forceinline__ void xcd_barrier_complete(unsigned* bar, unsigned x, unsigned& nloc, unsigned& nx) {
    const unsigned G = gridDim.x * gridDim.y * gridDim.z;
    unsigned sum, cnt, mine, sp = 0u;
    for (;;) {
        sum = 0u; cnt = 0u; mine = 0u;
#pragma unroll
        for (unsigned j = 0; j < 16; ++j) { const unsigned c = xb_ld(&bar[XB_XCNT(j)]); sum += c; cnt += (c > 0u) ? 1u : 0u; mine = (j == x) ? c : mine; }
        if (sum == G) break;
        __builtin_amdgcn_s_sleep(1);
        if ((++sp & 255u) == 0u) { if (xb_ld(&bar[XB_TMO])) break; if (sp > XB_SPIN_CAP) { atomicAdd(&bar[XB_TMO], 1u); break; } }
    }
    nloc = mine > 0u ? mine : 1u; nx = cnt > 0u ? cnt : 1u;
}
__device__ __forceinline__ void xcd_barrier(const XcdBarrier& b) {
    asm volatile("s_waitcnt vmcnt(0)" ::: "memory");
    __syncthreads();
    if (threadIdx.x == 0) {
        unsigned* bar = b.bar;
        __builtin_amdgcn_s_waitcnt(0);
        unsigned nloc = b.st[0], nx = b.st[1];
        if (nloc == 0u) { xcd_barrier_complete(bar, b.x, nloc, nx); b.st[0] = nloc; b.st[1] = nx; }
        const unsigned old = xb_add(&bar[XB_XSUB(b.x)], 1u);
        const unsigned gen = old / nloc;
        if (old + 1u == (gen + 1u) * nloc) {
            __builtin_amdgcn_fence(__ATOMIC_RELEASE, "agent");
            asm volatile("s_waitcnt vmcnt(0)" ::: "memory");
            const unsigned og = xb_add(&bar[XB_TOP], 1u);
            const unsigned tg = og / nx;
            if (og + 1u == (tg + 1u) * nx) xb_add(&bar[XB_TOPGEN], 1u);
            else XB_SPIN(xb_ld(&bar[XB_TOPGEN]) == tg, bar);
            __builtin_amdgcn_fence(__ATOMIC_ACQUIRE, "agent");
            xb_add(&bar[XB_XGEN(b.x)], 1u);
            asm volatile("s_waitcnt vmcnt(0)" ::: "memory");
        } else {
            XB_SPIN(xb_ld(&bar[XB_XGEN(b.x)]) == gen, bar);
            __builtin_amdgcn_fence(__ATOMIC_ACQUIRE, "agent");
            asm volatile("s_waitcnt vmcnt(0)" ::: "memory");
        }
    }
    __syncthreads();
}

__global__ void __launch_bounds__(NT, 2) k_mega(Params p) {
    extern __shared__ __attribute__((aligned(16))) unsigned char lds_raw[];
    LAS unsigned char* lds = (LAS unsigned char*)lds_raw;
    const int bid = blockIdx.x, nb = gridDim.x;
    volatile LAS unsigned* bst = (volatile LAS unsigned*)(lds + LDS_BYTES - 16);
    if (threadIdx.x < 4) bst[threadIdx.x] = 0u;
    __syncthreads();
    const XcdBarrier xb = xcd_barrier_post(p.bar, bst);
    phase_prep(p, lds, bid, nb);
    xcd_barrier(xb);
    { pg8::Gemm g{p.hnb, p.w_in_t, D, D, D, 0}; pg8::StaticOrder S; S.init(RT / 256, INW / 256, nb, bid); EpiProj E{p.xp, p.glu};
      pg8::gemm_phase<EpiProj, pg8::StaticOrder>(lds, g, S, E); }
    { const int nproj = (RT / 256) * (INW / 256); const int first = (nproj > nb && nproj < 2 * nb) ? nproj - nb : 0, nfree = nb - first;
      for (int uu = bid - first; uu >= 0 && uu < 64; uu += nfree) {
        __syncthreads();
        const bool pw = uu < 32;
        pg8::Gemm g{pw ? p.w_out_t + PWD : p.w_out_t, pw ? p.pw_b16 : p.pool_ws, D, pw ? CWD : 256, pw ? CWD : 256, pw ? 0 : 256};
        pg8::OneUnit S; S.u.pm = (uu & 31) >> 2; S.u.pn = uu & 3; EpiBf16Out E{p.w_eff_t, D, pw ? PWD : 0, nullptr};
        pg8::gemm_phase<EpiBf16Out, pg8::OneUnit>(lds, g, S, E);
      }
    }
    xcd_barrier(xb);
    phase_mix(p, lds, bid, nb);
    xcd_barrier(xb);
    { pg8::Gemm g{p.mixb, p.w_eff_t, D, D, D, 0}; pg8::StaticOrder S; S.init(SEQ / 256, D / 256, nb, bid); EpiResid E{p.x, p.bias_eff, p.h2b, p.ssq};
      pg8::gemm_phase<EpiResid, pg8::StaticOrder>(lds, g, S, E); }
    xcd_barrier(xb);
    { pg8::Gemm g{p.h2b, p.wq_t, D, D, D, 0}; pg8::StaticOrder S; S.init(SEQ / 256, D / 256, nb, bid); EpiQTopk E{p.ssq, p.rstd, p.keysb, p.idx, p.gsu};
      pg8::gemm_phase<EpiQTopk, pg8::StaticOrder>(lds, g, S, E); }
    xcd_barrier(xb);
    phase_pd(p, bid, nb);
    xcd_barrier(xb);
    phase_pa(p, bid, nb);
    xcd_barrier(xb);
    phase_pu(p, bid, nb);
    xcd_barrier(xb);
    phase_pf(p, bid, nb);
}

extern "C" void kernel_launch(void* const* d_in, const int* in_sizes, int n_in, void* d_out, int out_size, void* d_ws, size_t ws_size, hipStream_t stream) {
    Params p{};
    p.x = (const float*)d_in[0]; p.meta = (const float*)d_in[1]; p.mix_g = (const float*)d_in[2]; p.w_in = (const float*)d_in[3];
    p.pool_w = (const float*)d_in[4]; p.pool_scale = (const float*)d_in[5]; p.dw_w = (const float*)d_in[6]; p.dw_b = (const float*)d_in[7];
    p.ln_g = (const float*)d_in[8]; p.ln_b = (const float*)d_in[9]; p.pw_w = (const float*)d_in[10]; p.pw_b = (const float*)d_in[11];
    p.w_out = (const float*)d_in[12]; p.ffn_g = (const float*)d_in[13]; p.wq = (const float*)d_in[14]; p.keys = (const float*)d_in[15];
    p.down = (const float*)d_in[16]; p.up = (const float*)d_in[17]; p.fin_g = (const float*)d_in[18];
    p.out = (float*)d_out;
    char* w = (char*)d_ws; size_t off = 0;
    auto take = [&](size_t bytes) { char* r = w + off; off += (bytes + 255) & ~(size_t)255; return r; };
    p.idx = (unsigned short*)take((size_t)SEQ * 128 * 2);
    p.gsu = (float*)take((size_t)SEQ * 128 * 4);
    p.part = (bf16_t*)take((size_t)SEQ * 16 * 128 * 2);
    p.act = (bf16_t*)take((size_t)SEQ * 128 * 2);
    p.ssq2 = (float*)take((size_t)SEQ * 16 * 4);
    p.h3b = (bf16_t*)take((size_t)SEQ * D * 2);
    p.hnb = (bf16_t*)take((size_t)RT * D * 2);
    p.w_in_t = (bf16_t*)take((size_t)INW * D * 2);
    p.xp = (bf16_t*)take((size_t)RT * PWD * 2);
    p.glu = (bf16_t*)take((size_t)RT * CWD * 2);
    p.mixb = (bf16_t*)take((size_t)SEQ * D * 2);
    p.h2b = (bf16_t*)take((size_t)SEQ * D * 2);
    p.pool_ws = (bf16_t*)take((size_t)4 * 256 * 256 * 2);
    p.pw_b16 = (bf16_t*)take((size_t)CWD * CWD * 2);
    p.w_eff_t = (bf16_t*)take((size_t)D * D * 2);
    p.bias_eff = (float*)take((size_t)D * 4);
    p.w_out_t = (bf16_t*)take((size_t)D * D * 2);
    p.ssq = (float*)take((size_t)SEQ * 32 * 4);
    p.bar = (unsigned*)take((size_t)XCD_BAR_WORDS * 4);
    p.rstd = (float*)take((size_t)SEQ * 4);
    p.wq_t = (bf16_t*)take((size_t)D * D * 2);
    p.keysb = (bf16_t*)take((size_t)8 * 2 * 128 * 128 * 2);
    p.qb = (bf16_t*)take((size_t)SEQ * D * 2);
    p.down8 = (unsigned char*)take((size_t)16384 * D);
    p.up8 = (unsigned char*)take((size_t)16384 * D);
    p.sdn = (float*)take((size_t)16384 * 4);
    p.sup = (float*)take((size_t)16384 * 4);
    static int grid_blocks = 0;
    if (!grid_blocks) {
        int dev = 0, cus = 0, per_cu = 0;
        (void)hipGetDevice(&dev);
        (void)hipDeviceGetAttribute(&cus, hipDeviceAttributeMultiprocessorCount, dev);
        (void)hipFuncSetAttribute((const void*)k_mega, hipFuncAttributeMaxDynamicSharedMemorySize, LDS_BYTES);
        (void)hipOccupancyMaxActiveBlocksPerMultiprocessor(&per_cu, k_mega, NT, LDS_BYTES);
        if (per_cu < 1) { fprintf(stderr, "occupancy query says %d workgroups per CU: nothing launched\n", per_cu); grid_blocks = -1; }
        else if (cus != (SEQ / 256) * (D / 256)) { fprintf(stderr, "this build needs a %d-CU device (got %d): nothing launched\n", (SEQ / 256) * (D / 256), cus); grid_blocks = -1; }
        else grid_blocks = cus;
    }
    if (grid_blocks < 0) return;
    (void)hipMemsetAsync(p.bar, 0, (size_t)XCD_BAR_WORDS * 4, stream);
    void* args[] = {&p};
    hipError_t e = hipLaunchCooperativeKernel((void*)k_mega, dim3(grid_blocks), dim3(NT), args, LDS_BYTES, stream);
    if (e != hipSuccess) fprintf(stderr, "cooperative launch failed: %s (grid %d)\n", hipGetErrorString(e), grid_blocks);
}
```

```cpp
#include <hip/hip_runtime.h>
#include <hip/hip_cooperative_groups.h>
#include <stdint.h>
#include <cstdio>
namespace cg = cooperative_groups;

#define NT 512
#define LAS __attribute__((address_space(3)))
typedef unsigned short bf16_t;
typedef short bf16x8 __attribute__((ext_vector_type(8)));
typedef float f32x4 __attribute__((ext_vector_type(4)));
typedef unsigned u32x4 __attribute__((ext_vector_type(4)));
typedef unsigned u32x2 __attribute__((ext_vector_type(2)));

constexpr int D = 2048, SEQ = 8192, NMETA = 16, T = SEQ + NMETA;
constexpr int PWD = 1024, CWD = 1024, INW = 3072;
constexpr int KS = 31;
constexpr int RPAD = 240, RT = 8448;
constexpr int LDS_BYTES = 151552;

struct Params {
    const float *x, *meta, *mix_g, *w_in, *pool_w, *pool_scale, *dw_w, *dw_b, *ln_g, *ln_b, *pw_w, *pw_b, *w_out, *ffn_g, *wq, *keys, *down, *up, *fin_g;
    float* out;
    unsigned short* idx;
    unsigned* bar;
    bf16_t *hnb, *w_in_t, *xp, *glu, *mixb, *h2b, *pool_ws, *pw_b16, *w_eff_t, *w_out_t, *wq_t, *keysb, *qb;
    unsigned char *down8, *up8;
    float *sdn, *sup;
    float *gsu;
    bf16_t* part;
    bf16_t* act;
    float* ssq2;
    bf16_t* h3b;
    float *ssq, *rstd, *bias_eff;
};

__device__ __forceinline__ unsigned cvt_pk_bf16(float lo, float hi) { unsigned r; asm volatile("v_cvt_pk_bf16_f32 %0, %1, %2" : "=v"(r) : "v"(lo), "v"(hi)); return r; }
__device__ __forceinline__ float wave_sum(float v) {
#pragma unroll
    for (int o = 1; o < 64; o <<= 1) v += __shfl_xor(v, o);
    return v;
}

__device__ __forceinline__ const float* hrow(const Params& p, int t) { return t < NMETA ? p.meta + (size_t)t * D : p.x + (size_t)(t - NMETA) * D; }

__device__ __forceinline__ float block_sum(float v, float* red) {
#pragma unroll
    for (int o = 32; o; o >>= 1) v += __shfl_xor(v, o);
    __syncthreads();
    if ((threadIdx.x & 63) == 0) red[threadIdx.x >> 6] = v;
    __syncthreads();
    float s = 0.f;
#pragma unroll
    for (int i = 0; i < NT / 64; ++i) s += red[i];
    return s;
}

namespace pg8 {
constexpr int BM = 256, BK = 64, HALF = 128, HTB = HALF * BK * 2, STAGE_BYTES = 8 * HTB, NXCD = 8, WGM = 8;
__device__ __forceinline__ int lds_byte(int r, int c) { const int st = (r >> 4) * 2 + (c >> 5), rr = r & 15, cc = c & 31, ob = rr * 64 + cc * 2; return st * 1024 + (ob ^ (((ob >> 9) & 1) << 5)); }
__device__ __forceinline__ void stage_rc(int b, int& R, int& C) { const int st = b / 1024, sb = b % 1024, swz = sb ^ (((sb >> 9) & 1) << 5); R = (st >> 1) * 16 + swz / 64; C = (st & 1) * 32 + (swz % 64) / 2; }
struct Unit { int pm, pn; };
struct Gemm { const bf16_t* A; const bf16_t* Bt; int lda, ldb, K; int a_col_per_pn; };
struct StaticOrder {
    int nM, nN, nwg, G, c;
    __device__ void init(int nM_, int nN_, int G_, int c_) { nM = nM_; nN = nN_; nwg = nM * nN; G = G_; c = c_; }
    __device__ bool next(int i, Unit& u) const {
        const long L = (long)i * G + c; if (L >= nwg) return false;
        int wgid = (int)L; { const int q = nwg / NXCD, r = nwg % NXCD, xcd = wgid % NXCD, off = wgid / NXCD; wgid = (xcd < r ? xcd * (q + 1) : r * (q + 1) + (xcd - r) * q) + off; }
        const int nig = WGM * nN, gid = wgid / nig, fm = gid * WGM, gsz = (nM - fm) < WGM ? (nM - fm) : WGM;
        u.pm = fm + ((wgid % nig) % gsz); u.pn = (wgid % nig) / gsz; return true;
    }
};
struct OneUnit { Unit u; __device__ bool next(int i, Unit& o) const { if (i) return false; o = u; return true; } };
template <class Epi, class Sched>
__device__ __forceinline__ void gemm_phase(LAS unsigned char* lds, const Gemm g, const Sched& S, const Epi& E) {
    const int tid = threadIdx.x, wid = __builtin_amdgcn_readfirstlane(tid >> 6), lane = tid & 63, wr = wid >> 2, wc = wid & 3, fr = lane & 15, fq = lane >> 4;
    const int K = g.K, nt = K / BK;
    unsigned voffA[2], voffB[2];
#pragma unroll
    for (int i = 0; i < 2; ++i) { int R, C; stage_rc(tid * 16 + i * 8192, R, C);
        voffA[i] = (unsigned)(R * g.lda + C) * 2u; voffB[i] = (unsigned)(R * g.ldb + C) * 2u; }
    const size_t kstep = (size_t)(BK * 2);
    const size_t hstepA = (size_t)HALF * g.lda * 2, hstepB = (size_t)HALF * g.ldb * 2;
    const size_t tstepA = 2 * hstepA, tstepB = 2 * hstepB;
    const unsigned ldsw = (unsigned)wid * 1024u;
    const int aoff = lds_byte(wr * 64 + fr, fq * 8), boff = lds_byte(wc * 32 + fr, fq * 8);
#define PG8_SA(b, h) (((b) * 2 + (h)) * HTB)
#define PG8_SB(b, h) ((4 + (b) * 2 + (h)) * HTB)
#define PG8_STAGE(bufoff, gbase, voff) do { _Pragma("unroll") for (int _i = 0; _i < 2; ++_i) \
        __builtin_amdgcn_global_load_lds((const unsigned*)((const char*)(gbase) + (voff)[_i]), (LAS unsigned*)(lds + (bufoff) + ldsw + _i * 8192), 16, 0, 0); } while (0)
#define PG8_LDA(dst, b, h) do { _Pragma("unroll") for (int m = 0; m < 4; ++m) _Pragma("unroll") for (int k = 0; k < 2; ++k) dst[m][k] = *(const LAS bf16x8*)(lds + PG8_SA(b, h) + aoff + m * 2048 + k * 1024); } while (0)
#define PG8_LDB(dst, b, h) do { _Pragma("unroll") for (int n = 0; n < 2; ++n) _Pragma("unroll") for (int k = 0; k < 2; ++k) dst[n][k] = *(const LAS bf16x8*)(lds + PG8_SB(b, h) + boff + n * 2048 + k * 1024); } while (0)
#define PG8_MMA(ai, bj, At, Bt) do { __builtin_amdgcn_s_setprio(1); _Pragma("unroll") for (int m = 0; m < 4; ++m) _Pragma("unroll") for (int n = 0; n < 2; ++n) _Pragma("unroll") for (int k = 0; k < 2; ++k) \
        acc[ai][bj][m][n] = __builtin_amdgcn_mfma_f32_16x16x32_bf16(Bt[n][k], At[m][k], acc[ai][bj][m][n], 0, 0, 0); __builtin_amdgcn_s_setprio(0); } while (0)
#define PG8_WAIT_V(n) asm volatile("s_waitcnt vmcnt(" #n ")" ::: "memory")
#define PG8_WAIT_L(n) asm volatile("s_waitcnt lgkmcnt(" #n ")" ::: "memory")
#define PG8_BAR __builtin_amdgcn_s_barrier()
#define PG8_SCHED __builtin_amdgcn_sched_barrier(0)
    Unit cur, nxt; int ui = 0;
    if (!S.next(0, cur)) return;
    f32x4 acc[2][2][4][2];
#pragma unroll
    for (int a = 0; a < 2; ++a)
#pragma unroll
        for (int b = 0; b < 2; ++b)
#pragma unroll
            for (int m = 0; m < 4; ++m)
#pragma unroll
                for (int n = 0; n < 2; ++n) acc[a][b][m][n] = (f32x4){0.f, 0.f, 0.f, 0.f};
    bf16x8 At[4][2], B0[2][2], B1[2][2];
    const char* cA = (const char*)g.A + (size_t)cur.pm * tstepA + (size_t)cur.pn * g.a_col_per_pn * 2; const char* cB = (const char*)g.Bt + (size_t)cur.pn * tstepB;
    PG8_STAGE(PG8_SB(0, 0), cB, voffB); PG8_STAGE(PG8_SA(0, 0), cA, voffA); PG8_STAGE(PG8_SB(0, 1), cB + hstepB, voffB); PG8_STAGE(PG8_SA(0, 1), cA + hstepA, voffA);
    if (wr == 1) PG8_BAR;
    PG8_WAIT_V(4); PG8_BAR;
    PG8_STAGE(PG8_SB(1, 0), cB + kstep, voffB); PG8_STAGE(PG8_SA(1, 0), cA + kstep, voffA); PG8_STAGE(PG8_SB(1, 1), cB + hstepB + kstep, voffB);
    PG8_WAIT_V(6); PG8_BAR;
    for (;;) {
        const bool has_next = S.next(ui + 1, nxt);
        const char* nA = has_next ? (const char*)g.A + (size_t)nxt.pm * tstepA + (size_t)nxt.pn * g.a_col_per_pn * 2 : cA; const char* nB = has_next ? (const char*)g.Bt + (size_t)nxt.pn * tstepB : cB;
        for (int t = 0; t < nt; t += 2) {
            const bool last = (t == nt - 2);
            const char* a1 = cA + (size_t)(t + 1) * kstep;
            const char* a2 = last ? nA : cA + (size_t)(t + 2) * kstep; const char* b2 = last ? nB : cB + (size_t)(t + 2) * kstep;
            const char* a3 = a2 + kstep; const char* b3 = b2 + kstep;
            PG8_LDB(B0, 0, 0); PG8_SCHED; PG8_LDA(At, 0, 0); PG8_STAGE(PG8_SA(1, 1), a1 + hstepA, voffA);
            PG8_WAIT_L(8); PG8_BAR; PG8_WAIT_L(0); PG8_MMA(0, 0, At, B0); PG8_BAR; PG8_SCHED;
            PG8_LDB(B1, 0, 1); PG8_STAGE(PG8_SB(0, 0), b2, voffB);
            PG8_BAR; PG8_WAIT_L(0); PG8_MMA(0, 1, At, B1); PG8_BAR;
            PG8_LDA(At, 0, 1); PG8_STAGE(PG8_SA(0, 0), a2, voffA);
            PG8_BAR; PG8_WAIT_L(0); PG8_MMA(1, 0, At, B0); PG8_BAR; PG8_SCHED;
            PG8_STAGE(PG8_SB(0, 1), b2 + hstepB, voffB);
            PG8_WAIT_V(6); PG8_BAR; PG8_MMA(1, 1, At, B1); PG8_BAR;
            PG8_LDB(B0, 1, 0); PG8_SCHED; PG8_LDA(At, 1, 0); PG8_STAGE(PG8_SA(0, 1), a2 + hstepA, voffA);
            PG8_WAIT_L(8); PG8_BAR; PG8_WAIT_L(0); PG8_MMA(0, 0, At, B0); PG8_BAR; PG8_SCHED;
            PG8_LDB(B1, 1, 1); PG8_STAGE(PG8_SB(1, 0), b3, voffB);
            PG8_BAR; PG8_WAIT_L(0); PG8_MMA(0, 1, At, B1); PG8_BAR;
            PG8_LDA(At, 1, 1); PG8_STAGE(PG8_SA(1, 0), a3, voffA);
            PG8_BAR; PG8_WAIT_L(0); PG8_MMA(1, 0, At, B0); PG8_BAR; PG8_SCHED;
            PG8_STAGE(PG8_SB(1, 1), b3 + hstepB, voffB);
            PG8_WAIT_V(6); PG8_BAR; PG8_MMA(1, 1, At, B1); PG8_BAR;
        }
        if constexpr (!Epi::AFTER_DRAIN) E(acc, cur, wr, wc, fr, fq);
        if (!has_next) break;
#pragma unroll
        for (int a = 0; a < 2; ++a)
#pragma unroll
            for (int b = 0; b < 2; ++b)
#pragma unroll
                for (int m = 0; m < 4; ++m)
#pragma unroll
                    for (int n = 0; n < 2; ++n) acc[a][b][m][n] = (f32x4){0.f, 0.f, 0.f, 0.f};
        cur = nxt; cA = nA; cB = nB; ++ui;
    }
    PG8_WAIT_V(0);
    if (wr == 0) PG8_BAR;
    PG8_BAR;
    if constexpr (Epi::AFTER_DRAIN) E.fused(acc, cur, wr, wc, fr, fq, lds, wid, lane);
#undef PG8_SA
#undef PG8_SB
#undef PG8_STAGE
#undef PG8_LDA
#undef PG8_LDB
#undef PG8_MMA
#undef PG8_WAIT_V
#undef PG8_WAIT_L
#undef PG8_BAR
#undef PG8_SCHED
}
}

struct EpiProjF32 {
    static constexpr bool AFTER_DRAIN = false;
    float* proj;
    __device__ __forceinline__ void operator()(const f32x4 (&acc)[2][2][4][2], const pg8::Unit& u, int wr, int wc, int fr, int fq) const {
#pragma unroll
        for (int ai = 0; ai < 2; ++ai)
#pragma unroll
            for (int m = 0; m < 4; ++m) {
                const int t = u.pm * 256 + ai * 128 + wr * 64 + m * 16 + fr - RPAD;
                if (t >= 0) {
#pragma unroll
                    for (int bj = 0; bj < 2; ++bj)
#pragma unroll
                        for (int n = 0; n < 2; ++n) {
                            const int off = wc * 32 + n * 16 + fq * 4;
                            const int col = u.pn < 4 ? u.pn * 256 + bj * 128 + off : (bj ? 2048 : 1024) + (u.pn - 4) * 128 + off;
                            *(f32x4*)(proj + (size_t)t * INW + col) = acc[ai][bj][m][n];
                        }
                }
            }
    }
};


__device__ __forceinline__ float sigmoidf_fast(float x) { return __builtin_amdgcn_rcpf(1.0f + __expf(-x)); }

struct EpiProj {
    static constexpr bool AFTER_DRAIN = false;
    bf16_t* xp; bf16_t* glu;
    __device__ __forceinline__ void operator()(const f32x4 (&acc)[2][2][4][2], const pg8::Unit& u, int wr, int wc, int fr, int fq) const {
#pragma unroll
        for (int ai = 0; ai < 2; ++ai)
#pragma unroll
            for (int m = 0; m < 4; ++m) {
                const size_t row = (size_t)(u.pm * 256 + ai * 128 + wr * 64 + m * 16 + fr);
                if (u.pn < 4) {
#pragma unroll
                    for (int bj = 0; bj < 2; ++bj)
#pragma unroll
                        for (int n = 0; n < 2; ++n) { const f32x4 v = acc[ai][bj][m][n]; u32x2 w; w.x = cvt_pk_bf16(v[0], v[1]); w.y = cvt_pk_bf16(v[2], v[3]);
                            *(u32x2*)(xp + row * PWD + u.pn * 256 + bj * 128 + wc * 32 + n * 16 + fq * 4) = w; }
                } else {
#pragma unroll
                    for (int n = 0; n < 2; ++n) { const f32x4 a = acc[ai][0][m][n], g = acc[ai][1][m][n]; u32x2 w;
                        w.x = cvt_pk_bf16(a[0] * sigmoidf_fast(g[0]), a[1] * sigmoidf_fast(g[1])); w.y = cvt_pk_bf16(a[2] * sigmoidf_fast(g[2]), a[3] * sigmoidf_fast(g[3]));
                        *(u32x2*)(glu + row * CWD + (u.pn - 4) * 128 + wc * 32 + n * 16 + fq * 4) = w; }
                }
            }
    }
};
struct EpiBf16Out {
    static constexpr bool AFTER_DRAIN = false;
    bf16_t* O; int ldc; int col0; const float* bias;
    __device__ __forceinline__ void operator()(const f32x4 (&acc)[2][2][4][2], const pg8::Unit& u, int wr, int wc, int fr, int fq) const {
#pragma unroll
        for (int ai = 0; ai < 2; ++ai)
#pragma unroll
            for (int m = 0; m < 4; ++m) {
                const size_t row = (size_t)(u.pm * 256 + ai * 128 + wr * 64 + m * 16 + fr);
#pragma unroll
                for (int bj = 0; bj < 2; ++bj)
#pragma unroll
                    for (int n = 0; n < 2; ++n) { const int c = u.pn * 256 + bj * 128 + wc * 32 + n * 16 + fq * 4; f32x4 v = acc[ai][bj][m][n];
                        if (bias) v += *(const f32x4*)(bias + c);
                        u32x2 w; w.x = cvt_pk_bf16(v[0], v[1]); w.y = cvt_pk_bf16(v[2], v[3]);
                        *(u32x2*)(O + row * ldc + col0 + c) = w; }
            }
    }
};
struct EpiResid {
    static constexpr bool AFTER_DRAIN = false;
    const float* x; const float* bias; bf16_t* h2b; float* ssq;
    __device__ __forceinline__ void operator()(const f32x4 (&acc)[2][2][4][2], const pg8::Unit& u, int wr, int wc, int fr, int fq) const {
#pragma unroll
        for (int ai = 0; ai < 2; ++ai)
#pragma unroll
            for (int m = 0; m < 4; ++m) {
                const size_t row = (size_t)(u.pm * 256 + ai * 128 + wr * 64 + m * 16 + fr);
                float ss = 0.f;
#pragma unroll
                for (int bj = 0; bj < 2; ++bj)
#pragma unroll
                    for (int n = 0; n < 2; ++n) { const int c = u.pn * 256 + bj * 128 + wc * 32 + n * 16 + fq * 4;
                        const f32x4 v = acc[ai][bj][m][n] + *(const f32x4*)(x + row * D + c) + *(const f32x4*)(bias + c);
                        u32x2 w; w.x = cvt_pk_bf16(v[0], v[1]); w.y = cvt_pk_bf16(v[2], v[3]);
                        *(u32x2*)(h2b + row * D + c) = w;
                        ss += (v[0] * v[0] + v[1] * v[1]) + (v[2] * v[2] + v[3] * v[3]); }
                ss += __shfl_xor(ss, 16); ss += __shfl_xor(ss, 32);
                if (fq == 0) ssq[row * 32 + u.pn * 4 + wc] = ss;
            }
    }
};

__device__ __forceinline__ float fsel(int mask, float a, float b) { return __int_as_float((__float_as_int(a) & ~mask) | (__float_as_int(b) & mask)); }
__device__ __forceinline__ float bf_lo(unsigned w) { return __uint_as_float(w << 16); }
__device__ __forceinline__ float bf_hi(unsigned w) { return __uint_as_float(w & 0xffff0000u); }

__device__ __forceinline__ u32x4 bload16(__amdgpu_buffer_rsrc_t r, int voff, int soff) { return __builtin_bit_cast(u32x4, __builtin_amdgcn_raw_buffer_load_b128(r, voff, soff, 0)); }
__device__ __forceinline__ unsigned bload4(__amdgpu_buffer_rsrc_t r, int voff, int soff) { return (unsigned)__builtin_amdgcn_raw_buffer_load_b32(r, voff, soff, 0); }
__device__ __forceinline__ void bstore4(__amdgpu_buffer_rsrc_t r, unsigned v, int voff, int soff) { __builtin_amdgcn_raw_buffer_store_b32(v, r, voff, soff, 0); }
__device__ __forceinline__ u32x2 bload8(__amdgpu_buffer_rsrc_t r, int voff, int soff) { return __builtin_bit_cast(u32x2, __builtin_amdgcn_raw_buffer_load_b64(r, voff, soff, 0)); }
template <int W> __device__ __forceinline__ void pool_tile(__amdgpu_buffer_rsrc_t rxp, __amdgpu_buffer_rsrc_t rpo, int r0, int tile, int tid) {
    unsigned v[32 + W - 1];
#pragma unroll
    for (int i = 0; i < 32 + W - 1; ++i) v[i] = bload4(rxp, tid * 4, (r0 - (W - 1) + i) * 2048);
    float s0 = 0.f, s1 = 0.f;
#pragma unroll
    for (int i = 0; i < W - 1; ++i) { s0 += bf_lo(v[i]); s1 += bf_hi(v[i]); }
    constexpr float inv = 1.0f / (float)W;
#pragma unroll
    for (int i = 0; i < 32; ++i) {
        const float a0 = bf_lo(v[W - 1 + i]), a1 = bf_hi(v[W - 1 + i]);
        s0 += a0; s1 += a1;
        bstore4(rpo, cvt_pk_bf16(s0 * inv - a0, s1 * inv - a1), tid * 4, (tile * 32 + i) * 4096);
        s0 -= bf_lo(v[i]); s1 -= bf_hi(v[i]);
    }
}
__device__ __forceinline__ void phase_mix(const Params& p, LAS unsigned char* lds, int bid, int nb) {
    const int tid = threadIdx.x, lane = tid & 63, wave = tid >> 6;
    LAS unsigned* gl = (LAS unsigned*)lds;
    LAS float* red = (LAS float*)(lds + 62 * 2048);
    const __amdgpu_buffer_rsrc_t rxp = __builtin_amdgcn_make_buffer_rsrc((void*)p.xp, 0, RT * PWD * 2, 0x00020000);
    const __amdgpu_buffer_rsrc_t rgl = __builtin_amdgcn_make_buffer_rsrc((void*)p.glu, 0, RT * CWD * 2, 0x00020000);
    const __amdgpu_buffer_rsrc_t rpo = __builtin_amdgcn_make_buffer_rsrc((void*)p.mixb, 0, SEQ * D * 2, 0x00020000);
    const __amdgpu_buffer_rsrc_t rww = __builtin_amdgcn_make_buffer_rsrc((void*)p.dw_w, 0, KS * CWD * 4, 0x00020000);
    const __amdgpu_buffer_rsrc_t rwb = __builtin_amdgcn_make_buffer_rsrc((void*)p.dw_b, 0, CWD * 4, 0x00020000);
    const __amdgpu_buffer_rsrc_t rlg = __builtin_amdgcn_make_buffer_rsrc((void*)p.ln_g, 0, CWD * 4, 0x00020000);
    const __amdgpu_buffer_rsrc_t rlb = __builtin_amdgcn_make_buffer_rsrc((void*)p.ln_b, 0, CWD * 4, 0x00020000);
    for (int tile = bid; tile < SEQ / 32; tile += nb) {
        const int r0 = 256 + tile * 32;
        __syncthreads();
#pragma unroll
        for (int j = 0; j < 16; ++j) { const int ch = j * NT + tid; if (ch < 62 * 128)
            *(LAS u32x4*)(lds + ch * 16) = bload16(rgl, tid * 16, (r0 - 30) * 2048 + j * 8192); }
        { const int g = __builtin_amdgcn_readfirstlane(tid >> 7);
          if (g == 0) pool_tile<2>(rxp, rpo, r0, tile, tid); else if (g == 1) pool_tile<4>(rxp, rpo, r0, tile, tid); else if (g == 2) pool_tile<8>(rxp, rpo, r0, tile, tid); else pool_tile<16>(rxp, rpo, r0, tile, tid); }
        __syncthreads();
#pragma unroll 1
        for (int hf = 0; hf < 2; ++hf) {
            float c0[16], c1[16];
            {
                float w0[KS], w1[KS];
#pragma unroll
                for (int k = 0; k < KS; ++k) { const u32x2 wv = bload8(rww, tid * 8, k * 4096); w0[k] = __uint_as_float(wv.x); w1[k] = __uint_as_float(wv.y); }
                const u32x2 bvv = bload8(rwb, tid * 8, 0); const float b0 = __uint_as_float(bvv.x), b1 = __uint_as_float(bvv.y);
#pragma unroll
                for (int i = 0; i < 16; ++i) { c0[i] = b0; c1[i] = b1; }
                const LAS unsigned* glh = gl + hf * 16 * 512 + tid;
#pragma unroll
                for (int rr = 0; rr < 46; ++rr) {
                    if ((rr & 7) == 0) asm volatile("" ::: "memory");
                    const unsigned vv = glh[rr * 512]; const float x0 = bf_lo(vv), x1 = bf_hi(vv);
#pragma unroll
                    for (int i = 0; i < 16; ++i) { const int k = rr - i; if (k >= 0 && k < KS) { c0[i] += x0 * w0[k]; c1[i] += x1 * w1[k]; } }
                }
            }
            asm volatile("" ::: "memory");
#pragma unroll
            for (int which = 0; which < 2; ++which) {
                float st[16];
#pragma unroll
                for (int i = 0; i < 16; ++i) st[i] = which == 0 ? c0[i] + c1[i] : c0[i] * c0[i] + c1[i] * c1[i];
#pragma unroll
                for (int lvl = 0; lvl < 4; ++lvl) {
                    const int o = 32 >> lvl, n = 8 >> lvl; const int mk = -((lane >> (5 - lvl)) & 1);
#pragma unroll
                    for (int j = 0; j < 8; ++j) if (j < n) st[j] = fsel(mk, st[j], st[j + n]) + __shfl_xor(fsel(mk, st[j + n], st[j]), o);
                }
                float tot = st[0] + __shfl_xor(st[0], 2); tot += __shfl_xor(tot, 1);
                if ((lane & 3) == 0) red[wave * 32 + which * 16 + (lane >> 2)] = tot;
            }
            __syncthreads();
            if (tid < 32) { float t = 0.f;
#pragma unroll
                for (int q = 0; q < 8; ++q) t += red[q * 32 + tid];
                red[256 + tid] = t; }
            __syncthreads();
            const u32x2 lgv = bload8(rlg, tid * 8, 0), lbv = bload8(rlb, tid * 8, 0); const float lg0 = __uint_as_float(lgv.x), lg1 = __uint_as_float(lgv.y), lb0 = __uint_as_float(lbv.x), lb1 = __uint_as_float(lbv.y);
#pragma unroll
            for (int i = 0; i < 16; ++i) {
                const float s1 = red[256 + i], s2 = red[256 + 16 + i];
                const float mu = s1 * (1.0f / CWD), var = fmaxf(s2 * (1.0f / CWD) - mu * mu, 0.f), rs = rsqrtf(var + 1e-5f);
                const float y0 = (c0[i] - mu) * rs * lg0 + lb0, y1 = (c1[i] - mu) * rs * lg1 + lb1;
                bstore4(rpo, cvt_pk_bf16(y0 * sigmoidf_fast(y0), y1 * sigmoidf_fast(y1)), tid * 4, (tile * 32 + hf * 16 + i) * 4096 + 2048);
            }
            __syncthreads();
        }
    }
}

typedef float f32x16 __attribute__((ext_vector_type(16)));
__device__ __forceinline__ int okey(float s) { const int u = __float_as_int(s); return u ^ ((u >> 31) & 0x7fffffff); }
__device__ __forceinline__ float okey_inv(int k) { return __int_as_float(k ^ ((k >> 31) & 0x7fffffff)); }
__device__ __forceinline__ void sort16_desc(int (&v)[16]) {
#pragma unroll
    for (int k = 2; k <= 16; k <<= 1) {
#pragma unroll
        for (int j = k >> 1; j > 0; j >>= 1) {
#pragma unroll
            for (int i = 0; i < 16; ++i) {
                const int l = i ^ j;
                if (l > i) { const bool desc = (i & k) == 0; const int hi = max(v[i], v[l]), lo = min(v[i], v[l]); v[i] = desc ? hi : lo; v[l] = desc ? lo : hi; }
            }
        }
    }
}
__device__ __forceinline__ void merge16_desc(int (&a)[16], const int (&b)[16]) {
#pragma unroll
    for (int i = 0; i < 16; ++i) a[i] = max(a[i], b[15 - i]);
#pragma unroll
    for (int j = 8; j > 0; j >>= 1) {
#pragma unroll
        for (int i = 0; i < 16; ++i) { const int l = i ^ j; if (l > i) { const int hi = max(a[i], a[l]), lo = min(a[i], a[l]); a[i] = hi; a[l] = lo; } }
    }
}
__device__ __forceinline__ void pair_merge(int (&a)[16]) {
    int b[16];
#pragma unroll
    for (int i = 0; i < 16; ++i) b[i] = __shfl_xor(a[i], 32);
    merge16_desc(a, b);
}
constexpr int CELL_I[64] = {0,0,0,0,0,0,0,0,0,0,0,0,0,0,0,0,1,1,1,1,1,1,1,1,2,2,2,2,2,3,3,3,3,4,4,4,5,5,6,6,7,7,8,9,10,11,12,13,14,15,0,0,0,0,0,0,0,0,0,0,0,0,0,0};
constexpr int CELL_J[64] = {0,1,2,3,4,5,6,7,8,9,10,11,12,13,14,15,0,1,2,3,4,5,6,7,0,1,2,3,4,0,1,2,3,0,1,2,0,1,0,1,0,1,0,0,0,0,0,0,0,0,0,0,0,0,0,0,0,0,0,0,0,0,0,0};
constexpr int NCELL = 50;

struct EpiQTopk {
    static constexpr bool AFTER_DRAIN = true;
    const float* ssq; float* rstd; const bf16_t* keysb; unsigned short* idx; float* gsu;
    __device__ __forceinline__ void fused(const f32x4 (&acc)[2][2][4][2], const pg8::Unit& u, int wr, int wc, int fr, int fq, LAS unsigned char* lds, int wid, int lane) const {
        const int hh = lane >> 5, l31 = lane & 31, h = u.pn;
        LAS float* svt = (LAS float*)(lds + 65536 + (wid * 64 + lane) * 164);
        LAS unsigned char* sit = (LAS unsigned char*)(svt + 32);
        float rs[2][4];
#pragma unroll
        for (int ai = 0; ai < 2; ++ai)
#pragma unroll
            for (int m = 0; m < 4; ++m) {
                const size_t row = (size_t)(u.pm * 256 + ai * 128 + wr * 64 + m * 16 + fr);
                const f32x4* sp = (const f32x4*)(ssq + row * 32); f32x4 t = sp[0];
#pragma unroll
                for (int i = 1; i < 8; ++i) t += sp[i];
                rs[ai][m] = rsqrtf(((t[0] + t[1]) + (t[2] + t[3])) * (1.0f / D) + 1e-6f);
                if (u.pn == 0 && wc == 0 && fq == 0) rstd[row] = rs[ai][m];
            }
        const int trow = wid * 32 + l31;
#pragma unroll
        for (int ph = 0; ph < 2; ++ph) {
#pragma unroll
            for (int ai = 0; ai < 2; ++ai)
#pragma unroll
                for (int m = 0; m < 4; ++m) { const int row = ai * 128 + wr * 64 + m * 16 + fr;
#pragma unroll
                    for (int n = 0; n < 2; ++n) { const f32x4 v = acc[ai][ph][m][n] * rs[ai][m]; const int chunk = 4 * wc + 2 * n + (fq >> 1);
                        u32x2 w; w.x = cvt_pk_bf16(v[0], v[1]); w.y = cvt_pk_bf16(v[2], v[3]);
                        *(LAS u32x2*)(lds + row * 256 + ((chunk ^ (row & 15)) << 4) + (fq & 1) * 8) = w; } }
            __syncthreads();
            const bf16_t* krow = keysb + ((size_t)(h * 2 + ph) * 128 + l31) * 128 + 8 * hh;
            bf16x8 bq[8];
#pragma unroll
            for (int ks = 0; ks < 8; ++ks) bq[ks] = *(const LAS bf16x8*)(lds + trow * 256 + (((ks * 2 + hh) ^ (trow & 15)) << 4));
            int top[16];
#pragma unroll
            for (int i = 0; i < 16; ++i) top[i] = (int)0x80000000;
            bf16x8 ak[8];
#pragma unroll
            for (int ks = 0; ks < 8; ++ks) ak[ks] = *(const bf16x8*)(krow + ks * 16);
#pragma unroll 1
            for (int kt = 0; kt < 4; ++kt) {
                f32x16 c = {0.f, 0.f, 0.f, 0.f, 0.f, 0.f, 0.f, 0.f, 0.f, 0.f, 0.f, 0.f, 0.f, 0.f, 0.f, 0.f};
#pragma unroll
                for (int ks = 0; ks < 8; ++ks) c = __builtin_amdgcn_mfma_f32_32x32x16_bf16(ak[ks], bq[ks], c, 0, 0, 0);
                { const int kn = kt < 3 ? kt + 1 : 3;
#pragma unroll
                  for (int ks = 0; ks < 8; ++ks) ak[ks] = *(const bf16x8*)(krow + (size_t)kn * 32 * 128 + ks * 16); }
                int v[16];
                const int lowb = (127 - kt * 32) ^ (hh << 2);
#pragma unroll
                for (int r = 0; r < 16; ++r) v[r] = (okey(c[r]) & ~127) | (lowb - ((r & 3) + 8 * (r >> 2)));
                sort16_desc(v);
                merge16_desc(top, v);
            }
            pair_merge(top);
#pragma unroll
            for (int i = 0; i < 16; ++i) { svt[ph * 16 + i] = okey_inv(top[i] & ~127); sit[ph * 16 + i] = (unsigned char)(127 - (top[i] & 127)); }
            __syncthreads();
        }
        float sv[2][16];
#pragma unroll
        for (int i = 0; i < 16; ++i) { sv[0][i] = svt[i]; sv[1][i] = svt[16 + i]; }
        int w0[16], w1[16];
#pragma unroll
        for (int s = 0; s < 32; ++s) {
            const int e0 = 2 * s, e1 = 2 * s + 1;
            int key;
            if (e0 >= NCELL) key = (int)0x80000000;
            else {
                const float v0 = sv[0][CELL_I[e0]] + sv[1][CELL_J[e0]];
                const int k0 = (okey(v0) & ~255) | (255 - (CELL_I[e0] * 16 + CELL_J[e0]));
                if (e1 >= NCELL) key = hh ? (int)0x80000000 : k0;
                else { const float v1 = sv[0][CELL_I[e1]] + sv[1][CELL_J[e1]];
                    const int k1 = (okey(v1) & ~255) | (255 - (CELL_I[e1] * 16 + CELL_J[e1]));
                    key = hh ? k1 : k0; }
            }
            if (s < 16) w0[s] = key; else w1[s - 16] = key;
        }
        sort16_desc(w0); sort16_desc(w1); merge16_desc(w0, w1); pair_merge(w0);
        const float mx = okey_inv(w0[0] & ~255);
        float sum = 0.f;
#pragma unroll
        for (int k = 0; k < 16; ++k) sum += __expf(okey_inv(w0[k] & ~255) - mx);
        const float inv = 1.0f / sum;
        int eo[8]; float go[8]; const int hmask = -hh;
#pragma unroll
        for (int k = 0; k < 8; ++k) { const int kk = (w0[k] & ~hmask) | (w0[8 + k] & hmask); const int cc = 255 - (kk & 255);
            eo[k] = (int)sit[cc >> 4] * 128 + (int)sit[16 + (cc & 15)]; go[k] = __expf(okey_inv(kk & ~255) - mx) * inv; }
        const size_t ob = (size_t)(u.pm * 256 + trow) * 128 + h * 16 + hh * 8;
        *(u32x4*)(idx + ob) = (u32x4){(unsigned)eo[0] | ((unsigned)eo[1] << 16), (unsigned)eo[2] | ((unsigned)eo[3] << 16), (unsigned)eo[4] | ((unsigned)eo[5] << 16), (unsigned)eo[6] | ((unsigned)eo[7] << 16)};
        *(f32x4*)(gsu + ob) = (f32x4){go[0], go[1], go[2], go[3]};
        *(f32x4*)(gsu + ob + 4) = (f32x4){go[4], go[5], go[6], go[7]};
    }
    __device__ __forceinline__ void operator()(const f32x4 (&)[2][2][4][2], const pg8::Unit&, int, int, int, int) const {}
};

typedef float f32x2 __attribute__((ext_vector_type(2)));
template <int N> __device__ __forceinline__ f32x2 dot16_fp8(const u32x4 w, const f32x2 (&x)[N], int o, f32x2 acc) {
    const unsigned ww[4] = {w.x, w.y, w.z, w.w};
#pragma unroll
    for (int d = 0; d < 4; ++d) { acc += __builtin_amdgcn_cvt_pk_f32_fp8((int)ww[d], false) * x[o + 2 * d]; acc += __builtin_amdgcn_cvt_pk_f32_fp8((int)ww[d], true) * x[o + 2 * d + 1]; }
    return acc;
}
template <int N> __device__ __forceinline__ void axpy16_fp8(const u32x4 w, float a, f32x2 (&y)[N], int o) {
    const unsigned ww[4] = {w.x, w.y, w.z, w.w}; const f32x2 a2 = {a, a};
#pragma unroll
    for (int d = 0; d < 4; ++d) { y[o + 2 * d] += a2 * __builtin_amdgcn_cvt_pk_f32_fp8((int)ww[d], false); y[o + 2 * d + 1] += a2 * __builtin_amdgcn_cvt_pk_f32_fp8((int)ww[d], true); }
}
__device__ __forceinline__ void bstore16(__amdgpu_buffer_rsrc_t r, f32x4 v, int voff, int soff) { __builtin_amdgcn_raw_buffer_store_b128(__builtin_bit_cast(__attribute__((__vector_size__(4 * sizeof(unsigned)))) unsigned, v), r, voff, soff, 0); }
__device__ __forceinline__ void bstore8(__amdgpu_buffer_rsrc_t r, f32x2 v, int voff, int soff) { __builtin_amdgcn_raw_buffer_store_b64(__builtin_bit_cast(__attribute__((__vector_size__(2 * sizeof(unsigned)))) unsigned, v), r, voff, soff, 0); }
__device__ __forceinline__ f32x2 fsel2(int mask, f32x2 a, f32x2 b) { return (f32x2){fsel(mask, a.x, b.x), fsel(mask, a.y, b.y)}; }
__device__ __forceinline__ f32x2 shx2(f32x2 a, int o) { return (f32x2){__shfl_xor(a.x, o), __shfl_xor(a.y, o)}; }

__device__ __forceinline__ void phase_pd(const Params& p, int bid, int nb) {
    const int tid = threadIdx.x, lane = tid & 63, wave = __builtin_amdgcn_readfirstlane(tid >> 6);
    const int v = bid & 7, lw = (bid >> 3) * 8 + wave, NLW = (nb >> 3) * 8;
    const int c = lane & 7, sub = lane >> 3;
    const int m0 = -(lane & 1), m1 = -((lane >> 1) & 1), m2 = -((lane >> 2) & 1);
    const __amdgpu_buffer_rsrc_t rd = __builtin_amdgcn_make_buffer_rsrc((void*)p.down8, 0, 16384 * D, 0x00020000);
    const __amdgpu_buffer_rsrc_t rh = __builtin_amdgcn_make_buffer_rsrc((void*)p.h2b, 0, SEQ * D * 2, 0x00020000);
    const __amdgpu_buffer_rsrc_t rg1 = __builtin_amdgcn_make_buffer_rsrc((void*)p.ffn_g, 0, D * 4, 0x00020000);
    const __amdgpu_buffer_rsrc_t ri = __builtin_amdgcn_make_buffer_rsrc((void*)p.idx, 0, SEQ * 128 * 2, 0x00020000);
    const __amdgpu_buffer_rsrc_t rrs = __builtin_amdgcn_make_buffer_rsrc((void*)p.rstd, 0, SEQ * 4, 0x00020000);
    const __amdgpu_buffer_rsrc_t rp = __builtin_amdgcn_make_buffer_rsrc((void*)p.part, 0, SEQ * 16 * 128 * 2, 0x00020000);
    const int vsub = sub * 32, vc2 = c * 32, vc1 = c * 16, vl4 = lane * 4;
#pragma unroll 1
    for (int pass = 0; pass < 2; ++pass) {
        const int sl = v * 2 + pass;
        f32x2 gs[8];
#pragma unroll
        for (int i = 0; i < 4; ++i) { const f32x4 g = __builtin_bit_cast(f32x4, bload16(rg1, c * 64, sl * 512 + i * 16)); gs[2 * i] = (f32x2){g[0], g[1]}; gs[2 * i + 1] = (f32x2){g[2], g[3]}; }
        u32x4 ix[2], hh[2]; unsigned rsb;
        {
            const int t = lw;
#pragma unroll
            for (int i = 0; i < 2; ++i) ix[i] = bload16(ri, vsub, t * 256 + i * 16);
            hh[0] = bload16(rh, vc2, t * 4096 + sl * 256); hh[1] = bload16(rh, vc2, t * 4096 + sl * 256 + 16); rsb = bload4(rrs, 0, t * 4);
        }
#pragma unroll 1
        for (int t = lw; t < SEQ; t += NLW) {
            asm volatile("" ::: "memory");
            u32x4 w[16];
            {
                const unsigned ew[8] = {ix[0].x, ix[0].y, ix[0].z, ix[0].w, ix[1].x, ix[1].y, ix[1].z, ix[1].w};
#pragma unroll
                for (int g = 0; g < 16; ++g) { const unsigned e = (g & 1) ? (ew[g >> 1] >> 16) : (ew[g >> 1] & 0xffffu); w[g] = bload16(rd, (int)(e * 2048u) + vc1, sl * 128); }
            }
            f32x2 xs[8];
            {
                const float rs = __uint_as_float(rsb);
                const unsigned hw[8] = {hh[0].x, hh[0].y, hh[0].z, hh[0].w, hh[1].x, hh[1].y, hh[1].z, hh[1].w};
#pragma unroll
                for (int i = 0; i < 8; ++i) xs[i] = (f32x2){bf_lo(hw[i]) * rs, bf_hi(hw[i]) * rs} * gs[i];
            }
            asm volatile("" ::: "memory");
            {
                const int tn = t + NLW < SEQ ? t + NLW : t;
#pragma unroll
                for (int i = 0; i < 2; ++i) ix[i] = bload16(ri, vsub, tn * 256 + i * 16);
                hh[0] = bload16(rh, vc2, tn * 4096 + sl * 256); hh[1] = bload16(rh, vc2, tn * 4096 + sl * 256 + 16); rsb = bload4(rrs, 0, tn * 4);
            }
            asm volatile("" ::: "memory");
            float r[16];
#pragma unroll
            for (int g = 0; g < 16; ++g) { const f32x2 z = {0.f, 0.f}; const f32x2 s2 = dot16_fp8(w[g], xs, 0, z); r[g] = s2.x + s2.y; }
            float k8[8], k4[4];
#pragma unroll
            for (int i = 0; i < 8; ++i) k8[i] = fsel(m2, r[i], r[i + 8]) + __shfl_xor(fsel(m2, r[i + 8], r[i]), 4);
#pragma unroll
            for (int i = 0; i < 4; ++i) k4[i] = fsel(m1, k8[i], k8[i + 4]) + __shfl_xor(fsel(m1, k8[i + 4], k8[i]), 2);
            const float k0 = fsel(m0, k4[0], k4[2]) + __shfl_xor(fsel(m0, k4[2], k4[0]), 1);
            const float k1 = fsel(m0, k4[1], k4[3]) + __shfl_xor(fsel(m0, k4[3], k4[1]), 1);
            bstore4(rp, cvt_pk_bf16(k0, k1), vl4, (t * 16 + sl) * 256);
        }
    }
}
__device__ __forceinline__ void phase_pa(const Params& p, int bid, int nb) {
    const int tid = threadIdx.x, lane = tid & 63, wave = tid >> 6;
    const int gw = bid * 8 + wave, NGW = nb * 8;
    for (int it = gw; it < SEQ * 2; it += NGW) {
        const int t = it >> 1, pp = (it & 1) * 64 + lane;
        const bf16_t* pr = p.part + (size_t)t * 2048 + pp;
        float hs = 0.f;
#pragma unroll
        for (int sl = 0; sl < 16; ++sl) hs += __uint_as_float((unsigned)pr[sl * 128] << 16);
        const int e = (int)p.idx[(size_t)t * 128 + pp];
        hs *= p.sdn[e];
        const float av = p.gsu[(size_t)t * 128 + pp] * p.sup[e] * 0.5f * hs * (1.0f + erff(hs * 0.70710678118654752f));
        p.act[(size_t)t * 128 + pp] = (bf16_t)(cvt_pk_bf16(av, 0.f) & 0xffffu);
    }
}
__device__ __forceinline__ void phase_pu(const Params& p, int bid, int nb) {
    const int tid = threadIdx.x, lane = tid & 63, wave = __builtin_amdgcn_readfirstlane(tid >> 6);
    const int v = bid & 7, lw = (bid >> 3) * 8 + wave, NLW = (nb >> 3) * 8;
    const int c = lane & 7, sub = lane >> 3;
    const int m3 = -((lane >> 3) & 1), m4 = -((lane >> 4) & 1), m5 = -((lane >> 5) & 1);
    const __amdgpu_buffer_rsrc_t ru = __builtin_amdgcn_make_buffer_rsrc((void*)p.up8, 0, 16384 * D, 0x00020000);
    const __amdgpu_buffer_rsrc_t rh = __builtin_amdgcn_make_buffer_rsrc((void*)p.h2b, 0, SEQ * D * 2, 0x00020000);
    const __amdgpu_buffer_rsrc_t ri = __builtin_amdgcn_make_buffer_rsrc((void*)p.idx, 0, SEQ * 128 * 2, 0x00020000);
    const __amdgpu_buffer_rsrc_t ra = __builtin_amdgcn_make_buffer_rsrc((void*)p.act, 0, SEQ * 128 * 2, 0x00020000);
    const __amdgpu_buffer_rsrc_t ro = __builtin_amdgcn_make_buffer_rsrc((void*)p.h3b, 0, SEQ * D * 2, 0x00020000);
    const __amdgpu_buffer_rsrc_t rq = __builtin_amdgcn_make_buffer_rsrc((void*)p.ssq2, 0, SEQ * 16 * 4, 0x00020000);
    const int vsub = sub * 32, vc1 = c * 16, vh = c * 32 + sub * 4;
#pragma unroll 1
    for (int pass = 0; pass < 2; ++pass) {
        const int sl = v * 2 + pass;
        u32x4 ix[2], ac[2]; unsigned hb;
        {
            const int t = lw;
#pragma unroll
            for (int i = 0; i < 2; ++i) { ix[i] = bload16(ri, vsub, t * 256 + i * 16); ac[i] = bload16(ra, vsub, t * 256 + i * 16); }
            hb = bload4(rh, vh, t * 4096 + sl * 256);
        }
#pragma unroll 1
        for (int t = lw; t < SEQ; t += NLW) {
            asm volatile("" ::: "memory");
            u32x4 w[16];
            {
                const unsigned ew[8] = {ix[0].x, ix[0].y, ix[0].z, ix[0].w, ix[1].x, ix[1].y, ix[1].z, ix[1].w};
#pragma unroll
                for (int g = 0; g < 16; ++g) { const unsigned e = (g & 1) ? (ew[g >> 1] >> 16) : (ew[g >> 1] & 0xffffu); w[g] = bload16(ru, (int)(e * 2048u) + vc1, sl * 128); }
            }
            const unsigned aw[8] = {ac[0].x, ac[0].y, ac[0].z, ac[0].w, ac[1].x, ac[1].y, ac[1].z, ac[1].w};
            float a[16];
#pragma unroll
            for (int g = 0; g < 16; ++g) a[g] = (g & 1) ? bf_hi(aw[g >> 1]) : bf_lo(aw[g >> 1]);
            const unsigned hcur = hb;
            asm volatile("" ::: "memory");
            {
                const int tn = t + NLW < SEQ ? t + NLW : t;
#pragma unroll
                for (int i = 0; i < 2; ++i) { ix[i] = bload16(ri, vsub, tn * 256 + i * 16); ac[i] = bload16(ra, vsub, tn * 256 + i * 16); }
                hb = bload4(rh, vh, tn * 4096 + sl * 256);
            }
            asm volatile("" ::: "memory");
            f32x2 acc[8];
#pragma unroll
            for (int i = 0; i < 8; ++i) acc[i] = (f32x2){0.f, 0.f};
#pragma unroll
            for (int g = 0; g < 16; ++g) axpy16_fp8(w[g], a[g], acc, 0);
            f32x2 k4[4], k2[2];
#pragma unroll
            for (int i = 0; i < 4; ++i) k4[i] = fsel2(m5, acc[i], acc[i + 4]) + shx2(fsel2(m5, acc[i + 4], acc[i]), 32);
#pragma unroll
            for (int i = 0; i < 2; ++i) k2[i] = fsel2(m4, k4[i], k4[i + 2]) + shx2(fsel2(m4, k4[i + 2], k4[i]), 16);
            f32x2 h3 = fsel2(m3, k2[0], k2[1]) + shx2(fsel2(m3, k2[1], k2[0]), 8);
            h3 += (f32x2){bf_lo(hcur), bf_hi(hcur)};
            bstore4(ro, cvt_pk_bf16(h3.x, h3.y), vh, t * 4096 + sl * 256);
            const float ss = wave_sum(h3.x * h3.x + h3.y * h3.y);
            if (lane == 0) bstore4(rq, __float_as_uint(ss), 0, (t * 16 + sl) * 4);
        }
    }
}
__device__ __forceinline__ void phase_pf(const Params& p, int bid, int nb) {
    const int tid = threadIdx.x, lane = tid & 63, wave = tid >> 6;
    const int gw = bid * 8 + wave, NGW = nb * 8;
    for (int t = gw; t < SEQ; t += NGW) {
        const f32x4* sp = (const f32x4*)(p.ssq2 + (size_t)t * 16); f32x4 q = sp[0] + sp[1] + sp[2] + sp[3];
        const float rf = rsqrtf(((q[0] + q[1]) + (q[2] + q[3])) * (1.0f / D) + 1e-6f);
        const u32x4* hp = (const u32x4*)(p.h3b + (size_t)t * D) + lane;
        f32x4* o = (f32x4*)(p.out + (size_t)t * D) + 2 * lane; const f32x4* g = (const f32x4*)p.fin_g + 2 * lane;
#pragma unroll
        for (int j = 0; j < 4; ++j) { const u32x4 h = hp[64 * j]; const f32x4 g0 = g[128 * j], g1 = g[128 * j + 1];
            o[128 * j] = (f32x4){bf_lo(h.x) * rf * g0[0], bf_hi(h.x) * rf * g0[1], bf_lo(h.y) * rf * g0[2], bf_hi(h.y) * rf * g0[3]};
            o[128 * j + 1] = (f32x4){bf_lo(h.z) * rf * g1[0], bf_hi(h.z) * rf * g1[1], bf_lo(h.w) * rf * g1[2], bf_hi(h.w) * rf * g1[3]}; }
    }
}

__device__ __forceinline__ void fp8_row(const float* src, unsigned char* dst, float* inv_scale, int lane) {
    f32x4 v[2][4]; float am = 0.f;
#pragma unroll
    for (int k = 0; k < 2; ++k)
#pragma unroll
        for (int i = 0; i < 4; ++i) { v[k][i] = *(const f32x4*)(src + 1024 * k + 16 * lane + 4 * i);
            am = fmaxf(am, fmaxf(fmaxf(fabsf(v[k][i].x), fabsf(v[k][i].y)), fmaxf(fabsf(v[k][i].z), fabsf(v[k][i].w)))); }
#pragma unroll
    for (int o = 1; o < 64; o <<= 1) am = fmaxf(am, __shfl_xor(am, o));
    int be = (__float_as_int(am) >> 23) & 255; be = be < 8 ? 8 : (be > 248 ? 248 : be);
    const float sc = __int_as_float((260 - be) << 23), isc = __int_as_float((be - 6) << 23);
#pragma unroll
    for (int k = 0; k < 2; ++k) { u32x4 w; unsigned ww[4];
#pragma unroll
        for (int i = 0; i < 4; ++i) { int t = 0; t = __builtin_amdgcn_cvt_pk_fp8_f32(v[k][i].x * sc, v[k][i].y * sc, t, false); t = __builtin_amdgcn_cvt_pk_fp8_f32(v[k][i].z * sc, v[k][i].w * sc, t, true); ww[i] = (unsigned)t; }
        w.x = ww[0]; w.y = ww[1]; w.z = ww[2]; w.w = ww[3];
        *(u32x4*)(dst + 1024 * k + 16 * lane) = w; }
    if (lane == 0) *inv_scale = isc;
}

__device__ __forceinline__ void fp8_row2(const float* s0, unsigned char* d0, float* i0, const float* s1, unsigned char* d1, float* i1, int lane) {
    f32x4 v[2][2][4]; float am[2] = {0.f, 0.f};
#pragma unroll
    for (int r = 0; r < 2; ++r)
#pragma unroll
        for (int k = 0; k < 2; ++k)
#pragma unroll
            for (int i = 0; i < 4; ++i) v[r][k][i] = __builtin_nontemporal_load((const f32x4*)((r ? s1 : s0) + 1024 * k + 16 * lane + 4 * i));
#pragma unroll
    for (int r = 0; r < 2; ++r) {
#pragma unroll
        for (int k = 0; k < 2; ++k)
#pragma unroll
            for (int i = 0; i < 4; ++i) am[r] = fmaxf(am[r], fmaxf(fmaxf(fabsf(v[r][k][i].x), fabsf(v[r][k][i].y)), fmaxf(fabsf(v[r][k][i].z), fabsf(v[r][k][i].w))));
#pragma unroll
        for (int o = 1; o < 64; o <<= 1) am[r] = fmaxf(am[r], __shfl_xor(am[r], o));
        int be = (__float_as_int(am[r]) >> 23) & 255; be = be < 8 ? 8 : (be > 248 ? 248 : be);
        const float sc = __int_as_float((260 - be) << 23), isc = __int_as_float((be - 6) << 23);
#pragma unroll
        for (int k = 0; k < 2; ++k) { u32x4 w; unsigned ww[4];
#pragma unroll
            for (int i = 0; i < 4; ++i) { int t = 0; t = __builtin_amdgcn_cvt_pk_fp8_f32(v[r][k][i].x * sc, v[r][k][i].y * sc, t, false); t = __builtin_amdgcn_cvt_pk_fp8_f32(v[r][k][i].z * sc, v[r][k][i].w * sc, t, true); ww[i] = (unsigned)t; }
            w.x = ww[0]; w.y = ww[1]; w.z = ww[2]; w.w = ww[3];
            *(u32x4*)((r ? d1 : d0) + 1024 * k + 16 * lane) = w; }
        if (lane == 0) *(r ? i1 : i0) = isc;
    }
}

__device__ __forceinline__ void tr_item(const float* W, int ldw, int srccol0, int k0, bf16_t* WT, int ldt, int n0, const float* kscale, const float* nscale, LAS float* scr, int lane) {
    float tv[32];
#pragma unroll
    for (int i = 0; i < 32; ++i) { const int kk = 2 * i + (lane >> 5); tv[i] = W[(size_t)(k0 + kk) * ldw + srccol0 + (lane & 31)]; }
    const float ns = nscale ? nscale[srccol0 + (lane & 31)] : 1.0f;
#pragma unroll
    for (int i = 0; i < 32; ++i) { const int kk = 2 * i + (lane >> 5); float v = tv[i] * ns;
        if (kscale) v *= kscale[k0 + kk]; scr[kk * 33 + (lane & 31)] = v; }
    asm volatile("s_waitcnt lgkmcnt(0)" ::: "memory");
    const int c = lane & 7;
#pragma unroll
    for (int j = 0; j < 4; ++j) { const int n = (lane >> 3) + 8 * j; const LAS float* s = scr + (8 * c) * 33 + n;
        u32x4 o; o.x = cvt_pk_bf16(s[0 * 33], s[1 * 33]); o.y = cvt_pk_bf16(s[2 * 33], s[3 * 33]); o.z = cvt_pk_bf16(s[4 * 33], s[5 * 33]); o.w = cvt_pk_bf16(s[6 * 33], s[7 * 33]);
        *(u32x4*)(WT + (size_t)(n0 + n) * ldt + k0 + 8 * c) = o; }
    asm volatile("s_waitcnt lgkmcnt(0)" ::: "memory");
}
__device__ __forceinline__ int win_srccol(int n) { const int pn = n >> 8, w = n & 255; return pn < 4 ? n : ((w >> 7) ? 2048 : 1024) + (pn - 4) * 128 + (w & 127); }

__device__ __forceinline__ void phase_prep(const Params& p, LAS unsigned char* lds, int bid, int nb) {
    const int tid = threadIdx.x, lane = tid & 63, wave = tid >> 6;
    const int gw = bid * 8 + wave, NGW = nb * 8;
    LAS float* scr = (LAS float*)(lds + wave * 8448);
    for (int r = gw; r < RT; r += NGW) {
        unsigned long long* o8 = (unsigned long long*)(p.hnb + (size_t)r * D) + lane;
        if (r < RPAD) {
#pragma unroll
            for (int j = 0; j < 8; ++j) o8[64 * j] = 0ull;
        } else {
            const f32x4* xr = (const f32x4*)hrow(p, r - RPAD) + lane;
            const f32x4* gr = (const f32x4*)p.mix_g + lane;
            f32x4 v[8]; float s = 0.f;
#pragma unroll
            for (int j = 0; j < 8; ++j) { v[j] = __builtin_nontemporal_load(xr + 64 * j); s += (v[j].x * v[j].x + v[j].y * v[j].y) + (v[j].z * v[j].z + v[j].w * v[j].w); }
            const float rs = rsqrtf(wave_sum(s) * (1.0f / D) + 1e-6f);
#pragma unroll
            for (int j = 0; j < 8; ++j) { const f32x4 gv = gr[64 * j];
                o8[64 * j] = (unsigned long long)cvt_pk_bf16(v[j].x * rs * gv.x, v[j].y * rs * gv.y) | ((unsigned long long)cvt_pk_bf16(v[j].z * rs * gv.z, v[j].w * rs * gv.w) << 32); }
        }
    }
    for (int it = gw; it < (D / 64) * (INW / 32); it += NGW) {
        const int kb = it / (INW / 32), nbk = it % (INW / 32);
        tr_item(p.w_in, INW, win_srccol(nbk * 32), kb * 64, p.w_in_t, D, nbk * 32, nullptr, nullptr, scr, lane);
    }
    for (int i = gw * 64 + lane; i < 4 * 256 * 256 / 4; i += NGW * 64) { const f32x4 v = ((const f32x4*)p.pool_w)[i];
        const int g = i >> 14, d = (i & 63) * 4; const f32x4 sc = *(const f32x4*)(p.pool_scale + g * 256 + d);
        u32x2 w; w.x = cvt_pk_bf16(v[0] * sc[0], v[1] * sc[1]); w.y = cvt_pk_bf16(v[2] * sc[2], v[3] * sc[3]); ((u32x2*)p.pool_ws)[i] = w; }
    for (int i = gw * 64 + lane; i < CWD * CWD / 4; i += NGW * 64) { const f32x4 v = ((const f32x4*)p.pw_w)[i];
        u32x2 w; w.x = cvt_pk_bf16(v[0], v[1]); w.y = cvt_pk_bf16(v[2], v[3]); ((u32x2*)p.pw_b16)[i] = w; }
    for (int it = gw; it < 32 * 64; it += NGW) { const int kb = it >> 6, nbk = it & 63;
        tr_item(p.w_out, D, nbk * 32, kb * 64, p.w_out_t, D, nbk * 32, nullptr, nullptr, scr, lane); }
    for (int it = gw; it < 32 * 64; it += NGW) { const int kb = it >> 6, nbk = it & 63;
        tr_item(p.wq, D, nbk * 32, kb * 64, p.wq_t, D, nbk * 32, p.ffn_g, nullptr, scr, lane); }
    for (int i = gw * 64 + lane; i < 8 * 2 * 128 * 128 / 4; i += NGW * 64) { const f32x4 v = ((const f32x4*)p.keys)[i];
        u32x2 w; w.x = cvt_pk_bf16(v[0], v[1]); w.y = cvt_pk_bf16(v[2], v[3]); ((u32x2*)p.keysb)[i] = w; }
    for (int e = gw; e < 16384; e += NGW)
        fp8_row2(p.down + (size_t)e * D, p.down8 + (size_t)e * D, p.sdn + e, p.up + (size_t)e * D, p.up8 + (size_t)e * D, p.sup + e, lane);
}


#define XB_TMO      128
#define XB_XCNT(j)  (256  + 64 * (j))
#define XB_XSUB(j)  (1280 + 64 * (j))
#define XB_XGEN(j)  (2304 + 64 * (j))
#define XB_TOP      3328
#define XB_TOPGEN   3392
#define XCD_BAR_WORDS 3456
#define XB_SPIN_CAP (1u << 18)
__device__ __forceinline__ unsigned xb_ld(unsigned* p)              { return __hip_atomic_load(p, __ATOMIC_RELAXED, __HIP_MEMORY_SCOPE_AGENT); }
__device__ __forceinline__ unsigned xb_add(unsigned* p, unsigned v) { return __hip_atomic_fetch_add(p, v, __ATOMIC_RELAXED, __HIP_MEMORY_SCOPE_AGENT); }
__device__ __forceinline__ unsigned xb_xcc_id() { return (unsigned)__builtin_amdgcn_s_getreg((3 << 11) | 20) & 0xFu; }
#define XB_SPIN(cond, bar) do { unsigned _sp = 0; while (cond) { __builtin_amdgcn_s_sleep(1); \
    if ((++_sp & 255u) == 0u) { if (xb_ld(&(bar)[XB_TMO])) break; if (_sp > XB_SPIN_CAP) { atomicAdd(&(bar)[XB_TMO], 1u); break; } } } } while (0)
struct XcdBarrier { unsigned* bar; unsigned x; volatile LAS unsigned* st; };
__device__ __forceinline__ XcdBarrier xcd_barrier_post(unsigned* bar, volatile LAS unsigned* st) {
    XcdBarrier b; b.bar = bar; b.x = xb_xcc_id(); b.st = st;
    if (threadIdx.x == 0) (void)xb_add(&bar[XB_XCNT(b.x)], 1u);
    return b;
}
__device__ __forceinline__ void xcd_barrier_complete(unsigned* bar, unsigned x, unsigned& nloc, unsigned& nx) {
    const unsigned G = gridDim.x * gridDim.y * gridDim.z;
    unsigned sum, cnt, mine, sp = 0u;
    for (;;) {
        sum = 0u; cnt = 0u; mine = 0u;
#pragma unroll
        for (unsigned j = 0; j < 16; ++j) { const unsigned c = xb_ld(&bar[XB_XCNT(j)]); sum += c; cnt += (c > 0u) ? 1u : 0u; mine = (j == x) ? c : mine; }
        if (sum == G) break;
        __builtin_amdgcn_s_sleep(1);
        if ((++sp & 255u) == 0u) { if (xb_ld(&bar[XB_TMO])) break; if (sp > XB_SPIN_CAP) { atomicAdd(&bar[XB_TMO], 1u); break; } }
    }
    nloc = mine > 0u ? mine : 1u; nx = cnt > 0u ? cnt : 1u;
}
__device__ __forceinline__ void xcd_barrier(const XcdBarrier& b) {
    asm volatile("s_waitcnt vmcnt(0)" ::: "memory");
    __syncthreads();
    if (threadIdx.x == 0) {
        unsigned* bar = b.bar;
        __builtin_amdgcn_s_waitcnt(0);
        unsigned nloc = b.st[0], nx = b.st[1];
        if (nloc == 0u) { xcd_barrier_complete(bar, b.x, nloc, nx); b.st[0] = nloc; b.st[1] = nx; }
        const unsigned old = xb_add(&bar[XB_XSUB(b.x)], 1u);
        const unsigned gen = old / nloc;
        if (old + 1u == (gen + 1u) * nloc) {
            __builtin_amdgcn_fence(__ATOMIC_RELEASE, "agent");
            asm volatile("s_waitcnt vmcnt(0)" ::: "memory");
            const unsigned og = xb_add(&bar[XB_TOP], 1u);
            const unsigned tg = og / nx;
            if (og + 1u == (tg + 1u) * nx) xb_add(&bar[XB_TOPGEN], 1u);
            else XB_SPIN(xb_ld(&bar[XB_TOPGEN]) == tg, bar);
            __builtin_amdgcn_fence(__ATOMIC_ACQUIRE, "agent");
            xb_add(&bar[XB_XGEN(b.x)], 1u);
            asm volatile("s_waitcnt vmcnt(0)" ::: "memory");
        } else {
            XB_SPIN(xb_ld(&bar[XB_XGEN(b.x)]) == gen, bar);
            __builtin_amdgcn_fence(__ATOMIC_ACQUIRE, "agent");
            asm volatile("s_waitcnt vmcnt(0)" ::: "memory");
        }
    }
    __syncthreads();
}

__global__ void __launch_bounds__(NT, 2) k_mega(Params p) {
    extern __shared__ __attribute__((aligned(16))) unsigned char lds_raw[];
    LAS unsigned char* lds = (LAS unsigned char*)lds_raw;
    const int bid = blockIdx.x, nb = gridDim.x;
    volatile LAS unsigned* bst = (volatile LAS unsigned*)(lds + LDS_BYTES - 16);
    if (threadIdx.x < 4) bst[threadIdx.x] = 0u;
    __syncthreads();
    const XcdBarrier xb = xcd_barrier_post(p.bar, bst);
    phase_prep(p, lds, bid, nb);
    xcd_barrier(xb);
    { pg8::Gemm g{p.hnb, p.w_in_t, D, D, D, 0}; pg8::StaticOrder S; S.init(RT / 256, INW / 256, nb, bid); EpiProj E{p.xp, p.glu};
      pg8::gemm_phase<EpiProj, pg8::StaticOrder>(lds, g, S, E); }
    { const int nproj = (RT / 256) * (INW / 256); const int first = (nproj > nb && nproj < 2 * nb) ? nproj - nb : 0, nfree = nb - first;
      for (int uu = bid - first; uu >= 0 && uu < 64; uu += nfree) {
        __syncthreads();
        const bool pw = uu < 32;
        pg8::Gemm g{pw ? p.w_out_t + PWD : p.w_out_t, pw ? p.pw_b16 : p.pool_ws, D, pw ? CWD : 256, pw ? CWD : 256, pw ? 0 : 256};
        pg8::OneUnit S; S.u.pm = (uu & 31) >> 2; S.u.pn = uu & 3; EpiBf16Out E{p.w_eff_t, D, pw ? PWD : 0, nullptr};
        pg8::gemm_phase<EpiBf16Out, pg8::OneUnit>(lds, g, S, E);
      }
      { const int b0 = nfree >= 96 ? first + 64 : 0;
        for (int nbk = bid - b0; nbk >= 0 && nbk < D / 64; nbk += nb) {
          __syncthreads();
          const int lane = threadIdx.x & 63, wv = threadIdx.x >> 6, n = nbk * 64 + lane;
          float a[8] = {0.f, 0.f, 0.f, 0.f, 0.f, 0.f, 0.f, 0.f};
          for (int j = wv * 128; j < wv * 128 + 128; j += 8) {
#pragma unroll
            for (int q = 0; q < 8; ++q) a[q] += p.pw_b[j + q] * p.w_out[(size_t)(PWD + j + q) * D + n]; }
          LAS float* red = (LAS float*)lds;
          red[wv * 64 + lane] = ((a[0] + a[1]) + (a[2] + a[3])) + ((a[4] + a[5]) + (a[6] + a[7]));
          __syncthreads();
          if (wv == 0) { float t = 0.f;
#pragma unroll
            for (int q = 0; q < 8; ++q) t += red[q * 64 + lane];
            p.bias_eff[n] = t; }
        } }
    }
    xcd_barrier(xb);
    phase_mix(p, lds, bid, nb);
    xcd_barrier(xb);
    { pg8::Gemm g{p.mixb, p.w_eff_t, D, D, D, 0}; pg8::StaticOrder S; S.init(SEQ / 256, D / 256, nb, bid); EpiResid E{p.x, p.bias_eff, p.h2b, p.ssq};
      pg8::gemm_phase<EpiResid, pg8::StaticOrder>(lds, g, S, E); }
    xcd_barrier(xb);
    { pg8::Gemm g{p.h2b, p.wq_t, D, D, D, 0}; pg8::StaticOrder S; S.init(SEQ / 256, D / 256, nb, bid); EpiQTopk E{p.ssq, p.rstd, p.keysb, p.idx, p.gsu};
      pg8::gemm_phase<EpiQTopk, pg8::StaticOrder>(lds, g, S, E); }
    xcd_barrier(xb);
    phase_pd(p, bid, nb);
    xcd_barrier(xb);
    phase_pa(p, bid, nb);
    xcd_barrier(xb);
    phase_pu(p, bid, nb);
    xcd_barrier(xb);
    phase_pf(p, bid, nb);
}

extern "C" void kernel_launch(void* const* d_in, const int* in_sizes, int n_in, void* d_out, int out_size, void* d_ws, size_t ws_size, hipStream_t stream) {
    Params p{};
    p.x = (const float*)d_in[0]; p.meta = (const float*)d_in[1]; p.mix_g = (const float*)d_in[2]; p.w_in = (const float*)d_in[3];
    p.pool_w = (const float*)d_in[4]; p.pool_scale = (const float*)d_in[5]; p.dw_w = (const float*)d_in[6]; p.dw_b = (const float*)d_in[7];
    p.ln_g = (const float*)d_in[8]; p.ln_b = (const float*)d_in[9]; p.pw_w = (const float*)d_in[10]; p.pw_b = (const float*)d_in[11];
    p.w_out = (const float*)d_in[12]; p.ffn_g = (const float*)d_in[13]; p.wq = (const float*)d_in[14]; p.keys = (const float*)d_in[15];
    p.down = (const float*)d_in[16]; p.up = (const float*)d_in[17]; p.fin_g = (const float*)d_in[18];
    p.out = (float*)d_out;
    char* w = (char*)d_ws; size_t off = 0;
    auto take = [&](size_t bytes) { char* r = w + off; off += (bytes + 255) & ~(size_t)255; return r; };
    p.idx = (unsigned short*)take((size_t)SEQ * 128 * 2);
    p.gsu = (float*)take((size_t)SEQ * 128 * 4);
    p.part = (bf16_t*)take((size_t)SEQ * 16 * 128 * 2);
    p.act = (bf16_t*)take((size_t)SEQ * 128 * 2);
    p.ssq2 = (float*)take((size_t)SEQ * 16 * 4);
    p.h3b = (bf16_t*)take((size_t)SEQ * D * 2);
    p.hnb = (bf16_t*)take((size_t)RT * D * 2);
    p.w_in_t = (bf16_t*)take((size_t)INW * D * 2);
    p.xp = (bf16_t*)take((size_t)RT * PWD * 2);
    p.glu = (bf16_t*)take((size_t)RT * CWD * 2);
    p.mixb = (bf16_t*)take((size_t)SEQ * D * 2);
    p.h2b = (bf16_t*)take((size_t)SEQ * D * 2);
    p.pool_ws = (bf16_t*)take((size_t)4 * 256 * 256 * 2);
    p.pw_b16 = (bf16_t*)take((size_t)CWD * CWD * 2);
    p.w_eff_t = (bf16_t*)take((size_t)D * D * 2);
    p.bias_eff = (float*)take((size_t)D * 4);
    p.w_out_t = (bf16_t*)take((size_t)D * D * 2);
    p.ssq = (float*)take((size_t)SEQ * 32 * 4);
    p.bar = (unsigned*)take((size_t)XCD_BAR_WORDS * 4);
    p.rstd = (float*)take((size_t)SEQ * 4);
    p.wq_t = (bf16_t*)take((size_t)D * D * 2);
    p.keysb = (bf16_t*)take((size_t)8 * 2 * 128 * 128 * 2);
    p.qb = (bf16_t*)take((size_t)SEQ * D * 2);
    p.down8 = (unsigned char*)take((size_t)16384 * D);
    p.up8 = (unsigned char*)take((size_t)16384 * D);
    p.sdn = (float*)take((size_t)16384 * 4);
    p.sup = (float*)take((size_t)16384 * 4);
    static int grid_blocks = 0;
    if (!grid_blocks) {
        int dev = 0, cus = 0, per_cu = 0;
        (void)hipGetDevice(&dev);
        (void)hipDeviceGetAttribute(&cus, hipDeviceAttributeMultiprocessorCount, dev);
        (void)hipFuncSetAttribute((const void*)k_mega, hipFuncAttributeMaxDynamicSharedMemorySize, LDS_BYTES);
        (void)hipOccupancyMaxActiveBlocksPerMultiprocessor(&per_cu, k_mega, NT, LDS_BYTES);
        if (per_cu < 1) { fprintf(stderr, "occupancy query says %d workgroups per CU: nothing launched\n", per_cu); grid_blocks = -1; }
        else if (cus != (SEQ / 256) * (D / 256)) { fprintf(stderr, "this build needs a %d-CU device (got %d): nothing launched\n", (SEQ / 256) * (D / 256), cus); grid_blocks = -1; }
        else grid_blocks = cus;
    }
    if (grid_blocks < 0) return;
    (void)hipMemsetAsync(p.bar, 0, (size_t)XCD_BAR_WORDS * 4, stream);
    void* args[] = {&p};
    hipError_t e = hipLaunchCooperativeKernel((void*)k_mega, dim3(grid_blocks), dim3(NT), args, LDS_BYTES, stream);
    if (e != hipSuccess) fprintf(stderr, "cooperative launch failed: %s (grid %d)\n", hipGetErrorString(e), grid_blocks);
}
```

```cpp
#include <hip/hip_runtime.h>
#include <hip/hip_cooperative_groups.h>
#include <stdint.h>
#include <cstdio>
namespace cg = cooperative_groups;

#define NT 512
#define LAS __attribute__((address_space(3)))
typedef unsigned short bf16_t;
typedef short bf16x8 __attribute__((ext_vector_type(8)));
typedef float f32x4 __attribute__((ext_vector_type(4)));
typedef unsigned u32x4 __attribute__((ext_vector_type(4)));
typedef unsigned u32x2 __attribute__((ext_vector_type(2)));

constexpr int D = 2048, SEQ = 8192, NMETA = 16, T = SEQ + NMETA;
constexpr int PWD = 1024, CWD = 1024, INW = 3072;
constexpr int KS = 31;
constexpr int RPAD = 240, RT = 8448;
constexpr int LDS_BYTES = 151552;

struct Params {
    const float *x, *meta, *mix_g, *w_in, *pool_w, *pool_scale, *dw_w, *dw_b, *ln_g, *ln_b, *pw_w, *pw_b, *w_out, *ffn_g, *wq, *keys, *down, *up, *fin_g;
    float* out;
    unsigned short* idx;
    unsigned* bar;
    bf16_t *hnb, *w_in_t, *xp, *glu, *mixb, *h2b, *pool_ws, *pw_b16, *w_eff_t, *w_out_t, *wq_t, *keysb, *qb;
    unsigned char *down8, *up8;
    float *sdn, *sup;
    float *gsu;
    bf16_t* part;
    bf16_t* act;
    float* ssq2;
    bf16_t* h3b;
    float *ssq, *rstd, *bias_eff;
};

__device__ __forceinline__ unsigned cvt_pk_bf16(float lo, float hi) { unsigned r; asm volatile("v_cvt_pk_bf16_f32 %0, %1, %2" : "=v"(r) : "v"(lo), "v"(hi)); return r; }
__device__ __forceinline__ float wave_sum(float v) {
#pragma unroll
    for (int o = 1; o < 64; o <<= 1) v += __shfl_xor(v, o);
    return v;
}

__device__ __forceinline__ const float* hrow(const Params& p, int t) { return t < NMETA ? p.meta + (size_t)t * D : p.x + (size_t)(t - NMETA) * D; }

__device__ __forceinline__ float block_sum(float v, float* red) {
#pragma unroll
    for (int o = 32; o; o >>= 1) v += __shfl_xor(v, o);
    __syncthreads();
    if ((threadIdx.x & 63) == 0) red[threadIdx.x >> 6] = v;
    __syncthreads();
    float s = 0.f;
#pragma unroll
    for (int i = 0; i < NT / 64; ++i) s += red[i];
    return s;
}

namespace pg8 {
constexpr int BM = 256, BK = 64, HALF = 128, HTB = HALF * BK * 2, STAGE_BYTES = 8 * HTB, NXCD = 8, WGM = 8;
__device__ __forceinline__ int lds_byte(int r, int c) { const int st = (r >> 4) * 2 + (c >> 5), rr = r & 15, cc = c & 31, ob = rr * 64 + cc * 2; return st * 1024 + (ob ^ (((ob >> 9) & 1) << 5)); }
__device__ __forceinline__ void stage_rc(int b, int& R, int& C) { const int st = b / 1024, sb = b % 1024, swz = sb ^ (((sb >> 9) & 1) << 5); R = (st >> 1) * 16 + swz / 64; C = (st & 1) * 32 + (swz % 64) / 2; }
struct Unit { int pm, pn; };
struct Gemm { const bf16_t* A; const bf16_t* Bt; int lda, ldb, K; int a_col_per_pn; };
struct StaticOrder {
    int nM, nN, nwg, G, c;
    __device__ void init(int nM_, int nN_, int G_, int c_) { nM = nM_; nN = nN_; nwg = nM * nN; G = G_; c = c_; }
    __device__ bool next(int i, Unit& u) const {
        const long L = (long)i * G + c; if (L >= nwg) return false;
        int wgid = (int)L; { const int q = nwg / NXCD, r = nwg % NXCD, xcd = wgid % NXCD, off = wgid / NXCD; wgid = (xcd < r ? xcd * (q + 1) : r * (q + 1) + (xcd - r) * q) + off; }
        const int nig = WGM * nN, gid = wgid / nig, fm = gid * WGM, gsz = (nM - fm) < WGM ? (nM - fm) : WGM;
        u.pm = fm + ((wgid % nig) % gsz); u.pn = (wgid % nig) / gsz; return true;
    }
};
struct OneUnit { Unit u; __device__ bool next(int i, Unit& o) const { if (i) return false; o = u; return true; } };
template <class Epi, class Sched>
__device__ __forceinline__ void gemm_phase(LAS unsigned char* lds, const Gemm g, const Sched& S, const Epi& E) {
    const int tid = threadIdx.x, wid = __builtin_amdgcn_readfirstlane(tid >> 6), lane = tid & 63, wr = wid >> 2, wc = wid & 3, fr = lane & 15, fq = lane >> 4;
    const int K = g.K, nt = K / BK;
    unsigned voffA[2], voffB[2];
#pragma unroll
    for (int i = 0; i < 2; ++i) { int R, C; stage_rc(tid * 16 + i * 8192, R, C);
        voffA[i] = (unsigned)(R * g.lda + C) * 2u; voffB[i] = (unsigned)(R * g.ldb + C) * 2u; }
    const size_t kstep = (size_t)(BK * 2);
    const size_t hstepA = (size_t)HALF * g.lda * 2, hstepB = (size_t)HALF * g.ldb * 2;
    const size_t tstepA = 2 * hstepA, tstepB = 2 * hstepB;
    const unsigned ldsw = (unsigned)wid * 1024u;
    const int aoff = lds_byte(wr * 64 + fr, fq * 8), boff = lds_byte(wc * 32 + fr, fq * 8);
#define PG8_SA(b, h) (((b) * 2 + (h)) * HTB)
#define PG8_SB(b, h) ((4 + (b) * 2 + (h)) * HTB)
#define PG8_STAGE(bufoff, gbase, voff) do { _Pragma("unroll") for (int _i = 0; _i < 2; ++_i) \
        __builtin_amdgcn_global_load_lds((const unsigned*)((const char*)(gbase) + (voff)[_i]), (LAS unsigned*)(lds + (bufoff) + ldsw + _i * 8192), 16, 0, 0); } while (0)
#define PG8_LDA(dst, b, h) do { _Pragma("unroll") for (int m = 0; m < 4; ++m) _Pragma("unroll") for (int k = 0; k < 2; ++k) dst[m][k] = *(const LAS bf16x8*)(lds + PG8_SA(b, h) + aoff + m * 2048 + k * 1024); } while (0)
#define PG8_LDB(dst, b, h) do { _Pragma("unroll") for (int n = 0; n < 2; ++n) _Pragma("unroll") for (int k = 0; k < 2; ++k) dst[n][k] = *(const LAS bf16x8*)(lds + PG8_SB(b, h) + boff + n * 2048 + k * 1024); } while (0)
#define PG8_MMA(ai, bj, At, Bt) do { __builtin_amdgcn_s_setprio(1); _Pragma("unroll") for (int m = 0; m < 4; ++m) _Pragma("unroll") for (int n = 0; n < 2; ++n) _Pragma("unroll") for (int k = 0; k < 2; ++k) \
        acc[ai][bj][m][n] = __builtin_amdgcn_mfma_f32_16x16x32_bf16(Bt[n][k], At[m][k], acc[ai][bj][m][n], 0, 0, 0); __builtin_amdgcn_s_setprio(0); } while (0)
#define PG8_WAIT_V(n) asm volatile("s_waitcnt vmcnt(" #n ")" ::: "memory")
#define PG8_WAIT_L(n) asm volatile("s_waitcnt lgkmcnt(" #n ")" ::: "memory")
#define PG8_BAR __builtin_amdgcn_s_barrier()
#define PG8_SCHED __builtin_amdgcn_sched_barrier(0)
    Unit cur, nxt; int ui = 0;
    if (!S.next(0, cur)) return;
    f32x4 acc[2][2][4][2];
#pragma unroll
    for (int a = 0; a < 2; ++a)
#pragma unroll
        for (int b = 0; b < 2; ++b)
#pragma unroll
            for (int m = 0; m < 4; ++m)
#pragma unroll
                for (int n = 0; n < 2; ++n) acc[a][b][m][n] = (f32x4){0.f, 0.f, 0.f, 0.f};
    bf16x8 At[4][2], B0[2][2], B1[2][2];
    const char* cA = (const char*)g.A + (size_t)cur.pm * tstepA + (size_t)cur.pn * g.a_col_per_pn * 2; const char* cB = (const char*)g.Bt + (size_t)cur.pn * tstepB;
    PG8_STAGE(PG8_SB(0, 0), cB, voffB); PG8_STAGE(PG8_SA(0, 0), cA, voffA); PG8_STAGE(PG8_SB(0, 1), cB + hstepB, voffB); PG8_STAGE(PG8_SA(0, 1), cA + hstepA, voffA);
    if (wr == 1) PG8_BAR;
    PG8_WAIT_V(4); PG8_BAR;
    PG8_STAGE(PG8_SB(1, 0), cB + kstep, voffB); PG8_STAGE(PG8_SA(1, 0), cA + kstep, voffA); PG8_STAGE(PG8_SB(1, 1), cB + hstepB + kstep, voffB);
    PG8_WAIT_V(6); PG8_BAR;
    for (;;) {
        const bool has_next = S.next(ui + 1, nxt);
        const char* nA = has_next ? (const char*)g.A + (size_t)nxt.pm * tstepA + (size_t)nxt.pn * g.a_col_per_pn * 2 : cA; const char* nB = has_next ? (const char*)g.Bt + (size_t)nxt.pn * tstepB : cB;
        for (int t = 0; t < nt; t += 2) {
            const bool last = (t == nt - 2);
            const char* a1 = cA + (size_t)(t + 1) * kstep;
            const char* a2 = last ? nA : cA + (size_t)(t + 2) * kstep; const char* b2 = last ? nB : cB + (size_t)(t + 2) * kstep;
            const char* a3 = a2 + kstep; const char* b3 = b2 + kstep;
            PG8_LDB(B0, 0, 0); PG8_SCHED; PG8_LDA(At, 0, 0); PG8_STAGE(PG8_SA(1, 1), a1 + hstepA, voffA);
            PG8_WAIT_L(8); PG8_BAR; PG8_WAIT_L(0); PG8_MMA(0, 0, At, B0); PG8_BAR; PG8_SCHED;
            PG8_LDB(B1, 0, 1); PG8_STAGE(PG8_SB(0, 0), b2, voffB);
            PG8_BAR; PG8_WAIT_L(0); PG8_MMA(0, 1, At, B1); PG8_BAR;
            PG8_LDA(At, 0, 1); PG8_STAGE(PG8_SA(0, 0), a2, voffA);
            PG8_BAR; PG8_WAIT_L(0); PG8_MMA(1, 0, At, B0); PG8_BAR; PG8_SCHED;
            PG8_STAGE(PG8_SB(0, 1), b2 + hstepB, voffB);
            PG8_WAIT_V(6); PG8_BAR; PG8_MMA(1, 1, At, B1); PG8_BAR;
            PG8_LDB(B0, 1, 0); PG8_SCHED; PG8_LDA(At, 1, 0); PG8_STAGE(PG8_SA(0, 1), a2 + hstepA, voffA);
            PG8_WAIT_L(8); PG8_BAR; PG8_WAIT_L(0); PG8_MMA(0, 0, At, B0); PG8_BAR; PG8_SCHED;
            PG8_LDB(B1, 1, 1); PG8_STAGE(PG8_SB(1, 0), b3, voffB);
            PG8_BAR; PG8_WAIT_L(0); PG8_MMA(0, 1, At, B1); PG8_BAR;
            PG8_LDA(At, 1, 1); PG8_STAGE(PG8_SA(1, 0), a3, voffA);
            PG8_BAR; PG8_WAIT_L(0); PG8_MMA(1, 0, At, B0); PG8_BAR; PG8_SCHED;
            PG8_STAGE(PG8_SB(1, 1), b3 + hstepB, voffB);
            PG8_WAIT_V(6); PG8_BAR; PG8_MMA(1, 1, At, B1); PG8_BAR;
        }
        if constexpr (!Epi::AFTER_DRAIN) E(acc, cur, wr, wc, fr, fq);
        if (!has_next) break;
#pragma unroll
        for (int a = 0; a < 2; ++a)
#pragma unroll
            for (int b = 0; b < 2; ++b)
#pragma unroll
                for (int m = 0; m < 4; ++m)
#pragma unroll
                    for (int n = 0; n < 2; ++n) acc[a][b][m][n] = (f32x4){0.f, 0.f, 0.f, 0.f};
        cur = nxt; cA = nA; cB = nB; ++ui;
    }
    PG8_WAIT_V(0);
    if (wr == 0) PG8_BAR;
    PG8_BAR;
    if constexpr (Epi::AFTER_DRAIN) E.fused(acc, cur, wr, wc, fr, fq, lds, wid, lane);
#undef PG8_SA
#undef PG8_SB
#undef PG8_STAGE
#undef PG8_LDA
#undef PG8_LDB
#undef PG8_MMA
#undef PG8_WAIT_V
#undef PG8_WAIT_L
#undef PG8_BAR
#undef PG8_SCHED
}
}

struct EpiProjF32 {
    static constexpr bool AFTER_DRAIN = false;
    float* proj;
    __device__ __forceinline__ void operator()(const f32x4 (&acc)[2][2][4][2], const pg8::Unit& u, int wr, int wc, int fr, int fq) const {
#pragma unroll
        for (int ai = 0; ai < 2; ++ai)
#pragma unroll
            for (int m = 0; m < 4; ++m) {
                const int t = u.pm * 256 + ai * 128 + wr * 64 + m * 16 + fr - RPAD;
                if (t >= 0) {
#pragma unroll
                    for (int bj = 0; bj < 2; ++bj)
#pragma unroll
                        for (int n = 0; n < 2; ++n) {
                            const int off = wc * 32 + n * 16 + fq * 4;
                            const int col = u.pn < 4 ? u.pn * 256 + bj * 128 + off : (bj ? 2048 : 1024) + (u.pn - 4) * 128 + off;
                            *(f32x4*)(proj + (size_t)t * INW + col) = acc[ai][bj][m][n];
                        }
                }
            }
    }
};


__device__ __forceinline__ float sigmoidf_fast(float x) { return __builtin_amdgcn_rcpf(1.0f + __expf(-x)); }

struct EpiProj {
    static constexpr bool AFTER_DRAIN = false;
    bf16_t* xp; bf16_t* glu;
    __device__ __forceinline__ void operator()(const f32x4 (&acc)[2][2][4][2], const pg8::Unit& u, int wr, int wc, int fr, int fq) const {
#pragma unroll
        for (int ai = 0; ai < 2; ++ai)
#pragma unroll
            for (int m = 0; m < 4; ++m) {
                const size_t row = (size_t)(u.pm * 256 + ai * 128 + wr * 64 + m * 16 + fr);
                if (u.pn < 4) {
#pragma unroll
                    for (int bj = 0; bj < 2; ++bj)
#pragma unroll
                        for (int n = 0; n < 2; ++n) { const f32x4 v = acc[ai][bj][m][n]; u32x2 w; w.x = cvt_pk_bf16(v[0], v[1]); w.y = cvt_pk_bf16(v[2], v[3]);
                            *(u32x2*)(xp + row * PWD + u.pn * 256 + bj * 128 + wc * 32 + n * 16 + fq * 4) = w; }
                } else {
#pragma unroll
                    for (int n = 0; n < 2; ++n) { const f32x4 a = acc[ai][0][m][n], g = acc[ai][1][m][n]; u32x2 w;
                        w.x = cvt_pk_bf16(a[0] * sigmoidf_fast(g[0]), a[1] * sigmoidf_fast(g[1])); w.y = cvt_pk_bf16(a[2] * sigmoidf_fast(g[2]), a[3] * sigmoidf_fast(g[3]));
                        *(u32x2*)(glu + row * CWD + (u.pn - 4) * 128 + wc * 32 + n * 16 + fq * 4) = w; }
                }
            }
    }
};
struct EpiBf16Out {
    static constexpr bool AFTER_DRAIN = false;
    bf16_t* O; int ldc; int col0; const float* bias;
    __device__ __forceinline__ void operator()(const f32x4 (&acc)[2][2][4][2], const pg8::Unit& u, int wr, int wc, int fr, int fq) const {
#pragma unroll
        for (int ai = 0; ai < 2; ++ai)
#pragma unroll
            for (int m = 0; m < 4; ++m) {
                const size_t row = (size_t)(u.pm * 256 + ai * 128 + wr * 64 + m * 16 + fr);
#pragma unroll
                for (int bj = 0; bj < 2; ++bj)
#pragma unroll
                    for (int n = 0; n < 2; ++n) { const int c = u.pn * 256 + bj * 128 + wc * 32 + n * 16 + fq * 4; f32x4 v = acc[ai][bj][m][n];
                        if (bias) v += *(const f32x4*)(bias + c);
                        u32x2 w; w.x = cvt_pk_bf16(v[0], v[1]); w.y = cvt_pk_bf16(v[2], v[3]);
                        *(u32x2*)(O + row * ldc + col0 + c) = w; }
            }
    }
};
struct EpiResid {
    static constexpr bool AFTER_DRAIN = false;
    const float* x; const float* bias; bf16_t* h2b; float* ssq;
    __device__ __forceinline__ void operator()(const f32x4 (&acc)[2][2][4][2], const pg8::Unit& u, int wr, int wc, int fr, int fq) const {
#pragma unroll
        for (int ai = 0; ai < 2; ++ai)
#pragma unroll
            for (int m = 0; m < 4; ++m) {
                const size_t row = (size_t)(u.pm * 256 + ai * 128 + wr * 64 + m * 16 + fr);
                float ss = 0.f;
#pragma unroll
                for (int bj = 0; bj < 2; ++bj)
#pragma unroll
                    for (int n = 0; n < 2; ++n) { const int c = u.pn * 256 + bj * 128 + wc * 32 + n * 16 + fq * 4;
                        const f32x4 v = acc[ai][bj][m][n] + *(const f32x4*)(x + row * D + c) + *(const f32x4*)(bias + c);
                        u32x2 w; w.x = cvt_pk_bf16(v[0], v[1]); w.y = cvt_pk_bf16(v[2], v[3]);
                        *(u32x2*)(h2b + row * D + c) = w;
                        ss += (v[0] * v[0] + v[1] * v[1]) + (v[2] * v[2] + v[3] * v[3]); }
                ss += __shfl_xor(ss, 16); ss += __shfl_xor(ss, 32);
                if (fq == 0) ssq[row * 32 + u.pn * 4 + wc] = ss;
            }
    }
};

__device__ __forceinline__ float fsel(int mask, float a, float b) { return __int_as_float((__float_as_int(a) & ~mask) | (__float_as_int(b) & mask)); }
__device__ __forceinline__ float bf_lo(unsigned w) { return __uint_as_float(w << 16); }
__device__ __forceinline__ float bf_hi(unsigned w) { return __uint_as_float(w & 0xffff0000u); }

__device__ __forceinline__ u32x4 bload16(__amdgpu_buffer_rsrc_t r, int voff, int soff) { return __builtin_bit_cast(u32x4, __builtin_amdgcn_raw_buffer_load_b128(r, voff, soff, 0)); }
__device__ __forceinline__ unsigned bload4(__amdgpu_buffer_rsrc_t r, int voff, int soff) { return (unsigned)__builtin_amdgcn_raw_buffer_load_b32(r, voff, soff, 0); }
__device__ __forceinline__ void bstore4(__amdgpu_buffer_rsrc_t r, unsigned v, int voff, int soff) { __builtin_amdgcn_raw_buffer_store_b32(v, r, voff, soff, 0); }
__device__ __forceinline__ u32x2 bload8(__amdgpu_buffer_rsrc_t r, int voff, int soff) { return __builtin_bit_cast(u32x2, __builtin_amdgcn_raw_buffer_load_b64(r, voff, soff, 0)); }
template <int W> __device__ __forceinline__ void pool_tile(__amdgpu_buffer_rsrc_t rxp, __amdgpu_buffer_rsrc_t rpo, int r0, int tile, int tid) {
    unsigned v[32 + W - 1];
#pragma unroll
    for (int i = 0; i < 32 + W - 1; ++i) v[i] = bload4(rxp, tid * 4, (r0 - (W - 1) + i) * 2048);
    float s0 = 0.f, s1 = 0.f;
#pragma unroll
    for (int i = 0; i < W - 1; ++i) { s0 += bf_lo(v[i]); s1 += bf_hi(v[i]); }
    constexpr float inv = 1.0f / (float)W;
#pragma unroll
    for (int i = 0; i < 32; ++i) {
        const float a0 = bf_lo(v[W - 1 + i]), a1 = bf_hi(v[W - 1 + i]);
        s0 += a0; s1 += a1;
        bstore4(rpo, cvt_pk_bf16(s0 * inv - a0, s1 * inv - a1), tid * 4, (tile * 32 + i) * 4096);
        s0 -= bf_lo(v[i]); s1 -= bf_hi(v[i]);
    }
}
__device__ __forceinline__ void phase_mix(const Params& p, LAS unsigned char* lds, int bid, int nb) {
    const int tid = threadIdx.x, lane = tid & 63, wave = tid >> 6;
    LAS unsigned* gl = (LAS unsigned*)lds;
    LAS float* red = (LAS float*)(lds + 62 * 2048);
    const __amdgpu_buffer_rsrc_t rxp = __builtin_amdgcn_make_buffer_rsrc((void*)p.xp, 0, RT * PWD * 2, 0x00020000);
    const __amdgpu_buffer_rsrc_t rgl = __builtin_amdgcn_make_buffer_rsrc((void*)p.glu, 0, RT * CWD * 2, 0x00020000);
    const __amdgpu_buffer_rsrc_t rpo = __builtin_amdgcn_make_buffer_rsrc((void*)p.mixb, 0, SEQ * D * 2, 0x00020000);
    const __amdgpu_buffer_rsrc_t rww = __builtin_amdgcn_make_buffer_rsrc((void*)p.dw_w, 0, KS * CWD * 4, 0x00020000);
    const __amdgpu_buffer_rsrc_t rwb = __builtin_amdgcn_make_buffer_rsrc((void*)p.dw_b, 0, CWD * 4, 0x00020000);
    const __amdgpu_buffer_rsrc_t rlg = __builtin_amdgcn_make_buffer_rsrc((void*)p.ln_g, 0, CWD * 4, 0x00020000);
    const __amdgpu_buffer_rsrc_t rlb = __builtin_amdgcn_make_buffer_rsrc((void*)p.ln_b, 0, CWD * 4, 0x00020000);
    for (int tile = bid; tile < SEQ / 32; tile += nb) {
        const int r0 = 256 + tile * 32;
        __syncthreads();
#pragma unroll
        for (int j = 0; j < 16; ++j) { const int ch = j * NT + tid; if (ch < 62 * 128)
            *(LAS u32x4*)(lds + ch * 16) = bload16(rgl, tid * 16, (r0 - 30) * 2048 + j * 8192); }
        { const int g = __builtin_amdgcn_readfirstlane(tid >> 7);
          if (g == 0) pool_tile<2>(rxp, rpo, r0, tile, tid); else if (g == 1) pool_tile<4>(rxp, rpo, r0, tile, tid); else if (g == 2) pool_tile<8>(rxp, rpo, r0, tile, tid); else pool_tile<16>(rxp, rpo, r0, tile, tid); }
        __syncthreads();
#pragma unroll 1
        for (int hf = 0; hf < 2; ++hf) {
            float c0[16], c1[16];
            {
                float w0[KS], w1[KS];
#pragma unroll
                for (int k = 0; k < KS; ++k) { const u32x2 wv = bload8(rww, tid * 8, k * 4096); w0[k] = __uint_as_float(wv.x); w1[k] = __uint_as_float(wv.y); }
                const u32x2 bvv = bload8(rwb, tid * 8, 0); const float b0 = __uint_as_float(bvv.x), b1 = __uint_as_float(bvv.y);
#pragma unroll
                for (int i = 0; i < 16; ++i) { c0[i] = b0; c1[i] = b1; }
                const LAS unsigned* glh = gl + hf * 16 * 512 + tid;
#pragma unroll
                for (int rr = 0; rr < 46; ++rr) {
                    if ((rr & 7) == 0) asm volatile("" ::: "memory");
                    const unsigned vv = glh[rr * 512]; const float x0 = bf_lo(vv), x1 = bf_hi(vv);
#pragma unroll
                    for (int i = 0; i < 16; ++i) { const int k = rr - i; if (k >= 0 && k < KS) { c0[i] += x0 * w0[k]; c1[i] += x1 * w1[k]; } }
                }
            }
            asm volatile("" ::: "memory");
#pragma unroll
            for (int which = 0; which < 2; ++which) {
                float st[16];
#pragma unroll
                for (int i = 0; i < 16; ++i) st[i] = which == 0 ? c0[i] + c1[i] : c0[i] * c0[i] + c1[i] * c1[i];
#pragma unroll
                for (int lvl = 0; lvl < 4; ++lvl) {
                    const int o = 32 >> lvl, n = 8 >> lvl; const int mk = -((lane >> (5 - lvl)) & 1);
#pragma unroll
                    for (int j = 0; j < 8; ++j) if (j < n) st[j] = fsel(mk, st[j], st[j + n]) + __shfl_xor(fsel(mk, st[j + n], st[j]), o);
                }
                float tot = st[0] + __shfl_xor(st[0], 2); tot += __shfl_xor(tot, 1);
                if ((lane & 3) == 0) red[wave * 32 + which * 16 + (lane >> 2)] = tot;
            }
            __syncthreads();
            if (tid < 32) { float t = 0.f;
#pragma unroll
                for (int q = 0; q < 8; ++q) t += red[q * 32 + tid];
                red[256 + tid] = t; }
            __syncthreads();
            const u32x2 lgv = bload8(rlg, tid * 8, 0), lbv = bload8(rlb, tid * 8, 0); const float lg0 = __uint_as_float(lgv.x), lg1 = __uint_as_float(lgv.y), lb0 = __uint_as_float(lbv.x), lb1 = __uint_as_float(lbv.y);
#pragma unroll
            for (int i = 0; i < 16; ++i) {
                const float s1 = red[256 + i], s2 = red[256 + 16 + i];
                const float mu = s1 * (1.0f / CWD), var = fmaxf(s2 * (1.0f / CWD) - mu * mu, 0.f), rs = rsqrtf(var + 1e-5f);
                const float y0 = (c0[i] - mu) * rs * lg0 + lb0, y1 = (c1[i] - mu) * rs * lg1 + lb1;
                bstore4(rpo, cvt_pk_bf16(y0 * sigmoidf_fast(y0), y1 * sigmoidf_fast(y1)), tid * 4, (tile * 32 + hf * 16 + i) * 4096 + 2048);
            }
            __syncthreads();
        }
    }
}

typedef float f32x16 __attribute__((ext_vector_type(16)));
__device__ __forceinline__ int okey(float s) { const int u = __float_as_int(s); return u ^ ((u >> 31) & 0x7fffffff); }
__device__ __forceinline__ float okey_inv(int k) { return __int_as_float(k ^ ((k >> 31) & 0x7fffffff)); }
__device__ __forceinline__ void sort16_desc(int (&v)[16]) {
#pragma unroll
    for (int k = 2; k <= 16; k <<= 1) {
#pragma unroll
        for (int j = k >> 1; j > 0; j >>= 1) {
#pragma unroll
            for (int i = 0; i < 16; ++i) {
                const int l = i ^ j;
                if (l > i) { const bool desc = (i & k) == 0; const int hi = max(v[i], v[l]), lo = min(v[i], v[l]); v[i] = desc ? hi : lo; v[l] = desc ? lo : hi; }
            }
        }
    }
}
__device__ __forceinline__ void merge16_desc(int (&a)[16], const int (&b)[16]) {
#pragma unroll
    for (int i = 0; i < 16; ++i) a[i] = max(a[i], b[15 - i]);
#pragma unroll
    for (int j = 8; j > 0; j >>= 1) {
#pragma unroll
        for (int i = 0; i < 16; ++i) { const int l = i ^ j; if (l > i) { const int hi = max(a[i], a[l]), lo = min(a[i], a[l]); a[i] = hi; a[l] = lo; } }
    }
}
__device__ __forceinline__ void pair_merge(int (&a)[16]) {
    int b[16];
#pragma unroll
    for (int i = 0; i < 16; ++i) b[i] = __shfl_xor(a[i], 32);
    merge16_desc(a, b);
}
constexpr int CELL_I[64] = {0,0,0,0,0,0,0,0,0,0,0,0,0,0,0,0,1,1,1,1,1,1,1,1,2,2,2,2,2,3,3,3,3,4,4,4,5,5,6,6,7,7,8,9,10,11,12,13,14,15,0,0,0,0,0,0,0,0,0,0,0,0,0,0};
constexpr int CELL_J[64] = {0,1,2,3,4,5,6,7,8,9,10,11,12,13,14,15,0,1,2,3,4,5,6,7,0,1,2,3,4,0,1,2,3,0,1,2,0,1,0,1,0,1,0,0,0,0,0,0,0,0,0,0,0,0,0,0,0,0,0,0,0,0,0,0};
constexpr int NCELL = 50;

struct EpiQTopk {
    static constexpr bool AFTER_DRAIN = true;
    const float* ssq; float* rstd; const bf16_t* keysb; unsigned short* idx; float* gsu;
    __device__ __forceinline__ void fused(const f32x4 (&acc)[2][2][4][2], const pg8::Unit& u, int wr, int wc, int fr, int fq, LAS unsigned char* lds, int wid, int lane) const {
        const int hh = lane >> 5, l31 = lane & 31, h = u.pn;
        LAS float* svt = (LAS float*)(lds + 65536 + (wid * 64 + lane) * 164);
        LAS unsigned char* sit = (LAS unsigned char*)(svt + 32);
        float rs[2][4];
#pragma unroll
        for (int ai = 0; ai < 2; ++ai)
#pragma unroll
            for (int m = 0; m < 4; ++m) {
                const size_t row = (size_t)(u.pm * 256 + ai * 128 + wr * 64 + m * 16 + fr);
                const f32x4* sp = (const f32x4*)(ssq + row * 32); f32x4 t = sp[0];
#pragma unroll
                for (int i = 1; i < 8; ++i) t += sp[i];
                rs[ai][m] = rsqrtf(((t[0] + t[1]) + (t[2] + t[3])) * (1.0f / D) + 1e-6f);
                if (u.pn == 0 && wc == 0 && fq == 0) rstd[row] = rs[ai][m];
            }
        const int trow = wid * 32 + l31;
#pragma unroll
        for (int ph = 0; ph < 2; ++ph) {
#pragma unroll
            for (int ai = 0; ai < 2; ++ai)
#pragma unroll
                for (int m = 0; m < 4; ++m) { const int row = ai * 128 + wr * 64 + m * 16 + fr;
#pragma unroll
                    for (int n = 0; n < 2; ++n) { const f32x4 v = acc[ai][ph][m][n] * rs[ai][m]; const int chunk = 4 * wc + 2 * n + (fq >> 1);
                        u32x2 w; w.x = cvt_pk_bf16(v[0], v[1]); w.y = cvt_pk_bf16(v[2], v[3]);
                        *(LAS u32x2*)(lds + row * 256 + ((chunk ^ (row & 15)) << 4) + (fq & 1) * 8) = w; } }
            __syncthreads();
            const bf16_t* krow = keysb + ((size_t)(h * 2 + ph) * 128 + l31) * 128 + 8 * hh;
            bf16x8 bq[8];
#pragma unroll
            for (int ks = 0; ks < 8; ++ks) bq[ks] = *(const LAS bf16x8*)(lds + trow * 256 + (((ks * 2 + hh) ^ (trow & 15)) << 4));
            int top[16];
#pragma unroll
            for (int i = 0; i < 16; ++i) top[i] = (int)0x80000000;
            bf16x8 ak[8];
#pragma unroll
            for (int ks = 0; ks < 8; ++ks) ak[ks] = *(const bf16x8*)(krow + ks * 16);
#pragma unroll 1
            for (int kt = 0; kt < 4; ++kt) {
                f32x16 c = {0.f, 0.f, 0.f, 0.f, 0.f, 0.f, 0.f, 0.f, 0.f, 0.f, 0.f, 0.f, 0.f, 0.f, 0.f, 0.f};
#pragma unroll
                for (int ks = 0; ks < 8; ++ks) c = __builtin_amdgcn_mfma_f32_32x32x16_bf16(ak[ks], bq[ks], c, 0, 0, 0);
                { const int kn = kt < 3 ? kt + 1 : 3;
#pragma unroll
                  for (int ks = 0; ks < 8; ++ks) ak[ks] = *(const bf16x8*)(krow + (size_t)kn * 32 * 128 + ks * 16); }
                int v[16];
                const int lowb = (127 - kt * 32) ^ (hh << 2);
#pragma unroll
                for (int r = 0; r < 16; ++r) v[r] = (okey(c[r]) & ~127) | (lowb - ((r & 3) + 8 * (r >> 2)));
                sort16_desc(v);
                merge16_desc(top, v);
            }
            pair_merge(top);
#pragma unroll
            for (int i = 0; i < 16; ++i) { svt[ph * 16 + i] = okey_inv(top[i] & ~127); sit[ph * 16 + i] = (unsigned char)(127 - (top[i] & 127)); }
            __syncthreads();
        }
        float sv[2][16];
#pragma unroll
        for (int i = 0; i < 16; ++i) { sv[0][i] = svt[i]; sv[1][i] = svt[16 + i]; }
        int w0[16], w1[16];
#pragma unroll
        for (int s = 0; s < 32; ++s) {
            const int e0 = 2 * s, e1 = 2 * s + 1;
            int key;
            if (e0 >= NCELL) key = (int)0x80000000;
            else {
                const float v0 = sv[0][CELL_I[e0]] + sv[1][CELL_J[e0]];
                const int k0 = (okey(v0) & ~255) | (255 - (CELL_I[e0] * 16 + CELL_J[e0]));
                if (e1 >= NCELL) key = hh ? (int)0x80000000 : k0;
                else { const float v1 = sv[0][CELL_I[e1]] + sv[1][CELL_J[e1]];
                    const int k1 = (okey(v1) & ~255) | (255 - (CELL_I[e1] * 16 + CELL_J[e1]));
                    key = hh ? k1 : k0; }
            }
            if (s < 16) w0[s] = key; else w1[s - 16] = key;
        }
        sort16_desc(w0); sort16_desc(w1); merge16_desc(w0, w1); pair_merge(w0);
        const float mx = okey_inv(w0[0] & ~255);
        float sum = 0.f;
#pragma unroll
        for (int k = 0; k < 16; ++k) sum += __expf(okey_inv(w0[k] & ~255) - mx);
        const float inv = 1.0f / sum;
        int eo[8]; float go[8]; const int hmask = -hh;
#pragma unroll
        for (int k = 0; k < 8; ++k) { const int kk = (w0[k] & ~hmask) | (w0[8 + k] & hmask); const int cc = 255 - (kk & 255);
            eo[k] = (int)sit[cc >> 4] * 128 + (int)sit[16 + (cc & 15)]; go[k] = __expf(okey_inv(kk & ~255) - mx) * inv; }
        const size_t ob = (size_t)(u.pm * 256 + trow) * 128 + h * 16 + hh * 8;
        *(u32x4*)(idx + ob) = (u32x4){(unsigned)eo[0] | ((unsigned)eo[1] << 16), (unsigned)eo[2] | ((unsigned)eo[3] << 16), (unsigned)eo[4] | ((unsigned)eo[5] << 16), (unsigned)eo[6] | ((unsigned)eo[7] << 16)};
        *(f32x4*)(gsu + ob) = (f32x4){go[0], go[1], go[2], go[3]};
        *(f32x4*)(gsu + ob + 4) = (f32x4){go[4], go[5], go[6], go[7]};
    }
    __device__ __forceinline__ void operator()(const f32x4 (&)[2][2][4][2], const pg8::Unit&, int, int, int, int) const {}
};

__device__ __forceinline__ void fp8_row2(const float* s0, unsigned char* d0, float* i0, const float* s1, unsigned char* d1, float* i1, int lane) {
    f32x4 v[2][2][4]; float am[2] = {0.f, 0.f};
#pragma unroll
    for (int r = 0; r < 2; ++r)
#pragma unroll
        for (int k = 0; k < 2; ++k)
#pragma unroll
            for (int i = 0; i < 4; ++i) v[r][k][i] = __builtin_nontemporal_load((const f32x4*)((r ? s1 : s0) + 1024 * k + 16 * lane + 4 * i));
#pragma unroll
    for (int r = 0; r < 2; ++r) {
#pragma unroll
        for (int k = 0; k < 2; ++k)
#pragma unroll
            for (int i = 0; i < 4; ++i) am[r] = fmaxf(am[r], fmaxf(fmaxf(fabsf(v[r][k][i].x), fabsf(v[r][k][i].y)), fmaxf(fabsf(v[r][k][i].z), fabsf(v[r][k][i].w))));
#pragma unroll
        for (int o = 1; o < 64; o <<= 1) am[r] = fmaxf(am[r], __shfl_xor(am[r], o));
        int be = (__float_as_int(am[r]) >> 23) & 255; be = be < 8 ? 8 : (be > 248 ? 248 : be);
        const float sc = __int_as_float((260 - be) << 23), isc = __int_as_float((be - 6) << 23);
#pragma unroll
        for (int k = 0; k < 2; ++k) { u32x4 w; unsigned ww[4];
#pragma unroll
            for (int i = 0; i < 4; ++i) { int t = 0; t = __builtin_amdgcn_cvt_pk_fp8_f32(v[r][k][i].x * sc, v[r][k][i].y * sc, t, false); t = __builtin_amdgcn_cvt_pk_fp8_f32(v[r][k][i].z * sc, v[r][k][i].w * sc, t, true); ww[i] = (unsigned)t; }
            w.x = ww[0]; w.y = ww[1]; w.z = ww[2]; w.w = ww[3];
            *(u32x4*)((r ? d1 : d0) + 1024 * k + 16 * lane) = w; }
        if (lane == 0) *(r ? i1 : i0) = isc;
    }
}

typedef float f32x2 __attribute__((ext_vector_type(2)));
template <int N> __device__ __forceinline__ f32x2 dot16_fp8(const u32x4 w, const f32x2 (&x)[N], int o, f32x2 acc) {
    const unsigned ww[4] = {w.x, w.y, w.z, w.w};
#pragma unroll
    for (int d = 0; d < 4; ++d) { acc += __builtin_amdgcn_cvt_pk_f32_fp8((int)ww[d], false) * x[o + 2 * d]; acc += __builtin_amdgcn_cvt_pk_f32_fp8((int)ww[d], true) * x[o + 2 * d + 1]; }
    return acc;
}
template <int N> __device__ __forceinline__ void axpy16_fp8(const u32x4 w, float a, f32x2 (&y)[N], int o) {
    const unsigned ww[4] = {w.x, w.y, w.z, w.w}; const f32x2 a2 = {a, a};
#pragma unroll
    for (int d = 0; d < 4; ++d) { y[o + 2 * d] += a2 * __builtin_amdgcn_cvt_pk_f32_fp8((int)ww[d], false); y[o + 2 * d + 1] += a2 * __builtin_amdgcn_cvt_pk_f32_fp8((int)ww[d], true); }
}
__device__ __forceinline__ void bstore16(__amdgpu_buffer_rsrc_t r, f32x4 v, int voff, int soff) { __builtin_amdgcn_raw_buffer_store_b128(__builtin_bit_cast(__attribute__((__vector_size__(4 * sizeof(unsigned)))) unsigned, v), r, voff, soff, 0); }
__device__ __forceinline__ void bstore8(__amdgpu_buffer_rsrc_t r, f32x2 v, int voff, int soff) { __builtin_amdgcn_raw_buffer_store_b64(__builtin_bit_cast(__attribute__((__vector_size__(2 * sizeof(unsigned)))) unsigned, v), r, voff, soff, 0); }
__device__ __forceinline__ f32x2 fsel2(int mask, f32x2 a, f32x2 b) { return (f32x2){fsel(mask, a.x, b.x), fsel(mask, a.y, b.y)}; }
__device__ __forceinline__ f32x2 shx2(f32x2 a, int o) { return (f32x2){__shfl_xor(a.x, o), __shfl_xor(a.y, o)}; }

__device__ __forceinline__ void phase_pd(const Params& p, int bid, int nb) {
    const int tid = threadIdx.x, lane = tid & 63, wave = __builtin_amdgcn_readfirstlane(tid >> 6);
    if (wave == 7) {
        for (int e = bid; e < 16384; e += 2 * nb) { const int e2 = e + nb < 16384 ? e + nb : e;
            fp8_row2(p.up + (size_t)e * D, p.up8 + (size_t)e * D, p.sup + e, p.up + (size_t)e2 * D, p.up8 + (size_t)e2 * D, p.sup + e2, lane); }
        return;
    }
    const int v = bid & 7, lw = (bid >> 3) * 7 + wave, NLW = (nb >> 3) * 7;
    const int c = lane & 7, sub = lane >> 3;
    const int m0 = -(lane & 1), m1 = -((lane >> 1) & 1), m2 = -((lane >> 2) & 1);
    const __amdgpu_buffer_rsrc_t rd = __builtin_amdgcn_make_buffer_rsrc((void*)p.down8, 0, 16384 * D, 0x00020000);
    const __amdgpu_buffer_rsrc_t rh = __builtin_amdgcn_make_buffer_rsrc((void*)p.h2b, 0, SEQ * D * 2, 0x00020000);
    const __amdgpu_buffer_rsrc_t rg1 = __builtin_amdgcn_make_buffer_rsrc((void*)p.ffn_g, 0, D * 4, 0x00020000);
    const __amdgpu_buffer_rsrc_t ri = __builtin_amdgcn_make_buffer_rsrc((void*)p.idx, 0, SEQ * 128 * 2, 0x00020000);
    const __amdgpu_buffer_rsrc_t rrs = __builtin_amdgcn_make_buffer_rsrc((void*)p.rstd, 0, SEQ * 4, 0x00020000);
    const __amdgpu_buffer_rsrc_t rp = __builtin_amdgcn_make_buffer_rsrc((void*)p.part, 0, SEQ * 16 * 128 * 2, 0x00020000);
    const int vsub = sub * 32, vc2 = c * 32, vc1 = c * 16, vl4 = lane * 4;
#pragma unroll 1
    for (int pass = 0; pass < 2; ++pass) {
        const int sl = v * 2 + pass;
        f32x2 gs[8];
#pragma unroll
        for (int i = 0; i < 4; ++i) { const f32x4 g = __builtin_bit_cast(f32x4, bload16(rg1, c * 64, sl * 512 + i * 16)); gs[2 * i] = (f32x2){g[0], g[1]}; gs[2 * i + 1] = (f32x2){g[2], g[3]}; }
        u32x4 ix[2], hh[2]; unsigned rsb;
        {
            const int t = lw;
#pragma unroll
            for (int i = 0; i < 2; ++i) ix[i] = bload16(ri, vsub, t * 256 + i * 16);
            hh[0] = bload16(rh, vc2, t * 4096 + sl * 256); hh[1] = bload16(rh, vc2, t * 4096 + sl * 256 + 16); rsb = bload4(rrs, 0, t * 4);
        }
#pragma unroll 1
        for (int t = lw; t < SEQ; t += NLW) {
            asm volatile("" ::: "memory");
            u32x4 w[16];
            {
                const unsigned ew[8] = {ix[0].x, ix[0].y, ix[0].z, ix[0].w, ix[1].x, ix[1].y, ix[1].z, ix[1].w};
#pragma unroll
                for (int g = 0; g < 16; ++g) { const unsigned e = (g & 1) ? (ew[g >> 1] >> 16) : (ew[g >> 1] & 0xffffu); w[g] = bload16(rd, (int)(e * 2048u) + vc1, sl * 128); }
            }
            f32x2 xs[8];
            {
                const float rs = __uint_as_float(rsb);
                const unsigned hw[8] = {hh[0].x, hh[0].y, hh[0].z, hh[0].w, hh[1].x, hh[1].y, hh[1].z, hh[1].w};
#pragma unroll
                for (int i = 0; i < 8; ++i) xs[i] = (f32x2){bf_lo(hw[i]) * rs, bf_hi(hw[i]) * rs} * gs[i];
            }
            asm volatile("" ::: "memory");
            {
                const int tn = t + NLW < SEQ ? t + NLW : t;
#pragma unroll
                for (int i = 0; i < 2; ++i) ix[i] = bload16(ri, vsub, tn * 256 + i * 16);
                hh[0] = bload16(rh, vc2, tn * 4096 + sl * 256); hh[1] = bload16(rh, vc2, tn * 4096 + sl * 256 + 16); rsb = bload4(rrs, 0, tn * 4);
            }
            asm volatile("" ::: "memory");
            float r[16];
#pragma unroll
            for (int g = 0; g < 16; ++g) { const f32x2 z = {0.f, 0.f}; const f32x2 s2 = dot16_fp8(w[g], xs, 0, z); r[g] = s2.x + s2.y; }
            float k8[8], k4[4];
#pragma unroll
            for (int i = 0; i < 8; ++i) k8[i] = fsel(m2, r[i], r[i + 8]) + __shfl_xor(fsel(m2, r[i + 8], r[i]), 4);
#pragma unroll
            for (int i = 0; i < 4; ++i) k4[i] = fsel(m1, k8[i], k8[i + 4]) + __shfl_xor(fsel(m1, k8[i + 4], k8[i]), 2);
            const float k0 = fsel(m0, k4[0], k4[2]) + __shfl_xor(fsel(m0, k4[2], k4[0]), 1);
            const float k1 = fsel(m0, k4[1], k4[3]) + __shfl_xor(fsel(m0, k4[3], k4[1]), 1);
            bstore4(rp, cvt_pk_bf16(k0, k1), vl4, (t * 16 + sl) * 256);
        }
    }
}
__device__ __forceinline__ void phase_pa(const Params& p, int bid, int nb) {
    const int tid = threadIdx.x, lane = tid & 63, wave = tid >> 6;
    const int gw = bid * 8 + wave, NGW = nb * 8;
    for (int it = gw; it < SEQ * 2; it += NGW) {
        const int t = it >> 1, pp = (it & 1) * 64 + lane;
        const bf16_t* pr = p.part + (size_t)t * 2048 + pp;
        float hs = 0.f;
#pragma unroll
        for (int sl = 0; sl < 16; ++sl) hs += __uint_as_float((unsigned)pr[sl * 128] << 16);
        const int e = (int)p.idx[(size_t)t * 128 + pp];
        hs *= p.sdn[e];
        const float av = p.gsu[(size_t)t * 128 + pp] * p.sup[e] * 0.5f * hs * (1.0f + erff(hs * 0.70710678118654752f));
        p.act[(size_t)t * 128 + pp] = (bf16_t)(cvt_pk_bf16(av, 0.f) & 0xffffu);
    }
}
__device__ __forceinline__ void phase_pu(const Params& p, int bid, int nb) {
    const int tid = threadIdx.x, lane = tid & 63, wave = __builtin_amdgcn_readfirstlane(tid >> 6);
    const int v = bid & 7, lw = (bid >> 3) * 8 + wave, NLW = (nb >> 3) * 8;
    const int c = lane & 7, sub = lane >> 3;
    const int m3 = -((lane >> 3) & 1), m4 = -((lane >> 4) & 1), m5 = -((lane >> 5) & 1);
    const __amdgpu_buffer_rsrc_t ru = __builtin_amdgcn_make_buffer_rsrc((void*)p.up8, 0, 16384 * D, 0x00020000);
    const __amdgpu_buffer_rsrc_t rh = __builtin_amdgcn_make_buffer_rsrc((void*)p.h2b, 0, SEQ * D * 2, 0x00020000);
    const __amdgpu_buffer_rsrc_t ri = __builtin_amdgcn_make_buffer_rsrc((void*)p.idx, 0, SEQ * 128 * 2, 0x00020000);
    const __amdgpu_buffer_rsrc_t ra = __builtin_amdgcn_make_buffer_rsrc((void*)p.act, 0, SEQ * 128 * 2, 0x00020000);
    const __amdgpu_buffer_rsrc_t ro = __builtin_amdgcn_make_buffer_rsrc((void*)p.h3b, 0, SEQ * D * 2, 0x00020000);
    const __amdgpu_buffer_rsrc_t rq = __builtin_amdgcn_make_buffer_rsrc((void*)p.ssq2, 0, SEQ * 16 * 4, 0x00020000);
    const int vsub = sub * 32, vc1 = c * 16, vh = c * 32 + sub * 4;
#pragma unroll 1
    for (int pass = 0; pass < 2; ++pass) {
        const int sl = v * 2 + pass;
        u32x4 ix[2], ac[2]; unsigned hb;
        {
            const int t = lw;
#pragma unroll
            for (int i = 0; i < 2; ++i) { ix[i] = bload16(ri, vsub, t * 256 + i * 16); ac[i] = bload16(ra, vsub, t * 256 + i * 16); }
            hb = bload4(rh, vh, t * 4096 + sl * 256);
        }
#pragma unroll 1
        for (int t = lw; t < SEQ; t += NLW) {
            asm volatile("" ::: "memory");
            u32x4 w[16];
            {
                const unsigned ew[8] = {ix[0].x, ix[0].y, ix[0].z, ix[0].w, ix[1].x, ix[1].y, ix[1].z, ix[1].w};
#pragma unroll
                for (int g = 0; g < 16; ++g) { const unsigned e = (g & 1) ? (ew[g >> 1] >> 16) : (ew[g >> 1] & 0xffffu); w[g] = bload16(ru, (int)(e * 2048u) + vc1, sl * 128); }
            }
            const unsigned aw[8] = {ac[0].x, ac[0].y, ac[0].z, ac[0].w, ac[1].x, ac[1].y, ac[1].z, ac[1].w};
            float a[16];
#pragma unroll
            for (int g = 0; g < 16; ++g) a[g] = (g & 1) ? bf_hi(aw[g >> 1]) : bf_lo(aw[g >> 1]);
            const unsigned hcur = hb;
            asm volatile("" ::: "memory");
            {
                const int tn = t + NLW < SEQ ? t + NLW : t;
#pragma unroll
                for (int i = 0; i < 2; ++i) { ix[i] = bload16(ri, vsub, tn * 256 + i * 16); ac[i] = bload16(ra, vsub, tn * 256 + i * 16); }
                hb = bload4(rh, vh, tn * 4096 + sl * 256);
            }
            asm volatile("" ::: "memory");
            f32x2 acc[8];
#pragma unroll
            for (int i = 0; i < 8; ++i) acc[i] = (f32x2){0.f, 0.f};
#pragma unroll
            for (int g = 0; g < 16; ++g) axpy16_fp8(w[g], a[g], acc, 0);
            f32x2 k4[4], k2[2];
#pragma unroll
            for (int i = 0; i < 4; ++i) k4[i] = fsel2(m5, acc[i], acc[i + 4]) + shx2(fsel2(m5, acc[i + 4], acc[i]), 32);
#pragma unroll
            for (int i = 0; i < 2; ++i) k2[i] = fsel2(m4, k4[i], k4[i + 2]) + shx2(fsel2(m4, k4[i + 2], k4[i]), 16);
            f32x2 h3 = fsel2(m3, k2[0], k2[1]) + shx2(fsel2(m3, k2[1], k2[0]), 8);
            h3 += (f32x2){bf_lo(hcur), bf_hi(hcur)};
            bstore4(ro, cvt_pk_bf16(h3.x, h3.y), vh, t * 4096 + sl * 256);
            const float ss = wave_sum(h3.x * h3.x + h3.y * h3.y);
            if (lane == 0) bstore4(rq, __float_as_uint(ss), 0, (t * 16 + sl) * 4);
        }
    }
}
__device__ __forceinline__ void phase_pf(const Params& p, int bid, int nb) {
    const int tid = threadIdx.x, lane = tid & 63, wave = tid >> 6;
    const int gw = bid * 8 + wave, NGW = nb * 8;
    for (int t = gw; t < SEQ; t += NGW) {
        const f32x4* sp = (const f32x4*)(p.ssq2 + (size_t)t * 16); f32x4 q = sp[0] + sp[1] + sp[2] + sp[3];
        const float rf = rsqrtf(((q[0] + q[1]) + (q[2] + q[3])) * (1.0f / D) + 1e-6f);
        const u32x4* hp = (const u32x4*)(p.h3b + (size_t)t * D) + lane;
        f32x4* o = (f32x4*)(p.out + (size_t)t * D) + 2 * lane; const f32x4* g = (const f32x4*)p.fin_g + 2 * lane;
#pragma unroll
        for (int j = 0; j < 4; ++j) { const u32x4 h = hp[64 * j]; const f32x4 g0 = g[128 * j], g1 = g[128 * j + 1];
            o[128 * j] = (f32x4){bf_lo(h.x) * rf * g0[0], bf_hi(h.x) * rf * g0[1], bf_lo(h.y) * rf * g0[2], bf_hi(h.y) * rf * g0[3]};
            o[128 * j + 1] = (f32x4){bf_lo(h.z) * rf * g1[0], bf_hi(h.z) * rf * g1[1], bf_lo(h.w) * rf * g1[2], bf_hi(h.w) * rf * g1[3]}; }
    }
}

__device__ __forceinline__ void fp8_row(const float* src, unsigned char* dst, float* inv_scale, int lane) {
    f32x4 v[2][4]; float am = 0.f;
#pragma unroll
    for (int k = 0; k < 2; ++k)
#pragma unroll
        for (int i = 0; i < 4; ++i) { v[k][i] = *(const f32x4*)(src + 1024 * k + 16 * lane + 4 * i);
            am = fmaxf(am, fmaxf(fmaxf(fabsf(v[k][i].x), fabsf(v[k][i].y)), fmaxf(fabsf(v[k][i].z), fabsf(v[k][i].w)))); }
#pragma unroll
    for (int o = 1; o < 64; o <<= 1) am = fmaxf(am, __shfl_xor(am, o));
    int be = (__float_as_int(am) >> 23) & 255; be = be < 8 ? 8 : (be > 248 ? 248 : be);
    const float sc = __int_as_float((260 - be) << 23), isc = __int_as_float((be - 6) << 23);
#pragma unroll
    for (int k = 0; k < 2; ++k) { u32x4 w; unsigned ww[4];
#pragma unroll
        for (int i = 0; i < 4; ++i) { int t = 0; t = __builtin_amdgcn_cvt_pk_fp8_f32(v[k][i].x * sc, v[k][i].y * sc, t, false); t = __builtin_amdgcn_cvt_pk_fp8_f32(v[k][i].z * sc, v[k][i].w * sc, t, true); ww[i] = (unsigned)t; }
        w.x = ww[0]; w.y = ww[1]; w.z = ww[2]; w.w = ww[3];
        *(u32x4*)(dst + 1024 * k + 16 * lane) = w; }
    if (lane == 0) *inv_scale = isc;
}

__device__ __forceinline__ void tr_item(const float* W, int ldw, int srccol0, int k0, bf16_t* WT, int ldt, int n0, const float* kscale, const float* nscale, LAS float* scr, int lane) {
    float tv[32];
#pragma unroll
    for (int i = 0; i < 32; ++i) { const int kk = 2 * i + (lane >> 5); tv[i] = W[(size_t)(k0 + kk) * ldw + srccol0 + (lane & 31)]; }
    const float ns = nscale ? nscale[srccol0 + (lane & 31)] : 1.0f;
#pragma unroll
    for (int i = 0; i < 32; ++i) { const int kk = 2 * i + (lane >> 5); float v = tv[i] * ns;
        if (kscale) v *= kscale[k0 + kk]; scr[kk * 33 + (lane & 31)] = v; }
    asm volatile("s_waitcnt lgkmcnt(0)" ::: "memory");
    const int c = lane & 7;
#pragma unroll
    for (int j = 0; j < 4; ++j) { const int n = (lane >> 3) + 8 * j; const LAS float* s = scr + (8 * c) * 33 + n;
        u32x4 o; o.x = cvt_pk_bf16(s[0 * 33], s[1 * 33]); o.y = cvt_pk_bf16(s[2 * 33], s[3 * 33]); o.z = cvt_pk_bf16(s[4 * 33], s[5 * 33]); o.w = cvt_pk_bf16(s[6 * 33], s[7 * 33]);
        *(u32x4*)(WT + (size_t)(n0 + n) * ldt + k0 + 8 * c) = o; }
    asm volatile("s_waitcnt lgkmcnt(0)" ::: "memory");
}
__device__ __forceinline__ int win_srccol(int n) { const int pn = n >> 8, w = n & 255; return pn < 4 ? n : ((w >> 7) ? 2048 : 1024) + (pn - 4) * 128 + (w & 127); }

__device__ __forceinline__ void phase_prep(const Params& p, LAS unsigned char* lds, int bid, int nb) {
    const int tid = threadIdx.x, lane = tid & 63, wave = tid >> 6;
    const int gw = bid * 8 + wave, NGW = nb * 8;
    LAS float* scr = (LAS float*)(lds + wave * 8448);
    for (int r = gw; r < RT; r += NGW) {
        unsigned long long* o8 = (unsigned long long*)(p.hnb + (size_t)r * D) + lane;
        if (r < RPAD) {
#pragma unroll
            for (int j = 0; j < 8; ++j) o8[64 * j] = 0ull;
        } else {
            const f32x4* xr = (const f32x4*)hrow(p, r - RPAD) + lane;
            const f32x4* gr = (const f32x4*)p.mix_g + lane;
            f32x4 v[8]; float s = 0.f;
#pragma unroll
            for (int j = 0; j < 8; ++j) { v[j] = __builtin_nontemporal_load(xr + 64 * j); s += (v[j].x * v[j].x + v[j].y * v[j].y) + (v[j].z * v[j].z + v[j].w * v[j].w); }
            const float rs = rsqrtf(wave_sum(s) * (1.0f / D) + 1e-6f);
#pragma unroll
            for (int j = 0; j < 8; ++j) { const f32x4 gv = gr[64 * j];
                o8[64 * j] = (unsigned long long)cvt_pk_bf16(v[j].x * rs * gv.x, v[j].y * rs * gv.y) | ((unsigned long long)cvt_pk_bf16(v[j].z * rs * gv.z, v[j].w * rs * gv.w) << 32); }
        }
    }
    for (int it = gw; it < (D / 64) * (INW / 32); it += NGW) {
        const int kb = it / (INW / 32), nbk = it % (INW / 32);
        tr_item(p.w_in, INW, win_srccol(nbk * 32), kb * 64, p.w_in_t, D, nbk * 32, nullptr, nullptr, scr, lane);
    }
    for (int i = gw * 64 + lane; i < 4 * 256 * 256 / 4; i += NGW * 64) { const f32x4 v = ((const f32x4*)p.pool_w)[i];
        const int g = i >> 14, d = (i & 63) * 4; const f32x4 sc = *(const f32x4*)(p.pool_scale + g * 256 + d);
        u32x2 w; w.x = cvt_pk_bf16(v[0] * sc[0], v[1] * sc[1]); w.y = cvt_pk_bf16(v[2] * sc[2], v[3] * sc[3]); ((u32x2*)p.pool_ws)[i] = w; }
    for (int i = gw * 64 + lane; i < CWD * CWD / 4; i += NGW * 64) { const f32x4 v = ((const f32x4*)p.pw_w)[i];
        u32x2 w; w.x = cvt_pk_bf16(v[0], v[1]); w.y = cvt_pk_bf16(v[2], v[3]); ((u32x2*)p.pw_b16)[i] = w; }
    for (int it = gw; it < 32 * 64; it += NGW) { const int kb = it >> 6, nbk = it & 63;
        tr_item(p.w_out, D, nbk * 32, kb * 64, p.w_out_t, D, nbk * 32, nullptr, nullptr, scr, lane); }
    for (int it = gw; it < 32 * 64; it += NGW) { const int kb = it >> 6, nbk = it & 63;
        tr_item(p.wq, D, nbk * 32, kb * 64, p.wq_t, D, nbk * 32, p.ffn_g, nullptr, scr, lane); }
    for (int i = gw * 64 + lane; i < 8 * 2 * 128 * 128 / 4; i += NGW * 64) { const f32x4 v = ((const f32x4*)p.keys)[i];
        u32x2 w; w.x = cvt_pk_bf16(v[0], v[1]); w.y = cvt_pk_bf16(v[2], v[3]); ((u32x2*)p.keysb)[i] = w; }
    for (int e = gw; e < 16384; e += 2 * NGW) { const int e2 = e + NGW < 16384 ? e + NGW : e;
        fp8_row2(p.down + (size_t)e * D, p.down8 + (size_t)e * D, p.sdn + e, p.down + (size_t)e2 * D, p.down8 + (size_t)e2 * D, p.sdn + e2, lane); }
}


#define XB_TMO      128
#define XB_XCNT(j)  (256  + 64 * (j))
#define XB_XSUB(j)  (1280 + 64 * (j))
#define XB_XGEN(j)  (2304 + 64 * (j))
#define XB_TOP      3328
#define XB_TOPGEN   3392
#define XCD_BAR_WORDS 3456
#define XB_SPIN_CAP (1u << 18)
__device__ __forceinline__ unsigned xb_ld(unsigned* p)              { return __hip_atomic_load(p, __ATOMIC_RELAXED, __HIP_MEMORY_SCOPE_AGENT); }
__device__ __forceinline__ unsigned xb_add(unsigned* p, unsigned v) { return __hip_atomic_fetch_add(p, v, __ATOMIC_RELAXED, __HIP_MEMORY_SCOPE_AGENT); }
__device__ __forceinline__ unsigned xb_xcc_id() { return (unsigned)__builtin_amdgcn_s_getreg((3 << 11) | 20) & 0xFu; }
#define XB_SPIN(cond, bar) do { unsigned _sp = 0; while (cond) { __builtin_amdgcn_s_sleep(1); \
    if ((++_sp & 255u) == 0u) { if (xb_ld(&(bar)[XB_TMO])) break; if (_sp > XB_SPIN_CAP) { atomicAdd(&(bar)[XB_TMO], 1u); break; } } } } while (0)
struct XcdBarrier { unsigned* bar; unsigned x; volatile LAS unsigned* st; };
__device__ __forceinline__ XcdBarrier xcd_barrier_post(unsigned* bar, volatile LAS unsigned* st) {
    XcdBarrier b; b.bar = bar; b.x = xb_xcc_id(); b.st = st;
    if (threadIdx.x == 0) (void)xb_add(&bar[XB_XCNT(b.x)], 1u);
    return b;
}
__device__ __forceinline__ void xcd_barrier_complete(unsigned* bar, unsigned x, unsigned& nloc, unsigned& nx) {
    const unsigned G = gridDim.x * gridDim.y * gridDim.z;
    unsigned sum, cnt, mine, sp = 0u;
    for (;;) {
        sum = 0u; cnt = 0u; mine = 0u;
#pragma unroll
        for (unsigned j = 0; j < 16; ++j) { const unsigned c = xb_ld(&bar[XB_XCNT(j)]); sum += c; cnt += (c > 0u) ? 1u : 0u; mine = (j == x) ? c : mine; }
        if (sum == G) break;
        __builtin_amdgcn_s_sleep(1);
        if ((++sp & 255u) == 0u) { if (xb_ld(&bar[XB_TMO])) break; if (sp > XB_SPIN_CAP) { atomicAdd(&bar[XB_TMO], 1u); break; } }
    }
    nloc = mine > 0u ? mine : 1u; nx = cnt > 0u ? cnt : 1u;
}
__device__ __forceinline__ void xcd_barrier(const XcdBarrier& b) {
    asm volatile("s_waitcnt vmcnt(0)" ::: "memory");
    __syncthreads();
    if (threadIdx.x == 0) {
        unsigned* bar = b.bar;
        __builtin_amdgcn_s_waitcnt(0);
        unsigned nloc = b.st[0], nx = b.st[1];
        if (nloc == 0u) { xcd_barrier_complete(bar, b.x, nloc, nx); b.st[0] = nloc; b.st[1] = nx; }
        const unsigned old = xb_add(&bar[XB_XSUB(b.x)], 1u);
        const unsigned gen = old / nloc;
        if (old + 1u == (gen + 1u) * nloc) {
            __builtin_amdgcn_fence(__ATOMIC_RELEASE, "agent");
            asm volatile("s_waitcnt vmcnt(0)" ::: "memory");
            const unsigned og = xb_add(&bar[XB_TOP], 1u);
            const unsigned tg = og / nx;
            if (og + 1u == (tg + 1u) * nx) xb_add(&bar[XB_TOPGEN], 1u);
            else XB_SPIN(xb_ld(&bar[XB_TOPGEN]) == tg, bar);
            __builtin_amdgcn_fence(__ATOMIC_ACQUIRE, "agent");
            xb_add(&bar[XB_XGEN(b.x)], 1u);
            asm volatile("s_waitcnt vmcnt(0)" ::: "memory");
        } else {
            XB_SPIN(xb_ld(&bar[XB_XGEN(b.x)]) == gen, bar);
            __builtin_amdgcn_fence(__ATOMIC_ACQUIRE, "agent");
            asm volatile("s_waitcnt vmcnt(0)" ::: "memory");
        }
    }
    __syncthreads();
}

__global__ void __launch_bounds__(NT, 2) k_mega(Params p) {
    extern __shared__ __attribute__((aligned(16))) unsigned char lds_raw[];
    LAS unsigned char* lds = (LAS unsigned char*)lds_raw;
    const int bid = blockIdx.x, nb = gridDim.x;
    volatile LAS unsigned* bst = (volatile LAS unsigned*)(lds + LDS_BYTES - 16);
    if (threadIdx.x < 4) bst[threadIdx.x] = 0u;
    __syncthreads();
    const XcdBarrier xb = xcd_barrier_post(p.bar, bst);
    phase_prep(p, lds, bid, nb);
    xcd_barrier(xb);
    { pg8::Gemm g{p.hnb, p.w_in_t, D, D, D, 0}; pg8::StaticOrder S; S.init(RT / 256, INW / 256, nb, bid); EpiProj E{p.xp, p.glu};
      pg8::gemm_phase<EpiProj, pg8::StaticOrder>(lds, g, S, E); }
    { const int nproj = (RT / 256) * (INW / 256); const int first = (nproj > nb && nproj < 2 * nb) ? nproj - nb : 0, nfree = nb - first;
      for (int uu = bid - first; uu >= 0 && uu < 64; uu += nfree) {
        __syncthreads();
        const bool pw = uu < 32;
        pg8::Gemm g{pw ? p.w_out_t + PWD : p.w_out_t, pw ? p.pw_b16 : p.pool_ws, D, pw ? CWD : 256, pw ? CWD : 256, pw ? 0 : 256};
        pg8::OneUnit S; S.u.pm = (uu & 31) >> 2; S.u.pn = uu & 3; EpiBf16Out E{p.w_eff_t, D, pw ? PWD : 0, nullptr};
        pg8::gemm_phase<EpiBf16Out, pg8::OneUnit>(lds, g, S, E);
      }
      { const int b0 = nfree >= 96 ? first + 64 : 0;
        for (int nbk = bid - b0; nbk >= 0 && nbk < D / 64; nbk += nb) {
          __syncthreads();
          const int lane = threadIdx.x & 63, wv = threadIdx.x >> 6, n = nbk * 64 + lane;
          float a[8] = {0.f, 0.f, 0.f, 0.f, 0.f, 0.f, 0.f, 0.f};
          for (int j = wv * 128; j < wv * 128 + 128; j += 8) {
#pragma unroll
            for (int q = 0; q < 8; ++q) a[q] += p.pw_b[j + q] * p.w_out[(size_t)(PWD + j + q) * D + n]; }
          LAS float* red = (LAS float*)lds;
          red[wv * 64 + lane] = ((a[0] + a[1]) + (a[2] + a[3])) + ((a[4] + a[5]) + (a[6] + a[7]));
          __syncthreads();
          if (wv == 0) { float t = 0.f;
#pragma unroll
            for (int q = 0; q < 8; ++q) t += red[q * 64 + lane];
            p.bias_eff[n] = t; }
        } }
    }
    xcd_barrier(xb);
    phase_mix(p, lds, bid, nb);
    xcd_barrier(xb);
    { pg8::Gemm g{p.mixb, p.w_eff_t, D, D, D, 0}; pg8::StaticOrder S; S.init(SEQ / 256, D / 256, nb, bid); EpiResid E{p.x, p.bias_eff, p.h2b, p.ssq};
      pg8::gemm_phase<EpiResid, pg8::StaticOrder>(lds, g, S, E); }
    xcd_barrier(xb);
    { pg8::Gemm g{p.h2b, p.wq_t, D, D, D, 0}; pg8::StaticOrder S; S.init(SEQ / 256, D / 256, nb, bid); EpiQTopk E{p.ssq, p.rstd, p.keysb, p.idx, p.gsu};
      pg8::gemm_phase<EpiQTopk, pg8::StaticOrder>(lds, g, S, E); }
    xcd_barrier(xb);
    phase_pd(p, bid, nb);
    xcd_barrier(xb);
    phase_pa(p, bid, nb);
    xcd_barrier(xb);
    phase_pu(p, bid, nb);
    xcd_barrier(xb);
    phase_pf(p, bid, nb);
}

extern "C" void kernel_launch(void* const* d_in, const int* in_sizes, int n_in, void* d_out, int out_size, void* d_ws, size_t ws_size, hipStream_t stream) {
    Params p{};
    p.x = (const float*)d_in[0]; p.meta = (const float*)d_in[1]; p.mix_g = (const float*)d_in[2]; p.w_in = (const float*)d_in[3];
    p.pool_w = (const float*)d_in[4]; p.pool_scale = (const float*)d_in[5]; p.dw_w = (const float*)d_in[6]; p.dw_b = (const float*)d_in[7];
    p.ln_g = (const float*)d_in[8]; p.ln_b = (const float*)d_in[9]; p.pw_w = (const float*)d_in[10]; p.pw_b = (const float*)d_in[11];
    p.w_out = (const float*)d_in[12]; p.ffn_g = (const float*)d_in[13]; p.wq = (const float*)d_in[14]; p.keys = (const float*)d_in[15];
    p.down = (const float*)d_in[16]; p.up = (const float*)d_in[17]; p.fin_g = (const float*)d_in[18];
    p.out = (float*)d_out;
    char* w = (char*)d_ws; size_t off = 0;
    auto take = [&](size_t bytes) { char* r = w + off; off += (bytes + 255) & ~(size_t)255; return r; };
    p.idx = (unsigned short*)take((size_t)SEQ * 128 * 2);
    p.gsu = (float*)take((size_t)SEQ * 128 * 4);
    p.part = (bf16_t*)take((size_t)SEQ * 16 * 128 * 2);
    p.act = (bf16_t*)take((size_t)SEQ * 128 * 2);
    p.ssq2 = (float*)take((size_t)SEQ * 16 * 4);
    p.h3b = (bf16_t*)take((size_t)SEQ * D * 2);
    p.hnb = (bf16_t*)take((size_t)RT * D * 2);
    p.w_in_t = (bf16_t*)take((size_t)INW * D * 2);
    p.xp = (bf16_t*)take((size_t)RT * PWD * 2);
    p.glu = (bf16_t*)take((size_t)RT * CWD * 2);
    p.mixb = (bf16_t*)take((size_t)SEQ * D * 2);
    p.h2b = (bf16_t*)take((size_t)SEQ * D * 2);
    p.pool_ws = (bf16_t*)take((size_t)4 * 256 * 256 * 2);
    p.pw_b16 = (bf16_t*)take((size_t)CWD * CWD * 2);
    p.w_eff_t = (bf16_t*)take((size_t)D * D * 2);
    p.bias_eff = (float*)take((size_t)D * 4);
    p.w_out_t = (bf16_t*)take((size_t)D * D * 2);
    p.ssq = (float*)take((size_t)SEQ * 32 * 4);
    p.bar = (unsigned*)take((size_t)XCD_BAR_WORDS * 4);
    p.rstd = (float*)take((size_t)SEQ * 4);
    p.wq_t = (bf16_t*)take((size_t)D * D * 2);
    p.keysb = (bf16_t*)take((size_t)8 * 2 * 128 * 128 * 2);
    p.qb = (bf16_t*)take((size_t)SEQ * D * 2);
    p.down8 = (unsigned char*)take((size_t)16384 * D);
    p.up8 = (unsigned char*)take((size_t)16384 * D);
    p.sdn = (float*)take((size_t)16384 * 4);
    p.sup = (float*)take((size_t)16384 * 4);
    static int grid_blocks = 0;
    if (!grid_blocks) {
        int dev = 0, cus = 0, per_cu = 0;
        (void)hipGetDevice(&dev);
        (void)hipDeviceGetAttribute(&cus, hipDeviceAttributeMultiprocessorCount, dev);
        (void)hipFuncSetAttribute((const void*)k_mega, hipFuncAttributeMaxDynamicSharedMemorySize, LDS_BYTES);
        (void)hipOccupancyMaxActiveBlocksPerMultiprocessor(&per_cu, k_mega, NT, LDS_BYTES);
        if (per_cu < 1) { fprintf(stderr, "occupancy query says %d workgroups per CU: nothing launched\n", per_cu); grid_blocks = -1; }
        else if (cus != (SEQ / 256) * (D / 256)) { fprintf(stderr, "this build needs a %d-CU device (got %d): nothing launched\n", (SEQ / 256) * (D / 256), cus); grid_blocks = -1; }
        else grid_blocks = cus;
    }
    if (grid_blocks < 0) return;
    (void)hipMemsetAsync(p.bar, 0, (size_t)XCD_BAR_WORDS * 4, stream);
    void* args[] = {&p};
    hipError_t e = hipLaunchCooperativeKernel((void*)k_mega, dim3(grid_blocks), dim3(NT), args, LDS_BYTES, stream);
    if (e != hipSuccess) fprintf(stderr, "cooperative launch failed: %s (grid %d)\n", hipGetErrorString(e), grid_blocks);
}
```

```cpp
#include <hip/hip_runtime.h>
#include <hip/hip_cooperative_groups.h>
#include <stdint.h>
#include <cstdio>
namespace cg = cooperative_groups;

#define NT 512
#define LAS __attribute__((address_space(3)))
typedef unsigned short bf16_t;
typedef short bf16x8 __attribute__((ext_vector_type(8)));
typedef float f32x4 __attribute__((ext_vector_type(4)));
typedef unsigned u32x4 __attribute__((ext_vector_type(4)));
typedef unsigned u32x2 __attribute__((ext_vector_type(2)));

constexpr int D = 2048, SEQ = 8192, NMETA = 16, T = SEQ + NMETA;
constexpr int PWD = 1024, CWD = 1024, INW = 3072;
constexpr int KS = 31;
constexpr int RPAD = 240, RT = 8448;
constexpr int LDS_BYTES = 151552;

struct Params {
    const float *x, *meta, *mix_g, *w_in, *pool_w, *pool_scale, *dw_w, *dw_b, *ln_g, *ln_b, *pw_w, *pw_b, *w_out, *ffn_g, *wq, *keys, *down, *up, *fin_g;
    float* out;
    unsigned short* idx;
    unsigned* bar;
    bf16_t *hnb, *w_in_t, *xp, *glu, *mixb, *h2b, *pool_ws, *pw_b16, *w_eff_t, *w_out_t, *wq_t, *keysb, *qb;
    unsigned char *down8, *up8;
    float *sdn, *sup;
    float *gsu;
    bf16_t* part;
    bf16_t* act;
    float* ssq2;
    bf16_t* h3b;
    float *ssq, *rstd, *bias_eff;
};

__device__ __forceinline__ unsigned cvt_pk_bf16(float lo, float hi) { unsigned r; asm volatile("v_cvt_pk_bf16_f32 %0, %1, %2" : "=v"(r) : "v"(lo), "v"(hi)); return r; }
__device__ __forceinline__ float wave_sum(float v) {
#pragma unroll
    for (int o = 1; o < 64; o <<= 1) v += __shfl_xor(v, o);
    return v;
}

__device__ __forceinline__ const float* hrow(const Params& p, int t) { return t < NMETA ? p.meta + (size_t)t * D : p.x + (size_t)(t - NMETA) * D; }

__device__ __forceinline__ float block_sum(float v, float* red) {
#pragma unroll
    for (int o = 32; o; o >>= 1) v += __shfl_xor(v, o);
    __syncthreads();
    if ((threadIdx.x & 63) == 0) red[threadIdx.x >> 6] = v;
    __syncthreads();
    float s = 0.f;
#pragma unroll
    for (int i = 0; i < NT / 64; ++i) s += red[i];
    return s;
}

namespace pg8 {
constexpr int BM = 256, BK = 64, HALF = 128, HTB = HALF * BK * 2, STAGE_BYTES = 8 * HTB, NXCD = 8, WGM = 8;
__device__ __forceinline__ int lds_byte(int r, int c) { const int st = (r >> 4) * 2 + (c >> 5), rr = r & 15, cc = c & 31, ob = rr * 64 + cc * 2; return st * 1024 + (ob ^ (((ob >> 9) & 1) << 5)); }
__device__ __forceinline__ void stage_rc(int b, int& R, int& C) { const int st = b / 1024, sb = b % 1024, swz = sb ^ (((sb >> 9) & 1) << 5); R = (st >> 1) * 16 + swz / 64; C = (st & 1) * 32 + (swz % 64) / 2; }
__device__ __forceinline__ int perm32(int rho) { const int n = rho >> 4, i = rho & 15; return 8 * (i >> 2) + 4 * n + (i & 3); }
struct Unit { int pm, pn; };
struct Gemm { const bf16_t* A; const bf16_t* Bt; int lda, ldb, K; int a_col_per_pn; };
struct StaticOrder {
    int nM, nN, nwg, G, c;
    __device__ void init(int nM_, int nN_, int G_, int c_) { nM = nM_; nN = nN_; nwg = nM * nN; G = G_; c = c_; }
    __device__ bool next(int i, Unit& u) const {
        const long L = (long)i * G + c; if (L >= nwg) return false;
        int wgid = (int)L; { const int q = nwg / NXCD, r = nwg % NXCD, xcd = wgid % NXCD, off = wgid / NXCD; wgid = (xcd < r ? xcd * (q + 1) : r * (q + 1) + (xcd - r) * q) + off; }
        const int nig = WGM * nN, gid = wgid / nig, fm = gid * WGM, gsz = (nM - fm) < WGM ? (nM - fm) : WGM;
        u.pm = fm + ((wgid % nig) % gsz); u.pn = (wgid % nig) / gsz; return true;
    }
};
struct OneUnit { Unit u; __device__ bool next(int i, Unit& o) const { if (i) return false; o = u; return true; } };
template <class Epi, class Sched>
__device__ __forceinline__ void gemm_phase(LAS unsigned char* lds, const Gemm g, const Sched& S, const Epi& E) {
    const int tid = threadIdx.x, wid = __builtin_amdgcn_readfirstlane(tid >> 6), lane = tid & 63, wr = wid >> 2, wc = wid & 3, fr = lane & 15, fq = lane >> 4;
    const int K = g.K, nt = K / BK;
    unsigned voffA[2], voffB[2];
#pragma unroll
    for (int i = 0; i < 2; ++i) { int R, C; stage_rc(tid * 16 + i * 8192, R, C);
        const int Rb = Epi::PERM ? ((R & ~31) + perm32(R & 31)) : R;
        voffA[i] = (unsigned)(R * g.lda + C) * 2u; voffB[i] = (unsigned)(Rb * g.ldb + C) * 2u; }
    const size_t kstep = (size_t)(BK * 2);
    const size_t hstepA = (size_t)HALF * g.lda * 2, hstepB = (size_t)HALF * g.ldb * 2;
    const size_t tstepA = 2 * hstepA, tstepB = 2 * hstepB;
    const unsigned ldsw = (unsigned)wid * 1024u;
    const int aoff = lds_byte(wr * 64 + fr, fq * 8), boff = lds_byte(wc * 32 + fr, fq * 8);
#define PG8_SA(b, h) (((b) * 2 + (h)) * HTB)
#define PG8_SB(b, h) ((4 + (b) * 2 + (h)) * HTB)
#define PG8_STAGE(bufoff, gbase, voff) do { _Pragma("unroll") for (int _i = 0; _i < 2; ++_i) \
        __builtin_amdgcn_global_load_lds((const unsigned*)((const char*)(gbase) + (voff)[_i]), (LAS unsigned*)(lds + (bufoff) + ldsw + _i * 8192), 16, 0, 0); } while (0)
#define PG8_LDA(dst, b, h) do { _Pragma("unroll") for (int m = 0; m < 4; ++m) _Pragma("unroll") for (int k = 0; k < 2; ++k) dst[m][k] = *(const LAS bf16x8*)(lds + PG8_SA(b, h) + aoff + m * 2048 + k * 1024); } while (0)
#define PG8_LDB(dst, b, h) do { _Pragma("unroll") for (int n = 0; n < 2; ++n) _Pragma("unroll") for (int k = 0; k < 2; ++k) dst[n][k] = *(const LAS bf16x8*)(lds + PG8_SB(b, h) + boff + n * 2048 + k * 1024); } while (0)
#define PG8_MMA(ai, bj, At, Bt) do { __builtin_amdgcn_s_setprio(1); _Pragma("unroll") for (int m = 0; m < 4; ++m) _Pragma("unroll") for (int n = 0; n < 2; ++n) _Pragma("unroll") for (int k = 0; k < 2; ++k) \
        acc[ai][bj][m][n] = __builtin_amdgcn_mfma_f32_16x16x32_bf16(Bt[n][k], At[m][k], acc[ai][bj][m][n], 0, 0, 0); __builtin_amdgcn_s_setprio(0); } while (0)
#define PG8_WAIT_V(n) asm volatile("s_waitcnt vmcnt(" #n ")" ::: "memory")
#define PG8_WAIT_L(n) asm volatile("s_waitcnt lgkmcnt(" #n ")" ::: "memory")
#define PG8_BAR __builtin_amdgcn_s_barrier()
#define PG8_SCHED __builtin_amdgcn_sched_barrier(0)
    Unit cur, nxt; int ui = 0;
    if (!S.next(0, cur)) return;
    f32x4 acc[2][2][4][2];
#pragma unroll
    for (int a = 0; a < 2; ++a)
#pragma unroll
        for (int b = 0; b < 2; ++b)
#pragma unroll
            for (int m = 0; m < 4; ++m)
#pragma unroll
                for (int n = 0; n < 2; ++n) acc[a][b][m][n] = (f32x4){0.f, 0.f, 0.f, 0.f};
    bf16x8 At[4][2], B0[2][2], B1[2][2];
    const char* cA = (const char*)g.A + (size_t)cur.pm * tstepA + (size_t)cur.pn * g.a_col_per_pn * 2; const char* cB = (const char*)g.Bt + (size_t)cur.pn * tstepB;
    PG8_STAGE(PG8_SB(0, 0), cB, voffB); PG8_STAGE(PG8_SA(0, 0), cA, voffA); PG8_STAGE(PG8_SB(0, 1), cB + hstepB, voffB); PG8_STAGE(PG8_SA(0, 1), cA + hstepA, voffA);
    if (wr == 1) PG8_BAR;
    PG8_WAIT_V(4); PG8_BAR;
    PG8_STAGE(PG8_SB(1, 0), cB + kstep, voffB); PG8_STAGE(PG8_SA(1, 0), cA + kstep, voffA); PG8_STAGE(PG8_SB(1, 1), cB + hstepB + kstep, voffB);
    PG8_WAIT_V(6); PG8_BAR;
    for (;;) {
        const bool has_next = S.next(ui + 1, nxt);
        const char* nA = has_next ? (const char*)g.A + (size_t)nxt.pm * tstepA + (size_t)nxt.pn * g.a_col_per_pn * 2 : cA; const char* nB = has_next ? (const char*)g.Bt + (size_t)nxt.pn * tstepB : cB;
        for (int t = 0; t < nt; t += 2) {
            const bool last = (t == nt - 2);
            const char* a1 = cA + (size_t)(t + 1) * kstep;
            const char* a2 = last ? nA : cA + (size_t)(t + 2) * kstep; const char* b2 = last ? nB : cB + (size_t)(t + 2) * kstep;
            const char* a3 = a2 + kstep; const char* b3 = b2 + kstep;
            PG8_LDB(B0, 0, 0); PG8_SCHED; PG8_LDA(At, 0, 0); PG8_STAGE(PG8_SA(1, 1), a1 + hstepA, voffA);
            PG8_WAIT_L(8); PG8_BAR; PG8_WAIT_L(0); PG8_MMA(0, 0, At, B0); PG8_BAR; PG8_SCHED;
            PG8_LDB(B1, 0, 1); PG8_STAGE(PG8_SB(0, 0), b2, voffB);
            PG8_BAR; PG8_WAIT_L(0); PG8_MMA(0, 1, At, B1); PG8_BAR;
            PG8_LDA(At, 0, 1); PG8_STAGE(PG8_SA(0, 0), a2, voffA);
            PG8_BAR; PG8_WAIT_L(0); PG8_MMA(1, 0, At, B0); PG8_BAR; PG8_SCHED;
            PG8_STAGE(PG8_SB(0, 1), b2 + hstepB, voffB);
            PG8_WAIT_V(6); PG8_BAR; PG8_MMA(1, 1, At, B1); PG8_BAR;
            PG8_LDB(B0, 1, 0); PG8_SCHED; PG8_LDA(At, 1, 0); PG8_STAGE(PG8_SA(0, 1), a2 + hstepA, voffA);
            PG8_WAIT_L(8); PG8_BAR; PG8_WAIT_L(0); PG8_MMA(0, 0, At, B0); PG8_BAR; PG8_SCHED;
            PG8_LDB(B1, 1, 1); PG8_STAGE(PG8_SB(1, 0), b3, voffB);
            PG8_BAR; PG8_WAIT_L(0); PG8_MMA(0, 1, At, B1); PG8_BAR;
            PG8_LDA(At, 1, 1); PG8_STAGE(PG8_SA(1, 0), a3, voffA);
            PG8_BAR; PG8_WAIT_L(0); PG8_MMA(1, 0, At, B0); PG8_BAR; PG8_SCHED;
            PG8_STAGE(PG8_SB(1, 1), b3 + hstepB, voffB);
            PG8_WAIT_V(6); PG8_BAR; PG8_MMA(1, 1, At, B1); PG8_BAR;
        }
        if constexpr (!Epi::AFTER_DRAIN) E(acc, cur, wr, wc, fr, fq);
        if (!has_next) break;
#pragma unroll
        for (int a = 0; a < 2; ++a)
#pragma unroll
            for (int b = 0; b < 2; ++b)
#pragma unroll
                for (int m = 0; m < 4; ++m)
#pragma unroll
                    for (int n = 0; n < 2; ++n) acc[a][b][m][n] = (f32x4){0.f, 0.f, 0.f, 0.f};
        cur = nxt; cA = nA; cB = nB; ++ui;
    }
    PG8_WAIT_V(0);
    if (wr == 0) PG8_BAR;
    PG8_BAR;
    if constexpr (Epi::AFTER_DRAIN) E.fused(acc, cur, wr, wc, fr, fq, lds, wid, lane);
#undef PG8_SA
#undef PG8_SB
#undef PG8_STAGE
#undef PG8_LDA
#undef PG8_LDB
#undef PG8_MMA
#undef PG8_WAIT_V
#undef PG8_WAIT_L
#undef PG8_BAR
#undef PG8_SCHED
}
}

struct EpiProjF32 {
    static constexpr bool PERM = false;
    static constexpr bool AFTER_DRAIN = false;
    float* proj;
    __device__ __forceinline__ void operator()(const f32x4 (&acc)[2][2][4][2], const pg8::Unit& u, int wr, int wc, int fr, int fq) const {
#pragma unroll
        for (int ai = 0; ai < 2; ++ai)
#pragma unroll
            for (int m = 0; m < 4; ++m) {
                const int t = u.pm * 256 + ai * 128 + wr * 64 + m * 16 + fr - RPAD;
                if (t >= 0) {
#pragma unroll
                    for (int bj = 0; bj < 2; ++bj)
#pragma unroll
                        for (int n = 0; n < 2; ++n) {
                            const int off = wc * 32 + n * 16 + fq * 4;
                            const int col = u.pn < 4 ? u.pn * 256 + bj * 128 + off : (bj ? 2048 : 1024) + (u.pn - 4) * 128 + off;
                            *(f32x4*)(proj + (size_t)t * INW + col) = acc[ai][bj][m][n];
                        }
                }
            }
    }
};


__device__ __forceinline__ float sigmoidf_fast(float x) { return __builtin_amdgcn_rcpf(1.0f + __expf(-x)); }

struct EpiProj {
    static constexpr bool PERM = true;
    static constexpr bool AFTER_DRAIN = false;
    bf16_t* xp; bf16_t* glu;
    __device__ __forceinline__ void operator()(const f32x4 (&acc)[2][2][4][2], const pg8::Unit& u, int wr, int wc, int fr, int fq) const {
#pragma unroll
        for (int ai = 0; ai < 2; ++ai)
#pragma unroll
            for (int m = 0; m < 4; ++m) {
                const size_t row = (size_t)(u.pm * 256 + ai * 128 + wr * 64 + m * 16 + fr);
                if (u.pn < 4) {
#pragma unroll
                    for (int bj = 0; bj < 2; ++bj) { const f32x4 v0 = acc[ai][bj][m][0], v1 = acc[ai][bj][m][1];
                        *(u32x4*)(xp + row * PWD + u.pn * 256 + bj * 128 + wc * 32 + fq * 8) = (u32x4){cvt_pk_bf16(v0[0], v0[1]), cvt_pk_bf16(v0[2], v0[3]), cvt_pk_bf16(v1[0], v1[1]), cvt_pk_bf16(v1[2], v1[3])}; }
                } else {
                    const f32x4 a0 = acc[ai][0][m][0], a1 = acc[ai][0][m][1], g0 = acc[ai][1][m][0], g1 = acc[ai][1][m][1];
                    *(u32x4*)(glu + row * CWD + (u.pn - 4) * 128 + wc * 32 + fq * 8) = (u32x4){
                        cvt_pk_bf16(a0[0] * sigmoidf_fast(g0[0]), a0[1] * sigmoidf_fast(g0[1])), cvt_pk_bf16(a0[2] * sigmoidf_fast(g0[2]), a0[3] * sigmoidf_fast(g0[3])),
                        cvt_pk_bf16(a1[0] * sigmoidf_fast(g1[0]), a1[1] * sigmoidf_fast(g1[1])), cvt_pk_bf16(a1[2] * sigmoidf_fast(g1[2]), a1[3] * sigmoidf_fast(g1[3]))};
                }
            }
    }
};
struct EpiBf16Out {
    static constexpr bool PERM = true;
    static constexpr bool AFTER_DRAIN = false;
    bf16_t* O; int ldc; int col0; const float* bias;
    __device__ __forceinline__ void operator()(const f32x4 (&acc)[2][2][4][2], const pg8::Unit& u, int wr, int wc, int fr, int fq) const {
#pragma unroll
        for (int ai = 0; ai < 2; ++ai)
#pragma unroll
            for (int m = 0; m < 4; ++m) {
                const size_t row = (size_t)(u.pm * 256 + ai * 128 + wr * 64 + m * 16 + fr);
#pragma unroll
                for (int bj = 0; bj < 2; ++bj) { const int c = u.pn * 256 + bj * 128 + wc * 32 + fq * 8; f32x4 v0 = acc[ai][bj][m][0], v1 = acc[ai][bj][m][1];
                    if (bias) { v0 += *(const f32x4*)(bias + c); v1 += *(const f32x4*)(bias + c + 4); }
                    *(u32x4*)(O + row * ldc + col0 + c) = (u32x4){cvt_pk_bf16(v0[0], v0[1]), cvt_pk_bf16(v0[2], v0[3]), cvt_pk_bf16(v1[0], v1[1]), cvt_pk_bf16(v1[2], v1[3])}; }
            }
    }
};
struct EpiResid {
    static constexpr bool PERM = true;
    static constexpr bool AFTER_DRAIN = false;
    const float* x; const float* bias; bf16_t* h2b; float* ssq;
    __device__ __forceinline__ void operator()(const f32x4 (&acc)[2][2][4][2], const pg8::Unit& u, int wr, int wc, int fr, int fq) const {
#pragma unroll
        for (int ai = 0; ai < 2; ++ai)
#pragma unroll
            for (int m = 0; m < 4; ++m) {
                const size_t row = (size_t)(u.pm * 256 + ai * 128 + wr * 64 + m * 16 + fr);
                float ss = 0.f;
#pragma unroll
                for (int bj = 0; bj < 2; ++bj) { const int c = u.pn * 256 + bj * 128 + wc * 32 + fq * 8;
                    const f32x4 v0 = acc[ai][bj][m][0] + *(const f32x4*)(x + row * D + c) + *(const f32x4*)(bias + c);
                    const f32x4 v1 = acc[ai][bj][m][1] + *(const f32x4*)(x + row * D + c + 4) + *(const f32x4*)(bias + c + 4);
                    *(u32x4*)(h2b + row * D + c) = (u32x4){cvt_pk_bf16(v0[0], v0[1]), cvt_pk_bf16(v0[2], v0[3]), cvt_pk_bf16(v1[0], v1[1]), cvt_pk_bf16(v1[2], v1[3])};
                    ss += ((v0[0] * v0[0] + v0[1] * v0[1]) + (v0[2] * v0[2] + v0[3] * v0[3])) + ((v1[0] * v1[0] + v1[1] * v1[1]) + (v1[2] * v1[2] + v1[3] * v1[3])); }
                ss += __shfl_xor(ss, 16); ss += __shfl_xor(ss, 32);
                if (fq == 0) ssq[row * 32 + u.pn * 4 + wc] = ss;
            }
    }
};

__device__ __forceinline__ float fsel(int mask, float a, float b) { return __int_as_float((__float_as_int(a) & ~mask) | (__float_as_int(b) & mask)); }
__device__ __forceinline__ float bf_lo(unsigned w) { return __uint_as_float(w << 16); }
__device__ __forceinline__ float bf_hi(unsigned w) { return __uint_as_float(w & 0xffff0000u); }

__device__ __forceinline__ u32x4 bload16(__amdgpu_buffer_rsrc_t r, int voff, int soff) { return __builtin_bit_cast(u32x4, __builtin_amdgcn_raw_buffer_load_b128(r, voff, soff, 0)); }
__device__ __forceinline__ unsigned bload4(__amdgpu_buffer_rsrc_t r, int voff, int soff) { return (unsigned)__builtin_amdgcn_raw_buffer_load_b32(r, voff, soff, 0); }
__device__ __forceinline__ void bstore4(__amdgpu_buffer_rsrc_t r, unsigned v, int voff, int soff) { __builtin_amdgcn_raw_buffer_store_b32(v, r, voff, soff, 0); }
__device__ __forceinline__ u32x2 bload8(__amdgpu_buffer_rsrc_t r, int voff, int soff) { return __builtin_bit_cast(u32x2, __builtin_amdgcn_raw_buffer_load_b64(r, voff, soff, 0)); }
template <int W> __device__ __forceinline__ void pool_tile(__amdgpu_buffer_rsrc_t rxp, __amdgpu_buffer_rsrc_t rpo, int r0, int tile, int tid) {
    unsigned v[32 + W - 1];
#pragma unroll
    for (int i = 0; i < 32 + W - 1; ++i) v[i] = bload4(rxp, tid * 4, (r0 - (W - 1) + i) * 2048);
    float s0 = 0.f, s1 = 0.f;
#pragma unroll
    for (int i = 0; i < W - 1; ++i) { s0 += bf_lo(v[i]); s1 += bf_hi(v[i]); }
    constexpr float inv = 1.0f / (float)W;
#pragma unroll
    for (int i = 0; i < 32; ++i) {
        const float a0 = bf_lo(v[W - 1 + i]), a1 = bf_hi(v[W - 1 + i]);
        s0 += a0; s1 += a1;
        bstore4(rpo, cvt_pk_bf16(s0 * inv - a0, s1 * inv - a1), tid * 4, (tile * 32 + i) * 4096);
        s0 -= bf_lo(v[i]); s1 -= bf_hi(v[i]);
    }
}
__device__ __forceinline__ void phase_mix(const Params& p, LAS unsigned char* lds, int bid, int nb) {
    const int tid = threadIdx.x, lane = tid & 63, wave = tid >> 6;
    LAS unsigned* gl = (LAS unsigned*)lds;
    LAS float* red = (LAS float*)(lds + 62 * 2048);
    const __amdgpu_buffer_rsrc_t rxp = __builtin_amdgcn_make_buffer_rsrc((void*)p.xp, 0, RT * PWD * 2, 0x00020000);
    const __amdgpu_buffer_rsrc_t rgl = __builtin_amdgcn_make_buffer_rsrc((void*)p.glu, 0, RT * CWD * 2, 0x00020000);
    const __amdgpu_buffer_rsrc_t rpo = __builtin_amdgcn_make_buffer_rsrc((void*)p.mixb, 0, SEQ * D * 2, 0x00020000);
    const __amdgpu_buffer_rsrc_t rww = __builtin_amdgcn_make_buffer_rsrc((void*)p.dw_w, 0, KS * CWD * 4, 0x00020000);
    const __amdgpu_buffer_rsrc_t rwb = __builtin_amdgcn_make_buffer_rsrc((void*)p.dw_b, 0, CWD * 4, 0x00020000);
    const __amdgpu_buffer_rsrc_t rlg = __builtin_amdgcn_make_buffer_rsrc((void*)p.ln_g, 0, CWD * 4, 0x00020000);
    const __amdgpu_buffer_rsrc_t rlb = __builtin_amdgcn_make_buffer_rsrc((void*)p.ln_b, 0, CWD * 4, 0x00020000);
    for (int tile = bid; tile < SEQ / 32; tile += nb) {
        const int r0 = 256 + tile * 32;
        __syncthreads();
#pragma unroll
        for (int j = 0; j < 16; ++j) { const int ch = j * NT + tid; if (ch < 62 * 128)
            *(LAS u32x4*)(lds + ch * 16) = bload16(rgl, tid * 16, (r0 - 30) * 2048 + j * 8192); }
        { const int g = __builtin_amdgcn_readfirstlane(tid >> 7);
          if (g == 0) pool_tile<2>(rxp, rpo, r0, tile, tid); else if (g == 1) pool_tile<4>(rxp, rpo, r0, tile, tid); else if (g == 2) pool_tile<8>(rxp, rpo, r0, tile, tid); else pool_tile<16>(rxp, rpo, r0, tile, tid); }
        __syncthreads();
#pragma unroll 1
        for (int hf = 0; hf < 2; ++hf) {
            float c0[16], c1[16];
            {
                float w0[KS], w1[KS];
#pragma unroll
                for (int k = 0; k < KS; ++k) { const u32x2 wv = bload8(rww, tid * 8, k * 4096); w0[k] = __uint_as_float(wv.x); w1[k] = __uint_as_float(wv.y); }
                const u32x2 bvv = bload8(rwb, tid * 8, 0); const float b0 = __uint_as_float(bvv.x), b1 = __uint_as_float(bvv.y);
#pragma unroll
                for (int i = 0; i < 16; ++i) { c0[i] = b0; c1[i] = b1; }
                const LAS unsigned* glh = gl + hf * 16 * 512 + tid;
#pragma unroll
                for (int rr = 0; rr < 46; ++rr) {
                    if ((rr & 7) == 0) asm volatile("" ::: "memory");
                    const unsigned vv = glh[rr * 512]; const float x0 = bf_lo(vv), x1 = bf_hi(vv);
#pragma unroll
                    for (int i = 0; i < 16; ++i) { const int k = rr - i; if (k >= 0 && k < KS) { c0[i] += x0 * w0[k]; c1[i] += x1 * w1[k]; } }
                }
            }
            asm volatile("" ::: "memory");
#pragma unroll
            for (int which = 0; which < 2; ++which) {
                float st[16];
#pragma unroll
                for (int i = 0; i < 16; ++i) st[i] = which == 0 ? c0[i] + c1[i] : c0[i] * c0[i] + c1[i] * c1[i];
#pragma unroll
                for (int lvl = 0; lvl < 4; ++lvl) {
                    const int o = 32 >> lvl, n = 8 >> lvl; const int mk = -((lane >> (5 - lvl)) & 1);
#pragma unroll
                    for (int j = 0; j < 8; ++j) if (j < n) st[j] = fsel(mk, st[j], st[j + n]) + __shfl_xor(fsel(mk, st[j + n], st[j]), o);
                }
                float tot = st[0] + __shfl_xor(st[0], 2); tot += __shfl_xor(tot, 1);
                if ((lane & 3) == 0) red[wave * 32 + which * 16 + (lane >> 2)] = tot;
            }
            __syncthreads();
            if (tid < 32) { float t = 0.f;
#pragma unroll
                for (int q = 0; q < 8; ++q) t += red[q * 32 + tid];
                red[256 + tid] = t; }
            __syncthreads();
            const u32x2 lgv = bload8(rlg, tid * 8, 0), lbv = bload8(rlb, tid * 8, 0); const float lg0 = __uint_as_float(lgv.x), lg1 = __uint_as_float(lgv.y), lb0 = __uint_as_float(lbv.x), lb1 = __uint_as_float(lbv.y);
#pragma unroll
            for (int i = 0; i < 16; ++i) {
                const float s1 = red[256 + i], s2 = red[256 + 16 + i];
                const float mu = s1 * (1.0f / CWD), var = fmaxf(s2 * (1.0f / CWD) - mu * mu, 0.f), rs = rsqrtf(var + 1e-5f);
                const float y0 = (c0[i] - mu) * rs * lg0 + lb0, y1 = (c1[i] - mu) * rs * lg1 + lb1;
                bstore4(rpo, cvt_pk_bf16(y0 * sigmoidf_fast(y0), y1 * sigmoidf_fast(y1)), tid * 4, (tile * 32 + hf * 16 + i) * 4096 + 2048);
            }
            __syncthreads();
        }
    }
}

typedef float f32x16 __attribute__((ext_vector_type(16)));
__device__ __forceinline__ int okey(float s) { const int u = __float_as_int(s); return u ^ ((u >> 31) & 0x7fffffff); }
__device__ __forceinline__ float okey_inv(int k) { return __int_as_float(k ^ ((k >> 31) & 0x7fffffff)); }
__device__ __forceinline__ void sort16_desc(int (&v)[16]) {
#pragma unroll
    for (int k = 2; k <= 16; k <<= 1) {
#pragma unroll
        for (int j = k >> 1; j > 0; j >>= 1) {
#pragma unroll
            for (int i = 0; i < 16; ++i) {
                const int l = i ^ j;
                if (l > i) { const bool desc = (i & k) == 0; const int hi = max(v[i], v[l]), lo = min(v[i], v[l]); v[i] = desc ? hi : lo; v[l] = desc ? lo : hi; }
            }
        }
    }
}
__device__ __forceinline__ void merge16_desc(int (&a)[16], const int (&b)[16]) {
#pragma unroll
    for (int i = 0; i < 16; ++i) a[i] = max(a[i], b[15 - i]);
#pragma unroll
    for (int j = 8; j > 0; j >>= 1) {
#pragma unroll
        for (int i = 0; i < 16; ++i) { const int l = i ^ j; if (l > i) { const int hi = max(a[i], a[l]), lo = min(a[i], a[l]); a[i] = hi; a[l] = lo; } }
    }
}
__device__ __forceinline__ void pair_merge(int (&a)[16]) {
    int b[16];
#pragma unroll
    for (int i = 0; i < 16; ++i) b[i] = __shfl_xor(a[i], 32);
    merge16_desc(a, b);
}
constexpr int CELL_I[64] = {0,0,0,0,0,0,0,0,0,0,0,0,0,0,0,0,1,1,1,1,1,1,1,1,2,2,2,2,2,3,3,3,3,4,4,4,5,5,6,6,7,7,8,9,10,11,12,13,14,15,0,0,0,0,0,0,0,0,0,0,0,0,0,0};
constexpr int CELL_J[64] = {0,1,2,3,4,5,6,7,8,9,10,11,12,13,14,15,0,1,2,3,4,5,6,7,0,1,2,3,4,0,1,2,3,0,1,2,0,1,0,1,0,1,0,0,0,0,0,0,0,0,0,0,0,0,0,0,0,0,0,0,0,0,0,0};
constexpr int NCELL = 50;

struct EpiQTopk {
    static constexpr bool PERM = false;
    static constexpr bool AFTER_DRAIN = true;
    const float* ssq; float* rstd; const bf16_t* keysb; unsigned short* idx; float* gsu;
    __device__ __forceinline__ void fused(const f32x4 (&acc)[2][2][4][2], const pg8::Unit& u, int wr, int wc, int fr, int fq, LAS unsigned char* lds, int wid, int lane) const {
        const int hh = lane >> 5, l31 = lane & 31, h = u.pn;
        LAS float* svt = (LAS float*)(lds + 65536 + (wid * 64 + lane) * 164);
        LAS unsigned char* sit = (LAS unsigned char*)(svt + 32);
        float rs[2][4];
#pragma unroll
        for (int ai = 0; ai < 2; ++ai)
#pragma unroll
            for (int m = 0; m < 4; ++m) {
                const size_t row = (size_t)(u.pm * 256 + ai * 128 + wr * 64 + m * 16 + fr);
                const f32x4* sp = (const f32x4*)(ssq + row * 32); f32x4 t = sp[0];
#pragma unroll
                for (int i = 1; i < 8; ++i) t += sp[i];
                rs[ai][m] = rsqrtf(((t[0] + t[1]) + (t[2] + t[3])) * (1.0f / D) + 1e-6f);
                if (u.pn == 0 && wc == 0 && fq == 0) rstd[row] = rs[ai][m];
            }
        const int trow = wid * 32 + l31;
#pragma unroll
        for (int ph = 0; ph < 2; ++ph) {
#pragma unroll
            for (int ai = 0; ai < 2; ++ai)
#pragma unroll
                for (int m = 0; m < 4; ++m) { const int row = ai * 128 + wr * 64 + m * 16 + fr;
#pragma unroll
                    for (int n = 0; n < 2; ++n) { const f32x4 v = acc[ai][ph][m][n] * rs[ai][m]; const int chunk = 4 * wc + 2 * n + (fq >> 1);
                        u32x2 w; w.x = cvt_pk_bf16(v[0], v[1]); w.y = cvt_pk_bf16(v[2], v[3]);
                        *(LAS u32x2*)(lds + row * 256 + ((chunk ^ (row & 15)) << 4) + (fq & 1) * 8) = w; } }
            __syncthreads();
            const bf16_t* krow = keysb + ((size_t)(h * 2 + ph) * 128 + l31) * 128 + 8 * hh;
            bf16x8 bq[8];
#pragma unroll
            for (int ks = 0; ks < 8; ++ks) bq[ks] = *(const LAS bf16x8*)(lds + trow * 256 + (((ks * 2 + hh) ^ (trow & 15)) << 4));
            int top[16];
#pragma unroll
            for (int i = 0; i < 16; ++i) top[i] = (int)0x80000000;
            bf16x8 ak[8];
#pragma unroll
            for (int ks = 0; ks < 8; ++ks) ak[ks] = *(const bf16x8*)(krow + ks * 16);
#pragma unroll 1
            for (int kt = 0; kt < 4; ++kt) {
                f32x16 c = {0.f, 0.f, 0.f, 0.f, 0.f, 0.f, 0.f, 0.f, 0.f, 0.f, 0.f, 0.f, 0.f, 0.f, 0.f, 0.f};
#pragma unroll
                for (int ks = 0; ks < 8; ++ks) c = __builtin_amdgcn_mfma_f32_32x32x16_bf16(ak[ks], bq[ks], c, 0, 0, 0);
                { const int kn = kt < 3 ? kt + 1 : 3;
#pragma unroll
                  for (int ks = 0; ks < 8; ++ks) ak[ks] = *(const bf16x8*)(krow + (size_t)kn * 32 * 128 + ks * 16); }
                int v[16];
                const int lowb = (127 - kt * 32) ^ (hh << 2);
#pragma unroll
                for (int r = 0; r < 16; ++r) v[r] = (okey(c[r]) & ~127) | (lowb - ((r & 3) + 8 * (r >> 2)));
                sort16_desc(v);
                merge16_desc(top, v);
            }
            pair_merge(top);
#pragma unroll
            for (int i = 0; i < 16; ++i) { svt[ph * 16 + i] = okey_inv(top[i] & ~127); sit[ph * 16 + i] = (unsigned char)(127 - (top[i] & 127)); }
            __syncthreads();
        }
        float sv[2][16];
#pragma unroll
        for (int i = 0; i < 16; ++i) { sv[0][i] = svt[i]; sv[1][i] = svt[16 + i]; }
        int w0[16], w1[16];
#pragma unroll
        for (int s = 0; s < 32; ++s) {
            const int e0 = 2 * s, e1 = 2 * s + 1;
            int key;
            if (e0 >= NCELL) key = (int)0x80000000;
            else {
                const float v0 = sv[0][CELL_I[e0]] + sv[1][CELL_J[e0]];
                const int k0 = (okey(v0) & ~255) | (255 - (CELL_I[e0] * 16 + CELL_J[e0]));
                if (e1 >= NCELL) key = hh ? (int)0x80000000 : k0;
                else { const float v1 = sv[0][CELL_I[e1]] + sv[1][CELL_J[e1]];
                    const int k1 = (okey(v1) & ~255) | (255 - (CELL_I[e1] * 16 + CELL_J[e1]));
                    key = hh ? k1 : k0; }
            }
            if (s < 16) w0[s] = key; else w1[s - 16] = key;
        }
        sort16_desc(w0); sort16_desc(w1); merge16_desc(w0, w1); pair_merge(w0);
        const float mx = okey_inv(w0[0] & ~255);
        float sum = 0.f;
#pragma unroll
        for (int k = 0; k < 16; ++k) sum += __expf(okey_inv(w0[k] & ~255) - mx);
        const float inv = 1.0f / sum;
        int eo[8]; float go[8]; const int hmask = -hh;
#pragma unroll
        for (int k = 0; k < 8; ++k) { const int kk = (w0[k] & ~hmask) | (w0[8 + k] & hmask); const int cc = 255 - (kk & 255);
            eo[k] = (int)sit[cc >> 4] * 128 + (int)sit[16 + (cc & 15)]; go[k] = __expf(okey_inv(kk & ~255) - mx) * inv; }
        const size_t ob = (size_t)(u.pm * 256 + trow) * 128 + h * 16 + hh * 8;
        *(u32x4*)(idx + ob) = (u32x4){(unsigned)eo[0] | ((unsigned)eo[1] << 16), (unsigned)eo[2] | ((unsigned)eo[3] << 16), (unsigned)eo[4] | ((unsigned)eo[5] << 16), (unsigned)eo[6] | ((unsigned)eo[7] << 16)};
        *(f32x4*)(gsu + ob) = (f32x4){go[0], go[1], go[2], go[3]};
        *(f32x4*)(gsu + ob + 4) = (f32x4){go[4], go[5], go[6], go[7]};
    }
    __device__ __forceinline__ void operator()(const f32x4 (&)[2][2][4][2], const pg8::Unit&, int, int, int, int) const {}
};

__device__ __forceinline__ void fp8_row2(const float* s0, unsigned char* d0, float* i0, const float* s1, unsigned char* d1, float* i1, int lane) {
    f32x4 v[2][2][4]; float am[2] = {0.f, 0.f};
#pragma unroll
    for (int r = 0; r < 2; ++r)
#pragma unroll
        for (int k = 0; k < 2; ++k)
#pragma unroll
            for (int i = 0; i < 4; ++i) v[r][k][i] = __builtin_nontemporal_load((const f32x4*)((r ? s1 : s0) + 1024 * k + 16 * lane + 4 * i));
#pragma unroll
    for (int r = 0; r < 2; ++r) {
#pragma unroll
        for (int k = 0; k < 2; ++k)
#pragma unroll
            for (int i = 0; i < 4; ++i) am[r] = fmaxf(am[r], fmaxf(fmaxf(fabsf(v[r][k][i].x), fabsf(v[r][k][i].y)), fmaxf(fabsf(v[r][k][i].z), fabsf(v[r][k][i].w))));
#pragma unroll
        for (int o = 1; o < 64; o <<= 1) am[r] = fmaxf(am[r], __shfl_xor(am[r], o));
        int be = (__float_as_int(am[r]) >> 23) & 255; be = be < 8 ? 8 : (be > 248 ? 248 : be);
        const float sc = __int_as_float((260 - be) << 23), isc = __int_as_float((be - 6) << 23);
#pragma unroll
        for (int k = 0; k < 2; ++k) { u32x4 w; unsigned ww[4];
#pragma unroll
            for (int i = 0; i < 4; ++i) { int t = 0; t = __builtin_amdgcn_cvt_pk_fp8_f32(v[r][k][i].x * sc, v[r][k][i].y * sc, t, false); t = __builtin_amdgcn_cvt_pk_fp8_f32(v[r][k][i].z * sc, v[r][k][i].w * sc, t, true); ww[i] = (unsigned)t; }
            w.x = ww[0]; w.y = ww[1]; w.z = ww[2]; w.w = ww[3];
            *(u32x4*)((r ? d1 : d0) + 1024 * k + 16 * lane) = w; }
        if (lane == 0) *(r ? i1 : i0) = isc;
    }
}

typedef float f32x2 __attribute__((ext_vector_type(2)));
template <int N> __device__ __forceinline__ f32x2 dot16_fp8(const u32x4 w, const f32x2 (&x)[N], int o, f32x2 acc) {
    const unsigned ww[4] = {w.x, w.y, w.z, w.w};
#pragma unroll
    for (int d = 0; d < 4; ++d) { acc += __builtin_amdgcn_cvt_pk_f32_fp8((int)ww[d], false) * x[o + 2 * d]; acc += __builtin_amdgcn_cvt_pk_f32_fp8((int)ww[d], true) * x[o + 2 * d + 1]; }
    return acc;
}
template <int N> __device__ __forceinline__ void axpy16_fp8(const u32x4 w, float a, f32x2 (&y)[N], int o) {
    const unsigned ww[4] = {w.x, w.y, w.z, w.w}; const f32x2 a2 = {a, a};
#pragma unroll
    for (int d = 0; d < 4; ++d) { y[o + 2 * d] += a2 * __builtin_amdgcn_cvt_pk_f32_fp8((int)ww[d], false); y[o + 2 * d + 1] += a2 * __builtin_amdgcn_cvt_pk_f32_fp8((int)ww[d], true); }
}
__device__ __forceinline__ void bstore16(__amdgpu_buffer_rsrc_t r, f32x4 v, int voff, int soff) { __builtin_amdgcn_raw_buffer_store_b128(__builtin_bit_cast(__attribute__((__vector_size__(4 * sizeof(unsigned)))) unsigned, v), r, voff, soff, 0); }
__device__ __forceinline__ void bstore8(__amdgpu_buffer_rsrc_t r, f32x2 v, int voff, int soff) { __builtin_amdgcn_raw_buffer_store_b64(__builtin_bit_cast(__attribute__((__vector_size__(2 * sizeof(unsigned)))) unsigned, v), r, voff, soff, 0); }
__device__ __forceinline__ f32x2 fsel2(int mask, f32x2 a, f32x2 b) { return (f32x2){fsel(mask, a.x, b.x), fsel(mask, a.y, b.y)}; }
__device__ __forceinline__ f32x2 shx2(f32x2 a, int o) { return (f32x2){__shfl_xor(a.x, o), __shfl_xor(a.y, o)}; }

__device__ __forceinline__ void phase_pd(const Params& p, int bid, int nb) {
    const int tid = threadIdx.x, lane = tid & 63, wave = __builtin_amdgcn_readfirstlane(tid >> 6);
    if (wave == 7) {
        for (int e = bid; e < 16384; e += 2 * nb) { const int e2 = e + nb < 16384 ? e + nb : e;
            fp8_row2(p.up + (size_t)e * D, p.up8 + (size_t)e * D, p.sup + e, p.up + (size_t)e2 * D, p.up8 + (size_t)e2 * D, p.sup + e2, lane); }
        return;
    }
    const int v = bid & 7, lw = (bid >> 3) * 7 + wave, NLW = (nb >> 3) * 7;
    const int c = lane & 7, sub = lane >> 3;
    const int m0 = -(lane & 1), m1 = -((lane >> 1) & 1), m2 = -((lane >> 2) & 1);
    const __amdgpu_buffer_rsrc_t rd = __builtin_amdgcn_make_buffer_rsrc((void*)p.down8, 0, 16384 * D, 0x00020000);
    const __amdgpu_buffer_rsrc_t rh = __builtin_amdgcn_make_buffer_rsrc((void*)p.h2b, 0, SEQ * D * 2, 0x00020000);
    const __amdgpu_buffer_rsrc_t rg1 = __builtin_amdgcn_make_buffer_rsrc((void*)p.ffn_g, 0, D * 4, 0x00020000);
    const __amdgpu_buffer_rsrc_t ri = __builtin_amdgcn_make_buffer_rsrc((void*)p.idx, 0, SEQ * 128 * 2, 0x00020000);
    const __amdgpu_buffer_rsrc_t rrs = __builtin_amdgcn_make_buffer_rsrc((void*)p.rstd, 0, SEQ * 4, 0x00020000);
    const __amdgpu_buffer_rsrc_t rp = __builtin_amdgcn_make_buffer_rsrc((void*)p.part, 0, SEQ * 16 * 128 * 2, 0x00020000);
    const int vsub = sub * 32, vc2 = c * 32, vc1 = c * 16, vl4 = lane * 4;
#pragma unroll 1
    for (int pass = 0; pass < 2; ++pass) {
        const int sl = v * 2 + pass;
        f32x2 gs[8];
#pragma unroll
        for (int i = 0; i < 4; ++i) { const f32x4 g = __builtin_bit_cast(f32x4, bload16(rg1, c * 64, sl * 512 + i * 16)); gs[2 * i] = (f32x2){g[0], g[1]}; gs[2 * i + 1] = (f32x2){g[2], g[3]}; }
        u32x4 ix[2], hh[2]; unsigned rsb;
        {
            const int t = lw;
#pragma unroll
            for (int i = 0; i < 2; ++i) ix[i] = bload16(ri, vsub, t * 256 + i * 16);
            hh[0] = bload16(rh, vc2, t * 4096 + sl * 256); hh[1] = bload16(rh, vc2, t * 4096 + sl * 256 + 16); rsb = bload4(rrs, 0, t * 4);
        }
#pragma unroll 1
        for (int t = lw; t < SEQ; t += NLW) {
            asm volatile("" ::: "memory");
            u32x4 w[16];
            {
                const unsigned ew[8] = {ix[0].x, ix[0].y, ix[0].z, ix[0].w, ix[1].x, ix[1].y, ix[1].z, ix[1].w};
#pragma unroll
                for (int g = 0; g < 16; ++g) { const unsigned e = (g & 1) ? (ew[g >> 1] >> 16) : (ew[g >> 1] & 0xffffu); w[g] = bload16(rd, (int)(e * 2048u) + vc1, sl * 128); }
            }
            f32x2 xs[8];
            {
                const float rs = __uint_as_float(rsb);
                const unsigned hw[8] = {hh[0].x, hh[0].y, hh[0].z, hh[0].w, hh[1].x, hh[1].y, hh[1].z, hh[1].w};
#pragma unroll
                for (int i = 0; i < 8; ++i) xs[i] = (f32x2){bf_lo(hw[i]) * rs, bf_hi(hw[i]) * rs} * gs[i];
            }
            asm volatile("" ::: "memory");
            {
                const int tn = t + NLW < SEQ ? t + NLW : t;
#pragma unroll
                for (int i = 0; i < 2; ++i) ix[i] = bload16(ri, vsub, tn * 256 + i * 16);
                hh[0] = bload16(rh, vc2, tn * 4096 + sl * 256); hh[1] = bload16(rh, vc2, tn * 4096 + sl * 256 + 16); rsb = bload4(rrs, 0, tn * 4);
            }
            asm volatile("" ::: "memory");
            float r[16];
#pragma unroll
            for (int g = 0; g < 16; ++g) { const f32x2 z = {0.f, 0.f}; const f32x2 s2 = dot16_fp8(w[g], xs, 0, z); r[g] = s2.x + s2.y; }
            float k8[8], k4[4];
#pragma unroll
            for (int i = 0; i < 8; ++i) k8[i] = fsel(m2, r[i], r[i + 8]) + __shfl_xor(fsel(m2, r[i + 8], r[i]), 4);
#pragma unroll
            for (int i = 0; i < 4; ++i) k4[i] = fsel(m1, k8[i], k8[i + 4]) + __shfl_xor(fsel(m1, k8[i + 4], k8[i]), 2);
            const float k0 = fsel(m0, k4[0], k4[2]) + __shfl_xor(fsel(m0, k4[2], k4[0]), 1);
            const float k1 = fsel(m0, k4[1], k4[3]) + __shfl_xor(fsel(m0, k4[3], k4[1]), 1);
            bstore4(rp, cvt_pk_bf16(k0, k1), vl4, (t * 16 + sl) * 256);
        }
    }
}
__device__ __forceinline__ void phase_pa(const Params& p, int bid, int nb) {
    const int tid = threadIdx.x, lane = tid & 63, wave = tid >> 6;
    const int gw = bid * 8 + wave, NGW = nb * 8;
    for (int it = gw; it < SEQ * 2; it += NGW) {
        const int t = it >> 1, pp = (it & 1) * 64 + lane;
        const bf16_t* pr = p.part + (size_t)t * 2048 + pp;
        float hs = 0.f;
#pragma unroll
        for (int sl = 0; sl < 16; ++sl) hs += __uint_as_float((unsigned)pr[sl * 128] << 16);
        const int e = (int)p.idx[(size_t)t * 128 + pp];
        hs *= p.sdn[e];
        const float av = p.gsu[(size_t)t * 128 + pp] * p.sup[e] * 0.5f * hs * (1.0f + erff(hs * 0.70710678118654752f));
        p.act[(size_t)t * 128 + pp] = (bf16_t)(cvt_pk_bf16(av, 0.f) & 0xffffu);
    }
}
__device__ __forceinline__ void phase_pu(const Params& p, int bid, int nb) {
    const int tid = threadIdx.x, lane = tid & 63, wave = __builtin_amdgcn_readfirstlane(tid >> 6);
    const int v = bid & 7, lw = (bid >> 3) * 8 + wave, NLW = (nb >> 3) * 8;
    const int c = lane & 7, sub = lane >> 3;
    const int m3 = -((lane >> 3) & 1), m4 = -((lane >> 4) & 1), m5 = -((lane >> 5) & 1);
    const __amdgpu_buffer_rsrc_t ru = __builtin_amdgcn_make_buffer_rsrc((void*)p.up8, 0, 16384 * D, 0x00020000);
    const __amdgpu_buffer_rsrc_t rh = __builtin_amdgcn_make_buffer_rsrc((void*)p.h2b, 0, SEQ * D * 2, 0x00020000);
    const __amdgpu_buffer_rsrc_t ri = __builtin_amdgcn_make_buffer_rsrc((void*)p.idx, 0, SEQ * 128 * 2, 0x00020000);
    const __amdgpu_buffer_rsrc_t ra = __builtin_amdgcn_make_buffer_rsrc((void*)p.act, 0, SEQ * 128 * 2, 0x00020000);
    const __amdgpu_buffer_rsrc_t ro = __builtin_amdgcn_make_buffer_rsrc((void*)p.h3b, 0, SEQ * D * 2, 0x00020000);
    const __amdgpu_buffer_rsrc_t rq = __builtin_amdgcn_make_buffer_rsrc((void*)p.ssq2, 0, SEQ * 16 * 4, 0x00020000);
    const int vsub = sub * 32, vc1 = c * 16, vh = c * 32 + sub * 4;
#pragma unroll 1
    for (int pass = 0; pass < 2; ++pass) {
        const int sl = v * 2 + pass;
        u32x4 ix[2], ac[2]; unsigned hb;
        {
            const int t = lw;
#pragma unroll
            for (int i = 0; i < 2; ++i) { ix[i] = bload16(ri, vsub, t * 256 + i * 16); ac[i] = bload16(ra, vsub, t * 256 + i * 16); }
            hb = bload4(rh, vh, t * 4096 + sl * 256);
        }
#pragma unroll 1
        for (int t = lw; t < SEQ; t += NLW) {
            asm volatile("" ::: "memory");
            u32x4 w[16];
            {
                const unsigned ew[8] = {ix[0].x, ix[0].y, ix[0].z, ix[0].w, ix[1].x, ix[1].y, ix[1].z, ix[1].w};
#pragma unroll
                for (int g = 0; g < 16; ++g) { const unsigned e = (g & 1) ? (ew[g >> 1] >> 16) : (ew[g >> 1] & 0xffffu); w[g] = bload16(ru, (int)(e * 2048u) + vc1, sl * 128); }
            }
            const unsigned aw[8] = {ac[0].x, ac[0].y, ac[0].z, ac[0].w, ac[1].x, ac[1].y, ac[1].z, ac[1].w};
            float a[16];
#pragma unroll
            for (int g = 0; g < 16; ++g) a[g] = (g & 1) ? bf_hi(aw[g >> 1]) : bf_lo(aw[g >> 1]);
            const unsigned hcur = hb;
            asm volatile("" ::: "memory");
            {
                const int tn = t + NLW < SEQ ? t + NLW : t;
#pragma unroll
                for (int i = 0; i < 2; ++i) { ix[i] = bload16(ri, vsub, tn * 256 + i * 16); ac[i] = bload16(ra, vsub, tn * 256 + i * 16); }
                hb = bload4(rh, vh, tn * 4096 + sl * 256);
            }
            asm volatile("" ::: "memory");
            f32x2 acc[8];
#pragma unroll
            for (int i = 0; i < 8; ++i) acc[i] = (f32x2){0.f, 0.f};
#pragma unroll
            for (int g = 0; g < 16; ++g) axpy16_fp8(w[g], a[g], acc, 0);
            f32x2 k4[4], k2[2];
#pragma unroll
            for (int i = 0; i < 4; ++i) k4[i] = fsel2(m5, acc[i], acc[i + 4]) + shx2(fsel2(m5, acc[i + 4], acc[i]), 32);
#pragma unroll
            for (int i = 0; i < 2; ++i) k2[i] = fsel2(m4, k4[i], k4[i + 2]) + shx2(fsel2(m4, k4[i + 2], k4[i]), 16);
            f32x2 h3 = fsel2(m3, k2[0], k2[1]) + shx2(fsel2(m3, k2[1], k2[0]), 8);
            h3 += (f32x2){bf_lo(hcur), bf_hi(hcur)};
            bstore4(ro, cvt_pk_bf16(h3.x, h3.y), vh, t * 4096 + sl * 256);
            const float ss = wave_sum(h3.x * h3.x + h3.y * h3.y);
            if (lane == 0) bstore4(rq, __float_as_uint(ss), 0, (t * 16 + sl) * 4);
        }
    }
}
__device__ __forceinline__ void phase_pf(const Params& p, int bid, int nb) {
    const int tid = threadIdx.x, lane = tid & 63, wave = tid >> 6;
    const int gw = bid * 8 + wave, NGW = nb * 8;
    for (int t = gw; t < SEQ; t += NGW) {
        const f32x4* sp = (const f32x4*)(p.ssq2 + (size_t)t * 16); f32x4 q = sp[0] + sp[1] + sp[2] + sp[3];
        const float rf = rsqrtf(((q[0] + q[1]) + (q[2] + q[3])) * (1.0f / D) + 1e-6f);
        const u32x4* hp = (const u32x4*)(p.h3b + (size_t)t * D) + lane;
        f32x4* o = (f32x4*)(p.out + (size_t)t * D) + 2 * lane; const f32x4* g = (const f32x4*)p.fin_g + 2 * lane;
#pragma unroll
        for (int j = 0; j < 4; ++j) { const u32x4 h = hp[64 * j]; const f32x4 g0 = g[128 * j], g1 = g[128 * j + 1];
            o[128 * j] = (f32x4){bf_lo(h.x) * rf * g0[0], bf_hi(h.x) * rf * g0[1], bf_lo(h.y) * rf * g0[2], bf_hi(h.y) * rf * g0[3]};
            o[128 * j + 1] = (f32x4){bf_lo(h.z) * rf * g1[0], bf_hi(h.z) * rf * g1[1], bf_lo(h.w) * rf * g1[2], bf_hi(h.w) * rf * g1[3]}; }
    }
}

__device__ __forceinline__ void fp8_row(const float* src, unsigned char* dst, float* inv_scale, int lane) {
    f32x4 v[2][4]; float am = 0.f;
#pragma unroll
    for (int k = 0; k < 2; ++k)
#pragma unroll
        for (int i = 0; i < 4; ++i) { v[k][i] = *(const f32x4*)(src + 1024 * k + 16 * lane + 4 * i);
            am = fmaxf(am, fmaxf(fmaxf(fabsf(v[k][i].x), fabsf(v[k][i].y)), fmaxf(fabsf(v[k][i].z), fabsf(v[k][i].w)))); }
#pragma unroll
    for (int o = 1; o < 64; o <<= 1) am = fmaxf(am, __shfl_xor(am, o));
    int be = (__float_as_int(am) >> 23) & 255; be = be < 8 ? 8 : (be > 248 ? 248 : be);
    const float sc = __int_as_float((260 - be) << 23), isc = __int_as_float((be - 6) << 23);
#pragma unroll
    for (int k = 0; k < 2; ++k) { u32x4 w; unsigned ww[4];
#pragma unroll
        for (int i = 0; i < 4; ++i) { int t = 0; t = __builtin_amdgcn_cvt_pk_fp8_f32(v[k][i].x * sc, v[k][i].y * sc, t, false); t = __builtin_amdgcn_cvt_pk_fp8_f32(v[k][i].z * sc, v[k][i].w * sc, t, true); ww[i] = (unsigned)t; }
        w.x = ww[0]; w.y = ww[1]; w.z = ww[2]; w.w = ww[3];
        *(u32x4*)(dst + 1024 * k + 16 * lane) = w; }
    if (lane == 0) *inv_scale = isc;
}

__device__ __forceinline__ void tr_item(const float* W, int ldw, int srccol0, int k0, bf16_t* WT, int ldt, int n0, const float* kscale, const float* nscale, LAS float* scr, int lane) {
    float tv[32];
#pragma unroll
    for (int i = 0; i < 32; ++i) { const int kk = 2 * i + (lane >> 5); tv[i] = W[(size_t)(k0 + kk) * ldw + srccol0 + (lane & 31)]; }
    const float ns = nscale ? nscale[srccol0 + (lane & 31)] : 1.0f;
#pragma unroll
    for (int i = 0; i < 32; ++i) { const int kk = 2 * i + (lane >> 5); float v = tv[i] * ns;
        if (kscale) v *= kscale[k0 + kk]; scr[kk * 33 + (lane & 31)] = v; }
    asm volatile("s_waitcnt lgkmcnt(0)" ::: "memory");
    const int c = lane & 7;
#pragma unroll
    for (int j = 0; j < 4; ++j) { const int n = (lane >> 3) + 8 * j; const LAS float* s = scr + (8 * c) * 33 + n;
        u32x4 o; o.x = cvt_pk_bf16(s[0 * 33], s[1 * 33]); o.y = cvt_pk_bf16(s[2 * 33], s[3 * 33]); o.z = cvt_pk_bf16(s[4 * 33], s[5 * 33]); o.w = cvt_pk_bf16(s[6 * 33], s[7 * 33]);
        *(u32x4*)(WT + (size_t)(n0 + n) * ldt + k0 + 8 * c) = o; }
    asm volatile("s_waitcnt lgkmcnt(0)" ::: "memory");
}
__device__ __forceinline__ int win_srccol(int n) { const int pn = n >> 8, w = n & 255; return pn < 4 ? n : ((w >> 7) ? 2048 : 1024) + (pn - 4) * 128 + (w & 127); }

__device__ __forceinline__ void phase_prep(const Params& p, LAS unsigned char* lds, int bid, int nb) {
    const int tid = threadIdx.x, lane = tid & 63, wave = tid >> 6;
    const int gw = bid * 8 + wave, NGW = nb * 8;
    LAS float* scr = (LAS float*)(lds + wave * 8448);
    for (int r = gw; r < RT; r += NGW) {
        unsigned long long* o8 = (unsigned long long*)(p.hnb + (size_t)r * D) + lane;
        if (r < RPAD) {
#pragma unroll
            for (int j = 0; j < 8; ++j) o8[64 * j] = 0ull;
        } else {
            const f32x4* xr = (const f32x4*)hrow(p, r - RPAD) + lane;
            const f32x4* gr = (const f32x4*)p.mix_g + lane;
            f32x4 v[8]; float s = 0.f;
#pragma unroll
            for (int j = 0; j < 8; ++j) { v[j] = __builtin_nontemporal_load(xr + 64 * j); s += (v[j].x * v[j].x + v[j].y * v[j].y) + (v[j].z * v[j].z + v[j].w * v[j].w); }
            const float rs = rsqrtf(wave_sum(s) * (1.0f / D) + 1e-6f);
#pragma unroll
            for (int j = 0; j < 8; ++j) { const f32x4 gv = gr[64 * j];
                o8[64 * j] = (unsigned long long)cvt_pk_bf16(v[j].x * rs * gv.x, v[j].y * rs * gv.y) | ((unsigned long long)cvt_pk_bf16(v[j].z * rs * gv.z, v[j].w * rs * gv.w) << 32); }
        }
    }
    for (int it = gw; it < (D / 64) * (INW / 32); it += NGW) {
        const int kb = it / (INW / 32), nbk = it % (INW / 32);
        tr_item(p.w_in, INW, win_srccol(nbk * 32), kb * 64, p.w_in_t, D, nbk * 32, nullptr, nullptr, scr, lane);
    }
    for (int i = gw * 64 + lane; i < 4 * 256 * 256 / 4; i += NGW * 64) { const f32x4 v = ((const f32x4*)p.pool_w)[i];
        const int g = i >> 14, d = (i & 63) * 4; const f32x4 sc = *(const f32x4*)(p.pool_scale + g * 256 + d);
        u32x2 w; w.x = cvt_pk_bf16(v[0] * sc[0], v[1] * sc[1]); w.y = cvt_pk_bf16(v[2] * sc[2], v[3] * sc[3]); ((u32x2*)p.pool_ws)[i] = w; }
    for (int i = gw * 64 + lane; i < CWD * CWD / 4; i += NGW * 64) { const f32x4 v = ((const f32x4*)p.pw_w)[i];
        u32x2 w; w.x = cvt_pk_bf16(v[0], v[1]); w.y = cvt_pk_bf16(v[2], v[3]); ((u32x2*)p.pw_b16)[i] = w; }
    for (int it = gw; it < 32 * 64; it += NGW) { const int kb = it >> 6, nbk = it & 63;
        tr_item(p.w_out, D, nbk * 32, kb * 64, p.w_out_t, D, nbk * 32, nullptr, nullptr, scr, lane); }
    for (int it = gw; it < 32 * 64; it += NGW) { const int kb = it >> 6, nbk = it & 63;
        tr_item(p.wq, D, nbk * 32, kb * 64, p.wq_t, D, nbk * 32, p.ffn_g, nullptr, scr, lane); }
    for (int i = gw * 64 + lane; i < 8 * 2 * 128 * 128 / 4; i += NGW * 64) { const f32x4 v = ((const f32x4*)p.keys)[i];
        u32x2 w; w.x = cvt_pk_bf16(v[0], v[1]); w.y = cvt_pk_bf16(v[2], v[3]); ((u32x2*)p.keysb)[i] = w; }
    for (int e = gw; e < 16384; e += 2 * NGW) { const int e2 = e + NGW < 16384 ? e + NGW : e;
        fp8_row2(p.down + (size_t)e * D, p.down8 + (size_t)e * D, p.sdn + e, p.down + (size_t)e2 * D, p.down8 + (size_t)e2 * D, p.sdn + e2, lane); }
}


#define XB_TMO      128
#define XB_XCNT(j)  (256  + 64 * (j))
#define XB_XSUB(j)  (1280 + 64 * (j))
#define XB_XGEN(j)  (2304 + 64 * (j))
#define XB_TOP      3328
#define XB_TOPGEN   3392
#define XCD_BAR_WORDS 3456
#define XB_SPIN_CAP (1u << 18)
__device__ __forceinline__ unsigned xb_ld(unsigned* p)              { return __hip_atomic_load(p, __ATOMIC_RELAXED, __HIP_MEMORY_SCOPE_AGENT); }
__device__ __forceinline__ unsigned xb_add(unsigned* p, unsigned v) { return __hip_atomic_fetch_add(p, v, __ATOMIC_RELAXED, __HIP_MEMORY_SCOPE_AGENT); }
__device__ __forceinline__ unsigned xb_xcc_id() { return (unsigned)__builtin_amdgcn_s_getreg((3 << 11) | 20) & 0xFu; }
#define XB_SPIN(cond, bar) do { unsigned _sp = 0; while (cond) { __builtin_amdgcn_s_sleep(1); \
    if ((++_sp & 255u) == 0u) { if (xb_ld(&(bar)[XB_TMO])) break; if (_sp > XB_SPIN_CAP) { atomicAdd(&(bar)[XB_TMO], 1u); break; } } } } while (0)
struct XcdBarrier { unsigned* bar; unsigned x; volatile LAS unsigned* st; };
__device__ __forceinline__ XcdBarrier xcd_barrier_post(unsigned* bar, volatile LAS unsigned* st) {
    XcdBarrier b; b.bar = bar; b.x = xb_xcc_id(); b.st = st;
    if (threadIdx.x == 0) (void)xb_add(&bar[XB_XCNT(b.x)], 1u);
    return b;
}
__device__ __forceinline__ void xcd_barrier_complete(unsigned* bar, unsigned x, unsigned& nloc, unsigned& nx) {
    const unsigned G = gridDim.x * gridDim.y * gridDim.z;
    unsigned sum, cnt, mine, sp = 0u;
    for (;;) {
        sum = 0u; cnt = 0u; mine = 0u;
#pragma unroll
        for (unsigned j = 0; j < 16; ++j) { const unsigned c = xb_ld(&bar[XB_XCNT(j)]); sum += c; cnt += (c > 0u) ? 1u : 0u; mine = (j == x) ? c : mine; }
        if (sum == G) break;
        __builtin_amdgcn_s_sleep(1);
        if ((++sp & 255u) == 0u) { if (xb_ld(&bar[XB_TMO])) break; if (sp > XB_SPIN_CAP) { atomicAdd(&bar[XB_TMO], 1u); break; } }
    }
    nloc = mine > 0u ? mine : 1u; nx = cnt > 0u ? cnt : 1u;
}
__device__ __forceinline__ void xcd_barrier(const XcdBarrier& b) {
    asm volatile("s_waitcnt vmcnt(0)" ::: "memory");
    __syncthreads();
    if (threadIdx.x == 0) {
        unsigned* bar = b.bar;
        __builtin_amdgcn_s_waitcnt(0);
        unsigned nloc = b.st[0], nx = b.st[1];
        if (nloc == 0u) { xcd_barrier_complete(bar, b.x, nloc, nx); b.st[0] = nloc; b.st[1] = nx; }
        const unsigned old = xb_add(&bar[XB_XSUB(b.x)], 1u);
        const unsigned gen = old / nloc;
        if (old + 1u == (gen + 1u) * nloc) {
            __builtin_amdgcn_fence(__ATOMIC_RELEASE, "agent");
            asm volatile("s_waitcnt vmcnt(0)" ::: "memory");
            const unsigned og = xb_add(&bar[XB_TOP], 1u);
            const unsigned tg = og / nx;
            if (og + 1u == (tg + 1u) * nx) xb_add(&bar[XB_TOPGEN], 1u);
            else XB_SPIN(xb_ld(&bar[XB_TOPGEN]) == tg, bar);
            __builtin_amdgcn_fence(__ATOMIC_ACQUIRE, "agent");
            xb_add(&bar[XB_XGEN(b.x)], 1u);
            asm volatile("s_waitcnt vmcnt(0)" ::: "memory");
        } else {
            XB_SPIN(xb_ld(&bar[XB_XGEN(b.x)]) == gen, bar);
            __builtin_amdgcn_fence(__ATOMIC_ACQUIRE, "agent");
            asm volatile("s_waitcnt vmcnt(0)" ::: "memory");
        }
    }
    __syncthreads();
}

__global__ void __launch_bounds__(NT, 2) k_mega(Params p) {
    extern __shared__ __attribute__((aligned(16))) unsigned char lds_raw[];
    LAS unsigned char* lds = (LAS unsigned char*)lds_raw;
    const int bid = blockIdx.x, nb = gridDim.x;
    volatile LAS unsigned* bst = (volatile LAS unsigned*)(lds + LDS_BYTES - 16);
    if (threadIdx.x < 4) bst[threadIdx.x] = 0u;
    __syncthreads();
    const XcdBarrier xb = xcd_barrier_post(p.bar, bst);
    phase_prep(p, lds, bid, nb);
    xcd_barrier(xb);
    { pg8::Gemm g{p.hnb, p.w_in_t, D, D, D, 0}; pg8::StaticOrder S; S.init(RT / 256, INW / 256, nb, bid); EpiProj E{p.xp, p.glu};
      pg8::gemm_phase<EpiProj, pg8::StaticOrder>(lds, g, S, E); }
    { const int nproj = (RT / 256) * (INW / 256); const int first = (nproj > nb && nproj < 2 * nb) ? nproj - nb : 0, nfree = nb - first;
      for (int uu = bid - first; uu >= 0 && uu < 64; uu += nfree) {
        __syncthreads();
        const bool pw = uu < 32;
        pg8::Gemm g{pw ? p.w_out_t + PWD : p.w_out_t, pw ? p.pw_b16 : p.pool_ws, D, pw ? CWD : 256, pw ? CWD : 256, pw ? 0 : 256};
        pg8::OneUnit S; S.u.pm = (uu & 31) >> 2; S.u.pn = uu & 3; EpiBf16Out E{p.w_eff_t, D, pw ? PWD : 0, nullptr};
        pg8::gemm_phase<EpiBf16Out, pg8::OneUnit>(lds, g, S, E);
      }
      { const int b0 = nfree >= 96 ? first + 64 : 0;
        for (int nbk = bid - b0; nbk >= 0 && nbk < D / 64; nbk += nb) {
          __syncthreads();
          const int lane = threadIdx.x & 63, wv = threadIdx.x >> 6, n = nbk * 64 + lane;
          float a[8] = {0.f, 0.f, 0.f, 0.f, 0.f, 0.f, 0.f, 0.f};
          for (int j = wv * 128; j < wv * 128 + 128; j += 8) {
#pragma unroll
            for (int q = 0; q < 8; ++q) a[q] += p.pw_b[j + q] * p.w_out[(size_t)(PWD + j + q) * D + n]; }
          LAS float* red = (LAS float*)lds;
          red[wv * 64 + lane] = ((a[0] + a[1]) + (a[2] + a[3])) + ((a[4] + a[5]) + (a[6] + a[7]));
          __syncthreads();
          if (wv == 0) { float t = 0.f;
#pragma unroll
            for (int q = 0; q < 8; ++q) t += red[q * 64 + lane];
            p.bias_eff[n] = t; }
        } }
    }
    xcd_barrier(xb);
    phase_mix(p, lds, bid, nb);
    xcd_barrier(xb);
    { pg8::Gemm g{p.mixb, p.w_eff_t, D, D, D, 0}; pg8::StaticOrder S; S.init(SEQ / 256, D / 256, nb, bid); EpiResid E{p.x, p.bias_eff, p.h2b, p.ssq};
      pg8::gemm_phase<EpiResid, pg8::StaticOrder>(lds, g, S, E); }
    xcd_barrier(xb);
    { pg8::Gemm g{p.h2b, p.wq_t, D, D, D, 0}; pg8::StaticOrder S; S.init(SEQ / 256, D / 256, nb, bid); EpiQTopk E{p.ssq, p.rstd, p.keysb, p.idx, p.gsu};
      pg8::gemm_phase<EpiQTopk, pg8::StaticOrder>(lds, g, S, E); }
    xcd_barrier(xb);
    phase_pd(p, bid, nb);
    xcd_barrier(xb);
    phase_pa(p, bid, nb);
    xcd_barrier(xb);
    phase_pu(p, bid, nb);
    xcd_barrier(xb);
    phase_pf(p, bid, nb);
}

extern "C" void kernel_launch(void* const* d_in, const int* in_sizes, int n_in, void* d_out, int out_size, void* d_ws, size_t ws_size, hipStream_t stream) {
    Params p{};
    p.x = (const float*)d_in[0]; p.meta = (const float*)d_in[1]; p.mix_g = (const float*)d_in[2]; p.w_in = (const float*)d_in[3];
    p.pool_w = (const float*)d_in[4]; p.pool_scale = (const float*)d_in[5]; p.dw_w = (const float*)d_in[6]; p.dw_b = (const float*)d_in[7];
    p.ln_g = (const float*)d_in[8]; p.ln_b = (const float*)d_in[9]; p.pw_w = (const float*)d_in[10]; p.pw_b = (const float*)d_in[11];
    p.w_out = (const float*)d_in[12]; p.ffn_g = (const float*)d_in[13]; p.wq = (const float*)d_in[14]; p.keys = (const float*)d_in[15];
    p.down = (const float*)d_in[16]; p.up = (const float*)d_in[17]; p.fin_g = (const float*)d_in[18];
    p.out = (float*)d_out;
    char* w = (char*)d_ws; size_t off = 0;
    auto take = [&](size_t bytes) { char* r = w + off; off += (bytes + 255) & ~(size_t)255; return r; };
    p.idx = (unsigned short*)take((size_t)SEQ * 128 * 2);
    p.gsu = (float*)take((size_t)SEQ * 128 * 4);
    p.part = (bf16_t*)take((size_t)SEQ * 16 * 128 * 2);
    p.act = (bf16_t*)take((size_t)SEQ * 128 * 2);
    p.ssq2 = (float*)take((size_t)SEQ * 16 * 4);
    p.h3b = (bf16_t*)take((size_t)SEQ * D * 2);
    p.hnb = (bf16_t*)take((size_t)RT * D * 2);
    p.w_in_t = (bf16_t*)take((size_t)INW * D * 2);
    p.xp = (bf16_t*)take((size_t)RT * PWD * 2);
    p.glu = (bf16_t*)take((size_t)RT * CWD * 2);
    p.mixb = (bf16_t*)take((size_t)SEQ * D * 2);
    p.h2b = (bf16_t*)take((size_t)SEQ * D * 2);
    p.pool_ws = (bf16_t*)take((size_t)4 * 256 * 256 * 2);
    p.pw_b16 = (bf16_t*)take((size_t)CWD * CWD * 2);
    p.w_eff_t = (bf16_t*)take((size_t)D * D * 2);
    p.bias_eff = (float*)take((size_t)D * 4);
    p.w_out_t = (bf16_t*)take((size_t)D * D * 2);
    p.ssq = (float*)take((size_t)SEQ * 32 * 4);
    p.bar = (unsigned*)take((size_t)XCD_BAR_WORDS * 4);
    p.rstd = (float*)take((size_t)SEQ * 4);
    p.wq_t = (bf16_t*)take((size_t)D * D * 2);
    p.keysb = (bf16_t*)take((size_t)8 * 2 * 128 * 128 * 2);
    p.qb = (bf16_t*)take((size_t)SEQ * D * 2);
    p.down8 = (unsigned char*)take((size_t)16384 * D);
    p.up8 = (unsigned char*)take((size_t)16384 * D);
    p.sdn = (float*)take((size_t)16384 * 4);
    p.sup = (float*)take((size_t)16384 * 4);
    static int grid_blocks = 0;
    if (!grid_blocks) {
        int dev = 0, cus = 0, per_cu = 0;
        (void)hipGetDevice(&dev);
        (void)hipDeviceGetAttribute(&cus, hipDeviceAttributeMultiprocessorCount, dev);
        (void)hipFuncSetAttribute((const void*)k_mega, hipFuncAttributeMaxDynamicSharedMemorySize, LDS_BYTES);
        (void)hipOccupancyMaxActiveBlocksPerMultiprocessor(&per_cu, k_mega, NT, LDS_BYTES);
        if (per_cu < 1) { fprintf(stderr, "occupancy query says %d workgroups per CU: nothing launched\n", per_cu); grid_blocks = -1; }
        else if (cus != (SEQ / 256) * (D / 256)) { fprintf(stderr, "this build needs a %d-CU device (got %d): nothing launched\n", (SEQ / 256) * (D / 256), cus); grid_blocks = -1; }
        else grid_blocks = cus;
    }
    if (grid_blocks < 0) return;
    (void)hipMemsetAsync(p.bar, 0, (size_t)XCD_BAR_WORDS * 4, stream);
    void* args[] = {&p};
    hipError_t e = hipLaunchCooperativeKernel((void*)k_mega, dim3(grid_blocks), dim3(NT), args, LDS_BYTES, stream);
    if (e != hipSuccess) fprintf(stderr, "cooperative launch failed: %s (grid %d)\n", hipGetErrorString(e), grid_blocks);
}
```

```cpp
#include <hip/hip_runtime.h>
#include <hip/hip_cooperative_groups.h>
#include <stdint.h>
#include <cstdio>
namespace cg = cooperative_groups;

#define NT 512
#define LAS __attribute__((address_space(3)))
typedef unsigned short bf16_t;
typedef short bf16x8 __attribute__((ext_vector_type(8)));
typedef float f32x4 __attribute__((ext_vector_type(4)));
typedef unsigned u32x4 __attribute__((ext_vector_type(4)));
typedef unsigned u32x2 __attribute__((ext_vector_type(2)));

constexpr int D = 2048, SEQ = 8192, NMETA = 16, T = SEQ + NMETA;
constexpr int PWD = 1024, CWD = 1024, INW = 3072;
constexpr int KS = 31;
constexpr int RPAD = 240, RT = 8448;
constexpr int LDS_BYTES = 151552;

struct Params {
    const float *x, *meta, *mix_g, *w_in, *pool_w, *pool_scale, *dw_w, *dw_b, *ln_g, *ln_b, *pw_w, *pw_b, *w_out, *ffn_g, *wq, *keys, *down, *up, *fin_g;
    float* out;
    unsigned short* idx;
    unsigned* bar;
    bf16_t *hnb, *w_in_t, *xp, *glu, *mixb, *h2b, *pool_ws, *pw_b16, *w_eff_t, *w_out_t, *wq_t, *keysb, *qb;
    unsigned char *down8, *up8;
    float *sdn, *sup;
    float *gsu;
    bf16_t* part;
    bf16_t* act;
    float* ssq2;
    bf16_t* h3b;
    float *ssq, *rstd, *bias_eff;
};

__device__ __forceinline__ unsigned cvt_pk_bf16(float lo, float hi) { unsigned r; asm volatile("v_cvt_pk_bf16_f32 %0, %1, %2" : "=v"(r) : "v"(lo), "v"(hi)); return r; }
__device__ __forceinline__ void store16_wt(void* ptr, u32x4 v) { asm volatile("global_store_dwordx4 %0, %1, off sc1\n\ts_nop 1" :: "v"(ptr), "v"(v) : "memory"); }
__device__ __forceinline__ float wave_sum(float v) {
#pragma unroll
    for (int o = 1; o < 64; o <<= 1) v += __shfl_xor(v, o);
    return v;
}

__device__ __forceinline__ const float* hrow(const Params& p, int t) { return t < NMETA ? p.meta + (size_t)t * D : p.x + (size_t)(t - NMETA) * D; }

__device__ __forceinline__ float block_sum(float v, float* red) {
#pragma unroll
    for (int o = 32; o; o >>= 1) v += __shfl_xor(v, o);
    __syncthreads();
    if ((threadIdx.x & 63) == 0) red[threadIdx.x >> 6] = v;
    __syncthreads();
    float s = 0.f;
#pragma unroll
    for (int i = 0; i < NT / 64; ++i) s += red[i];
    return s;
}

namespace pg8 {
constexpr int BM = 256, BK = 64, HALF = 128, HTB = HALF * BK * 2, STAGE_BYTES = 8 * HTB, NXCD = 8, WGM = 8;
__device__ __forceinline__ int lds_byte(int r, int c) { const int st = (r >> 4) * 2 + (c >> 5), rr = r & 15, cc = c & 31, ob = rr * 64 + cc * 2; return st * 1024 + (ob ^ (((ob >> 9) & 1) << 5)); }
__device__ __forceinline__ void stage_rc(int b, int& R, int& C) { const int st = b / 1024, sb = b % 1024, swz = sb ^ (((sb >> 9) & 1) << 5); R = (st >> 1) * 16 + swz / 64; C = (st & 1) * 32 + (swz % 64) / 2; }
__device__ __forceinline__ int perm32(int rho) { const int n = rho >> 4, i = rho & 15; return 8 * (i >> 2) + 4 * n + (i & 3); }
struct Unit { int pm, pn; };
struct Gemm { const bf16_t* A; const bf16_t* Bt; int lda, ldb, K; int a_col_per_pn; };
struct StaticOrder {
    int nM, nN, nwg, G, c;
    __device__ void init(int nM_, int nN_, int G_, int c_) { nM = nM_; nN = nN_; nwg = nM * nN; G = G_; c = c_; }
    __device__ bool next(int i, Unit& u) const {
        const long L = (long)i * G + c; if (L >= nwg) return false;
        int wgid = (int)L; { const int q = nwg / NXCD, r = nwg % NXCD, xcd = wgid % NXCD, off = wgid / NXCD; wgid = (xcd < r ? xcd * (q + 1) : r * (q + 1) + (xcd - r) * q) + off; }
        const int nig = WGM * nN, gid = wgid / nig, fm = gid * WGM, gsz = (nM - fm) < WGM ? (nM - fm) : WGM;
        u.pm = fm + ((wgid % nig) % gsz); u.pn = (wgid % nig) / gsz; return true;
    }
};
struct OneUnit { Unit u; __device__ bool next(int i, Unit& o) const { if (i) return false; o = u; return true; } };
template <class Epi, class Sched>
__device__ __forceinline__ void gemm_phase(LAS unsigned char* lds, const Gemm g, const Sched& S, const Epi& E) {
    const int tid = threadIdx.x, wid = __builtin_amdgcn_readfirstlane(tid >> 6), lane = tid & 63, wr = wid >> 2, wc = wid & 3, fr = lane & 15, fq = lane >> 4;
    const int K = g.K, nt = K / BK;
    unsigned voffA[2], voffB[2];
#pragma unroll
    for (int i = 0; i < 2; ++i) { int R, C; stage_rc(tid * 16 + i * 8192, R, C);
        const int Rb = Epi::PERM ? ((R & ~31) + perm32(R & 31)) : R;
        voffA[i] = (unsigned)(R * g.lda + C) * 2u; voffB[i] = (unsigned)(Rb * g.ldb + C) * 2u; }
    const size_t kstep = (size_t)(BK * 2);
    const size_t hstepA = (size_t)HALF * g.lda * 2, hstepB = (size_t)HALF * g.ldb * 2;
    const size_t tstepA = 2 * hstepA, tstepB = 2 * hstepB;
    const unsigned ldsw = (unsigned)wid * 1024u;
    const int aoff = lds_byte(wr * 64 + fr, fq * 8), boff = lds_byte(wc * 32 + fr, fq * 8);
#define PG8_SA(b, h) (((b) * 2 + (h)) * HTB)
#define PG8_SB(b, h) ((4 + (b) * 2 + (h)) * HTB)
#define PG8_STAGE(bufoff, gbase, voff) do { _Pragma("unroll") for (int _i = 0; _i < 2; ++_i) \
        __builtin_amdgcn_global_load_lds((const unsigned*)((const char*)(gbase) + (voff)[_i]), (LAS unsigned*)(lds + (bufoff) + ldsw + _i * 8192), 16, 0, 0); } while (0)
#define PG8_LDA(dst, b, h) do { _Pragma("unroll") for (int m = 0; m < 4; ++m) _Pragma("unroll") for (int k = 0; k < 2; ++k) dst[m][k] = *(const LAS bf16x8*)(lds + PG8_SA(b, h) + aoff + m * 2048 + k * 1024); } while (0)
#define PG8_LDB(dst, b, h) do { _Pragma("unroll") for (int n = 0; n < 2; ++n) _Pragma("unroll") for (int k = 0; k < 2; ++k) dst[n][k] = *(const LAS bf16x8*)(lds + PG8_SB(b, h) + boff + n * 2048 + k * 1024); } while (0)
#define PG8_MMA(ai, bj, At, Bt) do { __builtin_amdgcn_s_setprio(1); _Pragma("unroll") for (int m = 0; m < 4; ++m) _Pragma("unroll") for (int n = 0; n < 2; ++n) _Pragma("unroll") for (int k = 0; k < 2; ++k) \
        acc[ai][bj][m][n] = __builtin_amdgcn_mfma_f32_16x16x32_bf16(Bt[n][k], At[m][k], acc[ai][bj][m][n], 0, 0, 0); __builtin_amdgcn_s_setprio(0); } while (0)
#define PG8_WAIT_V(n) asm volatile("s_waitcnt vmcnt(" #n ")" ::: "memory")
#define PG8_WAIT_L(n) asm volatile("s_waitcnt lgkmcnt(" #n ")" ::: "memory")
#define PG8_BAR __builtin_amdgcn_s_barrier()
#define PG8_SCHED __builtin_amdgcn_sched_barrier(0)
    Unit cur, nxt; int ui = 0;
    if (!S.next(0, cur)) return;
    f32x4 acc[2][2][4][2];
#pragma unroll
    for (int a = 0; a < 2; ++a)
#pragma unroll
        for (int b = 0; b < 2; ++b)
#pragma unroll
            for (int m = 0; m < 4; ++m)
#pragma unroll
                for (int n = 0; n < 2; ++n) acc[a][b][m][n] = (f32x4){0.f, 0.f, 0.f, 0.f};
    bf16x8 At[4][2], B0[2][2], B1[2][2];
    const char* cA = (const char*)g.A + (size_t)cur.pm * tstepA + (size_t)cur.pn * g.a_col_per_pn * 2; const char* cB = (const char*)g.Bt + (size_t)cur.pn * tstepB;
    PG8_STAGE(PG8_SB(0, 0), cB, voffB); PG8_STAGE(PG8_SA(0, 0), cA, voffA); PG8_STAGE(PG8_SB(0, 1), cB + hstepB, voffB); PG8_STAGE(PG8_SA(0, 1), cA + hstepA, voffA);
    if (wr == 1) PG8_BAR;
    PG8_WAIT_V(4); PG8_BAR;
    PG8_STAGE(PG8_SB(1, 0), cB + kstep, voffB); PG8_STAGE(PG8_SA(1, 0), cA + kstep, voffA); PG8_STAGE(PG8_SB(1, 1), cB + hstepB + kstep, voffB);
    PG8_WAIT_V(6); PG8_BAR;
    for (;;) {
        const bool has_next = S.next(ui + 1, nxt);
        const char* nA = has_next ? (const char*)g.A + (size_t)nxt.pm * tstepA + (size_t)nxt.pn * g.a_col_per_pn * 2 : cA; const char* nB = has_next ? (const char*)g.Bt + (size_t)nxt.pn * tstepB : cB;
        for (int t = 0; t < nt; t += 2) {
            const bool last = (t == nt - 2);
            const char* a1 = cA + (size_t)(t + 1) * kstep;
            const char* a2 = last ? nA : cA + (size_t)(t + 2) * kstep; const char* b2 = last ? nB : cB + (size_t)(t + 2) * kstep;
            const char* a3 = a2 + kstep; const char* b3 = b2 + kstep;
            PG8_LDB(B0, 0, 0); PG8_SCHED; PG8_LDA(At, 0, 0); PG8_STAGE(PG8_SA(1, 1), a1 + hstepA, voffA);
            PG8_WAIT_L(8); PG8_BAR; PG8_WAIT_L(0); PG8_MMA(0, 0, At, B0); PG8_BAR; PG8_SCHED;
            PG8_LDB(B1, 0, 1); PG8_STAGE(PG8_SB(0, 0), b2, voffB);
            PG8_BAR; PG8_WAIT_L(0); PG8_MMA(0, 1, At, B1); PG8_BAR;
            PG8_LDA(At, 0, 1); PG8_STAGE(PG8_SA(0, 0), a2, voffA);
            PG8_BAR; PG8_WAIT_L(0); PG8_MMA(1, 0, At, B0); PG8_BAR; PG8_SCHED;
            PG8_STAGE(PG8_SB(0, 1), b2 + hstepB, voffB);
            PG8_WAIT_V(6); PG8_BAR; PG8_MMA(1, 1, At, B1); PG8_BAR;
            PG8_LDB(B0, 1, 0); PG8_SCHED; PG8_LDA(At, 1, 0); PG8_STAGE(PG8_SA(0, 1), a2 + hstepA, voffA);
            PG8_WAIT_L(8); PG8_BAR; PG8_WAIT_L(0); PG8_MMA(0, 0, At, B0); PG8_BAR; PG8_SCHED;
            PG8_LDB(B1, 1, 1); PG8_STAGE(PG8_SB(1, 0), b3, voffB);
            PG8_BAR; PG8_WAIT_L(0); PG8_MMA(0, 1, At, B1); PG8_BAR;
            PG8_LDA(At, 1, 1); PG8_STAGE(PG8_SA(1, 0), a3, voffA);
            PG8_BAR; PG8_WAIT_L(0); PG8_MMA(1, 0, At, B0); PG8_BAR; PG8_SCHED;
            PG8_STAGE(PG8_SB(1, 1), b3 + hstepB, voffB);
            PG8_WAIT_V(6); PG8_BAR; PG8_MMA(1, 1, At, B1); PG8_BAR;
        }
        if constexpr (!Epi::AFTER_DRAIN) E(acc, cur, wr, wc, fr, fq);
        if (!has_next) break;
#pragma unroll
        for (int a = 0; a < 2; ++a)
#pragma unroll
            for (int b = 0; b < 2; ++b)
#pragma unroll
                for (int m = 0; m < 4; ++m)
#pragma unroll
                    for (int n = 0; n < 2; ++n) acc[a][b][m][n] = (f32x4){0.f, 0.f, 0.f, 0.f};
        cur = nxt; cA = nA; cB = nB; ++ui;
    }
    PG8_WAIT_V(0);
    if (wr == 0) PG8_BAR;
    PG8_BAR;
    if constexpr (Epi::AFTER_DRAIN) E.fused(acc, cur, wr, wc, fr, fq, lds, wid, lane);
#undef PG8_SA
#undef PG8_SB
#undef PG8_STAGE
#undef PG8_LDA
#undef PG8_LDB
#undef PG8_MMA
#undef PG8_WAIT_V
#undef PG8_WAIT_L
#undef PG8_BAR
#undef PG8_SCHED
}
}

struct EpiProjF32 {
    static constexpr bool PERM = false;
    static constexpr bool AFTER_DRAIN = false;
    float* proj;
    __device__ __forceinline__ void operator()(const f32x4 (&acc)[2][2][4][2], const pg8::Unit& u, int wr, int wc, int fr, int fq) const {
#pragma unroll
        for (int ai = 0; ai < 2; ++ai)
#pragma unroll
            for (int m = 0; m < 4; ++m) {
                const int t = u.pm * 256 + ai * 128 + wr * 64 + m * 16 + fr - RPAD;
                if (t >= 0) {
#pragma unroll
                    for (int bj = 0; bj < 2; ++bj)
#pragma unroll
                        for (int n = 0; n < 2; ++n) {
                            const int off = wc * 32 + n * 16 + fq * 4;
                            const int col = u.pn < 4 ? u.pn * 256 + bj * 128 + off : (bj ? 2048 : 1024) + (u.pn - 4) * 128 + off;
                            *(f32x4*)(proj + (size_t)t * INW + col) = acc[ai][bj][m][n];
                        }
                }
            }
    }
};


__device__ __forceinline__ float sigmoidf_fast(float x) { return __builtin_amdgcn_rcpf(1.0f + __expf(-x)); }

struct EpiProj {
    static constexpr bool PERM = true;
    static constexpr bool AFTER_DRAIN = false;
    bf16_t* xp; bf16_t* glu;
    __device__ __forceinline__ void operator()(const f32x4 (&acc)[2][2][4][2], const pg8::Unit& u, int wr, int wc, int fr, int fq) const {
#pragma unroll
        for (int ai = 0; ai < 2; ++ai)
#pragma unroll
            for (int m = 0; m < 4; ++m) {
                const size_t row = (size_t)(u.pm * 256 + ai * 128 + wr * 64 + m * 16 + fr);
                if (u.pn < 4) {
#pragma unroll
                    for (int bj = 0; bj < 2; ++bj) { const f32x4 v0 = acc[ai][bj][m][0], v1 = acc[ai][bj][m][1];
                        store16_wt(xp + row * PWD + u.pn * 256 + bj * 128 + wc * 32 + fq * 8, (u32x4){cvt_pk_bf16(v0[0], v0[1]), cvt_pk_bf16(v0[2], v0[3]), cvt_pk_bf16(v1[0], v1[1]), cvt_pk_bf16(v1[2], v1[3])}); }
                } else {
                    const f32x4 a0 = acc[ai][0][m][0], a1 = acc[ai][0][m][1], g0 = acc[ai][1][m][0], g1 = acc[ai][1][m][1];
                    store16_wt(glu + row * CWD + (u.pn - 4) * 128 + wc * 32 + fq * 8, (u32x4){
                        cvt_pk_bf16(a0[0] * sigmoidf_fast(g0[0]), a0[1] * sigmoidf_fast(g0[1])), cvt_pk_bf16(a0[2] * sigmoidf_fast(g0[2]), a0[3] * sigmoidf_fast(g0[3])),
                        cvt_pk_bf16(a1[0] * sigmoidf_fast(g1[0]), a1[1] * sigmoidf_fast(g1[1])), cvt_pk_bf16(a1[2] * sigmoidf_fast(g1[2]), a1[3] * sigmoidf_fast(g1[3]))});
                }
            }
    }
};
struct EpiBf16Out {
    static constexpr bool PERM = true;
    static constexpr bool AFTER_DRAIN = false;
    bf16_t* O; int ldc; int col0; const float* bias;
    __device__ __forceinline__ void operator()(const f32x4 (&acc)[2][2][4][2], const pg8::Unit& u, int wr, int wc, int fr, int fq) const {
#pragma unroll
        for (int ai = 0; ai < 2; ++ai)
#pragma unroll
            for (int m = 0; m < 4; ++m) {
                const size_t row = (size_t)(u.pm * 256 + ai * 128 + wr * 64 + m * 16 + fr);
#pragma unroll
                for (int bj = 0; bj < 2; ++bj) { const int c = u.pn * 256 + bj * 128 + wc * 32 + fq * 8; f32x4 v0 = acc[ai][bj][m][0], v1 = acc[ai][bj][m][1];
                    if (bias) { v0 += *(const f32x4*)(bias + c); v1 += *(const f32x4*)(bias + c + 4); }
                    *(u32x4*)(O + row * ldc + col0 + c) = (u32x4){cvt_pk_bf16(v0[0], v0[1]), cvt_pk_bf16(v0[2], v0[3]), cvt_pk_bf16(v1[0], v1[1]), cvt_pk_bf16(v1[2], v1[3])}; }
            }
    }
};
struct EpiResid {
    static constexpr bool PERM = true;
    static constexpr bool AFTER_DRAIN = false;
    const float* x; const float* bias; bf16_t* h2b; float* ssq;
    __device__ __forceinline__ void operator()(const f32x4 (&acc)[2][2][4][2], const pg8::Unit& u, int wr, int wc, int fr, int fq) const {
#pragma unroll
        for (int ai = 0; ai < 2; ++ai)
#pragma unroll
            for (int m = 0; m < 4; ++m) {
                const size_t row = (size_t)(u.pm * 256 + ai * 128 + wr * 64 + m * 16 + fr);
                float ss = 0.f;
#pragma unroll
                for (int bj = 0; bj < 2; ++bj) { const int c = u.pn * 256 + bj * 128 + wc * 32 + fq * 8;
                    const f32x4 v0 = acc[ai][bj][m][0] + *(const f32x4*)(x + row * D + c) + *(const f32x4*)(bias + c);
                    const f32x4 v1 = acc[ai][bj][m][1] + *(const f32x4*)(x + row * D + c + 4) + *(const f32x4*)(bias + c + 4);
                    store16_wt(h2b + row * D + c, (u32x4){cvt_pk_bf16(v0[0], v0[1]), cvt_pk_bf16(v0[2], v0[3]), cvt_pk_bf16(v1[0], v1[1]), cvt_pk_bf16(v1[2], v1[3])});
                    ss += ((v0[0] * v0[0] + v0[1] * v0[1]) + (v0[2] * v0[2] + v0[3] * v0[3])) + ((v1[0] * v1[0] + v1[1] * v1[1]) + (v1[2] * v1[2] + v1[3] * v1[3])); }
                ss += __shfl_xor(ss, 16); ss += __shfl_xor(ss, 32);
                if (fq == 0) ssq[row * 32 + u.pn * 4 + wc] = ss;
            }
    }
};

__device__ __forceinline__ float fsel(int mask, float a, float b) { return __int_as_float((__float_as_int(a) & ~mask) | (__float_as_int(b) & mask)); }
__device__ __forceinline__ float bf_lo(unsigned w) { return __uint_as_float(w << 16); }
__device__ __forceinline__ float bf_hi(unsigned w) { return __uint_as_float(w & 0xffff0000u); }

__device__ __forceinline__ u32x4 bload16(__amdgpu_buffer_rsrc_t r, int voff, int soff) { return __builtin_bit_cast(u32x4, __builtin_amdgcn_raw_buffer_load_b128(r, voff, soff, 0)); }
__device__ __forceinline__ unsigned bload4(__amdgpu_buffer_rsrc_t r, int voff, int soff) { return (unsigned)__builtin_amdgcn_raw_buffer_load_b32(r, voff, soff, 0); }
__device__ __forceinline__ void bstore4(__amdgpu_buffer_rsrc_t r, unsigned v, int voff, int soff) { __builtin_amdgcn_raw_buffer_store_b32(v, r, voff, soff, 0); }
__device__ __forceinline__ u32x2 bload8(__amdgpu_buffer_rsrc_t r, int voff, int soff) { return __builtin_bit_cast(u32x2, __builtin_amdgcn_raw_buffer_load_b64(r, voff, soff, 0)); }
template <int W> __device__ __forceinline__ void pool_tile(__amdgpu_buffer_rsrc_t rxp, __amdgpu_buffer_rsrc_t rpo, int r0, int tile, int tid) {
    unsigned v[32 + W - 1];
#pragma unroll
    for (int i = 0; i < 32 + W - 1; ++i) v[i] = bload4(rxp, tid * 4, (r0 - (W - 1) + i) * 2048);
    float s0 = 0.f, s1 = 0.f;
#pragma unroll
    for (int i = 0; i < W - 1; ++i) { s0 += bf_lo(v[i]); s1 += bf_hi(v[i]); }
    constexpr float inv = 1.0f / (float)W;
#pragma unroll
    for (int i = 0; i < 32; ++i) {
        const float a0 = bf_lo(v[W - 1 + i]), a1 = bf_hi(v[W - 1 + i]);
        s0 += a0; s1 += a1;
        bstore4(rpo, cvt_pk_bf16(s0 * inv - a0, s1 * inv - a1), tid * 4, (tile * 32 + i) * 4096);
        s0 -= bf_lo(v[i]); s1 -= bf_hi(v[i]);
    }
}
__device__ __forceinline__ void phase_mix(const Params& p, LAS unsigned char* lds, int bid, int nb) {
    const int tid = threadIdx.x, lane = tid & 63, wave = tid >> 6;
    LAS unsigned* gl = (LAS unsigned*)lds;
    LAS float* red = (LAS float*)(lds + 62 * 2048);
    const __amdgpu_buffer_rsrc_t rxp = __builtin_amdgcn_make_buffer_rsrc((void*)p.xp, 0, RT * PWD * 2, 0x00020000);
    const __amdgpu_buffer_rsrc_t rgl = __builtin_amdgcn_make_buffer_rsrc((void*)p.glu, 0, RT * CWD * 2, 0x00020000);
    const __amdgpu_buffer_rsrc_t rpo = __builtin_amdgcn_make_buffer_rsrc((void*)p.mixb, 0, SEQ * D * 2, 0x00020000);
    const __amdgpu_buffer_rsrc_t rww = __builtin_amdgcn_make_buffer_rsrc((void*)p.dw_w, 0, KS * CWD * 4, 0x00020000);
    const __amdgpu_buffer_rsrc_t rwb = __builtin_amdgcn_make_buffer_rsrc((void*)p.dw_b, 0, CWD * 4, 0x00020000);
    const __amdgpu_buffer_rsrc_t rlg = __builtin_amdgcn_make_buffer_rsrc((void*)p.ln_g, 0, CWD * 4, 0x00020000);
    const __amdgpu_buffer_rsrc_t rlb = __builtin_amdgcn_make_buffer_rsrc((void*)p.ln_b, 0, CWD * 4, 0x00020000);
    for (int tile = bid; tile < SEQ / 32; tile += nb) {
        const int r0 = 256 + tile * 32;
        __syncthreads();
#pragma unroll
        for (int j = 0; j < 16; ++j) { const int ch = j * NT + tid; if (ch < 62 * 128)
            *(LAS u32x4*)(lds + ch * 16) = bload16(rgl, tid * 16, (r0 - 30) * 2048 + j * 8192); }
        { const int g = __builtin_amdgcn_readfirstlane(tid >> 7);
          if (g == 0) pool_tile<2>(rxp, rpo, r0, tile, tid); else if (g == 1) pool_tile<4>(rxp, rpo, r0, tile, tid); else if (g == 2) pool_tile<8>(rxp, rpo, r0, tile, tid); else pool_tile<16>(rxp, rpo, r0, tile, tid); }
        __syncthreads();
#pragma unroll 1
        for (int hf = 0; hf < 2; ++hf) {
            float c0[16], c1[16];
            {
                float w0[KS], w1[KS];
#pragma unroll
                for (int k = 0; k < KS; ++k) { const u32x2 wv = bload8(rww, tid * 8, k * 4096); w0[k] = __uint_as_float(wv.x); w1[k] = __uint_as_float(wv.y); }
                const u32x2 bvv = bload8(rwb, tid * 8, 0); const float b0 = __uint_as_float(bvv.x), b1 = __uint_as_float(bvv.y);
#pragma unroll
                for (int i = 0; i < 16; ++i) { c0[i] = b0; c1[i] = b1; }
                const LAS unsigned* glh = gl + hf * 16 * 512 + tid;
#pragma unroll
                for (int rr = 0; rr < 46; ++rr) {
                    if ((rr & 7) == 0) asm volatile("" ::: "memory");
                    const unsigned vv = glh[rr * 512]; const float x0 = bf_lo(vv), x1 = bf_hi(vv);
#pragma unroll
                    for (int i = 0; i < 16; ++i) { const int k = rr - i; if (k >= 0 && k < KS) { c0[i] += x0 * w0[k]; c1[i] += x1 * w1[k]; } }
                }
            }
            asm volatile("" ::: "memory");
#pragma unroll
            for (int which = 0; which < 2; ++which) {
                float st[16];
#pragma unroll
                for (int i = 0; i < 16; ++i) st[i] = which == 0 ? c0[i] + c1[i] : c0[i] * c0[i] + c1[i] * c1[i];
#pragma unroll
                for (int lvl = 0; lvl < 4; ++lvl) {
                    const int o = 32 >> lvl, n = 8 >> lvl; const int mk = -((lane >> (5 - lvl)) & 1);
#pragma unroll
                    for (int j = 0; j < 8; ++j) if (j < n) st[j] = fsel(mk, st[j], st[j + n]) + __shfl_xor(fsel(mk, st[j + n], st[j]), o);
                }
                float tot = st[0] + __shfl_xor(st[0], 2); tot += __shfl_xor(tot, 1);
                if ((lane & 3) == 0) red[wave * 32 + which * 16 + (lane >> 2)] = tot;
            }
            __syncthreads();
            if (tid < 32) { float t = 0.f;
#pragma unroll
                for (int q = 0; q < 8; ++q) t += red[q * 32 + tid];
                red[256 + tid] = t; }
            __syncthreads();
            const u32x2 lgv = bload8(rlg, tid * 8, 0), lbv = bload8(rlb, tid * 8, 0); const float lg0 = __uint_as_float(lgv.x), lg1 = __uint_as_float(lgv.y), lb0 = __uint_as_float(lbv.x), lb1 = __uint_as_float(lbv.y);
#pragma unroll
            for (int i = 0; i < 16; ++i) {
                const float s1 = red[256 + i], s2 = red[256 + 16 + i];
                const float mu = s1 * (1.0f / CWD), var = fmaxf(s2 * (1.0f / CWD) - mu * mu, 0.f), rs = rsqrtf(var + 1e-5f);
                const float y0 = (c0[i] - mu) * rs * lg0 + lb0, y1 = (c1[i] - mu) * rs * lg1 + lb1;
                bstore4(rpo, cvt_pk_bf16(y0 * sigmoidf_fast(y0), y1 * sigmoidf_fast(y1)), tid * 4, (tile * 32 + hf * 16 + i) * 4096 + 2048);
            }
            __syncthreads();
        }
    }
}

typedef float f32x16 __attribute__((ext_vector_type(16)));
__device__ __forceinline__ int okey(float s) { const int u = __float_as_int(s); return u ^ ((u >> 31) & 0x7fffffff); }
__device__ __forceinline__ float okey_inv(int k) { return __int_as_float(k ^ ((k >> 31) & 0x7fffffff)); }
__device__ __forceinline__ void sort16_desc(int (&v)[16]) {
#pragma unroll
    for (int k = 2; k <= 16; k <<= 1) {
#pragma unroll
        for (int j = k >> 1; j > 0; j >>= 1) {
#pragma unroll
            for (int i = 0; i < 16; ++i) {
                const int l = i ^ j;
                if (l > i) { const bool desc = (i & k) == 0; const int hi = max(v[i], v[l]), lo = min(v[i], v[l]); v[i] = desc ? hi : lo; v[l] = desc ? lo : hi; }
            }
        }
    }
}
__device__ __forceinline__ void merge16_desc(int (&a)[16], const int (&b)[16]) {
#pragma unroll
    for (int i = 0; i < 16; ++i) a[i] = max(a[i], b[15 - i]);
#pragma unroll
    for (int j = 8; j > 0; j >>= 1) {
#pragma unroll
        for (int i = 0; i < 16; ++i) { const int l = i ^ j; if (l > i) { const int hi = max(a[i], a[l]), lo = min(a[i], a[l]); a[i] = hi; a[l] = lo; } }
    }
}
__device__ __forceinline__ void pair_merge(int (&a)[16]) {
    int b[16];
#pragma unroll
    for (int i = 0; i < 16; ++i) b[i] = __shfl_xor(a[i], 32);
    merge16_desc(a, b);
}
constexpr int CELL_I[64] = {0,0,0,0,0,0,0,0,0,0,0,0,0,0,0,0,1,1,1,1,1,1,1,1,2,2,2,2,2,3,3,3,3,4,4,4,5,5,6,6,7,7,8,9,10,11,12,13,14,15,0,0,0,0,0,0,0,0,0,0,0,0,0,0};
constexpr int CELL_J[64] = {0,1,2,3,4,5,6,7,8,9,10,11,12,13,14,15,0,1,2,3,4,5,6,7,0,1,2,3,4,0,1,2,3,0,1,2,0,1,0,1,0,1,0,0,0,0,0,0,0,0,0,0,0,0,0,0,0,0,0,0,0,0,0,0};
constexpr int NCELL = 50;

struct EpiQTopk {
    static constexpr bool PERM = false;
    static constexpr bool AFTER_DRAIN = true;
    const float* ssq; float* rstd; const bf16_t* keysb; unsigned short* idx; float* gsu;
    __device__ __forceinline__ void fused(const f32x4 (&acc)[2][2][4][2], const pg8::Unit& u, int wr, int wc, int fr, int fq, LAS unsigned char* lds, int wid, int lane) const {
        const int hh = lane >> 5, l31 = lane & 31, h = u.pn;
        LAS float* svt = (LAS float*)(lds + 65536 + (wid * 64 + lane) * 164);
        LAS unsigned char* sit = (LAS unsigned char*)(svt + 32);
        float rs[2][4];
#pragma unroll
        for (int ai = 0; ai < 2; ++ai)
#pragma unroll
            for (int m = 0; m < 4; ++m) {
                const size_t row = (size_t)(u.pm * 256 + ai * 128 + wr * 64 + m * 16 + fr);
                const f32x4* sp = (const f32x4*)(ssq + row * 32); f32x4 t = sp[0];
#pragma unroll
                for (int i = 1; i < 8; ++i) t += sp[i];
                rs[ai][m] = rsqrtf(((t[0] + t[1]) + (t[2] + t[3])) * (1.0f / D) + 1e-6f);
                if (u.pn == 0 && wc == 0 && fq == 0) rstd[row] = rs[ai][m];
            }
        const int trow = wid * 32 + l31;
#pragma unroll
        for (int ph = 0; ph < 2; ++ph) {
#pragma unroll
            for (int ai = 0; ai < 2; ++ai)
#pragma unroll
                for (int m = 0; m < 4; ++m) { const int row = ai * 128 + wr * 64 + m * 16 + fr;
#pragma unroll
                    for (int n = 0; n < 2; ++n) { const f32x4 v = acc[ai][ph][m][n] * rs[ai][m]; const int chunk = 4 * wc + 2 * n + (fq >> 1);
                        u32x2 w; w.x = cvt_pk_bf16(v[0], v[1]); w.y = cvt_pk_bf16(v[2], v[3]);
                        *(LAS u32x2*)(lds + row * 256 + ((chunk ^ (row & 15)) << 4) + (fq & 1) * 8) = w; } }
            __syncthreads();
            const bf16_t* krow = keysb + ((size_t)(h * 2 + ph) * 128 + l31) * 128 + 8 * hh;
            bf16x8 bq[8];
#pragma unroll
            for (int ks = 0; ks < 8; ++ks) bq[ks] = *(const LAS bf16x8*)(lds + trow * 256 + (((ks * 2 + hh) ^ (trow & 15)) << 4));
            int top[16];
#pragma unroll
            for (int i = 0; i < 16; ++i) top[i] = (int)0x80000000;
            bf16x8 ak[8];
#pragma unroll
            for (int ks = 0; ks < 8; ++ks) ak[ks] = *(const bf16x8*)(krow + ks * 16);
#pragma unroll 1
            for (int kt = 0; kt < 4; ++kt) {
                f32x16 c = {0.f, 0.f, 0.f, 0.f, 0.f, 0.f, 0.f, 0.f, 0.f, 0.f, 0.f, 0.f, 0.f, 0.f, 0.f, 0.f};
#pragma unroll
                for (int ks = 0; ks < 8; ++ks) c = __builtin_amdgcn_mfma_f32_32x32x16_bf16(ak[ks], bq[ks], c, 0, 0, 0);
                { const int kn = kt < 3 ? kt + 1 : 3;
#pragma unroll
                  for (int ks = 0; ks < 8; ++ks) ak[ks] = *(const bf16x8*)(krow + (size_t)kn * 32 * 128 + ks * 16); }
                int v[16];
                const int lowb = (127 - kt * 32) ^ (hh << 2);
#pragma unroll
                for (int r = 0; r < 16; ++r) v[r] = (okey(c[r]) & ~127) | (lowb - ((r & 3) + 8 * (r >> 2)));
                sort16_desc(v);
                merge16_desc(top, v);
            }
            pair_merge(top);
#pragma unroll
            for (int i = 0; i < 16; ++i) { svt[ph * 16 + i] = okey_inv(top[i] & ~127); sit[ph * 16 + i] = (unsigned char)(127 - (top[i] & 127)); }
            __syncthreads();
        }
        float sv[2][16];
#pragma unroll
        for (int i = 0; i < 16; ++i) { sv[0][i] = svt[i]; sv[1][i] = svt[16 + i]; }
        int w0[16], w1[16];
#pragma unroll
        for (int s = 0; s < 32; ++s) {
            const int e0 = 2 * s, e1 = 2 * s + 1;
            int key;
            if (e0 >= NCELL) key = (int)0x80000000;
            else {
                const float v0 = sv[0][CELL_I[e0]] + sv[1][CELL_J[e0]];
                const int k0 = (okey(v0) & ~255) | (255 - (CELL_I[e0] * 16 + CELL_J[e0]));
                if (e1 >= NCELL) key = hh ? (int)0x80000000 : k0;
                else { const float v1 = sv[0][CELL_I[e1]] + sv[1][CELL_J[e1]];
                    const int k1 = (okey(v1) & ~255) | (255 - (CELL_I[e1] * 16 + CELL_J[e1]));
                    key = hh ? k1 : k0; }
            }
            if (s < 16) w0[s] = key; else w1[s - 16] = key;
        }
        sort16_desc(w0); sort16_desc(w1); merge16_desc(w0, w1); pair_merge(w0);
        const float mx = okey_inv(w0[0] & ~255);
        float sum = 0.f;
#pragma unroll
        for (int k = 0; k < 16; ++k) sum += __expf(okey_inv(w0[k] & ~255) - mx);
        const float inv = 1.0f / sum;
        int eo[8]; float go[8]; const int hmask = -hh;
#pragma unroll
        for (int k = 0; k < 8; ++k) { const int kk = (w0[k] & ~hmask) | (w0[8 + k] & hmask); const int cc = 255 - (kk & 255);
            eo[k] = (int)sit[cc >> 4] * 128 + (int)sit[16 + (cc & 15)]; go[k] = __expf(okey_inv(kk & ~255) - mx) * inv; }
        const size_t ob = (size_t)(u.pm * 256 + trow) * 128 + h * 16 + hh * 8;
        *(u32x4*)(idx + ob) = (u32x4){(unsigned)eo[0] | ((unsigned)eo[1] << 16), (unsigned)eo[2] | ((unsigned)eo[3] << 16), (unsigned)eo[4] | ((unsigned)eo[5] << 16), (unsigned)eo[6] | ((unsigned)eo[7] << 16)};
        *(f32x4*)(gsu + ob) = (f32x4){go[0], go[1], go[2], go[3]};
        *(f32x4*)(gsu + ob + 4) = (f32x4){go[4], go[5], go[6], go[7]};
    }
    __device__ __forceinline__ void operator()(const f32x4 (&)[2][2][4][2], const pg8::Unit&, int, int, int, int) const {}
};

__device__ __forceinline__ void fp8_row2(const float* s0, unsigned char* d0, float* i0, const float* s1, unsigned char* d1, float* i1, int lane) {
    f32x4 v[2][2][4]; float am[2] = {0.f, 0.f};
#pragma unroll
    for (int r = 0; r < 2; ++r)
#pragma unroll
        for (int k = 0; k < 2; ++k)
#pragma unroll
            for (int i = 0; i < 4; ++i) v[r][k][i] = __builtin_nontemporal_load((const f32x4*)((r ? s1 : s0) + 1024 * k + 16 * lane + 4 * i));
#pragma unroll
    for (int r = 0; r < 2; ++r) {
#pragma unroll
        for (int k = 0; k < 2; ++k)
#pragma unroll
            for (int i = 0; i < 4; ++i) am[r] = fmaxf(am[r], fmaxf(fmaxf(fabsf(v[r][k][i].x), fabsf(v[r][k][i].y)), fmaxf(fabsf(v[r][k][i].z), fabsf(v[r][k][i].w))));
#pragma unroll
        for (int o = 1; o < 64; o <<= 1) am[r] = fmaxf(am[r], __shfl_xor(am[r], o));
        int be = (__float_as_int(am[r]) >> 23) & 255; be = be < 8 ? 8 : (be > 248 ? 248 : be);
        const float sc = __int_as_float((260 - be) << 23), isc = __int_as_float((be - 6) << 23);
#pragma unroll
        for (int k = 0; k < 2; ++k) { u32x4 w; unsigned ww[4];
#pragma unroll
            for (int i = 0; i < 4; ++i) { int t = 0; t = __builtin_amdgcn_cvt_pk_fp8_f32(v[r][k][i].x * sc, v[r][k][i].y * sc, t, false); t = __builtin_amdgcn_cvt_pk_fp8_f32(v[r][k][i].z * sc, v[r][k][i].w * sc, t, true); ww[i] = (unsigned)t; }
            w.x = ww[0]; w.y = ww[1]; w.z = ww[2]; w.w = ww[3];
            *(u32x4*)((r ? d1 : d0) + 1024 * k + 16 * lane) = w; }
        if (lane == 0) *(r ? i1 : i0) = isc;
    }
}

typedef float f32x2 __attribute__((ext_vector_type(2)));
template <int N> __device__ __forceinline__ f32x2 dot16_fp8(const u32x4 w, const f32x2 (&x)[N], int o, f32x2 acc) {
    const unsigned ww[4] = {w.x, w.y, w.z, w.w};
#pragma unroll
    for (int d = 0; d < 4; ++d) { acc += __builtin_amdgcn_cvt_pk_f32_fp8((int)ww[d], false) * x[o + 2 * d]; acc += __builtin_amdgcn_cvt_pk_f32_fp8((int)ww[d], true) * x[o + 2 * d + 1]; }
    return acc;
}
template <int N> __device__ __forceinline__ void axpy16_fp8(const u32x4 w, float a, f32x2 (&y)[N], int o) {
    const unsigned ww[4] = {w.x, w.y, w.z, w.w}; const f32x2 a2 = {a, a};
#pragma unroll
    for (int d = 0; d < 4; ++d) { y[o + 2 * d] += a2 * __builtin_amdgcn_cvt_pk_f32_fp8((int)ww[d], false); y[o + 2 * d + 1] += a2 * __builtin_amdgcn_cvt_pk_f32_fp8((int)ww[d], true); }
}
__device__ __forceinline__ void bstore16(__amdgpu_buffer_rsrc_t r, f32x4 v, int voff, int soff) { __builtin_amdgcn_raw_buffer_store_b128(__builtin_bit_cast(__attribute__((__vector_size__(4 * sizeof(unsigned)))) unsigned, v), r, voff, soff, 0); }
__device__ __forceinline__ void bstore8(__amdgpu_buffer_rsrc_t r, f32x2 v, int voff, int soff) { __builtin_amdgcn_raw_buffer_store_b64(__builtin_bit_cast(__attribute__((__vector_size__(2 * sizeof(unsigned)))) unsigned, v), r, voff, soff, 0); }
__device__ __forceinline__ f32x2 fsel2(int mask, f32x2 a, f32x2 b) { return (f32x2){fsel(mask, a.x, b.x), fsel(mask, a.y, b.y)}; }
__device__ __forceinline__ f32x2 shx2(f32x2 a, int o) { return (f32x2){__shfl_xor(a.x, o), __shfl_xor(a.y, o)}; }

__device__ __forceinline__ void phase_pd(const Params& p, int bid, int nb) {
    const int tid = threadIdx.x, lane = tid & 63, wave = __builtin_amdgcn_readfirstlane(tid >> 6);
    if (wave == 7) {
        for (int e = bid; e < 16384; e += 2 * nb) { const int e2 = e + nb < 16384 ? e + nb : e;
            fp8_row2(p.up + (size_t)e * D, p.up8 + (size_t)e * D, p.sup + e, p.up + (size_t)e2 * D, p.up8 + (size_t)e2 * D, p.sup + e2, lane); }
        return;
    }
    const int v = bid & 7, lw = (bid >> 3) * 7 + wave, NLW = (nb >> 3) * 7;
    const int c = lane & 7, sub = lane >> 3;
    const int m0 = -(lane & 1), m1 = -((lane >> 1) & 1), m2 = -((lane >> 2) & 1);
    const __amdgpu_buffer_rsrc_t rd = __builtin_amdgcn_make_buffer_rsrc((void*)p.down8, 0, 16384 * D, 0x00020000);
    const __amdgpu_buffer_rsrc_t rh = __builtin_amdgcn_make_buffer_rsrc((void*)p.h2b, 0, SEQ * D * 2, 0x00020000);
    const __amdgpu_buffer_rsrc_t rg1 = __builtin_amdgcn_make_buffer_rsrc((void*)p.ffn_g, 0, D * 4, 0x00020000);
    const __amdgpu_buffer_rsrc_t ri = __builtin_amdgcn_make_buffer_rsrc((void*)p.idx, 0, SEQ * 128 * 2, 0x00020000);
    const __amdgpu_buffer_rsrc_t rrs = __builtin_amdgcn_make_buffer_rsrc((void*)p.rstd, 0, SEQ * 4, 0x00020000);
    const __amdgpu_buffer_rsrc_t rp = __builtin_amdgcn_make_buffer_rsrc((void*)p.part, 0, SEQ * 16 * 128 * 2, 0x00020000);
    const int vsub = sub * 32, vc2 = c * 32, vc1 = c * 16, vl4 = lane * 4;
#pragma unroll 1
    for (int pass = 0; pass < 2; ++pass) {
        const int sl = v * 2 + pass;
        f32x2 gs[8];
#pragma unroll
        for (int i = 0; i < 4; ++i) { const f32x4 g = __builtin_bit_cast(f32x4, bload16(rg1, c * 64, sl * 512 + i * 16)); gs[2 * i] = (f32x2){g[0], g[1]}; gs[2 * i + 1] = (f32x2){g[2], g[3]}; }
        u32x4 ix[2], hh[2]; unsigned rsb;
        {
            const int t = lw;
#pragma unroll
            for (int i = 0; i < 2; ++i) ix[i] = bload16(ri, vsub, t * 256 + i * 16);
            hh[0] = bload16(rh, vc2, t * 4096 + sl * 256); hh[1] = bload16(rh, vc2, t * 4096 + sl * 256 + 16); rsb = bload4(rrs, 0, t * 4);
        }
#pragma unroll 1
        for (int t = lw; t < SEQ; t += NLW) {
            asm volatile("" ::: "memory");
            u32x4 w[16];
            {
                const unsigned ew[8] = {ix[0].x, ix[0].y, ix[0].z, ix[0].w, ix[1].x, ix[1].y, ix[1].z, ix[1].w};
#pragma unroll
                for (int g = 0; g < 16; ++g) { const unsigned e = (g & 1) ? (ew[g >> 1] >> 16) : (ew[g >> 1] & 0xffffu); w[g] = bload16(rd, (int)(e * 2048u) + vc1, sl * 128); }
            }
            f32x2 xs[8];
            {
                const float rs = __uint_as_float(rsb);
                const unsigned hw[8] = {hh[0].x, hh[0].y, hh[0].z, hh[0].w, hh[1].x, hh[1].y, hh[1].z, hh[1].w};
#pragma unroll
                for (int i = 0; i < 8; ++i) xs[i] = (f32x2){bf_lo(hw[i]) * rs, bf_hi(hw[i]) * rs} * gs[i];
            }
            asm volatile("" ::: "memory");
            {
                const int tn = t + NLW < SEQ ? t + NLW : t;
#pragma unroll
                for (int i = 0; i < 2; ++i) ix[i] = bload16(ri, vsub, tn * 256 + i * 16);
                hh[0] = bload16(rh, vc2, tn * 4096 + sl * 256); hh[1] = bload16(rh, vc2, tn * 4096 + sl * 256 + 16); rsb = bload4(rrs, 0, tn * 4);
            }
            asm volatile("" ::: "memory");
            float r[16];
#pragma unroll
            for (int g = 0; g < 16; ++g) { const f32x2 z = {0.f, 0.f}; const f32x2 s2 = dot16_fp8(w[g], xs, 0, z); r[g] = s2.x + s2.y; }
            float k8[8], k4[4];
#pragma unroll
            for (int i = 0; i < 8; ++i) k8[i] = fsel(m2, r[i], r[i + 8]) + __shfl_xor(fsel(m2, r[i + 8], r[i]), 4);
#pragma unroll
            for (int i = 0; i < 4; ++i) k4[i] = fsel(m1, k8[i], k8[i + 4]) + __shfl_xor(fsel(m1, k8[i + 4], k8[i]), 2);
            const float k0 = fsel(m0, k4[0], k4[2]) + __shfl_xor(fsel(m0, k4[2], k4[0]), 1);
            const float k1 = fsel(m0, k4[1], k4[3]) + __shfl_xor(fsel(m0, k4[3], k4[1]), 1);
            bstore4(rp, cvt_pk_bf16(k0, k1), vl4, (t * 16 + sl) * 256);
        }
    }
}
__device__ __forceinline__ void phase_pa(const Params& p, int bid, int nb) {
    const int tid = threadIdx.x, lane = tid & 63, wave = tid >> 6;
    const int gw = bid * 8 + wave, NGW = nb * 8;
    for (int it = gw; it < SEQ * 2; it += NGW) {
        const int t = it >> 1, pp = (it & 1) * 64 + lane;
        const bf16_t* pr = p.part + (size_t)t * 2048 + pp;
        float hs = 0.f;
#pragma unroll
        for (int sl = 0; sl < 16; ++sl) hs += __uint_as_float((unsigned)pr[sl * 128] << 16);
        const int e = (int)p.idx[(size_t)t * 128 + pp];
        hs *= p.sdn[e];
        const float av = p.gsu[(size_t)t * 128 + pp] * p.sup[e] * 0.5f * hs * (1.0f + erff(hs * 0.70710678118654752f));
        p.act[(size_t)t * 128 + pp] = (bf16_t)(cvt_pk_bf16(av, 0.f) & 0xffffu);
    }
}
__device__ __forceinline__ void phase_pu(const Params& p, int bid, int nb) {
    const int tid = threadIdx.x, lane = tid & 63, wave = __builtin_amdgcn_readfirstlane(tid >> 6);
    const int v = bid & 7, lw = (bid >> 3) * 8 + wave, NLW = (nb >> 3) * 8;
    const int c = lane & 7, sub = lane >> 3;
    const int m3 = -((lane >> 3) & 1), m4 = -((lane >> 4) & 1), m5 = -((lane >> 5) & 1);
    const __amdgpu_buffer_rsrc_t ru = __builtin_amdgcn_make_buffer_rsrc((void*)p.up8, 0, 16384 * D, 0x00020000);
    const __amdgpu_buffer_rsrc_t rh = __builtin_amdgcn_make_buffer_rsrc((void*)p.h2b, 0, SEQ * D * 2, 0x00020000);
    const __amdgpu_buffer_rsrc_t ri = __builtin_amdgcn_make_buffer_rsrc((void*)p.idx, 0, SEQ * 128 * 2, 0x00020000);
    const __amdgpu_buffer_rsrc_t ra = __builtin_amdgcn_make_buffer_rsrc((void*)p.act, 0, SEQ * 128 * 2, 0x00020000);
    const __amdgpu_buffer_rsrc_t ro = __builtin_amdgcn_make_buffer_rsrc((void*)p.h3b, 0, SEQ * D * 2, 0x00020000);
    const __amdgpu_buffer_rsrc_t rq = __builtin_amdgcn_make_buffer_rsrc((void*)p.ssq2, 0, SEQ * 16 * 4, 0x00020000);
    const int vsub = sub * 32, vc1 = c * 16, vh = c * 32 + sub * 4;
#pragma unroll 1
    for (int pass = 0; pass < 2; ++pass) {
        const int sl = v * 2 + pass;
        u32x4 ix[2], ac[2]; unsigned hb;
        {
            const int t = lw;
#pragma unroll
            for (int i = 0; i < 2; ++i) { ix[i] = bload16(ri, vsub, t * 256 + i * 16); ac[i] = bload16(ra, vsub, t * 256 + i * 16); }
            hb = bload4(rh, vh, t * 4096 + sl * 256);
        }
#pragma unroll 1
        for (int t = lw; t < SEQ; t += NLW) {
            asm volatile("" ::: "memory");
            u32x4 w[16];
            {
                const unsigned ew[8] = {ix[0].x, ix[0].y, ix[0].z, ix[0].w, ix[1].x, ix[1].y, ix[1].z, ix[1].w};
#pragma unroll
                for (int g = 0; g < 16; ++g) { const unsigned e = (g & 1) ? (ew[g >> 1] >> 16) : (ew[g >> 1] & 0xffffu); w[g] = bload16(ru, (int)(e * 2048u) + vc1, sl * 128); }
            }
            const unsigned aw[8] = {ac[0].x, ac[0].y, ac[0].z, ac[0].w, ac[1].x, ac[1].y, ac[1].z, ac[1].w};
            float a[16];
#pragma unroll
            for (int g = 0; g < 16; ++g) a[g] = (g & 1) ? bf_hi(aw[g >> 1]) : bf_lo(aw[g >> 1]);
            const unsigned hcur = hb;
            asm volatile("" ::: "memory");
            {
                const int tn = t + NLW < SEQ ? t + NLW : t;
#pragma unroll
                for (int i = 0; i < 2; ++i) { ix[i] = bload16(ri, vsub, tn * 256 + i * 16); ac[i] = bload16(ra, vsub, tn * 256 + i * 16); }
                hb = bload4(rh, vh, tn * 4096 + sl * 256);
            }
            asm volatile("" ::: "memory");
            f32x2 acc[8];
#pragma unroll
            for (int i = 0; i < 8; ++i) acc[i] = (f32x2){0.f, 0.f};
#pragma unroll
            for (int g = 0; g < 16; ++g) axpy16_fp8(w[g], a[g], acc, 0);
            f32x2 k4[4], k2[2];
#pragma unroll
            for (int i = 0; i < 4; ++i) k4[i] = fsel2(m5, acc[i], acc[i + 4]) + shx2(fsel2(m5, acc[i + 4], acc[i]), 32);
#pragma unroll
            for (int i = 0; i < 2; ++i) k2[i] = fsel2(m4, k4[i], k4[i + 2]) + shx2(fsel2(m4, k4[i + 2], k4[i]), 16);
            f32x2 h3 = fsel2(m3, k2[0], k2[1]) + shx2(fsel2(m3, k2[1], k2[0]), 8);
            h3 += (f32x2){bf_lo(hcur), bf_hi(hcur)};
            bstore4(ro, cvt_pk_bf16(h3.x, h3.y), vh, t * 4096 + sl * 256);
            const float ss = wave_sum(h3.x * h3.x + h3.y * h3.y);
            if (lane == 0) bstore4(rq, __float_as_uint(ss), 0, (t * 16 + sl) * 4);
        }
    }
}
__device__ __forceinline__ void phase_pf(const Params& p, int bid, int nb) {
    const int tid = threadIdx.x, lane = tid & 63, wave = tid >> 6;
    const int gw = bid * 8 + wave, NGW = nb * 8;
    for (int t = gw; t < SEQ; t += NGW) {
        const f32x4* sp = (const f32x4*)(p.ssq2 + (size_t)t * 16); f32x4 q = sp[0] + sp[1] + sp[2] + sp[3];
        const float rf = rsqrtf(((q[0] + q[1]) + (q[2] + q[3])) * (1.0f / D) + 1e-6f);
        const u32x4* hp = (const u32x4*)(p.h3b + (size_t)t * D) + lane;
        f32x4* o = (f32x4*)(p.out + (size_t)t * D) + 2 * lane; const f32x4* g = (const f32x4*)p.fin_g + 2 * lane;
#pragma unroll
        for (int j = 0; j < 4; ++j) { const u32x4 h = hp[64 * j]; const f32x4 g0 = g[128 * j], g1 = g[128 * j + 1];
            o[128 * j] = (f32x4){bf_lo(h.x) * rf * g0[0], bf_hi(h.x) * rf * g0[1], bf_lo(h.y) * rf * g0[2], bf_hi(h.y) * rf * g0[3]};
            o[128 * j + 1] = (f32x4){bf_lo(h.z) * rf * g1[0], bf_hi(h.z) * rf * g1[1], bf_lo(h.w) * rf * g1[2], bf_hi(h.w) * rf * g1[3]}; }
    }
}

__device__ __forceinline__ void fp8_row(const float* src, unsigned char* dst, float* inv_scale, int lane) {
    f32x4 v[2][4]; float am = 0.f;
#pragma unroll
    for (int k = 0; k < 2; ++k)
#pragma unroll
        for (int i = 0; i < 4; ++i) { v[k][i] = *(const f32x4*)(src + 1024 * k + 16 * lane + 4 * i);
            am = fmaxf(am, fmaxf(fmaxf(fabsf(v[k][i].x), fabsf(v[k][i].y)), fmaxf(fabsf(v[k][i].z), fabsf(v[k][i].w)))); }
#pragma unroll
    for (int o = 1; o < 64; o <<= 1) am = fmaxf(am, __shfl_xor(am, o));
    int be = (__float_as_int(am) >> 23) & 255; be = be < 8 ? 8 : (be > 248 ? 248 : be);
    const float sc = __int_as_float((260 - be) << 23), isc = __int_as_float((be - 6) << 23);
#pragma unroll
    for (int k = 0; k < 2; ++k) { u32x4 w; unsigned ww[4];
#pragma unroll
        for (int i = 0; i < 4; ++i) { int t = 0; t = __builtin_amdgcn_cvt_pk_fp8_f32(v[k][i].x * sc, v[k][i].y * sc, t, false); t = __builtin_amdgcn_cvt_pk_fp8_f32(v[k][i].z * sc, v[k][i].w * sc, t, true); ww[i] = (unsigned)t; }
        w.x = ww[0]; w.y = ww[1]; w.z = ww[2]; w.w = ww[3];
        *(u32x4*)(dst + 1024 * k + 16 * lane) = w; }
    if (lane == 0) *inv_scale = isc;
}

__device__ __forceinline__ void tr_item(const float* W, int ldw, int srccol0, int k0, bf16_t* WT, int ldt, int n0, const float* kscale, const float* nscale, LAS float* scr, int lane) {
    float tv[32];
#pragma unroll
    for (int i = 0; i < 32; ++i) { const int kk = 2 * i + (lane >> 5); tv[i] = W[(size_t)(k0 + kk) * ldw + srccol0 + (lane & 31)]; }
    const float ns = nscale ? nscale[srccol0 + (lane & 31)] : 1.0f;
#pragma unroll
    for (int i = 0; i < 32; ++i) { const int kk = 2 * i + (lane >> 5); float v = tv[i] * ns;
        if (kscale) v *= kscale[k0 + kk]; scr[kk * 33 + (lane & 31)] = v; }
    asm volatile("s_waitcnt lgkmcnt(0)" ::: "memory");
    const int c = lane & 7;
#pragma unroll
    for (int j = 0; j < 4; ++j) { const int n = (lane >> 3) + 8 * j; const LAS float* s = scr + (8 * c) * 33 + n;
        u32x4 o; o.x = cvt_pk_bf16(s[0 * 33], s[1 * 33]); o.y = cvt_pk_bf16(s[2 * 33], s[3 * 33]); o.z = cvt_pk_bf16(s[4 * 33], s[5 * 33]); o.w = cvt_pk_bf16(s[6 * 33], s[7 * 33]);
        *(u32x4*)(WT + (size_t)(n0 + n) * ldt + k0 + 8 * c) = o; }
    asm volatile("s_waitcnt lgkmcnt(0)" ::: "memory");
}
__device__ __forceinline__ int win_srccol(int n) { const int pn = n >> 8, w = n & 255; return pn < 4 ? n : ((w >> 7) ? 2048 : 1024) + (pn - 4) * 128 + (w & 127); }

__device__ __forceinline__ void phase_prep(const Params& p, LAS unsigned char* lds, int bid, int nb) {
    const int tid = threadIdx.x, lane = tid & 63, wave = tid >> 6;
    const int gw = bid * 8 + wave, NGW = nb * 8;
    LAS float* scr = (LAS float*)(lds + wave * 8448);
    for (int r = gw; r < RT; r += NGW) {
        unsigned long long* o8 = (unsigned long long*)(p.hnb + (size_t)r * D) + lane;
        if (r < RPAD) {
#pragma unroll
            for (int j = 0; j < 8; ++j) o8[64 * j] = 0ull;
        } else {
            const f32x4* xr = (const f32x4*)hrow(p, r - RPAD) + lane;
            const f32x4* gr = (const f32x4*)p.mix_g + lane;
            f32x4 v[8]; float s = 0.f;
#pragma unroll
            for (int j = 0; j < 8; ++j) { v[j] = __builtin_nontemporal_load(xr + 64 * j); s += (v[j].x * v[j].x + v[j].y * v[j].y) + (v[j].z * v[j].z + v[j].w * v[j].w); }
            const float rs = rsqrtf(wave_sum(s) * (1.0f / D) + 1e-6f);
#pragma unroll
            for (int j = 0; j < 8; ++j) { const f32x4 gv = gr[64 * j];
                o8[64 * j] = (unsigned long long)cvt_pk_bf16(v[j].x * rs * gv.x, v[j].y * rs * gv.y) | ((unsigned long long)cvt_pk_bf16(v[j].z * rs * gv.z, v[j].w * rs * gv.w) << 32); }
        }
    }
    for (int it = gw; it < (D / 64) * (INW / 32); it += NGW) {
        const int kb = it / (INW / 32), nbk = it % (INW / 32);
        tr_item(p.w_in, INW, win_srccol(nbk * 32), kb * 64, p.w_in_t, D, nbk * 32, nullptr, nullptr, scr, lane);
    }
    for (int i = gw * 64 + lane; i < 4 * 256 * 256 / 4; i += NGW * 64) { const f32x4 v = ((const f32x4*)p.pool_w)[i];
        const int g = i >> 14, d = (i & 63) * 4; const f32x4 sc = *(const f32x4*)(p.pool_scale + g * 256 + d);
        u32x2 w; w.x = cvt_pk_bf16(v[0] * sc[0], v[1] * sc[1]); w.y = cvt_pk_bf16(v[2] * sc[2], v[3] * sc[3]); ((u32x2*)p.pool_ws)[i] = w; }
    for (int i = gw * 64 + lane; i < CWD * CWD / 4; i += NGW * 64) { const f32x4 v = ((const f32x4*)p.pw_w)[i];
        u32x2 w; w.x = cvt_pk_bf16(v[0], v[1]); w.y = cvt_pk_bf16(v[2], v[3]); ((u32x2*)p.pw_b16)[i] = w; }
    for (int it = gw; it < 32 * 64; it += NGW) { const int kb = it >> 6, nbk = it & 63;
        tr_item(p.w_out, D, nbk * 32, kb * 64, p.w_out_t, D, nbk * 32, nullptr, nullptr, scr, lane); }
    for (int it = gw; it < 32 * 64; it += NGW) { const int kb = it >> 6, nbk = it & 63;
        tr_item(p.wq, D, nbk * 32, kb * 64, p.wq_t, D, nbk * 32, p.ffn_g, nullptr, scr, lane); }
    for (int i = gw * 64 + lane; i < 8 * 2 * 128 * 128 / 4; i += NGW * 64) { const f32x4 v = ((const f32x4*)p.keys)[i];
        u32x2 w; w.x = cvt_pk_bf16(v[0], v[1]); w.y = cvt_pk_bf16(v[2], v[3]); ((u32x2*)p.keysb)[i] = w; }
    for (int e = gw; e < 16384; e += 2 * NGW) { const int e2 = e + NGW < 16384 ? e + NGW : e;
        fp8_row2(p.down + (size_t)e * D, p.down8 + (size_t)e * D, p.sdn + e, p.down + (size_t)e2 * D, p.down8 + (size_t)e2 * D, p.sdn + e2, lane); }
}


#define XB_TMO      128
#define XB_XCNT(j)  (256  + 64 * (j))
#define XB_XSUB(j)  (1280 + 64 * (j))
#define XB_XGEN(j)  (2304 + 64 * (j))
#define XB_TOP      3328
#define XB_TOPGEN   3392
#define XCD_BAR_WORDS 3456
#define XB_SPIN_CAP (1u << 18)
__device__ __forceinline__ unsigned xb_ld(unsigned* p)              { return __hip_atomic_load(p, __ATOMIC_RELAXED, __HIP_MEMORY_SCOPE_AGENT); }
__device__ __forceinline__ unsigned xb_add(unsigned* p, unsigned v) { return __hip_atomic_fetch_add(p, v, __ATOMIC_RELAXED, __HIP_MEMORY_SCOPE_AGENT); }
__device__ __forceinline__ unsigned xb_xcc_id() { return (unsigned)__builtin_amdgcn_s_getreg((3 << 11) | 20) & 0xFu; }
#define XB_SPIN(cond, bar) do { unsigned _sp = 0; while (cond) { __builtin_amdgcn_s_sleep(1); \
    if ((++_sp & 255u) == 0u) { if (xb_ld(&(bar)[XB_TMO])) break; if (_sp > XB_SPIN_CAP) { atomicAdd(&(bar)[XB_TMO], 1u); break; } } } } while (0)
struct XcdBarrier { unsigned* bar; unsigned x; volatile LAS unsigned* st; };
__device__ __forceinline__ XcdBarrier xcd_barrier_post(unsigned* bar, volatile LAS unsigned* st) {
    XcdBarrier b; b.bar = bar; b.x = xb_xcc_id(); b.st = st;
    if (threadIdx.x == 0) (void)xb_add(&bar[XB_XCNT(b.x)], 1u);
    return b;
}
__device__ __forceinline__ void xcd_barrier_complete(unsigned* bar, unsigned x, unsigned& nloc, unsigned& nx) {
    const unsigned G = gridDim.x * gridDim.y * gridDim.z;
    unsigned sum, cnt, mine, sp = 0u;
    for (;;) {
        sum = 0u; cnt = 0u; mine = 0u;
#pragma unroll
        for (unsigned j = 0; j < 16; ++j) { const unsigned c = xb_ld(&bar[XB_XCNT(j)]); sum += c; cnt += (c > 0u) ? 1u : 0u; mine = (j == x) ? c : mine; }
        if (sum == G) break;
        __builtin_amdgcn_s_sleep(1);
        if ((++sp & 255u) == 0u) { if (xb_ld(&bar[XB_TMO])) break; if (sp > XB_SPIN_CAP) { atomicAdd(&bar[XB_TMO], 1u); break; } }
    }
    nloc = mine > 0u ? mine : 1u; nx = cnt > 0u ? cnt : 1u;
}
__device__ __forceinline__ void xcd_barrier(const XcdBarrier& b) {
    asm volatile("s_waitcnt vmcnt(0)" ::: "memory");
    __syncthreads();
    if (threadIdx.x == 0) {
        unsigned* bar = b.bar;
        __builtin_amdgcn_s_waitcnt(0);
        unsigned nloc = b.st[0], nx = b.st[1];
        if (nloc == 0u) { xcd_barrier_complete(bar, b.x, nloc, nx); b.st[0] = nloc; b.st[1] = nx; }
        const unsigned old = xb_add(&bar[XB_XSUB(b.x)], 1u);
        const unsigned gen = old / nloc;
        if (old + 1u == (gen + 1u) * nloc) {
            __builtin_amdgcn_fence(__ATOMIC_RELEASE, "agent");
            asm volatile("s_waitcnt vmcnt(0)" ::: "memory");
            const unsigned og = xb_add(&bar[XB_TOP], 1u);
            const unsigned tg = og / nx;
            if (og + 1u == (tg + 1u) * nx) xb_add(&bar[XB_TOPGEN], 1u);
            else XB_SPIN(xb_ld(&bar[XB_TOPGEN]) == tg, bar);
            __builtin_amdgcn_fence(__ATOMIC_ACQUIRE, "agent");
            xb_add(&bar[XB_XGEN(b.x)], 1u);
            asm volatile("s_waitcnt vmcnt(0)" ::: "memory");
        } else {
            XB_SPIN(xb_ld(&bar[XB_XGEN(b.x)]) == gen, bar);
            __builtin_amdgcn_fence(__ATOMIC_ACQUIRE, "agent");
            asm volatile("s_waitcnt vmcnt(0)" ::: "memory");
        }
    }
    __syncthreads();
}

__global__ void __launch_bounds__(NT, 2) k_mega(Params p) {
    extern __shared__ __attribute__((aligned(16))) unsigned char lds_raw[];
    LAS unsigned char* lds = (LAS unsigned char*)lds_raw;
    const int bid = blockIdx.x, nb = gridDim.x;
    volatile LAS unsigned* bst = (volatile LAS unsigned*)(lds + LDS_BYTES - 16);
    if (threadIdx.x < 4) bst[threadIdx.x] = 0u;
    __syncthreads();
    const XcdBarrier xb = xcd_barrier_post(p.bar, bst);
    phase_prep(p, lds, bid, nb);
    xcd_barrier(xb);
    { pg8::Gemm g{p.hnb, p.w_in_t, D, D, D, 0}; pg8::StaticOrder S; S.init(RT / 256, INW / 256, nb, bid); EpiProj E{p.xp, p.glu};
      pg8::gemm_phase<EpiProj, pg8::StaticOrder>(lds, g, S, E); }
    { const int nproj = (RT / 256) * (INW / 256); const int first = (nproj > nb && nproj < 2 * nb) ? nproj - nb : 0, nfree = nb - first;
      for (int uu = bid - first; uu >= 0 && uu < 64; uu += nfree) {
        __syncthreads();
        const bool pw = uu < 32;
        pg8::Gemm g{pw ? p.w_out_t + PWD : p.w_out_t, pw ? p.pw_b16 : p.pool_ws, D, pw ? CWD : 256, pw ? CWD : 256, pw ? 0 : 256};
        pg8::OneUnit S; S.u.pm = (uu & 31) >> 2; S.u.pn = uu & 3; EpiBf16Out E{p.w_eff_t, D, pw ? PWD : 0, nullptr};
        pg8::gemm_phase<EpiBf16Out, pg8::OneUnit>(lds, g, S, E);
      }
      { const int b0 = nfree >= 96 ? first + 64 : 0;
        for (int nbk = bid - b0; nbk >= 0 && nbk < D / 64; nbk += nb) {
          __syncthreads();
          const int lane = threadIdx.x & 63, wv = threadIdx.x >> 6, n = nbk * 64 + lane;
          float a[8] = {0.f, 0.f, 0.f, 0.f, 0.f, 0.f, 0.f, 0.f};
          for (int j = wv * 128; j < wv * 128 + 128; j += 8) {
#pragma unroll
            for (int q = 0; q < 8; ++q) a[q] += p.pw_b[j + q] * p.w_out[(size_t)(PWD + j + q) * D + n]; }
          LAS float* red = (LAS float*)lds;
          red[wv * 64 + lane] = ((a[0] + a[1]) + (a[2] + a[3])) + ((a[4] + a[5]) + (a[6] + a[7]));
          __syncthreads();
          if (wv == 0) { float t = 0.f;
#pragma unroll
            for (int q = 0; q < 8; ++q) t += red[q * 64 + lane];
            p.bias_eff[n] = t; }
        } }
    }
    xcd_barrier(xb);
    phase_mix(p, lds, bid, nb);
    xcd_barrier(xb);
    { pg8::Gemm g{p.mixb, p.w_eff_t, D, D, D, 0}; pg8::StaticOrder S; S.init(SEQ / 256, D / 256, nb, bid); EpiResid E{p.x, p.bias_eff, p.h2b, p.ssq};
      pg8::gemm_phase<EpiResid, pg8::StaticOrder>(lds, g, S, E); }
    xcd_barrier(xb);
    { pg8::Gemm g{p.h2b, p.wq_t, D, D, D, 0}; pg8::StaticOrder S; S.init(SEQ / 256, D / 256, nb, bid); EpiQTopk E{p.ssq, p.rstd, p.keysb, p.idx, p.gsu};
      pg8::gemm_phase<EpiQTopk, pg8::StaticOrder>(lds, g, S, E); }
    xcd_barrier(xb);
    phase_pd(p, bid, nb);
    xcd_barrier(xb);
    phase_pa(p, bid, nb);
    xcd_barrier(xb);
    phase_pu(p, bid, nb);
    xcd_barrier(xb);
    phase_pf(p, bid, nb);
}

extern "C" void kernel_launch(void* const* d_in, const int* in_sizes, int n_in, void* d_out, int out_size, void* d_ws, size_t ws_size, hipStream_t stream) {
    Params p{};
    p.x = (const float*)d_in[0]; p.meta = (const float*)d_in[1]; p.mix_g = (const float*)d_in[2]; p.w_in = (const float*)d_in[3];
    p.pool_w = (const float*)d_in[4]; p.pool_scale = (const float*)d_in[5]; p.dw_w = (const float*)d_in[6]; p.dw_b = (const float*)d_in[7];
    p.ln_g = (const float*)d_in[8]; p.ln_b = (const float*)d_in[9]; p.pw_w = (const float*)d_in[10]; p.pw_b = (const float*)d_in[11];
    p.w_out = (const float*)d_in[12]; p.ffn_g = (const float*)d_in[13]; p.wq = (const float*)d_in[14]; p.keys = (const float*)d_in[15];
    p.down = (const float*)d_in[16]; p.up = (const float*)d_in[17]; p.fin_g = (const float*)d_in[18];
    p.out = (float*)d_out;
    char* w = (char*)d_ws; size_t off = 0;
    auto take = [&](size_t bytes) { char* r = w + off; off += (bytes + 255) & ~(size_t)255; return r; };
    p.idx = (unsigned short*)take((size_t)SEQ * 128 * 2);
    p.gsu = (float*)take((size_t)SEQ * 128 * 4);
    p.part = (bf16_t*)take((size_t)SEQ * 16 * 128 * 2);
    p.act = (bf16_t*)take((size_t)SEQ * 128 * 2);
    p.ssq2 = (float*)take((size_t)SEQ * 16 * 4);
    p.h3b = (bf16_t*)take((size_t)SEQ * D * 2);
    p.hnb = (bf16_t*)take((size_t)RT * D * 2);
    p.w_in_t = (bf16_t*)take((size_t)INW * D * 2);
    p.xp = (bf16_t*)take((size_t)RT * PWD * 2);
    p.glu = (bf16_t*)take((size_t)RT * CWD * 2);
    p.mixb = (bf16_t*)take((size_t)SEQ * D * 2);
    p.h2b = (bf16_t*)take((size_t)SEQ * D * 2);
    p.pool_ws = (bf16_t*)take((size_t)4 * 256 * 256 * 2);
    p.pw_b16 = (bf16_t*)take((size_t)CWD * CWD * 2);
    p.w_eff_t = (bf16_t*)take((size_t)D * D * 2);
    p.bias_eff = (float*)take((size_t)D * 4);
    p.w_out_t = (bf16_t*)take((size_t)D * D * 2);
    p.ssq = (float*)take((size_t)SEQ * 32 * 4);
    p.bar = (unsigned*)take((size_t)XCD_BAR_WORDS * 4);
    p.rstd = (float*)take((size_t)SEQ * 4);
    p.wq_t = (bf16_t*)take((size_t)D * D * 2);
    p.keysb = (bf16_t*)take((size_t)8 * 2 * 128 * 128 * 2);
    p.qb = (bf16_t*)take((size_t)SEQ * D * 2);
    p.down8 = (unsigned char*)take((size_t)16384 * D);
    p.up8 = (unsigned char*)take((size_t)16384 * D);
    p.sdn = (float*)take((size_t)16384 * 4);
    p.sup = (float*)take((size_t)16384 * 4);
    static int grid_blocks = 0;
    if (!grid_blocks) {
        int dev = 0, cus = 0, per_cu = 0;
        (void)hipGetDevice(&dev);
        (void)hipDeviceGetAttribute(&cus, hipDeviceAttributeMultiprocessorCount, dev);
        (void)hipFuncSetAttribute((const void*)k_mega, hipFuncAttributeMaxDynamicSharedMemorySize, LDS_BYTES);
        (void)hipOccupancyMaxActiveBlocksPerMultiprocessor(&per_cu, k_mega, NT, LDS_BYTES);
        if (per_cu < 1) { fprintf(stderr, "occupancy query says %d workgroups per CU: nothing launched\n", per_cu); grid_blocks = -1; }
        else if (cus != (SEQ / 256) * (D / 256)) { fprintf(stderr, "this build needs a %d-CU device (got %d): nothing launched\n", (SEQ / 256) * (D / 256), cus); grid_blocks = -1; }
        else grid_blocks = cus;
    }
    if (grid_blocks < 0) return;
    (void)hipMemsetAsync(p.bar, 0, (size_t)XCD_BAR_WORDS * 4, stream);
    void* args[] = {&p};
    hipError_t e = hipLaunchCooperativeKernel((void*)k_mega, dim3(grid_blocks), dim3(NT), args, LDS_BYTES, stream);
    if (e != hipSuccess) fprintf(stderr, "cooperative launch failed: %s (grid %d)\n", hipGetErrorString(e), grid_blocks);
}
```

```cpp
#include <hip/hip_runtime.h>
#include <hip/hip_cooperative_groups.h>
#include <stdint.h>
#include <cstdio>
namespace cg = cooperative_groups;

#define NT 512
#define LAS __attribute__((address_space(3)))
typedef unsigned short bf16_t;
typedef short bf16x8 __attribute__((ext_vector_type(8)));
typedef float f32x4 __attribute__((ext_vector_type(4)));
typedef unsigned u32x4 __attribute__((ext_vector_type(4)));
typedef unsigned u32x2 __attribute__((ext_vector_type(2)));

constexpr int D = 2048, SEQ = 8192, NMETA = 16, T = SEQ + NMETA;
constexpr int PWD = 1024, CWD = 1024, INW = 3072;
constexpr int KS = 31;
constexpr int RPAD = 240, RT = 8448;
constexpr int LDS_BYTES = 151552;

struct Params {
    const float *x, *meta, *mix_g, *w_in, *pool_w, *pool_scale, *dw_w, *dw_b, *ln_g, *ln_b, *pw_w, *pw_b, *w_out, *ffn_g, *wq, *keys, *down, *up, *fin_g;
    float* out;
    unsigned short* idx;
    unsigned* bar;
    bf16_t *hnb, *w_in_t, *xp, *glu, *mixb, *h2b, *pool_ws, *pw_b16, *w_eff_t, *w_out_t, *wq_t, *keysb, *qb;
    unsigned char *down8, *up8;
    float *sdn, *sup;
    float *gsu;
    bf16_t* part;
    bf16_t* act;
    float* ssq2;
    bf16_t* h3b;
    float *ssq, *rstd, *bias_eff, *rstd1;
};

__device__ __forceinline__ unsigned cvt_pk_bf16(float lo, float hi) { unsigned r; asm volatile("v_cvt_pk_bf16_f32 %0, %1, %2" : "=v"(r) : "v"(lo), "v"(hi)); return r; }
__device__ __forceinline__ void store16_wt(void* ptr, u32x4 v) { asm volatile("global_store_dwordx4 %0, %1, off sc1\n\ts_nop 1" :: "v"(ptr), "v"(v) : "memory"); }
__device__ __forceinline__ float bf_lo(unsigned w) { return __uint_as_float(w << 16); }
__device__ __forceinline__ float bf_hi(unsigned w) { return __uint_as_float(w & 0xffff0000u); }
__device__ __forceinline__ float wave_sum(float v) {
#pragma unroll
    for (int o = 1; o < 64; o <<= 1) v += __shfl_xor(v, o);
    return v;
}

__device__ __forceinline__ const float* hrow(const Params& p, int t) { return t < NMETA ? p.meta + (size_t)t * D : p.x + (size_t)(t - NMETA) * D; }

__device__ __forceinline__ float block_sum(float v, float* red) {
#pragma unroll
    for (int o = 32; o; o >>= 1) v += __shfl_xor(v, o);
    __syncthreads();
    if ((threadIdx.x & 63) == 0) red[threadIdx.x >> 6] = v;
    __syncthreads();
    float s = 0.f;
#pragma unroll
    for (int i = 0; i < NT / 64; ++i) s += red[i];
    return s;
}

namespace pg8 {
constexpr int BM = 256, BK = 64, HALF = 128, HTB = HALF * BK * 2, STAGE_BYTES = 8 * HTB, NXCD = 8, WGM = 8;
__device__ __forceinline__ int lds_byte(int r, int c) { const int st = (r >> 4) * 2 + (c >> 5), rr = r & 15, cc = c & 31, ob = rr * 64 + cc * 2; return st * 1024 + (ob ^ (((ob >> 9) & 1) << 5)); }
__device__ __forceinline__ void stage_rc(int b, int& R, int& C) { const int st = b / 1024, sb = b % 1024, swz = sb ^ (((sb >> 9) & 1) << 5); R = (st >> 1) * 16 + swz / 64; C = (st & 1) * 32 + (swz % 64) / 2; }
__device__ __forceinline__ int perm32(int rho) { const int n = rho >> 4, i = rho & 15; return 8 * (i >> 2) + 4 * n + (i & 3); }
struct Unit { int pm, pn; };
struct Gemm { const bf16_t* A; const bf16_t* Bt; int lda, ldb, K; int a_col_per_pn; };
struct StaticOrder {
    int nM, nN, nwg, G, c;
    __device__ void init(int nM_, int nN_, int G_, int c_) { nM = nM_; nN = nN_; nwg = nM * nN; G = G_; c = c_; }
    __device__ bool next(int i, Unit& u) const {
        const long L = (long)i * G + c; if (L >= nwg) return false;
        int wgid = (int)L; { const int q = nwg / NXCD, r = nwg % NXCD, xcd = wgid % NXCD, off = wgid / NXCD; wgid = (xcd < r ? xcd * (q + 1) : r * (q + 1) + (xcd - r) * q) + off; }
        const int nig = WGM * nN, gid = wgid / nig, fm = gid * WGM, gsz = (nM - fm) < WGM ? (nM - fm) : WGM;
        u.pm = fm + ((wgid % nig) % gsz); u.pn = (wgid % nig) / gsz; return true;
    }
};
struct OneUnit { Unit u; __device__ bool next(int i, Unit& o) const { if (i) return false; o = u; return true; } };
template <class Epi, class Sched>
__device__ __forceinline__ void gemm_phase(LAS unsigned char* lds, const Gemm g, const Sched& S, const Epi& E) {
    const int tid = threadIdx.x, wid = __builtin_amdgcn_readfirstlane(tid >> 6), lane = tid & 63, wr = wid >> 2, wc = wid & 3, fr = lane & 15, fq = lane >> 4;
    const int K = g.K, nt = K / BK;
    unsigned voffA[2], voffB[2];
#pragma unroll
    for (int i = 0; i < 2; ++i) { int R, C; stage_rc(tid * 16 + i * 8192, R, C);
        const int Rb = Epi::PERM ? ((R & ~31) + perm32(R & 31)) : R;
        voffA[i] = (unsigned)(R * g.lda + C) * 2u; voffB[i] = (unsigned)(Rb * g.ldb + C) * 2u; }
    const size_t kstep = (size_t)(BK * 2);
    const size_t hstepA = (size_t)HALF * g.lda * 2, hstepB = (size_t)HALF * g.ldb * 2;
    const size_t tstepA = 2 * hstepA, tstepB = 2 * hstepB;
    const unsigned ldsw = (unsigned)wid * 1024u;
    const int aoff = lds_byte(wr * 64 + fr, fq * 8), boff = lds_byte(wc * 32 + fr, fq * 8);
#define PG8_SA(b, h) (((b) * 2 + (h)) * HTB)
#define PG8_SB(b, h) ((4 + (b) * 2 + (h)) * HTB)
#define PG8_STAGE(bufoff, gbase, voff) do { _Pragma("unroll") for (int _i = 0; _i < 2; ++_i) \
        __builtin_amdgcn_global_load_lds((const unsigned*)((const char*)(gbase) + (voff)[_i]), (LAS unsigned*)(lds + (bufoff) + ldsw + _i * 8192), 16, 0, 0); } while (0)
#define PG8_LDA(dst, b, h) do { _Pragma("unroll") for (int m = 0; m < 4; ++m) _Pragma("unroll") for (int k = 0; k < 2; ++k) dst[m][k] = *(const LAS bf16x8*)(lds + PG8_SA(b, h) + aoff + m * 2048 + k * 1024); } while (0)
#define PG8_LDB(dst, b, h) do { _Pragma("unroll") for (int n = 0; n < 2; ++n) _Pragma("unroll") for (int k = 0; k < 2; ++k) dst[n][k] = *(const LAS bf16x8*)(lds + PG8_SB(b, h) + boff + n * 2048 + k * 1024); } while (0)
#define PG8_MMA(ai, bj, At, Bt) do { __builtin_amdgcn_s_setprio(1); _Pragma("unroll") for (int m = 0; m < 4; ++m) _Pragma("unroll") for (int n = 0; n < 2; ++n) _Pragma("unroll") for (int k = 0; k < 2; ++k) \
        acc[ai][bj][m][n] = __builtin_amdgcn_mfma_f32_16x16x32_bf16(Bt[n][k], At[m][k], acc[ai][bj][m][n], 0, 0, 0); __builtin_amdgcn_s_setprio(0); } while (0)
#define PG8_WAIT_V(n) asm volatile("s_waitcnt vmcnt(" #n ")" ::: "memory")
#define PG8_WAIT_L(n) asm volatile("s_waitcnt lgkmcnt(" #n ")" ::: "memory")
#define PG8_BAR __builtin_amdgcn_s_barrier()
#define PG8_SCHED __builtin_amdgcn_sched_barrier(0)
    Unit cur, nxt; int ui = 0;
    if (!S.next(0, cur)) return;
    f32x4 acc[2][2][4][2];
#pragma unroll
    for (int a = 0; a < 2; ++a)
#pragma unroll
        for (int b = 0; b < 2; ++b)
#pragma unroll
            for (int m = 0; m < 4; ++m)
#pragma unroll
                for (int n = 0; n < 2; ++n) acc[a][b][m][n] = (f32x4){0.f, 0.f, 0.f, 0.f};
    bf16x8 At[4][2], B0[2][2], B1[2][2];
    const char* cA = (const char*)g.A + (size_t)cur.pm * tstepA + (size_t)cur.pn * g.a_col_per_pn * 2; const char* cB = (const char*)g.Bt + (size_t)cur.pn * tstepB;
    PG8_STAGE(PG8_SB(0, 0), cB, voffB); PG8_STAGE(PG8_SA(0, 0), cA, voffA); PG8_STAGE(PG8_SB(0, 1), cB + hstepB, voffB); PG8_STAGE(PG8_SA(0, 1), cA + hstepA, voffA);
    if (wr == 1) PG8_BAR;
    PG8_WAIT_V(4); PG8_BAR;
    PG8_STAGE(PG8_SB(1, 0), cB + kstep, voffB); PG8_STAGE(PG8_SA(1, 0), cA + kstep, voffA); PG8_STAGE(PG8_SB(1, 1), cB + hstepB + kstep, voffB);
    PG8_WAIT_V(6); PG8_BAR;
    for (;;) {
        const bool has_next = S.next(ui + 1, nxt);
        const char* nA = has_next ? (const char*)g.A + (size_t)nxt.pm * tstepA + (size_t)nxt.pn * g.a_col_per_pn * 2 : cA; const char* nB = has_next ? (const char*)g.Bt + (size_t)nxt.pn * tstepB : cB;
        for (int t = 0; t < nt; t += 2) {
            const bool last = (t == nt - 2);
            const char* a1 = cA + (size_t)(t + 1) * kstep;
            const char* a2 = last ? nA : cA + (size_t)(t + 2) * kstep; const char* b2 = last ? nB : cB + (size_t)(t + 2) * kstep;
            const char* a3 = a2 + kstep; const char* b3 = b2 + kstep;
            PG8_LDB(B0, 0, 0); PG8_SCHED; PG8_LDA(At, 0, 0); PG8_STAGE(PG8_SA(1, 1), a1 + hstepA, voffA);
            PG8_WAIT_L(8); PG8_BAR; PG8_WAIT_L(0); PG8_MMA(0, 0, At, B0); PG8_BAR; PG8_SCHED;
            PG8_LDB(B1, 0, 1); PG8_STAGE(PG8_SB(0, 0), b2, voffB);
            PG8_BAR; PG8_WAIT_L(0); PG8_MMA(0, 1, At, B1); PG8_BAR;
            PG8_LDA(At, 0, 1); PG8_STAGE(PG8_SA(0, 0), a2, voffA);
            PG8_BAR; PG8_WAIT_L(0); PG8_MMA(1, 0, At, B0); PG8_BAR; PG8_SCHED;
            PG8_STAGE(PG8_SB(0, 1), b2 + hstepB, voffB);
            PG8_WAIT_V(6); PG8_BAR; PG8_MMA(1, 1, At, B1); PG8_BAR;
            PG8_LDB(B0, 1, 0); PG8_SCHED; PG8_LDA(At, 1, 0); PG8_STAGE(PG8_SA(0, 1), a2 + hstepA, voffA);
            PG8_WAIT_L(8); PG8_BAR; PG8_WAIT_L(0); PG8_MMA(0, 0, At, B0); PG8_BAR; PG8_SCHED;
            PG8_LDB(B1, 1, 1); PG8_STAGE(PG8_SB(1, 0), b3, voffB);
            PG8_BAR; PG8_WAIT_L(0); PG8_MMA(0, 1, At, B1); PG8_BAR;
            PG8_LDA(At, 1, 1); PG8_STAGE(PG8_SA(1, 0), a3, voffA);
            PG8_BAR; PG8_WAIT_L(0); PG8_MMA(1, 0, At, B0); PG8_BAR; PG8_SCHED;
            PG8_STAGE(PG8_SB(1, 1), b3 + hstepB, voffB);
            PG8_WAIT_V(6); PG8_BAR; PG8_MMA(1, 1, At, B1); PG8_BAR;
        }
        if constexpr (!Epi::AFTER_DRAIN) E(acc, cur, wr, wc, fr, fq);
        if (!has_next) break;
#pragma unroll
        for (int a = 0; a < 2; ++a)
#pragma unroll
            for (int b = 0; b < 2; ++b)
#pragma unroll
                for (int m = 0; m < 4; ++m)
#pragma unroll
                    for (int n = 0; n < 2; ++n) acc[a][b][m][n] = (f32x4){0.f, 0.f, 0.f, 0.f};
        cur = nxt; cA = nA; cB = nB; ++ui;
    }
    PG8_WAIT_V(0);
    if (wr == 0) PG8_BAR;
    PG8_BAR;
    if constexpr (Epi::AFTER_DRAIN) E.fused(acc, cur, wr, wc, fr, fq, lds, wid, lane);
#undef PG8_SA
#undef PG8_SB
#undef PG8_STAGE
#undef PG8_LDA
#undef PG8_LDB
#undef PG8_MMA
#undef PG8_WAIT_V
#undef PG8_WAIT_L
#undef PG8_BAR
#undef PG8_SCHED
}
}

struct EpiProjF32 {
    static constexpr bool PERM = false;
    static constexpr bool AFTER_DRAIN = false;
    float* proj;
    __device__ __forceinline__ void operator()(const f32x4 (&acc)[2][2][4][2], const pg8::Unit& u, int wr, int wc, int fr, int fq) const {
#pragma unroll
        for (int ai = 0; ai < 2; ++ai)
#pragma unroll
            for (int m = 0; m < 4; ++m) {
                const int t = u.pm * 256 + ai * 128 + wr * 64 + m * 16 + fr - RPAD;
                if (t >= 0) {
#pragma unroll
                    for (int bj = 0; bj < 2; ++bj)
#pragma unroll
                        for (int n = 0; n < 2; ++n) {
                            const int off = wc * 32 + n * 16 + fq * 4;
                            const int col = u.pn < 4 ? u.pn * 256 + bj * 128 + off : (bj ? 2048 : 1024) + (u.pn - 4) * 128 + off;
                            *(f32x4*)(proj + (size_t)t * INW + col) = acc[ai][bj][m][n];
                        }
                }
            }
    }
};


__device__ __forceinline__ float sigmoidf_fast(float x) { return __builtin_amdgcn_rcpf(1.0f + __expf(-x)); }

struct EpiProj {
    static constexpr bool PERM = true;
    static constexpr bool AFTER_DRAIN = false;
    bf16_t* xp; bf16_t* glu; const float* rstd1;
    __device__ __forceinline__ void operator()(const f32x4 (&acc)[2][2][4][2], const pg8::Unit& u, int wr, int wc, int fr, int fq) const {
#pragma unroll
        for (int ai = 0; ai < 2; ++ai)
#pragma unroll
            for (int m = 0; m < 4; ++m) {
                const size_t row = (size_t)(u.pm * 256 + ai * 128 + wr * 64 + m * 16 + fr);
                const float rs = rstd1[row];
                if (u.pn < 4) {
#pragma unroll
                    for (int bj = 0; bj < 2; ++bj) { const f32x4 v0 = acc[ai][bj][m][0] * rs, v1 = acc[ai][bj][m][1] * rs;
                        store16_wt(xp + row * PWD + u.pn * 256 + bj * 128 + wc * 32 + fq * 8, (u32x4){cvt_pk_bf16(v0[0], v0[1]), cvt_pk_bf16(v0[2], v0[3]), cvt_pk_bf16(v1[0], v1[1]), cvt_pk_bf16(v1[2], v1[3])}); }
                } else {
                    const f32x4 a0 = acc[ai][0][m][0] * rs, a1 = acc[ai][0][m][1] * rs, g0 = acc[ai][1][m][0] * rs, g1 = acc[ai][1][m][1] * rs;
                    store16_wt(glu + row * CWD + (u.pn - 4) * 128 + wc * 32 + fq * 8, (u32x4){
                        cvt_pk_bf16(a0[0] * sigmoidf_fast(g0[0]), a0[1] * sigmoidf_fast(g0[1])), cvt_pk_bf16(a0[2] * sigmoidf_fast(g0[2]), a0[3] * sigmoidf_fast(g0[3])),
                        cvt_pk_bf16(a1[0] * sigmoidf_fast(g1[0]), a1[1] * sigmoidf_fast(g1[1])), cvt_pk_bf16(a1[2] * sigmoidf_fast(g1[2]), a1[3] * sigmoidf_fast(g1[3]))});
                }
            }
    }
};
struct EpiBf16Out {
    static constexpr bool PERM = true;
    static constexpr bool AFTER_DRAIN = false;
    bf16_t* O; int ldc; int col0; const float* bias;
    __device__ __forceinline__ void operator()(const f32x4 (&acc)[2][2][4][2], const pg8::Unit& u, int wr, int wc, int fr, int fq) const {
#pragma unroll
        for (int ai = 0; ai < 2; ++ai)
#pragma unroll
            for (int m = 0; m < 4; ++m) {
                const size_t row = (size_t)(u.pm * 256 + ai * 128 + wr * 64 + m * 16 + fr);
#pragma unroll
                for (int bj = 0; bj < 2; ++bj) { const int c = u.pn * 256 + bj * 128 + wc * 32 + fq * 8; f32x4 v0 = acc[ai][bj][m][0], v1 = acc[ai][bj][m][1];
                    if (bias) { v0 += *(const f32x4*)(bias + c); v1 += *(const f32x4*)(bias + c + 4); }
                    *(u32x4*)(O + row * ldc + col0 + c) = (u32x4){cvt_pk_bf16(v0[0], v0[1]), cvt_pk_bf16(v0[2], v0[3]), cvt_pk_bf16(v1[0], v1[1]), cvt_pk_bf16(v1[2], v1[3])}; }
            }
    }
};
struct EpiResid {
    static constexpr bool PERM = true;
    static constexpr bool AFTER_DRAIN = false;
    const bf16_t* xb; const float* bias; bf16_t* h2b; float* ssq;
    __device__ __forceinline__ void operator()(const f32x4 (&acc)[2][2][4][2], const pg8::Unit& u, int wr, int wc, int fr, int fq) const {
#pragma unroll
        for (int ai = 0; ai < 2; ++ai)
#pragma unroll
            for (int m = 0; m < 4; ++m) {
                const size_t row = (size_t)(u.pm * 256 + ai * 128 + wr * 64 + m * 16 + fr);
                float ss = 0.f;
#pragma unroll
                for (int bj = 0; bj < 2; ++bj) { const int c = u.pn * 256 + bj * 128 + wc * 32 + fq * 8;
                    const u32x4 xw = *(const u32x4*)(xb + (row + 256) * D + c);
                    const f32x4 v0 = acc[ai][bj][m][0] + (f32x4){bf_lo(xw.x), bf_hi(xw.x), bf_lo(xw.y), bf_hi(xw.y)} + *(const f32x4*)(bias + c);
                    const f32x4 v1 = acc[ai][bj][m][1] + (f32x4){bf_lo(xw.z), bf_hi(xw.z), bf_lo(xw.w), bf_hi(xw.w)} + *(const f32x4*)(bias + c + 4);
                    store16_wt(h2b + row * D + c, (u32x4){cvt_pk_bf16(v0[0], v0[1]), cvt_pk_bf16(v0[2], v0[3]), cvt_pk_bf16(v1[0], v1[1]), cvt_pk_bf16(v1[2], v1[3])});
                    ss += ((v0[0] * v0[0] + v0[1] * v0[1]) + (v0[2] * v0[2] + v0[3] * v0[3])) + ((v1[0] * v1[0] + v1[1] * v1[1]) + (v1[2] * v1[2] + v1[3] * v1[3])); }
                ss += __shfl_xor(ss, 16); ss += __shfl_xor(ss, 32);
                if (fq == 0) ssq[row * 32 + u.pn * 4 + wc] = ss;
            }
    }
};

__device__ __forceinline__ float fsel(int mask, float a, float b) { return __int_as_float((__float_as_int(a) & ~mask) | (__float_as_int(b) & mask)); }

__device__ __forceinline__ u32x4 bload16(__amdgpu_buffer_rsrc_t r, int voff, int soff) { return __builtin_bit_cast(u32x4, __builtin_amdgcn_raw_buffer_load_b128(r, voff, soff, 0)); }
__device__ __forceinline__ unsigned bload4(__amdgpu_buffer_rsrc_t r, int voff, int soff) { return (unsigned)__builtin_amdgcn_raw_buffer_load_b32(r, voff, soff, 0); }
__device__ __forceinline__ void bstore4(__amdgpu_buffer_rsrc_t r, unsigned v, int voff, int soff) { __builtin_amdgcn_raw_buffer_store_b32(v, r, voff, soff, 0); }
__device__ __forceinline__ u32x2 bload8(__amdgpu_buffer_rsrc_t r, int voff, int soff) { return __builtin_bit_cast(u32x2, __builtin_amdgcn_raw_buffer_load_b64(r, voff, soff, 0)); }
template <int W> __device__ __forceinline__ void pool_tile(__amdgpu_buffer_rsrc_t rxp, __amdgpu_buffer_rsrc_t rpo, int r0, int tile, int tid) {
    unsigned v[32 + W - 1];
#pragma unroll
    for (int i = 0; i < 32 + W - 1; ++i) v[i] = bload4(rxp, tid * 4, (r0 - (W - 1) + i) * 2048);
    float s0 = 0.f, s1 = 0.f;
#pragma unroll
    for (int i = 0; i < W - 1; ++i) { s0 += bf_lo(v[i]); s1 += bf_hi(v[i]); }
    constexpr float inv = 1.0f / (float)W;
#pragma unroll
    for (int i = 0; i < 32; ++i) {
        const float a0 = bf_lo(v[W - 1 + i]), a1 = bf_hi(v[W - 1 + i]);
        s0 += a0; s1 += a1;
        bstore4(rpo, cvt_pk_bf16(s0 * inv - a0, s1 * inv - a1), tid * 4, (tile * 32 + i) * 4096);
        s0 -= bf_lo(v[i]); s1 -= bf_hi(v[i]);
    }
}
__device__ __forceinline__ void phase_mix(const Params& p, LAS unsigned char* lds, int bid, int nb) {
    const int tid = threadIdx.x, lane = tid & 63, wave = tid >> 6;
    LAS unsigned* gl = (LAS unsigned*)lds;
    LAS float* red = (LAS float*)(lds + 62 * 2048);
    const __amdgpu_buffer_rsrc_t rxp = __builtin_amdgcn_make_buffer_rsrc((void*)p.xp, 0, RT * PWD * 2, 0x00020000);
    const __amdgpu_buffer_rsrc_t rgl = __builtin_amdgcn_make_buffer_rsrc((void*)p.glu, 0, RT * CWD * 2, 0x00020000);
    const __amdgpu_buffer_rsrc_t rpo = __builtin_amdgcn_make_buffer_rsrc((void*)p.mixb, 0, SEQ * D * 2, 0x00020000);
    const __amdgpu_buffer_rsrc_t rww = __builtin_amdgcn_make_buffer_rsrc((void*)p.dw_w, 0, KS * CWD * 4, 0x00020000);
    const __amdgpu_buffer_rsrc_t rwb = __builtin_amdgcn_make_buffer_rsrc((void*)p.dw_b, 0, CWD * 4, 0x00020000);
    const __amdgpu_buffer_rsrc_t rlg = __builtin_amdgcn_make_buffer_rsrc((void*)p.ln_g, 0, CWD * 4, 0x00020000);
    const __amdgpu_buffer_rsrc_t rlb = __builtin_amdgcn_make_buffer_rsrc((void*)p.ln_b, 0, CWD * 4, 0x00020000);
    for (int tile = bid; tile < SEQ / 32; tile += nb) {
        const int r0 = 256 + tile * 32;
        __syncthreads();
#pragma unroll
        for (int j = 0; j < 16; ++j) { const int ch = j * NT + tid; if (ch < 62 * 128)
            *(LAS u32x4*)(lds + ch * 16) = bload16(rgl, tid * 16, (r0 - 30) * 2048 + j * 8192); }
        { const int g = __builtin_amdgcn_readfirstlane(tid >> 7);
          if (g == 0) pool_tile<2>(rxp, rpo, r0, tile, tid); else if (g == 1) pool_tile<4>(rxp, rpo, r0, tile, tid); else if (g == 2) pool_tile<8>(rxp, rpo, r0, tile, tid); else pool_tile<16>(rxp, rpo, r0, tile, tid); }
        __syncthreads();
#pragma unroll 1
        for (int hf = 0; hf < 2; ++hf) {
            float c0[16], c1[16];
            {
                float w0[KS], w1[KS];
#pragma unroll
                for (int k = 0; k < KS; ++k) { const u32x2 wv = bload8(rww, tid * 8, k * 4096); w0[k] = __uint_as_float(wv.x); w1[k] = __uint_as_float(wv.y); }
                const u32x2 bvv = bload8(rwb, tid * 8, 0); const float b0 = __uint_as_float(bvv.x), b1 = __uint_as_float(bvv.y);
#pragma unroll
                for (int i = 0; i < 16; ++i) { c0[i] = b0; c1[i] = b1; }
                const LAS unsigned* glh = gl + hf * 16 * 512 + tid;
#pragma unroll
                for (int rr = 0; rr < 46; ++rr) {
                    if ((rr & 7) == 0) asm volatile("" ::: "memory");
                    const unsigned vv = glh[rr * 512]; const float x0 = bf_lo(vv), x1 = bf_hi(vv);
#pragma unroll
                    for (int i = 0; i < 16; ++i) { const int k = rr - i; if (k >= 0 && k < KS) { c0[i] += x0 * w0[k]; c1[i] += x1 * w1[k]; } }
                }
            }
            asm volatile("" ::: "memory");
#pragma unroll
            for (int which = 0; which < 2; ++which) {
                float st[16];
#pragma unroll
                for (int i = 0; i < 16; ++i) st[i] = which == 0 ? c0[i] + c1[i] : c0[i] * c0[i] + c1[i] * c1[i];
#pragma unroll
                for (int lvl = 0; lvl < 4; ++lvl) {
                    const int o = 32 >> lvl, n = 8 >> lvl; const int mk = -((lane >> (5 - lvl)) & 1);
#pragma unroll
                    for (int j = 0; j < 8; ++j) if (j < n) st[j] = fsel(mk, st[j], st[j + n]) + __shfl_xor(fsel(mk, st[j + n], st[j]), o);
                }
                float tot = st[0] + __shfl_xor(st[0], 2); tot += __shfl_xor(tot, 1);
                if ((lane & 3) == 0) red[wave * 32 + which * 16 + (lane >> 2)] = tot;
            }
            __syncthreads();
            if (tid < 32) { float t = 0.f;
#pragma unroll
                for (int q = 0; q < 8; ++q) t += red[q * 32 + tid];
                red[256 + tid] = t; }
            __syncthreads();
            const u32x2 lgv = bload8(rlg, tid * 8, 0), lbv = bload8(rlb, tid * 8, 0); const float lg0 = __uint_as_float(lgv.x), lg1 = __uint_as_float(lgv.y), lb0 = __uint_as_float(lbv.x), lb1 = __uint_as_float(lbv.y);
#pragma unroll
            for (int i = 0; i < 16; ++i) {
                const float s1 = red[256 + i], s2 = red[256 + 16 + i];
                const float mu = s1 * (1.0f / CWD), var = fmaxf(s2 * (1.0f / CWD) - mu * mu, 0.f), rs = rsqrtf(var + 1e-5f);
                const float y0 = (c0[i] - mu) * rs * lg0 + lb0, y1 = (c1[i] - mu) * rs * lg1 + lb1;
                bstore4(rpo, cvt_pk_bf16(y0 * sigmoidf_fast(y0), y1 * sigmoidf_fast(y1)), tid * 4, (tile * 32 + hf * 16 + i) * 4096 + 2048);
            }
            __syncthreads();
        }
    }
}

typedef float f32x16 __attribute__((ext_vector_type(16)));
__device__ __forceinline__ int okey(float s) { const int u = __float_as_int(s); return u ^ ((u >> 31) & 0x7fffffff); }
__device__ __forceinline__ float okey_inv(int k) { return __int_as_float(k ^ ((k >> 31) & 0x7fffffff)); }
__device__ __forceinline__ void sort16_desc(int (&v)[16]) {
#pragma unroll
    for (int k = 2; k <= 16; k <<= 1) {
#pragma unroll
        for (int j = k >> 1; j > 0; j >>= 1) {
#pragma unroll
            for (int i = 0; i < 16; ++i) {
                const int l = i ^ j;
                if (l > i) { const bool desc = (i & k) == 0; const int hi = max(v[i], v[l]), lo = min(v[i], v[l]); v[i] = desc ? hi : lo; v[l] = desc ? lo : hi; }
            }
        }
    }
}
__device__ __forceinline__ void merge16_desc(int (&a)[16], const int (&b)[16]) {
#pragma unroll
    for (int i = 0; i < 16; ++i) a[i] = max(a[i], b[15 - i]);
#pragma unroll
    for (int j = 8; j > 0; j >>= 1) {
#pragma unroll
        for (int i = 0; i < 16; ++i) { const int l = i ^ j; if (l > i) { const int hi = max(a[i], a[l]), lo = min(a[i], a[l]); a[i] = hi; a[l] = lo; } }
    }
}
__device__ __forceinline__ void pair_merge(int (&a)[16]) {
    int b[16];
#pragma unroll
    for (int i = 0; i < 16; ++i) b[i] = __shfl_xor(a[i], 32);
    merge16_desc(a, b);
}
constexpr int CELL_I[64] = {0,0,0,0,0,0,0,0,0,0,0,0,0,0,0,0,1,1,1,1,1,1,1,1,2,2,2,2,2,3,3,3,3,4,4,4,5,5,6,6,7,7,8,9,10,11,12,13,14,15,0,0,0,0,0,0,0,0,0,0,0,0,0,0};
constexpr int CELL_J[64] = {0,1,2,3,4,5,6,7,8,9,10,11,12,13,14,15,0,1,2,3,4,5,6,7,0,1,2,3,4,0,1,2,3,0,1,2,0,1,0,1,0,1,0,0,0,0,0,0,0,0,0,0,0,0,0,0,0,0,0,0,0,0,0,0};
constexpr int NCELL = 50;

struct EpiQTopk {
    static constexpr bool PERM = false;
    static constexpr bool AFTER_DRAIN = true;
    const float* ssq; float* rstd; const bf16_t* keysb; unsigned short* idx; float* gsu;
    __device__ __forceinline__ void fused(const f32x4 (&acc)[2][2][4][2], const pg8::Unit& u, int wr, int wc, int fr, int fq, LAS unsigned char* lds, int wid, int lane) const {
        const int hh = lane >> 5, l31 = lane & 31, h = u.pn;
        LAS float* svt = (LAS float*)(lds + 65536 + (wid * 64 + lane) * 164);
        LAS unsigned char* sit = (LAS unsigned char*)(svt + 32);
        float rs[2][4];
#pragma unroll
        for (int ai = 0; ai < 2; ++ai)
#pragma unroll
            for (int m = 0; m < 4; ++m) {
                const size_t row = (size_t)(u.pm * 256 + ai * 128 + wr * 64 + m * 16 + fr);
                const f32x4* sp = (const f32x4*)(ssq + row * 32); f32x4 t = sp[0];
#pragma unroll
                for (int i = 1; i < 8; ++i) t += sp[i];
                rs[ai][m] = rsqrtf(((t[0] + t[1]) + (t[2] + t[3])) * (1.0f / D) + 1e-6f);
                if (u.pn == 0 && wc == 0 && fq == 0) rstd[row] = rs[ai][m];
            }
        const int trow = wid * 32 + l31;
#pragma unroll
        for (int ph = 0; ph < 2; ++ph) {
#pragma unroll
            for (int ai = 0; ai < 2; ++ai)
#pragma unroll
                for (int m = 0; m < 4; ++m) { const int row = ai * 128 + wr * 64 + m * 16 + fr;
#pragma unroll
                    for (int n = 0; n < 2; ++n) { const f32x4 v = acc[ai][ph][m][n] * rs[ai][m]; const int chunk = 4 * wc + 2 * n + (fq >> 1);
                        u32x2 w; w.x = cvt_pk_bf16(v[0], v[1]); w.y = cvt_pk_bf16(v[2], v[3]);
                        *(LAS u32x2*)(lds + row * 256 + ((chunk ^ (row & 15)) << 4) + (fq & 1) * 8) = w; } }
            __syncthreads();
            const bf16_t* krow = keysb + ((size_t)(h * 2 + ph) * 128 + l31) * 128 + 8 * hh;
            bf16x8 bq[8];
#pragma unroll
            for (int ks = 0; ks < 8; ++ks) bq[ks] = *(const LAS bf16x8*)(lds + trow * 256 + (((ks * 2 + hh) ^ (trow & 15)) << 4));
            int top[16];
#pragma unroll
            for (int i = 0; i < 16; ++i) top[i] = (int)0x80000000;
            bf16x8 ak[8];
#pragma unroll
            for (int ks = 0; ks < 8; ++ks) ak[ks] = *(const bf16x8*)(krow + ks * 16);
#pragma unroll 1
            for (int kt = 0; kt < 4; ++kt) {
                f32x16 c = {0.f, 0.f, 0.f, 0.f, 0.f, 0.f, 0.f, 0.f, 0.f, 0.f, 0.f, 0.f, 0.f, 0.f, 0.f, 0.f};
#pragma unroll
                for (int ks = 0; ks < 8; ++ks) c = __builtin_amdgcn_mfma_f32_32x32x16_bf16(ak[ks], bq[ks], c, 0, 0, 0);
                { const int kn = kt < 3 ? kt + 1 : 3;
#pragma unroll
                  for (int ks = 0; ks < 8; ++ks) ak[ks] = *(const bf16x8*)(krow + (size_t)kn * 32 * 128 + ks * 16); }
                int v[16];
                const int lowb = (127 - kt * 32) ^ (hh << 2);
#pragma unroll
                for (int r = 0; r < 16; ++r) v[r] = (okey(c[r]) & ~127) | (lowb - ((r & 3) + 8 * (r >> 2)));
                sort16_desc(v);
                merge16_desc(top, v);
            }
            pair_merge(top);
#pragma unroll
            for (int i = 0; i < 16; ++i) { svt[ph * 16 + i] = okey_inv(top[i] & ~127); sit[ph * 16 + i] = (unsigned char)(127 - (top[i] & 127)); }
            __syncthreads();
        }
        float sv[2][16];
#pragma unroll
        for (int i = 0; i < 16; ++i) { sv[0][i] = svt[i]; sv[1][i] = svt[16 + i]; }
        int w0[16], w1[16];
#pragma unroll
        for (int s = 0; s < 32; ++s) {
            const int e0 = 2 * s, e1 = 2 * s + 1;
            int key;
            if (e0 >= NCELL) key = (int)0x80000000;
            else {
                const float v0 = sv[0][CELL_I[e0]] + sv[1][CELL_J[e0]];
                const int k0 = (okey(v0) & ~255) | (255 - (CELL_I[e0] * 16 + CELL_J[e0]));
                if (e1 >= NCELL) key = hh ? (int)0x80000000 : k0;
                else { const float v1 = sv[0][CELL_I[e1]] + sv[1][CELL_J[e1]];
                    const int k1 = (okey(v1) & ~255) | (255 - (CELL_I[e1] * 16 + CELL_J[e1]));
                    key = hh ? k1 : k0; }
            }
            if (s < 16) w0[s] = key; else w1[s - 16] = key;
        }
        sort16_desc(w0); sort16_desc(w1); merge16_desc(w0, w1); pair_merge(w0);
        const float mx = okey_inv(w0[0] & ~255);
        float sum = 0.f;
#pragma unroll
        for (int k = 0; k < 16; ++k) sum += __expf(okey_inv(w0[k] & ~255) - mx);
        const float inv = 1.0f / sum;
        int eo[8]; float go[8]; const int hmask = -hh;
#pragma unroll
        for (int k = 0; k < 8; ++k) { const int kk = (w0[k] & ~hmask) | (w0[8 + k] & hmask); const int cc = 255 - (kk & 255);
            eo[k] = (int)sit[cc >> 4] * 128 + (int)sit[16 + (cc & 15)]; go[k] = __expf(okey_inv(kk & ~255) - mx) * inv; }
        const size_t ob = (size_t)(u.pm * 256 + trow) * 128 + h * 16 + hh * 8;
        *(u32x4*)(idx + ob) = (u32x4){(unsigned)eo[0] | ((unsigned)eo[1] << 16), (unsigned)eo[2] | ((unsigned)eo[3] << 16), (unsigned)eo[4] | ((unsigned)eo[5] << 16), (unsigned)eo[6] | ((unsigned)eo[7] << 16)};
        *(f32x4*)(gsu + ob) = (f32x4){go[0], go[1], go[2], go[3]};
        *(f32x4*)(gsu + ob + 4) = (f32x4){go[4], go[5], go[6], go[7]};
    }
    __device__ __forceinline__ void operator()(const f32x4 (&)[2][2][4][2], const pg8::Unit&, int, int, int, int) const {}
};

__device__ __forceinline__ void fp8_row2(const float* s0, unsigned char* d0, float* i0, const float* s1, unsigned char* d1, float* i1, int lane) {
    f32x4 v[2][2][4]; float am[2] = {0.f, 0.f};
#pragma unroll
    for (int r = 0; r < 2; ++r)
#pragma unroll
        for (int k = 0; k < 2; ++k)
#pragma unroll
            for (int i = 0; i < 4; ++i) v[r][k][i] = __builtin_nontemporal_load((const f32x4*)((r ? s1 : s0) + 1024 * k + 16 * lane + 4 * i));
#pragma unroll
    for (int r = 0; r < 2; ++r) {
#pragma unroll
        for (int k = 0; k < 2; ++k)
#pragma unroll
            for (int i = 0; i < 4; ++i) am[r] = fmaxf(am[r], fmaxf(fmaxf(fabsf(v[r][k][i].x), fabsf(v[r][k][i].y)), fmaxf(fabsf(v[r][k][i].z), fabsf(v[r][k][i].w))));
#pragma unroll
        for (int o = 1; o < 64; o <<= 1) am[r] = fmaxf(am[r], __shfl_xor(am[r], o));
        int be = (__float_as_int(am[r]) >> 23) & 255; be = be < 8 ? 8 : (be > 248 ? 248 : be);
        const float sc = __int_as_float((260 - be) << 23), isc = __int_as_float((be - 6) << 23);
#pragma unroll
        for (int k = 0; k < 2; ++k) { u32x4 w; unsigned ww[4];
#pragma unroll
            for (int i = 0; i < 4; ++i) { int t = 0; t = __builtin_amdgcn_cvt_pk_fp8_f32(v[r][k][i].x * sc, v[r][k][i].y * sc, t, false); t = __builtin_amdgcn_cvt_pk_fp8_f32(v[r][k][i].z * sc, v[r][k][i].w * sc, t, true); ww[i] = (unsigned)t; }
            w.x = ww[0]; w.y = ww[1]; w.z = ww[2]; w.w = ww[3];
            *(u32x4*)((r ? d1 : d0) + 1024 * k + 16 * lane) = w; }
        if (lane == 0) *(r ? i1 : i0) = isc;
    }
}

typedef float f32x2 __attribute__((ext_vector_type(2)));
template <int N> __device__ __forceinline__ f32x2 dot16_fp8(const u32x4 w, const f32x2 (&x)[N], int o, f32x2 acc) {
    const unsigned ww[4] = {w.x, w.y, w.z, w.w};
#pragma unroll
    for (int d = 0; d < 4; ++d) { acc += __builtin_amdgcn_cvt_pk_f32_fp8((int)ww[d], false) * x[o + 2 * d]; acc += __builtin_amdgcn_cvt_pk_f32_fp8((int)ww[d], true) * x[o + 2 * d + 1]; }
    return acc;
}
template <int N> __device__ __forceinline__ void axpy16_fp8(const u32x4 w, float a, f32x2 (&y)[N], int o) {
    const unsigned ww[4] = {w.x, w.y, w.z, w.w}; const f32x2 a2 = {a, a};
#pragma unroll
    for (int d = 0; d < 4; ++d) { y[o + 2 * d] += a2 * __builtin_amdgcn_cvt_pk_f32_fp8((int)ww[d], false); y[o + 2 * d + 1] += a2 * __builtin_amdgcn_cvt_pk_f32_fp8((int)ww[d], true); }
}
__device__ __forceinline__ void bstore16(__amdgpu_buffer_rsrc_t r, f32x4 v, int voff, int soff) { __builtin_amdgcn_raw_buffer_store_b128(__builtin_bit_cast(__attribute__((__vector_size__(4 * sizeof(unsigned)))) unsigned, v), r, voff, soff, 0); }
__device__ __forceinline__ void bstore8(__amdgpu_buffer_rsrc_t r, f32x2 v, int voff, int soff) { __builtin_amdgcn_raw_buffer_store_b64(__builtin_bit_cast(__attribute__((__vector_size__(2 * sizeof(unsigned)))) unsigned, v), r, voff, soff, 0); }
__device__ __forceinline__ f32x2 fsel2(int mask, f32x2 a, f32x2 b) { return (f32x2){fsel(mask, a.x, b.x), fsel(mask, a.y, b.y)}; }
__device__ __forceinline__ f32x2 shx2(f32x2 a, int o) { return (f32x2){__shfl_xor(a.x, o), __shfl_xor(a.y, o)}; }

__device__ __forceinline__ void phase_pd(const Params& p, int bid, int nb) {
    const int tid = threadIdx.x, lane = tid & 63, wave = __builtin_amdgcn_readfirstlane(tid >> 6);
    if (wave == 7) {
        for (int e = bid; e < 16384; e += 2 * nb) { const int e2 = e + nb < 16384 ? e + nb : e;
            fp8_row2(p.up + (size_t)e * D, p.up8 + (size_t)e * D, p.sup + e, p.up + (size_t)e2 * D, p.up8 + (size_t)e2 * D, p.sup + e2, lane); }
        return;
    }
    const int v = bid & 7, lw = (bid >> 3) * 7 + wave, NLW = (nb >> 3) * 7;
    const int c = lane & 7, sub = lane >> 3;
    const int m0 = -(lane & 1), m1 = -((lane >> 1) & 1), m2 = -((lane >> 2) & 1);
    const __amdgpu_buffer_rsrc_t rd = __builtin_amdgcn_make_buffer_rsrc((void*)p.down8, 0, 16384 * D, 0x00020000);
    const __amdgpu_buffer_rsrc_t rh = __builtin_amdgcn_make_buffer_rsrc((void*)p.h2b, 0, SEQ * D * 2, 0x00020000);
    const __amdgpu_buffer_rsrc_t rg1 = __builtin_amdgcn_make_buffer_rsrc((void*)p.ffn_g, 0, D * 4, 0x00020000);
    const __amdgpu_buffer_rsrc_t ri = __builtin_amdgcn_make_buffer_rsrc((void*)p.idx, 0, SEQ * 128 * 2, 0x00020000);
    const __amdgpu_buffer_rsrc_t rrs = __builtin_amdgcn_make_buffer_rsrc((void*)p.rstd, 0, SEQ * 4, 0x00020000);
    const __amdgpu_buffer_rsrc_t rp = __builtin_amdgcn_make_buffer_rsrc((void*)p.part, 0, SEQ * 16 * 128 * 2, 0x00020000);
    const int vsub = sub * 32, vc2 = c * 32, vc1 = c * 16, vl4 = lane * 4;
#pragma unroll 1
    for (int pass = 0; pass < 2; ++pass) {
        const int sl = v * 2 + pass;
        f32x2 gs[8];
#pragma unroll
        for (int i = 0; i < 4; ++i) { const f32x4 g = __builtin_bit_cast(f32x4, bload16(rg1, c * 64, sl * 512 + i * 16)); gs[2 * i] = (f32x2){g[0], g[1]}; gs[2 * i + 1] = (f32x2){g[2], g[3]}; }
        u32x4 ix[2], hh[2]; unsigned rsb;
        {
            const int t = lw;
#pragma unroll
            for (int i = 0; i < 2; ++i) ix[i] = bload16(ri, vsub, t * 256 + i * 16);
            hh[0] = bload16(rh, vc2, t * 4096 + sl * 256); hh[1] = bload16(rh, vc2, t * 4096 + sl * 256 + 16); rsb = bload4(rrs, 0, t * 4);
        }
#pragma unroll 1
        for (int t = lw; t < SEQ; t += NLW) {
            asm volatile("" ::: "memory");
            u32x4 w[16];
            {
                const unsigned ew[8] = {ix[0].x, ix[0].y, ix[0].z, ix[0].w, ix[1].x, ix[1].y, ix[1].z, ix[1].w};
#pragma unroll
                for (int g = 0; g < 16; ++g) { const unsigned e = (g & 1) ? (ew[g >> 1] >> 16) : (ew[g >> 1] & 0xffffu); w[g] = bload16(rd, (int)(e * 2048u) + vc1, sl * 128); }
            }
            f32x2 xs[8];
            {
                const float rs = __uint_as_float(rsb);
                const unsigned hw[8] = {hh[0].x, hh[0].y, hh[0].z, hh[0].w, hh[1].x, hh[1].y, hh[1].z, hh[1].w};
#pragma unroll
                for (int i = 0; i < 8; ++i) xs[i] = (f32x2){bf_lo(hw[i]) * rs, bf_hi(hw[i]) * rs} * gs[i];
            }
            asm volatile("" ::: "memory");
            {
                const int tn = t + NLW < SEQ ? t + NLW : t;
#pragma unroll
                for (int i = 0; i < 2; ++i) ix[i] = bload16(ri, vsub, tn * 256 + i * 16);
                hh[0] = bload16(rh, vc2, tn * 4096 + sl * 256); hh[1] = bload16(rh, vc2, tn * 4096 + sl * 256 + 16); rsb = bload4(rrs, 0, tn * 4);
            }
            asm volatile("" ::: "memory");
            float r[16];
#pragma unroll
            for (int g = 0; g < 16; ++g) { const f32x2 z = {0.f, 0.f}; const f32x2 s2 = dot16_fp8(w[g], xs, 0, z); r[g] = s2.x + s2.y; }
            float k8[8], k4[4];
#pragma unroll
            for (int i = 0; i < 8; ++i) k8[i] = fsel(m2, r[i], r[i + 8]) + __shfl_xor(fsel(m2, r[i + 8], r[i]), 4);
#pragma unroll
            for (int i = 0; i < 4; ++i) k4[i] = fsel(m1, k8[i], k8[i + 4]) + __shfl_xor(fsel(m1, k8[i + 4], k8[i]), 2);
            const float k0 = fsel(m0, k4[0], k4[2]) + __shfl_xor(fsel(m0, k4[2], k4[0]), 1);
            const float k1 = fsel(m0, k4[1], k4[3]) + __shfl_xor(fsel(m0, k4[3], k4[1]), 1);
            bstore4(rp, cvt_pk_bf16(k0, k1), vl4, (t * 16 + sl) * 256);
        }
    }
}
__device__ __forceinline__ void phase_pa(const Params& p, int bid, int nb) {
    const int tid = threadIdx.x, lane = tid & 63, wave = tid >> 6;
    const int gw = bid * 8 + wave, NGW = nb * 8;
    for (int it = gw; it < SEQ * 2; it += NGW) {
        const int t = it >> 1, pp = (it & 1) * 64 + lane;
        const bf16_t* pr = p.part + (size_t)t * 2048 + pp;
        float hs = 0.f;
#pragma unroll
        for (int sl = 0; sl < 16; ++sl) hs += __uint_as_float((unsigned)pr[sl * 128] << 16);
        const int e = (int)p.idx[(size_t)t * 128 + pp];
        hs *= p.sdn[e];
        const float av = p.gsu[(size_t)t * 128 + pp] * p.sup[e] * 0.5f * hs * (1.0f + erff(hs * 0.70710678118654752f));
        p.act[(size_t)t * 128 + pp] = (bf16_t)(cvt_pk_bf16(av, 0.f) & 0xffffu);
    }
}
__device__ __forceinline__ void phase_pu(const Params& p, int bid, int nb) {
    const int tid = threadIdx.x, lane = tid & 63, wave = __builtin_amdgcn_readfirstlane(tid >> 6);
    const int v = bid & 7, lw = (bid >> 3) * 8 + wave, NLW = (nb >> 3) * 8;
    const int c = lane & 7, sub = lane >> 3;
    const int m3 = -((lane >> 3) & 1), m4 = -((lane >> 4) & 1), m5 = -((lane >> 5) & 1);
    const __amdgpu_buffer_rsrc_t ru = __builtin_amdgcn_make_buffer_rsrc((void*)p.up8, 0, 16384 * D, 0x00020000);
    const __amdgpu_buffer_rsrc_t rh = __builtin_amdgcn_make_buffer_rsrc((void*)p.h2b, 0, SEQ * D * 2, 0x00020000);
    const __amdgpu_buffer_rsrc_t ri = __builtin_amdgcn_make_buffer_rsrc((void*)p.idx, 0, SEQ * 128 * 2, 0x00020000);
    const __amdgpu_buffer_rsrc_t ra = __builtin_amdgcn_make_buffer_rsrc((void*)p.act, 0, SEQ * 128 * 2, 0x00020000);
    const __amdgpu_buffer_rsrc_t ro = __builtin_amdgcn_make_buffer_rsrc((void*)p.h3b, 0, SEQ * D * 2, 0x00020000);
    const __amdgpu_buffer_rsrc_t rq = __builtin_amdgcn_make_buffer_rsrc((void*)p.ssq2, 0, SEQ * 16 * 4, 0x00020000);
    const int vsub = sub * 32, vc1 = c * 16, vh = c * 32 + sub * 4;
#pragma unroll 1
    for (int pass = 0; pass < 2; ++pass) {
        const int sl = v * 2 + pass;
        u32x4 ix[2], ac[2]; unsigned hb;
        {
            const int t = lw;
#pragma unroll
            for (int i = 0; i < 2; ++i) { ix[i] = bload16(ri, vsub, t * 256 + i * 16); ac[i] = bload16(ra, vsub, t * 256 + i * 16); }
            hb = bload4(rh, vh, t * 4096 + sl * 256);
        }
#pragma unroll 1
        for (int t = lw; t < SEQ; t += NLW) {
            asm volatile("" ::: "memory");
            u32x4 w[16];
            {
                const unsigned ew[8] = {ix[0].x, ix[0].y, ix[0].z, ix[0].w, ix[1].x, ix[1].y, ix[1].z, ix[1].w};
#pragma unroll
                for (int g = 0; g < 16; ++g) { const unsigned e = (g & 1) ? (ew[g >> 1] >> 16) : (ew[g >> 1] & 0xffffu); w[g] = bload16(ru, (int)(e * 2048u) + vc1, sl * 128); }
            }
            const unsigned aw[8] = {ac[0].x, ac[0].y, ac[0].z, ac[0].w, ac[1].x, ac[1].y, ac[1].z, ac[1].w};
            float a[16];
#pragma unroll
            for (int g = 0; g < 16; ++g) a[g] = (g & 1) ? bf_hi(aw[g >> 1]) : bf_lo(aw[g >> 1]);
            const unsigned hcur = hb;
            asm volatile("" ::: "memory");
            {
                const int tn = t + NLW < SEQ ? t + NLW : t;
#pragma unroll
                for (int i = 0; i < 2; ++i) { ix[i] = bload16(ri, vsub, tn * 256 + i * 16); ac[i] = bload16(ra, vsub, tn * 256 + i * 16); }
                hb = bload4(rh, vh, tn * 4096 + sl * 256);
            }
            asm volatile("" ::: "memory");
            f32x2 acc[8];
#pragma unroll
            for (int i = 0; i < 8; ++i) acc[i] = (f32x2){0.f, 0.f};
#pragma unroll
            for (int g = 0; g < 16; ++g) axpy16_fp8(w[g], a[g], acc, 0);
            f32x2 k4[4], k2[2];
#pragma unroll
            for (int i = 0; i < 4; ++i) k4[i] = fsel2(m5, acc[i], acc[i + 4]) + shx2(fsel2(m5, acc[i + 4], acc[i]), 32);
#pragma unroll
            for (int i = 0; i < 2; ++i) k2[i] = fsel2(m4, k4[i], k4[i + 2]) + shx2(fsel2(m4, k4[i + 2], k4[i]), 16);
            f32x2 h3 = fsel2(m3, k2[0], k2[1]) + shx2(fsel2(m3, k2[1], k2[0]), 8);
            h3 += (f32x2){bf_lo(hcur), bf_hi(hcur)};
            bstore4(ro, cvt_pk_bf16(h3.x, h3.y), vh, t * 4096 + sl * 256);
            const float ss = wave_sum(h3.x * h3.x + h3.y * h3.y);
            if (lane == 0) bstore4(rq, __float_as_uint(ss), 0, (t * 16 + sl) * 4);
        }
    }
}
__device__ __forceinline__ void phase_pf(const Params& p, int bid, int nb) {
    const int tid = threadIdx.x, lane = tid & 63, wave = tid >> 6;
    const int gw = bid * 8 + wave, NGW = nb * 8;
    for (int t = gw; t < SEQ; t += NGW) {
        const f32x4* sp = (const f32x4*)(p.ssq2 + (size_t)t * 16); f32x4 q = sp[0] + sp[1] + sp[2] + sp[3];
        const float rf = rsqrtf(((q[0] + q[1]) + (q[2] + q[3])) * (1.0f / D) + 1e-6f);
        const u32x4* hp = (const u32x4*)(p.h3b + (size_t)t * D) + lane;
        f32x4* o = (f32x4*)(p.out + (size_t)t * D) + 2 * lane; const f32x4* g = (const f32x4*)p.fin_g + 2 * lane;
#pragma unroll
        for (int j = 0; j < 4; ++j) { const u32x4 h = hp[64 * j]; const f32x4 g0 = g[128 * j], g1 = g[128 * j + 1];
            o[128 * j] = (f32x4){bf_lo(h.x) * rf * g0[0], bf_hi(h.x) * rf * g0[1], bf_lo(h.y) * rf * g0[2], bf_hi(h.y) * rf * g0[3]};
            o[128 * j + 1] = (f32x4){bf_lo(h.z) * rf * g1[0], bf_hi(h.z) * rf * g1[1], bf_lo(h.w) * rf * g1[2], bf_hi(h.w) * rf * g1[3]}; }
    }
}

__device__ __forceinline__ void fp8_row(const float* src, unsigned char* dst, float* inv_scale, int lane) {
    f32x4 v[2][4]; float am = 0.f;
#pragma unroll
    for (int k = 0; k < 2; ++k)
#pragma unroll
        for (int i = 0; i < 4; ++i) { v[k][i] = *(const f32x4*)(src + 1024 * k + 16 * lane + 4 * i);
            am = fmaxf(am, fmaxf(fmaxf(fabsf(v[k][i].x), fabsf(v[k][i].y)), fmaxf(fabsf(v[k][i].z), fabsf(v[k][i].w)))); }
#pragma unroll
    for (int o = 1; o < 64; o <<= 1) am = fmaxf(am, __shfl_xor(am, o));
    int be = (__float_as_int(am) >> 23) & 255; be = be < 8 ? 8 : (be > 248 ? 248 : be);
    const float sc = __int_as_float((260 - be) << 23), isc = __int_as_float((be - 6) << 23);
#pragma unroll
    for (int k = 0; k < 2; ++k) { u32x4 w; unsigned ww[4];
#pragma unroll
        for (int i = 0; i < 4; ++i) { int t = 0; t = __builtin_amdgcn_cvt_pk_fp8_f32(v[k][i].x * sc, v[k][i].y * sc, t, false); t = __builtin_amdgcn_cvt_pk_fp8_f32(v[k][i].z * sc, v[k][i].w * sc, t, true); ww[i] = (unsigned)t; }
        w.x = ww[0]; w.y = ww[1]; w.z = ww[2]; w.w = ww[3];
        *(u32x4*)(dst + 1024 * k + 16 * lane) = w; }
    if (lane == 0) *inv_scale = isc;
}

__device__ __forceinline__ void tr_item(const float* W, int ldw, int srccol0, int k0, bf16_t* WT, int ldt, int n0, const float* kscale, const float* nscale, LAS float* scr, int lane) {
    float tv[32];
#pragma unroll
    for (int i = 0; i < 32; ++i) { const int kk = 2 * i + (lane >> 5); tv[i] = W[(size_t)(k0 + kk) * ldw + srccol0 + (lane & 31)]; }
    const float ns = nscale ? nscale[srccol0 + (lane & 31)] : 1.0f;
#pragma unroll
    for (int i = 0; i < 32; ++i) { const int kk = 2 * i + (lane >> 5); float v = tv[i] * ns;
        if (kscale) v *= kscale[k0 + kk]; scr[kk * 33 + (lane & 31)] = v; }
    asm volatile("s_waitcnt lgkmcnt(0)" ::: "memory");
    const int c = lane & 7;
#pragma unroll
    for (int j = 0; j < 4; ++j) { const int n = (lane >> 3) + 8 * j; const LAS float* s = scr + (8 * c) * 33 + n;
        u32x4 o; o.x = cvt_pk_bf16(s[0 * 33], s[1 * 33]); o.y = cvt_pk_bf16(s[2 * 33], s[3 * 33]); o.z = cvt_pk_bf16(s[4 * 33], s[5 * 33]); o.w = cvt_pk_bf16(s[6 * 33], s[7 * 33]);
        *(u32x4*)(WT + (size_t)(n0 + n) * ldt + k0 + 8 * c) = o; }
    asm volatile("s_waitcnt lgkmcnt(0)" ::: "memory");
}
__device__ __forceinline__ int win_srccol(int n) { const int pn = n >> 8, w = n & 255; return pn < 4 ? n : ((w >> 7) ? 2048 : 1024) + (pn - 4) * 128 + (w & 127); }

__device__ __forceinline__ void phase_prep(const Params& p, LAS unsigned char* lds, int bid, int nb) {
    const int tid = threadIdx.x, lane = tid & 63, wave = tid >> 6;
    const int gw = bid * 8 + wave, NGW = nb * 8;
    LAS float* scr = (LAS float*)(lds + wave * 8448);
    for (int r = gw; r < RT; r += NGW) {
        unsigned long long* o8 = (unsigned long long*)(p.hnb + (size_t)r * D) + lane;
        if (r < RPAD) {
#pragma unroll
            for (int j = 0; j < 8; ++j) o8[64 * j] = 0ull;
            if (lane == 0) p.rstd1[r] = 0.f;
        } else {
            const f32x4* xr = (const f32x4*)hrow(p, r - RPAD) + lane;
            f32x4 v[8]; float s = 0.f;
#pragma unroll
            for (int j = 0; j < 8; ++j) { v[j] = __builtin_nontemporal_load(xr + 64 * j); s += (v[j].x * v[j].x + v[j].y * v[j].y) + (v[j].z * v[j].z + v[j].w * v[j].w); }
            const float rs = rsqrtf(wave_sum(s) * (1.0f / D) + 1e-6f);
            if (lane == 0) p.rstd1[r] = rs;
#pragma unroll
            for (int j = 0; j < 8; ++j)
                o8[64 * j] = (unsigned long long)cvt_pk_bf16(v[j].x, v[j].y) | ((unsigned long long)cvt_pk_bf16(v[j].z, v[j].w) << 32);
        }
    }
    for (int it = gw; it < (D / 64) * (INW / 32); it += NGW) {
        const int kb = it / (INW / 32), nbk = it % (INW / 32);
        tr_item(p.w_in, INW, win_srccol(nbk * 32), kb * 64, p.w_in_t, D, nbk * 32, p.mix_g, nullptr, scr, lane);
    }
    for (int i = gw * 64 + lane; i < 4 * 256 * 256 / 4; i += NGW * 64) { const f32x4 v = ((const f32x4*)p.pool_w)[i];
        const int g = i >> 14, d = (i & 63) * 4; const f32x4 sc = *(const f32x4*)(p.pool_scale + g * 256 + d);
        u32x2 w; w.x = cvt_pk_bf16(v[0] * sc[0], v[1] * sc[1]); w.y = cvt_pk_bf16(v[2] * sc[2], v[3] * sc[3]); ((u32x2*)p.pool_ws)[i] = w; }
    for (int i = gw * 64 + lane; i < CWD * CWD / 4; i += NGW * 64) { const f32x4 v = ((const f32x4*)p.pw_w)[i];
        u32x2 w; w.x = cvt_pk_bf16(v[0], v[1]); w.y = cvt_pk_bf16(v[2], v[3]); ((u32x2*)p.pw_b16)[i] = w; }
    for (int it = gw; it < 32 * 64; it += NGW) { const int kb = it >> 6, nbk = it & 63;
        tr_item(p.w_out, D, nbk * 32, kb * 64, p.w_out_t, D, nbk * 32, nullptr, nullptr, scr, lane); }
    for (int it = gw; it < 32 * 64; it += NGW) { const int kb = it >> 6, nbk = it & 63;
        tr_item(p.wq, D, nbk * 32, kb * 64, p.wq_t, D, nbk * 32, p.ffn_g, nullptr, scr, lane); }
    for (int i = gw * 64 + lane; i < 8 * 2 * 128 * 128 / 4; i += NGW * 64) { const f32x4 v = ((const f32x4*)p.keys)[i];
        u32x2 w; w.x = cvt_pk_bf16(v[0], v[1]); w.y = cvt_pk_bf16(v[2], v[3]); ((u32x2*)p.keysb)[i] = w; }
    for (int e = gw; e < 16384; e += 2 * NGW) { const int e2 = e + NGW < 16384 ? e + NGW : e;
        fp8_row2(p.down + (size_t)e * D, p.down8 + (size_t)e * D, p.sdn + e, p.down + (size_t)e2 * D, p.down8 + (size_t)e2 * D, p.sdn + e2, lane); }
}


#define XB_TMO      128
#define XB_XCNT(j)  (256  + 64 * (j))
#define XB_XSUB(j)  (1280 + 64 * (j))
#define XB_XGEN(j)  (2304 + 64 * (j))
#define XB_TOP      3328
#define XB_TOPGEN   3392
#define XCD_BAR_WORDS 3456
#define XB_SPIN_CAP (1u << 18)
__device__ __forceinline__ unsigned xb_ld(unsigned* p)              { return __hip_atomic_load(p, __ATOMIC_RELAXED, __HIP_MEMORY_SCOPE_AGENT); }
__device__ __forceinline__ unsigned xb_add(unsigned* p, unsigned v) { return __hip_atomic_fetch_add(p, v, __ATOMIC_RELAXED, __HIP_MEMORY_SCOPE_AGENT); }
__device__ __forceinline__ unsigned xb_xcc_id() { return (unsigned)__builtin_amdgcn_s_getreg((3 << 11) | 20) & 0xFu; }
#define XB_SPIN(cond, bar) do { unsigned _sp = 0; while (cond) { __builtin_amdgcn_s_sleep(1); \
    if ((++_sp & 255u) == 0u) { if (xb_ld(&(bar)[XB_TMO])) break; if (_sp > XB_SPIN_CAP) { atomicAdd(&(bar)[XB_TMO], 1u); break; } } } } while (0)
struct XcdBarrier { unsigned* bar; unsigned x; volatile LAS unsigned* st; };
__device__ __forceinline__ XcdBarrier xcd_barrier_post(unsigned* bar, volatile LAS unsigned* st) {
    XcdBarrier b; b.bar = bar; b.x = xb_xcc_id(); b.st = st;
    if (threadIdx.x == 0) (void)xb_add(&bar[XB_XCNT(b.x)], 1u);
    return b;
}
__device__ __forceinline__ void xcd_barrier_complete(unsigned* bar, unsigned x, unsigned& nloc, unsigned& nx) {
    const unsigned G = gridDim.x * gridDim.y * gridDim.z;
    unsigned sum, cnt, mine, sp = 0u;
    for (;;) {
        sum = 0u; cnt = 0u; mine = 0u;
#pragma unroll
        for (unsigned j = 0; j < 16; ++j) { const unsigned c = xb_ld(&bar[XB_XCNT(j)]); sum += c; cnt += (c > 0u) ? 1u : 0u; mine = (j == x) ? c : mine; }
        if (sum == G) break;
        __builtin_amdgcn_s_sleep(1);
        if ((++sp & 255u) == 0u) { if (xb_ld(&bar[XB_TMO])) break; if (sp > XB_SPIN_CAP) { atomicAdd(&bar[XB_TMO], 1u); break; } }
    }
    nloc = mine > 0u ? mine : 1u; nx = cnt > 0u ? cnt : 1u;
}
__device__ __forceinline__ void xcd_barrier(const XcdBarrier& b) {
    asm volatile("s_waitcnt vmcnt(0)" ::: "memory");
    __syncthreads();
    if (threadIdx.x == 0) {
        unsigned* bar = b.bar;
        __builtin_amdgcn_s_waitcnt(0);
        unsigned nloc = b.st[0], nx = b.st[1];
        if (nloc == 0u) { xcd_barrier_complete(bar, b.x, nloc, nx); b.st[0] = nloc; b.st[1] = nx; }
        const unsigned old = xb_add(&bar[XB_XSUB(b.x)], 1u);
        const unsigned gen = old / nloc;
        if (old + 1u == (gen + 1u) * nloc) {
            __builtin_amdgcn_fence(__ATOMIC_RELEASE, "agent");
            asm volatile("s_waitcnt vmcnt(0)" ::: "memory");
            const unsigned og = xb_add(&bar[XB_TOP], 1u);
            const unsigned tg = og / nx;
            if (og + 1u == (tg + 1u) * nx) xb_add(&bar[XB_TOPGEN], 1u);
            else XB_SPIN(xb_ld(&bar[XB_TOPGEN]) == tg, bar);
            __builtin_amdgcn_fence(__ATOMIC_ACQUIRE, "agent");
            xb_add(&bar[XB_XGEN(b.x)], 1u);
            asm volatile("s_waitcnt vmcnt(0)" ::: "memory");
        } else {
            XB_SPIN(xb_ld(&bar[XB_XGEN(b.x)]) == gen, bar);
            __builtin_amdgcn_fence(__ATOMIC_ACQUIRE, "agent");
            asm volatile("s_waitcnt vmcnt(0)" ::: "memory");
        }
    }
    __syncthreads();
}

__global__ void __launch_bounds__(NT, 2) k_mega(Params p) {
    extern __shared__ __attribute__((aligned(16))) unsigned char lds_raw[];
    LAS unsigned char* lds = (LAS unsigned char*)lds_raw;
    const int bid = blockIdx.x, nb = gridDim.x;
    volatile LAS unsigned* bst = (volatile LAS unsigned*)(lds + LDS_BYTES - 16);
    if (threadIdx.x < 4) bst[threadIdx.x] = 0u;
    __syncthreads();
    const XcdBarrier xb = xcd_barrier_post(p.bar, bst);
    phase_prep(p, lds, bid, nb);
    xcd_barrier(xb);
    { pg8::Gemm g{p.hnb, p.w_in_t, D, D, D, 0}; pg8::StaticOrder S; S.init(RT / 256, INW / 256, nb, bid); EpiProj E{p.xp, p.glu, p.rstd1};
      pg8::gemm_phase<EpiProj, pg8::StaticOrder>(lds, g, S, E); }
    { const int nproj = (RT / 256) * (INW / 256); const int first = (nproj > nb && nproj < 2 * nb) ? nproj - nb : 0, nfree = nb - first;
      for (int uu = bid - first; uu >= 0 && uu < 64; uu += nfree) {
        __syncthreads();
        const bool pw = uu < 32;
        pg8::Gemm g{pw ? p.w_out_t + PWD : p.w_out_t, pw ? p.pw_b16 : p.pool_ws, D, pw ? CWD : 256, pw ? CWD : 256, pw ? 0 : 256};
        pg8::OneUnit S; S.u.pm = (uu & 31) >> 2; S.u.pn = uu & 3; EpiBf16Out E{p.w_eff_t, D, pw ? PWD : 0, nullptr};
        pg8::gemm_phase<EpiBf16Out, pg8::OneUnit>(lds, g, S, E);
      }
      { const int b0 = nfree >= 96 ? first + 64 : 0;
        for (int nbk = bid - b0; nbk >= 0 && nbk < D / 64; nbk += nb) {
          __syncthreads();
          const int lane = threadIdx.x & 63, wv = threadIdx.x >> 6, n = nbk * 64 + lane;
          float a[8] = {0.f, 0.f, 0.f, 0.f, 0.f, 0.f, 0.f, 0.f};
          for (int j = wv * 128; j < wv * 128 + 128; j += 8) {
#pragma unroll
            for (int q = 0; q < 8; ++q) a[q] += p.pw_b[j + q] * p.w_out[(size_t)(PWD + j + q) * D + n]; }
          LAS float* red = (LAS float*)lds;
          red[wv * 64 + lane] = ((a[0] + a[1]) + (a[2] + a[3])) + ((a[4] + a[5]) + (a[6] + a[7]));
          __syncthreads();
          if (wv == 0) { float t = 0.f;
#pragma unroll
            for (int q = 0; q < 8; ++q) t += red[q * 64 + lane];
            p.bias_eff[n] = t; }
        } }
    }
    xcd_barrier(xb);
    phase_mix(p, lds, bid, nb);
    xcd_barrier(xb);
    { pg8::Gemm g{p.mixb, p.w_eff_t, D, D, D, 0}; pg8::StaticOrder S; S.init(SEQ / 256, D / 256, nb, bid); EpiResid E{p.hnb, p.bias_eff, p.h2b, p.ssq};
      pg8::gemm_phase<EpiResid, pg8::StaticOrder>(lds, g, S, E); }
    xcd_barrier(xb);
    { pg8::Gemm g{p.h2b, p.wq_t, D, D, D, 0}; pg8::StaticOrder S; S.init(SEQ / 256, D / 256, nb, bid); EpiQTopk E{p.ssq, p.rstd, p.keysb, p.idx, p.gsu};
      pg8::gemm_phase<EpiQTopk, pg8::StaticOrder>(lds, g, S, E); }
    xcd_barrier(xb);
    phase_pd(p, bid, nb);
    xcd_barrier(xb);
    phase_pa(p, bid, nb);
    xcd_barrier(xb);
    phase_pu(p, bid, nb);
    xcd_barrier(xb);
    phase_pf(p, bid, nb);
}

extern "C" void kernel_launch(void* const* d_in, const int* in_sizes, int n_in, void* d_out, int out_size, void* d_ws, size_t ws_size, hipStream_t stream) {
    Params p{};
    p.x = (const float*)d_in[0]; p.meta = (const float*)d_in[1]; p.mix_g = (const float*)d_in[2]; p.w_in = (const float*)d_in[3];
    p.pool_w = (const float*)d_in[4]; p.pool_scale = (const float*)d_in[5]; p.dw_w = (const float*)d_in[6]; p.dw_b = (const float*)d_in[7];
    p.ln_g = (const float*)d_in[8]; p.ln_b = (const float*)d_in[9]; p.pw_w = (const float*)d_in[10]; p.pw_b = (const float*)d_in[11];
    p.w_out = (const float*)d_in[12]; p.ffn_g = (const float*)d_in[13]; p.wq = (const float*)d_in[14]; p.keys = (const float*)d_in[15];
    p.down = (const float*)d_in[16]; p.up = (const float*)d_in[17]; p.fin_g = (const float*)d_in[18];
    p.out = (float*)d_out;
    char* w = (char*)d_ws; size_t off = 0;
    auto take = [&](size_t bytes) { char* r = w + off; off += (bytes + 255) & ~(size_t)255; return r; };
    p.idx = (unsigned short*)take((size_t)SEQ * 128 * 2);
    p.gsu = (float*)take((size_t)SEQ * 128 * 4);
    p.part = (bf16_t*)take((size_t)SEQ * 16 * 128 * 2);
    p.act = (bf16_t*)take((size_t)SEQ * 128 * 2);
    p.ssq2 = (float*)take((size_t)SEQ * 16 * 4);
    p.h3b = (bf16_t*)take((size_t)SEQ * D * 2);
    p.hnb = (bf16_t*)take((size_t)RT * D * 2);
    p.rstd1 = (float*)take((size_t)RT * 4);
    p.w_in_t = (bf16_t*)take((size_t)INW * D * 2);
    p.xp = (bf16_t*)take((size_t)RT * PWD * 2);
    p.glu = (bf16_t*)take((size_t)RT * CWD * 2);
    p.mixb = (bf16_t*)take((size_t)SEQ * D * 2);
    p.h2b = (bf16_t*)take((size_t)SEQ * D * 2);
    p.pool_ws = (bf16_t*)take((size_t)4 * 256 * 256 * 2);
    p.pw_b16 = (bf16_t*)take((size_t)CWD * CWD * 2);
    p.w_eff_t = (bf16_t*)take((size_t)D * D * 2);
    p.bias_eff = (float*)take((size_t)D * 4);
    p.w_out_t = (bf16_t*)take((size_t)D * D * 2);
    p.ssq = (float*)take((size_t)SEQ * 32 * 4);
    p.bar = (unsigned*)take((size_t)XCD_BAR_WORDS * 4);
    p.rstd = (float*)take((size_t)SEQ * 4);
    p.wq_t = (bf16_t*)take((size_t)D * D * 2);
    p.keysb = (bf16_t*)take((size_t)8 * 2 * 128 * 128 * 2);
    p.qb = (bf16_t*)take((size_t)SEQ * D * 2);
    p.down8 = (unsigned char*)take((size_t)16384 * D);
    p.up8 = (unsigned char*)take((size_t)16384 * D);
    p.sdn = (float*)take((size_t)16384 * 4);
    p.sup = (float*)take((size_t)16384 * 4);
    static int grid_blocks = 0;
    if (!grid_blocks) {
        int dev = 0, cus = 0, per_cu = 0;
        (void)hipGetDevice(&dev);
        (void)hipDeviceGetAttribute(&cus, hipDeviceAttributeMultiprocessorCount, dev);
        (void)hipFuncSetAttribute((const void*)k_mega, hipFuncAttributeMaxDynamicSharedMemorySize, LDS_BYTES);
        (void)hipOccupancyMaxActiveBlocksPerMultiprocessor(&per_cu, k_mega, NT, LDS_BYTES);
        if (per_cu < 1) { fprintf(stderr, "occupancy query says %d workgroups per CU: nothing launched\n", per_cu); grid_blocks = -1; }
        else if (cus != (SEQ / 256) * (D / 256)) { fprintf(stderr, "this build needs a %d-CU device (got %d): nothing launched\n", (SEQ / 256) * (D / 256), cus); grid_blocks = -1; }
        else grid_blocks = cus;
    }
    if (grid_blocks < 0) return;
    (void)hipMemsetAsync(p.bar, 0, (size_t)XCD_BAR_WORDS * 4, stream);
    void* args[] = {&p};
    hipError_t e = hipLaunchCooperativeKernel((void*)k_mega, dim3(grid_blocks), dim3(NT), args, LDS_BYTES, stream);
    if (e != hipSuccess) fprintf(stderr, "cooperative launch failed: %s (grid %d)\n", hipGetErrorString(e), grid_blocks);
}
```

```cpp
#include <hip/hip_runtime.h>
#include <hip/hip_cooperative_groups.h>
#include <stdint.h>
#include <cstdio>
namespace cg = cooperative_groups;

#define NT 512
#define LAS __attribute__((address_space(3)))
typedef unsigned short bf16_t;
typedef short bf16x8 __attribute__((ext_vector_type(8)));
typedef float f32x4 __attribute__((ext_vector_type(4)));
typedef unsigned u32x4 __attribute__((ext_vector_type(4)));
typedef unsigned u32x2 __attribute__((ext_vector_type(2)));

constexpr int D = 2048, SEQ = 8192, NMETA = 16, T = SEQ + NMETA;
constexpr int PWD = 1024, CWD = 1024, INW = 3072;
constexpr int KS = 31;
constexpr int RPAD = 240, RT = 8448;
constexpr int LDS_BYTES = 151552;

struct Params {
    const float *x, *meta, *mix_g, *w_in, *pool_w, *pool_scale, *dw_w, *dw_b, *ln_g, *ln_b, *pw_w, *pw_b, *w_out, *ffn_g, *wq, *keys, *down, *up, *fin_g;
    float* out;
    unsigned short* idx;
    unsigned* bar;
    bf16_t *hnb, *w_in_t, *xp, *glu, *mixb, *h2b, *pool_ws, *pw_b16, *w_eff_t, *w_out_t, *wq_t, *keysb, *qb;
    unsigned char *down8, *up8;
    float *sdn, *sup;
    float *gsu;
    bf16_t* part;
    bf16_t* act;
    float* ssq2;
    bf16_t* h3b;
    float *ssq, *rstd, *bias_eff, *rstd1;
};

__device__ __forceinline__ unsigned cvt_pk_bf16(float lo, float hi) { unsigned r; asm volatile("v_cvt_pk_bf16_f32 %0, %1, %2" : "=v"(r) : "v"(lo), "v"(hi)); return r; }
__device__ __forceinline__ void store16_wt(void* ptr, u32x4 v) { asm volatile("global_store_dwordx4 %0, %1, off sc1\n\ts_nop 1" :: "v"(ptr), "v"(v) : "memory"); }
__device__ __forceinline__ float bf_lo(unsigned w) { return __uint_as_float(w << 16); }
__device__ __forceinline__ float bf_hi(unsigned w) { return __uint_as_float(w & 0xffff0000u); }
__device__ __forceinline__ float wave_sum(float v) {
#pragma unroll
    for (int o = 1; o < 64; o <<= 1) v += __shfl_xor(v, o);
    return v;
}

__device__ __forceinline__ const float* hrow(const Params& p, int t) { return t < NMETA ? p.meta + (size_t)t * D : p.x + (size_t)(t - NMETA) * D; }

__device__ __forceinline__ float block_sum(float v, float* red) {
#pragma unroll
    for (int o = 32; o; o >>= 1) v += __shfl_xor(v, o);
    __syncthreads();
    if ((threadIdx.x & 63) == 0) red[threadIdx.x >> 6] = v;
    __syncthreads();
    float s = 0.f;
#pragma unroll
    for (int i = 0; i < NT / 64; ++i) s += red[i];
    return s;
}

namespace pg8 {
constexpr int BM = 256, BK = 64, HALF = 128, HTB = HALF * BK * 2, STAGE_BYTES = 8 * HTB, NXCD = 8, WGM = 8;
__device__ __forceinline__ int lds_byte(int r, int c) { const int st = (r >> 4) * 2 + (c >> 5), rr = r & 15, cc = c & 31, ob = rr * 64 + cc * 2; return st * 1024 + (ob ^ (((ob >> 9) & 1) << 5)); }
__device__ __forceinline__ void stage_rc(int b, int& R, int& C) { const int st = b / 1024, sb = b % 1024, swz = sb ^ (((sb >> 9) & 1) << 5); R = (st >> 1) * 16 + swz / 64; C = (st & 1) * 32 + (swz % 64) / 2; }
__device__ __forceinline__ int perm32(int rho) { const int n = rho >> 4, i = rho & 15; return 8 * (i >> 2) + 4 * n + (i & 3); }
struct Unit { int pm, pn; };
struct Gemm { const bf16_t* A; const bf16_t* Bt; int lda, ldb, K; int a_col_per_pn; };
struct StaticOrder {
    int nM, nN, nwg, G, c;
    __device__ void init(int nM_, int nN_, int G_, int c_) { nM = nM_; nN = nN_; nwg = nM * nN; G = G_; c = c_; }
    __device__ bool next(int i, Unit& u) const {
        const long L = (long)i * G + c; if (L >= nwg) return false;
        int wgid = (int)L; { const int q = nwg / NXCD, r = nwg % NXCD, xcd = wgid % NXCD, off = wgid / NXCD; wgid = (xcd < r ? xcd * (q + 1) : r * (q + 1) + (xcd - r) * q) + off; }
        const int nig = WGM * nN, gid = wgid / nig, fm = gid * WGM, gsz = (nM - fm) < WGM ? (nM - fm) : WGM;
        u.pm = fm + ((wgid % nig) % gsz); u.pn = (wgid % nig) / gsz; return true;
    }
};
struct OneUnit { Unit u; __device__ bool next(int i, Unit& o) const { if (i) return false; o = u; return true; } };
template <class Epi, class Sched>
__device__ __forceinline__ void gemm_phase(LAS unsigned char* lds, const Gemm g, const Sched& S, const Epi& E) {
    const int tid = threadIdx.x, wid = __builtin_amdgcn_readfirstlane(tid >> 6), lane = tid & 63, wr = wid >> 2, wc = wid & 3, fr = lane & 15, fq = lane >> 4;
    const int K = g.K, nt = K / BK;
    unsigned voffA[2], voffB[2];
#pragma unroll
    for (int i = 0; i < 2; ++i) { int R, C; stage_rc(tid * 16 + i * 8192, R, C);
        const int Rb = Epi::PERM ? ((R & ~31) + perm32(R & 31)) : R;
        voffA[i] = (unsigned)(R * g.lda + C) * 2u; voffB[i] = (unsigned)(Rb * g.ldb + C) * 2u; }
    const size_t kstep = (size_t)(BK * 2);
    const size_t hstepA = (size_t)HALF * g.lda * 2, hstepB = (size_t)HALF * g.ldb * 2;
    const size_t tstepA = 2 * hstepA, tstepB = 2 * hstepB;
    const unsigned ldsw = (unsigned)wid * 1024u;
    const int aoff = lds_byte(wr * 64 + fr, fq * 8), boff = lds_byte(wc * 32 + fr, fq * 8);
#define PG8_SA(b, h) (((b) * 2 + (h)) * HTB)
#define PG8_SB(b, h) ((4 + (b) * 2 + (h)) * HTB)
#define PG8_STAGE(bufoff, gbase, voff) do { _Pragma("unroll") for (int _i = 0; _i < 2; ++_i) \
        __builtin_amdgcn_global_load_lds((const unsigned*)((const char*)(gbase) + (voff)[_i]), (LAS unsigned*)(lds + (bufoff) + ldsw + _i * 8192), 16, 0, 0); } while (0)
#define PG8_LDA(dst, b, h) do { _Pragma("unroll") for (int m = 0; m < 4; ++m) _Pragma("unroll") for (int k = 0; k < 2; ++k) dst[m][k] = *(const LAS bf16x8*)(lds + PG8_SA(b, h) + aoff + m * 2048 + k * 1024); } while (0)
#define PG8_LDB(dst, b, h) do { _Pragma("unroll") for (int n = 0; n < 2; ++n) _Pragma("unroll") for (int k = 0; k < 2; ++k) dst[n][k] = *(const LAS bf16x8*)(lds + PG8_SB(b, h) + boff + n * 2048 + k * 1024); } while (0)
#define PG8_MMA(ai, bj, At, Bt) do { __builtin_amdgcn_s_setprio(1); _Pragma("unroll") for (int m = 0; m < 4; ++m) _Pragma("unroll") for (int n = 0; n < 2; ++n) _Pragma("unroll") for (int k = 0; k < 2; ++k) \
        acc[ai][bj][m][n] = __builtin_amdgcn_mfma_f32_16x16x32_bf16(Bt[n][k], At[m][k], acc[ai][bj][m][n], 0, 0, 0); __builtin_amdgcn_s_setprio(0); } while (0)
#define PG8_WAIT_V(n) asm volatile("s_waitcnt vmcnt(" #n ")" ::: "memory")
#define PG8_WAIT_L(n) asm volatile("s_waitcnt lgkmcnt(" #n ")" ::: "memory")
#define PG8_BAR __builtin_amdgcn_s_barrier()
#define PG8_SCHED __builtin_amdgcn_sched_barrier(0)
    Unit cur, nxt; int ui = 0;
    if (!S.next(0, cur)) return;
    f32x4 acc[2][2][4][2];
#pragma unroll
    for (int a = 0; a < 2; ++a)
#pragma unroll
        for (int b = 0; b < 2; ++b)
#pragma unroll
            for (int m = 0; m < 4; ++m)
#pragma unroll
                for (int n = 0; n < 2; ++n) acc[a][b][m][n] = (f32x4){0.f, 0.f, 0.f, 0.f};
    bf16x8 At[4][2], B0[2][2], B1[2][2];
    const char* cA = (const char*)g.A + (size_t)cur.pm * tstepA + (size_t)cur.pn * g.a_col_per_pn * 2; const char* cB = (const char*)g.Bt + (size_t)cur.pn * tstepB;
    PG8_STAGE(PG8_SB(0, 0), cB, voffB); PG8_STAGE(PG8_SA(0, 0), cA, voffA); PG8_STAGE(PG8_SB(0, 1), cB + hstepB, voffB); PG8_STAGE(PG8_SA(0, 1), cA + hstepA, voffA);
    if (wr == 1) PG8_BAR;
    PG8_WAIT_V(4); PG8_BAR;
    PG8_STAGE(PG8_SB(1, 0), cB + kstep, voffB); PG8_STAGE(PG8_SA(1, 0), cA + kstep, voffA); PG8_STAGE(PG8_SB(1, 1), cB + hstepB + kstep, voffB);
    PG8_WAIT_V(6); PG8_BAR;
    for (;;) {
        const bool has_next = S.next(ui + 1, nxt);
        const char* nA = has_next ? (const char*)g.A + (size_t)nxt.pm * tstepA + (size_t)nxt.pn * g.a_col_per_pn * 2 : cA; const char* nB = has_next ? (const char*)g.Bt + (size_t)nxt.pn * tstepB : cB;
        for (int t = 0; t < nt; t += 2) {
            const bool last = (t == nt - 2);
            const char* a1 = cA + (size_t)(t + 1) * kstep;
            const char* a2 = last ? nA : cA + (size_t)(t + 2) * kstep; const char* b2 = last ? nB : cB + (size_t)(t + 2) * kstep;
            const char* a3 = a2 + kstep; const char* b3 = b2 + kstep;
            PG8_LDB(B0, 0, 0); PG8_SCHED; PG8_LDA(At, 0, 0); PG8_STAGE(PG8_SA(1, 1), a1 + hstepA, voffA);
            PG8_WAIT_L(8); PG8_BAR; PG8_WAIT_L(0); PG8_MMA(0, 0, At, B0); PG8_BAR; PG8_SCHED;
            PG8_LDB(B1, 0, 1); PG8_STAGE(PG8_SB(0, 0), b2, voffB);
            PG8_BAR; PG8_WAIT_L(0); PG8_MMA(0, 1, At, B1); PG8_BAR;
            PG8_LDA(At, 0, 1); PG8_STAGE(PG8_SA(0, 0), a2, voffA);
            PG8_BAR; PG8_WAIT_L(0); PG8_MMA(1, 0, At, B0); PG8_BAR; PG8_SCHED;
            PG8_STAGE(PG8_SB(0, 1), b2 + hstepB, voffB);
            PG8_WAIT_V(6); PG8_BAR; PG8_MMA(1, 1, At, B1); PG8_BAR;
            PG8_LDB(B0, 1, 0); PG8_SCHED; PG8_LDA(At, 1, 0); PG8_STAGE(PG8_SA(0, 1), a2 + hstepA, voffA);
            PG8_WAIT_L(8); PG8_BAR; PG8_WAIT_L(0); PG8_MMA(0, 0, At, B0); PG8_BAR; PG8_SCHED;
            PG8_LDB(B1, 1, 1); PG8_STAGE(PG8_SB(1, 0), b3, voffB);
            PG8_BAR; PG8_WAIT_L(0); PG8_MMA(0, 1, At, B1); PG8_BAR;
            PG8_LDA(At, 1, 1); PG8_STAGE(PG8_SA(1, 0), a3, voffA);
            PG8_BAR; PG8_WAIT_L(0); PG8_MMA(1, 0, At, B0); PG8_BAR; PG8_SCHED;
            PG8_STAGE(PG8_SB(1, 1), b3 + hstepB, voffB);
            PG8_WAIT_V(6); PG8_BAR; PG8_MMA(1, 1, At, B1); PG8_BAR;
        }
        if constexpr (!Epi::AFTER_DRAIN) E(acc, cur, wr, wc, fr, fq);
        if (!has_next) break;
#pragma unroll
        for (int a = 0; a < 2; ++a)
#pragma unroll
            for (int b = 0; b < 2; ++b)
#pragma unroll
                for (int m = 0; m < 4; ++m)
#pragma unroll
                    for (int n = 0; n < 2; ++n) acc[a][b][m][n] = (f32x4){0.f, 0.f, 0.f, 0.f};
        cur = nxt; cA = nA; cB = nB; ++ui;
    }
    PG8_WAIT_V(0);
    if (wr == 0) PG8_BAR;
    PG8_BAR;
    if constexpr (Epi::AFTER_DRAIN) E.fused(acc, cur, wr, wc, fr, fq, lds, wid, lane);
#undef PG8_SA
#undef PG8_SB
#undef PG8_STAGE
#undef PG8_LDA
#undef PG8_LDB
#undef PG8_MMA
#undef PG8_WAIT_V
#undef PG8_WAIT_L
#undef PG8_BAR
#undef PG8_SCHED
}
}

struct EpiProjF32 {
    static constexpr bool PERM = false;
    static constexpr bool AFTER_DRAIN = false;
    float* proj;
    __device__ __forceinline__ void operator()(const f32x4 (&acc)[2][2][4][2], const pg8::Unit& u, int wr, int wc, int fr, int fq) const {
#pragma unroll
        for (int ai = 0; ai < 2; ++ai)
#pragma unroll
            for (int m = 0; m < 4; ++m) {
                const int t = u.pm * 256 + ai * 128 + wr * 64 + m * 16 + fr - RPAD;
                if (t >= 0) {
#pragma unroll
                    for (int bj = 0; bj < 2; ++bj)
#pragma unroll
                        for (int n = 0; n < 2; ++n) {
                            const int off = wc * 32 + n * 16 + fq * 4;
                            const int col = u.pn < 4 ? u.pn * 256 + bj * 128 + off : (bj ? 2048 : 1024) + (u.pn - 4) * 128 + off;
                            *(f32x4*)(proj + (size_t)t * INW + col) = acc[ai][bj][m][n];
                        }
                }
            }
    }
};


__device__ __forceinline__ float sigmoidf_fast(float x) { return __builtin_amdgcn_rcpf(1.0f + __expf(-x)); }

struct EpiProj {
    static constexpr bool PERM = true;
    static constexpr bool AFTER_DRAIN = false;
    bf16_t* xp; bf16_t* glu; const float* rstd1;
    __device__ __forceinline__ void operator()(const f32x4 (&acc)[2][2][4][2], const pg8::Unit& u, int wr, int wc, int fr, int fq) const {
#pragma unroll
        for (int ai = 0; ai < 2; ++ai)
#pragma unroll
            for (int m = 0; m < 4; ++m) {
                const size_t row = (size_t)(u.pm * 256 + ai * 128 + wr * 64 + m * 16 + fr);
                const float rs = rstd1[row];
                if (u.pn < 4) {
#pragma unroll
                    for (int bj = 0; bj < 2; ++bj) { const f32x4 v0 = acc[ai][bj][m][0] * rs, v1 = acc[ai][bj][m][1] * rs;
                        store16_wt(xp + row * PWD + u.pn * 256 + bj * 128 + wc * 32 + fq * 8, (u32x4){cvt_pk_bf16(v0[0], v0[1]), cvt_pk_bf16(v0[2], v0[3]), cvt_pk_bf16(v1[0], v1[1]), cvt_pk_bf16(v1[2], v1[3])}); }
                } else {
                    const f32x4 a0 = acc[ai][0][m][0] * rs, a1 = acc[ai][0][m][1] * rs, g0 = acc[ai][1][m][0] * rs, g1 = acc[ai][1][m][1] * rs;
                    store16_wt(glu + row * CWD + (u.pn - 4) * 128 + wc * 32 + fq * 8, (u32x4){
                        cvt_pk_bf16(a0[0] * sigmoidf_fast(g0[0]), a0[1] * sigmoidf_fast(g0[1])), cvt_pk_bf16(a0[2] * sigmoidf_fast(g0[2]), a0[3] * sigmoidf_fast(g0[3])),
                        cvt_pk_bf16(a1[0] * sigmoidf_fast(g1[0]), a1[1] * sigmoidf_fast(g1[1])), cvt_pk_bf16(a1[2] * sigmoidf_fast(g1[2]), a1[3] * sigmoidf_fast(g1[3]))});
                }
            }
    }
};
struct EpiBf16Out {
    static constexpr bool PERM = true;
    static constexpr bool AFTER_DRAIN = false;
    bf16_t* O; int ldc; int col0; const float* bias;
    __device__ __forceinline__ void operator()(const f32x4 (&acc)[2][2][4][2], const pg8::Unit& u, int wr, int wc, int fr, int fq) const {
#pragma unroll
        for (int ai = 0; ai < 2; ++ai)
#pragma unroll
            for (int m = 0; m < 4; ++m) {
                const size_t row = (size_t)(u.pm * 256 + ai * 128 + wr * 64 + m * 16 + fr);
#pragma unroll
                for (int bj = 0; bj < 2; ++bj) { const int c = u.pn * 256 + bj * 128 + wc * 32 + fq * 8; f32x4 v0 = acc[ai][bj][m][0], v1 = acc[ai][bj][m][1];
                    if (bias) { v0 += *(const f32x4*)(bias + c); v1 += *(const f32x4*)(bias + c + 4); }
                    *(u32x4*)(O + row * ldc + col0 + c) = (u32x4){cvt_pk_bf16(v0[0], v0[1]), cvt_pk_bf16(v0[2], v0[3]), cvt_pk_bf16(v1[0], v1[1]), cvt_pk_bf16(v1[2], v1[3])}; }
            }
    }
};
struct EpiResid {
    static constexpr bool PERM = true;
    static constexpr bool AFTER_DRAIN = false;
    const bf16_t* xb; const float* bias; bf16_t* h2b; float* ssq;
    __device__ __forceinline__ void operator()(const f32x4 (&acc)[2][2][4][2], const pg8::Unit& u, int wr, int wc, int fr, int fq) const {
#pragma unroll
        for (int ai = 0; ai < 2; ++ai)
#pragma unroll
            for (int m = 0; m < 4; ++m) {
                const size_t row = (size_t)(u.pm * 256 + ai * 128 + wr * 64 + m * 16 + fr);
                float ss = 0.f;
#pragma unroll
                for (int bj = 0; bj < 2; ++bj) { const int c = u.pn * 256 + bj * 128 + wc * 32 + fq * 8;
                    const u32x4 xw = *(const u32x4*)(xb + (row + 256) * D + c);
                    const f32x4 v0 = acc[ai][bj][m][0] + (f32x4){bf_lo(xw.x), bf_hi(xw.x), bf_lo(xw.y), bf_hi(xw.y)} + *(const f32x4*)(bias + c);
                    const f32x4 v1 = acc[ai][bj][m][1] + (f32x4){bf_lo(xw.z), bf_hi(xw.z), bf_lo(xw.w), bf_hi(xw.w)} + *(const f32x4*)(bias + c + 4);
                    store16_wt(h2b + row * D + c, (u32x4){cvt_pk_bf16(v0[0], v0[1]), cvt_pk_bf16(v0[2], v0[3]), cvt_pk_bf16(v1[0], v1[1]), cvt_pk_bf16(v1[2], v1[3])});
                    ss += ((v0[0] * v0[0] + v0[1] * v0[1]) + (v0[2] * v0[2] + v0[3] * v0[3])) + ((v1[0] * v1[0] + v1[1] * v1[1]) + (v1[2] * v1[2] + v1[3] * v1[3])); }
                ss += __shfl_xor(ss, 16); ss += __shfl_xor(ss, 32);
                if (fq == 0) ssq[row * 32 + u.pn * 4 + wc] = ss;
            }
    }
};

__device__ __forceinline__ float fsel(int mask, float a, float b) { return __int_as_float((__float_as_int(a) & ~mask) | (__float_as_int(b) & mask)); }

__device__ __forceinline__ u32x4 bload16(__amdgpu_buffer_rsrc_t r, int voff, int soff) { return __builtin_bit_cast(u32x4, __builtin_amdgcn_raw_buffer_load_b128(r, voff, soff, 0)); }
__device__ __forceinline__ unsigned bload4(__amdgpu_buffer_rsrc_t r, int voff, int soff) { return (unsigned)__builtin_amdgcn_raw_buffer_load_b32(r, voff, soff, 0); }
__device__ __forceinline__ void bstore4(__amdgpu_buffer_rsrc_t r, unsigned v, int voff, int soff) { __builtin_amdgcn_raw_buffer_store_b32(v, r, voff, soff, 0); }
__device__ __forceinline__ u32x2 bload8(__amdgpu_buffer_rsrc_t r, int voff, int soff) { return __builtin_bit_cast(u32x2, __builtin_amdgcn_raw_buffer_load_b64(r, voff, soff, 0)); }
template <int W> __device__ __forceinline__ void pool_tile(__amdgpu_buffer_rsrc_t rxp, __amdgpu_buffer_rsrc_t rpo, int r0, int tile, int tid) {
    unsigned v[32 + W - 1];
#pragma unroll
    for (int i = 0; i < 32 + W - 1; ++i) v[i] = bload4(rxp, tid * 4, (r0 - (W - 1) + i) * 2048);
    float s0 = 0.f, s1 = 0.f;
#pragma unroll
    for (int i = 0; i < W - 1; ++i) { s0 += bf_lo(v[i]); s1 += bf_hi(v[i]); }
    constexpr float inv = 1.0f / (float)W;
#pragma unroll
    for (int i = 0; i < 32; ++i) {
        const float a0 = bf_lo(v[W - 1 + i]), a1 = bf_hi(v[W - 1 + i]);
        s0 += a0; s1 += a1;
        bstore4(rpo, cvt_pk_bf16(s0 * inv - a0, s1 * inv - a1), tid * 4, (tile * 32 + i) * 4096);
        s0 -= bf_lo(v[i]); s1 -= bf_hi(v[i]);
    }
}
__device__ __forceinline__ void phase_mix(const Params& p, LAS unsigned char* lds, int bid, int nb) {
    const int tid = threadIdx.x, lane = tid & 63, wave = tid >> 6;
    LAS unsigned* gl = (LAS unsigned*)lds;
    LAS float* red = (LAS float*)(lds + 62 * 2048);
    const __amdgpu_buffer_rsrc_t rxp = __builtin_amdgcn_make_buffer_rsrc((void*)p.xp, 0, RT * PWD * 2, 0x00020000);
    const __amdgpu_buffer_rsrc_t rgl = __builtin_amdgcn_make_buffer_rsrc((void*)p.glu, 0, RT * CWD * 2, 0x00020000);
    const __amdgpu_buffer_rsrc_t rpo = __builtin_amdgcn_make_buffer_rsrc((void*)p.mixb, 0, SEQ * D * 2, 0x00020000);
    const __amdgpu_buffer_rsrc_t rww = __builtin_amdgcn_make_buffer_rsrc((void*)p.dw_w, 0, KS * CWD * 4, 0x00020000);
    const __amdgpu_buffer_rsrc_t rwb = __builtin_amdgcn_make_buffer_rsrc((void*)p.dw_b, 0, CWD * 4, 0x00020000);
    const __amdgpu_buffer_rsrc_t rlg = __builtin_amdgcn_make_buffer_rsrc((void*)p.ln_g, 0, CWD * 4, 0x00020000);
    const __amdgpu_buffer_rsrc_t rlb = __builtin_amdgcn_make_buffer_rsrc((void*)p.ln_b, 0, CWD * 4, 0x00020000);
    for (int tile = bid; tile < SEQ / 32; tile += nb) {
        const int r0 = 256 + tile * 32;
        __syncthreads();
#pragma unroll
        for (int j = 0; j < 16; ++j) { const int ch = j * NT + tid; if (ch < 62 * 128)
            *(LAS u32x4*)(lds + ch * 16) = bload16(rgl, tid * 16, (r0 - 30) * 2048 + j * 8192); }
        { const int g = __builtin_amdgcn_readfirstlane(tid >> 7);
          if (g == 0) pool_tile<2>(rxp, rpo, r0, tile, tid); else if (g == 1) pool_tile<4>(rxp, rpo, r0, tile, tid); else if (g == 2) pool_tile<8>(rxp, rpo, r0, tile, tid); else pool_tile<16>(rxp, rpo, r0, tile, tid); }
        __syncthreads();
#pragma unroll 1
        for (int hf = 0; hf < 2; ++hf) {
            float c0[16], c1[16];
            {
                float w0[KS], w1[KS];
#pragma unroll
                for (int k = 0; k < KS; ++k) { const u32x2 wv = bload8(rww, tid * 8, k * 4096); w0[k] = __uint_as_float(wv.x); w1[k] = __uint_as_float(wv.y); }
                const u32x2 bvv = bload8(rwb, tid * 8, 0); const float b0 = __uint_as_float(bvv.x), b1 = __uint_as_float(bvv.y);
#pragma unroll
                for (int i = 0; i < 16; ++i) { c0[i] = b0; c1[i] = b1; }
                const LAS unsigned* glh = gl + hf * 16 * 512 + tid;
#pragma unroll
                for (int rr = 0; rr < 46; ++rr) {
                    if ((rr & 7) == 0) asm volatile("" ::: "memory");
                    const unsigned vv = glh[rr * 512]; const float x0 = bf_lo(vv), x1 = bf_hi(vv);
#pragma unroll
                    for (int i = 0; i < 16; ++i) { const int k = rr - i; if (k >= 0 && k < KS) { c0[i] += x0 * w0[k]; c1[i] += x1 * w1[k]; } }
                }
            }
            asm volatile("" ::: "memory");
#pragma unroll
            for (int which = 0; which < 2; ++which) {
                float st[16];
#pragma unroll
                for (int i = 0; i < 16; ++i) st[i] = which == 0 ? c0[i] + c1[i] : c0[i] * c0[i] + c1[i] * c1[i];
#pragma unroll
                for (int lvl = 0; lvl < 4; ++lvl) {
                    const int o = 32 >> lvl, n = 8 >> lvl; const int mk = -((lane >> (5 - lvl)) & 1);
#pragma unroll
                    for (int j = 0; j < 8; ++j) if (j < n) st[j] = fsel(mk, st[j], st[j + n]) + __shfl_xor(fsel(mk, st[j + n], st[j]), o);
                }
                float tot = st[0] + __shfl_xor(st[0], 2); tot += __shfl_xor(tot, 1);
                if ((lane & 3) == 0) red[wave * 32 + which * 16 + (lane >> 2)] = tot;
            }
            __syncthreads();
            if (tid < 32) { float t = 0.f;
#pragma unroll
                for (int q = 0; q < 8; ++q) t += red[q * 32 + tid];
                red[256 + tid] = t; }
            __syncthreads();
            const u32x2 lgv = bload8(rlg, tid * 8, 0), lbv = bload8(rlb, tid * 8, 0); const float lg0 = __uint_as_float(lgv.x), lg1 = __uint_as_float(lgv.y), lb0 = __uint_as_float(lbv.x), lb1 = __uint_as_float(lbv.y);
#pragma unroll
            for (int i = 0; i < 16; ++i) {
                const float s1 = red[256 + i], s2 = red[256 + 16 + i];
                const float mu = s1 * (1.0f / CWD), var = fmaxf(s2 * (1.0f / CWD) - mu * mu, 0.f), rs = rsqrtf(var + 1e-5f);
                const float y0 = (c0[i] - mu) * rs * lg0 + lb0, y1 = (c1[i] - mu) * rs * lg1 + lb1;
                bstore4(rpo, cvt_pk_bf16(y0 * sigmoidf_fast(y0), y1 * sigmoidf_fast(y1)), tid * 4, (tile * 32 + hf * 16 + i) * 4096 + 2048);
            }
            __syncthreads();
        }
    }
}

typedef float f32x16 __attribute__((ext_vector_type(16)));
__device__ __forceinline__ int okey(float s) { const int u = __float_as_int(s); return u ^ ((u >> 31) & 0x7fffffff); }
__device__ __forceinline__ float okey_inv(int k) { return __int_as_float(k ^ ((k >> 31) & 0x7fffffff)); }
__device__ __forceinline__ void sort16_desc(int (&v)[16]) {
#pragma unroll
    for (int k = 2; k <= 16; k <<= 1) {
#pragma unroll
        for (int j = k >> 1; j > 0; j >>= 1) {
#pragma unroll
            for (int i = 0; i < 16; ++i) {
                const int l = i ^ j;
                if (l > i) { const bool desc = (i & k) == 0; const int hi = max(v[i], v[l]), lo = min(v[i], v[l]); v[i] = desc ? hi : lo; v[l] = desc ? lo : hi; }
            }
        }
    }
}
__device__ __forceinline__ void merge16_desc(int (&a)[16], const int (&b)[16]) {
#pragma unroll
    for (int i = 0; i < 16; ++i) a[i] = max(a[i], b[15 - i]);
#pragma unroll
    for (int j = 8; j > 0; j >>= 1) {
#pragma unroll
        for (int i = 0; i < 16; ++i) { const int l = i ^ j; if (l > i) { const int hi = max(a[i], a[l]), lo = min(a[i], a[l]); a[i] = hi; a[l] = lo; } }
    }
}
__device__ __forceinline__ void pair_merge(int (&a)[16]) {
    int b[16];
#pragma unroll
    for (int i = 0; i < 16; ++i) b[i] = __shfl_xor(a[i], 32);
    merge16_desc(a, b);
}
constexpr int CELL_I[64] = {0,0,0,0,0,0,0,0,0,0,0,0,0,0,0,0,1,1,1,1,1,1,1,1,2,2,2,2,2,3,3,3,3,4,4,4,5,5,6,6,7,7,8,9,10,11,12,13,14,15,0,0,0,0,0,0,0,0,0,0,0,0,0,0};
constexpr int CELL_J[64] = {0,1,2,3,4,5,6,7,8,9,10,11,12,13,14,15,0,1,2,3,4,5,6,7,0,1,2,3,4,0,1,2,3,0,1,2,0,1,0,1,0,1,0,0,0,0,0,0,0,0,0,0,0,0,0,0,0,0,0,0,0,0,0,0};
constexpr int NCELL = 50;

struct EpiQTopk {
    static constexpr bool PERM = false;
    static constexpr bool AFTER_DRAIN = true;
    const float* ssq; float* rstd; const bf16_t* keysb; unsigned short* idx; float* gsu;
    __device__ __forceinline__ void fused(const f32x4 (&acc)[2][2][4][2], const pg8::Unit& u, int wr, int wc, int fr, int fq, LAS unsigned char* lds, int wid, int lane) const {
        const int hh = lane >> 5, l31 = lane & 31, h = u.pn;
        LAS float* svt = (LAS float*)(lds + 65536 + (wid * 64 + lane) * 164);
        LAS unsigned char* sit = (LAS unsigned char*)(svt + 32);
        float rs[2][4];
#pragma unroll
        for (int ai = 0; ai < 2; ++ai)
#pragma unroll
            for (int m = 0; m < 4; ++m) {
                const size_t row = (size_t)(u.pm * 256 + ai * 128 + wr * 64 + m * 16 + fr);
                const f32x4* sp = (const f32x4*)(ssq + row * 32); f32x4 t = sp[0];
#pragma unroll
                for (int i = 1; i < 8; ++i) t += sp[i];
                rs[ai][m] = rsqrtf(((t[0] + t[1]) + (t[2] + t[3])) * (1.0f / D) + 1e-6f);
                if (u.pn == 0 && wc == 0 && fq == 0) rstd[row] = rs[ai][m];
            }
        const int trow = wid * 32 + l31;
#pragma unroll
        for (int ph = 0; ph < 2; ++ph) {
#pragma unroll
            for (int ai = 0; ai < 2; ++ai)
#pragma unroll
                for (int m = 0; m < 4; ++m) { const int row = ai * 128 + wr * 64 + m * 16 + fr;
#pragma unroll
                    for (int n = 0; n < 2; ++n) { const f32x4 v = acc[ai][ph][m][n] * rs[ai][m]; const int chunk = 4 * wc + 2 * n + (fq >> 1);
                        u32x2 w; w.x = cvt_pk_bf16(v[0], v[1]); w.y = cvt_pk_bf16(v[2], v[3]);
                        *(LAS u32x2*)(lds + row * 256 + ((chunk ^ (row & 15)) << 4) + (fq & 1) * 8) = w; } }
            __syncthreads();
            const bf16_t* krow = keysb + ((size_t)(h * 2 + ph) * 128 + l31) * 128 + 8 * hh;
            bf16x8 bq[8];
#pragma unroll
            for (int ks = 0; ks < 8; ++ks) bq[ks] = *(const LAS bf16x8*)(lds + trow * 256 + (((ks * 2 + hh) ^ (trow & 15)) << 4));
            int top[16];
#pragma unroll
            for (int i = 0; i < 16; ++i) top[i] = (int)0x80000000;
            bf16x8 ak[8];
#pragma unroll
            for (int ks = 0; ks < 8; ++ks) ak[ks] = *(const bf16x8*)(krow + ks * 16);
#pragma unroll 1
            for (int kt = 0; kt < 4; ++kt) {
                f32x16 c = {0.f, 0.f, 0.f, 0.f, 0.f, 0.f, 0.f, 0.f, 0.f, 0.f, 0.f, 0.f, 0.f, 0.f, 0.f, 0.f};
#pragma unroll
                for (int ks = 0; ks < 8; ++ks) c = __builtin_amdgcn_mfma_f32_32x32x16_bf16(ak[ks], bq[ks], c, 0, 0, 0);
                { const int kn = kt < 3 ? kt + 1 : 3;
#pragma unroll
                  for (int ks = 0; ks < 8; ++ks) ak[ks] = *(const bf16x8*)(krow + (size_t)kn * 32 * 128 + ks * 16); }
                int v[16];
                const int lowb = (127 - kt * 32) ^ (hh << 2);
#pragma unroll
                for (int r = 0; r < 16; ++r) v[r] = (okey(c[r]) & ~127) | (lowb - ((r & 3) + 8 * (r >> 2)));
                sort16_desc(v);
                merge16_desc(top, v);
            }
            pair_merge(top);
#pragma unroll
            for (int i = 0; i < 16; ++i) { svt[ph * 16 + i] = okey_inv(top[i] & ~127); sit[ph * 16 + i] = (unsigned char)(127 - (top[i] & 127)); }
            __syncthreads();
        }
        float sv[2][16];
#pragma unroll
        for (int i = 0; i < 16; ++i) { sv[0][i] = svt[i]; sv[1][i] = svt[16 + i]; }
        int w0[16], w1[16];
#pragma unroll
        for (int s = 0; s < 32; ++s) {
            const int e0 = 2 * s, e1 = 2 * s + 1;
            int key;
            if (e0 >= NCELL) key = (int)0x80000000;
            else {
                const float v0 = sv[0][CELL_I[e0]] + sv[1][CELL_J[e0]];
                const int k0 = (okey(v0) & ~255) | (255 - (CELL_I[e0] * 16 + CELL_J[e0]));
                if (e1 >= NCELL) key = hh ? (int)0x80000000 : k0;
                else { const float v1 = sv[0][CELL_I[e1]] + sv[1][CELL_J[e1]];
                    const int k1 = (okey(v1) & ~255) | (255 - (CELL_I[e1] * 16 + CELL_J[e1]));
                    key = hh ? k1 : k0; }
            }
            if (s < 16) w0[s] = key; else w1[s - 16] = key;
        }
        sort16_desc(w0); sort16_desc(w1); merge16_desc(w0, w1); pair_merge(w0);
        const float mx = okey_inv(w0[0] & ~255);
        float sum = 0.f;
#pragma unroll
        for (int k = 0; k < 16; ++k) sum += __expf(okey_inv(w0[k] & ~255) - mx);
        const float inv = 1.0f / sum;
        int eo[8]; float go[8]; const int hmask = -hh;
#pragma unroll
        for (int k = 0; k < 8; ++k) { const int kk = (w0[k] & ~hmask) | (w0[8 + k] & hmask); const int cc = 255 - (kk & 255);
            eo[k] = (int)sit[cc >> 4] * 128 + (int)sit[16 + (cc & 15)]; go[k] = __expf(okey_inv(kk & ~255) - mx) * inv; }
        const size_t ob = (size_t)(u.pm * 256 + trow) * 128 + h * 16 + hh * 8;
        *(u32x4*)(idx + ob) = (u32x4){(unsigned)eo[0] | ((unsigned)eo[1] << 16), (unsigned)eo[2] | ((unsigned)eo[3] << 16), (unsigned)eo[4] | ((unsigned)eo[5] << 16), (unsigned)eo[6] | ((unsigned)eo[7] << 16)};
        *(f32x4*)(gsu + ob) = (f32x4){go[0], go[1], go[2], go[3]};
        *(f32x4*)(gsu + ob + 4) = (f32x4){go[4], go[5], go[6], go[7]};
    }
    __device__ __forceinline__ void operator()(const f32x4 (&)[2][2][4][2], const pg8::Unit&, int, int, int, int) const {}
};

__device__ __forceinline__ void fp8_row2(const float* s0, unsigned char* d0, float* i0, const float* s1, unsigned char* d1, float* i1, int lane) {
    f32x4 v[2][2][4]; float am[2] = {0.f, 0.f};
#pragma unroll
    for (int r = 0; r < 2; ++r)
#pragma unroll
        for (int k = 0; k < 2; ++k)
#pragma unroll
            for (int i = 0; i < 4; ++i) v[r][k][i] = __builtin_nontemporal_load((const f32x4*)((r ? s1 : s0) + 1024 * k + 16 * lane + 4 * i));
#pragma unroll
    for (int r = 0; r < 2; ++r) {
#pragma unroll
        for (int k = 0; k < 2; ++k)
#pragma unroll
            for (int i = 0; i < 4; ++i) am[r] = fmaxf(am[r], fmaxf(fmaxf(fabsf(v[r][k][i].x), fabsf(v[r][k][i].y)), fmaxf(fabsf(v[r][k][i].z), fabsf(v[r][k][i].w))));
#pragma unroll
        for (int o = 1; o < 64; o <<= 1) am[r] = fmaxf(am[r], __shfl_xor(am[r], o));
        int be = (__float_as_int(am[r]) >> 23) & 255; be = be < 8 ? 8 : (be > 248 ? 248 : be);
        const float sc = __int_as_float((260 - be) << 23), isc = __int_as_float((be - 6) << 23);
#pragma unroll
        for (int k = 0; k < 2; ++k) { u32x4 w; unsigned ww[4];
#pragma unroll
            for (int i = 0; i < 4; ++i) { int t = 0; t = __builtin_amdgcn_cvt_pk_fp8_f32(v[r][k][i].x * sc, v[r][k][i].y * sc, t, false); t = __builtin_amdgcn_cvt_pk_fp8_f32(v[r][k][i].z * sc, v[r][k][i].w * sc, t, true); ww[i] = (unsigned)t; }
            w.x = ww[0]; w.y = ww[1]; w.z = ww[2]; w.w = ww[3];
            *(u32x4*)((r ? d1 : d0) + 1024 * k + 16 * lane) = w; }
        if (lane == 0) *(r ? i1 : i0) = isc;
    }
}

typedef float f32x2 __attribute__((ext_vector_type(2)));
template <int N> __device__ __forceinline__ f32x2 dot16_fp8(const u32x4 w, const f32x2 (&x)[N], int o, f32x2 acc) {
    const unsigned ww[4] = {w.x, w.y, w.z, w.w};
#pragma unroll
    for (int d = 0; d < 4; ++d) { acc += __builtin_amdgcn_cvt_pk_f32_fp8((int)ww[d], false) * x[o + 2 * d]; acc += __builtin_amdgcn_cvt_pk_f32_fp8((int)ww[d], true) * x[o + 2 * d + 1]; }
    return acc;
}
template <int N> __device__ __forceinline__ void axpy16_fp8(const u32x4 w, float a, f32x2 (&y)[N], int o) {
    const unsigned ww[4] = {w.x, w.y, w.z, w.w}; const f32x2 a2 = {a, a};
#pragma unroll
    for (int d = 0; d < 4; ++d) { y[o + 2 * d] += a2 * __builtin_amdgcn_cvt_pk_f32_fp8((int)ww[d], false); y[o + 2 * d + 1] += a2 * __builtin_amdgcn_cvt_pk_f32_fp8((int)ww[d], true); }
}
__device__ __forceinline__ void bstore16(__amdgpu_buffer_rsrc_t r, f32x4 v, int voff, int soff) { __builtin_amdgcn_raw_buffer_store_b128(__builtin_bit_cast(__attribute__((__vector_size__(4 * sizeof(unsigned)))) unsigned, v), r, voff, soff, 0); }
__device__ __forceinline__ void bstore8(__amdgpu_buffer_rsrc_t r, f32x2 v, int voff, int soff) { __builtin_amdgcn_raw_buffer_store_b64(__builtin_bit_cast(__attribute__((__vector_size__(2 * sizeof(unsigned)))) unsigned, v), r, voff, soff, 0); }
__device__ __forceinline__ f32x2 fsel2(int mask, f32x2 a, f32x2 b) { return (f32x2){fsel(mask, a.x, b.x), fsel(mask, a.y, b.y)}; }
__device__ __forceinline__ f32x2 shx2(f32x2 a, int o) { return (f32x2){__shfl_xor(a.x, o), __shfl_xor(a.y, o)}; }

__device__ __forceinline__ void phase_pd(const Params& p, LAS unsigned char* lds, int bid, int nb) {
    const int tid = threadIdx.x, lane = tid & 63, wave = __builtin_amdgcn_readfirstlane(tid >> 6);
    if (wave == 7) {
        for (int e = bid; e < 16384; e += 2 * nb) { const int e2 = e + nb < 16384 ? e + nb : e;
            fp8_row2(p.up + (size_t)e * D, p.up8 + (size_t)e * D, p.sup + e, p.up + (size_t)e2 * D, p.up8 + (size_t)e2 * D, p.sup + e2, lane); }
        return;
    }
    const int v = bid & 7, lw = (bid >> 3) * 7 + wave, NLW = (nb >> 3) * 7;
    const int c = lane & 7, sub = lane >> 3;
    const int m0 = -(lane & 1), m1 = -((lane >> 1) & 1), m2 = -((lane >> 2) & 1);
    const __amdgpu_buffer_rsrc_t rd = __builtin_amdgcn_make_buffer_rsrc((void*)p.down8, 0, 16384 * D, 0x00020000);
    const __amdgpu_buffer_rsrc_t rh = __builtin_amdgcn_make_buffer_rsrc((void*)p.h2b, 0, SEQ * D * 2, 0x00020000);
    const __amdgpu_buffer_rsrc_t rg1 = __builtin_amdgcn_make_buffer_rsrc((void*)p.ffn_g, 0, D * 4, 0x00020000);
    const __amdgpu_buffer_rsrc_t ri = __builtin_amdgcn_make_buffer_rsrc((void*)p.idx, 0, SEQ * 128 * 2, 0x00020000);
    const __amdgpu_buffer_rsrc_t rrs = __builtin_amdgcn_make_buffer_rsrc((void*)p.rstd, 0, SEQ * 4, 0x00020000);
    const __amdgpu_buffer_rsrc_t rp = __builtin_amdgcn_make_buffer_rsrc((void*)p.part, 0, SEQ * 8 * 128 * 2, 0x00020000);
    LAS f32x2* pl = (LAS f32x2*)lds + wave * (40 * 64) + lane;
    const int vsub = sub * 32, vc2 = c * 32, vc1 = c * 16, vl4 = lane * 4;
#pragma unroll 1
    for (int pass = 0; pass < 2; ++pass) {
        const int sl = v * 2 + pass;
        f32x2 gs[8];
#pragma unroll
        for (int i = 0; i < 4; ++i) { const f32x4 g = __builtin_bit_cast(f32x4, bload16(rg1, c * 64, sl * 512 + i * 16)); gs[2 * i] = (f32x2){g[0], g[1]}; gs[2 * i + 1] = (f32x2){g[2], g[3]}; }
        u32x4 ix[2], hh[2]; unsigned rsb;
        {
            const int t = lw;
#pragma unroll
            for (int i = 0; i < 2; ++i) ix[i] = bload16(ri, vsub, t * 256 + i * 16);
            hh[0] = bload16(rh, vc2, t * 4096 + sl * 256); hh[1] = bload16(rh, vc2, t * 4096 + sl * 256 + 16); rsb = bload4(rrs, 0, t * 4);
        }
        int trip = 0;
#pragma unroll 1
        for (int t = lw; t < SEQ; t += NLW) {
            asm volatile("" ::: "memory");
            u32x4 w[16];
            {
                const unsigned ew[8] = {ix[0].x, ix[0].y, ix[0].z, ix[0].w, ix[1].x, ix[1].y, ix[1].z, ix[1].w};
#pragma unroll
                for (int g = 0; g < 16; ++g) { const unsigned e = (g & 1) ? (ew[g >> 1] >> 16) : (ew[g >> 1] & 0xffffu); w[g] = bload16(rd, (int)(e * 2048u) + vc1, sl * 128); }
            }
            f32x2 xs[8];
            {
                const float rs = __uint_as_float(rsb);
                const unsigned hw[8] = {hh[0].x, hh[0].y, hh[0].z, hh[0].w, hh[1].x, hh[1].y, hh[1].z, hh[1].w};
#pragma unroll
                for (int i = 0; i < 8; ++i) xs[i] = (f32x2){bf_lo(hw[i]) * rs, bf_hi(hw[i]) * rs} * gs[i];
            }
            asm volatile("" ::: "memory");
            {
                const int tn = t + NLW < SEQ ? t + NLW : t;
#pragma unroll
                for (int i = 0; i < 2; ++i) ix[i] = bload16(ri, vsub, tn * 256 + i * 16);
                hh[0] = bload16(rh, vc2, tn * 4096 + sl * 256); hh[1] = bload16(rh, vc2, tn * 4096 + sl * 256 + 16); rsb = bload4(rrs, 0, tn * 4);
            }
            asm volatile("" ::: "memory");
            float r[16];
#pragma unroll
            for (int g = 0; g < 16; ++g) { const f32x2 z = {0.f, 0.f}; const f32x2 s2 = dot16_fp8(w[g], xs, 0, z); r[g] = s2.x + s2.y; }
            float k8[8], k4[4];
#pragma unroll
            for (int i = 0; i < 8; ++i) k8[i] = fsel(m2, r[i], r[i + 8]) + __shfl_xor(fsel(m2, r[i + 8], r[i]), 4);
#pragma unroll
            for (int i = 0; i < 4; ++i) k4[i] = fsel(m1, k8[i], k8[i + 4]) + __shfl_xor(fsel(m1, k8[i + 4], k8[i]), 2);
            const float k0 = fsel(m0, k4[0], k4[2]) + __shfl_xor(fsel(m0, k4[2], k4[0]), 1);
            const float k1 = fsel(m0, k4[1], k4[3]) + __shfl_xor(fsel(m0, k4[3], k4[1]), 1);
            if (pass == 0) pl[trip * 64] = (f32x2){k0, k1};
            else { const f32x2 pv = pl[trip * 64]; bstore4(rp, cvt_pk_bf16(k0 + pv.x, k1 + pv.y), vl4, (t * 8 + v) * 256); }
            ++trip;
        }
    }
}
__device__ __forceinline__ void phase_pa(const Params& p, int bid, int nb) {
    const int tid = threadIdx.x, lane = tid & 63, wave = tid >> 6;
    const int gw = bid * 8 + wave, NGW = nb * 8;
    for (int it = gw; it < SEQ * 2; it += NGW) {
        const int t = it >> 1, pp = (it & 1) * 64 + lane;
        const bf16_t* pr = p.part + (size_t)t * 1024 + pp;
        float hs = 0.f;
#pragma unroll
        for (int sl = 0; sl < 8; ++sl) hs += __uint_as_float((unsigned)pr[sl * 128] << 16);
        const int e = (int)p.idx[(size_t)t * 128 + pp];
        hs *= p.sdn[e];
        const float av = p.gsu[(size_t)t * 128 + pp] * p.sup[e] * 0.5f * hs * (1.0f + erff(hs * 0.70710678118654752f));
        p.act[(size_t)t * 128 + pp] = (bf16_t)(cvt_pk_bf16(av, 0.f) & 0xffffu);
    }
}
__device__ __forceinline__ void phase_pu(const Params& p, int bid, int nb) {
    const int tid = threadIdx.x, lane = tid & 63, wave = __builtin_amdgcn_readfirstlane(tid >> 6);
    const int v = bid & 7, lw = (bid >> 3) * 8 + wave, NLW = (nb >> 3) * 8;
    const int c = lane & 7, sub = lane >> 3;
    const int m3 = -((lane >> 3) & 1), m4 = -((lane >> 4) & 1), m5 = -((lane >> 5) & 1);
    const __amdgpu_buffer_rsrc_t ru = __builtin_amdgcn_make_buffer_rsrc((void*)p.up8, 0, 16384 * D, 0x00020000);
    const __amdgpu_buffer_rsrc_t rh = __builtin_amdgcn_make_buffer_rsrc((void*)p.h2b, 0, SEQ * D * 2, 0x00020000);
    const __amdgpu_buffer_rsrc_t ri = __builtin_amdgcn_make_buffer_rsrc((void*)p.idx, 0, SEQ * 128 * 2, 0x00020000);
    const __amdgpu_buffer_rsrc_t ra = __builtin_amdgcn_make_buffer_rsrc((void*)p.act, 0, SEQ * 128 * 2, 0x00020000);
    const __amdgpu_buffer_rsrc_t ro = __builtin_amdgcn_make_buffer_rsrc((void*)p.h3b, 0, SEQ * D * 2, 0x00020000);
    const __amdgpu_buffer_rsrc_t rq = __builtin_amdgcn_make_buffer_rsrc((void*)p.ssq2, 0, SEQ * 16 * 4, 0x00020000);
    const int vsub = sub * 32, vc1 = c * 16, vh = c * 32 + sub * 4;
#pragma unroll 1
    for (int pass = 0; pass < 2; ++pass) {
        const int sl = v * 2 + pass;
        u32x4 ix[2], ac[2]; unsigned hb;
        {
            const int t = lw;
#pragma unroll
            for (int i = 0; i < 2; ++i) { ix[i] = bload16(ri, vsub, t * 256 + i * 16); ac[i] = bload16(ra, vsub, t * 256 + i * 16); }
            hb = bload4(rh, vh, t * 4096 + sl * 256);
        }
#pragma unroll 1
        for (int t = lw; t < SEQ; t += NLW) {
            asm volatile("" ::: "memory");
            u32x4 w[16];
            {
                const unsigned ew[8] = {ix[0].x, ix[0].y, ix[0].z, ix[0].w, ix[1].x, ix[1].y, ix[1].z, ix[1].w};
#pragma unroll
                for (int g = 0; g < 16; ++g) { const unsigned e = (g & 1) ? (ew[g >> 1] >> 16) : (ew[g >> 1] & 0xffffu); w[g] = bload16(ru, (int)(e * 2048u) + vc1, sl * 128); }
            }
            const unsigned aw[8] = {ac[0].x, ac[0].y, ac[0].z, ac[0].w, ac[1].x, ac[1].y, ac[1].z, ac[1].w};
            float a[16];
#pragma unroll
            for (int g = 0; g < 16; ++g) a[g] = (g & 1) ? bf_hi(aw[g >> 1]) : bf_lo(aw[g >> 1]);
            const unsigned hcur = hb;
            asm volatile("" ::: "memory");
            {
                const int tn = t + NLW < SEQ ? t + NLW : t;
#pragma unroll
                for (int i = 0; i < 2; ++i) { ix[i] = bload16(ri, vsub, tn * 256 + i * 16); ac[i] = bload16(ra, vsub, tn * 256 + i * 16); }
                hb = bload4(rh, vh, tn * 4096 + sl * 256);
            }
            asm volatile("" ::: "memory");
            f32x2 acc[8];
#pragma unroll
            for (int i = 0; i < 8; ++i) acc[i] = (f32x2){0.f, 0.f};
#pragma unroll
            for (int g = 0; g < 16; ++g) axpy16_fp8(w[g], a[g], acc, 0);
            f32x2 k4[4], k2[2];
#pragma unroll
            for (int i = 0; i < 4; ++i) k4[i] = fsel2(m5, acc[i], acc[i + 4]) + shx2(fsel2(m5, acc[i + 4], acc[i]), 32);
#pragma unroll
            for (int i = 0; i < 2; ++i) k2[i] = fsel2(m4, k4[i], k4[i + 2]) + shx2(fsel2(m4, k4[i + 2], k4[i]), 16);
            f32x2 h3 = fsel2(m3, k2[0], k2[1]) + shx2(fsel2(m3, k2[1], k2[0]), 8);
            h3 += (f32x2){bf_lo(hcur), bf_hi(hcur)};
            bstore4(ro, cvt_pk_bf16(h3.x, h3.y), vh, t * 4096 + sl * 256);
            const float ss = wave_sum(h3.x * h3.x + h3.y * h3.y);
            if (lane == 0) bstore4(rq, __float_as_uint(ss), 0, (t * 16 + sl) * 4);
        }
    }
}
__device__ __forceinline__ void phase_pf(const Params& p, int bid, int nb) {
    const int tid = threadIdx.x, lane = tid & 63, wave = tid >> 6;
    const int gw = bid * 8 + wave, NGW = nb * 8;
    for (int t = gw; t < SEQ; t += NGW) {
        const f32x4* sp = (const f32x4*)(p.ssq2 + (size_t)t * 16); f32x4 q = sp[0] + sp[1] + sp[2] + sp[3];
        const float rf = rsqrtf(((q[0] + q[1]) + (q[2] + q[3])) * (1.0f / D) + 1e-6f);
        const u32x4* hp = (const u32x4*)(p.h3b + (size_t)t * D) + lane;
        f32x4* o = (f32x4*)(p.out + (size_t)t * D) + 2 * lane; const f32x4* g = (const f32x4*)p.fin_g + 2 * lane;
#pragma unroll
        for (int j = 0; j < 4; ++j) { const u32x4 h = hp[64 * j]; const f32x4 g0 = g[128 * j], g1 = g[128 * j + 1];
            o[128 * j] = (f32x4){bf_lo(h.x) * rf * g0[0], bf_hi(h.x) * rf * g0[1], bf_lo(h.y) * rf * g0[2], bf_hi(h.y) * rf * g0[3]};
            o[128 * j + 1] = (f32x4){bf_lo(h.z) * rf * g1[0], bf_hi(h.z) * rf * g1[1], bf_lo(h.w) * rf * g1[2], bf_hi(h.w) * rf * g1[3]}; }
    }
}

__device__ __forceinline__ void fp8_row(const float* src, unsigned char* dst, float* inv_scale, int lane) {
    f32x4 v[2][4]; float am = 0.f;
#pragma unroll
    for (int k = 0; k < 2; ++k)
#pragma unroll
        for (int i = 0; i < 4; ++i) { v[k][i] = *(const f32x4*)(src + 1024 * k + 16 * lane + 4 * i);
            am = fmaxf(am, fmaxf(fmaxf(fabsf(v[k][i].x), fabsf(v[k][i].y)), fmaxf(fabsf(v[k][i].z), fabsf(v[k][i].w)))); }
#pragma unroll
    for (int o = 1; o < 64; o <<= 1) am = fmaxf(am, __shfl_xor(am, o));
    int be = (__float_as_int(am) >> 23) & 255; be = be < 8 ? 8 : (be > 248 ? 248 : be);
    const float sc = __int_as_float((260 - be) << 23), isc = __int_as_float((be - 6) << 23);
#pragma unroll
    for (int k = 0; k < 2; ++k) { u32x4 w; unsigned ww[4];
#pragma unroll
        for (int i = 0; i < 4; ++i) { int t = 0; t = __builtin_amdgcn_cvt_pk_fp8_f32(v[k][i].x * sc, v[k][i].y * sc, t, false); t = __builtin_amdgcn_cvt_pk_fp8_f32(v[k][i].z * sc, v[k][i].w * sc, t, true); ww[i] = (unsigned)t; }
        w.x = ww[0]; w.y = ww[1]; w.z = ww[2]; w.w = ww[3];
        *(u32x4*)(dst + 1024 * k + 16 * lane) = w; }
    if (lane == 0) *inv_scale = isc;
}

__device__ __forceinline__ void tr_item(const float* W, int ldw, int srccol0, int k0, bf16_t* WT, int ldt, int n0, const float* kscale, const float* nscale, LAS float* scr, int lane) {
    float tv[32];
#pragma unroll
    for (int i = 0; i < 32; ++i) { const int kk = 2 * i + (lane >> 5); tv[i] = W[(size_t)(k0 + kk) * ldw + srccol0 + (lane & 31)]; }
    const float ns = nscale ? nscale[srccol0 + (lane & 31)] : 1.0f;
#pragma unroll
    for (int i = 0; i < 32; ++i) { const int kk = 2 * i + (lane >> 5); float v = tv[i] * ns;
        if (kscale) v *= kscale[k0 + kk]; scr[kk * 33 + (lane & 31)] = v; }
    asm volatile("s_waitcnt lgkmcnt(0)" ::: "memory");
    const int c = lane & 7;
#pragma unroll
    for (int j = 0; j < 4; ++j) { const int n = (lane >> 3) + 8 * j; const LAS float* s = scr + (8 * c) * 33 + n;
        u32x4 o; o.x = cvt_pk_bf16(s[0 * 33], s[1 * 33]); o.y = cvt_pk_bf16(s[2 * 33], s[3 * 33]); o.z = cvt_pk_bf16(s[4 * 33], s[5 * 33]); o.w = cvt_pk_bf16(s[6 * 33], s[7 * 33]);
        *(u32x4*)(WT + (size_t)(n0 + n) * ldt + k0 + 8 * c) = o; }
    asm volatile("s_waitcnt lgkmcnt(0)" ::: "memory");
}
__device__ __forceinline__ int win_srccol(int n) { const int pn = n >> 8, w = n & 255; return pn < 4 ? n : ((w >> 7) ? 2048 : 1024) + (pn - 4) * 128 + (w & 127); }

__device__ __forceinline__ void phase_prep(const Params& p, LAS unsigned char* lds, int bid, int nb) {
    const int tid = threadIdx.x, lane = tid & 63, wave = tid >> 6;
    const int gw = bid * 8 + wave, NGW = nb * 8;
    LAS float* scr = (LAS float*)(lds + wave * 8448);
    for (int r = gw; r < RT; r += NGW) {
        unsigned long long* o8 = (unsigned long long*)(p.hnb + (size_t)r * D) + lane;
        if (r < RPAD) {
#pragma unroll
            for (int j = 0; j < 8; ++j) o8[64 * j] = 0ull;
            if (lane == 0) p.rstd1[r] = 0.f;
        } else {
            const f32x4* xr = (const f32x4*)hrow(p, r - RPAD) + lane;
            f32x4 v[8]; float s = 0.f;
#pragma unroll
            for (int j = 0; j < 8; ++j) { v[j] = __builtin_nontemporal_load(xr + 64 * j); s += (v[j].x * v[j].x + v[j].y * v[j].y) + (v[j].z * v[j].z + v[j].w * v[j].w); }
            const float rs = rsqrtf(wave_sum(s) * (1.0f / D) + 1e-6f);
            if (lane == 0) p.rstd1[r] = rs;
#pragma unroll
            for (int j = 0; j < 8; ++j)
                o8[64 * j] = (unsigned long long)cvt_pk_bf16(v[j].x, v[j].y) | ((unsigned long long)cvt_pk_bf16(v[j].z, v[j].w) << 32);
        }
    }
    for (int it = gw; it < (D / 64) * (INW / 32); it += NGW) {
        const int kb = it / (INW / 32), nbk = it % (INW / 32);
        tr_item(p.w_in, INW, win_srccol(nbk * 32), kb * 64, p.w_in_t, D, nbk * 32, p.mix_g, nullptr, scr, lane);
    }
    for (int i = gw * 64 + lane; i < 4 * 256 * 256 / 4; i += NGW * 64) { const f32x4 v = ((const f32x4*)p.pool_w)[i];
        const int g = i >> 14, d = (i & 63) * 4; const f32x4 sc = *(const f32x4*)(p.pool_scale + g * 256 + d);
        u32x2 w; w.x = cvt_pk_bf16(v[0] * sc[0], v[1] * sc[1]); w.y = cvt_pk_bf16(v[2] * sc[2], v[3] * sc[3]); ((u32x2*)p.pool_ws)[i] = w; }
    for (int i = gw * 64 + lane; i < CWD * CWD / 4; i += NGW * 64) { const f32x4 v = ((const f32x4*)p.pw_w)[i];
        u32x2 w; w.x = cvt_pk_bf16(v[0], v[1]); w.y = cvt_pk_bf16(v[2], v[3]); ((u32x2*)p.pw_b16)[i] = w; }
    for (int it = gw; it < 32 * 64; it += NGW) { const int kb = it >> 6, nbk = it & 63;
        tr_item(p.w_out, D, nbk * 32, kb * 64, p.w_out_t, D, nbk * 32, nullptr, nullptr, scr, lane); }
    for (int it = gw; it < 32 * 64; it += NGW) { const int kb = it >> 6, nbk = it & 63;
        tr_item(p.wq, D, nbk * 32, kb * 64, p.wq_t, D, nbk * 32, p.ffn_g, nullptr, scr, lane); }
    for (int i = gw * 64 + lane; i < 8 * 2 * 128 * 128 / 4; i += NGW * 64) { const f32x4 v = ((const f32x4*)p.keys)[i];
        u32x2 w; w.x = cvt_pk_bf16(v[0], v[1]); w.y = cvt_pk_bf16(v[2], v[3]); ((u32x2*)p.keysb)[i] = w; }
    for (int e = gw; e < 16384; e += 2 * NGW) { const int e2 = e + NGW < 16384 ? e + NGW : e;
        fp8_row2(p.down + (size_t)e * D, p.down8 + (size_t)e * D, p.sdn + e, p.down + (size_t)e2 * D, p.down8 + (size_t)e2 * D, p.sdn + e2, lane); }
}


#define XB_TMO      128
#define XB_XCNT(j)  (256  + 64 * (j))
#define XB_XSUB(j)  (1280 + 64 * (j))
#define XB_XGEN(j)  (2304 + 64 * (j))
#define XB_TOP      3328
#define XB_TOPGEN   3392
#define XCD_BAR_WORDS 3456
#define XB_SPIN_CAP (1u << 18)
__device__ __forceinline__ unsigned xb_ld(unsigned* p)              { return __hip_atomic_load(p, __ATOMIC_RELAXED, __HIP_MEMORY_SCOPE_AGENT); }
__device__ __forceinline__ unsigned xb_add(unsigned* p, unsigned v) { return __hip_atomic_fetch_add(p, v, __ATOMIC_RELAXED, __HIP_MEMORY_SCOPE_AGENT); }
__device__ __forceinline__ unsigned xb_xcc_id() { return (unsigned)__builtin_amdgcn_s_getreg((3 << 11) | 20) & 0xFu; }
#define XB_SPIN(cond, bar) do { unsigned _sp = 0; while (cond) { __builtin_amdgcn_s_sleep(1); \
    if ((++_sp & 255u) == 0u) { if (xb_ld(&(bar)[XB_TMO])) break; if (_sp > XB_SPIN_CAP) { atomicAdd(&(bar)[XB_TMO], 1u); break; } } } } while (0)
struct XcdBarrier { unsigned* bar; unsigned x; volatile LAS unsigned* st; };
__device__ __forceinline__ XcdBarrier xcd_barrier_post(unsigned* bar, volatile LAS unsigned* st) {
    XcdBarrier b; b.bar = bar; b.x = xb_xcc_id(); b.st = st;
    if (threadIdx.x == 0) (void)xb_add(&bar[XB_XCNT(b.x)], 1u);
    return b;
}
__device__ __forceinline__ void xcd_barrier_complete(unsigned* bar, unsigned x, unsigned& nloc, unsigned& nx) {
    const unsigned G = gridDim.x * gridDim.y * gridDim.z;
    unsigned sum, cnt, mine, sp = 0u;
    for (;;) {
        sum = 0u; cnt = 0u; mine = 0u;
#pragma unroll
        for (unsigned j = 0; j < 16; ++j) { const unsigned c = xb_ld(&bar[XB_XCNT(j)]); sum += c; cnt += (c > 0u) ? 1u : 0u; mine = (j == x) ? c : mine; }
        if (sum == G) break;
        __builtin_amdgcn_s_sleep(1);
        if ((++sp & 255u) == 0u) { if (xb_ld(&bar[XB_TMO])) break; if (sp > XB_SPIN_CAP) { atomicAdd(&bar[XB_TMO], 1u); break; } }
    }
    nloc = mine > 0u ? mine : 1u; nx = cnt > 0u ? cnt : 1u;
}
__device__ __forceinline__ void xcd_barrier(const XcdBarrier& b) {
    asm volatile("s_waitcnt vmcnt(0)" ::: "memory");
    __syncthreads();
    if (threadIdx.x == 0) {
        unsigned* bar = b.bar;
        __builtin_amdgcn_s_waitcnt(0);
        unsigned nloc = b.st[0], nx = b.st[1];
        if (nloc == 0u) { xcd_barrier_complete(bar, b.x, nloc, nx); b.st[0] = nloc; b.st[1] = nx; }
        const unsigned old = xb_add(&bar[XB_XSUB(b.x)], 1u);
        const unsigned gen = old / nloc;
        if (old + 1u == (gen + 1u) * nloc) {
            __builtin_amdgcn_fence(__ATOMIC_RELEASE, "agent");
            asm volatile("s_waitcnt vmcnt(0)" ::: "memory");
            const unsigned og = xb_add(&bar[XB_TOP], 1u);
            const unsigned tg = og / nx;
            if (og + 1u == (tg + 1u) * nx) xb_add(&bar[XB_TOPGEN], 1u);
            else XB_SPIN(xb_ld(&bar[XB_TOPGEN]) == tg, bar);
            __builtin_amdgcn_fence(__ATOMIC_ACQUIRE, "agent");
            xb_add(&bar[XB_XGEN(b.x)], 1u);
            asm volatile("s_waitcnt vmcnt(0)" ::: "memory");
        } else {
            XB_SPIN(xb_ld(&bar[XB_XGEN(b.x)]) == gen, bar);
            __builtin_amdgcn_fence(__ATOMIC_ACQUIRE, "agent");
            asm volatile("s_waitcnt vmcnt(0)" ::: "memory");
        }
    }
    __syncthreads();
}

__global__ void __launch_bounds__(NT, 2) k_mega(Params p) {
    extern __shared__ __attribute__((aligned(16))) unsigned char lds_raw[];
    LAS unsigned char* lds = (LAS unsigned char*)lds_raw;
    const int bid = blockIdx.x, nb = gridDim.x;
    volatile LAS unsigned* bst = (volatile LAS unsigned*)(lds + LDS_BYTES - 16);
    if (threadIdx.x < 4) bst[threadIdx.x] = 0u;
    __syncthreads();
    const XcdBarrier xb = xcd_barrier_post(p.bar, bst);
    phase_prep(p, lds, bid, nb);
    xcd_barrier(xb);
    { pg8::Gemm g{p.hnb, p.w_in_t, D, D, D, 0}; pg8::StaticOrder S; S.init(RT / 256, INW / 256, nb, bid); EpiProj E{p.xp, p.glu, p.rstd1};
      pg8::gemm_phase<EpiProj, pg8::StaticOrder>(lds, g, S, E); }
    { const int nproj = (RT / 256) * (INW / 256); const int first = (nproj > nb && nproj < 2 * nb) ? nproj - nb : 0, nfree = nb - first;
      for (int uu = bid - first; uu >= 0 && uu < 64; uu += nfree) {
        __syncthreads();
        const bool pw = uu < 32;
        pg8::Gemm g{pw ? p.w_out_t + PWD : p.w_out_t, pw ? p.pw_b16 : p.pool_ws, D, pw ? CWD : 256, pw ? CWD : 256, pw ? 0 : 256};
        pg8::OneUnit S; S.u.pm = (uu & 31) >> 2; S.u.pn = uu & 3; EpiBf16Out E{p.w_eff_t, D, pw ? PWD : 0, nullptr};
        pg8::gemm_phase<EpiBf16Out, pg8::OneUnit>(lds, g, S, E);
      }
      { const int b0 = nfree >= 96 ? first + 64 : 0;
        for (int nbk = bid - b0; nbk >= 0 && nbk < D / 64; nbk += nb) {
          __syncthreads();
          const int lane = threadIdx.x & 63, wv = threadIdx.x >> 6, n = nbk * 64 + lane;
          float a[8] = {0.f, 0.f, 0.f, 0.f, 0.f, 0.f, 0.f, 0.f};
          for (int j = wv * 128; j < wv * 128 + 128; j += 8) {
#pragma unroll
            for (int q = 0; q < 8; ++q) a[q] += p.pw_b[j + q] * p.w_out[(size_t)(PWD + j + q) * D + n]; }
          LAS float* red = (LAS float*)lds;
          red[wv * 64 + lane] = ((a[0] + a[1]) + (a[2] + a[3])) + ((a[4] + a[5]) + (a[6] + a[7]));
          __syncthreads();
          if (wv == 0) { float t = 0.f;
#pragma unroll
            for (int q = 0; q < 8; ++q) t += red[q * 64 + lane];
            p.bias_eff[n] = t; }
        } }
    }
    xcd_barrier(xb);
    phase_mix(p, lds, bid, nb);
    xcd_barrier(xb);
    { pg8::Gemm g{p.mixb, p.w_eff_t, D, D, D, 0}; pg8::StaticOrder S; S.init(SEQ / 256, D / 256, nb, bid); EpiResid E{p.hnb, p.bias_eff, p.h2b, p.ssq};
      pg8::gemm_phase<EpiResid, pg8::StaticOrder>(lds, g, S, E); }
    xcd_barrier(xb);
    { pg8::Gemm g{p.h2b, p.wq_t, D, D, D, 0}; pg8::StaticOrder S; S.init(SEQ / 256, D / 256, nb, bid); EpiQTopk E{p.ssq, p.rstd, p.keysb, p.idx, p.gsu};
      pg8::gemm_phase<EpiQTopk, pg8::StaticOrder>(lds, g, S, E); }
    xcd_barrier(xb);
    phase_pd(p, lds, bid, nb);
    xcd_barrier(xb);
    phase_pa(p, bid, nb);
    xcd_barrier(xb);
    phase_pu(p, bid, nb);
    xcd_barrier(xb);
    phase_pf(p, bid, nb);
}

extern "C" void kernel_launch(void* const* d_in, const int* in_sizes, int n_in, void* d_out, int out_size, void* d_ws, size_t ws_size, hipStream_t stream) {
    Params p{};
    p.x = (const float*)d_in[0]; p.meta = (const float*)d_in[1]; p.mix_g = (const float*)d_in[2]; p.w_in = (const float*)d_in[3];
    p.pool_w = (const float*)d_in[4]; p.pool_scale = (const float*)d_in[5]; p.dw_w = (const float*)d_in[6]; p.dw_b = (const float*)d_in[7];
    p.ln_g = (const float*)d_in[8]; p.ln_b = (const float*)d_in[9]; p.pw_w = (const float*)d_in[10]; p.pw_b = (const float*)d_in[11];
    p.w_out = (const float*)d_in[12]; p.ffn_g = (const float*)d_in[13]; p.wq = (const float*)d_in[14]; p.keys = (const float*)d_in[15];
    p.down = (const float*)d_in[16]; p.up = (const float*)d_in[17]; p.fin_g = (const float*)d_in[18];
    p.out = (float*)d_out;
    char* w = (char*)d_ws; size_t off = 0;
    auto take = [&](size_t bytes) { char* r = w + off; off += (bytes + 255) & ~(size_t)255; return r; };
    p.idx = (unsigned short*)take((size_t)SEQ * 128 * 2);
    p.gsu = (float*)take((size_t)SEQ * 128 * 4);
    p.part = (bf16_t*)take((size_t)SEQ * 8 * 128 * 2);
    p.act = (bf16_t*)take((size_t)SEQ * 128 * 2);
    p.ssq2 = (float*)take((size_t)SEQ * 16 * 4);
    p.h3b = (bf16_t*)take((size_t)SEQ * D * 2);
    p.hnb = (bf16_t*)take((size_t)RT * D * 2);
    p.rstd1 = (float*)take((size_t)RT * 4);
    p.w_in_t = (bf16_t*)take((size_t)INW * D * 2);
    p.xp = (bf16_t*)take((size_t)RT * PWD * 2);
    p.glu = (bf16_t*)take((size_t)RT * CWD * 2);
    p.mixb = (bf16_t*)take((size_t)SEQ * D * 2);
    p.h2b = (bf16_t*)take((size_t)SEQ * D * 2);
    p.pool_ws = (bf16_t*)take((size_t)4 * 256 * 256 * 2);
    p.pw_b16 = (bf16_t*)take((size_t)CWD * CWD * 2);
    p.w_eff_t = (bf16_t*)take((size_t)D * D * 2);
    p.bias_eff = (float*)take((size_t)D * 4);
    p.w_out_t = (bf16_t*)take((size_t)D * D * 2);
    p.ssq = (float*)take((size_t)SEQ * 32 * 4);
    p.bar = (unsigned*)take((size_t)XCD_BAR_WORDS * 4);
    p.rstd = (float*)take((size_t)SEQ * 4);
    p.wq_t = (bf16_t*)take((size_t)D * D * 2);
    p.keysb = (bf16_t*)take((size_t)8 * 2 * 128 * 128 * 2);
    p.qb = (bf16_t*)take((size_t)SEQ * D * 2);
    p.down8 = (unsigned char*)take((size_t)16384 * D);
    p.up8 = (unsigned char*)take((size_t)16384 * D);
    p.sdn = (float*)take((size_t)16384 * 4);
    p.sup = (float*)take((size_t)16384 * 4);
    static int grid_blocks = 0;
    if (!grid_blocks) {
        int dev = 0, cus = 0, per_cu = 0;
        (void)hipGetDevice(&dev);
        (void)hipDeviceGetAttribute(&cus, hipDeviceAttributeMultiprocessorCount, dev);
        (void)hipFuncSetAttribute((const void*)k_mega, hipFuncAttributeMaxDynamicSharedMemorySize, LDS_BYTES);
        (void)hipOccupancyMaxActiveBlocksPerMultiprocessor(&per_cu, k_mega, NT, LDS_BYTES);
        if (per_cu < 1) { fprintf(stderr, "occupancy query says %d workgroups per CU: nothing launched\n", per_cu); grid_blocks = -1; }
        else if (cus != (SEQ / 256) * (D / 256)) { fprintf(stderr, "this build needs a %d-CU device (got %d): nothing launched\n", (SEQ / 256) * (D / 256), cus); grid_blocks = -1; }
        else grid_blocks = cus;
    }
    if (grid_blocks < 0) return;
    (void)hipMemsetAsync(p.bar, 0, (size_t)XCD_BAR_WORDS * 4, stream);
    void* args[] = {&p};
    hipError_t e = hipLaunchCooperativeKernel((void*)k_mega, dim3(grid_blocks), dim3(NT), args, LDS_BYTES, stream);
    if (e != hipSuccess) fprintf(stderr, "cooperative launch failed: %s (grid %d)\n", hipGetErrorString(e), grid_blocks);
}
```

```cpp
#include <hip/hip_runtime.h>
#include <hip/hip_cooperative_groups.h>
#include <stdint.h>
#include <cstdio>
namespace cg = cooperative_groups;

#define NT 512
#define LAS __attribute__((address_space(3)))
typedef unsigned short bf16_t;
typedef short bf16x8 __attribute__((ext_vector_type(8)));
typedef float f32x4 __attribute__((ext_vector_type(4)));
typedef unsigned u32x4 __attribute__((ext_vector_type(4)));
typedef unsigned u32x2 __attribute__((ext_vector_type(2)));

constexpr int D = 2048, SEQ = 8192, NMETA = 16, T = SEQ + NMETA;
constexpr int PWD = 1024, CWD = 1024, INW = 3072;
constexpr int KS = 31;
constexpr int RPAD = 240, RT = 8448;
constexpr int LDS_BYTES = 151552;

struct Params {
    const float *x, *meta, *mix_g, *w_in, *pool_w, *pool_scale, *dw_w, *dw_b, *ln_g, *ln_b, *pw_w, *pw_b, *w_out, *ffn_g, *wq, *keys, *down, *up, *fin_g;
    float* out;
    unsigned short* idx;
    unsigned* bar;
    bf16_t *hnb, *w_in_t, *xp, *glu, *mixb, *h2b, *pool_ws, *pw_b16, *w_eff_t, *w_out_t, *wq_t, *keysb, *qb;
    unsigned char *down8, *up8;
    float *sdn, *sup;
    float *gsu;
    bf16_t* part;
    bf16_t* act;
    float* ssq2;
    bf16_t* h3b;
    float *ssq, *rstd, *bias_eff, *rstd1;
};

__device__ __forceinline__ unsigned cvt_pk_bf16(float lo, float hi) { unsigned r; asm volatile("v_cvt_pk_bf16_f32 %0, %1, %2" : "=v"(r) : "v"(lo), "v"(hi)); return r; }
__device__ __forceinline__ void store16_wt(void* ptr, u32x4 v) { asm volatile("global_store_dwordx4 %0, %1, off sc1\n\ts_nop 1" :: "v"(ptr), "v"(v) : "memory"); }
__device__ __forceinline__ float bf_lo(unsigned w) { return __uint_as_float(w << 16); }
__device__ __forceinline__ float bf_hi(unsigned w) { return __uint_as_float(w & 0xffff0000u); }
__device__ __forceinline__ float wave_sum(float v) {
#pragma unroll
    for (int o = 1; o < 64; o <<= 1) v += __shfl_xor(v, o);
    return v;
}

__device__ __forceinline__ const float* hrow(const Params& p, int t) { return t < NMETA ? p.meta + (size_t)t * D : p.x + (size_t)(t - NMETA) * D; }

__device__ __forceinline__ float block_sum(float v, float* red) {
#pragma unroll
    for (int o = 32; o; o >>= 1) v += __shfl_xor(v, o);
    __syncthreads();
    if ((threadIdx.x & 63) == 0) red[threadIdx.x >> 6] = v;
    __syncthreads();
    float s = 0.f;
#pragma unroll
    for (int i = 0; i < NT / 64; ++i) s += red[i];
    return s;
}

namespace pg8 {
constexpr int BM = 256, BK = 64, HALF = 128, HTB = HALF * BK * 2, STAGE_BYTES = 8 * HTB, NXCD = 8, WGM = 8;
__device__ __forceinline__ int lds_byte(int r, int c) { const int st = (r >> 4) * 2 + (c >> 5), rr = r & 15, cc = c & 31, ob = rr * 64 + cc * 2; return st * 1024 + (ob ^ (((ob >> 9) & 1) << 5)); }
__device__ __forceinline__ void stage_rc(int b, int& R, int& C) { const int st = b / 1024, sb = b % 1024, swz = sb ^ (((sb >> 9) & 1) << 5); R = (st >> 1) * 16 + swz / 64; C = (st & 1) * 32 + (swz % 64) / 2; }
__device__ __forceinline__ int perm32(int rho) { const int n = rho >> 4, i = rho & 15; return 8 * (i >> 2) + 4 * n + (i & 3); }
struct Unit { int pm, pn; };
struct Gemm { const bf16_t* A; const bf16_t* Bt; int lda, ldb, K; int a_col_per_pn; };
struct StaticOrder {
    int nM, nN, nwg, G, c;
    __device__ void init(int nM_, int nN_, int G_, int c_) { nM = nM_; nN = nN_; nwg = nM * nN; G = G_; c = c_; }
    __device__ bool next(int i, Unit& u) const {
        const long L = (long)i * G + c; if (L >= nwg) return false;
        int wgid = (int)L; { const int q = nwg / NXCD, r = nwg % NXCD, xcd = wgid % NXCD, off = wgid / NXCD; wgid = (xcd < r ? xcd * (q + 1) : r * (q + 1) + (xcd - r) * q) + off; }
        const int nig = WGM * nN, gid = wgid / nig, fm = gid * WGM, gsz = (nM - fm) < WGM ? (nM - fm) : WGM;
        u.pm = fm + ((wgid % nig) % gsz); u.pn = (wgid % nig) / gsz; return true;
    }
};
struct OneUnit { Unit u; __device__ bool next(int i, Unit& o) const { if (i) return false; o = u; return true; } };
template <class Epi, class Sched>
__device__ __forceinline__ void gemm_phase(LAS unsigned char* lds, const Gemm g, const Sched& S, const Epi& E) {
    const int tid = threadIdx.x, wid = __builtin_amdgcn_readfirstlane(tid >> 6), lane = tid & 63, wr = wid >> 2, wc = wid & 3, fr = lane & 15, fq = lane >> 4;
    const int K = g.K, nt = K / BK;
    unsigned voffA[2], voffB[2];
#pragma unroll
    for (int i = 0; i < 2; ++i) { int R, C; stage_rc(tid * 16 + i * 8192, R, C);
        const int Rb = Epi::PERM ? ((R & ~31) + perm32(R & 31)) : R;
        voffA[i] = (unsigned)(R * g.lda + C) * 2u; voffB[i] = (unsigned)(Rb * g.ldb + C) * 2u; }
    const size_t kstep = (size_t)(BK * 2);
    const size_t hstepA = (size_t)HALF * g.lda * 2, hstepB = (size_t)HALF * g.ldb * 2;
    const size_t tstepA = 2 * hstepA, tstepB = 2 * hstepB;
    const unsigned ldsw = (unsigned)wid * 1024u;
    const int aoff = lds_byte(wr * 64 + fr, fq * 8), boff = lds_byte(wc * 32 + fr, fq * 8);
#define PG8_SA(b, h) (((b) * 2 + (h)) * HTB)
#define PG8_SB(b, h) ((4 + (b) * 2 + (h)) * HTB)
#define PG8_STAGE(bufoff, gbase, voff) do { _Pragma("unroll") for (int _i = 0; _i < 2; ++_i) \
        __builtin_amdgcn_global_load_lds((const unsigned*)((const char*)(gbase) + (voff)[_i]), (LAS unsigned*)(lds + (bufoff) + ldsw + _i * 8192), 16, 0, 0); } while (0)
#define PG8_LDA(dst, b, h) do { _Pragma("unroll") for (int m = 0; m < 4; ++m) _Pragma("unroll") for (int k = 0; k < 2; ++k) dst[m][k] = *(const LAS bf16x8*)(lds + PG8_SA(b, h) + aoff + m * 2048 + k * 1024); } while (0)
#define PG8_LDB(dst, b, h) do { _Pragma("unroll") for (int n = 0; n < 2; ++n) _Pragma("unroll") for (int k = 0; k < 2; ++k) dst[n][k] = *(const LAS bf16x8*)(lds + PG8_SB(b, h) + boff + n * 2048 + k * 1024); } while (0)
#define PG8_MMA(ai, bj, At, Bt) do { __builtin_amdgcn_s_setprio(1); _Pragma("unroll") for (int m = 0; m < 4; ++m) _Pragma("unroll") for (int n = 0; n < 2; ++n) _Pragma("unroll") for (int k = 0; k < 2; ++k) \
        acc[ai][bj][m][n] = __builtin_amdgcn_mfma_f32_16x16x32_bf16(Bt[n][k], At[m][k], acc[ai][bj][m][n], 0, 0, 0); __builtin_amdgcn_s_setprio(0); } while (0)
#define PG8_WAIT_V(n) asm volatile("s_waitcnt vmcnt(" #n ")" ::: "memory")
#define PG8_WAIT_L(n) asm volatile("s_waitcnt lgkmcnt(" #n ")" ::: "memory")
#define PG8_BAR __builtin_amdgcn_s_barrier()
#define PG8_SCHED __builtin_amdgcn_sched_barrier(0)
    Unit cur, nxt; int ui = 0;
    if (!S.next(0, cur)) return;
    f32x4 acc[2][2][4][2];
#pragma unroll
    for (int a = 0; a < 2; ++a)
#pragma unroll
        for (int b = 0; b < 2; ++b)
#pragma unroll
            for (int m = 0; m < 4; ++m)
#pragma unroll
                for (int n = 0; n < 2; ++n) acc[a][b][m][n] = (f32x4){0.f, 0.f, 0.f, 0.f};
    bf16x8 At[4][2], B0[2][2], B1[2][2];
    const char* cA = (const char*)g.A + (size_t)cur.pm * tstepA + (size_t)cur.pn * g.a_col_per_pn * 2; const char* cB = (const char*)g.Bt + (size_t)cur.pn * tstepB;
    PG8_STAGE(PG8_SB(0, 0), cB, voffB); PG8_STAGE(PG8_SA(0, 0), cA, voffA); PG8_STAGE(PG8_SB(0, 1), cB + hstepB, voffB); PG8_STAGE(PG8_SA(0, 1), cA + hstepA, voffA);
    if (wr == 1) PG8_BAR;
    PG8_WAIT_V(4); PG8_BAR;
    PG8_STAGE(PG8_SB(1, 0), cB + kstep, voffB); PG8_STAGE(PG8_SA(1, 0), cA + kstep, voffA); PG8_STAGE(PG8_SB(1, 1), cB + hstepB + kstep, voffB);
    PG8_WAIT_V(6); PG8_BAR;
    for (;;) {
        const bool has_next = S.next(ui + 1, nxt);
        const char* nA = has_next ? (const char*)g.A + (size_t)nxt.pm * tstepA + (size_t)nxt.pn * g.a_col_per_pn * 2 : cA; const char* nB = has_next ? (const char*)g.Bt + (size_t)nxt.pn * tstepB : cB;
        for (int t = 0; t < nt; t += 2) {
            const bool last = (t == nt - 2);
            const char* a1 = cA + (size_t)(t + 1) * kstep;
            const char* a2 = last ? nA : cA + (size_t)(t + 2) * kstep; const char* b2 = last ? nB : cB + (size_t)(t + 2) * kstep;
            const char* a3 = a2 + kstep; const char* b3 = b2 + kstep;
            PG8_LDB(B0, 0, 0); PG8_SCHED; PG8_LDA(At, 0, 0); PG8_STAGE(PG8_SA(1, 1), a1 + hstepA, voffA);
            PG8_WAIT_L(8); PG8_BAR; PG8_WAIT_L(0); PG8_MMA(0, 0, At, B0); PG8_BAR; PG8_SCHED;
            PG8_LDB(B1, 0, 1); PG8_STAGE(PG8_SB(0, 0), b2, voffB);
            PG8_BAR; PG8_WAIT_L(0); PG8_MMA(0, 1, At, B1); PG8_BAR;
            PG8_LDA(At, 0, 1); PG8_STAGE(PG8_SA(0, 0), a2, voffA);
            PG8_BAR; PG8_WAIT_L(0); PG8_MMA(1, 0, At, B0); PG8_BAR; PG8_SCHED;
            PG8_STAGE(PG8_SB(0, 1), b2 + hstepB, voffB);
            PG8_WAIT_V(6); PG8_BAR; PG8_MMA(1, 1, At, B1); PG8_BAR;
            PG8_LDB(B0, 1, 0); PG8_SCHED; PG8_LDA(At, 1, 0); PG8_STAGE(PG8_SA(0, 1), a2 + hstepA, voffA);
            PG8_WAIT_L(8); PG8_BAR; PG8_WAIT_L(0); PG8_MMA(0, 0, At, B0); PG8_BAR; PG8_SCHED;
            PG8_LDB(B1, 1, 1); PG8_STAGE(PG8_SB(1, 0), b3, voffB);
            PG8_BAR; PG8_WAIT_L(0); PG8_MMA(0, 1, At, B1); PG8_BAR;
            PG8_LDA(At, 1, 1); PG8_STAGE(PG8_SA(1, 0), a3, voffA);
            PG8_BAR; PG8_WAIT_L(0); PG8_MMA(1, 0, At, B0); PG8_BAR; PG8_SCHED;
            PG8_STAGE(PG8_SB(1, 1), b3 + hstepB, voffB);
            PG8_WAIT_V(6); PG8_BAR; PG8_MMA(1, 1, At, B1); PG8_BAR;
        }
        if constexpr (!Epi::AFTER_DRAIN) E(acc, cur, wr, wc, fr, fq);
        if (!has_next) break;
#pragma unroll
        for (int a = 0; a < 2; ++a)
#pragma unroll
            for (int b = 0; b < 2; ++b)
#pragma unroll
                for (int m = 0; m < 4; ++m)
#pragma unroll
                    for (int n = 0; n < 2; ++n) acc[a][b][m][n] = (f32x4){0.f, 0.f, 0.f, 0.f};
        cur = nxt; cA = nA; cB = nB; ++ui;
    }
    PG8_WAIT_V(0);
    if (wr == 0) PG8_BAR;
    PG8_BAR;
    if constexpr (Epi::AFTER_DRAIN) E.fused(acc, cur, wr, wc, fr, fq, lds, wid, lane);
#undef PG8_SA
#undef PG8_SB
#undef PG8_STAGE
#undef PG8_LDA
#undef PG8_LDB
#undef PG8_MMA
#undef PG8_WAIT_V
#undef PG8_WAIT_L
#undef PG8_BAR
#undef PG8_SCHED
}
}

struct EpiProjF32 {
    static constexpr bool PERM = false;
    static constexpr bool AFTER_DRAIN = false;
    float* proj;
    __device__ __forceinline__ void operator()(const f32x4 (&acc)[2][2][4][2], const pg8::Unit& u, int wr, int wc, int fr, int fq) const {
#pragma unroll
        for (int ai = 0; ai < 2; ++ai)
#pragma unroll
            for (int m = 0; m < 4; ++m) {
                const int t = u.pm * 256 + ai * 128 + wr * 64 + m * 16 + fr - RPAD;
                if (t >= 0) {
#pragma unroll
                    for (int bj = 0; bj < 2; ++bj)
#pragma unroll
                        for (int n = 0; n < 2; ++n) {
                            const int off = wc * 32 + n * 16 + fq * 4;
                            const int col = u.pn < 4 ? u.pn * 256 + bj * 128 + off : (bj ? 2048 : 1024) + (u.pn - 4) * 128 + off;
                            *(f32x4*)(proj + (size_t)t * INW + col) = acc[ai][bj][m][n];
                        }
                }
            }
    }
};


__device__ __forceinline__ float sigmoidf_fast(float x) { return __builtin_amdgcn_rcpf(1.0f + __expf(-x)); }

struct EpiProj {
    static constexpr bool PERM = true;
    static constexpr bool AFTER_DRAIN = false;
    bf16_t* xp; bf16_t* glu; const float* rstd1;
    __device__ __forceinline__ void operator()(const f32x4 (&acc)[2][2][4][2], const pg8::Unit& u, int wr, int wc, int fr, int fq) const {
#pragma unroll
        for (int ai = 0; ai < 2; ++ai)
#pragma unroll
            for (int m = 0; m < 4; ++m) {
                const size_t row = (size_t)(u.pm * 256 + ai * 128 + wr * 64 + m * 16 + fr);
                const float rs = rstd1[row];
                if (u.pn < 4) {
#pragma unroll
                    for (int bj = 0; bj < 2; ++bj) { const f32x4 v0 = acc[ai][bj][m][0] * rs, v1 = acc[ai][bj][m][1] * rs;
                        store16_wt(xp + row * PWD + u.pn * 256 + bj * 128 + wc * 32 + fq * 8, (u32x4){cvt_pk_bf16(v0[0], v0[1]), cvt_pk_bf16(v0[2], v0[3]), cvt_pk_bf16(v1[0], v1[1]), cvt_pk_bf16(v1[2], v1[3])}); }
                } else {
                    const f32x4 a0 = acc[ai][0][m][0] * rs, a1 = acc[ai][0][m][1] * rs, g0 = acc[ai][1][m][0] * rs, g1 = acc[ai][1][m][1] * rs;
                    store16_wt(glu + row * CWD + (u.pn - 4) * 128 + wc * 32 + fq * 8, (u32x4){
                        cvt_pk_bf16(a0[0] * sigmoidf_fast(g0[0]), a0[1] * sigmoidf_fast(g0[1])), cvt_pk_bf16(a0[2] * sigmoidf_fast(g0[2]), a0[3] * sigmoidf_fast(g0[3])),
                        cvt_pk_bf16(a1[0] * sigmoidf_fast(g1[0]), a1[1] * sigmoidf_fast(g1[1])), cvt_pk_bf16(a1[2] * sigmoidf_fast(g1[2]), a1[3] * sigmoidf_fast(g1[3]))});
                }
            }
    }
};
struct EpiBf16Out {
    static constexpr bool PERM = true;
    static constexpr bool AFTER_DRAIN = false;
    bf16_t* O; int ldc; int col0; const float* bias;
    __device__ __forceinline__ void operator()(const f32x4 (&acc)[2][2][4][2], const pg8::Unit& u, int wr, int wc, int fr, int fq) const {
#pragma unroll
        for (int ai = 0; ai < 2; ++ai)
#pragma unroll
            for (int m = 0; m < 4; ++m) {
                const size_t row = (size_t)(u.pm * 256 + ai * 128 + wr * 64 + m * 16 + fr);
#pragma unroll
                for (int bj = 0; bj < 2; ++bj) { const int c = u.pn * 256 + bj * 128 + wc * 32 + fq * 8; f32x4 v0 = acc[ai][bj][m][0], v1 = acc[ai][bj][m][1];
                    if (bias) { v0 += *(const f32x4*)(bias + c); v1 += *(const f32x4*)(bias + c + 4); }
                    *(u32x4*)(O + row * ldc + col0 + c) = (u32x4){cvt_pk_bf16(v0[0], v0[1]), cvt_pk_bf16(v0[2], v0[3]), cvt_pk_bf16(v1[0], v1[1]), cvt_pk_bf16(v1[2], v1[3])}; }
            }
    }
};
struct EpiResid {
    static constexpr bool PERM = true;
    static constexpr bool AFTER_DRAIN = false;
    const bf16_t* xb; const float* bias; bf16_t* h2b; float* ssq;
    __device__ __forceinline__ void operator()(const f32x4 (&acc)[2][2][4][2], const pg8::Unit& u, int wr, int wc, int fr, int fq) const {
#pragma unroll
        for (int ai = 0; ai < 2; ++ai)
#pragma unroll
            for (int m = 0; m < 4; ++m) {
                const size_t row = (size_t)(u.pm * 256 + ai * 128 + wr * 64 + m * 16 + fr);
                float ss = 0.f;
#pragma unroll
                for (int bj = 0; bj < 2; ++bj) { const int c = u.pn * 256 + bj * 128 + wc * 32 + fq * 8;
                    const u32x4 xw = *(const u32x4*)(xb + (row + 256) * D + c);
                    const f32x4 v0 = acc[ai][bj][m][0] + (f32x4){bf_lo(xw.x), bf_hi(xw.x), bf_lo(xw.y), bf_hi(xw.y)} + *(const f32x4*)(bias + c);
                    const f32x4 v1 = acc[ai][bj][m][1] + (f32x4){bf_lo(xw.z), bf_hi(xw.z), bf_lo(xw.w), bf_hi(xw.w)} + *(const f32x4*)(bias + c + 4);
                    store16_wt(h2b + row * D + c, (u32x4){cvt_pk_bf16(v0[0], v0[1]), cvt_pk_bf16(v0[2], v0[3]), cvt_pk_bf16(v1[0], v1[1]), cvt_pk_bf16(v1[2], v1[3])});
                    ss += ((v0[0] * v0[0] + v0[1] * v0[1]) + (v0[2] * v0[2] + v0[3] * v0[3])) + ((v1[0] * v1[0] + v1[1] * v1[1]) + (v1[2] * v1[2] + v1[3] * v1[3])); }
                ss += __shfl_xor(ss, 16); ss += __shfl_xor(ss, 32);
                if (fq == 0) ssq[row * 32 + u.pn * 4 + wc] = ss;
            }
    }
};

__device__ __forceinline__ float fsel(int mask, float a, float b) { return __int_as_float((__float_as_int(a) & ~mask) | (__float_as_int(b) & mask)); }

__device__ __forceinline__ u32x4 bload16(__amdgpu_buffer_rsrc_t r, int voff, int soff) { return __builtin_bit_cast(u32x4, __builtin_amdgcn_raw_buffer_load_b128(r, voff, soff, 0)); }
__device__ __forceinline__ unsigned bload4(__amdgpu_buffer_rsrc_t r, int voff, int soff) { return (unsigned)__builtin_amdgcn_raw_buffer_load_b32(r, voff, soff, 0); }
__device__ __forceinline__ void bstore4(__amdgpu_buffer_rsrc_t r, unsigned v, int voff, int soff) { __builtin_amdgcn_raw_buffer_store_b32(v, r, voff, soff, 0); }
__device__ __forceinline__ u32x2 bload8(__amdgpu_buffer_rsrc_t r, int voff, int soff) { return __builtin_bit_cast(u32x2, __builtin_amdgcn_raw_buffer_load_b64(r, voff, soff, 0)); }
template <int W> __device__ __forceinline__ void pool_tile(__amdgpu_buffer_rsrc_t rxp, __amdgpu_buffer_rsrc_t rpo, int r0, int tile, int tid) {
    unsigned v[32 + W - 1];
#pragma unroll
    for (int i = 0; i < 32 + W - 1; ++i) v[i] = bload4(rxp, tid * 4, (r0 - (W - 1) + i) * 2048);
    float s0 = 0.f, s1 = 0.f;
#pragma unroll
    for (int i = 0; i < W - 1; ++i) { s0 += bf_lo(v[i]); s1 += bf_hi(v[i]); }
    constexpr float inv = 1.0f / (float)W;
#pragma unroll
    for (int i = 0; i < 32; ++i) {
        const float a0 = bf_lo(v[W - 1 + i]), a1 = bf_hi(v[W - 1 + i]);
        s0 += a0; s1 += a1;
        bstore4(rpo, cvt_pk_bf16(s0 * inv - a0, s1 * inv - a1), tid * 4, (tile * 32 + i) * 4096);
        s0 -= bf_lo(v[i]); s1 -= bf_hi(v[i]);
    }
}
__device__ __forceinline__ void phase_mix(const Params& p, LAS unsigned char* lds, int bid, int nb) {
    const int tid = threadIdx.x, lane = tid & 63, wave = tid >> 6;
    LAS unsigned* gl = (LAS unsigned*)lds;
    LAS float* red = (LAS float*)(lds + 62 * 2048);
    const __amdgpu_buffer_rsrc_t rxp = __builtin_amdgcn_make_buffer_rsrc((void*)p.xp, 0, RT * PWD * 2, 0x00020000);
    const __amdgpu_buffer_rsrc_t rgl = __builtin_amdgcn_make_buffer_rsrc((void*)p.glu, 0, RT * CWD * 2, 0x00020000);
    const __amdgpu_buffer_rsrc_t rpo = __builtin_amdgcn_make_buffer_rsrc((void*)p.mixb, 0, SEQ * D * 2, 0x00020000);
    const __amdgpu_buffer_rsrc_t rww = __builtin_amdgcn_make_buffer_rsrc((void*)p.dw_w, 0, KS * CWD * 4, 0x00020000);
    const __amdgpu_buffer_rsrc_t rwb = __builtin_amdgcn_make_buffer_rsrc((void*)p.dw_b, 0, CWD * 4, 0x00020000);
    const __amdgpu_buffer_rsrc_t rlg = __builtin_amdgcn_make_buffer_rsrc((void*)p.ln_g, 0, CWD * 4, 0x00020000);
    const __amdgpu_buffer_rsrc_t rlb = __builtin_amdgcn_make_buffer_rsrc((void*)p.ln_b, 0, CWD * 4, 0x00020000);
    for (int tile = bid; tile < SEQ / 32; tile += nb) {
        const int r0 = 256 + tile * 32;
        __syncthreads();
#pragma unroll
        for (int j = 0; j < 16; ++j) { const int ch = j * NT + tid; if (ch < 62 * 128)
            *(LAS u32x4*)(lds + ch * 16) = bload16(rgl, tid * 16, (r0 - 30) * 2048 + j * 8192); }
        { const int g = __builtin_amdgcn_readfirstlane(tid >> 7);
          if (g == 0) pool_tile<2>(rxp, rpo, r0, tile, tid); else if (g == 1) pool_tile<4>(rxp, rpo, r0, tile, tid); else if (g == 2) pool_tile<8>(rxp, rpo, r0, tile, tid); else pool_tile<16>(rxp, rpo, r0, tile, tid); }
        __syncthreads();
#pragma unroll 1
        for (int hf = 0; hf < 2; ++hf) {
            float c0[16], c1[16];
            {
                float w0[KS], w1[KS];
#pragma unroll
                for (int k = 0; k < KS; ++k) { const u32x2 wv = bload8(rww, tid * 8, k * 4096); w0[k] = __uint_as_float(wv.x); w1[k] = __uint_as_float(wv.y); }
                const u32x2 bvv = bload8(rwb, tid * 8, 0); const float b0 = __uint_as_float(bvv.x), b1 = __uint_as_float(bvv.y);
#pragma unroll
                for (int i = 0; i < 16; ++i) { c0[i] = b0; c1[i] = b1; }
                const LAS unsigned* glh = gl + hf * 16 * 512 + tid;
#pragma unroll
                for (int rr = 0; rr < 46; ++rr) {
                    if ((rr & 7) == 0) asm volatile("" ::: "memory");
                    const unsigned vv = glh[rr * 512]; const float x0 = bf_lo(vv), x1 = bf_hi(vv);
#pragma unroll
                    for (int i = 0; i < 16; ++i) { const int k = rr - i; if (k >= 0 && k < KS) { c0[i] += x0 * w0[k]; c1[i] += x1 * w1[k]; } }
                }
            }
            asm volatile("" ::: "memory");
#pragma unroll
            for (int which = 0; which < 2; ++which) {
                float st[16];
#pragma unroll
                for (int i = 0; i < 16; ++i) st[i] = which == 0 ? c0[i] + c1[i] : c0[i] * c0[i] + c1[i] * c1[i];
#pragma unroll
                for (int lvl = 0; lvl < 4; ++lvl) {
                    const int o = 32 >> lvl, n = 8 >> lvl; const int mk = -((lane >> (5 - lvl)) & 1);
#pragma unroll
                    for (int j = 0; j < 8; ++j) if (j < n) st[j] = fsel(mk, st[j], st[j + n]) + __shfl_xor(fsel(mk, st[j + n], st[j]), o);
                }
                float tot = st[0] + __shfl_xor(st[0], 2); tot += __shfl_xor(tot, 1);
                if ((lane & 3) == 0) red[wave * 32 + which * 16 + (lane >> 2)] = tot;
            }
            __syncthreads();
            if (tid < 32) { float t = 0.f;
#pragma unroll
                for (int q = 0; q < 8; ++q) t += red[q * 32 + tid];
                red[256 + tid] = t; }
            __syncthreads();
            const u32x2 lgv = bload8(rlg, tid * 8, 0), lbv = bload8(rlb, tid * 8, 0); const float lg0 = __uint_as_float(lgv.x), lg1 = __uint_as_float(lgv.y), lb0 = __uint_as_float(lbv.x), lb1 = __uint_as_float(lbv.y);
#pragma unroll
            for (int i = 0; i < 16; ++i) {
                const float s1 = red[256 + i], s2 = red[256 + 16 + i];
                const float mu = s1 * (1.0f / CWD), var = fmaxf(s2 * (1.0f / CWD) - mu * mu, 0.f), rs = rsqrtf(var + 1e-5f);
                const float y0 = (c0[i] - mu) * rs * lg0 + lb0, y1 = (c1[i] - mu) * rs * lg1 + lb1;
                bstore4(rpo, cvt_pk_bf16(y0 * sigmoidf_fast(y0), y1 * sigmoidf_fast(y1)), tid * 4, (tile * 32 + hf * 16 + i) * 4096 + 2048);
            }
            __syncthreads();
        }
    }
}

typedef float f32x16 __attribute__((ext_vector_type(16)));
__device__ __forceinline__ int okey(float s) { const int u = __float_as_int(s); return u ^ ((u >> 31) & 0x7fffffff); }
__device__ __forceinline__ float okey_inv(int k) { return __int_as_float(k ^ ((k >> 31) & 0x7fffffff)); }
__device__ __forceinline__ void sort16_desc(int (&v)[16]) {
#pragma unroll
    for (int k = 2; k <= 16; k <<= 1) {
#pragma unroll
        for (int j = k >> 1; j > 0; j >>= 1) {
#pragma unroll
            for (int i = 0; i < 16; ++i) {
                const int l = i ^ j;
                if (l > i) { const bool desc = (i & k) == 0; const int hi = max(v[i], v[l]), lo = min(v[i], v[l]); v[i] = desc ? hi : lo; v[l] = desc ? lo : hi; }
            }
        }
    }
}
__device__ __forceinline__ void merge16_desc(int (&a)[16], const int (&b)[16]) {
#pragma unroll
    for (int i = 0; i < 16; ++i) a[i] = max(a[i], b[15 - i]);
#pragma unroll
    for (int j = 8; j > 0; j >>= 1) {
#pragma unroll
        for (int i = 0; i < 16; ++i) { const int l = i ^ j; if (l > i) { const int hi = max(a[i], a[l]), lo = min(a[i], a[l]); a[i] = hi; a[l] = lo; } }
    }
}
__device__ __forceinline__ void pair_merge(int (&a)[16]) {
    int b[16];
#pragma unroll
    for (int i = 0; i < 16; ++i) b[i] = __shfl_xor(a[i], 32);
    merge16_desc(a, b);
}
constexpr int CELL_I[64] = {0,0,0,0,0,0,0,0,0,0,0,0,0,0,0,0,1,1,1,1,1,1,1,1,2,2,2,2,2,3,3,3,3,4,4,4,5,5,6,6,7,7,8,9,10,11,12,13,14,15,0,0,0,0,0,0,0,0,0,0,0,0,0,0};
constexpr int CELL_J[64] = {0,1,2,3,4,5,6,7,8,9,10,11,12,13,14,15,0,1,2,3,4,5,6,7,0,1,2,3,4,0,1,2,3,0,1,2,0,1,0,1,0,1,0,0,0,0,0,0,0,0,0,0,0,0,0,0,0,0,0,0,0,0,0,0};
constexpr int NCELL = 50;

struct EpiQTopk {
    static constexpr bool PERM = false;
    static constexpr bool AFTER_DRAIN = true;
    const float* ssq; float* rstd; const bf16_t* keysb; unsigned short* idx; float* gsu;
    __device__ __forceinline__ void fused(const f32x4 (&acc)[2][2][4][2], const pg8::Unit& u, int wr, int wc, int fr, int fq, LAS unsigned char* lds, int wid, int lane) const {
        const int hh = lane >> 5, l31 = lane & 31, h = u.pn;
        LAS float* svt = (LAS float*)(lds + 65536 + (wid * 64 + lane) * 164);
        LAS unsigned char* sit = (LAS unsigned char*)(svt + 32);
        float rs[2][4];
#pragma unroll
        for (int ai = 0; ai < 2; ++ai)
#pragma unroll
            for (int m = 0; m < 4; ++m) {
                const size_t row = (size_t)(u.pm * 256 + ai * 128 + wr * 64 + m * 16 + fr);
                const f32x4* sp = (const f32x4*)(ssq + row * 32); f32x4 t = sp[0];
#pragma unroll
                for (int i = 1; i < 8; ++i) t += sp[i];
                rs[ai][m] = rsqrtf(((t[0] + t[1]) + (t[2] + t[3])) * (1.0f / D) + 1e-6f);
                if (u.pn == 0 && wc == 0 && fq == 0) rstd[row] = rs[ai][m];
            }
        const int trow = wid * 32 + l31;
#pragma unroll
        for (int ph = 0; ph < 2; ++ph) {
#pragma unroll
            for (int ai = 0; ai < 2; ++ai)
#pragma unroll
                for (int m = 0; m < 4; ++m) { const int row = ai * 128 + wr * 64 + m * 16 + fr;
#pragma unroll
                    for (int n = 0; n < 2; ++n) { const f32x4 v = acc[ai][ph][m][n] * rs[ai][m]; const int chunk = 4 * wc + 2 * n + (fq >> 1);
                        u32x2 w; w.x = cvt_pk_bf16(v[0], v[1]); w.y = cvt_pk_bf16(v[2], v[3]);
                        *(LAS u32x2*)(lds + row * 256 + ((chunk ^ (row & 15)) << 4) + (fq & 1) * 8) = w; } }
            __syncthreads();
            const bf16_t* krow = keysb + ((size_t)(h * 2 + ph) * 128 + l31) * 128 + 8 * hh;
            bf16x8 bq[8];
#pragma unroll
            for (int ks = 0; ks < 8; ++ks) bq[ks] = *(const LAS bf16x8*)(lds + trow * 256 + (((ks * 2 + hh) ^ (trow & 15)) << 4));
            int top[16];
#pragma unroll
            for (int i = 0; i < 16; ++i) top[i] = (int)0x80000000;
            bf16x8 ak[8];
#pragma unroll
            for (int ks = 0; ks < 8; ++ks) ak[ks] = *(const bf16x8*)(krow + ks * 16);
#pragma unroll 1
            for (int kt = 0; kt < 4; ++kt) {
                f32x16 c = {0.f, 0.f, 0.f, 0.f, 0.f, 0.f, 0.f, 0.f, 0.f, 0.f, 0.f, 0.f, 0.f, 0.f, 0.f, 0.f};
#pragma unroll
                for (int ks = 0; ks < 8; ++ks) c = __builtin_amdgcn_mfma_f32_32x32x16_bf16(ak[ks], bq[ks], c, 0, 0, 0);
                { const int kn = kt < 3 ? kt + 1 : 3;
#pragma unroll
                  for (int ks = 0; ks < 8; ++ks) ak[ks] = *(const bf16x8*)(krow + (size_t)kn * 32 * 128 + ks * 16); }
                int v[16];
                const int lowb = (127 - kt * 32) ^ (hh << 2);
#pragma unroll
                for (int r = 0; r < 16; ++r) v[r] = (okey(c[r]) & ~127) | (lowb - ((r & 3) + 8 * (r >> 2)));
                sort16_desc(v);
                merge16_desc(top, v);
            }
            pair_merge(top);
#pragma unroll
            for (int i = 0; i < 16; ++i) { svt[ph * 16 + i] = okey_inv(top[i] & ~127); sit[ph * 16 + i] = (unsigned char)(127 - (top[i] & 127)); }
            __syncthreads();
        }
        float sv[2][16];
#pragma unroll
        for (int i = 0; i < 16; ++i) { sv[0][i] = svt[i]; sv[1][i] = svt[16 + i]; }
        int w0[16], w1[16];
#pragma unroll
        for (int s = 0; s < 32; ++s) {
            const int e0 = 2 * s, e1 = 2 * s + 1;
            int key;
            if (e0 >= NCELL) key = (int)0x80000000;
            else {
                const float v0 = sv[0][CELL_I[e0]] + sv[1][CELL_J[e0]];
                const int k0 = (okey(v0) & ~255) | (255 - (CELL_I[e0] * 16 + CELL_J[e0]));
                if (e1 >= NCELL) key = hh ? (int)0x80000000 : k0;
                else { const float v1 = sv[0][CELL_I[e1]] + sv[1][CELL_J[e1]];
                    const int k1 = (okey(v1) & ~255) | (255 - (CELL_I[e1] * 16 + CELL_J[e1]));
                    key = hh ? k1 : k0; }
            }
            if (s < 16) w0[s] = key; else w1[s - 16] = key;
        }
        sort16_desc(w0); sort16_desc(w1); merge16_desc(w0, w1); pair_merge(w0);
        const float mx = okey_inv(w0[0] & ~255);
        float sum = 0.f;
#pragma unroll
        for (int k = 0; k < 16; ++k) sum += __expf(okey_inv(w0[k] & ~255) - mx);
        const float inv = 1.0f / sum;
        int eo[8]; float go[8]; const int hmask = -hh;
#pragma unroll
        for (int k = 0; k < 8; ++k) { const int kk = (w0[k] & ~hmask) | (w0[8 + k] & hmask); const int cc = 255 - (kk & 255);
            eo[k] = (int)sit[cc >> 4] * 128 + (int)sit[16 + (cc & 15)]; go[k] = __expf(okey_inv(kk & ~255) - mx) * inv; }
        const size_t ob = (size_t)(u.pm * 256 + trow) * 128 + h * 16 + hh * 8;
        *(u32x4*)(idx + ob) = (u32x4){(unsigned)eo[0] | ((unsigned)eo[1] << 16), (unsigned)eo[2] | ((unsigned)eo[3] << 16), (unsigned)eo[4] | ((unsigned)eo[5] << 16), (unsigned)eo[6] | ((unsigned)eo[7] << 16)};
        *(f32x4*)(gsu + ob) = (f32x4){go[0], go[1], go[2], go[3]};
        *(f32x4*)(gsu + ob + 4) = (f32x4){go[4], go[5], go[6], go[7]};
    }
    __device__ __forceinline__ void operator()(const f32x4 (&)[2][2][4][2], const pg8::Unit&, int, int, int, int) const {}
};

__device__ __forceinline__ void fp8_row2(const float* s0, unsigned char* d0, float* i0, const float* s1, unsigned char* d1, float* i1, int lane) {
    f32x4 v[2][2][4]; float am[2] = {0.f, 0.f};
#pragma unroll
    for (int r = 0; r < 2; ++r)
#pragma unroll
        for (int k = 0; k < 2; ++k)
#pragma unroll
            for (int i = 0; i < 4; ++i) v[r][k][i] = __builtin_nontemporal_load((const f32x4*)((r ? s1 : s0) + 1024 * k + 16 * lane + 4 * i));
#pragma unroll
    for (int r = 0; r < 2; ++r) {
#pragma unroll
        for (int k = 0; k < 2; ++k)
#pragma unroll
            for (int i = 0; i < 4; ++i) am[r] = fmaxf(am[r], fmaxf(fmaxf(fabsf(v[r][k][i].x), fabsf(v[r][k][i].y)), fmaxf(fabsf(v[r][k][i].z), fabsf(v[r][k][i].w))));
#pragma unroll
        for (int o = 1; o < 64; o <<= 1) am[r] = fmaxf(am[r], __shfl_xor(am[r], o));
        int be = (__float_as_int(am[r]) >> 23) & 255; be = be < 8 ? 8 : (be > 248 ? 248 : be);
        const float sc = __int_as_float((260 - be) << 23), isc = __int_as_float((be - 6) << 23);
#pragma unroll
        for (int k = 0; k < 2; ++k) { u32x4 w; unsigned ww[4];
#pragma unroll
            for (int i = 0; i < 4; ++i) { int t = 0; t = __builtin_amdgcn_cvt_pk_fp8_f32(v[r][k][i].x * sc, v[r][k][i].y * sc, t, false); t = __builtin_amdgcn_cvt_pk_fp8_f32(v[r][k][i].z * sc, v[r][k][i].w * sc, t, true); ww[i] = (unsigned)t; }
            w.x = ww[0]; w.y = ww[1]; w.z = ww[2]; w.w = ww[3];
            *(u32x4*)((r ? d1 : d0) + 1024 * k + 16 * lane) = w; }
        if (lane == 0) *(r ? i1 : i0) = isc;
    }
}

typedef float f32x2 __attribute__((ext_vector_type(2)));
template <int N> __device__ __forceinline__ f32x2 dot16_fp8(const u32x4 w, const f32x2 (&x)[N], int o, f32x2 acc) {
    const unsigned ww[4] = {w.x, w.y, w.z, w.w};
#pragma unroll
    for (int d = 0; d < 4; ++d) { acc += __builtin_amdgcn_cvt_pk_f32_fp8((int)ww[d], false) * x[o + 2 * d]; acc += __builtin_amdgcn_cvt_pk_f32_fp8((int)ww[d], true) * x[o + 2 * d + 1]; }
    return acc;
}
template <int N> __device__ __forceinline__ void axpy16_fp8(const u32x4 w, float a, f32x2 (&y)[N], int o) {
    const unsigned ww[4] = {w.x, w.y, w.z, w.w}; const f32x2 a2 = {a, a};
#pragma unroll
    for (int d = 0; d < 4; ++d) { y[o + 2 * d] += a2 * __builtin_amdgcn_cvt_pk_f32_fp8((int)ww[d], false); y[o + 2 * d + 1] += a2 * __builtin_amdgcn_cvt_pk_f32_fp8((int)ww[d], true); }
}
__device__ __forceinline__ void bstore16(__amdgpu_buffer_rsrc_t r, f32x4 v, int voff, int soff) { __builtin_amdgcn_raw_buffer_store_b128(__builtin_bit_cast(__attribute__((__vector_size__(4 * sizeof(unsigned)))) unsigned, v), r, voff, soff, 0); }
__device__ __forceinline__ void bstore8(__amdgpu_buffer_rsrc_t r, f32x2 v, int voff, int soff) { __builtin_amdgcn_raw_buffer_store_b64(__builtin_bit_cast(__attribute__((__vector_size__(2 * sizeof(unsigned)))) unsigned, v), r, voff, soff, 0); }
__device__ __forceinline__ f32x2 fsel2(int mask, f32x2 a, f32x2 b) { return (f32x2){fsel(mask, a.x, b.x), fsel(mask, a.y, b.y)}; }
__device__ __forceinline__ f32x2 shx2(f32x2 a, int o) { return (f32x2){__shfl_xor(a.x, o), __shfl_xor(a.y, o)}; }

__device__ __forceinline__ void phase_pd(const Params& p, LAS unsigned char* lds, int bid, int nb) {
    const int tid = threadIdx.x, lane = tid & 63, wave = __builtin_amdgcn_readfirstlane(tid >> 6);
    if (wave == 7) {
        for (int e = bid; e < 16384; e += 2 * nb) { const int e2 = e + nb < 16384 ? e + nb : e;
            fp8_row2(p.up + (size_t)e * D, p.up8 + (size_t)e * D, p.sup + e, p.up + (size_t)e2 * D, p.up8 + (size_t)e2 * D, p.sup + e2, lane); }
        return;
    }
    const int v = bid & 7, lw = (bid >> 3) * 7 + wave, NLW = (nb >> 3) * 7;
    const int c = lane & 7, sub = lane >> 3;
    const int m0 = -(lane & 1), m1 = -((lane >> 1) & 1), m2 = -((lane >> 2) & 1);
    const __amdgpu_buffer_rsrc_t rd = __builtin_amdgcn_make_buffer_rsrc((void*)p.down8, 0, 16384 * D, 0x00020000);
    const __amdgpu_buffer_rsrc_t rh = __builtin_amdgcn_make_buffer_rsrc((void*)p.h2b, 0, SEQ * D * 2, 0x00020000);
    const __amdgpu_buffer_rsrc_t rg1 = __builtin_amdgcn_make_buffer_rsrc((void*)p.ffn_g, 0, D * 4, 0x00020000);
    const __amdgpu_buffer_rsrc_t ri = __builtin_amdgcn_make_buffer_rsrc((void*)p.idx, 0, SEQ * 128 * 2, 0x00020000);
    const __amdgpu_buffer_rsrc_t rrs = __builtin_amdgcn_make_buffer_rsrc((void*)p.rstd, 0, SEQ * 4, 0x00020000);
    const __amdgpu_buffer_rsrc_t rp = __builtin_amdgcn_make_buffer_rsrc((void*)p.part, 0, SEQ * 8 * 128 * 2, 0x00020000);
    LAS f32x2* pl = (LAS f32x2*)lds + wave * (40 * 64) + lane;
    const int vsub = sub * 32, vc2 = c * 32, vc1 = c * 16, vl4 = lane * 4;
#pragma unroll 1
    for (int pass = 0; pass < 2; ++pass) {
        const int sl = v * 2 + pass;
        f32x2 gs[8];
#pragma unroll
        for (int i = 0; i < 4; ++i) { const f32x4 g = __builtin_bit_cast(f32x4, bload16(rg1, c * 64, sl * 512 + i * 16)); gs[2 * i] = (f32x2){g[0], g[1]}; gs[2 * i + 1] = (f32x2){g[2], g[3]}; }
        u32x4 ix[2], hh[2]; unsigned rsb;
        {
            const int t = lw;
#pragma unroll
            for (int i = 0; i < 2; ++i) ix[i] = bload16(ri, vsub, t * 256 + i * 16);
            hh[0] = bload16(rh, vc2, t * 4096 + sl * 256); hh[1] = bload16(rh, vc2, t * 4096 + sl * 256 + 16); rsb = bload4(rrs, 0, t * 4);
        }
        int trip = 0;
#pragma unroll 1
        for (int t = lw; t < SEQ; t += NLW) {
            asm volatile("" ::: "memory");
            u32x4 w[16];
            {
                const unsigned ew[8] = {ix[0].x, ix[0].y, ix[0].z, ix[0].w, ix[1].x, ix[1].y, ix[1].z, ix[1].w};
#pragma unroll
                for (int g = 0; g < 16; ++g) { const unsigned e = (g & 1) ? (ew[g >> 1] >> 16) : (ew[g >> 1] & 0xffffu); w[g] = bload16(rd, (int)(e * 2048u) + vc1, sl * 128); }
            }
            f32x2 xs[8];
            {
                const float rs = __uint_as_float(rsb);
                const unsigned hw[8] = {hh[0].x, hh[0].y, hh[0].z, hh[0].w, hh[1].x, hh[1].y, hh[1].z, hh[1].w};
#pragma unroll
                for (int i = 0; i < 8; ++i) xs[i] = (f32x2){bf_lo(hw[i]) * rs, bf_hi(hw[i]) * rs} * gs[i];
            }
            asm volatile("" ::: "memory");
            {
                const int tn = t + NLW < SEQ ? t + NLW : t;
#pragma unroll
                for (int i = 0; i < 2; ++i) ix[i] = bload16(ri, vsub, tn * 256 + i * 16);
                hh[0] = bload16(rh, vc2, tn * 4096 + sl * 256); hh[1] = bload16(rh, vc2, tn * 4096 + sl * 256 + 16); rsb = bload4(rrs, 0, tn * 4);
            }
            asm volatile("" ::: "memory");
            float r[16];
#pragma unroll
            for (int g = 0; g < 16; ++g) { const f32x2 z = {0.f, 0.f}; const f32x2 s2 = dot16_fp8(w[g], xs, 0, z); r[g] = s2.x + s2.y; }
            float k8[8], k4[4];
#pragma unroll
            for (int i = 0; i < 8; ++i) k8[i] = fsel(m2, r[i], r[i + 8]) + __shfl_xor(fsel(m2, r[i + 8], r[i]), 4);
#pragma unroll
            for (int i = 0; i < 4; ++i) k4[i] = fsel(m1, k8[i], k8[i + 4]) + __shfl_xor(fsel(m1, k8[i + 4], k8[i]), 2);
            const float k0 = fsel(m0, k4[0], k4[2]) + __shfl_xor(fsel(m0, k4[2], k4[0]), 1);
            const float k1 = fsel(m0, k4[1], k4[3]) + __shfl_xor(fsel(m0, k4[3], k4[1]), 1);
            if (pass == 0) pl[trip * 64] = (f32x2){k0, k1};
            else { const f32x2 pv = pl[trip * 64]; bstore4(rp, cvt_pk_bf16(k0 + pv.x, k1 + pv.y), vl4, (t * 8 + v) * 256); }
            ++trip;
        }
    }
}
__device__ __forceinline__ void phase_pa(const Params& p, int bid, int nb) {
    const int tid = threadIdx.x, lane = tid & 63, wave = tid >> 6;
    const int gw = bid * 8 + wave, NGW = nb * 8;
    for (int it = gw; it < SEQ * 2; it += NGW) {
        const int t = it >> 1, pp = (it & 1) * 64 + lane;
        const bf16_t* pr = p.part + (size_t)t * 1024 + pp;
        float hs = 0.f;
#pragma unroll
        for (int sl = 0; sl < 8; ++sl) hs += __uint_as_float((unsigned)pr[sl * 128] << 16);
        const int e = (int)p.idx[(size_t)t * 128 + pp];
        hs *= p.sdn[e];
        const float av = p.gsu[(size_t)t * 128 + pp] * p.sup[e] * 0.5f * hs * (1.0f + erff(hs * 0.70710678118654752f));
        p.act[(size_t)t * 128 + pp] = (bf16_t)(cvt_pk_bf16(av, 0.f) & 0xffffu);
    }
}
__device__ __forceinline__ void phase_pu(const Params& p, int bid, int nb) {
    const int tid = threadIdx.x, lane = tid & 63, wave = __builtin_amdgcn_readfirstlane(tid >> 6);
    const int v = bid & 7, lw = (bid >> 3) * 8 + wave, NLW = (nb >> 3) * 8;
    const int c = lane & 7, sub = lane >> 3;
    const int m3 = -((lane >> 3) & 1), m4 = -((lane >> 4) & 1), m5 = -((lane >> 5) & 1);
    const __amdgpu_buffer_rsrc_t ru = __builtin_amdgcn_make_buffer_rsrc((void*)p.up8, 0, 16384 * D, 0x00020000);
    const __amdgpu_buffer_rsrc_t rh = __builtin_amdgcn_make_buffer_rsrc((void*)p.h2b, 0, SEQ * D * 2, 0x00020000);
    const __amdgpu_buffer_rsrc_t ri = __builtin_amdgcn_make_buffer_rsrc((void*)p.idx, 0, SEQ * 128 * 2, 0x00020000);
    const __amdgpu_buffer_rsrc_t ra = __builtin_amdgcn_make_buffer_rsrc((void*)p.act, 0, SEQ * 128 * 2, 0x00020000);
    const __amdgpu_buffer_rsrc_t ro = __builtin_amdgcn_make_buffer_rsrc((void*)p.h3b, 0, SEQ * D * 2, 0x00020000);
    const __amdgpu_buffer_rsrc_t rq = __builtin_amdgcn_make_buffer_rsrc((void*)p.ssq2, 0, SEQ * 16 * 4, 0x00020000);
    const int vsub = sub * 32, vc1 = c * 16, vh = c * 32 + sub * 4;
#pragma unroll 1
    for (int pass = 0; pass < 2; ++pass) {
        const int sl = v * 2 + pass;
        u32x4 ix[2], ac[2]; unsigned hb;
        {
            const int t = lw;
#pragma unroll
            for (int i = 0; i < 2; ++i) { ix[i] = bload16(ri, vsub, t * 256 + i * 16); ac[i] = bload16(ra, vsub, t * 256 + i * 16); }
            hb = bload4(rh, vh, t * 4096 + sl * 256);
        }
#pragma unroll 1
        for (int t = lw; t < SEQ; t += NLW) {
            asm volatile("" ::: "memory");
            u32x4 w[16];
            {
                const unsigned ew[8] = {ix[0].x, ix[0].y, ix[0].z, ix[0].w, ix[1].x, ix[1].y, ix[1].z, ix[1].w};
#pragma unroll
                for (int g = 0; g < 16; ++g) { const unsigned e = (g & 1) ? (ew[g >> 1] >> 16) : (ew[g >> 1] & 0xffffu); w[g] = bload16(ru, (int)(e * 2048u) + vc1, sl * 128); }
            }
            const unsigned aw[8] = {ac[0].x, ac[0].y, ac[0].z, ac[0].w, ac[1].x, ac[1].y, ac[1].z, ac[1].w};
            float a[16];
#pragma unroll
            for (int g = 0; g < 16; ++g) a[g] = (g & 1) ? bf_hi(aw[g >> 1]) : bf_lo(aw[g >> 1]);
            const unsigned hcur = hb;
            asm volatile("" ::: "memory");
            {
                const int tn = t + NLW < SEQ ? t + NLW : t;
#pragma unroll
                for (int i = 0; i < 2; ++i) { ix[i] = bload16(ri, vsub, tn * 256 + i * 16); ac[i] = bload16(ra, vsub, tn * 256 + i * 16); }
                hb = bload4(rh, vh, tn * 4096 + sl * 256);
            }
            asm volatile("" ::: "memory");
            f32x2 acc[8];
#pragma unroll
            for (int i = 0; i < 8; ++i) acc[i] = (f32x2){0.f, 0.f};
#pragma unroll
            for (int g = 0; g < 16; ++g) axpy16_fp8(w[g], a[g], acc, 0);
            f32x2 k4[4], k2[2];
#pragma unroll
            for (int i = 0; i < 4; ++i) k4[i] = fsel2(m5, acc[i], acc[i + 4]) + shx2(fsel2(m5, acc[i + 4], acc[i]), 32);
#pragma unroll
            for (int i = 0; i < 2; ++i) k2[i] = fsel2(m4, k4[i], k4[i + 2]) + shx2(fsel2(m4, k4[i + 2], k4[i]), 16);
            f32x2 h3 = fsel2(m3, k2[0], k2[1]) + shx2(fsel2(m3, k2[1], k2[0]), 8);
            h3 += (f32x2){bf_lo(hcur), bf_hi(hcur)};
            bstore4(ro, cvt_pk_bf16(h3.x, h3.y), vh, t * 4096 + sl * 256);
            const float ss = wave_sum(h3.x * h3.x + h3.y * h3.y);
            if (lane == 0) bstore4(rq, __float_as_uint(ss), 0, (t * 16 + sl) * 4);
        }
    }
}
__device__ __forceinline__ void phase_pf(const Params& p, int bid, int nb) {
    const int tid = threadIdx.x, lane = tid & 63, wave = tid >> 6;
    const int gw = bid * 8 + wave, NGW = nb * 8;
    for (int t = gw; t < SEQ; t += NGW) {
        const f32x4* sp = (const f32x4*)(p.ssq2 + (size_t)t * 16); f32x4 q = sp[0] + sp[1] + sp[2] + sp[3];
        const float rf = rsqrtf(((q[0] + q[1]) + (q[2] + q[3])) * (1.0f / D) + 1e-6f);
        const u32x4* hp = (const u32x4*)(p.h3b + (size_t)t * D) + lane;
        f32x4* o = (f32x4*)(p.out + (size_t)t * D) + 2 * lane; const f32x4* g = (const f32x4*)p.fin_g + 2 * lane;
#pragma unroll
        for (int j = 0; j < 4; ++j) { const u32x4 h = hp[64 * j]; const f32x4 g0 = g[128 * j], g1 = g[128 * j + 1];
            o[128 * j] = (f32x4){bf_lo(h.x) * rf * g0[0], bf_hi(h.x) * rf * g0[1], bf_lo(h.y) * rf * g0[2], bf_hi(h.y) * rf * g0[3]};
            o[128 * j + 1] = (f32x4){bf_lo(h.z) * rf * g1[0], bf_hi(h.z) * rf * g1[1], bf_lo(h.w) * rf * g1[2], bf_hi(h.w) * rf * g1[3]}; }
    }
}

__device__ __forceinline__ void fp8_row(const float* src, unsigned char* dst, float* inv_scale, int lane) {
    f32x4 v[2][4]; float am = 0.f;
#pragma unroll
    for (int k = 0; k < 2; ++k)
#pragma unroll
        for (int i = 0; i < 4; ++i) { v[k][i] = *(const f32x4*)(src + 1024 * k + 16 * lane + 4 * i);
            am = fmaxf(am, fmaxf(fmaxf(fabsf(v[k][i].x), fabsf(v[k][i].y)), fmaxf(fabsf(v[k][i].z), fabsf(v[k][i].w)))); }
#pragma unroll
    for (int o = 1; o < 64; o <<= 1) am = fmaxf(am, __shfl_xor(am, o));
    int be = (__float_as_int(am) >> 23) & 255; be = be < 8 ? 8 : (be > 248 ? 248 : be);
    const float sc = __int_as_float((260 - be) << 23), isc = __int_as_float((be - 6) << 23);
#pragma unroll
    for (int k = 0; k < 2; ++k) { u32x4 w; unsigned ww[4];
#pragma unroll
        for (int i = 0; i < 4; ++i) { int t = 0; t = __builtin_amdgcn_cvt_pk_fp8_f32(v[k][i].x * sc, v[k][i].y * sc, t, false); t = __builtin_amdgcn_cvt_pk_fp8_f32(v[k][i].z * sc, v[k][i].w * sc, t, true); ww[i] = (unsigned)t; }
        w.x = ww[0]; w.y = ww[1]; w.z = ww[2]; w.w = ww[3];
        *(u32x4*)(dst + 1024 * k + 16 * lane) = w; }
    if (lane == 0) *inv_scale = isc;
}

__device__ __forceinline__ void tr_item(const float* W, int ldw, int srccol0, int k0, bf16_t* WT, int ldt, int n0, const float* kscale, const float* nscale, LAS float* scr, int lane) {
    f32x4 tv[8];
#pragma unroll
    for (int i = 0; i < 8; ++i) { const int kk = 8 * i + (lane >> 3); tv[i] = __builtin_nontemporal_load((const f32x4*)(W + (size_t)(k0 + kk) * ldw + srccol0 + 4 * (lane & 7))); }
    f32x4 ns = {1.f, 1.f, 1.f, 1.f};
    if (nscale) ns = *(const f32x4*)(nscale + srccol0 + 4 * (lane & 7));
#pragma unroll
    for (int i = 0; i < 8; ++i) { const int kk = 8 * i + (lane >> 3); f32x4 v = tv[i] * ns;
        if (kscale) v *= kscale[k0 + kk];
        LAS float* d = scr + kk * 33 + 4 * (lane & 7); d[0] = v[0]; d[1] = v[1]; d[2] = v[2]; d[3] = v[3]; }
    asm volatile("s_waitcnt lgkmcnt(0)" ::: "memory");
    const int c = lane & 7;
#pragma unroll
    for (int j = 0; j < 4; ++j) { const int n = (lane >> 3) + 8 * j; const LAS float* s = scr + (8 * c) * 33 + n;
        u32x4 o; o.x = cvt_pk_bf16(s[0 * 33], s[1 * 33]); o.y = cvt_pk_bf16(s[2 * 33], s[3 * 33]); o.z = cvt_pk_bf16(s[4 * 33], s[5 * 33]); o.w = cvt_pk_bf16(s[6 * 33], s[7 * 33]);
        *(u32x4*)(WT + (size_t)(n0 + n) * ldt + k0 + 8 * c) = o; }
    asm volatile("s_waitcnt lgkmcnt(0)" ::: "memory");
}
__device__ __forceinline__ int win_srccol(int n) { const int pn = n >> 8, w = n & 255; return pn < 4 ? n : ((w >> 7) ? 2048 : 1024) + (pn - 4) * 128 + (w & 127); }

__device__ __forceinline__ void phase_prep(const Params& p, LAS unsigned char* lds, int bid, int nb) {
    const int tid = threadIdx.x, lane = tid & 63, wave = tid >> 6;
    const int gw = bid * 8 + wave, NGW = nb * 8;
    LAS float* scr = (LAS float*)(lds + wave * 8448);
    for (int r = gw; r < RT; r += NGW) {
        unsigned long long* o8 = (unsigned long long*)(p.hnb + (size_t)r * D) + lane;
        if (r < RPAD) {
#pragma unroll
            for (int j = 0; j < 8; ++j) o8[64 * j] = 0ull;
            if (lane == 0) p.rstd1[r] = 0.f;
        } else {
            const f32x4* xr = (const f32x4*)hrow(p, r - RPAD) + lane;
            f32x4 v[8]; float s = 0.f;
#pragma unroll
            for (int j = 0; j < 8; ++j) { v[j] = __builtin_nontemporal_load(xr + 64 * j); s += (v[j].x * v[j].x + v[j].y * v[j].y) + (v[j].z * v[j].z + v[j].w * v[j].w); }
            const float rs = rsqrtf(wave_sum(s) * (1.0f / D) + 1e-6f);
            if (lane == 0) p.rstd1[r] = rs;
#pragma unroll
            for (int j = 0; j < 8; ++j)
                o8[64 * j] = (unsigned long long)cvt_pk_bf16(v[j].x, v[j].y) | ((unsigned long long)cvt_pk_bf16(v[j].z, v[j].w) << 32);
        }
    }
    for (int it = gw; it < (D / 64) * (INW / 32); it += NGW) {
        const int kb = it / (INW / 32), nbk = it % (INW / 32);
        tr_item(p.w_in, INW, win_srccol(nbk * 32), kb * 64, p.w_in_t, D, nbk * 32, p.mix_g, nullptr, scr, lane);
    }
    for (int i = gw * 64 + lane; i < 4 * 256 * 256 / 4; i += NGW * 64) { const f32x4 v = ((const f32x4*)p.pool_w)[i];
        const int g = i >> 14, d = (i & 63) * 4; const f32x4 sc = *(const f32x4*)(p.pool_scale + g * 256 + d);
        u32x2 w; w.x = cvt_pk_bf16(v[0] * sc[0], v[1] * sc[1]); w.y = cvt_pk_bf16(v[2] * sc[2], v[3] * sc[3]); ((u32x2*)p.pool_ws)[i] = w; }
    for (int i = gw * 64 + lane; i < CWD * CWD / 4; i += NGW * 64) { const f32x4 v = ((const f32x4*)p.pw_w)[i];
        u32x2 w; w.x = cvt_pk_bf16(v[0], v[1]); w.y = cvt_pk_bf16(v[2], v[3]); ((u32x2*)p.pw_b16)[i] = w; }
    for (int it = gw; it < 32 * 64; it += NGW) { const int kb = it >> 6, nbk = it & 63;
        tr_item(p.w_out, D, nbk * 32, kb * 64, p.w_out_t, D, nbk * 32, nullptr, nullptr, scr, lane); }
    for (int it = gw; it < 32 * 64; it += NGW) { const int kb = it >> 6, nbk = it & 63;
        tr_item(p.wq, D, nbk * 32, kb * 64, p.wq_t, D, nbk * 32, p.ffn_g, nullptr, scr, lane); }
    for (int i = gw * 64 + lane; i < 8 * 2 * 128 * 128 / 4; i += NGW * 64) { const f32x4 v = ((const f32x4*)p.keys)[i];
        u32x2 w; w.x = cvt_pk_bf16(v[0], v[1]); w.y = cvt_pk_bf16(v[2], v[3]); ((u32x2*)p.keysb)[i] = w; }
    for (int e = gw; e < 16384; e += 2 * NGW) { const int e2 = e + NGW < 16384 ? e + NGW : e;
        fp8_row2(p.down + (size_t)e * D, p.down8 + (size_t)e * D, p.sdn + e, p.down + (size_t)e2 * D, p.down8 + (size_t)e2 * D, p.sdn + e2, lane); }
}


#define XB_TMO      128
#define XB_XCNT(j)  (256  + 64 * (j))
#define XB_XSUB(j)  (1280 + 64 * (j))
#define XB_XGEN(j)  (2304 + 64 * (j))
#define XB_TOP      3328
#define XB_TOPGEN   3392
#define XCD_BAR_WORDS 3456
#define XB_SPIN_CAP (1u << 18)
__device__ __forceinline__ unsigned xb_ld(unsigned* p)              { return __hip_atomic_load(p, __ATOMIC_RELAXED, __HIP_MEMORY_SCOPE_AGENT); }
__device__ __forceinline__ unsigned xb_add(unsigned* p, unsigned v) { return __hip_atomic_fetch_add(p, v, __ATOMIC_RELAXED, __HIP_MEMORY_SCOPE_AGENT); }
__device__ __forceinline__ unsigned xb_xcc_id() { return (unsigned)__builtin_amdgcn_s_getreg((3 << 11) | 20) & 0xFu; }
#define XB_SPIN(cond, bar) do { unsigned _sp = 0; while (cond) { __builtin_amdgcn_s_sleep(1); \
    if ((++_sp & 255u) == 0u) { if (xb_ld(&(bar)[XB_TMO])) break; if (_sp > XB_SPIN_CAP) { atomicAdd(&(bar)[XB_TMO], 1u); break; } } } } while (0)
struct XcdBarrier { unsigned* bar; unsigned x; volatile LAS unsigned* st; };
__device__ __forceinline__ XcdBarrier xcd_barrier_post(unsigned* bar, volatile LAS unsigned* st) {
    XcdBarrier b; b.bar = bar; b.x = xb_xcc_id(); b.st = st;
    if (threadIdx.x == 0) (void)xb_add(&bar[XB_XCNT(b.x)], 1u);
    return b;
}
__device__ __forceinline__ void xcd_barrier_complete(unsigned* bar, unsigned x, unsigned& nloc, unsigned& nx) {
    const unsigned G = gridDim.x * gridDim.y * gridDim.z;
    unsigned sum, cnt, mine, sp = 0u;
    for (;;) {
        sum = 0u; cnt = 0u; mine = 0u;
#pragma unroll
        for (unsigned j = 0; j < 16; ++j) { const unsigned c = xb_ld(&bar[XB_XCNT(j)]); sum += c; cnt += (c > 0u) ? 1u : 0u; mine = (j == x) ? c : mine; }
        if (sum == G) break;
        __builtin_amdgcn_s_sleep(1);
        if ((++sp & 255u) == 0u) { if (xb_ld(&bar[XB_TMO])) break; if (sp > XB_SPIN_CAP) { atomicAdd(&bar[XB_TMO], 1u); break; } }
    }
    nloc = mine > 0u ? mine : 1u; nx = cnt > 0u ? cnt : 1u;
}
__device__ __forceinline__ void xcd_barrier(const XcdBarrier& b) {
    asm volatile("s_waitcnt vmcnt(0)" ::: "memory");
    __syncthreads();
    if (threadIdx.x == 0) {
        unsigned* bar = b.bar;
        __builtin_amdgcn_s_waitcnt(0);
        unsigned nloc = b.st[0], nx = b.st[1];
        if (nloc == 0u) { xcd_barrier_complete(bar, b.x, nloc, nx); b.st[0] = nloc; b.st[1] = nx; }
        const unsigned old = xb_add(&bar[XB_XSUB(b.x)], 1u);
        const unsigned gen = old / nloc;
        if (old + 1u == (gen + 1u) * nloc) {
            __builtin_amdgcn_fence(__ATOMIC_RELEASE, "agent");
            asm volatile("s_waitcnt vmcnt(0)" ::: "memory");
            const unsigned og = xb_add(&bar[XB_TOP], 1u);
            const unsigned tg = og / nx;
            if (og + 1u == (tg + 1u) * nx) xb_add(&bar[XB_TOPGEN], 1u);
            else XB_SPIN(xb_ld(&bar[XB_TOPGEN]) == tg, bar);
            __builtin_amdgcn_fence(__ATOMIC_ACQUIRE, "agent");
            xb_add(&bar[XB_XGEN(b.x)], 1u);
            asm volatile("s_waitcnt vmcnt(0)" ::: "memory");
        } else {
            XB_SPIN(xb_ld(&bar[XB_XGEN(b.x)]) == gen, bar);
            __builtin_amdgcn_fence(__ATOMIC_ACQUIRE, "agent");
            asm volatile("s_waitcnt vmcnt(0)" ::: "memory");
        }
    }
    __syncthreads();
}

__global__ void __launch_bounds__(NT, 2) k_mega(Params p) {
    extern __shared__ __attribute__((aligned(16))) unsigned char lds_raw[];
    LAS unsigned char* lds = (LAS unsigned char*)lds_raw;
    const int bid = blockIdx.x, nb = gridDim.x;
    volatile LAS unsigned* bst = (volatile LAS unsigned*)(lds + LDS_BYTES - 16);
    if (threadIdx.x < 4) bst[threadIdx.x] = 0u;
    __syncthreads();
    const XcdBarrier xb = xcd_barrier_post(p.bar, bst);
    phase_prep(p, lds, bid, nb);
    xcd_barrier(xb);
    { pg8::Gemm g{p.hnb, p.w_in_t, D, D, D, 0}; pg8::StaticOrder S; S.init(RT / 256, INW / 256, nb, bid); EpiProj E{p.xp, p.glu, p.rstd1};
      pg8::gemm_phase<EpiProj, pg8::StaticOrder>(lds, g, S, E); }
    { const int nproj = (RT / 256) * (INW / 256); const int first = (nproj > nb && nproj < 2 * nb) ? nproj - nb : 0, nfree = nb - first;
      for (int uu = bid - first; uu >= 0 && uu < 64; uu += nfree) {
        __syncthreads();
        const bool pw = uu < 32;
        pg8::Gemm g{pw ? p.w_out_t + PWD : p.w_out_t, pw ? p.pw_b16 : p.pool_ws, D, pw ? CWD : 256, pw ? CWD : 256, pw ? 0 : 256};
        pg8::OneUnit S; S.u.pm = (uu & 31) >> 2; S.u.pn = uu & 3; EpiBf16Out E{p.w_eff_t, D, pw ? PWD : 0, nullptr};
        pg8::gemm_phase<EpiBf16Out, pg8::OneUnit>(lds, g, S, E);
      }
      { const int b0 = nfree >= 96 ? first + 64 : 0;
        for (int nbk = bid - b0; nbk >= 0 && nbk < D / 64; nbk += nb) {
          __syncthreads();
          const int lane = threadIdx.x & 63, wv = threadIdx.x >> 6, n = nbk * 64 + lane;
          float a[8] = {0.f, 0.f, 0.f, 0.f, 0.f, 0.f, 0.f, 0.f};
          for (int j = wv * 128; j < wv * 128 + 128; j += 8) {
#pragma unroll
            for (int q = 0; q < 8; ++q) a[q] += p.pw_b[j + q] * p.w_out[(size_t)(PWD + j + q) * D + n]; }
          LAS float* red = (LAS float*)lds;
          red[wv * 64 + lane] = ((a[0] + a[1]) + (a[2] + a[3])) + ((a[4] + a[5]) + (a[6] + a[7]));
          __syncthreads();
          if (wv == 0) { float t = 0.f;
#pragma unroll
            for (int q = 0; q < 8; ++q) t += red[q * 64 + lane];
            p.bias_eff[n] = t; }
        } }
    }
    xcd_barrier(xb);
    phase_mix(p, lds, bid, nb);
    xcd_barrier(xb);
    { pg8::Gemm g{p.mixb, p.w_eff_t, D, D, D, 0}; pg8::StaticOrder S; S.init(SEQ / 256, D / 256, nb, bid); EpiResid E{p.hnb, p.bias_eff, p.h2b, p.ssq};
      pg8::gemm_phase<EpiResid, pg8::StaticOrder>(lds, g, S, E); }
    xcd_barrier(xb);
    { pg8::Gemm g{p.h2b, p.wq_t, D, D, D, 0}; pg8::StaticOrder S; S.init(SEQ / 256, D / 256, nb, bid); EpiQTopk E{p.ssq, p.rstd, p.keysb, p.idx, p.gsu};
      pg8::gemm_phase<EpiQTopk, pg8::StaticOrder>(lds, g, S, E); }
    xcd_barrier(xb);
    phase_pd(p, lds, bid, nb);
    xcd_barrier(xb);
    phase_pa(p, bid, nb);
    xcd_barrier(xb);
    phase_pu(p, bid, nb);
    xcd_barrier(xb);
    phase_pf(p, bid, nb);
}

extern "C" void kernel_launch(void* const* d_in, const int* in_sizes, int n_in, void* d_out, int out_size, void* d_ws, size_t ws_size, hipStream_t stream) {
    Params p{};
    p.x = (const float*)d_in[0]; p.meta = (const float*)d_in[1]; p.mix_g = (const float*)d_in[2]; p.w_in = (const float*)d_in[3];
    p.pool_w = (const float*)d_in[4]; p.pool_scale = (const float*)d_in[5]; p.dw_w = (const float*)d_in[6]; p.dw_b = (const float*)d_in[7];
    p.ln_g = (const float*)d_in[8]; p.ln_b = (const float*)d_in[9]; p.pw_w = (const float*)d_in[10]; p.pw_b = (const float*)d_in[11];
    p.w_out = (const float*)d_in[12]; p.ffn_g = (const float*)d_in[13]; p.wq = (const float*)d_in[14]; p.keys = (const float*)d_in[15];
    p.down = (const float*)d_in[16]; p.up = (const float*)d_in[17]; p.fin_g = (const float*)d_in[18];
    p.out = (float*)d_out;
    char* w = (char*)d_ws; size_t off = 0;
    auto take = [&](size_t bytes) { char* r = w + off; off += (bytes + 255) & ~(size_t)255; return r; };
    p.idx = (unsigned short*)take((size_t)SEQ * 128 * 2);
    p.gsu = (float*)take((size_t)SEQ * 128 * 4);
    p.part = (bf16_t*)take((size_t)SEQ * 8 * 128 * 2);
    p.act = (bf16_t*)take((size_t)SEQ * 128 * 2);
    p.ssq2 = (float*)take((size_t)SEQ * 16 * 4);
    p.h3b = (bf16_t*)take((size_t)SEQ * D * 2);
    p.hnb = (bf16_t*)take((size_t)RT * D * 2);
    p.rstd1 = (float*)take((size_t)RT * 4);
    p.w_in_t = (bf16_t*)take((size_t)INW * D * 2);
    p.xp = (bf16_t*)take((size_t)RT * PWD * 2);
    p.glu = (bf16_t*)take((size_t)RT * CWD * 2);
    p.mixb = (bf16_t*)take((size_t)SEQ * D * 2);
    p.h2b = (bf16_t*)take((size_t)SEQ * D * 2);
    p.pool_ws = (bf16_t*)take((size_t)4 * 256 * 256 * 2);
    p.pw_b16 = (bf16_t*)take((size_t)CWD * CWD * 2);
    p.w_eff_t = (bf16_t*)take((size_t)D * D * 2);
    p.bias_eff = (float*)take((size_t)D * 4);
    p.w_out_t = (bf16_t*)take((size_t)D * D * 2);
    p.ssq = (float*)take((size_t)SEQ * 32 * 4);
    p.bar = (unsigned*)take((size_t)XCD_BAR_WORDS * 4);
    p.rstd = (float*)take((size_t)SEQ * 4);
    p.wq_t = (bf16_t*)take((size_t)D * D * 2);
    p.keysb = (bf16_t*)take((size_t)8 * 2 * 128 * 128 * 2);
    p.qb = (bf16_t*)take((size_t)SEQ * D * 2);
    p.down8 = (unsigned char*)take((size_t)16384 * D);
    p.up8 = (unsigned char*)take((size_t)16384 * D);
    p.sdn = (float*)take((size_t)16384 * 4);
    p.sup = (float*)take((size_t)16384 * 4);
    static int grid_blocks = 0;
    if (!grid_blocks) {
        int dev = 0, cus = 0, per_cu = 0;
        (void)hipGetDevice(&dev);
        (void)hipDeviceGetAttribute(&cus, hipDeviceAttributeMultiprocessorCount, dev);
        (void)hipFuncSetAttribute((const void*)k_mega, hipFuncAttributeMaxDynamicSharedMemorySize, LDS_BYTES);
        (void)hipOccupancyMaxActiveBlocksPerMultiprocessor(&per_cu, k_mega, NT, LDS_BYTES);
        if (per_cu < 1) { fprintf(stderr, "occupancy query says %d workgroups per CU: nothing launched\n", per_cu); grid_blocks = -1; }
        else if (cus != (SEQ / 256) * (D / 256)) { fprintf(stderr, "this build needs a %d-CU device (got %d): nothing launched\n", (SEQ / 256) * (D / 256), cus); grid_blocks = -1; }
        else grid_blocks = cus;
    }
    if (grid_blocks < 0) return;
    (void)hipMemsetAsync(p.bar, 0, (size_t)XCD_BAR_WORDS * 4, stream);
    void* args[] = {&p};
    hipError_t e = hipLaunchCooperativeKernel((void*)k_mega, dim3(grid_blocks), dim3(NT), args, LDS_BYTES, stream);
    if (e != hipSuccess) fprintf(stderr, "cooperative launch failed: %s (grid %d)\n", hipGetErrorString(e), grid_blocks);
}
```

```cpp
#include <hip/hip_runtime.h>
#include <hip/hip_cooperative_groups.h>
#include <stdint.h>
#include <cstdio>
namespace cg = cooperative_groups;

#define NT 512
#define LAS __attribute__((address_space(3)))
typedef unsigned short bf16_t;
typedef short bf16x8 __attribute__((ext_vector_type(8)));
typedef float f32x4 __attribute__((ext_vector_type(4)));
typedef unsigned u32x4 __attribute__((ext_vector_type(4)));
typedef unsigned u32x2 __attribute__((ext_vector_type(2)));

constexpr int D = 2048, SEQ = 8192, NMETA = 16, T = SEQ + NMETA;
constexpr int PWD = 1024, CWD = 1024, INW = 3072;
constexpr int KS = 31;
constexpr int RPAD = 240, RT = 8448;
constexpr int LDS_BYTES = 151552;

struct Params {
    const float *x, *meta, *mix_g, *w_in, *pool_w, *pool_scale, *dw_w, *dw_b, *ln_g, *ln_b, *pw_w, *pw_b, *w_out, *ffn_g, *wq, *keys, *down, *up, *fin_g;
    float* out;
    unsigned short* idx;
    unsigned* bar;
    bf16_t *hnb, *w_in_t, *xp, *glu, *mixb, *h2b, *pool_ws, *pw_b16, *w_eff_t, *w_out_t, *wq_t, *keysb, *qb;
    unsigned char *down8, *up8;
    float *sdn, *sup;
    float *gsu;
    bf16_t* part;
    bf16_t* act;
    float* ssq2;
    bf16_t* h3b;
    float *ssq, *rstd, *bias_eff, *rstd1;
};

__device__ __forceinline__ unsigned cvt_pk_bf16(float lo, float hi) { unsigned r; asm volatile("v_cvt_pk_bf16_f32 %0, %1, %2" : "=v"(r) : "v"(lo), "v"(hi)); return r; }
__device__ __forceinline__ void store16_wt(void* ptr, u32x4 v) { asm volatile("global_store_dwordx4 %0, %1, off sc1\n\ts_nop 1" :: "v"(ptr), "v"(v) : "memory"); }
__device__ __forceinline__ float bf_lo(unsigned w) { return __uint_as_float(w << 16); }
__device__ __forceinline__ float bf_hi(unsigned w) { return __uint_as_float(w & 0xffff0000u); }
__device__ __forceinline__ float wave_sum(float v) {
#pragma unroll
    for (int o = 1; o < 64; o <<= 1) v += __shfl_xor(v, o);
    return v;
}

__device__ __forceinline__ const float* hrow(const Params& p, int t) { return t < NMETA ? p.meta + (size_t)t * D : p.x + (size_t)(t - NMETA) * D; }

__device__ __forceinline__ float block_sum(float v, float* red) {
#pragma unroll
    for (int o = 32; o; o >>= 1) v += __shfl_xor(v, o);
    __syncthreads();
    if ((threadIdx.x & 63) == 0) red[threadIdx.x >> 6] = v;
    __syncthreads();
    float s = 0.f;
#pragma unroll
    for (int i = 0; i < NT / 64; ++i) s += red[i];
    return s;
}

namespace pg8 {
constexpr int BM = 256, BK = 64, HALF = 128, HTB = HALF * BK * 2, STAGE_BYTES = 8 * HTB, NXCD = 8, WGM = 8;
__device__ __forceinline__ int lds_byte(int r, int c) { const int st = (r >> 4) * 2 + (c >> 5), rr = r & 15, cc = c & 31, ob = rr * 64 + cc * 2; return st * 1024 + (ob ^ (((ob >> 9) & 1) << 5)); }
__device__ __forceinline__ void stage_rc(int b, int& R, int& C) { const int st = b / 1024, sb = b % 1024, swz = sb ^ (((sb >> 9) & 1) << 5); R = (st >> 1) * 16 + swz / 64; C = (st & 1) * 32 + (swz % 64) / 2; }
__device__ __forceinline__ int perm32(int rho) { const int n = rho >> 4, i = rho & 15; return 8 * (i >> 2) + 4 * n + (i & 3); }
struct Unit { int pm, pn; };
struct Gemm { const bf16_t* A; const bf16_t* Bt; int lda, ldb, K; int a_col_per_pn; };
struct StaticOrder {
    int nM, nN, nwg, G, c;
    __device__ void init(int nM_, int nN_, int G_, int c_) { nM = nM_; nN = nN_; nwg = nM * nN; G = G_; c = c_; }
    __device__ bool next(int i, Unit& u) const {
        const long L = (long)i * G + c; if (L >= nwg) return false;
        int wgid = (int)L; { const int q = nwg / NXCD, r = nwg % NXCD, xcd = wgid % NXCD, off = wgid / NXCD; wgid = (xcd < r ? xcd * (q + 1) : r * (q + 1) + (xcd - r) * q) + off; }
        const int nig = WGM * nN, gid = wgid / nig, fm = gid * WGM, gsz = (nM - fm) < WGM ? (nM - fm) : WGM;
        u.pm = fm + ((wgid % nig) % gsz); u.pn = (wgid % nig) / gsz; return true;
    }
};
struct OneUnit { Unit u; __device__ bool next(int i, Unit& o) const { if (i) return false; o = u; return true; } };
template <class Epi, class Sched>
__device__ __forceinline__ void gemm_phase(LAS unsigned char* lds, const Gemm g, const Sched& S, const Epi& E) {
    const int tid = threadIdx.x, wid = __builtin_amdgcn_readfirstlane(tid >> 6), lane = tid & 63, wr = wid >> 2, wc = wid & 3, fr = lane & 15, fq = lane >> 4;
    const int K = g.K, nt = K / BK;
    unsigned voffA[2], voffB[2];
#pragma unroll
    for (int i = 0; i < 2; ++i) { int R, C; stage_rc(tid * 16 + i * 8192, R, C);
        const int Rb = Epi::PERM ? ((R & ~31) + perm32(R & 31)) : R;
        voffA[i] = (unsigned)(R * g.lda + C) * 2u; voffB[i] = (unsigned)(Rb * g.ldb + C) * 2u; }
    const size_t kstep = (size_t)(BK * 2);
    const size_t hstepA = (size_t)HALF * g.lda * 2, hstepB = (size_t)HALF * g.ldb * 2;
    const size_t tstepA = 2 * hstepA, tstepB = 2 * hstepB;
    const unsigned ldsw = (unsigned)wid * 1024u;
    const int aoff = lds_byte(wr * 64 + fr, fq * 8), boff = lds_byte(wc * 32 + fr, fq * 8);
#define PG8_SA(b, h) (((b) * 2 + (h)) * HTB)
#define PG8_SB(b, h) ((4 + (b) * 2 + (h)) * HTB)
#define PG8_STAGE(bufoff, gbase, voff) do { _Pragma("unroll") for (int _i = 0; _i < 2; ++_i) \
        __builtin_amdgcn_global_load_lds((const unsigned*)((const char*)(gbase) + (voff)[_i]), (LAS unsigned*)(lds + (bufoff) + ldsw + _i * 8192), 16, 0, 0); } while (0)
#define PG8_LDA(dst, b, h) do { _Pragma("unroll") for (int m = 0; m < 4; ++m) _Pragma("unroll") for (int k = 0; k < 2; ++k) dst[m][k] = *(const LAS bf16x8*)(lds + PG8_SA(b, h) + aoff + m * 2048 + k * 1024); } while (0)
#define PG8_LDB(dst, b, h) do { _Pragma("unroll") for (int n = 0; n < 2; ++n) _Pragma("unroll") for (int k = 0; k < 2; ++k) dst[n][k] = *(const LAS bf16x8*)(lds + PG8_SB(b, h) + boff + n * 2048 + k * 1024); } while (0)
#define PG8_MMA(ai, bj, At, Bt) do { __builtin_amdgcn_s_setprio(1); _Pragma("unroll") for (int m = 0; m < 4; ++m) _Pragma("unroll") for (int n = 0; n < 2; ++n) _Pragma("unroll") for (int k = 0; k < 2; ++k) \
        acc[ai][bj][m][n] = __builtin_amdgcn_mfma_f32_16x16x32_bf16(Bt[n][k], At[m][k], acc[ai][bj][m][n], 0, 0, 0); __builtin_amdgcn_s_setprio(0); } while (0)
#define PG8_WAIT_V(n) asm volatile("s_waitcnt vmcnt(" #n ")" ::: "memory")
#define PG8_WAIT_L(n) asm volatile("s_waitcnt lgkmcnt(" #n ")" ::: "memory")
#define PG8_BAR __builtin_amdgcn_s_barrier()
#define PG8_SCHED __builtin_amdgcn_sched_barrier(0)
    Unit cur, nxt; int ui = 0;
    if (!S.next(0, cur)) return;
    f32x4 acc[2][2][4][2];
#pragma unroll
    for (int a = 0; a < 2; ++a)
#pragma unroll
        for (int b = 0; b < 2; ++b)
#pragma unroll
            for (int m = 0; m < 4; ++m)
#pragma unroll
                for (int n = 0; n < 2; ++n) acc[a][b][m][n] = (f32x4){0.f, 0.f, 0.f, 0.f};
    bf16x8 At[4][2], B0[2][2], B1[2][2];
    const char* cA = (const char*)g.A + (size_t)cur.pm * tstepA + (size_t)cur.pn * g.a_col_per_pn * 2; const char* cB = (const char*)g.Bt + (size_t)cur.pn * tstepB;
    PG8_STAGE(PG8_SB(0, 0), cB, voffB); PG8_STAGE(PG8_SA(0, 0), cA, voffA); PG8_STAGE(PG8_SB(0, 1), cB + hstepB, voffB); PG8_STAGE(PG8_SA(0, 1), cA + hstepA, voffA);
    if (wr == 1) PG8_BAR;
    PG8_WAIT_V(4); PG8_BAR;
    PG8_STAGE(PG8_SB(1, 0), cB + kstep, voffB); PG8_STAGE(PG8_SA(1, 0), cA + kstep, voffA); PG8_STAGE(PG8_SB(1, 1), cB + hstepB + kstep, voffB);
    PG8_WAIT_V(6); PG8_BAR;
    for (;;) {
        const bool has_next = S.next(ui + 1, nxt);
        const char* nA = has_next ? (const char*)g.A + (size_t)nxt.pm * tstepA + (size_t)nxt.pn * g.a_col_per_pn * 2 : cA; const char* nB = has_next ? (const char*)g.Bt + (size_t)nxt.pn * tstepB : cB;
        for (int t = 0; t < nt; t += 2) {
            const bool last = (t == nt - 2);
            const char* a1 = cA + (size_t)(t + 1) * kstep;
            const char* a2 = last ? nA : cA + (size_t)(t + 2) * kstep; const char* b2 = last ? nB : cB + (size_t)(t + 2) * kstep;
            const char* a3 = a2 + kstep; const char* b3 = b2 + kstep;
            PG8_LDB(B0, 0, 0); PG8_SCHED; PG8_LDA(At, 0, 0); PG8_STAGE(PG8_SA(1, 1), a1 + hstepA, voffA);
            PG8_WAIT_L(8); PG8_BAR; PG8_WAIT_L(0); PG8_MMA(0, 0, At, B0); PG8_BAR; PG8_SCHED;
            PG8_LDB(B1, 0, 1); PG8_STAGE(PG8_SB(0, 0), b2, voffB);
            PG8_BAR; PG8_WAIT_L(0); PG8_MMA(0, 1, At, B1); PG8_BAR;
            PG8_LDA(At, 0, 1); PG8_STAGE(PG8_SA(0, 0), a2, voffA);
            PG8_BAR; PG8_WAIT_L(0); PG8_MMA(1, 0, At, B0); PG8_BAR; PG8_SCHED;
            PG8_STAGE(PG8_SB(0, 1), b2 + hstepB, voffB);
            PG8_WAIT_V(6); PG8_BAR; PG8_MMA(1, 1, At, B1); PG8_BAR;
            PG8_LDB(B0, 1, 0); PG8_SCHED; PG8_LDA(At, 1, 0); PG8_STAGE(PG8_SA(0, 1), a2 + hstepA, voffA);
            PG8_WAIT_L(8); PG8_BAR; PG8_WAIT_L(0); PG8_MMA(0, 0, At, B0); PG8_BAR; PG8_SCHED;
            PG8_LDB(B1, 1, 1); PG8_STAGE(PG8_SB(1, 0), b3, voffB);
            PG8_BAR; PG8_WAIT_L(0); PG8_MMA(0, 1, At, B1); PG8_BAR;
            PG8_LDA(At, 1, 1); PG8_STAGE(PG8_SA(1, 0), a3, voffA);
            PG8_BAR; PG8_WAIT_L(0); PG8_MMA(1, 0, At, B0); PG8_BAR; PG8_SCHED;
            PG8_STAGE(PG8_SB(1, 1), b3 + hstepB, voffB);
            PG8_WAIT_V(6); PG8_BAR; PG8_MMA(1, 1, At, B1); PG8_BAR;
        }
        if constexpr (!Epi::AFTER_DRAIN) E(acc, cur, wr, wc, fr, fq);
        if (!has_next) break;
#pragma unroll
        for (int a = 0; a < 2; ++a)
#pragma unroll
            for (int b = 0; b < 2; ++b)
#pragma unroll
                for (int m = 0; m < 4; ++m)
#pragma unroll
                    for (int n = 0; n < 2; ++n) acc[a][b][m][n] = (f32x4){0.f, 0.f, 0.f, 0.f};
        cur = nxt; cA = nA; cB = nB; ++ui;
    }
    PG8_WAIT_V(0);
    if (wr == 0) PG8_BAR;
    PG8_BAR;
    if constexpr (Epi::AFTER_DRAIN) E.fused(acc, cur, wr, wc, fr, fq, lds, wid, lane);
#undef PG8_SA
#undef PG8_SB
#undef PG8_STAGE
#undef PG8_LDA
#undef PG8_LDB
#undef PG8_MMA
#undef PG8_WAIT_V
#undef PG8_WAIT_L
#undef PG8_BAR
#undef PG8_SCHED
}
}

struct EpiProjF32 {
    static constexpr bool PERM = false;
    static constexpr bool AFTER_DRAIN = false;
    float* proj;
    __device__ __forceinline__ void operator()(const f32x4 (&acc)[2][2][4][2], const pg8::Unit& u, int wr, int wc, int fr, int fq) const {
#pragma unroll
        for (int ai = 0; ai < 2; ++ai)
#pragma unroll
            for (int m = 0; m < 4; ++m) {
                const int t = u.pm * 256 + ai * 128 + wr * 64 + m * 16 + fr - RPAD;
                if (t >= 0) {
#pragma unroll
                    for (int bj = 0; bj < 2; ++bj)
#pragma unroll
                        for (int n = 0; n < 2; ++n) {
                            const int off = wc * 32 + n * 16 + fq * 4;
                            const int col = u.pn < 4 ? u.pn * 256 + bj * 128 + off : (bj ? 2048 : 1024) + (u.pn - 4) * 128 + off;
                            *(f32x4*)(proj + (size_t)t * INW + col) = acc[ai][bj][m][n];
                        }
                }
            }
    }
};


__device__ __forceinline__ float sigmoidf_fast(float x) { return __builtin_amdgcn_rcpf(1.0f + __expf(-x)); }

struct EpiProj {
    static constexpr bool PERM = true;
    static constexpr bool AFTER_DRAIN = false;
    bf16_t* xp; bf16_t* glu; const float* rstd1;
    __device__ __forceinline__ void operator()(const f32x4 (&acc)[2][2][4][2], const pg8::Unit& u, int wr, int wc, int fr, int fq) const {
#pragma unroll
        for (int ai = 0; ai < 2; ++ai)
#pragma unroll
            for (int m = 0; m < 4; ++m) {
                const size_t row = (size_t)(u.pm * 256 + ai * 128 + wr * 64 + m * 16 + fr);
                const float rs = rstd1[row];
                if (u.pn < 4) {
#pragma unroll
                    for (int bj = 0; bj < 2; ++bj) { const f32x4 v0 = acc[ai][bj][m][0] * rs, v1 = acc[ai][bj][m][1] * rs;
                        store16_wt(xp + row * PWD + u.pn * 256 + bj * 128 + wc * 32 + fq * 8, (u32x4){cvt_pk_bf16(v0[0], v0[1]), cvt_pk_bf16(v0[2], v0[3]), cvt_pk_bf16(v1[0], v1[1]), cvt_pk_bf16(v1[2], v1[3])}); }
                } else {
                    const f32x4 a0 = acc[ai][0][m][0] * rs, a1 = acc[ai][0][m][1] * rs, g0 = acc[ai][1][m][0] * rs, g1 = acc[ai][1][m][1] * rs;
                    store16_wt(glu + row * CWD + (u.pn - 4) * 128 + wc * 32 + fq * 8, (u32x4){
                        cvt_pk_bf16(a0[0] * sigmoidf_fast(g0[0]), a0[1] * sigmoidf_fast(g0[1])), cvt_pk_bf16(a0[2] * sigmoidf_fast(g0[2]), a0[3] * sigmoidf_fast(g0[3])),
                        cvt_pk_bf16(a1[0] * sigmoidf_fast(g1[0]), a1[1] * sigmoidf_fast(g1[1])), cvt_pk_bf16(a1[2] * sigmoidf_fast(g1[2]), a1[3] * sigmoidf_fast(g1[3]))});
                }
            }
    }
};
struct EpiBf16Out {
    static constexpr bool PERM = true;
    static constexpr bool AFTER_DRAIN = false;
    bf16_t* O; int ldc; int col0; const float* bias;
    __device__ __forceinline__ void operator()(const f32x4 (&acc)[2][2][4][2], const pg8::Unit& u, int wr, int wc, int fr, int fq) const {
#pragma unroll
        for (int ai = 0; ai < 2; ++ai)
#pragma unroll
            for (int m = 0; m < 4; ++m) {
                const size_t row = (size_t)(u.pm * 256 + ai * 128 + wr * 64 + m * 16 + fr);
#pragma unroll
                for (int bj = 0; bj < 2; ++bj) { const int c = u.pn * 256 + bj * 128 + wc * 32 + fq * 8; f32x4 v0 = acc[ai][bj][m][0], v1 = acc[ai][bj][m][1];
                    if (bias) { v0 += *(const f32x4*)(bias + c); v1 += *(const f32x4*)(bias + c + 4); }
                    *(u32x4*)(O + row * ldc + col0 + c) = (u32x4){cvt_pk_bf16(v0[0], v0[1]), cvt_pk_bf16(v0[2], v0[3]), cvt_pk_bf16(v1[0], v1[1]), cvt_pk_bf16(v1[2], v1[3])}; }
            }
    }
};
struct EpiResid {
    static constexpr bool PERM = true;
    static constexpr bool AFTER_DRAIN = false;
    const bf16_t* xb; const float* bias; bf16_t* h2b; float* ssq;
    __device__ __forceinline__ void operator()(const f32x4 (&acc)[2][2][4][2], const pg8::Unit& u, int wr, int wc, int fr, int fq) const {
#pragma unroll
        for (int ai = 0; ai < 2; ++ai)
#pragma unroll
            for (int m = 0; m < 4; ++m) {
                const size_t row = (size_t)(u.pm * 256 + ai * 128 + wr * 64 + m * 16 + fr);
                float ss = 0.f;
#pragma unroll
                for (int bj = 0; bj < 2; ++bj) { const int c = u.pn * 256 + bj * 128 + wc * 32 + fq * 8;
                    const u32x4 xw = *(const u32x4*)(xb + (row + 256) * D + c);
                    const f32x4 v0 = acc[ai][bj][m][0] + (f32x4){bf_lo(xw.x), bf_hi(xw.x), bf_lo(xw.y), bf_hi(xw.y)} + *(const f32x4*)(bias + c);
                    const f32x4 v1 = acc[ai][bj][m][1] + (f32x4){bf_lo(xw.z), bf_hi(xw.z), bf_lo(xw.w), bf_hi(xw.w)} + *(const f32x4*)(bias + c + 4);
                    store16_wt(h2b + row * D + c, (u32x4){cvt_pk_bf16(v0[0], v0[1]), cvt_pk_bf16(v0[2], v0[3]), cvt_pk_bf16(v1[0], v1[1]), cvt_pk_bf16(v1[2], v1[3])});
                    ss += ((v0[0] * v0[0] + v0[1] * v0[1]) + (v0[2] * v0[2] + v0[3] * v0[3])) + ((v1[0] * v1[0] + v1[1] * v1[1]) + (v1[2] * v1[2] + v1[3] * v1[3])); }
                ss += __shfl_xor(ss, 16); ss += __shfl_xor(ss, 32);
                if (fq == 0) ssq[row * 32 + u.pn * 4 + wc] = ss;
            }
    }
};

__device__ __forceinline__ float fsel(int mask, float a, float b) { return __int_as_float((__float_as_int(a) & ~mask) | (__float_as_int(b) & mask)); }

__device__ __forceinline__ u32x4 bload16(__amdgpu_buffer_rsrc_t r, int voff, int soff) { return __builtin_bit_cast(u32x4, __builtin_amdgcn_raw_buffer_load_b128(r, voff, soff, 0)); }
__device__ __forceinline__ unsigned bload4(__amdgpu_buffer_rsrc_t r, int voff, int soff) { return (unsigned)__builtin_amdgcn_raw_buffer_load_b32(r, voff, soff, 0); }
__device__ __forceinline__ void bstore4(__amdgpu_buffer_rsrc_t r, unsigned v, int voff, int soff) { __builtin_amdgcn_raw_buffer_store_b32(v, r, voff, soff, 0); }
__device__ __forceinline__ u32x2 bload8(__amdgpu_buffer_rsrc_t r, int voff, int soff) { return __builtin_bit_cast(u32x2, __builtin_amdgcn_raw_buffer_load_b64(r, voff, soff, 0)); }
template <int W> __device__ __forceinline__ void pool_tile(__amdgpu_buffer_rsrc_t rxp, __amdgpu_buffer_rsrc_t rpo, int r0, int tile, int tid) {
    unsigned v[32 + W - 1];
#pragma unroll
    for (int i = 0; i < 32 + W - 1; ++i) v[i] = bload4(rxp, tid * 4, (r0 - (W - 1) + i) * 2048);
    float s0 = 0.f, s1 = 0.f;
#pragma unroll
    for (int i = 0; i < W - 1; ++i) { s0 += bf_lo(v[i]); s1 += bf_hi(v[i]); }
    constexpr float inv = 1.0f / (float)W;
#pragma unroll
    for (int i = 0; i < 32; ++i) {
        const float a0 = bf_lo(v[W - 1 + i]), a1 = bf_hi(v[W - 1 + i]);
        s0 += a0; s1 += a1;
        bstore4(rpo, cvt_pk_bf16(s0 * inv - a0, s1 * inv - a1), tid * 4, (tile * 32 + i) * 4096);
        s0 -= bf_lo(v[i]); s1 -= bf_hi(v[i]);
    }
}
__device__ __forceinline__ void phase_mix(const Params& p, LAS unsigned char* lds, int bid, int nb) {
    const int tid = threadIdx.x, lane = tid & 63, wave = tid >> 6;
    LAS unsigned* gl = (LAS unsigned*)lds;
    LAS float* red = (LAS float*)(lds + 62 * 2048);
    const __amdgpu_buffer_rsrc_t rxp = __builtin_amdgcn_make_buffer_rsrc((void*)p.xp, 0, RT * PWD * 2, 0x00020000);
    const __amdgpu_buffer_rsrc_t rgl = __builtin_amdgcn_make_buffer_rsrc((void*)p.glu, 0, RT * CWD * 2, 0x00020000);
    const __amdgpu_buffer_rsrc_t rpo = __builtin_amdgcn_make_buffer_rsrc((void*)p.mixb, 0, SEQ * D * 2, 0x00020000);
    const __amdgpu_buffer_rsrc_t rww = __builtin_amdgcn_make_buffer_rsrc((void*)p.dw_w, 0, KS * CWD * 4, 0x00020000);
    const __amdgpu_buffer_rsrc_t rwb = __builtin_amdgcn_make_buffer_rsrc((void*)p.dw_b, 0, CWD * 4, 0x00020000);
    const __amdgpu_buffer_rsrc_t rlg = __builtin_amdgcn_make_buffer_rsrc((void*)p.ln_g, 0, CWD * 4, 0x00020000);
    const __amdgpu_buffer_rsrc_t rlb = __builtin_amdgcn_make_buffer_rsrc((void*)p.ln_b, 0, CWD * 4, 0x00020000);
    for (int tile = bid; tile < SEQ / 32; tile += nb) {
        const int r0 = 256 + tile * 32;
        __syncthreads();
#pragma unroll
        for (int j = 0; j < 16; ++j) { const int ch = j * NT + tid; if (ch < 62 * 128)
            *(LAS u32x4*)(lds + ch * 16) = bload16(rgl, tid * 16, (r0 - 30) * 2048 + j * 8192); }
        { const int g = __builtin_amdgcn_readfirstlane(tid >> 7);
          if (g == 0) pool_tile<2>(rxp, rpo, r0, tile, tid); else if (g == 1) pool_tile<4>(rxp, rpo, r0, tile, tid); else if (g == 2) pool_tile<8>(rxp, rpo, r0, tile, tid); else pool_tile<16>(rxp, rpo, r0, tile, tid); }
        __syncthreads();
#pragma unroll 1
        for (int hf = 0; hf < 2; ++hf) {
            float c0[16], c1[16];
            {
                float w0[KS], w1[KS];
#pragma unroll
                for (int k = 0; k < KS; ++k) { const u32x2 wv = bload8(rww, tid * 8, k * 4096); w0[k] = __uint_as_float(wv.x); w1[k] = __uint_as_float(wv.y); }
                const u32x2 bvv = bload8(rwb, tid * 8, 0); const float b0 = __uint_as_float(bvv.x), b1 = __uint_as_float(bvv.y);
#pragma unroll
                for (int i = 0; i < 16; ++i) { c0[i] = b0; c1[i] = b1; }
                const LAS unsigned* glh = gl + hf * 16 * 512 + tid;
#pragma unroll
                for (int rr = 0; rr < 46; ++rr) {
                    if ((rr & 7) == 0) asm volatile("" ::: "memory");
                    const unsigned vv = glh[rr * 512]; const float x0 = bf_lo(vv), x1 = bf_hi(vv);
#pragma unroll
                    for (int i = 0; i < 16; ++i) { const int k = rr - i; if (k >= 0 && k < KS) { c0[i] += x0 * w0[k]; c1[i] += x1 * w1[k]; } }
                }
            }
            asm volatile("" ::: "memory");
#pragma unroll
            for (int which = 0; which < 2; ++which) {
                float st[16];
#pragma unroll
                for (int i = 0; i < 16; ++i) st[i] = which == 0 ? c0[i] + c1[i] : c0[i] * c0[i] + c1[i] * c1[i];
#pragma unroll
                for (int lvl = 0; lvl < 4; ++lvl) {
                    const int o = 32 >> lvl, n = 8 >> lvl; const int mk = -((lane >> (5 - lvl)) & 1);
#pragma unroll
                    for (int j = 0; j < 8; ++j) if (j < n) st[j] = fsel(mk, st[j], st[j + n]) + __shfl_xor(fsel(mk, st[j + n], st[j]), o);
                }
                float tot = st[0] + __shfl_xor(st[0], 2); tot += __shfl_xor(tot, 1);
                if ((lane & 3) == 0) red[wave * 32 + which * 16 + (lane >> 2)] = tot;
            }
            __syncthreads();
            if (tid < 32) { float t = 0.f;
#pragma unroll
                for (int q = 0; q < 8; ++q) t += red[q * 32 + tid];
                red[256 + tid] = t; }
            __syncthreads();
            const u32x2 lgv = bload8(rlg, tid * 8, 0), lbv = bload8(rlb, tid * 8, 0); const float lg0 = __uint_as_float(lgv.x), lg1 = __uint_as_float(lgv.y), lb0 = __uint_as_float(lbv.x), lb1 = __uint_as_float(lbv.y);
#pragma unroll
            for (int i = 0; i < 16; ++i) {
                const float s1 = red[256 + i], s2 = red[256 + 16 + i];
                const float mu = s1 * (1.0f / CWD), var = fmaxf(s2 * (1.0f / CWD) - mu * mu, 0.f), rs = rsqrtf(var + 1e-5f);
                const float y0 = (c0[i] - mu) * rs * lg0 + lb0, y1 = (c1[i] - mu) * rs * lg1 + lb1;
                bstore4(rpo, cvt_pk_bf16(y0 * sigmoidf_fast(y0), y1 * sigmoidf_fast(y1)), tid * 4, (tile * 32 + hf * 16 + i) * 4096 + 2048);
            }
            __syncthreads();
        }
    }
}

typedef float f32x16 __attribute__((ext_vector_type(16)));
__device__ __forceinline__ int okey(float s) { const int u = __float_as_int(s); return u ^ ((u >> 31) & 0x7fffffff); }
__device__ __forceinline__ float okey_inv(int k) { return __int_as_float(k ^ ((k >> 31) & 0x7fffffff)); }
__device__ __forceinline__ void sort16_desc(int (&v)[16]) {
#pragma unroll
    for (int k = 2; k <= 16; k <<= 1) {
#pragma unroll
        for (int j = k >> 1; j > 0; j >>= 1) {
#pragma unroll
            for (int i = 0; i < 16; ++i) {
                const int l = i ^ j;
                if (l > i) { const bool desc = (i & k) == 0; const int hi = max(v[i], v[l]), lo = min(v[i], v[l]); v[i] = desc ? hi : lo; v[l] = desc ? lo : hi; }
            }
        }
    }
}
__device__ __forceinline__ void merge16_desc(int (&a)[16], const int (&b)[16]) {
#pragma unroll
    for (int i = 0; i < 16; ++i) a[i] = max(a[i], b[15 - i]);
#pragma unroll
    for (int j = 8; j > 0; j >>= 1) {
#pragma unroll
        for (int i = 0; i < 16; ++i) { const int l = i ^ j; if (l > i) { const int hi = max(a[i], a[l]), lo = min(a[i], a[l]); a[i] = hi; a[l] = lo; } }
    }
}
__device__ __forceinline__ void pair_merge(int (&a)[16]) {
    int b[16];
#pragma unroll
    for (int i = 0; i < 16; ++i) b[i] = __shfl_xor(a[i], 32);
    merge16_desc(a, b);
}
constexpr int CELL_I[64] = {0,0,0,0,0,0,0,0,0,0,0,0,0,0,0,0,1,1,1,1,1,1,1,1,2,2,2,2,2,3,3,3,3,4,4,4,5,5,6,6,7,7,8,9,10,11,12,13,14,15,0,0,0,0,0,0,0,0,0,0,0,0,0,0};
constexpr int CELL_J[64] = {0,1,2,3,4,5,6,7,8,9,10,11,12,13,14,15,0,1,2,3,4,5,6,7,0,1,2,3,4,0,1,2,3,0,1,2,0,1,0,1,0,1,0,0,0,0,0,0,0,0,0,0,0,0,0,0,0,0,0,0,0,0,0,0};
constexpr int NCELL = 50;

struct EpiQTopk {
    static constexpr bool PERM = false;
    static constexpr bool AFTER_DRAIN = true;
    const float* ssq; float* rstd; const bf16_t* keysb; unsigned short* idx; float* gsu;
    __device__ __forceinline__ void fused(const f32x4 (&acc)[2][2][4][2], const pg8::Unit& u, int wr, int wc, int fr, int fq, LAS unsigned char* lds, int wid, int lane) const {
        const int hh = lane >> 5, l31 = lane & 31, h = u.pn;
        LAS float* svt = (LAS float*)(lds + 65536 + (wid * 64 + lane) * 164);
        LAS unsigned char* sit = (LAS unsigned char*)(svt + 32);
        float rs[2][4];
#pragma unroll
        for (int ai = 0; ai < 2; ++ai)
#pragma unroll
            for (int m = 0; m < 4; ++m) {
                const size_t row = (size_t)(u.pm * 256 + ai * 128 + wr * 64 + m * 16 + fr);
                const f32x4* sp = (const f32x4*)(ssq + row * 32); f32x4 t = sp[0];
#pragma unroll
                for (int i = 1; i < 8; ++i) t += sp[i];
                rs[ai][m] = rsqrtf(((t[0] + t[1]) + (t[2] + t[3])) * (1.0f / D) + 1e-6f);
                if (u.pn == 0 && wc == 0 && fq == 0) rstd[row] = rs[ai][m];
            }
        const int trow = wid * 32 + l31;
#pragma unroll
        for (int ph = 0; ph < 2; ++ph) {
#pragma unroll
            for (int ai = 0; ai < 2; ++ai)
#pragma unroll
                for (int m = 0; m < 4; ++m) { const int row = ai * 128 + wr * 64 + m * 16 + fr;
#pragma unroll
                    for (int n = 0; n < 2; ++n) { const f32x4 v = acc[ai][ph][m][n] * rs[ai][m]; const int chunk = 4 * wc + 2 * n + (fq >> 1);
                        u32x2 w; w.x = cvt_pk_bf16(v[0], v[1]); w.y = cvt_pk_bf16(v[2], v[3]);
                        *(LAS u32x2*)(lds + row * 256 + ((chunk ^ (row & 15)) << 4) + (fq & 1) * 8) = w; } }
            __syncthreads();
            const bf16_t* krow = keysb + ((size_t)(h * 2 + ph) * 128 + l31) * 128 + 8 * hh;
            bf16x8 bq[8];
#pragma unroll
            for (int ks = 0; ks < 8; ++ks) bq[ks] = *(const LAS bf16x8*)(lds + trow * 256 + (((ks * 2 + hh) ^ (trow & 15)) << 4));
            int top[16];
#pragma unroll
            for (int i = 0; i < 16; ++i) top[i] = (int)0x80000000;
            bf16x8 ak[8];
#pragma unroll
            for (int ks = 0; ks < 8; ++ks) ak[ks] = *(const bf16x8*)(krow + ks * 16);
#pragma unroll 1
            for (int kt = 0; kt < 4; ++kt) {
                f32x16 c = {0.f, 0.f, 0.f, 0.f, 0.f, 0.f, 0.f, 0.f, 0.f, 0.f, 0.f, 0.f, 0.f, 0.f, 0.f, 0.f};
#pragma unroll
                for (int ks = 0; ks < 8; ++ks) c = __builtin_amdgcn_mfma_f32_32x32x16_bf16(ak[ks], bq[ks], c, 0, 0, 0);
                { const int kn = kt < 3 ? kt + 1 : 3;
#pragma unroll
                  for (int ks = 0; ks < 8; ++ks) ak[ks] = *(const bf16x8*)(krow + (size_t)kn * 32 * 128 + ks * 16); }
                int v[16];
                const int lowb = (127 - kt * 32) ^ (hh << 2);
#pragma unroll
                for (int r = 0; r < 16; ++r) v[r] = (okey(c[r]) & ~127) | (lowb - ((r & 3) + 8 * (r >> 2)));
                sort16_desc(v);
                merge16_desc(top, v);
            }
            pair_merge(top);
#pragma unroll
            for (int i = 0; i < 16; ++i) { svt[ph * 16 + i] = okey_inv(top[i] & ~127); sit[ph * 16 + i] = (unsigned char)(127 - (top[i] & 127)); }
            __syncthreads();
        }
        float sv[2][16];
#pragma unroll
        for (int i = 0; i < 16; ++i) { sv[0][i] = svt[i]; sv[1][i] = svt[16 + i]; }
        int w0[16], w1[16];
#pragma unroll
        for (int s = 0; s < 32; ++s) {
            const int e0 = 2 * s, e1 = 2 * s + 1;
            int key;
            if (e0 >= NCELL) key = (int)0x80000000;
            else {
                const float v0 = sv[0][CELL_I[e0]] + sv[1][CELL_J[e0]];
                const int k0 = (okey(v0) & ~255) | (255 - (CELL_I[e0] * 16 + CELL_J[e0]));
                if (e1 >= NCELL) key = hh ? (int)0x80000000 : k0;
                else { const float v1 = sv[0][CELL_I[e1]] + sv[1][CELL_J[e1]];
                    const int k1 = (okey(v1) & ~255) | (255 - (CELL_I[e1] * 16 + CELL_J[e1]));
                    key = hh ? k1 : k0; }
            }
            if (s < 16) w0[s] = key; else w1[s - 16] = key;
        }
        sort16_desc(w0); sort16_desc(w1); merge16_desc(w0, w1); pair_merge(w0);
        const float mx = okey_inv(w0[0] & ~255);
        float sum = 0.f;
#pragma unroll
        for (int k = 0; k < 16; ++k) sum += __expf(okey_inv(w0[k] & ~255) - mx);
        const float inv = 1.0f / sum;
        int eo[8]; float go[8]; const int hmask = -hh;
#pragma unroll
        for (int k = 0; k < 8; ++k) { const int kk = (w0[k] & ~hmask) | (w0[8 + k] & hmask); const int cc = 255 - (kk & 255);
            eo[k] = (int)sit[cc >> 4] * 128 + (int)sit[16 + (cc & 15)]; go[k] = __expf(okey_inv(kk & ~255) - mx) * inv; }
        const size_t ob = (size_t)(u.pm * 256 + trow) * 128 + h * 16 + hh * 8;
        *(u32x4*)(idx + ob) = (u32x4){(unsigned)eo[0] | ((unsigned)eo[1] << 16), (unsigned)eo[2] | ((unsigned)eo[3] << 16), (unsigned)eo[4] | ((unsigned)eo[5] << 16), (unsigned)eo[6] | ((unsigned)eo[7] << 16)};
        *(f32x4*)(gsu + ob) = (f32x4){go[0], go[1], go[2], go[3]};
        *(f32x4*)(gsu + ob + 4) = (f32x4){go[4], go[5], go[6], go[7]};
    }
    __device__ __forceinline__ void operator()(const f32x4 (&)[2][2][4][2], const pg8::Unit&, int, int, int, int) const {}
};

__device__ __forceinline__ void fp8_row2(const float* s0, unsigned char* d0, float* i0, const float* s1, unsigned char* d1, float* i1, int lane) {
    f32x4 v[2][2][4]; float am[2] = {0.f, 0.f};
#pragma unroll
    for (int r = 0; r < 2; ++r)
#pragma unroll
        for (int k = 0; k < 2; ++k)
#pragma unroll
            for (int i = 0; i < 4; ++i) v[r][k][i] = __builtin_nontemporal_load((const f32x4*)((r ? s1 : s0) + 1024 * k + 16 * lane + 4 * i));
#pragma unroll
    for (int r = 0; r < 2; ++r) {
#pragma unroll
        for (int k = 0; k < 2; ++k)
#pragma unroll
            for (int i = 0; i < 4; ++i) am[r] = fmaxf(am[r], fmaxf(fmaxf(fabsf(v[r][k][i].x), fabsf(v[r][k][i].y)), fmaxf(fabsf(v[r][k][i].z), fabsf(v[r][k][i].w))));
#pragma unroll
        for (int o = 1; o < 64; o <<= 1) am[r] = fmaxf(am[r], __shfl_xor(am[r], o));
        int be = (__float_as_int(am[r]) >> 23) & 255; be = be < 8 ? 8 : (be > 248 ? 248 : be);
        const float sc = __int_as_float((260 - be) << 23), isc = __int_as_float((be - 6) << 23);
#pragma unroll
        for (int k = 0; k < 2; ++k) { u32x4 w; unsigned ww[4];
#pragma unroll
            for (int i = 0; i < 4; ++i) { int t = 0; t = __builtin_amdgcn_cvt_pk_fp8_f32(v[r][k][i].x * sc, v[r][k][i].y * sc, t, false); t = __builtin_amdgcn_cvt_pk_fp8_f32(v[r][k][i].z * sc, v[r][k][i].w * sc, t, true); ww[i] = (unsigned)t; }
            w.x = ww[0]; w.y = ww[1]; w.z = ww[2]; w.w = ww[3];
            *(u32x4*)((r ? d1 : d0) + 1024 * k + 16 * lane) = w; }
        if (lane == 0) *(r ? i1 : i0) = isc;
    }
}

typedef float f32x2 __attribute__((ext_vector_type(2)));
template <int N> __device__ __forceinline__ f32x2 dot16_fp8(const u32x4 w, const f32x2 (&x)[N], int o, f32x2 acc) {
    const unsigned ww[4] = {w.x, w.y, w.z, w.w};
#pragma unroll
    for (int d = 0; d < 4; ++d) { acc += __builtin_amdgcn_cvt_pk_f32_fp8((int)ww[d], false) * x[o + 2 * d]; acc += __builtin_amdgcn_cvt_pk_f32_fp8((int)ww[d], true) * x[o + 2 * d + 1]; }
    return acc;
}
template <int N> __device__ __forceinline__ void axpy16_fp8(const u32x4 w, float a, f32x2 (&y)[N], int o) {
    const unsigned ww[4] = {w.x, w.y, w.z, w.w}; const f32x2 a2 = {a, a};
#pragma unroll
    for (int d = 0; d < 4; ++d) { y[o + 2 * d] += a2 * __builtin_amdgcn_cvt_pk_f32_fp8((int)ww[d], false); y[o + 2 * d + 1] += a2 * __builtin_amdgcn_cvt_pk_f32_fp8((int)ww[d], true); }
}
__device__ __forceinline__ void bstore16(__amdgpu_buffer_rsrc_t r, f32x4 v, int voff, int soff) { __builtin_amdgcn_raw_buffer_store_b128(__builtin_bit_cast(__attribute__((__vector_size__(4 * sizeof(unsigned)))) unsigned, v), r, voff, soff, 0); }
__device__ __forceinline__ void bstore8(__amdgpu_buffer_rsrc_t r, f32x2 v, int voff, int soff) { __builtin_amdgcn_raw_buffer_store_b64(__builtin_bit_cast(__attribute__((__vector_size__(2 * sizeof(unsigned)))) unsigned, v), r, voff, soff, 0); }
__device__ __forceinline__ f32x2 fsel2(int mask, f32x2 a, f32x2 b) { return (f32x2){fsel(mask, a.x, b.x), fsel(mask, a.y, b.y)}; }
__device__ __forceinline__ f32x2 shx2(f32x2 a, int o) { return (f32x2){__shfl_xor(a.x, o), __shfl_xor(a.y, o)}; }

__device__ __forceinline__ void phase_pd(const Params& p, LAS unsigned char* lds, int bid, int nb) {
    const int tid = threadIdx.x, lane = tid & 63, wave = __builtin_amdgcn_readfirstlane(tid >> 6);
    if (wave == 7) {
        for (int e = bid; e < 16384; e += 2 * nb) { const int e2 = e + nb < 16384 ? e + nb : e;
            fp8_row2(p.up + (size_t)e * D, p.up8 + (size_t)e * D, p.sup + e, p.up + (size_t)e2 * D, p.up8 + (size_t)e2 * D, p.sup + e2, lane); }
        return;
    }
    const int v = bid & 7, lw = (bid >> 3) * 7 + wave, NLW = (nb >> 3) * 7;
    const int c = lane & 7, sub = lane >> 3;
    const int m0 = -(lane & 1), m1 = -((lane >> 1) & 1), m2 = -((lane >> 2) & 1);
    const __amdgpu_buffer_rsrc_t rd = __builtin_amdgcn_make_buffer_rsrc((void*)p.down8, 0, 16384 * D, 0x00020000);
    const __amdgpu_buffer_rsrc_t rh = __builtin_amdgcn_make_buffer_rsrc((void*)p.h2b, 0, SEQ * D * 2, 0x00020000);
    const __amdgpu_buffer_rsrc_t rg1 = __builtin_amdgcn_make_buffer_rsrc((void*)p.ffn_g, 0, D * 4, 0x00020000);
    const __amdgpu_buffer_rsrc_t ri = __builtin_amdgcn_make_buffer_rsrc((void*)p.idx, 0, SEQ * 128 * 2, 0x00020000);
    const __amdgpu_buffer_rsrc_t rrs = __builtin_amdgcn_make_buffer_rsrc((void*)p.rstd, 0, SEQ * 4, 0x00020000);
    const __amdgpu_buffer_rsrc_t rp = __builtin_amdgcn_make_buffer_rsrc((void*)p.part, 0, SEQ * 8 * 128 * 2, 0x00020000);
    LAS f32x2* pl = (LAS f32x2*)lds + wave * (40 * 64) + lane;
    const int vsub = sub * 32, vc2 = c * 32, vc1 = c * 16, vl4 = lane * 4;
#pragma unroll 1
    for (int pass = 0; pass < 2; ++pass) {
        const int sl = v * 2 + pass;
        f32x2 gs[8];
#pragma unroll
        for (int i = 0; i < 4; ++i) { const f32x4 g = __builtin_bit_cast(f32x4, bload16(rg1, c * 64, sl * 512 + i * 16)); gs[2 * i] = (f32x2){g[0], g[1]}; gs[2 * i + 1] = (f32x2){g[2], g[3]}; }
        u32x4 ix[2], hh[2]; unsigned rsb;
        {
            const int t = lw;
#pragma unroll
            for (int i = 0; i < 2; ++i) ix[i] = bload16(ri, vsub, t * 256 + i * 16);
            hh[0] = bload16(rh, vc2, t * 4096 + sl * 256); hh[1] = bload16(rh, vc2, t * 4096 + sl * 256 + 16); rsb = bload4(rrs, 0, t * 4);
        }
        int trip = 0;
#pragma unroll 1
        for (int t = lw; t < SEQ; t += NLW) {
            asm volatile("" ::: "memory");
            u32x4 w[16];
            {
                const unsigned ew[8] = {ix[0].x, ix[0].y, ix[0].z, ix[0].w, ix[1].x, ix[1].y, ix[1].z, ix[1].w};
#pragma unroll
                for (int g = 0; g < 16; ++g) { const unsigned e = (g & 1) ? (ew[g >> 1] >> 16) : (ew[g >> 1] & 0xffffu); w[g] = bload16(rd, (int)(e * 2048u) + vc1, sl * 128); }
            }
            f32x2 xs[8];
            {
                const float rs = __uint_as_float(rsb);
                const unsigned hw[8] = {hh[0].x, hh[0].y, hh[0].z, hh[0].w, hh[1].x, hh[1].y, hh[1].z, hh[1].w};
#pragma unroll
                for (int i = 0; i < 8; ++i) xs[i] = (f32x2){bf_lo(hw[i]) * rs, bf_hi(hw[i]) * rs} * gs[i];
            }
            asm volatile("" ::: "memory");
            {
                const int tn = t + NLW < SEQ ? t + NLW : t;
#pragma unroll
                for (int i = 0; i < 2; ++i) ix[i] = bload16(ri, vsub, tn * 256 + i * 16);
                hh[0] = bload16(rh, vc2, tn * 4096 + sl * 256); hh[1] = bload16(rh, vc2, tn * 4096 + sl * 256 + 16); rsb = bload4(rrs, 0, tn * 4);
            }
            asm volatile("" ::: "memory");
            float r[16];
#pragma unroll
            for (int g = 0; g < 16; ++g) { const f32x2 z = {0.f, 0.f}; const f32x2 s2 = dot16_fp8(w[g], xs, 0, z); r[g] = s2.x + s2.y; }
            float k8[8], k4[4];
#pragma unroll
            for (int i = 0; i < 8; ++i) k8[i] = fsel(m2, r[i], r[i + 8]) + __shfl_xor(fsel(m2, r[i + 8], r[i]), 4);
#pragma unroll
            for (int i = 0; i < 4; ++i) k4[i] = fsel(m1, k8[i], k8[i + 4]) + __shfl_xor(fsel(m1, k8[i + 4], k8[i]), 2);
            const float k0 = fsel(m0, k4[0], k4[2]) + __shfl_xor(fsel(m0, k4[2], k4[0]), 1);
            const float k1 = fsel(m0, k4[1], k4[3]) + __shfl_xor(fsel(m0, k4[3], k4[1]), 1);
            if (pass == 0) pl[trip * 64] = (f32x2){k0, k1};
            else { const f32x2 pv = pl[trip * 64]; bstore4(rp, cvt_pk_bf16(k0 + pv.x, k1 + pv.y), vl4, (t * 8 + v) * 256); }
            ++trip;
        }
    }
}
__device__ __forceinline__ void phase_pa(const Params& p, int bid, int nb) {
    const int tid = threadIdx.x, lane = tid & 63, wave = tid >> 6;
    const int gw = bid * 8 + wave, NGW = nb * 8;
    for (int it = gw; it < SEQ * 2; it += NGW) {
        const int t = it >> 1, pp = (it & 1) * 64 + lane;
        const bf16_t* pr = p.part + (size_t)t * 1024 + pp;
        float hs = 0.f;
#pragma unroll
        for (int sl = 0; sl < 8; ++sl) hs += __uint_as_float((unsigned)pr[sl * 128] << 16);
        const int e = (int)p.idx[(size_t)t * 128 + pp];
        hs *= p.sdn[e];
        const float av = p.gsu[(size_t)t * 128 + pp] * p.sup[e] * 0.5f * hs * (1.0f + erff(hs * 0.70710678118654752f));
        p.act[(size_t)t * 128 + pp] = (bf16_t)(cvt_pk_bf16(av, 0.f) & 0xffffu);
    }
}
__device__ __forceinline__ void phase_pu(const Params& p, int bid, int nb) {
    const int tid = threadIdx.x, lane = tid & 63, wave = __builtin_amdgcn_readfirstlane(tid >> 6);
    const int v = bid & 7, lw = (bid >> 3) * 8 + wave, NLW = (nb >> 3) * 8;
    const int c = lane & 7, sub = lane >> 3;
    const int m3 = -((lane >> 3) & 1), m4 = -((lane >> 4) & 1), m5 = -((lane >> 5) & 1);
    const __amdgpu_buffer_rsrc_t ru = __builtin_amdgcn_make_buffer_rsrc((void*)p.up8, 0, 16384 * D, 0x00020000);
    const __amdgpu_buffer_rsrc_t rh = __builtin_amdgcn_make_buffer_rsrc((void*)p.h2b, 0, SEQ * D * 2, 0x00020000);
    const __amdgpu_buffer_rsrc_t ri = __builtin_amdgcn_make_buffer_rsrc((void*)p.idx, 0, SEQ * 128 * 2, 0x00020000);
    const __amdgpu_buffer_rsrc_t ra = __builtin_amdgcn_make_buffer_rsrc((void*)p.act, 0, SEQ * 128 * 2, 0x00020000);
    const __amdgpu_buffer_rsrc_t ro = __builtin_amdgcn_make_buffer_rsrc((void*)p.h3b, 0, SEQ * D * 2, 0x00020000);
    const __amdgpu_buffer_rsrc_t rq = __builtin_amdgcn_make_buffer_rsrc((void*)p.ssq2, 0, SEQ * 16 * 4, 0x00020000);
    const int vsub = sub * 32, vc1 = c * 16, vh = c * 32 + sub * 4;
#pragma unroll 1
    for (int pass = 0; pass < 2; ++pass) {
        const int sl = v * 2 + pass;
        u32x4 ix[2], ac[2]; unsigned hb;
        {
            const int t = lw;
#pragma unroll
            for (int i = 0; i < 2; ++i) { ix[i] = bload16(ri, vsub, t * 256 + i * 16); ac[i] = bload16(ra, vsub, t * 256 + i * 16); }
            hb = bload4(rh, vh, t * 4096 + sl * 256);
        }
#pragma unroll 1
        for (int t = lw; t < SEQ; t += NLW) {
            asm volatile("" ::: "memory");
            u32x4 w[16];
            {
                const unsigned ew[8] = {ix[0].x, ix[0].y, ix[0].z, ix[0].w, ix[1].x, ix[1].y, ix[1].z, ix[1].w};
#pragma unroll
                for (int g = 0; g < 16; ++g) { const unsigned e = (g & 1) ? (ew[g >> 1] >> 16) : (ew[g >> 1] & 0xffffu); w[g] = bload16(ru, (int)(e * 2048u) + vc1, sl * 128); }
            }
            const unsigned aw[8] = {ac[0].x, ac[0].y, ac[0].z, ac[0].w, ac[1].x, ac[1].y, ac[1].z, ac[1].w};
            float a[16];
#pragma unroll
            for (int g = 0; g < 16; ++g) a[g] = (g & 1) ? bf_hi(aw[g >> 1]) : bf_lo(aw[g >> 1]);
            const unsigned hcur = hb;
            asm volatile("" ::: "memory");
            {
                const int tn = t + NLW < SEQ ? t + NLW : t;
#pragma unroll
                for (int i = 0; i < 2; ++i) { ix[i] = bload16(ri, vsub, tn * 256 + i * 16); ac[i] = bload16(ra, vsub, tn * 256 + i * 16); }
                hb = bload4(rh, vh, tn * 4096 + sl * 256);
            }
            asm volatile("" ::: "memory");
            f32x2 acc[8];
#pragma unroll
            for (int i = 0; i < 8; ++i) acc[i] = (f32x2){0.f, 0.f};
#pragma unroll
            for (int g = 0; g < 16; ++g) axpy16_fp8(w[g], a[g], acc, 0);
            f32x2 k4[4], k2[2];
#pragma unroll
            for (int i = 0; i < 4; ++i) k4[i] = fsel2(m5, acc[i], acc[i + 4]) + shx2(fsel2(m5, acc[i + 4], acc[i]), 32);
#pragma unroll
            for (int i = 0; i < 2; ++i) k2[i] = fsel2(m4, k4[i], k4[i + 2]) + shx2(fsel2(m4, k4[i + 2], k4[i]), 16);
            f32x2 h3 = fsel2(m3, k2[0], k2[1]) + shx2(fsel2(m3, k2[1], k2[0]), 8);
            h3 += (f32x2){bf_lo(hcur), bf_hi(hcur)};
            bstore4(ro, cvt_pk_bf16(h3.x, h3.y), vh, t * 4096 + sl * 256);
            const float ss = wave_sum(h3.x * h3.x + h3.y * h3.y);
            if (lane == 0) bstore4(rq, __float_as_uint(ss), 0, (t * 16 + sl) * 4);
        }
    }
}
__device__ __forceinline__ void phase_pf(const Params& p, int bid, int nb) {
    const int tid = threadIdx.x, lane = tid & 63, wave = tid >> 6;
    const int gw = bid * 8 + wave, NGW = nb * 8;
    for (int t = gw; t < SEQ; t += NGW) {
        const f32x4* sp = (const f32x4*)(p.ssq2 + (size_t)t * 16); f32x4 q = sp[0] + sp[1] + sp[2] + sp[3];
        const float rf = rsqrtf(((q[0] + q[1]) + (q[2] + q[3])) * (1.0f / D) + 1e-6f);
        const u32x4* hp = (const u32x4*)(p.h3b + (size_t)t * D) + lane;
        f32x4* o = (f32x4*)(p.out + (size_t)t * D) + 2 * lane; const f32x4* g = (const f32x4*)p.fin_g + 2 * lane;
#pragma unroll
        for (int j = 0; j < 4; ++j) { const u32x4 h = hp[64 * j]; const f32x4 g0 = g[128 * j], g1 = g[128 * j + 1];
            o[128 * j] = (f32x4){bf_lo(h.x) * rf * g0[0], bf_hi(h.x) * rf * g0[1], bf_lo(h.y) * rf * g0[2], bf_hi(h.y) * rf * g0[3]};
            o[128 * j + 1] = (f32x4){bf_lo(h.z) * rf * g1[0], bf_hi(h.z) * rf * g1[1], bf_lo(h.w) * rf * g1[2], bf_hi(h.w) * rf * g1[3]}; }
    }
}

__device__ __forceinline__ void fp8_row(const float* src, unsigned char* dst, float* inv_scale, int lane) {
    f32x4 v[2][4]; float am = 0.f;
#pragma unroll
    for (int k = 0; k < 2; ++k)
#pragma unroll
        for (int i = 0; i < 4; ++i) { v[k][i] = *(const f32x4*)(src + 1024 * k + 16 * lane + 4 * i);
            am = fmaxf(am, fmaxf(fmaxf(fabsf(v[k][i].x), fabsf(v[k][i].y)), fmaxf(fabsf(v[k][i].z), fabsf(v[k][i].w)))); }
#pragma unroll
    for (int o = 1; o < 64; o <<= 1) am = fmaxf(am, __shfl_xor(am, o));
    int be = (__float_as_int(am) >> 23) & 255; be = be < 8 ? 8 : (be > 248 ? 248 : be);
    const float sc = __int_as_float((260 - be) << 23), isc = __int_as_float((be - 6) << 23);
#pragma unroll
    for (int k = 0; k < 2; ++k) { u32x4 w; unsigned ww[4];
#pragma unroll
        for (int i = 0; i < 4; ++i) { int t = 0; t = __builtin_amdgcn_cvt_pk_fp8_f32(v[k][i].x * sc, v[k][i].y * sc, t, false); t = __builtin_amdgcn_cvt_pk_fp8_f32(v[k][i].z * sc, v[k][i].w * sc, t, true); ww[i] = (unsigned)t; }
        w.x = ww[0]; w.y = ww[1]; w.z = ww[2]; w.w = ww[3];
        *(u32x4*)(dst + 1024 * k + 16 * lane) = w; }
    if (lane == 0) *inv_scale = isc;
}

__device__ __forceinline__ void tr_item(const float* W, int ldw, int srccol0, int k0, bf16_t* WT, int ldt, int n0, const float* kscale, const float* nscale, LAS float* scr, int lane) {
    f32x4 tv[8];
#pragma unroll
    for (int i = 0; i < 8; ++i) { const int kk = 8 * i + (lane >> 3); tv[i] = __builtin_nontemporal_load((const f32x4*)(W + (size_t)(k0 + kk) * ldw + srccol0 + 4 * (lane & 7))); }
    f32x4 ns = {1.f, 1.f, 1.f, 1.f};
    if (nscale) ns = *(const f32x4*)(nscale + srccol0 + 4 * (lane & 7));
#pragma unroll
    for (int i = 0; i < 8; ++i) { const int kk = 8 * i + (lane >> 3); f32x4 v = tv[i] * ns;
        if (kscale) v *= kscale[k0 + kk];
        LAS float* d = scr + kk * 33 + 4 * (lane & 7); d[0] = v[0]; d[1] = v[1]; d[2] = v[2]; d[3] = v[3]; }
    asm volatile("s_waitcnt lgkmcnt(0)" ::: "memory");
    const int c = lane & 7;
#pragma unroll
    for (int j = 0; j < 4; ++j) { const int n = (lane >> 3) + 8 * j; const LAS float* s = scr + (8 * c) * 33 + n;
        u32x4 o; o.x = cvt_pk_bf16(s[0 * 33], s[1 * 33]); o.y = cvt_pk_bf16(s[2 * 33], s[3 * 33]); o.z = cvt_pk_bf16(s[4 * 33], s[5 * 33]); o.w = cvt_pk_bf16(s[6 * 33], s[7 * 33]);
        *(u32x4*)(WT + (size_t)(n0 + n) * ldt + k0 + 8 * c) = o; }
    asm volatile("s_waitcnt lgkmcnt(0)" ::: "memory");
}
__device__ __forceinline__ int win_srccol(int n) { const int pn = n >> 8, w = n & 255; return pn < 4 ? n : ((w >> 7) ? 2048 : 1024) + (pn - 4) * 128 + (w & 127); }

__device__ __forceinline__ void phase_prep(const Params& p, LAS unsigned char* lds, int bid, int nb, int nlate) {
    const int tid = threadIdx.x, lane = tid & 63, wave = tid >> 6;
    const int gw = bid * 8 + wave, NGW = nb * 8;
    LAS float* scr = (LAS float*)(lds + wave * 8448);
    for (int r = gw; r < RT; r += NGW) {
        unsigned long long* o8 = (unsigned long long*)(p.hnb + (size_t)r * D) + lane;
        if (r < RPAD) {
#pragma unroll
            for (int j = 0; j < 8; ++j) o8[64 * j] = 0ull;
            if (lane == 0) p.rstd1[r] = 0.f;
        } else {
            const f32x4* xr = (const f32x4*)hrow(p, r - RPAD) + lane;
            f32x4 v[8]; float s = 0.f;
#pragma unroll
            for (int j = 0; j < 8; ++j) { v[j] = __builtin_nontemporal_load(xr + 64 * j); s += (v[j].x * v[j].x + v[j].y * v[j].y) + (v[j].z * v[j].z + v[j].w * v[j].w); }
            const float rs = rsqrtf(wave_sum(s) * (1.0f / D) + 1e-6f);
            if (lane == 0) p.rstd1[r] = rs;
#pragma unroll
            for (int j = 0; j < 8; ++j)
                o8[64 * j] = (unsigned long long)cvt_pk_bf16(v[j].x, v[j].y) | ((unsigned long long)cvt_pk_bf16(v[j].z, v[j].w) << 32);
        }
    }
    for (int it = gw; it < (D / 64) * (INW / 32); it += NGW) {
        const int kb = it / (INW / 32), nbk = it % (INW / 32);
        tr_item(p.w_in, INW, win_srccol(nbk * 32), kb * 64, p.w_in_t, D, nbk * 32, p.mix_g, nullptr, scr, lane);
    }
    for (int i = gw * 64 + lane; i < 4 * 256 * 256 / 4; i += NGW * 64) { const f32x4 v = ((const f32x4*)p.pool_w)[i];
        const int g = i >> 14, d = (i & 63) * 4; const f32x4 sc = *(const f32x4*)(p.pool_scale + g * 256 + d);
        u32x2 w; w.x = cvt_pk_bf16(v[0] * sc[0], v[1] * sc[1]); w.y = cvt_pk_bf16(v[2] * sc[2], v[3] * sc[3]); ((u32x2*)p.pool_ws)[i] = w; }
    for (int i = gw * 64 + lane; i < CWD * CWD / 4; i += NGW * 64) { const f32x4 v = ((const f32x4*)p.pw_w)[i];
        u32x2 w; w.x = cvt_pk_bf16(v[0], v[1]); w.y = cvt_pk_bf16(v[2], v[3]); ((u32x2*)p.pw_b16)[i] = w; }
    for (int it = gw; it < 32 * 64; it += NGW) { const int kb = it >> 6, nbk = it & 63;
        tr_item(p.w_out, D, nbk * 32, kb * 64, p.w_out_t, D, nbk * 32, nullptr, nullptr, scr, lane); }
    for (int it = gw; it < 32 * 64; it += NGW) { const int kb = it >> 6, nbk = it & 63;
        tr_item(p.wq, D, nbk * 32, kb * 64, p.wq_t, D, nbk * 32, p.ffn_g, nullptr, scr, lane); }
    for (int i = gw * 64 + lane; i < 8 * 2 * 128 * 128 / 4; i += NGW * 64) { const f32x4 v = ((const f32x4*)p.keys)[i];
        u32x2 w; w.x = cvt_pk_bf16(v[0], v[1]); w.y = cvt_pk_bf16(v[2], v[3]); ((u32x2*)p.keysb)[i] = w; }
    for (int e = gw; e < 16384 - nlate; e += 2 * NGW) { const int e2 = e + NGW < 16384 - nlate ? e + NGW : e;
        fp8_row2(p.down + (size_t)e * D, p.down8 + (size_t)e * D, p.sdn + e, p.down + (size_t)e2 * D, p.down8 + (size_t)e2 * D, p.sdn + e2, lane); }
}


#define XB_TMO      128
#define XB_XCNT(j)  (256  + 64 * (j))
#define XB_XSUB(j)  (1280 + 64 * (j))
#define XB_XGEN(j)  (2304 + 64 * (j))
#define XB_TOP      3328
#define XB_TOPGEN   3392
#define XCD_BAR_WORDS 3456
#define XB_SPIN_CAP (1u << 18)
__device__ __forceinline__ unsigned xb_ld(unsigned* p)              { return __hip_atomic_load(p, __ATOMIC_RELAXED, __HIP_MEMORY_SCOPE_AGENT); }
__device__ __forceinline__ unsigned xb_add(unsigned* p, unsigned v) { return __hip_atomic_fetch_add(p, v, __ATOMIC_RELAXED, __HIP_MEMORY_SCOPE_AGENT); }
__device__ __forceinline__ unsigned xb_xcc_id() { return (unsigned)__builtin_amdgcn_s_getreg((3 << 11) | 20) & 0xFu; }
#define XB_SPIN(cond, bar) do { unsigned _sp = 0; while (cond) { __builtin_amdgcn_s_sleep(1); \
    if ((++_sp & 255u) == 0u) { if (xb_ld(&(bar)[XB_TMO])) break; if (_sp > XB_SPIN_CAP) { atomicAdd(&(bar)[XB_TMO], 1u); break; } } } } while (0)
struct XcdBarrier { unsigned* bar; unsigned x; volatile LAS unsigned* st; };
__device__ __forceinline__ XcdBarrier xcd_barrier_post(unsigned* bar, volatile LAS unsigned* st) {
    XcdBarrier b; b.bar = bar; b.x = xb_xcc_id(); b.st = st;
    if (threadIdx.x == 0) (void)xb_add(&bar[XB_XCNT(b.x)], 1u);
    return b;
}
__device__ __forceinline__ void xcd_barrier_complete(unsigned* bar, unsigned x, unsigned& nloc, unsigned& nx) {
    const unsigned G = gridDim.x * gridDim.y * gridDim.z;
    unsigned sum, cnt, mine, sp = 0u;
    for (;;) {
        sum = 0u; cnt = 0u; mine = 0u;
#pragma unroll
        for (unsigned j = 0; j < 16; ++j) { const unsigned c = xb_ld(&bar[XB_XCNT(j)]); sum += c; cnt += (c > 0u) ? 1u : 0u; mine = (j == x) ? c : mine; }
        if (sum == G) break;
        __builtin_amdgcn_s_sleep(1);
        if ((++sp & 255u) == 0u) { if (xb_ld(&bar[XB_TMO])) break; if (sp > XB_SPIN_CAP) { atomicAdd(&bar[XB_TMO], 1u); break; } }
    }
    nloc = mine > 0u ? mine : 1u; nx = cnt > 0u ? cnt : 1u;
}
__device__ __forceinline__ void xcd_barrier(const XcdBarrier& b) {
    asm volatile("s_waitcnt vmcnt(0)" ::: "memory");
    __syncthreads();
    if (threadIdx.x == 0) {
        unsigned* bar = b.bar;
        __builtin_amdgcn_s_waitcnt(0);
        unsigned nloc = b.st[0], nx = b.st[1];
        if (nloc == 0u) { xcd_barrier_complete(bar, b.x, nloc, nx); b.st[0] = nloc; b.st[1] = nx; }
        const unsigned old = xb_add(&bar[XB_XSUB(b.x)], 1u);
        const unsigned gen = old / nloc;
        if (old + 1u == (gen + 1u) * nloc) {
            __builtin_amdgcn_fence(__ATOMIC_RELEASE, "agent");
            asm volatile("s_waitcnt vmcnt(0)" ::: "memory");
            const unsigned og = xb_add(&bar[XB_TOP], 1u);
            const unsigned tg = og / nx;
            if (og + 1u == (tg + 1u) * nx) xb_add(&bar[XB_TOPGEN], 1u);
            else XB_SPIN(xb_ld(&bar[XB_TOPGEN]) == tg, bar);
            __builtin_amdgcn_fence(__ATOMIC_ACQUIRE, "agent");
            xb_add(&bar[XB_XGEN(b.x)], 1u);
            asm volatile("s_waitcnt vmcnt(0)" ::: "memory");
        } else {
            XB_SPIN(xb_ld(&bar[XB_XGEN(b.x)]) == gen, bar);
            __builtin_amdgcn_fence(__ATOMIC_ACQUIRE, "agent");
            asm volatile("s_waitcnt vmcnt(0)" ::: "memory");
        }
    }
    __syncthreads();
}

__global__ void __launch_bounds__(NT, 2) k_mega(Params p) {
    extern __shared__ __attribute__((aligned(16))) unsigned char lds_raw[];
    LAS unsigned char* lds = (LAS unsigned char*)lds_raw;
    const int bid = blockIdx.x, nb = gridDim.x;
    volatile LAS unsigned* bst = (volatile LAS unsigned*)(lds + LDS_BYTES - 16);
    if (threadIdx.x < 4) bst[threadIdx.x] = 0u;
    __syncthreads();
    const XcdBarrier xb = xcd_barrier_post(p.bar, bst);
    const int nproj0 = (RT / 256) * (INW / 256); const int first0 = (nproj0 > nb && nproj0 < 2 * nb) ? nproj0 - nb : 0;
    const int lateb0 = first0 + 32, nlateb = (first0 > 0 && nb - lateb0 > 0) ? nb - lateb0 : 0;
    const int nlate = nlateb * 8 * 8;
    phase_prep(p, lds, bid, nb, nlate);
    xcd_barrier(xb);
    { pg8::Gemm g{p.hnb, p.w_in_t, D, D, D, 0}; pg8::StaticOrder S; S.init(RT / 256, INW / 256, nb, bid); EpiProj E{p.xp, p.glu, p.rstd1};
      pg8::gemm_phase<EpiProj, pg8::StaticOrder>(lds, g, S, E); }
    { const int nproj = (RT / 256) * (INW / 256); const int first = (nproj > nb && nproj < 2 * nb) ? nproj - nb : 0, nfree = nb - first;
      for (int uu = bid - first; uu >= 0 && uu < 64; uu += nfree) {
        __syncthreads();
        const bool pw = uu < 32;
        pg8::Gemm g{pw ? p.w_out_t + PWD : p.w_out_t, pw ? p.pw_b16 : p.pool_ws, D, pw ? CWD : 256, pw ? CWD : 256, pw ? 0 : 256};
        pg8::OneUnit S; S.u.pm = (uu & 31) >> 2; S.u.pn = uu & 3; EpiBf16Out E{p.w_eff_t, D, pw ? PWD : 0, nullptr};
        pg8::gemm_phase<EpiBf16Out, pg8::OneUnit>(lds, g, S, E);
      }
      { const int b0 = nfree >= 96 ? first + 64 : 0;
        for (int nbk = bid - b0; nbk >= 0 && nbk < D / 64; nbk += nb) {
          __syncthreads();
          const int lane = threadIdx.x & 63, wv = threadIdx.x >> 6, n = nbk * 64 + lane;
          float a[8] = {0.f, 0.f, 0.f, 0.f, 0.f, 0.f, 0.f, 0.f};
          for (int j = wv * 128; j < wv * 128 + 128; j += 8) {
#pragma unroll
            for (int q = 0; q < 8; ++q) a[q] += p.pw_b[j + q] * p.w_out[(size_t)(PWD + j + q) * D + n]; }
          LAS float* red = (LAS float*)lds;
          red[wv * 64 + lane] = ((a[0] + a[1]) + (a[2] + a[3])) + ((a[4] + a[5]) + (a[6] + a[7]));
          __syncthreads();
          if (wv == 0) { float t = 0.f;
#pragma unroll
            for (int q = 0; q < 8; ++q) t += red[q * 64 + lane];
            p.bias_eff[n] = t; }
        } }
      if (nlateb > 0 && bid >= lateb0) { const int lane = threadIdx.x & 63, lwv = (bid - lateb0) * 8 + (int)(threadIdx.x >> 6), nlw = nlateb * 8;
        for (int e = 16384 - nlate + lwv; e < 16384; e += 2 * nlw) { const int e2 = e + nlw < 16384 ? e + nlw : e;
          fp8_row2(p.down + (size_t)e * D, p.down8 + (size_t)e * D, p.sdn + e, p.down + (size_t)e2 * D, p.down8 + (size_t)e2 * D, p.sdn + e2, lane); } }
    }
    xcd_barrier(xb);
    phase_mix(p, lds, bid, nb);
    xcd_barrier(xb);
    { pg8::Gemm g{p.mixb, p.w_eff_t, D, D, D, 0}; pg8::StaticOrder S; S.init(SEQ / 256, D / 256, nb, bid); EpiResid E{p.hnb, p.bias_eff, p.h2b, p.ssq};
      pg8::gemm_phase<EpiResid, pg8::StaticOrder>(lds, g, S, E); }
    xcd_barrier(xb);
    { pg8::Gemm g{p.h2b, p.wq_t, D, D, D, 0}; pg8::StaticOrder S; S.init(SEQ / 256, D / 256, nb, bid); EpiQTopk E{p.ssq, p.rstd, p.keysb, p.idx, p.gsu};
      pg8::gemm_phase<EpiQTopk, pg8::StaticOrder>(lds, g, S, E); }
    xcd_barrier(xb);
    phase_pd(p, lds, bid, nb);
    xcd_barrier(xb);
    phase_pa(p, bid, nb);
    xcd_barrier(xb);
    phase_pu(p, bid, nb);
    xcd_barrier(xb);
    phase_pf(p, bid, nb);
}

extern "C" void kernel_launch(void* const* d_in, const int* in_sizes, int n_in, void* d_out, int out_size, void* d_ws, size_t ws_size, hipStream_t stream) {
    Params p{};
    p.x = (const float*)d_in[0]; p.meta = (const float*)d_in[1]; p.mix_g = (const float*)d_in[2]; p.w_in = (const float*)d_in[3];
    p.pool_w = (const float*)d_in[4]; p.pool_scale = (const float*)d_in[5]; p.dw_w = (const float*)d_in[6]; p.dw_b = (const float*)d_in[7];
    p.ln_g = (const float*)d_in[8]; p.ln_b = (const float*)d_in[9]; p.pw_w = (const float*)d_in[10]; p.pw_b = (const float*)d_in[11];
    p.w_out = (const float*)d_in[12]; p.ffn_g = (const float*)d_in[13]; p.wq = (const float*)d_in[14]; p.keys = (const float*)d_in[15];
    p.down = (const float*)d_in[16]; p.up = (const float*)d_in[17]; p.fin_g = (const float*)d_in[18];
    p.out = (float*)d_out;
    char* w = (char*)d_ws; size_t off = 0;
    auto take = [&](size_t bytes) { char* r = w + off; off += (bytes + 255) & ~(size_t)255; return r; };
    p.idx = (unsigned short*)take((size_t)SEQ * 128 * 2);
    p.gsu = (float*)take((size_t)SEQ * 128 * 4);
    p.part = (bf16_t*)take((size_t)SEQ * 8 * 128 * 2);
    p.act = (bf16_t*)take((size_t)SEQ * 128 * 2);
    p.ssq2 = (float*)take((size_t)SEQ * 16 * 4);
    p.h3b = (bf16_t*)take((size_t)SEQ * D * 2);
    p.hnb = (bf16_t*)take((size_t)RT * D * 2);
    p.rstd1 = (float*)take((size_t)RT * 4);
    p.w_in_t = (bf16_t*)take((size_t)INW * D * 2);
    p.xp = (bf16_t*)take((size_t)RT * PWD * 2);
    p.glu = (bf16_t*)take((size_t)RT * CWD * 2);
    p.mixb = (bf16_t*)take((size_t)SEQ * D * 2);
    p.h2b = (bf16_t*)take((size_t)SEQ * D * 2);
    p.pool_ws = (bf16_t*)take((size_t)4 * 256 * 256 * 2);
    p.pw_b16 = (bf16_t*)take((size_t)CWD * CWD * 2);
    p.w_eff_t = (bf16_t*)take((size_t)D * D * 2);
    p.bias_eff = (float*)take((size_t)D * 4);
    p.w_out_t = (bf16_t*)take((size_t)D * D * 2);
    p.ssq = (float*)take((size_t)SEQ * 32 * 4);
    p.bar = (unsigned*)take((size_t)XCD_BAR_WORDS * 4);
    p.rstd = (float*)take((size_t)SEQ * 4);
    p.wq_t = (bf16_t*)take((size_t)D * D * 2);
    p.keysb = (bf16_t*)take((size_t)8 * 2 * 128 * 128 * 2);
    p.qb = (bf16_t*)take((size_t)SEQ * D * 2);
    p.down8 = (unsigned char*)take((size_t)16384 * D);
    p.up8 = (unsigned char*)take((size_t)16384 * D);
    p.sdn = (float*)take((size_t)16384 * 4);
    p.sup = (float*)take((size_t)16384 * 4);
    static int grid_blocks = 0;
    if (!grid_blocks) {
        int dev = 0, cus = 0, per_cu = 0;
        (void)hipGetDevice(&dev);
        (void)hipDeviceGetAttribute(&cus, hipDeviceAttributeMultiprocessorCount, dev);
        (void)hipFuncSetAttribute((const void*)k_mega, hipFuncAttributeMaxDynamicSharedMemorySize, LDS_BYTES);
        (void)hipOccupancyMaxActiveBlocksPerMultiprocessor(&per_cu, k_mega, NT, LDS_BYTES);
        if (per_cu < 1) { fprintf(stderr, "occupancy query says %d workgroups per CU: nothing launched\n", per_cu); grid_blocks = -1; }
        else if (cus != (SEQ / 256) * (D / 256)) { fprintf(stderr, "this build needs a %d-CU device (got %d): nothing launched\n", (SEQ / 256) * (D / 256), cus); grid_blocks = -1; }
        else grid_blocks = cus;
    }
    if (grid_blocks < 0) return;
    (void)hipMemsetAsync(p.bar, 0, (size_t)XCD_BAR_WORDS * 4, stream);
    void* args[] = {&p};
    hipError_t e = hipLaunchCooperativeKernel((void*)k_mega, dim3(grid_blocks), dim3(NT), args, LDS_BYTES, stream);
    if (e != hipSuccess) fprintf(stderr, "cooperative launch failed: %s (grid %d)\n", hipGetErrorString(e), grid_blocks);
}
```

```cpp
#include <hip/hip_runtime.h>
#include <hip/hip_cooperative_groups.h>
#include <stdint.h>
#include <cstdio>
namespace cg = cooperative_groups;

#define NT 512
#define LAS __attribute__((address_space(3)))
typedef unsigned short bf16_t;
typedef short bf16x8 __attribute__((ext_vector_type(8)));
typedef float f32x4 __attribute__((ext_vector_type(4)));
typedef unsigned u32x4 __attribute__((ext_vector_type(4)));
typedef unsigned u32x2 __attribute__((ext_vector_type(2)));

constexpr int D = 2048, SEQ = 8192, NMETA = 16, T = SEQ + NMETA;
constexpr int PWD = 1024, CWD = 1024, INW = 3072;
constexpr int KS = 31;
constexpr int RPAD = 240, RT = 8448;
constexpr int LDS_BYTES = 151552;

struct Params {
    const float *x, *meta, *mix_g, *w_in, *pool_w, *pool_scale, *dw_w, *dw_b, *ln_g, *ln_b, *pw_w, *pw_b, *w_out, *ffn_g, *wq, *keys, *down, *up, *fin_g;
    float* out;
    unsigned short* idx;
    unsigned* bar;
    bf16_t *hnb, *w_in_t, *xp, *glu, *mixb, *h2b, *pool_ws, *pw_b16, *w_eff_t, *w_out_t, *wq_t, *keysb, *qb;
    unsigned char *down8, *up8;
    float *sdn, *sup;
    float *gsu;
    bf16_t* part;
    bf16_t* act;
    float* ssq2;
    bf16_t* h3b;
    float *ssq, *rstd, *bias_eff, *rstd1;
};

__device__ __forceinline__ unsigned cvt_pk_bf16(float lo, float hi) { unsigned r; asm volatile("v_cvt_pk_bf16_f32 %0, %1, %2" : "=v"(r) : "v"(lo), "v"(hi)); return r; }
__device__ __forceinline__ void store16_wt(void* ptr, u32x4 v) { asm volatile("global_store_dwordx4 %0, %1, off sc1\n\ts_nop 1" :: "v"(ptr), "v"(v) : "memory"); }
__device__ __forceinline__ float bf_lo(unsigned w) { return __uint_as_float(w << 16); }
__device__ __forceinline__ float bf_hi(unsigned w) { return __uint_as_float(w & 0xffff0000u); }
__device__ __forceinline__ float wave_sum(float v) {
#pragma unroll
    for (int o = 1; o < 64; o <<= 1) v += __shfl_xor(v, o);
    return v;
}

__device__ __forceinline__ const float* hrow(const Params& p, int t) { return t < NMETA ? p.meta + (size_t)t * D : p.x + (size_t)(t - NMETA) * D; }

__device__ __forceinline__ float block_sum(float v, float* red) {
#pragma unroll
    for (int o = 32; o; o >>= 1) v += __shfl_xor(v, o);
    __syncthreads();
    if ((threadIdx.x & 63) == 0) red[threadIdx.x >> 6] = v;
    __syncthreads();
    float s = 0.f;
#pragma unroll
    for (int i = 0; i < NT / 64; ++i) s += red[i];
    return s;
}

namespace pg8 {
constexpr int BM = 256, BK = 64, HALF = 128, HTB = HALF * BK * 2, STAGE_BYTES = 8 * HTB, NXCD = 8, WGM = 8;
__device__ __forceinline__ int lds_byte(int r, int c) { const int st = (r >> 4) * 2 + (c >> 5), rr = r & 15, cc = c & 31, ob = rr * 64 + cc * 2; return st * 1024 + (ob ^ (((ob >> 9) & 1) << 5)); }
__device__ __forceinline__ void stage_rc(int b, int& R, int& C) { const int st = b / 1024, sb = b % 1024, swz = sb ^ (((sb >> 9) & 1) << 5); R = (st >> 1) * 16 + swz / 64; C = (st & 1) * 32 + (swz % 64) / 2; }
__device__ __forceinline__ int perm32(int rho) { const int n = rho >> 4, i = rho & 15; return 8 * (i >> 2) + 4 * n + (i & 3); }
struct Unit { int pm, pn; };
struct Gemm { const bf16_t* A; const bf16_t* Bt; int lda, ldb, K; int a_col_per_pn; };
struct StaticOrder {
    int nM, nN, nwg, G, c;
    __device__ void init(int nM_, int nN_, int G_, int c_) { nM = nM_; nN = nN_; nwg = nM * nN; G = G_; c = c_; }
    __device__ bool next(int i, Unit& u) const {
        const long L = (long)i * G + c; if (L >= nwg) return false;
        int wgid = (int)L; { const int q = nwg / NXCD, r = nwg % NXCD, xcd = wgid % NXCD, off = wgid / NXCD; wgid = (xcd < r ? xcd * (q + 1) : r * (q + 1) + (xcd - r) * q) + off; }
        const int nig = WGM * nN, gid = wgid / nig, fm = gid * WGM, gsz = (nM - fm) < WGM ? (nM - fm) : WGM;
        u.pm = fm + ((wgid % nig) % gsz); u.pn = (wgid % nig) / gsz; return true;
    }
};
struct OneUnit { Unit u; __device__ bool next(int i, Unit& o) const { if (i) return false; o = u; return true; } };
template <class Epi, class Sched>
__device__ __forceinline__ void gemm_phase(LAS unsigned char* lds, const Gemm g, const Sched& S, const Epi& E) {
    const int tid = threadIdx.x, wid = __builtin_amdgcn_readfirstlane(tid >> 6), lane = tid & 63, wr = wid >> 2, wc = wid & 3, fr = lane & 15, fq = lane >> 4;
    const int K = g.K, nt = K / BK;
    unsigned voffA[2], voffB[2];
#pragma unroll
    for (int i = 0; i < 2; ++i) { int R, C; stage_rc(tid * 16 + i * 8192, R, C);
        const int Rb = Epi::PERM ? ((R & ~31) + perm32(R & 31)) : R;
        voffA[i] = (unsigned)(R * g.lda + C) * 2u; voffB[i] = (unsigned)(Rb * g.ldb + C) * 2u; }
    const size_t kstep = (size_t)(BK * 2);
    const size_t hstepA = (size_t)HALF * g.lda * 2, hstepB = (size_t)HALF * g.ldb * 2;
    const size_t tstepA = 2 * hstepA, tstepB = 2 * hstepB;
    const unsigned ldsw = (unsigned)wid * 1024u;
    const int aoff = lds_byte(wr * 64 + fr, fq * 8), boff = lds_byte(wc * 32 + fr, fq * 8);
#define PG8_SA(b, h) (((b) * 2 + (h)) * HTB)
#define PG8_SB(b, h) ((4 + (b) * 2 + (h)) * HTB)
#define PG8_STAGE(bufoff, gbase, voff) do { _Pragma("unroll") for (int _i = 0; _i < 2; ++_i) \
        __builtin_amdgcn_global_load_lds((const unsigned*)((const char*)(gbase) + (voff)[_i]), (LAS unsigned*)(lds + (bufoff) + ldsw + _i * 8192), 16, 0, 0); } while (0)
#define PG8_LDA(dst, b, h) do { _Pragma("unroll") for (int m = 0; m < 4; ++m) _Pragma("unroll") for (int k = 0; k < 2; ++k) dst[m][k] = *(const LAS bf16x8*)(lds + PG8_SA(b, h) + aoff + m * 2048 + k * 1024); } while (0)
#define PG8_LDB(dst, b, h) do { _Pragma("unroll") for (int n = 0; n < 2; ++n) _Pragma("unroll") for (int k = 0; k < 2; ++k) dst[n][k] = *(const LAS bf16x8*)(lds + PG8_SB(b, h) + boff + n * 2048 + k * 1024); } while (0)
#define PG8_MMA(ai, bj, At, Bt) do { __builtin_amdgcn_s_setprio(1); _Pragma("unroll") for (int m = 0; m < 4; ++m) _Pragma("unroll") for (int n = 0; n < 2; ++n) _Pragma("unroll") for (int k = 0; k < 2; ++k) \
        acc[ai][bj][m][n] = __builtin_amdgcn_mfma_f32_16x16x32_bf16(Bt[n][k], At[m][k], acc[ai][bj][m][n], 0, 0, 0); __builtin_amdgcn_s_setprio(0); } while (0)
#define PG8_WAIT_V(n) asm volatile("s_waitcnt vmcnt(" #n ")" ::: "memory")
#define PG8_WAIT_L(n) asm volatile("s_waitcnt lgkmcnt(" #n ")" ::: "memory")
#define PG8_BAR __builtin_amdgcn_s_barrier()
#define PG8_SCHED __builtin_amdgcn_sched_barrier(0)
    Unit cur, nxt; int ui = 0;
    if (!S.next(0, cur)) return;
    f32x4 acc[2][2][4][2];
#pragma unroll
    for (int a = 0; a < 2; ++a)
#pragma unroll
        for (int b = 0; b < 2; ++b)
#pragma unroll
            for (int m = 0; m < 4; ++m)
#pragma unroll
                for (int n = 0; n < 2; ++n) acc[a][b][m][n] = (f32x4){0.f, 0.f, 0.f, 0.f};
    bf16x8 At[4][2], B0[2][2], B1[2][2];
    const char* cA = (const char*)g.A + (size_t)cur.pm * tstepA + (size_t)cur.pn * g.a_col_per_pn * 2; const char* cB = (const char*)g.Bt + (size_t)cur.pn * tstepB;
    PG8_STAGE(PG8_SB(0, 0), cB, voffB); PG8_STAGE(PG8_SA(0, 0), cA, voffA); PG8_STAGE(PG8_SB(0, 1), cB + hstepB, voffB); PG8_STAGE(PG8_SA(0, 1), cA + hstepA, voffA);
    if (wr == 1) PG8_BAR;
    PG8_WAIT_V(4); PG8_BAR;
    PG8_STAGE(PG8_SB(1, 0), cB + kstep, voffB); PG8_STAGE(PG8_SA(1, 0), cA + kstep, voffA); PG8_STAGE(PG8_SB(1, 1), cB + hstepB + kstep, voffB);
    PG8_WAIT_V(6); PG8_BAR;
    for (;;) {
        const bool has_next = S.next(ui + 1, nxt);
        const char* nA = has_next ? (const char*)g.A + (size_t)nxt.pm * tstepA + (size_t)nxt.pn * g.a_col_per_pn * 2 : cA; const char* nB = has_next ? (const char*)g.Bt + (size_t)nxt.pn * tstepB : cB;
        for (int t = 0; t < nt; t += 2) {
            const bool last = (t == nt - 2);
            const char* a1 = cA + (size_t)(t + 1) * kstep;
            const char* a2 = last ? nA : cA + (size_t)(t + 2) * kstep; const char* b2 = last ? nB : cB + (size_t)(t + 2) * kstep;
            const char* a3 = a2 + kstep; const char* b3 = b2 + kstep;
            PG8_LDB(B0, 0, 0); PG8_SCHED; PG8_LDA(At, 0, 0); PG8_STAGE(PG8_SA(1, 1), a1 + hstepA, voffA);
            PG8_WAIT_L(8); PG8_BAR; PG8_WAIT_L(0); PG8_MMA(0, 0, At, B0); PG8_BAR; PG8_SCHED;
            PG8_LDB(B1, 0, 1); PG8_STAGE(PG8_SB(0, 0), b2, voffB);
            PG8_BAR; PG8_WAIT_L(0); PG8_MMA(0, 1, At, B1); PG8_BAR;
            PG8_LDA(At, 0, 1); PG8_STAGE(PG8_SA(0, 0), a2, voffA);
            PG8_BAR; PG8_WAIT_L(0); PG8_MMA(1, 0, At, B0); PG8_BAR; PG8_SCHED;
            PG8_STAGE(PG8_SB(0, 1), b2 + hstepB, voffB);
            PG8_WAIT_V(6); PG8_BAR; PG8_MMA(1, 1, At, B1); PG8_BAR;
            PG8_LDB(B0, 1, 0); PG8_SCHED; PG8_LDA(At, 1, 0); PG8_STAGE(PG8_SA(0, 1), a2 + hstepA, voffA);
            PG8_WAIT_L(8); PG8_BAR; PG8_WAIT_L(0); PG8_MMA(0, 0, At, B0); PG8_BAR; PG8_SCHED;
            PG8_LDB(B1, 1, 1); PG8_STAGE(PG8_SB(1, 0), b3, voffB);
            PG8_BAR; PG8_WAIT_L(0); PG8_MMA(0, 1, At, B1); PG8_BAR;
            PG8_LDA(At, 1, 1); PG8_STAGE(PG8_SA(1, 0), a3, voffA);
            PG8_BAR; PG8_WAIT_L(0); PG8_MMA(1, 0, At, B0); PG8_BAR; PG8_SCHED;
            PG8_STAGE(PG8_SB(1, 1), b3 + hstepB, voffB);
            PG8_WAIT_V(6); PG8_BAR; PG8_MMA(1, 1, At, B1); PG8_BAR;
        }
        if constexpr (!Epi::AFTER_DRAIN) E(acc, cur, wr, wc, fr, fq);
        if (!has_next) break;
#pragma unroll
        for (int a = 0; a < 2; ++a)
#pragma unroll
            for (int b = 0; b < 2; ++b)
#pragma unroll
                for (int m = 0; m < 4; ++m)
#pragma unroll
                    for (int n = 0; n < 2; ++n) acc[a][b][m][n] = (f32x4){0.f, 0.f, 0.f, 0.f};
        cur = nxt; cA = nA; cB = nB; ++ui;
    }
    PG8_WAIT_V(0);
    if (wr == 0) PG8_BAR;
    PG8_BAR;
    if constexpr (Epi::AFTER_DRAIN) E.fused(acc, cur, wr, wc, fr, fq, lds, wid, lane);
#undef PG8_SA
#undef PG8_SB
#undef PG8_STAGE
#undef PG8_LDA
#undef PG8_LDB
#undef PG8_MMA
#undef PG8_WAIT_V
#undef PG8_WAIT_L
#undef PG8_BAR
#undef PG8_SCHED
}
}

struct EpiProjF32 {
    static constexpr bool PERM = false;
    static constexpr bool AFTER_DRAIN = false;
    float* proj;
    __device__ __forceinline__ void operator()(const f32x4 (&acc)[2][2][4][2], const pg8::Unit& u, int wr, int wc, int fr, int fq) const {
#pragma unroll
        for (int ai = 0; ai < 2; ++ai)
#pragma unroll
            for (int m = 0; m < 4; ++m) {
                const int t = u.pm * 256 + ai * 128 + wr * 64 + m * 16 + fr - RPAD;
                if (t >= 0) {
#pragma unroll
                    for (int bj = 0; bj < 2; ++bj)
#pragma unroll
                        for (int n = 0; n < 2; ++n) {
                            const int off = wc * 32 + n * 16 + fq * 4;
                            const int col = u.pn < 4 ? u.pn * 256 + bj * 128 + off : (bj ? 2048 : 1024) + (u.pn - 4) * 128 + off;
                            *(f32x4*)(proj + (size_t)t * INW + col) = acc[ai][bj][m][n];
                        }
                }
            }
    }
};


__device__ __forceinline__ float sigmoidf_fast(float x) { return __builtin_amdgcn_rcpf(1.0f + __expf(-x)); }

struct EpiProj {
    static constexpr bool PERM = true;
    static constexpr bool AFTER_DRAIN = false;
    bf16_t* xp; bf16_t* glu; const float* rstd1;
    __device__ __forceinline__ void operator()(const f32x4 (&acc)[2][2][4][2], const pg8::Unit& u, int wr, int wc, int fr, int fq) const {
#pragma unroll
        for (int ai = 0; ai < 2; ++ai)
#pragma unroll
            for (int m = 0; m < 4; ++m) {
                const size_t row = (size_t)(u.pm * 256 + ai * 128 + wr * 64 + m * 16 + fr);
                const float rs = rstd1[row];
                if (u.pn < 4) {
#pragma unroll
                    for (int bj = 0; bj < 2; ++bj) { const f32x4 v0 = acc[ai][bj][m][0] * rs, v1 = acc[ai][bj][m][1] * rs;
                        store16_wt(xp + row * PWD + u.pn * 256 + bj * 128 + wc * 32 + fq * 8, (u32x4){cvt_pk_bf16(v0[0], v0[1]), cvt_pk_bf16(v0[2], v0[3]), cvt_pk_bf16(v1[0], v1[1]), cvt_pk_bf16(v1[2], v1[3])}); }
                } else {
                    const f32x4 a0 = acc[ai][0][m][0] * rs, a1 = acc[ai][0][m][1] * rs, g0 = acc[ai][1][m][0] * rs, g1 = acc[ai][1][m][1] * rs;
                    store16_wt(glu + row * CWD + (u.pn - 4) * 128 + wc * 32 + fq * 8, (u32x4){
                        cvt_pk_bf16(a0[0] * sigmoidf_fast(g0[0]), a0[1] * sigmoidf_fast(g0[1])), cvt_pk_bf16(a0[2] * sigmoidf_fast(g0[2]), a0[3] * sigmoidf_fast(g0[3])),
                        cvt_pk_bf16(a1[0] * sigmoidf_fast(g1[0]), a1[1] * sigmoidf_fast(g1[1])), cvt_pk_bf16(a1[2] * sigmoidf_fast(g1[2]), a1[3] * sigmoidf_fast(g1[3]))});
                }
            }
    }
};
struct EpiBf16Out {
    static constexpr bool PERM = true;
    static constexpr bool AFTER_DRAIN = false;
    bf16_t* O; int ldc; int col0; const float* bias;
    __device__ __forceinline__ void operator()(const f32x4 (&acc)[2][2][4][2], const pg8::Unit& u, int wr, int wc, int fr, int fq) const {
#pragma unroll
        for (int ai = 0; ai < 2; ++ai)
#pragma unroll
            for (int m = 0; m < 4; ++m) {
                const size_t row = (size_t)(u.pm * 256 + ai * 128 + wr * 64 + m * 16 + fr);
#pragma unroll
                for (int bj = 0; bj < 2; ++bj) { const int c = u.pn * 256 + bj * 128 + wc * 32 + fq * 8; f32x4 v0 = acc[ai][bj][m][0], v1 = acc[ai][bj][m][1];
                    if (bias) { v0 += *(const f32x4*)(bias + c); v1 += *(const f32x4*)(bias + c + 4); }
                    *(u32x4*)(O + row * ldc + col0 + c) = (u32x4){cvt_pk_bf16(v0[0], v0[1]), cvt_pk_bf16(v0[2], v0[3]), cvt_pk_bf16(v1[0], v1[1]), cvt_pk_bf16(v1[2], v1[3])}; }
            }
    }
};
struct EpiResid {
    static constexpr bool PERM = true;
    static constexpr bool AFTER_DRAIN = false;
    const bf16_t* xb; const float* bias; bf16_t* h2b; float* ssq;
    __device__ __forceinline__ void operator()(const f32x4 (&acc)[2][2][4][2], const pg8::Unit& u, int wr, int wc, int fr, int fq) const {
#pragma unroll
        for (int ai = 0; ai < 2; ++ai)
#pragma unroll
            for (int m = 0; m < 4; ++m) {
                const size_t row = (size_t)(u.pm * 256 + ai * 128 + wr * 64 + m * 16 + fr);
                float ss = 0.f;
#pragma unroll
                for (int bj = 0; bj < 2; ++bj) { const int c = u.pn * 256 + bj * 128 + wc * 32 + fq * 8;
                    const u32x4 xw = *(const u32x4*)(xb + (row + 256) * D + c);
                    const f32x4 v0 = acc[ai][bj][m][0] + (f32x4){bf_lo(xw.x), bf_hi(xw.x), bf_lo(xw.y), bf_hi(xw.y)} + *(const f32x4*)(bias + c);
                    const f32x4 v1 = acc[ai][bj][m][1] + (f32x4){bf_lo(xw.z), bf_hi(xw.z), bf_lo(xw.w), bf_hi(xw.w)} + *(const f32x4*)(bias + c + 4);
                    store16_wt(h2b + row * D + c, (u32x4){cvt_pk_bf16(v0[0], v0[1]), cvt_pk_bf16(v0[2], v0[3]), cvt_pk_bf16(v1[0], v1[1]), cvt_pk_bf16(v1[2], v1[3])});
                    ss += ((v0[0] * v0[0] + v0[1] * v0[1]) + (v0[2] * v0[2] + v0[3] * v0[3])) + ((v1[0] * v1[0] + v1[1] * v1[1]) + (v1[2] * v1[2] + v1[3] * v1[3])); }
                ss += __shfl_xor(ss, 16); ss += __shfl_xor(ss, 32);
                if (fq == 0) ssq[row * 32 + u.pn * 4 + wc] = ss;
            }
    }
};

__device__ __forceinline__ float fsel(int mask, float a, float b) { return __int_as_float((__float_as_int(a) & ~mask) | (__float_as_int(b) & mask)); }

__device__ __forceinline__ u32x4 bload16(__amdgpu_buffer_rsrc_t r, int voff, int soff) { return __builtin_bit_cast(u32x4, __builtin_amdgcn_raw_buffer_load_b128(r, voff, soff, 0)); }
__device__ __forceinline__ unsigned bload4(__amdgpu_buffer_rsrc_t r, int voff, int soff) { return (unsigned)__builtin_amdgcn_raw_buffer_load_b32(r, voff, soff, 0); }
__device__ __forceinline__ void bstore4(__amdgpu_buffer_rsrc_t r, unsigned v, int voff, int soff) { __builtin_amdgcn_raw_buffer_store_b32(v, r, voff, soff, 0); }
__device__ __forceinline__ u32x2 bload8(__amdgpu_buffer_rsrc_t r, int voff, int soff) { return __builtin_bit_cast(u32x2, __builtin_amdgcn_raw_buffer_load_b64(r, voff, soff, 0)); }
template <int W> __device__ __forceinline__ void pool_tile(__amdgpu_buffer_rsrc_t rxp, __amdgpu_buffer_rsrc_t rpo, int r0, int tile, int tid) {
    unsigned v[32 + W - 1];
#pragma unroll
    for (int i = 0; i < 32 + W - 1; ++i) v[i] = bload4(rxp, tid * 4, (r0 - (W - 1) + i) * 2048);
    float s0 = 0.f, s1 = 0.f;
#pragma unroll
    for (int i = 0; i < W - 1; ++i) { s0 += bf_lo(v[i]); s1 += bf_hi(v[i]); }
    constexpr float inv = 1.0f / (float)W;
#pragma unroll
    for (int i = 0; i < 32; ++i) {
        const float a0 = bf_lo(v[W - 1 + i]), a1 = bf_hi(v[W - 1 + i]);
        s0 += a0; s1 += a1;
        bstore4(rpo, cvt_pk_bf16(s0 * inv - a0, s1 * inv - a1), tid * 4, (tile * 32 + i) * 4096);
        s0 -= bf_lo(v[i]); s1 -= bf_hi(v[i]);
    }
}
__device__ __forceinline__ void phase_mix(const Params& p, LAS unsigned char* lds, int bid, int nb) {
    const int tid = threadIdx.x, lane = tid & 63, wave = tid >> 6;
    LAS unsigned* gl = (LAS unsigned*)lds;
    LAS float* red = (LAS float*)(lds + 62 * 2048);
    const __amdgpu_buffer_rsrc_t rxp = __builtin_amdgcn_make_buffer_rsrc((void*)p.xp, 0, RT * PWD * 2, 0x00020000);
    const __amdgpu_buffer_rsrc_t rgl = __builtin_amdgcn_make_buffer_rsrc((void*)p.glu, 0, RT * CWD * 2, 0x00020000);
    const __amdgpu_buffer_rsrc_t rpo = __builtin_amdgcn_make_buffer_rsrc((void*)p.mixb, 0, SEQ * D * 2, 0x00020000);
    const __amdgpu_buffer_rsrc_t rww = __builtin_amdgcn_make_buffer_rsrc((void*)p.dw_w, 0, KS * CWD * 4, 0x00020000);
    const __amdgpu_buffer_rsrc_t rwb = __builtin_amdgcn_make_buffer_rsrc((void*)p.dw_b, 0, CWD * 4, 0x00020000);
    const __amdgpu_buffer_rsrc_t rlg = __builtin_amdgcn_make_buffer_rsrc((void*)p.ln_g, 0, CWD * 4, 0x00020000);
    const __amdgpu_buffer_rsrc_t rlb = __builtin_amdgcn_make_buffer_rsrc((void*)p.ln_b, 0, CWD * 4, 0x00020000);
    for (int tile = bid; tile < SEQ / 32; tile += nb) {
        const int r0 = 256 + tile * 32;
        __syncthreads();
#pragma unroll
        for (int j = 0; j < 16; ++j) { const int ch = j * NT + tid; if (ch < 62 * 128)
            *(LAS u32x4*)(lds + ch * 16) = bload16(rgl, tid * 16, (r0 - 30) * 2048 + j * 8192); }
        { const int g = __builtin_amdgcn_readfirstlane(tid >> 7);
          if (g == 0) pool_tile<2>(rxp, rpo, r0, tile, tid); else if (g == 1) pool_tile<4>(rxp, rpo, r0, tile, tid); else if (g == 2) pool_tile<8>(rxp, rpo, r0, tile, tid); else pool_tile<16>(rxp, rpo, r0, tile, tid); }
        __syncthreads();
#pragma unroll 1
        for (int hf = 0; hf < 2; ++hf) {
            float c0[16], c1[16];
            {
                float w0[KS], w1[KS];
#pragma unroll
                for (int k = 0; k < KS; ++k) { const u32x2 wv = bload8(rww, tid * 8, k * 4096); w0[k] = __uint_as_float(wv.x); w1[k] = __uint_as_float(wv.y); }
                const u32x2 bvv = bload8(rwb, tid * 8, 0); const float b0 = __uint_as_float(bvv.x), b1 = __uint_as_float(bvv.y);
#pragma unroll
                for (int i = 0; i < 16; ++i) { c0[i] = b0; c1[i] = b1; }
                const LAS unsigned* glh = gl + hf * 16 * 512 + tid;
#pragma unroll
                for (int rr = 0; rr < 46; ++rr) {
                    if ((rr & 7) == 0) asm volatile("" ::: "memory");
                    const unsigned vv = glh[rr * 512]; const float x0 = bf_lo(vv), x1 = bf_hi(vv);
#pragma unroll
                    for (int i = 0; i < 16; ++i) { const int k = rr - i; if (k >= 0 && k < KS) { c0[i] += x0 * w0[k]; c1[i] += x1 * w1[k]; } }
                }
            }
            asm volatile("" ::: "memory");
#pragma unroll
            for (int which = 0; which < 2; ++which) {
                float st[16];
#pragma unroll
                for (int i = 0; i < 16; ++i) st[i] = which == 0 ? c0[i] + c1[i] : c0[i] * c0[i] + c1[i] * c1[i];
#pragma unroll
                for (int lvl = 0; lvl < 4; ++lvl) {
                    const int o = 32 >> lvl, n = 8 >> lvl; const int mk = -((lane >> (5 - lvl)) & 1);
#pragma unroll
                    for (int j = 0; j < 8; ++j) if (j < n) st[j] = fsel(mk, st[j], st[j + n]) + __shfl_xor(fsel(mk, st[j + n], st[j]), o);
                }
                float tot = st[0] + __shfl_xor(st[0], 2); tot += __shfl_xor(tot, 1);
                if ((lane & 3) == 0) red[wave * 32 + which * 16 + (lane >> 2)] = tot;
            }
            __syncthreads();
            if (tid < 32) { float t = 0.f;
#pragma unroll
                for (int q = 0; q < 8; ++q) t += red[q * 32 + tid];
                red[256 + tid] = t; }
            __syncthreads();
            const u32x2 lgv = bload8(rlg, tid * 8, 0), lbv = bload8(rlb, tid * 8, 0); const float lg0 = __uint_as_float(lgv.x), lg1 = __uint_as_float(lgv.y), lb0 = __uint_as_float(lbv.x), lb1 = __uint_as_float(lbv.y);
#pragma unroll
            for (int i = 0; i < 16; ++i) {
                const float s1 = red[256 + i], s2 = red[256 + 16 + i];
                const float mu = s1 * (1.0f / CWD), var = fmaxf(s2 * (1.0f / CWD) - mu * mu, 0.f), rs = rsqrtf(var + 1e-5f);
                const float y0 = (c0[i] - mu) * rs * lg0 + lb0, y1 = (c1[i] - mu) * rs * lg1 + lb1;
                bstore4(rpo, cvt_pk_bf16(y0 * sigmoidf_fast(y0), y1 * sigmoidf_fast(y1)), tid * 4, (tile * 32 + hf * 16 + i) * 4096 + 2048);
            }
            __syncthreads();
        }
    }
}

typedef float f32x16 __attribute__((ext_vector_type(16)));
__device__ __forceinline__ int okey(float s) { const int u = __float_as_int(s); return u ^ ((u >> 31) & 0x7fffffff); }
__device__ __forceinline__ float okey_inv(int k) { return __int_as_float(k ^ ((k >> 31) & 0x7fffffff)); }
__device__ __forceinline__ void sort16_desc(int (&v)[16]) {
#pragma unroll
    for (int k = 2; k <= 16; k <<= 1) {
#pragma unroll
        for (int j = k >> 1; j > 0; j >>= 1) {
#pragma unroll
            for (int i = 0; i < 16; ++i) {
                const int l = i ^ j;
                if (l > i) { const bool desc = (i & k) == 0; const int hi = max(v[i], v[l]), lo = min(v[i], v[l]); v[i] = desc ? hi : lo; v[l] = desc ? lo : hi; }
            }
        }
    }
}
__device__ __forceinline__ void merge16_desc(int (&a)[16], const int (&b)[16]) {
#pragma unroll
    for (int i = 0; i < 16; ++i) a[i] = max(a[i], b[15 - i]);
#pragma unroll
    for (int j = 8; j > 0; j >>= 1) {
#pragma unroll
        for (int i = 0; i < 16; ++i) { const int l = i ^ j; if (l > i) { const int hi = max(a[i], a[l]), lo = min(a[i], a[l]); a[i] = hi; a[l] = lo; } }
    }
}
__device__ __forceinline__ void pair_merge(int (&a)[16]) {
    int b[16];
#pragma unroll
    for (int i = 0; i < 16; ++i) b[i] = __shfl_xor(a[i], 32);
    merge16_desc(a, b);
}
constexpr int CELL_I[64] = {0,0,0,0,0,0,0,0,0,0,0,0,0,0,0,0,1,1,1,1,1,1,1,1,2,2,2,2,2,3,3,3,3,4,4,4,5,5,6,6,7,7,8,9,10,11,12,13,14,15,0,0,0,0,0,0,0,0,0,0,0,0,0,0};
constexpr int CELL_J[64] = {0,1,2,3,4,5,6,7,8,9,10,11,12,13,14,15,0,1,2,3,4,5,6,7,0,1,2,3,4,0,1,2,3,0,1,2,0,1,0,1,0,1,0,0,0,0,0,0,0,0,0,0,0,0,0,0,0,0,0,0,0,0,0,0};
constexpr int NCELL = 50;

struct EpiQTopk {
    static constexpr bool PERM = false;
    static constexpr bool AFTER_DRAIN = true;
    const float* ssq; float* rstd; const bf16_t* keysb; unsigned short* idx; float* gsu;
    __device__ __forceinline__ void fused(const f32x4 (&acc)[2][2][4][2], const pg8::Unit& u, int wr, int wc, int fr, int fq, LAS unsigned char* lds, int wid, int lane) const {
        const int hh = lane >> 5, l31 = lane & 31, h = u.pn;
        LAS float* svt = (LAS float*)(lds + 65536 + (wid * 64 + lane) * 164);
        LAS unsigned char* sit = (LAS unsigned char*)(svt + 32);
        float rs[2][4];
#pragma unroll
        for (int ai = 0; ai < 2; ++ai)
#pragma unroll
            for (int m = 0; m < 4; ++m) {
                const size_t row = (size_t)(u.pm * 256 + ai * 128 + wr * 64 + m * 16 + fr);
                const f32x4* sp = (const f32x4*)(ssq + row * 32); f32x4 t = sp[0];
#pragma unroll
                for (int i = 1; i < 8; ++i) t += sp[i];
                rs[ai][m] = rsqrtf(((t[0] + t[1]) + (t[2] + t[3])) * (1.0f / D) + 1e-6f);
                if (u.pn == 0 && wc == 0 && fq == 0) rstd[row] = rs[ai][m];
            }
        const int trow = wid * 32 + l31;
#pragma unroll
        for (int ph = 0; ph < 2; ++ph) {
#pragma unroll
            for (int ai = 0; ai < 2; ++ai)
#pragma unroll
                for (int m = 0; m < 4; ++m) { const int row = ai * 128 + wr * 64 + m * 16 + fr;
#pragma unroll
                    for (int n = 0; n < 2; ++n) { const f32x4 v = acc[ai][ph][m][n] * rs[ai][m]; const int chunk = 4 * wc + 2 * n + (fq >> 1);
                        u32x2 w; w.x = cvt_pk_bf16(v[0], v[1]); w.y = cvt_pk_bf16(v[2], v[3]);
                        *(LAS u32x2*)(lds + row * 256 + ((chunk ^ (row & 15)) << 4) + (fq & 1) * 8) = w; } }
            __syncthreads();
            const bf16_t* krow = keysb + ((size_t)(h * 2 + ph) * 128 + l31) * 128 + 8 * hh;
            bf16x8 bq[8];
#pragma unroll
            for (int ks = 0; ks < 8; ++ks) bq[ks] = *(const LAS bf16x8*)(lds + trow * 256 + (((ks * 2 + hh) ^ (trow & 15)) << 4));
            int top[16];
#pragma unroll
            for (int i = 0; i < 16; ++i) top[i] = (int)0x80000000;
            bf16x8 ak[8];
#pragma unroll
            for (int ks = 0; ks < 8; ++ks) ak[ks] = *(const bf16x8*)(krow + ks * 16);
#pragma unroll 1
            for (int kt = 0; kt < 4; ++kt) {
                f32x16 c = {0.f, 0.f, 0.f, 0.f, 0.f, 0.f, 0.f, 0.f, 0.f, 0.f, 0.f, 0.f, 0.f, 0.f, 0.f, 0.f};
#pragma unroll
                for (int ks = 0; ks < 8; ++ks) c = __builtin_amdgcn_mfma_f32_32x32x16_bf16(ak[ks], bq[ks], c, 0, 0, 0);
                { const int kn = kt < 3 ? kt + 1 : 3;
#pragma unroll
                  for (int ks = 0; ks < 8; ++ks) ak[ks] = *(const bf16x8*)(krow + (size_t)kn * 32 * 128 + ks * 16); }
                int v[16];
                const int lowb = (127 - kt * 32) ^ (hh << 2);
#pragma unroll
                for (int r = 0; r < 16; ++r) v[r] = (okey(c[r]) & ~127) | (lowb - ((r & 3) + 8 * (r >> 2)));
                sort16_desc(v);
                merge16_desc(top, v);
            }
            pair_merge(top);
#pragma unroll
            for (int i = 0; i < 16; ++i) { svt[ph * 16 + i] = okey_inv(top[i] & ~127); sit[ph * 16 + i] = (unsigned char)(127 - (top[i] & 127)); }
            __syncthreads();
        }
        float sv[2][16];
#pragma unroll
        for (int i = 0; i < 16; ++i) { sv[0][i] = svt[i]; sv[1][i] = svt[16 + i]; }
        int w0[16], w1[16];
#pragma unroll
        for (int s = 0; s < 32; ++s) {
            const int e0 = 2 * s, e1 = 2 * s + 1;
            int key;
            if (e0 >= NCELL) key = (int)0x80000000;
            else {
                const float v0 = sv[0][CELL_I[e0]] + sv[1][CELL_J[e0]];
                const int k0 = (okey(v0) & ~255) | (255 - (CELL_I[e0] * 16 + CELL_J[e0]));
                if (e1 >= NCELL) key = hh ? (int)0x80000000 : k0;
                else { const float v1 = sv[0][CELL_I[e1]] + sv[1][CELL_J[e1]];
                    const int k1 = (okey(v1) & ~255) | (255 - (CELL_I[e1] * 16 + CELL_J[e1]));
                    key = hh ? k1 : k0; }
            }
            if (s < 16) w0[s] = key; else w1[s - 16] = key;
        }
        sort16_desc(w0); sort16_desc(w1); merge16_desc(w0, w1); pair_merge(w0);
        const float mx = okey_inv(w0[0] & ~255);
        float sum = 0.f;
#pragma unroll
        for (int k = 0; k < 16; ++k) sum += __expf(okey_inv(w0[k] & ~255) - mx);
        const float inv = 1.0f / sum;
        int eo[8]; float go[8]; const int hmask = -hh;
#pragma unroll
        for (int k = 0; k < 8; ++k) { const int kk = (w0[k] & ~hmask) | (w0[8 + k] & hmask); const int cc = 255 - (kk & 255);
            eo[k] = (int)sit[cc >> 4] * 128 + (int)sit[16 + (cc & 15)]; go[k] = __expf(okey_inv(kk & ~255) - mx) * inv; }
        const size_t ob = (size_t)(u.pm * 256 + trow) * 128 + h * 16 + hh * 8;
        *(u32x4*)(idx + ob) = (u32x4){(unsigned)eo[0] | ((unsigned)eo[1] << 16), (unsigned)eo[2] | ((unsigned)eo[3] << 16), (unsigned)eo[4] | ((unsigned)eo[5] << 16), (unsigned)eo[6] | ((unsigned)eo[7] << 16)};
        *(f32x4*)(gsu + ob) = (f32x4){go[0], go[1], go[2], go[3]};
        *(f32x4*)(gsu + ob + 4) = (f32x4){go[4], go[5], go[6], go[7]};
    }
    __device__ __forceinline__ void operator()(const f32x4 (&)[2][2][4][2], const pg8::Unit&, int, int, int, int) const {}
};

__device__ __forceinline__ float q6(float x) { return __builtin_amdgcn_fmed3f(x, -6.0f, 6.0f); }
__device__ __forceinline__ unsigned enc8_fp4(f32x4 a, f32x4 b, float sc) {
    unsigned e = 0;
    e = __builtin_amdgcn_cvt_scalef32_pk_fp4_f32(e, q6(a.x * sc), q6(a.y * sc), 1.0f, 0);
    e = __builtin_amdgcn_cvt_scalef32_pk_fp4_f32(e, q6(a.z * sc), q6(a.w * sc), 1.0f, 1);
    e = __builtin_amdgcn_cvt_scalef32_pk_fp4_f32(e, q6(b.x * sc), q6(b.y * sc), 1.0f, 2);
    e = __builtin_amdgcn_cvt_scalef32_pk_fp4_f32(e, q6(b.z * sc), q6(b.w * sc), 1.0f, 3);
    return e;
}
template <bool G> __device__ __forceinline__ void fp4_row2(const float* s0, unsigned char* d0, float* i0, const float* s1, unsigned char* d1, float* i1, const f32x4 (&gg)[2][4], int lane) {
    f32x4 v[2][2][4]; float am[2] = {0.f, 0.f};
#pragma unroll
    for (int r = 0; r < 2; ++r)
#pragma unroll
        for (int k = 0; k < 2; ++k)
#pragma unroll
            for (int i = 0; i < 4; ++i) v[r][k][i] = __builtin_nontemporal_load((const f32x4*)((r ? s1 : s0) + 1024 * k + 16 * lane + 4 * i));
#pragma unroll
    for (int r = 0; r < 2; ++r) {
#pragma unroll
        for (int k = 0; k < 2; ++k)
#pragma unroll
            for (int i = 0; i < 4; ++i) { if (G) v[r][k][i] *= gg[k][i]; am[r] = fmaxf(am[r], fmaxf(fmaxf(fabsf(v[r][k][i].x), fabsf(v[r][k][i].y)), fmaxf(fabsf(v[r][k][i].z), fabsf(v[r][k][i].w)))); }
#pragma unroll
        for (int o = 1; o < 64; o <<= 1) am[r] = fmaxf(am[r], __shfl_xor(am[r], o));
        const float a = fmaxf(am[r], 1e-30f), sc = 6.0f / a, isc = a * (1.0f / 6.0f);
#pragma unroll
        for (int k = 0; k < 2; ++k) { u32x2 w; w.x = enc8_fp4(v[r][k][0], v[r][k][1], sc); w.y = enc8_fp4(v[r][k][2], v[r][k][3], sc);
            *(u32x2*)((r ? d1 : d0) + 512 * k + 8 * lane) = w; }
        if (lane == 0) *(r ? i1 : i0) = isc;
    }
}

typedef float f32x2 __attribute__((ext_vector_type(2)));
typedef __bf16 bf16x2h __attribute__((ext_vector_type(2)));
template <int B> __device__ __forceinline__ float d2_fp4(unsigned w, unsigned h, float acc) {
    return __builtin_amdgcn_fdot2_f32_bf16(__builtin_amdgcn_cvt_scalef32_pk_bf16_fp4(w, 1.0f, B), __builtin_bit_cast(bf16x2h, h), acc, false); }
__device__ __forceinline__ float dot8_fp4(unsigned w, const unsigned (&h)[16], int o, float acc) {
    acc = d2_fp4<0>(w, h[o], acc); acc = d2_fp4<1>(w, h[o + 1], acc); acc = d2_fp4<2>(w, h[o + 2], acc); acc = d2_fp4<3>(w, h[o + 3], acc); return acc; }
__device__ __forceinline__ float dot32_fp4(const u32x4 w, const unsigned (&h)[16]) {
    float a0 = dot8_fp4(w.x, h, 0, 0.f), a1 = dot8_fp4(w.y, h, 4, 0.f); a0 = dot8_fp4(w.z, h, 8, a0); a1 = dot8_fp4(w.w, h, 12, a1); return a0 + a1; }
__device__ __forceinline__ void axpy8_fp4(unsigned w, f32x2 a2, f32x2 (&y)[16], int o) {
    y[o] += a2 * __builtin_amdgcn_cvt_scalef32_pk_f32_fp4(w, 1.0f, 0); y[o + 1] += a2 * __builtin_amdgcn_cvt_scalef32_pk_f32_fp4(w, 1.0f, 1);
    y[o + 2] += a2 * __builtin_amdgcn_cvt_scalef32_pk_f32_fp4(w, 1.0f, 2); y[o + 3] += a2 * __builtin_amdgcn_cvt_scalef32_pk_f32_fp4(w, 1.0f, 3); }
__device__ __forceinline__ void axpy32_fp4(const u32x4 w, float a, f32x2 (&y)[16]) {
    const f32x2 a2 = {a, a}; axpy8_fp4(w.x, a2, y, 0); axpy8_fp4(w.y, a2, y, 4); axpy8_fp4(w.z, a2, y, 8); axpy8_fp4(w.w, a2, y, 12); }
__device__ __forceinline__ void bstore16(__amdgpu_buffer_rsrc_t r, f32x4 v, int voff, int soff) { __builtin_amdgcn_raw_buffer_store_b128(__builtin_bit_cast(__attribute__((__vector_size__(4 * sizeof(unsigned)))) unsigned, v), r, voff, soff, 0); }
__device__ __forceinline__ void bstore8(__amdgpu_buffer_rsrc_t r, f32x2 v, int voff, int soff) { __builtin_amdgcn_raw_buffer_store_b64(__builtin_bit_cast(__attribute__((__vector_size__(2 * sizeof(unsigned)))) unsigned, v), r, voff, soff, 0); }
__device__ __forceinline__ f32x2 fsel2(int mask, f32x2 a, f32x2 b) { return (f32x2){fsel(mask, a.x, b.x), fsel(mask, a.y, b.y)}; }
__device__ __forceinline__ f32x2 shx2(f32x2 a, int o) { return (f32x2){__shfl_xor(a.x, o), __shfl_xor(a.y, o)}; }

__device__ __forceinline__ void phase_pd(const Params& p, LAS unsigned char* lds, int bid, int nb) {
    const int tid = threadIdx.x, lane = tid & 63, wave = __builtin_amdgcn_readfirstlane(tid >> 6);
    if (wave == 7) {
        const f32x4 z = {0.f, 0.f, 0.f, 0.f}; const f32x4 gg[2][4] = {{z, z, z, z}, {z, z, z, z}};
        for (int e = bid; e < 16384; e += 2 * nb) { const int e2 = e + nb < 16384 ? e + nb : e;
            fp4_row2<false>(p.up + (size_t)e * D, p.up8 + (size_t)e * 1024, p.sup + e, p.up + (size_t)e2 * D, p.up8 + (size_t)e2 * 1024, p.sup + e2, gg, lane); }
        return;
    }
    const int v = bid & 7, lw = (bid >> 3) * 7 + wave, NLW = (nb >> 3) * 7;
    const int c = lane & 7, sub = lane >> 3;
    const int m0 = -(lane & 1), m1 = -((lane >> 1) & 1), m2 = -((lane >> 2) & 1);
    const __amdgpu_buffer_rsrc_t rd = __builtin_amdgcn_make_buffer_rsrc((void*)p.down8, 0, 16384 * 1024, 0x00020000);
    const __amdgpu_buffer_rsrc_t rh = __builtin_amdgcn_make_buffer_rsrc((void*)p.h2b, 0, SEQ * D * 2, 0x00020000);
    const __amdgpu_buffer_rsrc_t ri = __builtin_amdgcn_make_buffer_rsrc((void*)p.idx, 0, SEQ * 128 * 2, 0x00020000);
    const __amdgpu_buffer_rsrc_t rp = __builtin_amdgcn_make_buffer_rsrc((void*)p.part, 0, SEQ * 8 * 128 * 2, 0x00020000);
    const int vsub = sub * 32, vc4 = c * 64, vc1 = c * 16, vl4 = lane * 4;
    u32x4 ix[2], hh[4];
    {
        const int t = lw;
#pragma unroll
        for (int i = 0; i < 2; ++i) ix[i] = bload16(ri, vsub, t * 256 + i * 16);
#pragma unroll
        for (int i = 0; i < 4; ++i) hh[i] = bload16(rh, vc4, t * 4096 + v * 512 + i * 16);
    }
#pragma unroll 1
    for (int t = lw; t < SEQ; t += NLW) {
        asm volatile("" ::: "memory");
        u32x4 w[16];
        {
            const unsigned ew[8] = {ix[0].x, ix[0].y, ix[0].z, ix[0].w, ix[1].x, ix[1].y, ix[1].z, ix[1].w};
#pragma unroll
            for (int g = 0; g < 16; ++g) { const unsigned e = (g & 1) ? (ew[g >> 1] >> 16) : (ew[g >> 1] & 0xffffu); w[g] = bload16(rd, (int)(e * 1024u) + vc1, v * 128); }
        }
        const unsigned hw[16] = {hh[0].x, hh[0].y, hh[0].z, hh[0].w, hh[1].x, hh[1].y, hh[1].z, hh[1].w, hh[2].x, hh[2].y, hh[2].z, hh[2].w, hh[3].x, hh[3].y, hh[3].z, hh[3].w};
        asm volatile("" ::: "memory");
        {
            const int tn = t + NLW < SEQ ? t + NLW : t;
#pragma unroll
            for (int i = 0; i < 2; ++i) ix[i] = bload16(ri, vsub, tn * 256 + i * 16);
#pragma unroll
            for (int i = 0; i < 4; ++i) hh[i] = bload16(rh, vc4, tn * 4096 + v * 512 + i * 16);
        }
        asm volatile("" ::: "memory");
        float r[16];
#pragma unroll
        for (int g = 0; g < 16; ++g) r[g] = dot32_fp4(w[g], hw);
        float k8[8], k4[4];
#pragma unroll
        for (int i = 0; i < 8; ++i) k8[i] = fsel(m2, r[i], r[i + 8]) + __shfl_xor(fsel(m2, r[i + 8], r[i]), 4);
#pragma unroll
        for (int i = 0; i < 4; ++i) k4[i] = fsel(m1, k8[i], k8[i + 4]) + __shfl_xor(fsel(m1, k8[i + 4], k8[i]), 2);
        const float k0 = fsel(m0, k4[0], k4[2]) + __shfl_xor(fsel(m0, k4[2], k4[0]), 1);
        const float k1 = fsel(m0, k4[1], k4[3]) + __shfl_xor(fsel(m0, k4[3], k4[1]), 1);
        bstore4(rp, cvt_pk_bf16(k0, k1), vl4, (t * 8 + v) * 256);
    }
}
__device__ __forceinline__ void phase_pa(const Params& p, int bid, int nb) {
    const int tid = threadIdx.x, lane = tid & 63, wave = tid >> 6;
    const int gw = bid * 8 + wave, NGW = nb * 8;
    for (int it = gw; it < SEQ * 2; it += NGW) {
        const int t = it >> 1, pp = (it & 1) * 64 + lane;
        const bf16_t* pr = p.part + (size_t)t * 1024 + pp;
        float hs = 0.f;
#pragma unroll
        for (int sl = 0; sl < 8; ++sl) hs += __uint_as_float((unsigned)pr[sl * 128] << 16);
        const int e = (int)p.idx[(size_t)t * 128 + pp];
        hs *= p.sdn[e] * p.rstd[t];
        const float av = p.gsu[(size_t)t * 128 + pp] * p.sup[e] * 0.5f * hs * (1.0f + erff(hs * 0.70710678118654752f));
        p.act[(size_t)t * 128 + pp] = (bf16_t)(cvt_pk_bf16(av, 0.f) & 0xffffu);
    }
}
__device__ __forceinline__ void phase_pu(const Params& p, int bid, int nb) {
    const int tid = threadIdx.x, lane = tid & 63, wave = __builtin_amdgcn_readfirstlane(tid >> 6);
    const int v = bid & 7, lw = (bid >> 3) * 8 + wave, NLW = (nb >> 3) * 8;
    const int c = lane & 7, sub = lane >> 3;
    const int m3 = -((lane >> 3) & 1), m4 = -((lane >> 4) & 1), m5 = -((lane >> 5) & 1);
    const __amdgpu_buffer_rsrc_t ru = __builtin_amdgcn_make_buffer_rsrc((void*)p.up8, 0, 16384 * 1024, 0x00020000);
    const __amdgpu_buffer_rsrc_t rh = __builtin_amdgcn_make_buffer_rsrc((void*)p.h2b, 0, SEQ * D * 2, 0x00020000);
    const __amdgpu_buffer_rsrc_t ri = __builtin_amdgcn_make_buffer_rsrc((void*)p.idx, 0, SEQ * 128 * 2, 0x00020000);
    const __amdgpu_buffer_rsrc_t ra = __builtin_amdgcn_make_buffer_rsrc((void*)p.act, 0, SEQ * 128 * 2, 0x00020000);
    const __amdgpu_buffer_rsrc_t ro = __builtin_amdgcn_make_buffer_rsrc((void*)p.h3b, 0, SEQ * D * 2, 0x00020000);
    const __amdgpu_buffer_rsrc_t rq = __builtin_amdgcn_make_buffer_rsrc((void*)p.ssq2, 0, SEQ * 8 * 4, 0x00020000);
    const int vsub = sub * 32, vc1 = c * 16, vh = c * 64 + sub * 8;
    u32x4 ix[2], ac[2]; u32x2 hb;
    {
        const int t = lw;
#pragma unroll
        for (int i = 0; i < 2; ++i) { ix[i] = bload16(ri, vsub, t * 256 + i * 16); ac[i] = bload16(ra, vsub, t * 256 + i * 16); }
        hb = bload8(rh, vh, t * 4096 + v * 512);
    }
#pragma unroll 1
    for (int t = lw; t < SEQ; t += NLW) {
        asm volatile("" ::: "memory");
        u32x4 w[16];
        {
            const unsigned ew[8] = {ix[0].x, ix[0].y, ix[0].z, ix[0].w, ix[1].x, ix[1].y, ix[1].z, ix[1].w};
#pragma unroll
            for (int g = 0; g < 16; ++g) { const unsigned e = (g & 1) ? (ew[g >> 1] >> 16) : (ew[g >> 1] & 0xffffu); w[g] = bload16(ru, (int)(e * 1024u) + vc1, v * 128); }
        }
        const unsigned aw[8] = {ac[0].x, ac[0].y, ac[0].z, ac[0].w, ac[1].x, ac[1].y, ac[1].z, ac[1].w};
        float a[16];
#pragma unroll
        for (int g = 0; g < 16; ++g) a[g] = (g & 1) ? bf_hi(aw[g >> 1]) : bf_lo(aw[g >> 1]);
        const u32x2 hcur = hb;
        asm volatile("" ::: "memory");
        {
            const int tn = t + NLW < SEQ ? t + NLW : t;
#pragma unroll
            for (int i = 0; i < 2; ++i) { ix[i] = bload16(ri, vsub, tn * 256 + i * 16); ac[i] = bload16(ra, vsub, tn * 256 + i * 16); }
            hb = bload8(rh, vh, tn * 4096 + v * 512);
        }
        asm volatile("" ::: "memory");
        f32x2 acc[16];
#pragma unroll
        for (int i = 0; i < 16; ++i) acc[i] = (f32x2){0.f, 0.f};
#pragma unroll
        for (int g = 0; g < 16; ++g) axpy32_fp4(w[g], a[g], acc);
        f32x2 k8[8], k4[4];
#pragma unroll
        for (int i = 0; i < 8; ++i) k8[i] = fsel2(m5, acc[i], acc[i + 8]) + shx2(fsel2(m5, acc[i + 8], acc[i]), 32);
#pragma unroll
        for (int i = 0; i < 4; ++i) k4[i] = fsel2(m4, k8[i], k8[i + 4]) + shx2(fsel2(m4, k8[i + 4], k8[i]), 16);
        f32x2 ha = fsel2(m3, k4[0], k4[2]) + shx2(fsel2(m3, k4[2], k4[0]), 8);
        f32x2 hc = fsel2(m3, k4[1], k4[3]) + shx2(fsel2(m3, k4[3], k4[1]), 8);
        ha += (f32x2){bf_lo(hcur.x), bf_hi(hcur.x)}; hc += (f32x2){bf_lo(hcur.y), bf_hi(hcur.y)};
        u32x2 ov; ov.x = cvt_pk_bf16(ha.x, ha.y); ov.y = cvt_pk_bf16(hc.x, hc.y);
        __builtin_amdgcn_raw_buffer_store_b64(__builtin_bit_cast(__attribute__((__vector_size__(2 * sizeof(unsigned)))) unsigned, ov), ro, vh, t * 4096 + v * 512, 0);
        const float ss = wave_sum((ha.x * ha.x + ha.y * ha.y) + (hc.x * hc.x + hc.y * hc.y));
        if (lane == 0) bstore4(rq, __float_as_uint(ss), 0, (t * 8 + v) * 4);
    }
}
__device__ __forceinline__ void phase_pf(const Params& p, int bid, int nb) {
    const int tid = threadIdx.x, lane = tid & 63, wave = tid >> 6;
    const int gw = bid * 8 + wave, NGW = nb * 8;
    for (int t = gw; t < SEQ; t += NGW) {
        const f32x4* sp = (const f32x4*)(p.ssq2 + (size_t)t * 8); f32x4 q = sp[0] + sp[1];
        const float rf = rsqrtf(((q[0] + q[1]) + (q[2] + q[3])) * (1.0f / D) + 1e-6f);
        const u32x4* hp = (const u32x4*)(p.h3b + (size_t)t * D) + lane;
        f32x4* o = (f32x4*)(p.out + (size_t)t * D) + 2 * lane; const f32x4* g = (const f32x4*)p.fin_g + 2 * lane;
#pragma unroll
        for (int j = 0; j < 4; ++j) { const u32x4 h = hp[64 * j]; const f32x4 g0 = g[128 * j], g1 = g[128 * j + 1];
            o[128 * j] = (f32x4){bf_lo(h.x) * rf * g0[0], bf_hi(h.x) * rf * g0[1], bf_lo(h.y) * rf * g0[2], bf_hi(h.y) * rf * g0[3]};
            o[128 * j + 1] = (f32x4){bf_lo(h.z) * rf * g1[0], bf_hi(h.z) * rf * g1[1], bf_lo(h.w) * rf * g1[2], bf_hi(h.w) * rf * g1[3]}; }
    }
}

__device__ __forceinline__ void fp8_row(const float* src, unsigned char* dst, float* inv_scale, int lane) {
    f32x4 v[2][4]; float am = 0.f;
#pragma unroll
    for (int k = 0; k < 2; ++k)
#pragma unroll
        for (int i = 0; i < 4; ++i) { v[k][i] = *(const f32x4*)(src + 1024 * k + 16 * lane + 4 * i);
            am = fmaxf(am, fmaxf(fmaxf(fabsf(v[k][i].x), fabsf(v[k][i].y)), fmaxf(fabsf(v[k][i].z), fabsf(v[k][i].w)))); }
#pragma unroll
    for (int o = 1; o < 64; o <<= 1) am = fmaxf(am, __shfl_xor(am, o));
    int be = (__float_as_int(am) >> 23) & 255; be = be < 8 ? 8 : (be > 248 ? 248 : be);
    const float sc = __int_as_float((260 - be) << 23), isc = __int_as_float((be - 6) << 23);
#pragma unroll
    for (int k = 0; k < 2; ++k) { u32x4 w; unsigned ww[4];
#pragma unroll
        for (int i = 0; i < 4; ++i) { int t = 0; t = __builtin_amdgcn_cvt_pk_fp8_f32(v[k][i].x * sc, v[k][i].y * sc, t, false); t = __builtin_amdgcn_cvt_pk_fp8_f32(v[k][i].z * sc, v[k][i].w * sc, t, true); ww[i] = (unsigned)t; }
        w.x = ww[0]; w.y = ww[1]; w.z = ww[2]; w.w = ww[3];
        *(u32x4*)(dst + 1024 * k + 16 * lane) = w; }
    if (lane == 0) *inv_scale = isc;
}

__device__ __forceinline__ void tr_item(const float* W, int ldw, int srccol0, int k0, bf16_t* WT, int ldt, int n0, const float* kscale, const float* nscale, LAS float* scr, int lane) {
    f32x4 tv[8];
#pragma unroll
    for (int i = 0; i < 8; ++i) { const int kk = 8 * i + (lane >> 3); tv[i] = __builtin_nontemporal_load((const f32x4*)(W + (size_t)(k0 + kk) * ldw + srccol0 + 4 * (lane & 7))); }
    f32x4 ns = {1.f, 1.f, 1.f, 1.f};
    if (nscale) ns = *(const f32x4*)(nscale + srccol0 + 4 * (lane & 7));
#pragma unroll
    for (int i = 0; i < 8; ++i) { const int kk = 8 * i + (lane >> 3); f32x4 v = tv[i] * ns;
        if (kscale) v *= kscale[k0 + kk];
        LAS float* d = scr + kk * 33 + 4 * (lane & 7); d[0] = v[0]; d[1] = v[1]; d[2] = v[2]; d[3] = v[3]; }
    asm volatile("s_waitcnt lgkmcnt(0)" ::: "memory");
    const int c = lane & 7;
#pragma unroll
    for (int j = 0; j < 4; ++j) { const int n = (lane >> 3) + 8 * j; const LAS float* s = scr + (8 * c) * 33 + n;
        u32x4 o; o.x = cvt_pk_bf16(s[0 * 33], s[1 * 33]); o.y = cvt_pk_bf16(s[2 * 33], s[3 * 33]); o.z = cvt_pk_bf16(s[4 * 33], s[5 * 33]); o.w = cvt_pk_bf16(s[6 * 33], s[7 * 33]);
        *(u32x4*)(WT + (size_t)(n0 + n) * ldt + k0 + 8 * c) = o; }
    asm volatile("s_waitcnt lgkmcnt(0)" ::: "memory");
}
__device__ __forceinline__ int win_srccol(int n) { const int pn = n >> 8, w = n & 255; return pn < 4 ? n : ((w >> 7) ? 2048 : 1024) + (pn - 4) * 128 + (w & 127); }

__device__ __forceinline__ void phase_prep(const Params& p, LAS unsigned char* lds, int bid, int nb, int nlate) {
    const int tid = threadIdx.x, lane = tid & 63, wave = tid >> 6;
    const int gw = bid * 8 + wave, NGW = nb * 8;
    LAS float* scr = (LAS float*)(lds + wave * 8448);
    for (int r = gw; r < RT; r += NGW) {
        unsigned long long* o8 = (unsigned long long*)(p.hnb + (size_t)r * D) + lane;
        if (r < RPAD) {
#pragma unroll
            for (int j = 0; j < 8; ++j) o8[64 * j] = 0ull;
            if (lane == 0) p.rstd1[r] = 0.f;
        } else {
            const f32x4* xr = (const f32x4*)hrow(p, r - RPAD) + lane;
            f32x4 v[8]; float s = 0.f;
#pragma unroll
            for (int j = 0; j < 8; ++j) { v[j] = __builtin_nontemporal_load(xr + 64 * j); s += (v[j].x * v[j].x + v[j].y * v[j].y) + (v[j].z * v[j].z + v[j].w * v[j].w); }
            const float rs = rsqrtf(wave_sum(s) * (1.0f / D) + 1e-6f);
            if (lane == 0) p.rstd1[r] = rs;
#pragma unroll
            for (int j = 0; j < 8; ++j)
                o8[64 * j] = (unsigned long long)cvt_pk_bf16(v[j].x, v[j].y) | ((unsigned long long)cvt_pk_bf16(v[j].z, v[j].w) << 32);
        }
    }
    for (int it = gw; it < (D / 64) * (INW / 32); it += NGW) {
        const int kb = it / (INW / 32), nbk = it % (INW / 32);
        tr_item(p.w_in, INW, win_srccol(nbk * 32), kb * 64, p.w_in_t, D, nbk * 32, p.mix_g, nullptr, scr, lane);
    }
    for (int i = gw * 64 + lane; i < 4 * 256 * 256 / 4; i += NGW * 64) { const f32x4 v = ((const f32x4*)p.pool_w)[i];
        const int g = i >> 14, d = (i & 63) * 4; const f32x4 sc = *(const f32x4*)(p.pool_scale + g * 256 + d);
        u32x2 w; w.x = cvt_pk_bf16(v[0] * sc[0], v[1] * sc[1]); w.y = cvt_pk_bf16(v[2] * sc[2], v[3] * sc[3]); ((u32x2*)p.pool_ws)[i] = w; }
    for (int i = gw * 64 + lane; i < CWD * CWD / 4; i += NGW * 64) { const f32x4 v = ((const f32x4*)p.pw_w)[i];
        u32x2 w; w.x = cvt_pk_bf16(v[0], v[1]); w.y = cvt_pk_bf16(v[2], v[3]); ((u32x2*)p.pw_b16)[i] = w; }
    for (int it = gw; it < 32 * 64; it += NGW) { const int kb = it >> 6, nbk = it & 63;
        tr_item(p.w_out, D, nbk * 32, kb * 64, p.w_out_t, D, nbk * 32, nullptr, nullptr, scr, lane); }
    for (int it = gw; it < 32 * 64; it += NGW) { const int kb = it >> 6, nbk = it & 63;
        tr_item(p.wq, D, nbk * 32, kb * 64, p.wq_t, D, nbk * 32, p.ffn_g, nullptr, scr, lane); }
    for (int i = gw * 64 + lane; i < 8 * 2 * 128 * 128 / 4; i += NGW * 64) { const f32x4 v = ((const f32x4*)p.keys)[i];
        u32x2 w; w.x = cvt_pk_bf16(v[0], v[1]); w.y = cvt_pk_bf16(v[2], v[3]); ((u32x2*)p.keysb)[i] = w; }
    f32x4 gg[2][4];
#pragma unroll
    for (int k = 0; k < 2; ++k)
#pragma unroll
        for (int i = 0; i < 4; ++i) gg[k][i] = *(const f32x4*)(p.ffn_g + 1024 * k + 16 * lane + 4 * i);
    for (int e = gw; e < 16384 - nlate; e += 2 * NGW) { const int e2 = e + NGW < 16384 - nlate ? e + NGW : e;
        fp4_row2<true>(p.down + (size_t)e * D, p.down8 + (size_t)e * 1024, p.sdn + e, p.down + (size_t)e2 * D, p.down8 + (size_t)e2 * 1024, p.sdn + e2, gg, lane); }
}


#define XB_TMO      128
#define XB_XCNT(j)  (256  + 64 * (j))
#define XB_XSUB(j)  (1280 + 64 * (j))
#define XB_XGEN(j)  (2304 + 64 * (j))
#define XB_TOP      3328
#define XB_TOPGEN   3392
#define XCD_BAR_WORDS 3456
#define XB_SPIN_CAP (1u << 18)
__device__ __forceinline__ unsigned xb_ld(unsigned* p)              { return __hip_atomic_load(p, __ATOMIC_RELAXED, __HIP_MEMORY_SCOPE_AGENT); }
__device__ __forceinline__ unsigned xb_add(unsigned* p, unsigned v) { return __hip_atomic_fetch_add(p, v, __ATOMIC_RELAXED, __HIP_MEMORY_SCOPE_AGENT); }
__device__ __forceinline__ unsigned xb_xcc_id() { return (unsigned)__builtin_amdgcn_s_getreg((3 << 11) | 20) & 0xFu; }
#define XB_SPIN(cond, bar) do { unsigned _sp = 0; while (cond) { __builtin_amdgcn_s_sleep(1); \
    if ((++_sp & 255u) == 0u) { if (xb_ld(&(bar)[XB_TMO])) break; if (_sp > XB_SPIN_CAP) { atomicAdd(&(bar)[XB_TMO], 1u); break; } } } } while (0)
struct XcdBarrier { unsigned* bar; unsigned x; volatile LAS unsigned* st; };
__device__ __forceinline__ XcdBarrier xcd_barrier_post(unsigned* bar, volatile LAS unsigned* st) {
    XcdBarrier b; b.bar = bar; b.x = xb_xcc_id(); b.st = st;
    if (threadIdx.x == 0) (void)xb_add(&bar[XB_XCNT(b.x)], 1u);
    return b;
}
__device__ __forceinline__ void xcd_barrier_complete(unsigned* bar, unsigned x, unsigned& nloc, unsigned& nx) {
    const unsigned G = gridDim.x * gridDim.y * gridDim.z;
    unsigned sum, cnt, mine, sp = 0u;
    for (;;) {
        sum = 0u; cnt = 0u; mine = 0u;
#pragma unroll
        for (unsigned j = 0; j < 16; ++j) { const unsigned c = xb_ld(&bar[XB_XCNT(j)]); sum += c; cnt += (c > 0u) ? 1u : 0u; mine = (j == x) ? c : mine; }
        if (sum == G) break;
        __builtin_amdgcn_s_sleep(1);
        if ((++sp & 255u) == 0u) { if (xb_ld(&bar[XB_TMO])) break; if (sp > XB_SPIN_CAP) { atomicAdd(&bar[XB_TMO], 1u); break; } }
    }
    nloc = mine > 0u ? mine : 1u; nx = cnt > 0u ? cnt : 1u;
}
__device__ __forceinline__ void xcd_barrier(const XcdBarrier& b) {
    asm volatile("s_waitcnt vmcnt(0)" ::: "memory");
    __syncthreads();
    if (threadIdx.x == 0) {
        unsigned* bar = b.bar;
        __builtin_amdgcn_s_waitcnt(0);
        unsigned nloc = b.st[0], nx = b.st[1];
        if (nloc == 0u) { xcd_barrier_complete(bar, b.x, nloc, nx); b.st[0] = nloc; b.st[1] = nx; }
        const unsigned old = xb_add(&bar[XB_XSUB(b.x)], 1u);
        const unsigned gen = old / nloc;
        if (old + 1u == (gen + 1u) * nloc) {
            __builtin_amdgcn_fence(__ATOMIC_RELEASE, "agent");
            asm volatile("s_waitcnt vmcnt(0)" ::: "memory");
            const unsigned og = xb_add(&bar[XB_TOP], 1u);
            const unsigned tg = og / nx;
            if (og + 1u == (tg + 1u) * nx) xb_add(&bar[XB_TOPGEN], 1u);
            else XB_SPIN(xb_ld(&bar[XB_TOPGEN]) == tg, bar);
            __builtin_amdgcn_fence(__ATOMIC_ACQUIRE, "agent");
            xb_add(&bar[XB_XGEN(b.x)], 1u);
            asm volatile("s_waitcnt vmcnt(0)" ::: "memory");
        } else {
            XB_SPIN(xb_ld(&bar[XB_XGEN(b.x)]) == gen, bar);
            __builtin_amdgcn_fence(__ATOMIC_ACQUIRE, "agent");
            asm volatile("s_waitcnt vmcnt(0)" ::: "memory");
        }
    }
    __syncthreads();
}

__global__ void __launch_bounds__(NT, 2) k_mega(Params p) {
    extern __shared__ __attribute__((aligned(16))) unsigned char lds_raw[];
    LAS unsigned char* lds = (LAS unsigned char*)lds_raw;
    const int bid = blockIdx.x, nb = gridDim.x;
    volatile LAS unsigned* bst = (volatile LAS unsigned*)(lds + LDS_BYTES - 16);
    if (threadIdx.x < 4) bst[threadIdx.x] = 0u;
    __syncthreads();
    const XcdBarrier xb = xcd_barrier_post(p.bar, bst);
    const int nproj0 = (RT / 256) * (INW / 256); const int first0 = (nproj0 > nb && nproj0 < 2 * nb) ? nproj0 - nb : 0;
    const int lateb0 = first0 + 32, nlateb = (first0 > 0 && nb - lateb0 > 0) ? nb - lateb0 : 0;
    const int nlate = nlateb * 8 * 8;
    phase_prep(p, lds, bid, nb, nlate);
    xcd_barrier(xb);
    { pg8::Gemm g{p.hnb, p.w_in_t, D, D, D, 0}; pg8::StaticOrder S; S.init(RT / 256, INW / 256, nb, bid); EpiProj E{p.xp, p.glu, p.rstd1};
      pg8::gemm_phase<EpiProj, pg8::StaticOrder>(lds, g, S, E); }
    { const int nproj = (RT / 256) * (INW / 256); const int first = (nproj > nb && nproj < 2 * nb) ? nproj - nb : 0, nfree = nb - first;
      for (int uu = bid - first; uu >= 0 && uu < 64; uu += nfree) {
        __syncthreads();
        const bool pw = uu < 32;
        pg8::Gemm g{pw ? p.w_out_t + PWD : p.w_out_t, pw ? p.pw_b16 : p.pool_ws, D, pw ? CWD : 256, pw ? CWD : 256, pw ? 0 : 256};
        pg8::OneUnit S; S.u.pm = (uu & 31) >> 2; S.u.pn = uu & 3; EpiBf16Out E{p.w_eff_t, D, pw ? PWD : 0, nullptr};
        pg8::gemm_phase<EpiBf16Out, pg8::OneUnit>(lds, g, S, E);
      }
      { const int b0 = nfree >= 96 ? first + 64 : 0;
        for (int nbk = bid - b0; nbk >= 0 && nbk < D / 64; nbk += nb) {
          __syncthreads();
          const int lane = threadIdx.x & 63, wv = threadIdx.x >> 6, n = nbk * 64 + lane;
          float a[8] = {0.f, 0.f, 0.f, 0.f, 0.f, 0.f, 0.f, 0.f};
          for (int j = wv * 128; j < wv * 128 + 128; j += 8) {
#pragma unroll
            for (int q = 0; q < 8; ++q) a[q] += p.pw_b[j + q] * p.w_out[(size_t)(PWD + j + q) * D + n]; }
          LAS float* red = (LAS float*)lds;
          red[wv * 64 + lane] = ((a[0] + a[1]) + (a[2] + a[3])) + ((a[4] + a[5]) + (a[6] + a[7]));
          __syncthreads();
          if (wv == 0) { float t = 0.f;
#pragma unroll
            for (int q = 0; q < 8; ++q) t += red[q * 64 + lane];
            p.bias_eff[n] = t; }
        } }
      if (nlateb > 0 && bid >= lateb0) { const int lane = threadIdx.x & 63, lwv = (bid - lateb0) * 8 + (int)(threadIdx.x >> 6), nlw = nlateb * 8;
        f32x4 gg[2][4];
#pragma unroll
        for (int k = 0; k < 2; ++k)
#pragma unroll
          for (int i = 0; i < 4; ++i) gg[k][i] = *(const f32x4*)(p.ffn_g + 1024 * k + 16 * lane + 4 * i);
        for (int e = 16384 - nlate + lwv; e < 16384; e += 2 * nlw) { const int e2 = e + nlw < 16384 ? e + nlw : e;
          fp4_row2<true>(p.down + (size_t)e * D, p.down8 + (size_t)e * 1024, p.sdn + e, p.down + (size_t)e2 * D, p.down8 + (size_t)e2 * 1024, p.sdn + e2, gg, lane); } }
    }
    xcd_barrier(xb);
    phase_mix(p, lds, bid, nb);
    xcd_barrier(xb);
    { pg8::Gemm g{p.mixb, p.w_eff_t, D, D, D, 0}; pg8::StaticOrder S; S.init(SEQ / 256, D / 256, nb, bid); EpiResid E{p.hnb, p.bias_eff, p.h2b, p.ssq};
      pg8::gemm_phase<EpiResid, pg8::StaticOrder>(lds, g, S, E); }
    xcd_barrier(xb);
    { pg8::Gemm g{p.h2b, p.wq_t, D, D, D, 0}; pg8::StaticOrder S; S.init(SEQ / 256, D / 256, nb, bid); EpiQTopk E{p.ssq, p.rstd, p.keysb, p.idx, p.gsu};
      pg8::gemm_phase<EpiQTopk, pg8::StaticOrder>(lds, g, S, E); }
    xcd_barrier(xb);
    phase_pd(p, lds, bid, nb);
    xcd_barrier(xb);
    phase_pa(p, bid, nb);
    xcd_barrier(xb);
    phase_pu(p, bid, nb);
    xcd_barrier(xb);
    phase_pf(p, bid, nb);
}

extern "C" void kernel_launch(void* const* d_in, const int* in_sizes, int n_in, void* d_out, int out_size, void* d_ws, size_t ws_size, hipStream_t stream) {
    Params p{};
    p.x = (const float*)d_in[0]; p.meta = (const float*)d_in[1]; p.mix_g = (const float*)d_in[2]; p.w_in = (const float*)d_in[3];
    p.pool_w = (const float*)d_in[4]; p.pool_scale = (const float*)d_in[5]; p.dw_w = (const float*)d_in[6]; p.dw_b = (const float*)d_in[7];
    p.ln_g = (const float*)d_in[8]; p.ln_b = (const float*)d_in[9]; p.pw_w = (const float*)d_in[10]; p.pw_b = (const float*)d_in[11];
    p.w_out = (const float*)d_in[12]; p.ffn_g = (const float*)d_in[13]; p.wq = (const float*)d_in[14]; p.keys = (const float*)d_in[15];
    p.down = (const float*)d_in[16]; p.up = (const float*)d_in[17]; p.fin_g = (const float*)d_in[18];
    p.out = (float*)d_out;
    char* w = (char*)d_ws; size_t off = 0;
    auto take = [&](size_t bytes) { char* r = w + off; off += (bytes + 255) & ~(size_t)255; return r; };
    p.idx = (unsigned short*)take((size_t)SEQ * 128 * 2);
    p.gsu = (float*)take((size_t)SEQ * 128 * 4);
    p.part = (bf16_t*)take((size_t)SEQ * 8 * 128 * 2);
    p.act = (bf16_t*)take((size_t)SEQ * 128 * 2);
    p.ssq2 = (float*)take((size_t)SEQ * 16 * 4);
    p.h3b = (bf16_t*)take((size_t)SEQ * D * 2);
    p.hnb = (bf16_t*)take((size_t)RT * D * 2);
    p.rstd1 = (float*)take((size_t)RT * 4);
    p.w_in_t = (bf16_t*)take((size_t)INW * D * 2);
    p.xp = (bf16_t*)take((size_t)RT * PWD * 2);
    p.glu = (bf16_t*)take((size_t)RT * CWD * 2);
    p.mixb = (bf16_t*)take((size_t)SEQ * D * 2);
    p.h2b = (bf16_t*)take((size_t)SEQ * D * 2);
    p.pool_ws = (bf16_t*)take((size_t)4 * 256 * 256 * 2);
    p.pw_b16 = (bf16_t*)take((size_t)CWD * CWD * 2);
    p.w_eff_t = (bf16_t*)take((size_t)D * D * 2);
    p.bias_eff = (float*)take((size_t)D * 4);
    p.w_out_t = (bf16_t*)take((size_t)D * D * 2);
    p.ssq = (float*)take((size_t)SEQ * 32 * 4);
    p.bar = (unsigned*)take((size_t)XCD_BAR_WORDS * 4);
    p.rstd = (float*)take((size_t)SEQ * 4);
    p.wq_t = (bf16_t*)take((size_t)D * D * 2);
    p.keysb = (bf16_t*)take((size_t)8 * 2 * 128 * 128 * 2);
    p.qb = (bf16_t*)take((size_t)SEQ * D * 2);
    p.down8 = (unsigned char*)take((size_t)16384 * D);
    p.up8 = (unsigned char*)take((size_t)16384 * D);
    p.sdn = (float*)take((size_t)16384 * 4);
    p.sup = (float*)take((size_t)16384 * 4);
    static int grid_blocks = 0;
    if (!grid_blocks) {
        int dev = 0, cus = 0, per_cu = 0;
        (void)hipGetDevice(&dev);
        (void)hipDeviceGetAttribute(&cus, hipDeviceAttributeMultiprocessorCount, dev);
        (void)hipFuncSetAttribute((const void*)k_mega, hipFuncAttributeMaxDynamicSharedMemorySize, LDS_BYTES);
        (void)hipOccupancyMaxActiveBlocksPerMultiprocessor(&per_cu, k_mega, NT, LDS_BYTES);
        if (per_cu < 1) { fprintf(stderr, "occupancy query says %d workgroups per CU: nothing launched\n", per_cu); grid_blocks = -1; }
        else if (cus != (SEQ / 256) * (D / 256)) { fprintf(stderr, "this build needs a %d-CU device (got %d): nothing launched\n", (SEQ / 256) * (D / 256), cus); grid_blocks = -1; }
        else grid_blocks = cus;
    }
    if (grid_blocks < 0) return;
    (void)hipMemsetAsync(p.bar, 0, (size_t)XCD_BAR_WORDS * 4, stream);
    void* args[] = {&p};
    hipError_t e = hipLaunchCooperativeKernel((void*)k_mega, dim3(grid_blocks), dim3(NT), args, LDS_BYTES, stream);
    if (e != hipSuccess) fprintf(stderr, "cooperative launch failed: %s (grid %d)\n", hipGetErrorString(e), grid_blocks);
}
```
